# Optimizing an MI355X kernel written in HIP

```python
import math
import jax, jax.numpy as jnp
from jax import lax
import numpy as np

D_MODEL = 1024
BATCH = 8
SEQ = 8192
DEPTH = 4

EPS = 1e-6
GLA_HEADS = 4
GLA_DK = 48
GLA_DV = 96
GLA_GATE_RANK = 16
GLA_GATE_NORM = 16.0
GLA_CHUNK = 64
DSA_HEADS = 6
DSA_DH = 64
IDX_HEADS = 4
IDX_DIM = 32
TOPK_MAX = 256
QUERY_BLOCK = 128
POOL_GROUPS = 4
POOL_GC = 64
POOL_WINDOWS = (2, 4, 8, 16)
REL_BUCKETS = 32
REL_MAX_DIST = 128

GLA_W = GLA_HEADS * GLA_DV
DSA_W = DSA_HEADS * DSA_DH
POOL_W = POOL_GROUPS * POOL_GC
D_MIX = GLA_W + DSA_W + POOL_W

IN_SIZES = (
    GLA_HEADS * GLA_DK,
    GLA_HEADS * GLA_DK,
    GLA_W,
    GLA_GATE_RANK,
    GLA_W,
    DSA_W,
    DSA_W,
    DSA_W,
    DSA_W,
    IDX_HEADS * IDX_DIM,
    IDX_DIM,
    IDX_HEADS,
    POOL_W,
    POOL_W,
)
IN_COLS = sum(IN_SIZES)

kernel_name = 'hybrid_gla_dsa_pool'


def split_cols(p):
    outs = []
    off = 0
    for s in IN_SIZES:
        outs.append(p[..., off:off + s])
        off += s
    return outs


def rmsnorm(x, g):
    xf = x.astype(jnp.float32)
    y = xf * lax.rsqrt(jnp.mean(xf * xf, axis=-1, keepdims=True) + EPS)
    return (y * g.astype(jnp.float32)).astype(x.dtype)


def t5_bucket(rel):
    rel = jnp.maximum(rel, 0)
    max_exact = REL_BUCKETS // 2
    relf = jnp.maximum(rel, 1).astype(jnp.float32)
    large = max_exact + (jnp.log(relf / max_exact) / math.log(REL_MAX_DIST / max_exact)
                         * (REL_BUCKETS - max_exact)).astype(jnp.int32)
    large = jnp.minimum(large, REL_BUCKETS - 1)
    return jnp.where(rel < max_exact, rel, large)


def gla_mixer(q, k, v, glog):
    B, T, H, dk = q.shape
    dv = v.shape[-1]
    N = T // GLA_CHUNK
    def chunk(a):
        return a.astype(jnp.float32).reshape(B, N, GLA_CHUNK, H, a.shape[-1])
    qf, kf, vf, gf = chunk(q), chunk(k), chunk(v), chunk(glog)
    b = jnp.cumsum(gf, axis=2)
    b_last = b[:, :, -1:]
    qe = qf * jnp.exp(b) * (dk ** -0.5)
    ke = kf * jnp.exp(-b)
    kd = kf * jnp.exp(b_last - b)
    A = jnp.einsum('bnihd,bnjhd->bnhij', qe, ke)
    tril = jnp.tril(jnp.ones((GLA_CHUNK, GLA_CHUNK), dtype=bool))
    A = jnp.where(tril, A, 0.0)
    o_intra = jnp.einsum('bnhij,bnjhv->bnihv', A, vf)
    U = jnp.einsum('bnjhd,bnjhv->bnhdv', kd, vf)
    decay = jnp.exp(b_last[:, :, 0])
    def step(S, inp):
        dec, u = inp
        return dec[..., None] * S + u, S
    S0 = jnp.zeros((B, H, dk, dv), jnp.float32)
    _, S_prev = lax.scan(step, S0, (jnp.moveaxis(decay, 1, 0), jnp.moveaxis(U, 1, 0)))
    S_prev = jnp.moveaxis(S_prev, 0, 1)
    o_inter = jnp.einsum('bnihd,bnhdv->bnihv', qe, S_prev)
    return (o_intra + o_inter).reshape(B, T, H, dv)


def dsa_mixer(q, k, v, q_idx, k_idx, w_idx, rel_bias):
    B, T, H, dh = q.shape
    topk = min(TOPK_MAX, T // 4)
    NB = T // QUERY_BLOCK
    def blk(a):
        return jnp.moveaxis(a.reshape(B, NB, QUERY_BLOCK, *a.shape[2:]), 1, 0)
    pos_blk = jnp.arange(T, dtype=jnp.int32).reshape(NB, QUERY_BLOCK)
    key_pos = jnp.arange(T, dtype=jnp.int32)
    kidx_f = k_idx.astype(jnp.float32)
    rb = rel_bias.astype(jnp.float32)

    def body(args):
        qb, qib, wb, tq = args
        s = jax.nn.relu(jnp.einsum('bqhd,bsd->bqhs', qib.astype(jnp.float32), kidx_f)
                        * (IDX_DIM ** -0.5))
        score = jnp.einsum('bqhs,bqh->bqs', s, wb.astype(jnp.float32) * (IDX_HEADS ** -0.5))
        visible = key_pos[None, :] <= tq[:, None]
        score = jnp.where(visible[None], score, -jnp.inf)
        _, idx = lax.top_k(score, topk)
        kg = jax.vmap(lambda kk, ii: kk[ii])(k, idx)
        vg = jax.vmap(lambda vv, ii: vv[ii])(v, idx)
        logits = jnp.einsum('bqhd,bqkhd->bhqk', qb.astype(jnp.float32),
                            kg.astype(jnp.float32)) * (dh ** -0.5)
        rel = tq[None, :, None] - idx
        bias = rb[t5_bucket(rel)]
        logits = logits + jnp.moveaxis(bias, -1, 1)
        logits = jnp.where((rel >= 0)[:, None], logits, -1e30)
        p = jax.nn.softmax(logits, axis=-1)
        o = jnp.einsum('bhqk,bqkhd->bqhd', p, vg.astype(jnp.float32))
        return o.astype(q.dtype)

    o = lax.map(body, (blk(q), blk(q_idx), blk(w_idx), pos_blk))
    return jnp.moveaxis(o, 0, 1).reshape(B, T, H * dh)


def pool_mixer(u, pool_w, pool_scale):
    B, T, _ = u.shape
    ug = u.astype(jnp.float32).reshape(B, T, POOL_GROUPS, POOL_GC)
    cs = jnp.cumsum(ug, axis=1)
    pos = jnp.arange(T, dtype=jnp.int32)
    outs = []
    for gi, w in enumerate(POOL_WINDOWS):
        c = cs[:, :, gi]
        lower = jnp.pad(c, ((0, 0), (w, 0), (0, 0)))[:, :T]
        cnt = jnp.minimum(pos + 1, w).astype(jnp.float32)[None, :, None]
        outs.append((c - lower) / cnt - ug[:, :, gi])
    pooled = jnp.stack(outs, axis=2)
    y = jnp.einsum('btgc,gcd->btgd', pooled, pool_w.astype(jnp.float32)).reshape(B, T, POOL_W)
    return (y * pool_scale.astype(jnp.float32)).astype(u.dtype)


def setup_inputs(seed: int = 0) -> dict:
    key = jax.random.key(seed)
    ks = jax.random.split(key, 12)
    f = jnp.float32
    x = jax.random.normal(ks[0], (BATCH, SEQ, D_MODEL), f)
    norm_g = 1.0 + 0.05 * jax.random.normal(ks[1], (DEPTH, D_MODEL), f)
    w_in = jax.random.normal(ks[2], (DEPTH, D_MODEL, IN_COLS), f) * D_MODEL ** -0.5
    gla_gate_w2 = jax.random.normal(ks[3], (DEPTH, GLA_GATE_RANK, GLA_HEADS * GLA_DK), f) * GLA_GATE_RANK ** -0.5
    gla_gate_b = 0.1 * jax.random.normal(ks[4], (DEPTH, GLA_HEADS * GLA_DK), f)
    gla_norm_g = 1.0 + 0.05 * jax.random.normal(ks[5], (DEPTH, GLA_DV), f)
    rel_bias = 0.1 * jax.random.normal(ks[6], (REL_BUCKETS, DSA_HEADS), f)
    pool_w = jax.random.normal(ks[7], (DEPTH, POOL_GROUPS, POOL_GC, POOL_GC), f) * POOL_GC ** -0.5
    pool_scale = 1.0 + 0.1 * jax.random.normal(ks[8], (DEPTH, POOL_W), f)
    w_out = jax.random.normal(ks[9], (DEPTH, D_MIX, D_MODEL), f) * D_MIX ** -0.5
    final_norm_g = 1.0 + 0.05 * jax.random.normal(ks[10], (D_MODEL,), f)
    return {'x': x, 'norm_g': norm_g, 'w_in': w_in, 'gla_gate_w2': gla_gate_w2,
            'gla_gate_b': gla_gate_b, 'gla_norm_g': gla_norm_g, 'rel_bias': rel_bias,
            'pool_w': pool_w, 'pool_scale': pool_scale, 'w_out': w_out,
            'final_norm_g': final_norm_g}


def reference(x, norm_g, w_in, gla_gate_w2, gla_gate_b, gla_norm_g, rel_bias,
              pool_w, pool_scale, w_out, final_norm_g):
    B, T, _ = x.shape
    for l in range(DEPTH):
        h = rmsnorm(x, norm_g[l])
        p = jnp.einsum('btd,dc->btc', h, w_in[l])
        (gq, gk, gv, gz, ggate, dq, dk, dv, dgate,
         qi, ki, wi, pu, pgate) = split_cols(p)
        glog = jax.nn.log_sigmoid((jnp.einsum('btr,rc->btc', gz, gla_gate_w2[l])
                                   + gla_gate_b[l]).astype(jnp.float32)) / GLA_GATE_NORM
        o_gla = gla_mixer(gq.reshape(B, T, GLA_HEADS, GLA_DK),
                          gk.reshape(B, T, GLA_HEADS, GLA_DK),
                          gv.reshape(B, T, GLA_HEADS, GLA_DV),
                          glog.reshape(B, T, GLA_HEADS, GLA_DK))
        o_gla = rmsnorm(o_gla, gla_norm_g[l]).reshape(B, T, GLA_W).astype(x.dtype)
        y_gla = o_gla * jax.nn.silu(ggate)
        o_dsa = dsa_mixer(dq.reshape(B, T, DSA_HEADS, DSA_DH),
                          dk.reshape(B, T, DSA_HEADS, DSA_DH),
                          dv.reshape(B, T, DSA_HEADS, DSA_DH),
                          qi.reshape(B, T, IDX_HEADS, IDX_DIM), ki, wi, rel_bias)
        y_dsa = o_dsa * jax.nn.silu(dgate)
        y_pool = pool_mixer(pu, pool_w[l], pool_scale[l]) * jax.nn.silu(pgate)
        y = jnp.concatenate([y_gla, y_dsa, y_pool], axis=-1)
        x = x + jnp.einsum('btc,cd->btd', y, w_out[l])
    return rmsnorm(x, final_norm_g)
```

```cpp
#include <hip/hip_runtime.h>
#include <cstdio>
#include <cstdint>
namespace pg8 {
#define PG8_LAS __attribute__((address_space(3)))
typedef unsigned short bf16_t;
typedef short bf16x8 __attribute__((ext_vector_type(8)));
typedef float f32x4 __attribute__((ext_vector_type(4)));
typedef unsigned u32x4 __attribute__((ext_vector_type(4)));
constexpr int BM = 256, BK = 64, HALF = 128, HTB = HALF * BK * 2  , STAGE_BYTES = 8 * HTB, NXCD = 8, WGM = 8;

__host__ __device__ __forceinline__ int lds_byte(int r, int c) { const int st = (r >> 4) * 2 + (c >> 5), rr = r & 15, cc = c & 31, ob = rr * 64 + cc * 2; return st * 1024 + (ob ^ (((ob >> 9) & 1) << 5)); }
__host__ __device__ __forceinline__ void stage_rc(int b, int& R, int& C) { const int st = b / 1024, sb = b % 1024, swz = sb ^ (((sb >> 9) & 1) << 5); R = (st >> 1) * 16 + swz / 64; C = (st & 1) * 32 + (swz % 64) / 2; }
__host__ __device__ __forceinline__ int perm32(int rho) { const int n = rho >> 4, i = rho & 15; return 8 * (i >> 2) + 4 * n + (i & 3); }

struct Unit { int pm, pn; };
struct Gemm { const bf16_t* A; const bf16_t* Bt; int M, N, K; };

struct StaticOrder {
    int nM, nN, nwg, G, c;
    __host__ __device__ void init(int M, int N, int G_, int c_) { nM = M / BM; nN = N / BM; nwg = nM * nN; G = G_; c = c_; }
    __host__ __device__ bool next(int i, Unit& u) const {
        const long L = (long)i * G + c; if (L >= nwg) return false;
        int wgid = (int)L; { const int q = nwg / NXCD, r = nwg % NXCD, xcd = wgid % NXCD, off = wgid / NXCD; wgid = (xcd < r ? xcd * (q + 1) : r * (q + 1) + (xcd - r) * q) + off; }
        const int nig = WGM * nN, gid = wgid / nig, fm = gid * WGM, gsz = (nM - fm) < WGM ? (nM - fm) : WGM;
        u.pm = fm + ((wgid % nig) % gsz); u.pn = (wgid % nig) / gsz; return true;
    }
    __device__ __forceinline__ void a_ready(const Unit&) const {}
    __device__ __forceinline__ void done(const Unit&) const {}
};

__device__ __forceinline__ unsigned cvt_pk_bf16(float lo, float hi) { unsigned r; asm volatile("v_cvt_pk_bf16_f32 %0, %1, %2" : "=v"(r) : "v"(lo), "v"(hi)); return r; }
typedef float f32x2 __attribute__((ext_vector_type(2)));
struct EpiP {
    static constexpr bool PERM = true, AFTER_DRAIN = false;
    bf16_t* O; int ldc;
    __device__ __forceinline__ void operator()(const f32x4 (&acc)[2][2][4][2], const Unit& u, int wr, int wc, int fr, int fq) const {
        const int row0 = u.pm * BM + wr * 64 + fr, col0 = u.pn * BM + wc * 32 + 8 * fq;
#pragma unroll
        for (int ai = 0; ai < 2; ++ai)
#pragma unroll
            for (int m = 0; m < 4; ++m) { bf16_t* rowp = O + (size_t)(row0 + ai * HALF + m * 16) * ldc + col0;
#pragma unroll
                for (int bj = 0; bj < 2; ++bj) { const f32x4 v0 = acc[ai][bj][m][0], v1 = acc[ai][bj][m][1];
                    u32x4 w; w.x = cvt_pk_bf16(v0[0], v0[1]); w.y = cvt_pk_bf16(v0[2], v0[3]); w.z = cvt_pk_bf16(v1[0], v1[1]); w.w = cvt_pk_bf16(v1[2], v1[3]);
                    *(u32x4*)(rowp + bj * HALF) = w; } }
    }
};
struct EpiRes {
    static constexpr bool PERM = false, AFTER_DRAIN = false;
    const float* base; float* out; int ldc;
    __device__ __forceinline__ void operator()(const f32x4 (&acc)[2][2][4][2], const Unit& u, int wr, int wc, int fr, int fq) const {
        const int row0 = u.pm * BM + wr * 64 + fr, col0 = u.pn * BM + wc * 32 + 4 * fq;
#pragma unroll
        for (int ai = 0; ai < 2; ++ai)
#pragma unroll
            for (int m = 0; m < 4; ++m) { const size_t off = (size_t)(row0 + ai * HALF + m * 16) * ldc + col0;
#pragma unroll
                for (int bj = 0; bj < 2; ++bj)
#pragma unroll
                    for (int n = 0; n < 2; ++n) { const f32x4 bs = *(const f32x4*)(base + off + bj * HALF + n * 16); *(f32x4*)(out + off + bj * HALF + n * 16) = bs + acc[ai][bj][m][n]; } }
    }
};
template <class Epi, class Sched, bool ALIGN_EPI = false, bool SP2 = false>
__device__ __forceinline__ void gemm_phase(PG8_LAS unsigned char* lds, const Gemm g, const Sched& S, const Epi& E, const int tid) {
    const int wid = __builtin_amdgcn_readfirstlane(tid >> 6), lane = tid & 63, wr = wid >> 2, wc = wid & 3, fr = lane & 15, fq = lane >> 4;
    const int K = g.K, nt = K / BK;
    unsigned voffA[2], voffB[2];
#pragma unroll
    for (int i = 0; i < 2; ++i) { int R, C; stage_rc(tid * 16 + i * 8192, R, C); const int Rb = Epi::PERM ? ((R & ~31) + perm32(R & 31)) : R;
        voffA[i] = (unsigned)(R * K + C) * 2u; voffB[i] = (unsigned)(Rb * K + C) * 2u; }
    const size_t kstep = (size_t)(BK * 2);
    const size_t hstep = (size_t)HALF * K * 2;
    const size_t tstep = 2 * hstep;
    const unsigned ldsw = (unsigned)wid * 1024u;
    const int aoff = lds_byte(wr * 64 + fr, fq * 8), boff = lds_byte(wc * 32 + fr, fq * 8);
#define PG8_SA(b, h) (((b) * 2 + (h)) * HTB)
#define PG8_SB(b, h) ((4 + (b) * 2 + (h)) * HTB)
#define PG8_STAGE(bufoff, gbase, voff) do { _Pragma("unroll") for (int _i = 0; _i < 2; ++_i) \
        __builtin_amdgcn_global_load_lds((const unsigned*)((const char*)(gbase) + (voff)[_i]), (PG8_LAS unsigned*)(lds + (bufoff) + ldsw + _i * 8192), 16, 0, 0); } while (0)
#define PG8_LDA(dst, b, h) do { _Pragma("unroll") for (int m = 0; m < 4; ++m) _Pragma("unroll") for (int k = 0; k < 2; ++k) dst[m][k] = *(const PG8_LAS bf16x8*)(lds + PG8_SA(b, h) + aoff + m * 2048 + k * 1024); } while (0)
#define PG8_LDB(dst, b, h) do { _Pragma("unroll") for (int n = 0; n < 2; ++n) _Pragma("unroll") for (int k = 0; k < 2; ++k) dst[n][k] = *(const PG8_LAS bf16x8*)(lds + PG8_SB(b, h) + boff + n * 2048 + k * 1024); } while (0)
#define PG8_MMA(ai, bj, At, Bt) do { __builtin_amdgcn_s_setprio(1); _Pragma("unroll") for (int m = 0; m < 4; ++m) _Pragma("unroll") for (int n = 0; n < 2; ++n) _Pragma("unroll") for (int k = 0; k < 2; ++k) \
        acc[ai][bj][m][n] = __builtin_amdgcn_mfma_f32_16x16x32_bf16(Bt[n][k], At[m][k], acc[ai][bj][m][n], 0, 0, 0); __builtin_amdgcn_s_setprio(0); } while (0)
#define PG8_WAIT_V(n) asm volatile("s_waitcnt vmcnt(" #n ")" ::: "memory")
#define PG8_WAIT_L(n) asm volatile("s_waitcnt lgkmcnt(" #n ")" ::: "memory")
#define PG8_BAR __builtin_amdgcn_s_barrier()
#define PG8_SCHED __builtin_amdgcn_sched_barrier(0)
    Unit cur, nxt; int ui = 0;
    if (!S.next(0, cur)) return;
    f32x4 acc[2][2][4][2];
#pragma unroll
    for (int a = 0; a < 2; ++a)
#pragma unroll
        for (int b = 0; b < 2; ++b)
#pragma unroll
            for (int m = 0; m < 4; ++m)
#pragma unroll
                for (int n = 0; n < 2; ++n) acc[a][b][m][n] = (f32x4){0.f, 0.f, 0.f, 0.f};
    bf16x8 At[4][2], B0[2][2], B1[2][2];
    const char* cA = (const char*)g.A + (size_t)cur.pm * tstep; const char* cB = (const char*)g.Bt + (size_t)cur.pn * tstep;
    S.a_ready(cur);
    if constexpr (SP2) {
        PG8_STAGE(PG8_SB(0, 0), cB, voffB); PG8_STAGE(PG8_SB(0, 1), cB + hstep, voffB); PG8_STAGE(PG8_SA(0, 0), cA, voffA); PG8_STAGE(PG8_SA(0, 1), cA + hstep, voffA);
        if (wr == 1) PG8_BAR;
        PG8_WAIT_V(2); PG8_BAR;
        PG8_STAGE(PG8_SB(1, 0), cB + kstep, voffB); PG8_STAGE(PG8_SA(1, 0), cA + kstep, voffA); PG8_STAGE(PG8_SB(1, 1), cB + hstep + kstep, voffB);
        PG8_WAIT_V(6); PG8_BAR;
    } else {
        PG8_STAGE(PG8_SB(0, 0), cB, voffB); PG8_STAGE(PG8_SA(0, 0), cA, voffA); PG8_STAGE(PG8_SB(0, 1), cB + hstep, voffB); PG8_STAGE(PG8_SA(0, 1), cA + hstep, voffA);
        if (wr == 1) PG8_BAR;
        PG8_WAIT_V(4); PG8_BAR;
        PG8_STAGE(PG8_SB(1, 0), cB + kstep, voffB); PG8_STAGE(PG8_SA(1, 0), cA + kstep, voffA); PG8_STAGE(PG8_SB(1, 1), cB + hstep + kstep, voffB);
        PG8_WAIT_V(6); PG8_BAR;
    }
    for (;;) {
        const bool has_next = S.next(ui + 1, nxt);
        const char* nA = has_next ? (const char*)g.A + (size_t)nxt.pm * tstep : cA; const char* nB = has_next ? (const char*)g.Bt + (size_t)nxt.pn * tstep : cB;
        for (int t = 0; t < nt; t += 2) {
            const bool last = (t == nt - 2);
            const char* a1 = cA + (size_t)(t + 1) * kstep;
            const char* a2 = last ? nA : cA + (size_t)(t + 2) * kstep; const char* b2 = last ? nB : cB + (size_t)(t + 2) * kstep;
            const char* a3 = a2 + kstep; const char* b3 = b2 + kstep;
            if (last && has_next) S.a_ready(nxt);
            if constexpr (SP2) {
            PG8_LDB(B0, 0, 0); PG8_LDB(B1, 0, 1); PG8_SCHED; PG8_LDA(At, 0, 0); PG8_STAGE(PG8_SA(1, 1), a1 + hstep, voffA);
            PG8_WAIT_V(8); PG8_WAIT_L(0); PG8_BAR; PG8_MMA(0, 0, At, B0); PG8_MMA(0, 1, At, B1); PG8_BAR; PG8_SCHED;
            PG8_LDA(At, 0, 1); PG8_STAGE(PG8_SB(0, 0), b2, voffB); PG8_STAGE(PG8_SB(0, 1), b2 + hstep, voffB); PG8_STAGE(PG8_SA(0, 0), a2, voffA);
            PG8_WAIT_V(8); PG8_WAIT_L(0); PG8_BAR; PG8_MMA(1, 0, At, B0); PG8_MMA(1, 1, At, B1); PG8_BAR; PG8_SCHED;
            PG8_LDB(B0, 1, 0); PG8_LDB(B1, 1, 1); PG8_SCHED; PG8_LDA(At, 1, 0); PG8_STAGE(PG8_SA(0, 1), a2 + hstep, voffA);
            PG8_WAIT_V(8); PG8_WAIT_L(0); PG8_BAR; PG8_MMA(0, 0, At, B0); PG8_MMA(0, 1, At, B1); PG8_BAR; PG8_SCHED;
            PG8_LDA(At, 1, 1); PG8_STAGE(PG8_SB(1, 0), b3, voffB); PG8_STAGE(PG8_SB(1, 1), b3 + hstep, voffB); PG8_STAGE(PG8_SA(1, 0), a3, voffA);
            PG8_WAIT_V(8); PG8_WAIT_L(0); PG8_BAR; PG8_MMA(1, 0, At, B0); PG8_MMA(1, 1, At, B1); PG8_BAR; PG8_SCHED;
            } else {
            PG8_LDB(B0, 0, 0); PG8_SCHED; PG8_LDA(At, 0, 0); PG8_STAGE(PG8_SA(1, 1), a1 + hstep, voffA);
            PG8_WAIT_L(8); PG8_BAR; PG8_WAIT_L(0); PG8_MMA(0, 0, At, B0); PG8_BAR; PG8_SCHED;
            PG8_LDB(B1, 0, 1); PG8_STAGE(PG8_SB(0, 0), b2, voffB);
            PG8_BAR; PG8_WAIT_L(0); PG8_MMA(0, 1, At, B1); PG8_BAR;
            PG8_LDA(At, 0, 1); PG8_STAGE(PG8_SA(0, 0), a2, voffA);
            PG8_BAR; PG8_WAIT_L(0); PG8_MMA(1, 0, At, B0); PG8_BAR; PG8_SCHED;
            PG8_STAGE(PG8_SB(0, 1), b2 + hstep, voffB);
            PG8_WAIT_V(6); PG8_BAR; PG8_MMA(1, 1, At, B1); PG8_BAR;
            PG8_LDB(B0, 1, 0); PG8_SCHED; PG8_LDA(At, 1, 0); PG8_STAGE(PG8_SA(0, 1), a2 + hstep, voffA);
            PG8_WAIT_L(8); PG8_BAR; PG8_WAIT_L(0); PG8_MMA(0, 0, At, B0); PG8_BAR; PG8_SCHED;
            PG8_LDB(B1, 1, 1); PG8_STAGE(PG8_SB(1, 0), b3, voffB);
            PG8_BAR; PG8_WAIT_L(0); PG8_MMA(0, 1, At, B1); PG8_BAR;
            PG8_LDA(At, 1, 1); PG8_STAGE(PG8_SA(1, 0), a3, voffA);
            PG8_BAR; PG8_WAIT_L(0); PG8_MMA(1, 0, At, B0); PG8_BAR; PG8_SCHED;
            PG8_STAGE(PG8_SB(1, 1), b3 + hstep, voffB);
            PG8_WAIT_V(6); PG8_BAR; PG8_MMA(1, 1, At, B1); PG8_BAR;
            }
        }
        if constexpr (ALIGN_EPI) { if (wr == 0) PG8_BAR; }
        if constexpr (!Epi::AFTER_DRAIN) { E(acc, cur, wr, wc, fr, fq); S.done(cur); }
        if (!has_next) break;
#pragma unroll
        for (int a = 0; a < 2; ++a)
#pragma unroll
            for (int b = 0; b < 2; ++b)
#pragma unroll
                for (int m = 0; m < 4; ++m)
#pragma unroll
                    for (int n = 0; n < 2; ++n) acc[a][b][m][n] = (f32x4){0.f, 0.f, 0.f, 0.f};
        cur = nxt; cA = nA; cB = nB; ++ui;
        if constexpr (ALIGN_EPI) { if (wr == 1) PG8_BAR; }
    }
    PG8_WAIT_V(0);
    if constexpr (!ALIGN_EPI) { if (wr == 0) PG8_BAR; }
    PG8_BAR;
    if constexpr (Epi::AFTER_DRAIN) { E.fused(acc, cur, wr, wc, fr, fq, lds, wid, lane); S.done(cur); }
#undef PG8_SA
#undef PG8_SB
#undef PG8_STAGE
#undef PG8_LDA
#undef PG8_LDB
#undef PG8_MMA
#undef PG8_WAIT_V
#undef PG8_WAIT_L
#undef PG8_BAR
#undef PG8_SCHED
}
}

constexpr int NWAVES = 8, NTHR = 512;
constexpr int BATCH = 8, SEQ = 8192, DM = 1024, DEPTH = 4, M = BATCH * SEQ;
constexpr int IN_COLS = 3380, NP = 3584;
constexpr float EPS = 1e-6f;
constexpr int N_GQ = 0, N_GK = 192, N_GV = 384, N_GG = 768, N_DQ = 1152, N_DK = 1536, N_DV = 1920, N_DG = 2304, N_PU = 2688, N_PG = 2944, N_QI = 3200, N_KI = 3328, N_GZ = 3360, N_WI = 3376;
constexpr float LOG2E = 1.4426950408889634f;
constexpr size_t MiB = 1u << 20;
constexpr size_t WS_CTL = 0, CTL_ZERO_BYTES = 1 * MiB;
constexpr size_t WS_WIN = 2 * MiB;
constexpr size_t WS_WOUT = 32 * MiB;
constexpr size_t WS_XB = 48 * MiB;
constexpr size_t WS_P = 176 * MiB;
constexpr size_t WS_MASK = 624 * MiB;
constexpr size_t WS_END = 688 * MiB;
constexpr int CW_BAR = 4096;
constexpr int RING_BYTES = 131072, LDSCTL_OFF = RING_BYTES, MISC_OFF = LDSCTL_OFF + 320, LDS_BYTES = 147456;

#define GAS __attribute__((address_space(1)))
#define LAS __attribute__((address_space(3)))
typedef unsigned short bf16;
typedef unsigned v4u __attribute__((ext_vector_type(4)));
typedef unsigned v2u __attribute__((ext_vector_type(2)));
typedef float f32x4 __attribute__((ext_vector_type(4)));
typedef GAS unsigned gu32;
#define RLX_AGENT __ATOMIC_RELAXED, __HIP_MEMORY_SCOPE_AGENT
__device__ __forceinline__ unsigned f2bf(float f) { unsigned u = __builtin_bit_cast(unsigned, f); return (u + 0x7fffu + ((u >> 16) & 1u)) >> 16; }
__device__ __forceinline__ unsigned pk2(float lo, float hi) { return f2bf(lo) | (f2bf(hi) << 16); }
__device__ __forceinline__ float bf2f(unsigned short b) { return __builtin_bit_cast(float, (unsigned)b << 16); }
__device__ __forceinline__ float bflo(unsigned w) { return __builtin_bit_cast(float, w << 16); }
__device__ __forceinline__ float bfhi(unsigned w) { return __builtin_bit_cast(float, w & 0xffff0000u); }
__device__ __forceinline__ float wave_sum(float v) {
#pragma unroll
    for (int o = 1; o < 64; o <<= 1) v += __shfl_xor(v, o);
    return v;
}
__device__ __forceinline__ float silu_f(float x) { return x / (1.0f + __expf(-x)); }

__constant__ unsigned char T5B[128] = {0, 1, 2, 3, 4, 5, 6, 7, 8, 9, 10, 11, 12, 13, 14, 15, 16, 16, 16, 17, 17, 18, 18, 18, 19, 19, 19, 20, 20, 20, 20, 21, 21, 21, 21, 22, 22, 22, 22, 22, 23, 23, 23, 23, 23, 23, 24, 24, 24, 24, 24, 24, 25, 25, 25, 25, 25, 25, 25, 26, 26, 26, 26, 26, 26, 26, 26, 27, 27, 27, 27, 27, 27, 27, 27, 27, 27, 28, 28, 28, 28, 28, 28, 28, 28, 28, 28, 29, 29, 29, 29, 29, 29, 29, 29, 29, 29, 29, 29, 30, 30, 30, 30, 30, 30, 30, 30, 30, 30, 30, 30, 30, 30, 31, 31, 31, 31, 31, 31, 31, 31, 31, 31, 31, 31, 31, 31, 31};
__device__ __forceinline__ int t5_bucket(int rel) { return rel >= 128 ? 31 : (int)T5B[rel]; }

#define XB_TMO      128
#define XB_XCNT(j)  (256  + 64 * (j))
#define XB_XSUB(j)  (1280 + 64 * (j))
#define XB_XGEN(j)  (2304 + 64 * (j))
#define XB_TOP      3328
#define XB_TOPGEN   3392
#define XCD_BAR_WORDS 3456
#define XB_SPIN_CAP (1u << 18)

__device__ __forceinline__ unsigned xb_ld(unsigned* p)              { return __hip_atomic_load(p, __ATOMIC_RELAXED, __HIP_MEMORY_SCOPE_AGENT); }
__device__ __forceinline__ unsigned xb_add(unsigned* p, unsigned v) { return __hip_atomic_fetch_add(p, v, __ATOMIC_RELAXED, __HIP_MEMORY_SCOPE_AGENT); }
__device__ __forceinline__ unsigned xb_xcc_id() { return (unsigned)__builtin_amdgcn_s_getreg((3 << 11) | 20) & 0xFu; }
#define XB_SPIN(cond, bar) do { unsigned _sp = 0; while (cond) { __builtin_amdgcn_s_sleep(1); \
    if ((++_sp & 255u) == 0u) { if (xb_ld(&(bar)[XB_TMO])) break; if (_sp > XB_SPIN_CAP) { atomicAdd(&(bar)[XB_TMO], 1u); break; } } } } while (0)

struct XcdBarrier {
    unsigned* bar; unsigned x;
    volatile LAS unsigned* st;
};

__device__ __forceinline__ XcdBarrier xcd_barrier_post(unsigned* bar, volatile LAS unsigned* st) {
    XcdBarrier b; b.bar = bar; b.x = xb_xcc_id(); b.st = st;
    if (threadIdx.x == 0) (void)xb_add(&bar[XB_XCNT(b.x)], 1u);
    return b;
}
__device__ __forceinline__ void xcd_barrier_complete(unsigned* bar, unsigned x, unsigned& nloc, unsigned& nx) {
    const unsigned G = gridDim.x * gridDim.y * gridDim.z;
    unsigned sum, cnt, mine, sp = 0u;
    for (;;) {
        sum = 0u; cnt = 0u; mine = 0u;
#pragma unroll
        for (unsigned j = 0; j < 16; ++j) { const unsigned c = xb_ld(&bar[XB_XCNT(j)]); sum += c; cnt += (c > 0u) ? 1u : 0u; mine = (j == x) ? c : mine; }
        if (sum == G) break;
        __builtin_amdgcn_s_sleep(1);
        if ((++sp & 255u) == 0u) { if (xb_ld(&bar[XB_TMO])) break; if (sp > XB_SPIN_CAP) { atomicAdd(&bar[XB_TMO], 1u); break; } }
    }
    nloc = mine > 0u ? mine : 1u; nx = cnt > 0u ? cnt : 1u;
}

__device__ __forceinline__ void xcd_barrier(const XcdBarrier& b) {
    asm volatile("s_waitcnt vmcnt(0)" ::: "memory");
    __syncthreads();
    if (threadIdx.x == 0) {
        unsigned* bar = b.bar;
        __builtin_amdgcn_s_waitcnt(0);
        unsigned nloc = b.st[0], nx = b.st[1];
        if (nloc == 0u) { xcd_barrier_complete(bar, b.x, nloc, nx); b.st[0] = nloc; b.st[1] = nx; }
        const unsigned old = xb_add(&bar[XB_XSUB(b.x)], 1u);
        const unsigned gen = old / nloc;
        if (old + 1u == (gen + 1u) * nloc) {
            __builtin_amdgcn_fence(__ATOMIC_RELEASE, "agent");
            asm volatile("s_waitcnt vmcnt(0)" ::: "memory");
            const unsigned og = xb_add(&bar[XB_TOP], 1u);
            const unsigned tg = og / nx;
            if (og + 1u == (tg + 1u) * nx) xb_add(&bar[XB_TOPGEN], 1u);
            else XB_SPIN(xb_ld(&bar[XB_TOPGEN]) == tg, bar);
            __builtin_amdgcn_fence(__ATOMIC_ACQUIRE, "agent");
            xb_add(&bar[XB_XGEN(b.x)], 1u);
            asm volatile("s_waitcnt vmcnt(0)" ::: "memory");
        } else {
            XB_SPIN(xb_ld(&bar[XB_XGEN(b.x)]) == gen, bar);
            __builtin_amdgcn_fence(__ATOMIC_ACQUIRE, "agent");
            asm volatile("s_waitcnt vmcnt(0)" ::: "memory");
        }
    }
    __syncthreads();
}
struct Args {
    const float* x; const float* norm_g; const float* w_in; const float* gate_w2; const float* gate_b; const float* gla_norm_g;
    const float* rel_bias; const float* pool_w; const float* pool_scale; const float* w_out; const float* final_g;
    float* out; unsigned char* ws;
    int l_lo, l_hi, ph_lo, ph_hi, single, pad;
};

__device__ __forceinline__ int src_col(int n, float& sc) {
    sc = 1.f;
    if (n < 192) { sc = 0.14433756729740643f; return n; }
    if (n < 768) return n;
    if (n < 1152) return 784 + (n - 768);
    if (n < 1536) { sc = 0.125f * LOG2E; return 1168 + (n - 1152); }
    if (n < 1920) return 1552 + (n - 1536);
    if (n < 2304) return 1936 + (n - 1920);
    if (n < 2688) return 2320 + (n - 2304);
    if (n < 2944) return 2868 + (n - 2688);
    if (n < 3200) return 3124 + (n - 2944);
    if (n < 3328) { sc = 0.17677669529663687f; return 2704 + (n - 3200); }
    if (n < 3360) return 2832 + (n - 3328);
    if (n < 3376) return 768 + (n - 3360);
    if (n < 3380) { sc = 0.5f; return 2864 + (n - 3376); }
    return -1;
}
__device__ __forceinline__ void prologue_phase(const Args& a, int wg, int G, int tid) {
    bf16* WIN = (bf16*)(a.ws + WS_WIN); bf16* WOUT = (bf16*)(a.ws + WS_WOUT);
    const long gt = (long)wg * NTHR + tid, gs = (long)G * NTHR;
    for (long i = gt; i < 4L * NP * 128; i += gs) {
        const int n = (int)(i % NP), k8 = (int)((i / NP) % 128), l = (int)(i / ((long)NP * 128));
        float sc; const int c = src_col(n, sc);
        v4u o = {0u, 0u, 0u, 0u};
        if (c >= 0) { const float* w = a.w_in + ((size_t)l * 1024 + k8 * 8) * IN_COLS + c; float v[8];
#pragma unroll
            for (int j = 0; j < 8; ++j) v[j] = w[(size_t)j * IN_COLS] * sc;
            o.x = pk2(v[0], v[1]); o.y = pk2(v[2], v[3]); o.z = pk2(v[4], v[5]); o.w = pk2(v[6], v[7]); }
        *(v4u*)(WIN + ((size_t)l * NP + n) * 1024 + k8 * 8) = o;
    }
    for (long i = gt; i < 4L * 1024 * 128; i += gs) {
        const int n = (int)(i % 1024), k8 = (int)((i / 1024) % 128), l = (int)(i / (1024L * 128));
        const float* w = a.w_out + ((size_t)l * 1024 + k8 * 8) * 1024 + n; float v[8];
#pragma unroll
        for (int j = 0; j < 8; ++j) v[j] = w[(size_t)j * 1024];
        v4u o; o.x = pk2(v[0], v[1]); o.y = pk2(v[2], v[3]); o.z = pk2(v[4], v[5]); o.w = pk2(v[6], v[7]);
        *(v4u*)(WOUT + ((size_t)l * 1024 + n) * 1024 + k8 * 8) = o;
    }
}
__device__ __forceinline__ void norm_phase(const float* src, const float* g, bf16* dst, int gw, int NGW, int lane) {
    for (int m = gw; m < M; m += NGW) {
        const f32x4* xr = (const f32x4*)(src + (size_t)m * DM) + lane; f32x4 v[4]; float s = 0.f;
#pragma unroll
        for (int j = 0; j < 4; ++j) { v[j] = xr[64 * j]; s += (v[j].x * v[j].x + v[j].y * v[j].y) + (v[j].z * v[j].z + v[j].w * v[j].w); }
        const float r = 1.0f / sqrtf(wave_sum(s) * (1.f / DM) + EPS);
        const f32x4* gr = (const f32x4*)g + lane; v2u* o = (v2u*)(dst + (size_t)m * DM) + lane;
#pragma unroll
        for (int j = 0; j < 4; ++j) { const f32x4 gv = gr[64 * j]; v2u w; w.x = pk2(v[j].x * r * gv.x, v[j].y * r * gv.y); w.y = pk2(v[j].z * r * gv.z, v[j].w * r * gv.w); o[64 * j] = w; }
    }
}
__device__ __forceinline__ void final_norm_phase(float* x, const float* g, int gw, int NGW, int lane) {
    for (int m = gw; m < M; m += NGW) {
        f32x4* xr = (f32x4*)(x + (size_t)m * DM) + lane; f32x4 v[4]; float s = 0.f;
#pragma unroll
        for (int j = 0; j < 4; ++j) { v[j] = xr[64 * j]; s += (v[j].x * v[j].x + v[j].y * v[j].y) + (v[j].z * v[j].z + v[j].w * v[j].w); }
        const float r = 1.0f / sqrtf(wave_sum(s) * (1.f / DM) + EPS);
        const f32x4* gr = (const f32x4*)g + lane;
#pragma unroll
        for (int j = 0; j < 4; ++j) { const f32x4 gv = gr[64 * j]; xr[64 * j] = v[j] * r * gv; }
    }
}
__device__ __forceinline__ void pool_phase(const Args& a, int l, unsigned char* lds, int wg, int G, int tid) {
    float* wsm = (float*)lds; float* us = (float*)(lds + 16384); float* ps = (float*)(lds + 32768);
    const bf16* P = (const bf16*)(a.ws + WS_P); bf16* Y = (bf16*)(a.ws + WS_XB);
    for (int g = 0; g < 4; ++g) {
        __syncthreads();
        const float* pw = a.pool_w + (size_t)(l * 4 + g) * 4096;
        for (int i = tid; i < 4096; i += NTHR) wsm[i] = pw[i];
        const int w = 2 << g;
        for (int tile = wg; tile < M / 32; tile += G) {
            __syncthreads();
            const int m0 = tile * 32, t0 = m0 % SEQ;
            for (int i = tid; i < 47 * 64; i += NTHR) { const int r = i >> 6, c = i & 63; float v = 0.f;
                if (t0 + r - 15 >= 0) v = bf2f(P[(size_t)(m0 - 15 + r) * NP + N_PU + g * 64 + c]);
                us[i] = v; }
            __syncthreads();
            { const int t = tid >> 4, c4 = (tid & 15) * 4, pos = t0 + t; const int cnt = (pos + 1 < w) ? pos + 1 : w; const float inv = 1.0f / (float)cnt;
#pragma unroll
                for (int k = 0; k < 4; ++k) { const int c = c4 + k; float s = 0.f; for (int j = 0; j < w; ++j) s += us[(t + 15 - j) * 64 + c]; ps[t * 64 + c] = s * inv - us[(t + 15) * 64 + c]; } }
            __syncthreads();
            { const int t = tid >> 4, d4 = (tid & 15) * 4; float a0 = 0.f, a1 = 0.f, a2 = 0.f, a3 = 0.f;
                for (int c = 0; c < 64; ++c) { const float p = ps[t * 64 + c]; const f32x4 wv = *(const f32x4*)&wsm[c * 64 + d4]; a0 += p * wv.x; a1 += p * wv.y; a2 += p * wv.z; a3 += p * wv.w; }
                const size_t m = (size_t)m0 + t; const v2u gw2 = *(const v2u*)(P + m * NP + N_PG + g * 64 + d4);
                const float* scl = a.pool_scale + l * 256 + g * 64 + d4;
                const float y0 = a0 * scl[0] * silu_f(bflo(gw2.x)), y1 = a1 * scl[1] * silu_f(bfhi(gw2.x)), y2 = a2 * scl[2] * silu_f(bflo(gw2.y)), y3 = a3 * scl[3] * silu_f(bfhi(gw2.y));
                v2u o; o.x = pk2(y0, y1); o.y = pk2(y2, y3); *(v2u*)(Y + m * DM + 768 + g * 64 + d4) = o; }
        }
    }
    __syncthreads();
}
__device__ __forceinline__ void gla_rec_phase(const Args& a, int l, unsigned char* lds, int unit, int tid) {
    const int b = unit >> 2, h = unit & 3;
    float* qs = (float*)lds; float* ks = (float*)(lds + 12288); float* es = (float*)(lds + 24576); float* vs = (float*)(lds + 36864); float* os = (float*)(lds + 61440);
    float* w2s = (float*)(lds + 86016); float* bs = (float*)(lds + 89088); float* gzs = (float*)(lds + 89280);
    const bf16* P = (const bf16*)(a.ws + WS_P); bf16* Y = (bf16*)(a.ws + WS_XB);
    __syncthreads();
    for (int i = tid; i < 16 * 48; i += NTHR) { const int r = i / 48, d = i % 48; w2s[i] = a.gate_w2[(size_t)(l * 16 + r) * 192 + h * 48 + d]; }
    if (tid < 48) bs[tid] = a.gate_b[l * 192 + h * 48 + tid];
    float S[48];
#pragma unroll
    for (int d = 0; d < 48; ++d) S[d] = 0.f;
    for (int blk = 0; blk < SEQ / 64; ++blk) {
        const size_t m0 = (size_t)b * SEQ + (size_t)blk * 64;
        __syncthreads();
        for (int i = tid; i < 64 * 48; i += NTHR) { const int t = i / 48, d = i % 48; const bf16* row = P + (m0 + t) * NP; qs[i] = bf2f(row[N_GQ + h * 48 + d]); ks[i] = bf2f(row[N_GK + h * 48 + d]); }
        for (int i = tid; i < 64 * 96; i += NTHR) { const int t = i / 96, v = i % 96; vs[i] = bf2f(P[(m0 + t) * NP + N_GV + h * 96 + v]); }
        for (int i = tid; i < 64 * 16; i += NTHR) { const int t = i >> 4, r = i & 15; gzs[i] = bf2f(P[(m0 + t) * NP + N_GZ + r]); }
        __syncthreads();
        for (int i = tid; i < 64 * 48; i += NTHR) { const int t = i / 48, d = i % 48; float z = bs[d];
#pragma unroll
            for (int r = 0; r < 16; ++r) z += gzs[t * 16 + r] * w2s[r * 48 + d];
            const float ls = fminf(z, 0.f) - log1pf(__expf(-fabsf(z)));
            es[i] = __expf(ls * (1.0f / 16.0f)); }
        __syncthreads();
        if (tid < 96) { const int v = tid;
            for (int t = 0; t < 64; ++t) { const float vv = vs[t * 96 + v]; float o = 0.f;
#pragma unroll
                for (int d = 0; d < 48; ++d) { S[d] = es[t * 48 + d] * S[d] + ks[t * 48 + d] * vv; o += qs[t * 48 + d] * S[d]; }
                os[t * 96 + v] = o; } }
        __syncthreads();
        { const int t = tid >> 3, part = tid & 7; float ov[12]; float ss = 0.f;
#pragma unroll
            for (int k = 0; k < 12; ++k) { ov[k] = os[t * 96 + part * 12 + k]; ss += ov[k] * ov[k]; }
            ss += __shfl_xor(ss, 1); ss += __shfl_xor(ss, 2); ss += __shfl_xor(ss, 4);
            const float r = 1.0f / sqrtf(ss * (1.0f / 96.0f) + EPS);
            const size_t m = m0 + t; const bf16* gp = P + m * NP + N_GG + h * 96 + part * 12; const float* ng = a.gla_norm_g + l * 96 + part * 12;
            unsigned* yo = (unsigned*)(Y + m * DM + h * 96 + part * 12);
#pragma unroll
            for (int k = 0; k < 12; k += 2) { const float y0 = ov[k] * r * ng[k] * silu_f(bf2f(gp[k])), y1 = ov[k + 1] * r * ng[k + 1] * silu_f(bf2f(gp[k + 1])); yo[k >> 1] = pk2(y0, y1); } }
    }
    __syncthreads();
}
__device__ __forceinline__ void dsa_slow_phase(const Args& a, int l, unsigned char* lds, int wg, int G, int tid) {
    const int lane = tid & 63, wave = tid >> 6;
    unsigned* sc = (unsigned*)lds; int* hist = (int*)(lds + 32768); int* sel = (int*)(lds + 33792); float* qf = (float*)(lds + 34816); float* wq = (float*)(lds + 35328);
    int* misc = (int*)(lds + 35344); float* qh = (float*)(lds + 35456); float* lg = (float*)(lds + 36992); float* inv = (float*)(lds + 43136);
    const bf16* P = (const bf16*)(a.ws + WS_P); bf16* Y = (bf16*)(a.ws + WS_XB);
    for (int qi = wg; qi < M; qi += G) {
        const int t = qi >> 3, b = qi & 7; const size_t m = (size_t)b * SEQ + t; const int N = t + 1;
        __syncthreads();
        if (tid < 128) qf[tid] = bf2f(P[m * NP + N_QI + tid]);
        if (tid >= 128 && tid < 132) wq[tid - 128] = bf2f(P[m * NP + N_WI + tid - 128]);
        for (int i = tid; i < 384; i += NTHR) qh[i] = bf2f(P[m * NP + N_DQ + i]);
        __syncthreads();
        for (int s = tid; s < N; s += NTHR) {
            const v4u* kr = (const v4u*)(P + ((size_t)b * SEQ + s) * NP + N_KI); float kf[32];
#pragma unroll
            for (int c = 0; c < 4; ++c) { const v4u w = kr[c]; kf[8 * c] = bflo(w.x); kf[8 * c + 1] = bfhi(w.x); kf[8 * c + 2] = bflo(w.y); kf[8 * c + 3] = bfhi(w.y); kf[8 * c + 4] = bflo(w.z); kf[8 * c + 5] = bfhi(w.z); kf[8 * c + 6] = bflo(w.w); kf[8 * c + 7] = bfhi(w.w); }
            float score = 0.f;
#pragma unroll
            for (int hh = 0; hh < 4; ++hh) { float dot = 0.f;
#pragma unroll
                for (int d = 0; d < 32; ++d) dot += qf[hh * 32 + d] * kf[d];
                score += wq[hh] * fmaxf(dot, 0.f); }
            const unsigned u = __builtin_bit_cast(unsigned, score);
            sc[s] = (u & 0x80000000u) ? ~u : (u | 0x80000000u);
        }
        __syncthreads();
        int L;
        if (N <= 256) { if (tid < N) sel[tid] = tid; L = N; }
        else {
            unsigned prefix = 0u; int kk = 256;
            for (int pass = 0; pass < 4; ++pass) {
                const int shift = 24 - 8 * pass;
                if (tid < 256) hist[tid] = 0;
                __syncthreads();
                for (int s = tid; s < N; s += NTHR) { const unsigned key = sc[s]; const bool match = (pass == 0) ? true : ((key >> ((shift + 8) & 31)) == prefix); if (match) atomicAdd(&hist[(key >> shift) & 255u], 1); }
                __syncthreads();
                if (wave == 0) {
                    const int c0 = hist[4 * lane], c1 = hist[4 * lane + 1], c2 = hist[4 * lane + 2], c3 = hist[4 * lane + 3]; const int tot = c0 + c1 + c2 + c3;
                    int incl = tot;
#pragma unroll
                    for (int o = 1; o < 64; o <<= 1) { const int tt = __shfl_down(incl, o); if (lane + o < 64) incl += tt; }
                    const int excl = incl - tot;
                    if (excl < kk && kk <= incl) { int above = excl, D;
                        if (above + c3 >= kk) D = 4 * lane + 3;
                        else { above += c3; if (above + c2 >= kk) D = 4 * lane + 2; else { above += c2; if (above + c1 >= kk) D = 4 * lane + 1; else { above += c1; D = 4 * lane; } } }
                        misc[1] = D; misc[2] = above; }
                }
                __syncthreads();
                prefix = (prefix << 8) | (unsigned)misc[1]; kk -= misc[2];
            }
            const unsigned tau = prefix;
            const int seg = (((N + 7) >> 3) + 63) & ~63; const int s_lo = wave * seg, s_hi = (s_lo + seg < N) ? s_lo + seg : N;
            { int cg = 0, ce = 0;
                for (int base = s_lo; base < s_hi; base += 64) { const int s = base + lane; const bool in = s < s_hi; const unsigned key = in ? sc[s] : 0u;
                    cg += __popcll(__ballot(in && key > tau)); ce += __popcll(__ballot(in && key == tau)); }
                if (lane == 0) { misc[4 + wave] = cg; misc[12 + wave] = ce; } }
            __syncthreads();
            { int bg = 0, be = 0;
                for (int w2 = 0; w2 < 8; ++w2) if (w2 < wave) { bg += misc[4 + w2]; be += misc[12 + w2]; }
                int run_sel = bg + (be < kk ? be : kk), run_eq = be;
                for (int base = s_lo; base < s_hi; base += 64) { const int s = base + lane; const bool in = s < s_hi; const unsigned key = in ? sc[s] : 0u;
                    const bool gt = in && key > tau, eq = in && key == tau; const unsigned long long me = __ballot(eq); const unsigned long long lt = (1ull << lane) - 1ull;
                    const bool take = gt || (eq && (run_eq + __popcll(me & lt) < kk)); const unsigned long long mt = __ballot(take);
                    if (take) sel[run_sel + __popcll(mt & lt)] = s;
                    run_sel += __popcll(mt); run_eq += __popcll(me); } }
            L = 256;
        }
        __syncthreads();
        { const int j = tid >> 1, h0 = (tid & 1) * 3;
            if (j < L) { const int s = sel[j]; const size_t srow = (size_t)b * SEQ + s; const int bk = t5_bucket(t - s);
#pragma unroll
                for (int hh = 0; hh < 3; ++hh) { const int h = h0 + hh; const v4u* kr = (const v4u*)(P + srow * NP + N_DK + h * 64); const float* q = qh + h * 64; float dot = 0.f;
#pragma unroll
                    for (int c = 0; c < 8; ++c) { const v4u w = kr[c]; dot += q[8 * c] * bflo(w.x) + q[8 * c + 1] * bfhi(w.x) + q[8 * c + 2] * bflo(w.y) + q[8 * c + 3] * bfhi(w.y) + q[8 * c + 4] * bflo(w.z) + q[8 * c + 5] * bfhi(w.z) + q[8 * c + 6] * bflo(w.w) + q[8 * c + 7] * bfhi(w.w); }
                    lg[h * 256 + j] = dot + a.rel_bias[bk * 6 + h] * LOG2E; } }
            else {
#pragma unroll
                for (int hh = 0; hh < 3; ++hh) lg[(h0 + hh) * 256 + j] = -INFINITY; } }
        __syncthreads();
        if (wave < 6) { float* row = lg + wave * 256; float v0 = row[lane], v1 = row[lane + 64], v2 = row[lane + 128], v3 = row[lane + 192];
            float mx = fmaxf(fmaxf(v0, v1), fmaxf(v2, v3));
#pragma unroll
            for (int o = 1; o < 64; o <<= 1) mx = fmaxf(mx, __shfl_xor(mx, o));
            v0 = exp2f(v0 - mx); v1 = exp2f(v1 - mx); v2 = exp2f(v2 - mx); v3 = exp2f(v3 - mx);
            const float sm = wave_sum((v0 + v1) + (v2 + v3));
            row[lane] = v0; row[lane + 64] = v1; row[lane + 128] = v2; row[lane + 192] = v3;
            if (lane == 0) inv[wave] = 1.0f / sm; }
        __syncthreads();
        if (tid < 384) { const int h = tid >> 6, d = tid & 63; float acc = 0.f; const bf16* vb = P + (size_t)b * SEQ * NP + N_DV + h * 64 + d;
            for (int j = 0; j < L; ++j) acc += lg[h * 256 + j] * bf2f(vb[(size_t)sel[j] * NP]);
            const float o = acc * inv[h]; const float gate = bf2f(P[m * NP + N_DG + h * 64 + d]);
            Y[m * DM + 384 + h * 64 + d] = (bf16)f2bf(o * silu_f(gate)); }
    }
    __syncthreads();
}
#ifndef MK_SINGLE
#define MK_SINGLE 1
#endif
__global__ void __launch_bounds__(NTHR, 2) fwd(Args a) {
    extern __shared__ __attribute__((aligned(16))) unsigned char lds[];
    int tid = threadIdx.x, lane = tid & 63, wave = __builtin_amdgcn_readfirstlane(tid >> 6);
    int G = gridDim.x, wg = blockIdx.x;
#define LAUNDER() do { asm volatile("" : "+v"(tid)); asm volatile("" : "+s"(wg), "+s"(G)); lane = tid & 63; wave = __builtin_amdgcn_readfirstlane(tid >> 6); gw = wg * NWAVES + wave; NGW = G * NWAVES; } while (0)
    volatile LAS unsigned* MISC = (volatile LAS unsigned*)((LAS unsigned char*)lds + MISC_OFF);
    for (int u = tid; u < (LDS_BYTES - LDSCTL_OFF) / 4; u += NTHR) ((LAS unsigned*)((LAS unsigned char*)lds + LDSCTL_OFF))[u] = 0u;
    __syncthreads();
    XcdBarrier bar; bar.bar = (unsigned*)(a.ws + WS_CTL) + CW_BAR; bar.x = 0; bar.st = nullptr;
    const bool one = a.single != 0;
    if (one) bar = xcd_barrier_post((unsigned*)(a.ws + WS_CTL) + CW_BAR, MISC + 8);
#define IN(k) (a.ph_lo <= (k) && (k) < a.ph_hi)
#define SEAM() do { if (one) xcd_barrier(bar); } while (0)
    int gw = wg * NWAVES + wave, NGW = G * NWAVES;
    bf16* XB = (bf16*)(a.ws + WS_XB); bf16* PB = (bf16*)(a.ws + WS_P);
    if (IN(0)) { prologue_phase(a, wg, G, tid); SEAM(); }
    for (int l = a.l_lo; l < a.l_hi; ++l) {
        LAUNDER();
        if (IN(1)) { norm_phase(l == 0 ? a.x : a.out, a.norm_g + l * DM, XB, gw, NGW, lane); SEAM(); }
        LAUNDER();
        if (IN(2)) {
            pg8::Gemm g{XB, (const bf16*)(a.ws + WS_WIN) + (size_t)l * NP * 1024, M, NP, DM}; pg8::StaticOrder S; S.init(M, NP, G, wg);
            pg8::EpiP E{PB, NP};
            pg8::gemm_phase<pg8::EpiP, pg8::StaticOrder, true, true>((PG8_LAS unsigned char*)lds, g, S, E, tid);
            SEAM();
        }
        LAUNDER();
        if (IN(3)) {
            if (wg < 32) gla_rec_phase(a, l, lds, wg, tid);
            pool_phase(a, l, lds, wg, G, tid);
            dsa_slow_phase(a, l, lds, wg, G, tid);
            SEAM();
        }
        LAUNDER();
        if (IN(4)) {
            pg8::Gemm g{XB, (const bf16*)(a.ws + WS_WOUT) + (size_t)l * 1024 * 1024, M, DM, DM}; pg8::StaticOrder S; S.init(M, DM, G, wg);
            pg8::EpiRes E{l == 0 ? a.x : a.out, a.out, DM};
            pg8::gemm_phase<pg8::EpiRes, pg8::StaticOrder, true, true>((PG8_LAS unsigned char*)lds, g, S, E, tid);
            SEAM();
        }
    }
    if (IN(5)) final_norm_phase(a.out, a.final_g, gw, NGW, lane);
#undef IN
#undef SEAM
}

extern "C" void kernel_launch(void* const* d_in, const int* in_sizes, int n_in, void* d_out, int out_size, void* d_ws, size_t ws_size, hipStream_t stream) {
    static int grid = 0;
    if (grid == 0) {
        if (n_in != 11 || in_sizes[0] != M * DM || out_size != M * DM || ws_size < WS_END) { fprintf(stderr, "kernel_launch: unexpected shapes (n_in %d, in0 %d, out %d, ws %zu); nothing launched\n", n_in, n_in > 0 ? in_sizes[0] : -1, out_size, ws_size); grid = -1; return; }
        int dev = 0, cus = 0, per_cu = 0;
        if (hipGetDevice(&dev) != hipSuccess || hipDeviceGetAttribute(&cus, hipDeviceAttributeMultiprocessorCount, dev) != hipSuccess) { grid = -1; return; }
        if (hipFuncSetAttribute((const void*)fwd, hipFuncAttributeMaxDynamicSharedMemorySize, LDS_BYTES) != hipSuccess) { fprintf(stderr, "kernel_launch: hipFuncSetAttribute failed\n"); grid = -1; return; }
        if (hipOccupancyMaxActiveBlocksPerMultiprocessor(&per_cu, (const void*)fwd, NTHR, LDS_BYTES) != hipSuccess || per_cu < 1) fprintf(stderr, "kernel_launch: occupancy query reports %d\n", per_cu);
        (void)hipGetLastError();
        grid = cus;
    }
    if (grid < 0) return;
    if (hipMemsetAsync((char*)d_ws + WS_CTL, 0, CTL_ZERO_BYTES, stream) != hipSuccess) return;
    Args a{};
    a.x = (const float*)d_in[0]; a.norm_g = (const float*)d_in[1]; a.w_in = (const float*)d_in[2]; a.gate_w2 = (const float*)d_in[3]; a.gate_b = (const float*)d_in[4]; a.gla_norm_g = (const float*)d_in[5];
    a.rel_bias = (const float*)d_in[6]; a.pool_w = (const float*)d_in[7]; a.pool_scale = (const float*)d_in[8]; a.w_out = (const float*)d_in[9]; a.final_g = (const float*)d_in[10];
    a.out = (float*)d_out; a.ws = (unsigned char*)d_ws; a.pad = 0;
#if MK_SINGLE
    a.l_lo = 0; a.l_hi = DEPTH; a.ph_lo = 0; a.ph_hi = 6; a.single = 1;
    hipLaunchKernelGGL(fwd, dim3(grid), dim3(NTHR), LDS_BYTES, stream, a);
#else
    a.single = 0;
    a.l_lo = 0; a.l_hi = 0; a.ph_lo = 0; a.ph_hi = 1; hipLaunchKernelGGL(fwd, dim3(grid), dim3(NTHR), LDS_BYTES, stream, a);
    for (int l = 0; l < DEPTH; ++l) for (int ph = 1; ph <= 4; ++ph) { a.l_lo = l; a.l_hi = l + 1; a.ph_lo = ph; a.ph_hi = ph + 1; hipLaunchKernelGGL(fwd, dim3(grid), dim3(NTHR), LDS_BYTES, stream, a); }
    a.l_lo = 0; a.l_hi = 0; a.ph_lo = 5; a.ph_hi = 6; hipLaunchKernelGGL(fwd, dim3(grid), dim3(NTHR), LDS_BYTES, stream, a);
#endif
    const hipError_t le = hipPeekAtLastError();
    if (le != hipSuccess) fprintf(stderr, "kernel_launch: launch failed: %s\n", hipGetErrorName(le));
}
```

```cpp
#include <hip/hip_runtime.h>
#include <cstdio>
#include <cstdint>
namespace pg8 {
#define PG8_LAS __attribute__((address_space(3)))
typedef unsigned short bf16_t;
typedef short bf16x8 __attribute__((ext_vector_type(8)));
typedef float f32x4 __attribute__((ext_vector_type(4)));
typedef unsigned u32x4 __attribute__((ext_vector_type(4)));
constexpr int BM = 256, BK = 64, HALF = 128, HTB = HALF * BK * 2  , STAGE_BYTES = 8 * HTB, NXCD = 8, WGM = 8;

__host__ __device__ __forceinline__ int lds_byte(int r, int c) { const int st = (r >> 4) * 2 + (c >> 5), rr = r & 15, cc = c & 31, ob = rr * 64 + cc * 2; return st * 1024 + (ob ^ (((ob >> 9) & 1) << 5)); }
__host__ __device__ __forceinline__ void stage_rc(int b, int& R, int& C) { const int st = b / 1024, sb = b % 1024, swz = sb ^ (((sb >> 9) & 1) << 5); R = (st >> 1) * 16 + swz / 64; C = (st & 1) * 32 + (swz % 64) / 2; }
__host__ __device__ __forceinline__ int perm32(int rho) { const int n = rho >> 4, i = rho & 15; return 8 * (i >> 2) + 4 * n + (i & 3); }

struct Unit { int pm, pn; };
struct Gemm { const bf16_t* A; const bf16_t* Bt; int M, N, K; };

struct StaticOrder {
    int nM, nN, nwg, G, c;
    __host__ __device__ void init(int M, int N, int G_, int c_) { nM = M / BM; nN = N / BM; nwg = nM * nN; G = G_; c = c_; }
    __host__ __device__ bool next(int i, Unit& u) const {
        const long L = (long)i * G + c; if (L >= nwg) return false;
        int wgid = (int)L; { const int q = nwg / NXCD, r = nwg % NXCD, xcd = wgid % NXCD, off = wgid / NXCD; wgid = (xcd < r ? xcd * (q + 1) : r * (q + 1) + (xcd - r) * q) + off; }
        const int nig = WGM * nN, gid = wgid / nig, fm = gid * WGM, gsz = (nM - fm) < WGM ? (nM - fm) : WGM;
        u.pm = fm + ((wgid % nig) % gsz); u.pn = (wgid % nig) / gsz; return true;
    }
    __device__ __forceinline__ void a_ready(const Unit&) const {}
    __device__ __forceinline__ void done(const Unit&) const {}
};

__device__ __forceinline__ unsigned cvt_pk_bf16(float lo, float hi) { unsigned r; asm volatile("v_cvt_pk_bf16_f32 %0, %1, %2" : "=v"(r) : "v"(lo), "v"(hi)); return r; }
typedef float f32x2 __attribute__((ext_vector_type(2)));
struct EpiP {
    static constexpr bool PERM = true, AFTER_DRAIN = false;
    bf16_t* O; int ldc; const float* RS; bf16_t* KC;
    __device__ __forceinline__ void operator()(const f32x4 (&acc)[2][2][4][2], const Unit& u, int wr, int wc, int fr, int fq) const {
        const int row0 = u.pm * BM + wr * 64 + fr, col0 = u.pn * BM + wc * 32 + 8 * fq;
#pragma unroll
        for (int ai = 0; ai < 2; ++ai)
#pragma unroll
            for (int m = 0; m < 4; ++m) { const int row = row0 + ai * HALF + m * 16; bf16_t* rowp = O + (size_t)row * ldc + col0;
                const float r = RS[row];
#pragma unroll
                for (int bj = 0; bj < 2; ++bj) { const f32x4 v0 = acc[ai][bj][m][0] * r, v1 = acc[ai][bj][m][1] * r;
                    u32x4 w; w.x = cvt_pk_bf16(v0[0], v0[1]); w.y = cvt_pk_bf16(v0[2], v0[3]); w.z = cvt_pk_bf16(v1[0], v1[1]); w.w = cvt_pk_bf16(v1[2], v1[3]);
                    if (col0 + bj * HALF < 3384) *(u32x4*)(rowp + bj * HALF) = w;
                    if (bj == 0 && wc == 0 && u.pn == 13) *(u32x4*)(KC + (size_t)row * 32 + 8 * fq) = w; } }
    }
};
struct EpiRes {
    static constexpr bool PERM = true, AFTER_DRAIN = false;
    bf16_t* XA; int ldc; float* RS;
    __device__ __forceinline__ void operator()(const f32x4 (&acc)[2][2][4][2], const Unit& u, int wr, int wc, int fr, int fq) const {
        const int row0 = u.pm * BM + wr * 64 + fr, col0 = u.pn * BM + wc * 32 + 8 * fq, lane = fr + 16 * fq;
#pragma unroll
        for (int ai = 0; ai < 2; ++ai)
#pragma unroll
            for (int m = 0; m < 4; ++m) { const int row = row0 + ai * HALF + m * 16; const size_t off = (size_t)row * ldc + col0; float s = 0.f;
#pragma unroll
                for (int bj = 0; bj < 2; ++bj) { const u32x4 b = *(const u32x4*)(XA + off + bj * HALF); u32x4 w;
#pragma unroll
                    for (int k = 0; k < 4; ++k) { const float lo = __uint_as_float(b[k] << 16) + acc[ai][bj][m][k >> 1][2 * (k & 1)], hi = __uint_as_float(b[k] & 0xffff0000u) + acc[ai][bj][m][k >> 1][2 * (k & 1) + 1];
                        w[k] = cvt_pk_bf16(lo, hi); const float rl = __uint_as_float(w[k] << 16), rh = __uint_as_float(w[k] & 0xffff0000u); s += rl * rl + rh * rh; }
                    *(u32x4*)(XA + off + bj * HALF) = w; }
                s += __builtin_bit_cast(float, __builtin_amdgcn_ds_bpermute((lane ^ 16) << 2, __builtin_bit_cast(int, s)));
                s += __builtin_bit_cast(float, __builtin_amdgcn_ds_bpermute((lane ^ 32) << 2, __builtin_bit_cast(int, s)));
                if (fq == 0) RS[(size_t)row * 16 + u.pn * 4 + wc] = s; }
    }
};
template <class Epi, class Sched, bool ALIGN_EPI = false, bool SP2 = false>
__device__ __forceinline__ void gemm_phase(PG8_LAS unsigned char* lds, const Gemm g, const Sched& S, const Epi& E, const int tid) {
    const int wid = __builtin_amdgcn_readfirstlane(tid >> 6), lane = tid & 63, wr = wid >> 2, wc = wid & 3, fr = lane & 15, fq = lane >> 4;
    const int K = g.K, nt = K / BK;
    unsigned voffA[2], voffB[2];
#pragma unroll
    for (int i = 0; i < 2; ++i) { int R, C; stage_rc(tid * 16 + i * 8192, R, C); const int Rb = Epi::PERM ? ((R & ~31) + perm32(R & 31)) : R;
        voffA[i] = (unsigned)(R * K + C) * 2u; voffB[i] = (unsigned)(Rb * K + C) * 2u; }
    const size_t kstep = (size_t)(BK * 2);
    const size_t hstep = (size_t)HALF * K * 2;
    const size_t tstep = 2 * hstep;
    const unsigned ldsw = (unsigned)wid * 1024u;
    const int aoff = lds_byte(wr * 64 + fr, fq * 8), boff = lds_byte(wc * 32 + fr, fq * 8);
#define PG8_SA(b, h) (((b) * 2 + (h)) * HTB)
#define PG8_SB(b, h) ((4 + (b) * 2 + (h)) * HTB)
#define PG8_STAGE(bufoff, gbase, voff) do { _Pragma("unroll") for (int _i = 0; _i < 2; ++_i) \
        __builtin_amdgcn_global_load_lds((const unsigned*)((const char*)(gbase) + (voff)[_i]), (PG8_LAS unsigned*)(lds + (bufoff) + ldsw + _i * 8192), 16, 0, 0); } while (0)
#define PG8_LDA(dst, b, h) do { _Pragma("unroll") for (int m = 0; m < 4; ++m) _Pragma("unroll") for (int k = 0; k < 2; ++k) dst[m][k] = *(const PG8_LAS bf16x8*)(lds + PG8_SA(b, h) + aoff + m * 2048 + k * 1024); } while (0)
#define PG8_LDB(dst, b, h) do { _Pragma("unroll") for (int n = 0; n < 2; ++n) _Pragma("unroll") for (int k = 0; k < 2; ++k) dst[n][k] = *(const PG8_LAS bf16x8*)(lds + PG8_SB(b, h) + boff + n * 2048 + k * 1024); } while (0)
#define PG8_MMA(ai, bj, At, Bt) do { __builtin_amdgcn_s_setprio(1); _Pragma("unroll") for (int m = 0; m < 4; ++m) _Pragma("unroll") for (int n = 0; n < 2; ++n) _Pragma("unroll") for (int k = 0; k < 2; ++k) \
        acc[ai][bj][m][n] = __builtin_amdgcn_mfma_f32_16x16x32_bf16(Bt[n][k], At[m][k], acc[ai][bj][m][n], 0, 0, 0); __builtin_amdgcn_s_setprio(0); } while (0)
#define PG8_WAIT_V(n) asm volatile("s_waitcnt vmcnt(" #n ")" ::: "memory")
#define PG8_WAIT_L(n) asm volatile("s_waitcnt lgkmcnt(" #n ")" ::: "memory")
#define PG8_BAR __builtin_amdgcn_s_barrier()
#define PG8_SCHED __builtin_amdgcn_sched_barrier(0)
    Unit cur, nxt; int ui = 0;
    if (!S.next(0, cur)) return;
    f32x4 acc[2][2][4][2];
#pragma unroll
    for (int a = 0; a < 2; ++a)
#pragma unroll
        for (int b = 0; b < 2; ++b)
#pragma unroll
            for (int m = 0; m < 4; ++m)
#pragma unroll
                for (int n = 0; n < 2; ++n) acc[a][b][m][n] = (f32x4){0.f, 0.f, 0.f, 0.f};
    bf16x8 At[4][2], B0[2][2], B1[2][2];
    const char* cA = (const char*)g.A + (size_t)cur.pm * tstep; const char* cB = (const char*)g.Bt + (size_t)cur.pn * tstep;
    S.a_ready(cur);
    if constexpr (SP2) {
        PG8_STAGE(PG8_SB(0, 0), cB, voffB); PG8_STAGE(PG8_SB(0, 1), cB + hstep, voffB); PG8_STAGE(PG8_SA(0, 0), cA, voffA); PG8_STAGE(PG8_SA(0, 1), cA + hstep, voffA);
        if (wr == 1) PG8_BAR;
        PG8_WAIT_V(2); PG8_BAR;
        PG8_STAGE(PG8_SB(1, 0), cB + kstep, voffB); PG8_STAGE(PG8_SA(1, 0), cA + kstep, voffA); PG8_STAGE(PG8_SB(1, 1), cB + hstep + kstep, voffB);
        PG8_WAIT_V(6); PG8_BAR;
    } else {
        PG8_STAGE(PG8_SB(0, 0), cB, voffB); PG8_STAGE(PG8_SA(0, 0), cA, voffA); PG8_STAGE(PG8_SB(0, 1), cB + hstep, voffB); PG8_STAGE(PG8_SA(0, 1), cA + hstep, voffA);
        if (wr == 1) PG8_BAR;
        PG8_WAIT_V(4); PG8_BAR;
        PG8_STAGE(PG8_SB(1, 0), cB + kstep, voffB); PG8_STAGE(PG8_SA(1, 0), cA + kstep, voffA); PG8_STAGE(PG8_SB(1, 1), cB + hstep + kstep, voffB);
        PG8_WAIT_V(6); PG8_BAR;
    }
    for (;;) {
        const bool has_next = S.next(ui + 1, nxt);
        const char* nA = has_next ? (const char*)g.A + (size_t)nxt.pm * tstep : cA; const char* nB = has_next ? (const char*)g.Bt + (size_t)nxt.pn * tstep : cB;
        for (int t = 0; t < nt; t += 2) {
            const bool last = (t == nt - 2);
            const char* a1 = cA + (size_t)(t + 1) * kstep;
            const char* a2 = last ? nA : cA + (size_t)(t + 2) * kstep; const char* b2 = last ? nB : cB + (size_t)(t + 2) * kstep;
            const char* a3 = a2 + kstep; const char* b3 = b2 + kstep;
            if (last && has_next) S.a_ready(nxt);
            if constexpr (SP2) {
            PG8_LDB(B0, 0, 0); PG8_LDB(B1, 0, 1); PG8_SCHED; PG8_LDA(At, 0, 0); PG8_STAGE(PG8_SA(1, 1), a1 + hstep, voffA);
            PG8_WAIT_V(8); PG8_WAIT_L(0); PG8_BAR; PG8_MMA(0, 0, At, B0); PG8_MMA(0, 1, At, B1); PG8_BAR; PG8_SCHED;
            PG8_LDA(At, 0, 1); PG8_STAGE(PG8_SB(0, 0), b2, voffB); PG8_STAGE(PG8_SB(0, 1), b2 + hstep, voffB); PG8_STAGE(PG8_SA(0, 0), a2, voffA);
            PG8_WAIT_V(8); PG8_WAIT_L(0); PG8_BAR; PG8_MMA(1, 0, At, B0); PG8_MMA(1, 1, At, B1); PG8_BAR; PG8_SCHED;
            PG8_LDB(B0, 1, 0); PG8_LDB(B1, 1, 1); PG8_SCHED; PG8_LDA(At, 1, 0); PG8_STAGE(PG8_SA(0, 1), a2 + hstep, voffA);
            PG8_WAIT_V(8); PG8_WAIT_L(0); PG8_BAR; PG8_MMA(0, 0, At, B0); PG8_MMA(0, 1, At, B1); PG8_BAR; PG8_SCHED;
            PG8_LDA(At, 1, 1); PG8_STAGE(PG8_SB(1, 0), b3, voffB); PG8_STAGE(PG8_SB(1, 1), b3 + hstep, voffB); PG8_STAGE(PG8_SA(1, 0), a3, voffA);
            PG8_WAIT_V(8); PG8_WAIT_L(0); PG8_BAR; PG8_MMA(1, 0, At, B0); PG8_MMA(1, 1, At, B1); PG8_BAR; PG8_SCHED;
            } else {
            PG8_LDB(B0, 0, 0); PG8_SCHED; PG8_LDA(At, 0, 0); PG8_STAGE(PG8_SA(1, 1), a1 + hstep, voffA);
            PG8_WAIT_L(8); PG8_BAR; PG8_WAIT_L(0); PG8_MMA(0, 0, At, B0); PG8_BAR; PG8_SCHED;
            PG8_LDB(B1, 0, 1); PG8_STAGE(PG8_SB(0, 0), b2, voffB);
            PG8_BAR; PG8_WAIT_L(0); PG8_MMA(0, 1, At, B1); PG8_BAR;
            PG8_LDA(At, 0, 1); PG8_STAGE(PG8_SA(0, 0), a2, voffA);
            PG8_BAR; PG8_WAIT_L(0); PG8_MMA(1, 0, At, B0); PG8_BAR; PG8_SCHED;
            PG8_STAGE(PG8_SB(0, 1), b2 + hstep, voffB);
            PG8_WAIT_V(6); PG8_BAR; PG8_MMA(1, 1, At, B1); PG8_BAR;
            PG8_LDB(B0, 1, 0); PG8_SCHED; PG8_LDA(At, 1, 0); PG8_STAGE(PG8_SA(0, 1), a2 + hstep, voffA);
            PG8_WAIT_L(8); PG8_BAR; PG8_WAIT_L(0); PG8_MMA(0, 0, At, B0); PG8_BAR; PG8_SCHED;
            PG8_LDB(B1, 1, 1); PG8_STAGE(PG8_SB(1, 0), b3, voffB);
            PG8_BAR; PG8_WAIT_L(0); PG8_MMA(0, 1, At, B1); PG8_BAR;
            PG8_LDA(At, 1, 1); PG8_STAGE(PG8_SA(1, 0), a3, voffA);
            PG8_BAR; PG8_WAIT_L(0); PG8_MMA(1, 0, At, B0); PG8_BAR; PG8_SCHED;
            PG8_STAGE(PG8_SB(1, 1), b3 + hstep, voffB);
            PG8_WAIT_V(6); PG8_BAR; PG8_MMA(1, 1, At, B1); PG8_BAR;
            }
        }
        if constexpr (ALIGN_EPI) { if (wr == 0) PG8_BAR; }
        if constexpr (!Epi::AFTER_DRAIN) { E(acc, cur, wr, wc, fr, fq); S.done(cur); }
        if (!has_next) break;
#pragma unroll
        for (int a = 0; a < 2; ++a)
#pragma unroll
            for (int b = 0; b < 2; ++b)
#pragma unroll
                for (int m = 0; m < 4; ++m)
#pragma unroll
                    for (int n = 0; n < 2; ++n) acc[a][b][m][n] = (f32x4){0.f, 0.f, 0.f, 0.f};
        cur = nxt; cA = nA; cB = nB; ++ui;
        if constexpr (ALIGN_EPI) { if (wr == 1) PG8_BAR; }
    }
    PG8_WAIT_V(0);
    if constexpr (!ALIGN_EPI) { if (wr == 0) PG8_BAR; }
    PG8_BAR;
    if constexpr (Epi::AFTER_DRAIN) { E.fused(acc, cur, wr, wc, fr, fq, lds, wid, lane); S.done(cur); }
#undef PG8_SA
#undef PG8_SB
#undef PG8_STAGE
#undef PG8_LDA
#undef PG8_LDB
#undef PG8_MMA
#undef PG8_WAIT_V
#undef PG8_WAIT_L
#undef PG8_BAR
#undef PG8_SCHED
}
}
#include <hip/hip_bf16.h>
#include <cmath>
namespace attn_body {
using bf16=__hip_bfloat16;
using bf16x8=__attribute__((ext_vector_type(8)))short;
using s16x4=__attribute__((ext_vector_type(4)))short;
using f32x16=__attribute__((ext_vector_type(16)))float;
using u32x4=__attribute__((ext_vector_type(4)))unsigned;
constexpr int BATCH=8,NHEAD=6,SEQ=8192,D=64,DM=3584,DMO=1024;
constexpr int NW=8,QBLK=32,QB=QBLK*NW,KVBLK=64,NQB=SEQ/QB;
constexpr int ATTN_UNIT_ROWS=QB;
__device__ __forceinline__ int crow(int r,int hi){return (r&3)+8*(r>>2)+4*hi;}
#define SBAR() __builtin_amdgcn_sched_barrier(0)
typedef __attribute__((address_space(3))) const float* lds_cfptr;
__device__ __forceinline__ void biasadd(f32x16&p0,f32x16&p1,int tt,int tq,int hi,lds_cfptr dl,int h){
  const int rb=tq-64*tt-4*hi; const lds_cfptr dh=dl+h;
  #pragma unroll
  for(int r=0;r<16;++r){ const unsigned i0=(unsigned)(rb-(r&3)-8*(r>>2)), i1=i0-32u;
    float a0=dh[(i0<128u?i0:128u)*8], a1=dh[(i1<128u?i1:128u)*8];
    asm volatile("s_waitcnt lgkmcnt(0)":"+v"(a0),"+v"(a1)::"memory");
    p0[r]+=a0; p1[r]+=a1; }
}
template<int K> __device__ __forceinline__ float mandk(float p,unsigned bits){ unsigned m; asm("v_bfe_i32 %0, %1, %2, 1":"=v"(m):"v"(bits),"n"(K)); return __uint_as_float(__float_as_uint(p)&m); }
__device__ __forceinline__ float mand(float p,unsigned bits,int k){ return __uint_as_float(__float_as_uint(p)&(unsigned)__builtin_amdgcn_sbfe((int)bits,k,1)); }

constexpr int NSLOT=3, SLOTB=8192;
constexpr int LDS_K=0, LDS_V=NSLOT*SLOTB, LDS_WS=2*NSLOT*SLOTB, LDS_OST=LDS_WS+NW*64*4, LDS_BYTES=LDS_OST+NW*4096, LDS_QST=90624;
constexpr float C2=0.125f*1.4426950408889634f;
__device__ __forceinline__ void glds16(const void*gsrc,unsigned lds_dst){unsigned keep;
  asm volatile("s_mov_b32 %0, m0\n\ts_mov_b32 m0, %2\n\ts_nop 0\n\tglobal_load_lds_dwordx4 %1, off\n\ts_mov_b32 m0, %0":"=&s"(keep):"v"(gsrc),"s"(lds_dst):"memory");}
__device__ __forceinline__ float max3f(float a,float b,float c){float r;asm("v_max3_f32 %0, %1, %2, %3":"=v"(r):"v"(a),"v"(b),"v"(c));return r;}
__device__ __forceinline__ float max2f(float a,float b){float r;asm("v_max_f32_e32 %0, %1, %2":"=v"(r):"v"(a),"v"(b));return r;}
__device__ __forceinline__ float fadd_s(float a,float b){float r;asm("v_add_f32_e32 %0, %1, %2":"=v"(r):"v"(a),"v"(b));return r;}
__device__ __forceinline__ float fsub_s(float a,float b){float r;asm("v_sub_f32_e32 %0, %1, %2":"=v"(r):"v"(a),"v"(b));return r;}
typedef float f32x2_t __attribute__((ext_vector_type(2))); typedef __bf16 bf16x2_t __attribute__((ext_vector_type(2)));
__device__ __forceinline__ unsigned cvtpk_s(float lo,float hi){f32x2_t v={lo,hi};bf16x2_t b=__builtin_convertvector(v,bf16x2_t);return __builtin_bit_cast(unsigned,b);}
#define WAIT_BAR(N) asm volatile("s_waitcnt vmcnt(" #N ") lgkmcnt(0)\n\ts_barrier":::"memory")

__device__ __forceinline__ void qkt(f32x16&p0,f32x16&p1,const char*Kslot,const bf16x8*qr,const f32x16&negm,int r32,int hi){
  const char*kb=Kslot+hi*1024+r32*16;
  #pragma unroll
  for(int d0=0;d0<4;++d0){
    const bf16x8 b0=*reinterpret_cast<const bf16x8*>(kb+d0*2048);
    const bf16x8 b1=*reinterpret_cast<const bf16x8*>(kb+d0*2048+512);
    if(d0==0){p0=__builtin_amdgcn_mfma_f32_32x32x16_bf16(b0,qr[0],negm,0,0,0);p1=__builtin_amdgcn_mfma_f32_32x32x16_bf16(b1,qr[0],negm,0,0,0);}
    else{p0=__builtin_amdgcn_mfma_f32_32x32x16_bf16(b0,qr[d0],p0,0,0,0);p1=__builtin_amdgcn_mfma_f32_32x32x16_bf16(b1,qr[d0],p1,0,0,0);}}
}
typedef __attribute__((address_space(3))) const char* lds_cptr;
typedef short v4i16_t __attribute__((ext_vector_type(4)));
__device__ __forceinline__ void kload8(bf16x8*kf,lds_cptr kp){
  kf[0]=*(const __attribute__((address_space(3))) bf16x8*)(kp);      kf[1]=*(const __attribute__((address_space(3))) bf16x8*)(kp+512);
  kf[2]=*(const __attribute__((address_space(3))) bf16x8*)(kp+2048); kf[3]=*(const __attribute__((address_space(3))) bf16x8*)(kp+2560);
  kf[4]=*(const __attribute__((address_space(3))) bf16x8*)(kp+4096); kf[5]=*(const __attribute__((address_space(3))) bf16x8*)(kp+4608);
  kf[6]=*(const __attribute__((address_space(3))) bf16x8*)(kp+6144); kf[7]=*(const __attribute__((address_space(3))) bf16x8*)(kp+6656);
}
__device__ __forceinline__ void kload2(bf16x8*kf,lds_cptr kp,int j){ kf[2*j]=*(const __attribute__((address_space(3))) bf16x8*)(kp+j*2048); kf[2*j+1]=*(const __attribute__((address_space(3))) bf16x8*)(kp+j*2048+512); }
__device__ __forceinline__ s16x4 vtr(lds_cptr p){ return __builtin_bit_cast(s16x4,__builtin_amdgcn_ds_read_tr16_b64_v4i16((__attribute__((address_space(3))) v4i16_t*)p)); }
__device__ __forceinline__ float rowmax(const f32x16&p0,const f32x16&p1){
  float a=max3f(p0[0],p0[1],p1[0]),b=max3f(p0[2],p0[3],p1[1]);a=max3f(a,p1[2],p1[3]);
  #pragma unroll
  for(int r=4;r<16;r+=4){a=max3f(a,p0[r],p0[r+1]);b=max3f(b,p0[r+2],p0[r+3]);a=max3f(a,p1[r],p1[r+1]);b=max3f(b,p1[r+2],p1[r+3]);}
  const float m=max2f(a,b);
  auto rr=__builtin_amdgcn_permlane32_swap(__float_as_uint(m),__float_as_uint(m),false,false);
  return max2f(__uint_as_float(rr[0]),__uint_as_float(rr[1]));
}
__device__ __forceinline__ void pv(f32x16*o,int vb,bf16x8 pa0,bf16x8 pa1,bf16x8 pa2,bf16x8 pa3){
  #pragma unroll
  for(int d0=0;d0<2;++d0){s16x4 lo[4],hi[4];
    #pragma unroll
    for(int ks=0;ks<4;++ks){
      asm volatile("ds_read_b64_tr_b16 %0,%1 offset:%c2":"=&v"(lo[ks]):"v"(vb),"i"(d0*4096+ks*1024):"memory");
      asm volatile("ds_read_b64_tr_b16 %0,%1 offset:%c2":"=&v"(hi[ks]):"v"(vb),"i"(d0*4096+ks*1024+512):"memory");}
    asm volatile("s_waitcnt lgkmcnt(0)":::"memory");SBAR();
    #define PK(k) (bf16x8){lo[k][0],lo[k][1],lo[k][2],lo[k][3],hi[k][0],hi[k][1],hi[k][2],hi[k][3]}
    o[d0]=__builtin_amdgcn_mfma_f32_32x32x16_bf16(pa0,PK(0),o[d0],0,0,0);
    o[d0]=__builtin_amdgcn_mfma_f32_32x32x16_bf16(pa1,PK(1),o[d0],0,0,0);
    o[d0]=__builtin_amdgcn_mfma_f32_32x32x16_bf16(pa2,PK(2),o[d0],0,0,0);
    o[d0]=__builtin_amdgcn_mfma_f32_32x32x16_bf16(pa3,PK(3),o[d0],0,0,0);
    #undef PK
  }
}

#ifndef ATTN_STORE16
#define ATTN_STORE16(p,v) (*(u32x4*)(p)=(v))
#endif
template<int THRL> __device__ __forceinline__ void attn_unit(int b,int h,int qb,const bf16*Q,const bf16*__restrict__ K,const bf16*__restrict__ V,bf16*O,const bf16*GT,const unsigned*MK,lds_cfptr dl,char*shm,const int tid){
  const int lane=tid&63,r32=lane&31,hi=lane>>5; const int wid=__builtin_amdgcn_readfirstlane(tid>>6);
  const long rowbase=(long)b*SEQ; const int q0=qb*QB;
  const bf16*Qw=Q+(rowbase+q0+wid*QBLK)*DM+h*D;
  const bf16*Kh=K+rowbase*DM+h*D,*Vh=V+rowbase*DM+h*D;
  const unsigned lds0=(unsigned)(uintptr_t)shm;
  float*wsf=(float*)(shm+LDS_WS)+wid*64;
  const bf16*ksrc=Kh+(long)lane*DM+wid*8;
  const bf16*vsrc=Vh+(long)(16*(wid&3)+(lane>>2))*DM+(wid>>2)*32+(lane&3)*8;
  const unsigned kdst=lds0+LDS_K+wid*1024, vdst=lds0+LDS_V+wid*1024;
  #define DMA_K(t,slot) glds16(ksrc+(long)(t)*KVBLK*DM,(unsigned)__builtin_amdgcn_readfirstlane(kdst+(slot)))
  #define DMA_V(t,slot) glds16(vsrc+(long)(t)*KVBLK*DM,(unsigned)__builtin_amdgcn_readfirstlane(vdst+(slot)))
  const int vb0=(int)(lds0+LDS_V)+((lane>>4)&1)*32+(lane&3)*8+(4*hi+((lane&15)>>2))*64;
  const char*Kbase=shm+LDS_K; bf16x8 kf[8];
  const lds_cptr shm3=(lds_cptr)shm; const lds_cptr kp0=shm3+LDS_K+hi*1024+r32*16; const lds_cptr vp0=shm3+LDS_V+((lane>>4)&1)*32+(lane&3)*8+(4*hi+((lane&15)>>2))*64;
  const int NT=(q0+QB)/KVBLK;
  DMA_K(0,0);DMA_V(0,0);DMA_K(1,SLOTB);
  const __attribute__((address_space(3))) char* shm3q=(const __attribute__((address_space(3))) char*)shm;
  bf16x8 qr[4];
  #pragma unroll
  for(int d0=0;d0<4;++d0)qr[d0]=*reinterpret_cast<const bf16x8*>(&Qw[(long)r32*DM+d0*16+hi*8]);
  const __attribute__((address_space(3))) bf16x8* qls=(const __attribute__((address_space(3))) bf16x8*)(shm3q+LDS_QST+wid*4096)+lane;
  #pragma unroll
  for(int d0=0;d0<4;++d0)((__attribute__((address_space(3))) bf16x8*)qls)[64*d0]=qr[d0];
  float mhat=0.f,l_reg=0.f;f32x16 o[2];o[0]=f32x16{};o[1]=f32x16{};float nmh=0.f;
  const int tq=q0+wid*QBLK+r32;
  const unsigned*mbase=MK+((size_t)(b*256+(q0>>5)+wid)*128)*64;
  unsigned bits_cur=mbase[lane],bits_next=mbase[64+lane];
  #define CMASK(P0,P1,t) do{ if((t)>=NT-6)biasadd(P0,P1,(t),tq,hi,dl,h);}while(0)
  bool resc=false;
  #define START(P0,P1) do{ const float rm=rowmax(P0,P1); resc=false; \
    { const float dl=rm; mhat=fadd_s(mhat,dl); \
      _Pragma("unroll") for(int r=0;r<16;++r){P0[r]=fsub_s(P0[r],dl);P1[r]=fsub_s(P1[r],dl);} \
      nmh=-mhat; } \
    _Pragma("unroll") for(int r=0;r<16;++r)P0[r]=mand(__builtin_amdgcn_exp2f(P0[r]),bits_cur,r); }while(0)
  #define RESC() do{ if(resc){ asm volatile("s_waitcnt lgkmcnt(0)":::"memory"); \
      _Pragma("unroll") for(int d_=0;d_<2;++d_) _Pragma("unroll") for(int r=0;r<16;++r)o[d_][r]*=wsf[crow(r,hi)]; } }while(0)
  f32x16 pA0,pA1,pB0,pB1;
  int sl_prev=0,sl_cur=0,sl_next=SLOTB;
  #define ROT() do{sl_prev=sl_cur;sl_cur=sl_next;sl_next=(sl_next==(NSLOT-1)*SLOTB)?0:sl_next+SLOTB;}while(0)
  DMA_K(2,2*SLOTB);
  WAIT_BAR(3);
  { const f32x16 zc=f32x16{}; qkt(pA0,pA1,Kbase,qr,zc,r32,hi); }asm volatile("s_nop 15\n\ts_nop 7":"+v"(pA0),"+v"(pA1));CMASK(pA0,pA1,0);
  START(pA0,pA1);
  _Pragma("unroll") for(int r=0;r<16;++r)pA1[r]=mand(__builtin_amdgcn_exp2f(pA1[r]),bits_cur,16+r);
  WAIT_BAR(0);
  DMA_K(3,0);DMA_V(1,SLOTB);
  ROT();
  kload8(kf,kp0+sl_cur);
  WAIT_BAR(2);
  s16x4 vlo[8],vhi[8]; u32x4 pw0,pw1,pw2,pw3; bf16x8 qa_=qls[0],qb_;
  #define PKW(P,B) cvtpk_s(P[B],P[B+1])
  #define PAF(k) __builtin_bit_cast(bf16x8,pw##k)
  #define VFR(i) (bf16x8){vlo[i][0],vlo[i][1],vlo[i][2],vlo[i][3],vhi[i][0],vhi[i][1],vhi[i][2],vhi[i][3]}
  #define PIN(x) asm volatile("":"+v"(x))
  #define MX3(a,b,c) __builtin_fmaxf(__builtin_fmaxf((a),(b)),(c))
  #define GAPA(MF,A0,A1,A2,A3,W0,W1,PW) do{ MF; sacc+=A0; sacc+=A1; sacc+=A2; sacc+=A3; PIN(sacc); W0; W1; PIN(PW); SBAR(); }while(0)
  #define EX(v) __builtin_amdgcn_exp2f(v)
  #define GAPB(MF,X,B,MB) do{ MF; X[B]=mandk<(MB)+(B)>(EX(X[B]),bits_cur); X[B+1]=mandk<(MB)+(B)+1>(EX(X[B+1]),bits_cur); X[B+2]=mandk<(MB)+(B)+2>(EX(X[B+2]),bits_cur); X[B+3]=mandk<(MB)+(B)+3>(EX(X[B+3]),bits_cur); PIN(X); SBAR(); }while(0)
  #define VRD(i) do{ vlo[i]=vtr(vp_+(((i)>>2)*4096+((i)&3)*1024)); vhi[i]=vtr(vp_+(((i)>>2)*4096+((i)&3)*1024+512)); }while(0)
  #define KRD(G,j) do{ if(G){ kload2(kf,kp0+sl_next,j); SBAR(); } }while(0)
  #define STEP(C0,C1,P0,P1,t,GK,GV,GL) do{ SBAR(); \
    bits_cur=bits_next; if(GV){ bits_next=mbase[64*((t)+1)+lane]; } \
    f32x16 negm; { float nm_=nmh; asm volatile("":"+v"(nm_)); _Pragma("unroll") for(int r=0;r<16;++r)negm[r]=nm_; } \
    const lds_cptr vp_=vp0+sl_prev; \
    VRD(0); qb_=qls[64]; SBAR(); float sacc=(P0[0]+P0[1]); \
    GAPA(C0=__builtin_amdgcn_mfma_f32_32x32x16_bf16(kf[0],qa_,negm,0,0,0), P0[2],P0[3],P0[4],P0[5],     pw0[0]=PKW(P0,0), pw0[1]=PKW(P0,2), pw0); \
    VRD(4); SBAR(); GAPA(C1=__builtin_amdgcn_mfma_f32_32x32x16_bf16(kf[1],qa_,negm,0,0,0), P0[6],P0[7],P0[8],P0[9],     pw0[2]=PKW(P0,4), pw0[3]=PKW(P0,6), pw0); \
    VRD(1); qa_=qls[128]; SBAR(); GAPA(C0=__builtin_amdgcn_mfma_f32_32x32x16_bf16(kf[2],qb_,C0,0,0,0),   P0[10],P0[11],P0[12],P0[13], pw1[0]=PKW(P0,8), pw1[1]=PKW(P0,10), pw1); \
    VRD(5); SBAR(); GAPA(C1=__builtin_amdgcn_mfma_f32_32x32x16_bf16(kf[3],qb_,C1,0,0,0),   P0[14],P0[15],P1[0],P1[1],   pw1[2]=PKW(P0,12),pw1[3]=PKW(P0,14), pw1); \
    VRD(2); qb_=qls[192]; SBAR(); GAPA(C0=__builtin_amdgcn_mfma_f32_32x32x16_bf16(kf[4],qa_,C0,0,0,0),   P1[2],P1[3],P1[4],P1[5],     pw2[0]=PKW(P1,0), pw2[1]=PKW(P1,2), pw2); \
    VRD(6); SBAR(); GAPA(C1=__builtin_amdgcn_mfma_f32_32x32x16_bf16(kf[5],qa_,C1,0,0,0),   P1[6],P1[7],P1[8],P1[9],     pw2[2]=PKW(P1,4), pw2[3]=PKW(P1,6), pw2); \
    VRD(3); qa_=qls[0]; SBAR(); GAPA(C0=__builtin_amdgcn_mfma_f32_32x32x16_bf16(kf[6],qb_,C0,0,0,0),   P1[10],P1[11],P1[12],P1[13], pw3[0]=PKW(P1,8), pw3[1]=PKW(P1,10), pw3); \
    VRD(7); SBAR(); GAPA(C1=__builtin_amdgcn_mfma_f32_32x32x16_bf16(kf[7],qb_,C1,0,0,0),   P1[14],P1[15],0.f,0.f,       pw3[2]=PKW(P1,12),pw3[3]=PKW(P1,14), pw3); \
    l_reg+=sacc; \
    if(GK){DMA_K((t)+3,sl_cur);} if(GV){DMA_V((t)+1,sl_next);} \
    CMASK(C0,C1,t); \
    { float a=MX3(C0[0],C0[1],C1[0]),b=MX3(C0[2],C0[3],C1[1]); a=MX3(a,C1[2],C1[3]); \
      _Pragma("unroll") for(int r=4;r<16;r+=4){a=MX3(a,C0[r],C0[r+1]);b=MX3(b,C0[r+2],C0[r+3]);a=MX3(a,C1[r],C1[r+1]);b=MX3(b,C1[r+2],C1[r+3]);} \
      float rm=__builtin_fmaxf(a,b); { auto rr=__builtin_amdgcn_permlane32_swap(__float_as_uint(rm),__float_as_uint(rm),false,false); rm=__builtin_fmaxf(__uint_as_float(rr[0]),__uint_as_float(rr[1])); } \
      resc=false; \
      if(__builtin_expect(__any(rm>(float)THRL),0)){ const float dl=__builtin_fmaxf(rm,0.f); mhat+=dl; \
        _Pragma("unroll") for(int r=0;r<16;++r){C0[r]-=dl;C1[r]-=dl;} \
        nmh=-mhat; \
        const float f=__builtin_amdgcn_exp2f(-dl); l_reg*=f; if(hi==0)wsf[r32]=f; resc=true; } } \
    SBAR(); \
    GAPB(o[0]=__builtin_amdgcn_mfma_f32_32x32x16_bf16(PAF(0),VFR(0),o[0],0,0,0), C0,0,0); \
    GAPB(o[1]=__builtin_amdgcn_mfma_f32_32x32x16_bf16(PAF(0),VFR(4),o[1],0,0,0), C0,4,0); \
    KRD(GL,0); GAPB(o[0]=__builtin_amdgcn_mfma_f32_32x32x16_bf16(PAF(1),VFR(1),o[0],0,0,0), C0,8,0); \
    KRD(GL,1); GAPB(o[1]=__builtin_amdgcn_mfma_f32_32x32x16_bf16(PAF(1),VFR(5),o[1],0,0,0), C0,12,0); \
    KRD(GL,2); GAPB(o[0]=__builtin_amdgcn_mfma_f32_32x32x16_bf16(PAF(2),VFR(2),o[0],0,0,0), C1,0,16); \
    KRD(GL,3); GAPB(o[1]=__builtin_amdgcn_mfma_f32_32x32x16_bf16(PAF(2),VFR(6),o[1],0,0,0), C1,4,16); \
    GAPB(o[0]=__builtin_amdgcn_mfma_f32_32x32x16_bf16(PAF(3),VFR(3),o[0],0,0,0), C1,8,16); \
    GAPB(o[1]=__builtin_amdgcn_mfma_f32_32x32x16_bf16(PAF(3),VFR(7),o[1],0,0,0), C1,12,16); \
    }while(0)
  int t=1;
  #undef CMASK
  #define CMASK(P0,P1,t) do{}while(0)
  for(;t+7<NT;t+=2){
    STEP(pB0,pB1,pA0,pA1,t,true,true,true);     WAIT_BAR(2); RESC(); ROT();
    STEP(pA0,pA1,pB0,pB1,t+1,true,true,true);   WAIT_BAR(2); RESC(); ROT();
  }
  #undef CMASK
  #define CMASK(P0,P1,t) do{ if((t)>=NT-6)biasadd(P0,P1,(t),tq,hi,dl,h);}while(0)
  #define ENDW(tt) do{ if((tt)+3<NT){WAIT_BAR(2);} else if((tt)+2<NT){WAIT_BAR(1);} else {WAIT_BAR(0);} }while(0)
  for(;t+1<NT;t+=2){
    STEP(pB0,pB1,pA0,pA1,t,(t+3<NT),(t+1<NT),(t+1<NT));       ENDW(t);   RESC(); ROT();
    STEP(pA0,pA1,pB0,pB1,t+1,(t+4<NT),(t+2<NT),(t+2<NT));     ENDW(t+1); RESC(); ROT();
  }
  STEP(pB0,pB1,pA0,pA1,NT-1,false,false,false); RESC();
  { float sacc=pB0[0]+pB0[1]; _Pragma("unroll") for(int r=2;r<16;++r)sacc+=pB0[r]; _Pragma("unroll") for(int r=0;r<16;++r)sacc+=pB1[r]; l_reg+=sacc;
    pw0=(u32x4){PKW(pB0,0),PKW(pB0,2),PKW(pB0,4),PKW(pB0,6)};pw1=(u32x4){PKW(pB0,8),PKW(pB0,10),PKW(pB0,12),PKW(pB0,14)};pw2=(u32x4){PKW(pB1,0),PKW(pB1,2),PKW(pB1,4),PKW(pB1,6)};pw3=(u32x4){PKW(pB1,8),PKW(pB1,10),PKW(pB1,12),PKW(pB1,14)};
    SBAR(); pv(o,vb0+sl_cur,PAF(0),PAF(1),PAF(2),PAF(3)); }
  #undef PKW
  #undef PAF
  #undef VFR
  #undef PIN
  #undef MX3
  #undef GAPA
  #undef GAPB
  #undef EX
  #undef VRD
  #undef KRD
  #undef STEP
  #undef ENDW
  {auto rr=__builtin_amdgcn_permlane32_swap(__float_as_uint(l_reg),__float_as_uint(l_reg),false,false);l_reg=__uint_as_float(rr[0])+__uint_as_float(rr[1]);}
  if(hi==0)wsf[32+r32]=l_reg;asm volatile("s_waitcnt lgkmcnt(0)":::"memory");
  float rli[16];
  #pragma unroll
  for(int r=0;r<16;++r)rli[r]=__builtin_amdgcn_rcpf(wsf[32+crow(r,hi)]);
  bf16*Ow=O+(rowbase+q0+wid*QBLK)*DMO+h*D; const bf16*Gw=GT+(rowbase+q0+wid*QBLK)*DM+h*D;
  { bf16*stg=(bf16*)(shm+LDS_OST)+wid*2048;
    #pragma unroll
    for(int r=0;r<16;++r){const int orow=crow(r,hi);
      #pragma unroll
      for(int d0=0;d0<2;++d0)stg[orow*64+d0*32+r32]=__float2bfloat16(o[d0][r]*rli[r]);}
    asm volatile("s_waitcnt lgkmcnt(0)":::"memory");
    #pragma unroll
    for(int i=0;i<4;++i){const int row=i*8+(lane>>3),ch=lane&7; const u32x4 v=*(const u32x4*)(stg+row*64+ch*8); const u32x4 g=*(const u32x4*)(Gw+(long)row*DM+ch*8); u32x4 w;
      #pragma unroll
      for(int k=0;k<4;++k){ const float g0=__uint_as_float(g[k]<<16),g1=__uint_as_float(g[k]&0xffff0000u); const float v0=__uint_as_float(v[k]<<16),v1=__uint_as_float(v[k]&0xffff0000u);
        w[k]=cvtpk_s(v0*(g0/(1.0f+__expf(-g0))),v1*(g1/(1.0f+__expf(-g1)))); }
      ATTN_STORE16(Ow+(long)row*DMO+ch*8,w);} }
  asm volatile("s_waitcnt lgkmcnt(0)\n\ts_barrier":::"memory");
  #undef DMA_K
  #undef DMA_V
  #undef CMASK
  #undef START
  #undef RESC
  #undef ROT
}
constexpr int ATTN_LDS_BYTES=LDS_BYTES;
struct AttnTensors { const bf16* Q; const bf16* K; const bf16* V; bf16* O; const bf16* GT; const unsigned* MK; };
struct AttnUnit { int bh; int qb; };
struct StaticOrder {
  int wg,G;
  __device__ __forceinline__ explicit StaticOrder(int grid,int block):wg(block),G(grid){}
  __device__ __forceinline__ bool next(int i,AttnUnit&u)const{ const int p=wg+(i>>1)*G; if(p>=768)return false; const int s=p&15; u.bh=p>>4; u.qb=(i&1)?31-s:s; return true; }
  __device__ __forceinline__ void a_ready(const AttnUnit&)const{}
  __device__ __forceinline__ void done(const AttnUnit&)const{}
};
template<class Sched,int THRL=8> __device__ __forceinline__ void attn_phase(char*lds,const AttnTensors&T,lds_cfptr dl,const Sched&S,int tid){
  AttnUnit u;
  for(int i=0;S.next(i,u);++i){ asm volatile("":"+v"(tid)); S.a_ready(u); attn_unit<THRL>(u.bh/NHEAD,u.bh%NHEAD,u.qb,T.Q,T.K,T.V,T.O,T.GT,T.MK,dl,lds,tid); S.done(u); }
}
#undef SBAR
#undef WAIT_BAR
}

constexpr int NWAVES = 8, NTHR = 512;
constexpr int BATCH = 8, SEQ = 8192, DM = 1024, DEPTH = 4, M = BATCH * SEQ;
constexpr int IN_COLS = 3380, NP = 3584;
constexpr float EPS = 1e-6f;
constexpr int N_GQ = 0, N_GK = 192, N_GV = 384, N_GG = 768, N_DQ = 1152, N_DK = 1536, N_DV = 1920, N_DG = 2304, N_PU = 2688, N_PG = 2944, N_QI = 3200, N_KI = 3328, N_GZ = 3360, N_WI = 3376;
constexpr float LOG2E = 1.4426950408889634f;
constexpr size_t MiB = 1u << 20;
constexpr size_t WS_CTL = 0, CTL_ZERO_BYTES = 1 * MiB;
constexpr size_t WS_WIN = 2 * MiB;
constexpr size_t WS_WOUT = 32 * MiB;
constexpr size_t WS_XB = 48 * MiB;
constexpr size_t WS_P = 176 * MiB;
constexpr size_t WS_MASK = 624 * MiB;
constexpr size_t WS_GOP = 688 * MiB;
constexpr size_t WS_XA = 832 * MiB;
constexpr size_t WS_RSC = 44 * MiB;
constexpr size_t WS_RS = 40 * MiB;
constexpr size_t WS_ZW = 960 * MiB;
constexpr size_t WS_KC = 968 * MiB;
constexpr size_t WS_END = 972 * MiB;
constexpr int CW_BAR = 4096, CW_QUEUE = 8192;
constexpr int RING_BYTES = 131072, LDSCTL_OFF = RING_BYTES, MISC_OFF = LDSCTL_OFF + 320, LDS_BYTES = 147456;

#define GAS __attribute__((address_space(1)))
#define LAS __attribute__((address_space(3)))
typedef unsigned short bf16;
typedef unsigned v4u __attribute__((ext_vector_type(4)));
typedef unsigned v2u __attribute__((ext_vector_type(2)));
typedef float f32x4 __attribute__((ext_vector_type(4)));
typedef GAS unsigned gu32;
#define RLX_AGENT __ATOMIC_RELAXED, __HIP_MEMORY_SCOPE_AGENT
__device__ __forceinline__ unsigned f2bf(float f) { unsigned u = __builtin_bit_cast(unsigned, f); return (u + 0x7fffu + ((u >> 16) & 1u)) >> 16; }
__device__ __forceinline__ unsigned pk2(float lo, float hi) { return f2bf(lo) | (f2bf(hi) << 16); }
__device__ __forceinline__ float bf2f(unsigned short b) { return __builtin_bit_cast(float, (unsigned)b << 16); }
__device__ __forceinline__ float bflo(unsigned w) { return __builtin_bit_cast(float, w << 16); }
__device__ __forceinline__ float bfhi(unsigned w) { return __builtin_bit_cast(float, w & 0xffff0000u); }
__device__ __forceinline__ float shx(float v, int o, int lane) { return __builtin_bit_cast(float, __builtin_amdgcn_ds_bpermute((lane ^ o) << 2, __builtin_bit_cast(int, v))); }
__device__ __forceinline__ int shdn(int v, int o, int lane) { return __builtin_amdgcn_ds_bpermute(((lane + o) & 63) << 2, v); }
__device__ __forceinline__ float wave_sum(float v, int lane) {
#pragma unroll
    for (int o = 1; o < 64; o <<= 1) v += shx(v, o, lane);
    return v;
}
__device__ __forceinline__ float silu_f(float x) { return x / (1.0f + __expf(-x)); }

__constant__ unsigned char T5B[128] = {0, 1, 2, 3, 4, 5, 6, 7, 8, 9, 10, 11, 12, 13, 14, 15, 16, 16, 16, 17, 17, 18, 18, 18, 19, 19, 19, 20, 20, 20, 20, 21, 21, 21, 21, 22, 22, 22, 22, 22, 23, 23, 23, 23, 23, 23, 24, 24, 24, 24, 24, 24, 25, 25, 25, 25, 25, 25, 25, 26, 26, 26, 26, 26, 26, 26, 26, 27, 27, 27, 27, 27, 27, 27, 27, 27, 27, 28, 28, 28, 28, 28, 28, 28, 28, 28, 28, 29, 29, 29, 29, 29, 29, 29, 29, 29, 29, 29, 29, 30, 30, 30, 30, 30, 30, 30, 30, 30, 30, 30, 30, 30, 30, 31, 31, 31, 31, 31, 31, 31, 31, 31, 31, 31, 31, 31, 31, 31};
__device__ __forceinline__ int t5_bucket(int rel) { return rel >= 128 ? 31 : (int)T5B[rel]; }

#define XB_TMO      128
#define XB_XCNT(j)  (256  + 64 * (j))
#define XB_XSUB(j)  (1280 + 64 * (j))
#define XB_XGEN(j)  (2304 + 64 * (j))
#define XB_TOP      3328
#define XB_TOPGEN   3392
#define XCD_BAR_WORDS 3456
#define XB_SPIN_CAP (1u << 22)

__device__ __forceinline__ unsigned xb_ld(unsigned* p)              { return __hip_atomic_load(p, __ATOMIC_RELAXED, __HIP_MEMORY_SCOPE_AGENT); }
__device__ __forceinline__ unsigned xb_add(unsigned* p, unsigned v) { return __hip_atomic_fetch_add(p, v, __ATOMIC_RELAXED, __HIP_MEMORY_SCOPE_AGENT); }
__device__ __forceinline__ unsigned xb_xcc_id() { return (unsigned)__builtin_amdgcn_s_getreg((3 << 11) | 20) & 0xFu; }
#define XB_SPIN(cond, bar) do { unsigned _sp = 0; while (cond) { __builtin_amdgcn_s_sleep(1); \
    if ((++_sp & 255u) == 0u) { if (xb_ld(&(bar)[XB_TMO])) break; if (_sp > XB_SPIN_CAP) { atomicAdd(&(bar)[XB_TMO], 1u); break; } } } } while (0)

struct XcdBarrier {
    unsigned* bar; unsigned x;
    volatile LAS unsigned* st;
};

__device__ __forceinline__ XcdBarrier xcd_barrier_post(unsigned* bar, volatile LAS unsigned* st) {
    XcdBarrier b; b.bar = bar; b.x = xb_xcc_id(); b.st = st;
    if (threadIdx.x == 0) (void)xb_add(&bar[XB_XCNT(b.x)], 1u);
    return b;
}
__device__ __forceinline__ void xcd_barrier_complete(unsigned* bar, unsigned x, unsigned& nloc, unsigned& nx) {
    const unsigned G = gridDim.x * gridDim.y * gridDim.z;
    unsigned sum, cnt, mine, sp = 0u;
    for (;;) {
        sum = 0u; cnt = 0u; mine = 0u;
#pragma unroll
        for (unsigned j = 0; j < 16; ++j) { const unsigned c = xb_ld(&bar[XB_XCNT(j)]); sum += c; cnt += (c > 0u) ? 1u : 0u; mine = (j == x) ? c : mine; }
        if (sum == G) break;
        __builtin_amdgcn_s_sleep(1);
        if ((++sp & 255u) == 0u) { if (xb_ld(&bar[XB_TMO])) break; if (sp > XB_SPIN_CAP) { atomicAdd(&bar[XB_TMO], 1u); break; } }
    }
    nloc = mine > 0u ? mine : 1u; nx = cnt > 0u ? cnt : 1u;
}

__device__ __forceinline__ void xcd_barrier(const XcdBarrier& b) {
    asm volatile("s_waitcnt vmcnt(0)" ::: "memory");
    __syncthreads();
    if (threadIdx.x == 0) {
        unsigned* bar = b.bar;
        __builtin_amdgcn_s_waitcnt(0);
        unsigned nloc = b.st[0], nx = b.st[1];
        if (nloc == 0u) { xcd_barrier_complete(bar, b.x, nloc, nx); b.st[0] = nloc; b.st[1] = nx; }
        const unsigned old = xb_add(&bar[XB_XSUB(b.x)], 1u);
        const unsigned gen = old / nloc;
        if (old + 1u == (gen + 1u) * nloc) {
            __builtin_amdgcn_fence(__ATOMIC_RELEASE, "agent");
            asm volatile("s_waitcnt vmcnt(0)" ::: "memory");
            const unsigned og = xb_add(&bar[XB_TOP], 1u);
            const unsigned tg = og / nx;
            if (og + 1u == (tg + 1u) * nx) xb_add(&bar[XB_TOPGEN], 1u);
            else XB_SPIN(xb_ld(&bar[XB_TOPGEN]) == tg, bar);
            __builtin_amdgcn_fence(__ATOMIC_ACQUIRE, "agent");
            xb_add(&bar[XB_XGEN(b.x)], 1u);
            asm volatile("s_waitcnt vmcnt(0)" ::: "memory");
        } else {
            XB_SPIN(xb_ld(&bar[XB_XGEN(b.x)]) == gen, bar);
            __builtin_amdgcn_fence(__ATOMIC_ACQUIRE, "agent");
            asm volatile("s_waitcnt vmcnt(0)" ::: "memory");
        }
    }
    __syncthreads();
}
#ifndef IDX_NOFALLBACK
#define IDX_NOFALLBACK 0
#endif
#ifndef REP_RES
#define REP_RES 1
#endif
#ifndef REP_PATCH
#define REP_PATCH 1
#endif
#ifndef REP_P1
#define REP_P1 1
#endif
#ifndef REP_P3
#define REP_P3 1
#endif
#ifndef REP_HEAD
#define REP_HEAD 1
#endif
#ifndef REP_RES
#define REP_RES 1
#endif
#ifndef REP_P2
#define REP_P2 1
#endif
#ifndef REP_RANK
#define REP_RANK 1
#endif
#ifndef IDX_PRIO
#define IDX_PRIO 1
#endif
#ifndef IDX_PKFMA
#define IDX_PKFMA 0
#endif
#ifndef PROBE_MFMA2
#define PROBE_MFMA2 0
#endif
#ifndef PROBE_ADD2
#define PROBE_ADD2 0
#endif
#ifndef IDX_ASMFMA
#define IDX_ASMFMA 0
#endif
#ifndef IDX_ASMBIN
#define IDX_ASMBIN 0
#endif
namespace idxb {
typedef short bf16x8 __attribute__((ext_vector_type(8)));
typedef float f32x16 __attribute__((ext_vector_type(16)));
constexpr int ZBIN = 0, NBINS = 512, CAP = 256;
constexpr int L_HIST = 0, L_ZC = 65536, L_PAR = 81920, L_KBUF = 83968, L_XT = 116736;
enum { P_BSTAR = 0, P_KK, P_CCNT, P_TAU, P_CUT, P_MODE, P_TSTAR, P_RSTAR, P_OVF, P_NRANK, P_PRE, P_XL, P_XU };
__device__ __forceinline__ unsigned lds_add(unsigned* p, unsigned v) { return __hip_atomic_fetch_add((__attribute__((address_space(3))) unsigned*)p, v, __ATOMIC_RELAXED, __HIP_MEMORY_SCOPE_WORKGROUP); }
__device__ __forceinline__ int crow(int r, int hi) { return (r & 3) + 8 * (r >> 2) + 4 * hi; }
struct QFrag { bf16x8 q[4][2]; float w[4]; };
__device__ __forceinline__ f32x16 score_sub(const bf16x8 k0, const bf16x8 k1, const QFrag& Q) {
    f32x16 acc;
#pragma unroll
    for (int r = 0; r < 16; ++r) acc[r] = 0.f;
    const f32x16 zz = {0.f, 0.f, 0.f, 0.f, 0.f, 0.f, 0.f, 0.f, 0.f, 0.f, 0.f, 0.f, 0.f, 0.f, 0.f, 0.f};
    float INFV; asm("s_mov_b32 %0, 0x7f800000" : "=s"(INFV));
#pragma unroll
    for (int hp = 0; hp < 2; ++hp) {
        f32x16 d0 = __builtin_amdgcn_mfma_f32_32x32x16_bf16(k0, Q.q[2 * hp][0], zz, 0, 0, 0), d1 = __builtin_amdgcn_mfma_f32_32x32x16_bf16(k0, Q.q[2 * hp + 1][0], zz, 0, 0, 0);
        d0 = __builtin_amdgcn_mfma_f32_32x32x16_bf16(k1, Q.q[2 * hp][1], d0, 0, 0, 0); d1 = __builtin_amdgcn_mfma_f32_32x32x16_bf16(k1, Q.q[2 * hp + 1][1], d1, 0, 0, 0);
#if PROBE_MFMA2
        { f32x16 e0 = __builtin_amdgcn_mfma_f32_32x32x16_bf16(k0, Q.q[2 * hp][1], zz, 0, 0, 0); e0 = __builtin_amdgcn_mfma_f32_32x32x16_bf16(k1, Q.q[2 * hp][0], e0, 0, 0, 0);
          e0 = __builtin_amdgcn_mfma_f32_32x32x16_bf16(k0, Q.q[2 * hp + 1][1], e0, 0, 0, 0); e0 = __builtin_amdgcn_mfma_f32_32x32x16_bf16(k1, Q.q[2 * hp + 1][0], e0, 0, 0, 0); asm volatile("" :: "v"(e0)); }
#endif
#if IDX_PKFMA
        { typedef float f32x2 __attribute__((ext_vector_type(2)));
            const f32x2 wa = {Q.w[2 * hp], Q.w[2 * hp]}, wb = {Q.w[2 * hp + 1], Q.w[2 * hp + 1]};
#pragma unroll
            for (int r = 0; r < 16; r += 2) { const f32x2 ra = {__builtin_amdgcn_fmed3f(d0[r], 0.f, INFV), __builtin_amdgcn_fmed3f(d0[r + 1], 0.f, INFV)}, rb = {__builtin_amdgcn_fmed3f(d1[r], 0.f, INFV), __builtin_amdgcn_fmed3f(d1[r + 1], 0.f, INFV)};
                f32x2 ac = {acc[r], acc[r + 1]}; ac = __builtin_elementwise_fma(wa, ra, ac); ac = __builtin_elementwise_fma(wb, rb, ac); acc[r] = ac[0]; acc[r + 1] = ac[1]; } }
#else
#pragma unroll
        for (int r = 0; r < 16; ++r) {
#if IDX_ASMFMA
            const float r0 = __builtin_amdgcn_fmed3f(d0[r], 0.f, INFV), r1 = __builtin_amdgcn_fmed3f(d1[r], 0.f, INFV); float a0 = acc[r], a1;
            if (hp == 0) asm("v_mul_f32 %0, %1, %2" : "=v"(a0) : "v"(Q.w[0]), "v"(r0)); else asm("v_fma_f32 %0, %1, %2, %3" : "=v"(a0) : "v"(Q.w[2]), "v"(r0), "v"(acc[r]));
            asm("v_fma_f32 %0, %1, %2, %3" : "=v"(a1) : "v"(Q.w[2 * hp + 1]), "v"(r1), "v"(a0)); acc[r] = a1;
#else
            acc[r] = __builtin_fmaf(Q.w[2 * hp + 1], __builtin_amdgcn_fmed3f(d1[r], 0.f, INFV), __builtin_fmaf(Q.w[2 * hp], __builtin_amdgcn_fmed3f(d0[r], 0.f, INFV), acc[r]));
#endif
        }
#endif
    }
    return acc;
}
constexpr int G0 = (int)(0x3F800000u >> 18);
typedef __attribute__((address_space(3))) unsigned lds_u32;
__device__ __forceinline__ void hist_add(unsigned hb, float x, unsigned inc) {
    const float xc = __builtin_amdgcn_fmed3f(x, -254.0f, 254.0f);
#if IDX_ASMBIN
    float os, y; const unsigned m = 0x7fffffffu;
    asm("v_bfi_b32 %0, %1, 1.0, %2" : "=v"(os) : "s"(m), "v"(xc));
    asm("v_add_f32 %0, %1, %2" : "=v"(y) : "v"(xc), "v"(os));
    unsigned sh; asm("v_lshrrev_b32 %0, 18, %1" : "=v"(sh) : "v"(y));
    const unsigned a = hb + (sh << 2);
#else
    const float y = xc + __uint_as_float((__float_as_uint(xc) & 0x80000000u) | 0x3F800000u);
    const unsigned a = hb + ((__float_as_uint(y) >> 18) << 2);
#endif
    __hip_atomic_fetch_add((lds_u32*)a, inc, __ATOMIC_RELAXED, __HIP_MEMORY_SCOPE_WORKGROUP);
#if PROBE_ADD2
    __hip_atomic_fetch_add((lds_u32*)(a ^ 64u), 0u, __ATOMIC_RELAXED, __HIP_MEMORY_SCOPE_WORKGROUP);
#endif
}
__device__ __forceinline__ int hword(int q, int h) { return ((h >> 8) << 13) + q * 256 + (h & 255); }
__device__ __forceinline__ int rank_to_bin(int k) { return k < 256 ? 255 - k : k; }
__device__ __forceinline__ float xthr(int ot) { if (ot == 0) return 0.f;
    const unsigned B = (unsigned)(G0 + ot) << 18; unsigned hi = __float_as_uint(__uint_as_float(B) - 1.0f), lo = 0u;
#pragma unroll 1
    for (int i = 0; i < 32; ++i) { const unsigned mid = lo + ((hi - lo) >> 1); if (__float_as_uint(__uint_as_float(mid) + 1.0f) >= B) hi = mid; else lo = mid; }
    return __uint_as_float(hi); }
__device__ __forceinline__ unsigned wave_or(unsigned v) { int x = (int)v;
    x |= __builtin_amdgcn_update_dpp(0, x, 0x111, 0xf, 0xf, true); x |= __builtin_amdgcn_update_dpp(0, x, 0x112, 0xf, 0xf, true);
    x |= __builtin_amdgcn_update_dpp(0, x, 0x114, 0xf, 0xf, true); x |= __builtin_amdgcn_update_dpp(0, x, 0x118, 0xf, 0xf, true);
    x |= __builtin_amdgcn_update_dpp(0, x, 0x142, 0xf, 0xf, true); x |= __builtin_amdgcn_update_dpp(0, x, 0x143, 0xf, 0xf, true);
    return (unsigned)__builtin_amdgcn_readlane(x, 63); }
__device__ __forceinline__ float sel32(const f32x16& a, const f32x16& b, int e) {
    const bool b0 = e & 1, b1 = e & 2, b2 = e & 4, b3 = e & 8, b4 = e & 16;
    float v0 = a[0], v1 = a[1], v2 = a[2], v3 = a[3], v4 = a[4], v5 = a[5], v6 = a[6], v7 = a[7], v8 = a[8], v9 = a[9], v10 = a[10], v11 = a[11], v12 = a[12], v13 = a[13], v14 = a[14], v15 = a[15], v16 = b[0], v17 = b[1], v18 = b[2], v19 = b[3], v20 = b[4], v21 = b[5], v22 = b[6], v23 = b[7], v24 = b[8], v25 = b[9], v26 = b[10], v27 = b[11], v28 = b[12], v29 = b[13], v30 = b[14], v31 = b[15];
    asm("" : "+v"(v0)); asm("" : "+v"(v1)); asm("" : "+v"(v2)); asm("" : "+v"(v3)); asm("" : "+v"(v4)); asm("" : "+v"(v5)); asm("" : "+v"(v6)); asm("" : "+v"(v7)); asm("" : "+v"(v8)); asm("" : "+v"(v9)); asm("" : "+v"(v10)); asm("" : "+v"(v11)); asm("" : "+v"(v12)); asm("" : "+v"(v13)); asm("" : "+v"(v14)); asm("" : "+v"(v15)); asm("" : "+v"(v16)); asm("" : "+v"(v17)); asm("" : "+v"(v18)); asm("" : "+v"(v19)); asm("" : "+v"(v20)); asm("" : "+v"(v21)); asm("" : "+v"(v22)); asm("" : "+v"(v23)); asm("" : "+v"(v24)); asm("" : "+v"(v25)); asm("" : "+v"(v26)); asm("" : "+v"(v27)); asm("" : "+v"(v28)); asm("" : "+v"(v29)); asm("" : "+v"(v30)); asm("" : "+v"(v31));
    const float p0 = b0 ? v1 : v0, p1 = b0 ? v3 : v2, p2 = b0 ? v5 : v4, p3 = b0 ? v7 : v6, p4 = b0 ? v9 : v8, p5 = b0 ? v11 : v10, p6 = b0 ? v13 : v12, p7 = b0 ? v15 : v14, p8 = b0 ? v17 : v16, p9 = b0 ? v19 : v18, p10 = b0 ? v21 : v20, p11 = b0 ? v23 : v22, p12 = b0 ? v25 : v24, p13 = b0 ? v27 : v26, p14 = b0 ? v29 : v28, p15 = b0 ? v31 : v30;
    const float q0 = b1 ? p1 : p0, q1 = b1 ? p3 : p2, q2 = b1 ? p5 : p4, q3 = b1 ? p7 : p6, q4 = b1 ? p9 : p8, q5 = b1 ? p11 : p10, q6 = b1 ? p13 : p12, q7 = b1 ? p15 : p14;
    const float r0 = b2 ? q1 : q0, r1 = b2 ? q3 : q2, r2 = b2 ? q5 : q4, r3 = b2 ? q7 : q6;
    const float s0 = b3 ? r1 : r0, s1 = b3 ? r3 : r2;
    return b4 ? s1 : s0; }
__device__ __forceinline__ unsigned spread_nib(unsigned x) { x = (x | (x << 8)) & 0x00FF00FFu; return (x | (x << 4)) & 0x0F0F0F0Fu; }


template <int HP, int MODE, bool NEXT>
__device__ __forceinline__ void pstage(f32x16& acc, const f32x16& dc0, const f32x16& dc1, f32x16& dn0, f32x16& dn1, const bf16x8 ka, const bf16x8 kb,
                                       const bf16x8 qa0, const bf16x8 qa1, const bf16x8 qb0, const bf16x8 qb1, const float wA, const float wB,
                                       const unsigned hb, const unsigned inc, const int s0, const int t, const int hi, const float XU, const float XL, unsigned& wn, unsigned& wl) {
    const f32x16 zz = {0.f, 0.f, 0.f, 0.f, 0.f, 0.f, 0.f, 0.f, 0.f, 0.f, 0.f, 0.f, 0.f, 0.f, 0.f, 0.f};
    float INFV; asm("s_mov_b32 %0, 0x7f800000" : "=s"(INFV));
#pragma unroll
    for (int c = 3; c >= 0; --c) {
        if (NEXT) {
            if (c == 3) dn0 = __builtin_amdgcn_mfma_f32_32x32x16_bf16(ka, qa0, zz, 0, 0, 0);
            else if (c == 2) dn1 = __builtin_amdgcn_mfma_f32_32x32x16_bf16(ka, qb0, zz, 0, 0, 0);
            else if (c == 1) dn0 = __builtin_amdgcn_mfma_f32_32x32x16_bf16(kb, qa1, dn0, 0, 0, 0);
            else dn1 = __builtin_amdgcn_mfma_f32_32x32x16_bf16(kb, qb1, dn1, 0, 0, 0);
            __builtin_amdgcn_sched_barrier(0);
        }
#pragma unroll
        for (int r = 4 * c + 3; r >= 4 * c; --r) {
            const float r0 = __builtin_amdgcn_fmed3f(dc0[r], 0.f, INFV), r1 = __builtin_amdgcn_fmed3f(dc1[r], 0.f, INFV);
            float x = __builtin_fmaf(wB, r1, __builtin_fmaf(wA, r0, HP == 0 ? 0.f : acc[r]));
            if (MODE == 4) { if (s0 + crow(r, hi) > t) x = -__builtin_inff(); }
            acc[r] = x;
            if (MODE == 1) hist_add(hb, x, inc);
            if (MODE == 2) { if (s0 + crow(r, hi) <= t) hist_add(hb, x, inc); }
            if (MODE == 3 || MODE == 4) { const float t1 = x - XU, t2 = x - XL; wn = __builtin_amdgcn_alignbit(wn, __float_as_uint(t1), 31); wl = __builtin_amdgcn_alignbit(wl, __float_as_uint(t2), 31); }
        }
        if (NEXT) __builtin_amdgcn_sched_barrier(0);
    }
}
__device__ __forceinline__ void index_unit(const unsigned short* P, const unsigned short* KC, unsigned* MK, unsigned* ZWg, unsigned char* lds, int b, int qt, int tid) {
    const int lane = tid & 63, wave = __builtin_amdgcn_readfirstlane(tid >> 6), r32 = lane & 31, hi = lane >> 5;
    unsigned* hist32 = (unsigned*)(lds + L_HIST); unsigned* cand_s = (unsigned*)(lds + L_HIST); unsigned* cand_i = (unsigned*)(lds + L_HIST + 32768);     unsigned* zc = (unsigned*)(lds + L_ZC); int* par = (int*)(lds + L_PAR);
    const int t = qt * 32 + r32; const size_t qrow = (size_t)b * SEQ + t;
    const int kt_max = (qt * 32 + 31) >> 6, NTW = ((qt >> 3) + 1) * 4;
    const unsigned short* KI = KC + (size_t)b * SEQ * 32;
    QFrag Q; float invw;
    for (int rh_ = 0; rh_ < REP_HEAD; ++rh_) { asm volatile("" ::: "memory");
    { const unsigned short* qp = P + qrow * NP + N_QI + hi * 8; float var = 0.f;
#pragma unroll
        for (int h = 0; h < 4; ++h) { float s = 0.f;
#pragma unroll
            for (int ks = 0; ks < 2; ++ks) { Q.q[h][ks] = *(const bf16x8*)(qp + h * 32 + ks * 16);
#pragma unroll
                for (int j = 0; j < 8; ++j) { const float v = bf2f((unsigned short)Q.q[h][ks][j]); s += v * v; } }
            s += shx(s, 32, lane); Q.w[h] = bf2f(P[qrow * NP + N_WI + h]); var += Q.w[h] * Q.w[h] * s; }
        invw = 82.7f / sqrtf(var > 1e-20f ? var : 1e-20f);
#pragma unroll
        for (int h = 0; h < 4; ++h) Q.w[h] *= invw; }
    __syncthreads();
    { typedef unsigned u32x4z __attribute__((ext_vector_type(4))); for (int i = tid; i < (L_PAR + 2048) / 16; i += NTHR) ((__attribute__((address_space(3))) u32x4z*)lds)[i] = (u32x4z){0u, 0u, 0u, 0u}; }
    __syncthreads(); }
    __attribute__((address_space(3))) unsigned char* kbuf = (__attribute__((address_space(3))) unsigned char*)lds + L_KBUF + wave * 4096;
#define IDX_KISSUE(kt_) do { const unsigned short* kp_ = KI + (size_t)(kt_) * 2048 + lane * 8;        \
        __builtin_amdgcn_global_load_lds((const unsigned*)kp_, (__attribute__((address_space(3))) unsigned*)kbuf, 16, 0, 0); \
        __builtin_amdgcn_global_load_lds((const unsigned*)(kp_ + 512), (__attribute__((address_space(3))) unsigned*)(kbuf + 1024), 16, 0, 0); \
        __builtin_amdgcn_global_load_lds((const unsigned*)(kp_ + 1024), (__attribute__((address_space(3))) unsigned*)(kbuf + 2048), 16, 0, 0); \
        __builtin_amdgcn_global_load_lds((const unsigned*)(kp_ + 1536), (__attribute__((address_space(3))) unsigned*)(kbuf + 3072), 16, 0, 0); } while (0)
#define IDX_KREAD(dst) do { const int ko_ = r32 * 64 + hi * 16;                                     \
        dst[0] = *(__attribute__((address_space(3))) bf16x8*)(kbuf + ko_); dst[1] = *(__attribute__((address_space(3))) bf16x8*)(kbuf + ko_ + 32); \
        dst[2] = *(__attribute__((address_space(3))) bf16x8*)(kbuf + ko_ + 2048); dst[3] = *(__attribute__((address_space(3))) bf16x8*)(kbuf + ko_ + 2080); } while (0)
#define IDX_KTAKE(dst, cnt_) do { asm volatile("s_waitcnt vmcnt(" cnt_ ")" ::: "memory"); IDX_KREAD(dst); asm volatile("s_waitcnt lgkmcnt(0)" ::: "memory"); } while (0)
    const unsigned hb = (unsigned)(size_t)((__attribute__((address_space(3))) unsigned char*)lds) + L_HIST + r32 * 1024 - 4 * G0;
#if IDX_PRIO
    if (wave >= 4) __builtin_amdgcn_s_setprio(1);
#endif
    const int qlo = qt * 32;
#define IDX_PRO(dA, dB) do { const f32x16 zz_ = {0.f, 0.f, 0.f, 0.f, 0.f, 0.f, 0.f, 0.f, 0.f, 0.f, 0.f, 0.f, 0.f, 0.f, 0.f, 0.f}; \
        dA = __builtin_amdgcn_mfma_f32_32x32x16_bf16(kc[0], Q.q[0][0], zz_, 0, 0, 0); dB = __builtin_amdgcn_mfma_f32_32x32x16_bf16(kc[0], Q.q[1][0], zz_, 0, 0, 0); \
        dA = __builtin_amdgcn_mfma_f32_32x32x16_bf16(kc[1], Q.q[0][1], dA, 0, 0, 0); dB = __builtin_amdgcn_mfma_f32_32x32x16_bf16(kc[1], Q.q[1][1], dB, 0, 0, 0); } while (0)
#define IDX_QHI Q.q[2][0], Q.q[2][1], Q.q[3][0], Q.q[3][1]
#define IDX_QLO Q.q[0][0], Q.q[0][1], Q.q[1][0], Q.q[1][1]
    for (int rp1 = 0; rp1 < REP_P1; ++rp1) { bf16x8 kc[4]; const unsigned inc1 = (rp1 & 1) ? 0xffffffffu : 1u; if (wave <= kt_max) IDX_KISSUE(wave);
      for (int kt = wave; kt <= kt_max; kt += 8) {
        IDX_KTAKE(kc, "0"); if (kt + 8 <= kt_max) IDX_KISSUE(kt + 8);
        if (kt * 64 + 63 <= qlo) {
#pragma unroll
            for (int sub = 0; sub < 2; ++sub) { const f32x16 sc = score_sub(kc[2 * sub], kc[2 * sub + 1], Q);
#pragma unroll
                for (int r = 0; r < 16; ++r) hist_add(hb, sc[r], inc1); }
        } else {
#pragma unroll
            for (int sub = 0; sub < 2; ++sub) { const f32x16 sc = score_sub(kc[2 * sub], kc[2 * sub + 1], Q); const int s0 = kt * 64 + sub * 32;
#pragma unroll
                for (int r = 0; r < 16; ++r) { if (s0 + crow(r, hi) <= t) hist_add(hb, sc[r], inc1); } }
        }
      } }
    __syncthreads();
    for (int rr_ = 0; rr_ < REP_RES; ++rr_) { __syncthreads(); asm volatile("" ::: "memory");
    { typedef unsigned u32x4r __attribute__((ext_vector_type(4)));
        const int q = tid >> 4, j = tid & 15, N = qt * 32 + q + 1; const bool neg = j >= 8;
        const unsigned* hs = hist32 + (neg ? 8192 + q * 256 + 32 * (j - 8) : q * 256 + 224 - 32 * j); int c = 0;
#pragma unroll
        for (int u = 0; u < 8; ++u) { const u32x4r v = *(const u32x4r*)(hs + 4 * ((u + (j >> 1)) & 7)); c += (int)(v[0] + v[1] + v[2] + v[3]); }
        int incl = c;
#pragma unroll
        for (int o = 1; o < 16; o <<= 1) { const int v = __builtin_amdgcn_ds_bpermute(((lane - o) & 63) << 2, incl); if (j >= o) incl += v; }
        const int excl = incl - c;
        if (N <= 256) { if (j == 0) par[P_MODE * 32 + q] = 0; }
        else if (excl < 256 && 256 <= incl) { u32x4r w[8];
#pragma unroll
            for (int u = 0; u < 8; ++u) w[u] = *(const u32x4r*)(hs + 4 * u);
            int above = excl, isel = -1, cntb = 0, ab = 0;
#pragma unroll
            for (int i = 0; i < 32; ++i) { const int cb = (int)(neg ? w[i >> 2][i & 3] : w[(31 - i) >> 2][(31 - i) & 3]); if (isel < 0 && above + cb >= 256) { isel = i; cntb = cb; ab = above; } above += cb; }
            const int bsel = rank_to_bin(32 * j + isel), ot = bsel & 255; const float* XT = (const float*)(lds + L_XT);
            par[P_BSTAR * 32 + q] = bsel; par[P_KK * 32 + q] = 256 - ab; par[P_MODE * 32 + q] = (bsel != 0 && cntb > CAP) ? 3 : 1;
            const float xa = XT[ot], xb = XT[ot + 1];
            const float XL = neg ? -__uint_as_float(__float_as_uint(xb) - 1u) : xa;
            const float XU = neg ? (xa > 0.f ? -__uint_as_float(__float_as_uint(xa) - 1u) : 0.f) : xb;
            par[P_XL * 32 + q] = (int)__float_as_uint(XL); par[P_XU * 32 + q] = (int)__float_as_uint(XU); }
    } }
    __syncthreads();
    const int my_mode = par[P_MODE * 32 + r32], my_b = par[P_BSTAR * 32 + r32];
    __syncthreads();
    float XL = __uint_as_float((unsigned)par[P_XL * 32 + r32]), XU = __uint_as_float((unsigned)par[P_XU * 32 + r32]);
    if (my_mode == 0) { XL = -3.0e38f; XU = -3.0e38f; }
    if (my_mode == 3) { XL = __builtin_inff(); XU = __builtin_inff(); }
    const bool central = (my_mode == 1 && my_b == 0);
    unsigned* ZW = ZWg;
    for (int r2_ = 0; r2_ < REP_P2; ++r2_) { if (r2_) { __syncthreads(); for (int i = tid; i < 32 * 128; i += NTHR) zc[i] = 0u; if (tid < 32) { par[P_CCNT * 32 + tid] = 0; par[P_OVF * 32 + tid] = 0; } __syncthreads(); }
    { bf16x8 kc[4]; if (wave <= kt_max) IDX_KISSUE(wave);
      for (int kt = wave; kt < NTW; kt += 8) {
        unsigned word = 0u, wz = 0u;
        if (kt <= kt_max) {
            if (kt == wave) { IDX_KTAKE(kc, "0"); } else { IDX_KTAKE(kc, "2"); }
            if (kt + 8 <= kt_max) IDX_KISSUE(kt + 8);
            asm volatile("" ::: "memory");
            f32x16 s0v = score_sub(kc[0], kc[1], Q), s1v = score_sub(kc[2], kc[3], Q);
            const bool diag = kt * 64 + 63 > qlo;
            if (diag) {
#pragma unroll
                for (int r = 0; r < 16; ++r) { const int s = kt * 64 + crow(r, hi); if (s > t) s0v[r] = -__builtin_inff(); if (s + 32 > t) s1v[r] = -__builtin_inff(); } }
            unsigned wn = 0u, wl = 0u;
#pragma unroll
            for (int e = 31; e >= 0; --e) { const float x = (e < 16) ? s0v[e & 15] : s1v[e & 15]; float t1, t2;
#if IDX_ASMBIN
                asm("v_sub_f32 %0, %1, %2" : "=v"(t1) : "v"(x), "v"(XU)); asm("v_sub_f32 %0, %1, %2" : "=v"(t2) : "v"(x), "v"(XL));
#else
                t1 = x - XU; t2 = x - XL;
#endif
                wn = __builtin_amdgcn_alignbit(wn, __float_as_uint(t1), 31); wl = __builtin_amdgcn_alignbit(wl, __float_as_uint(t2), 31); }
            word = ~wn; const unsigned inb = wn & ~wl;
            if ((REP_P2 == 1 || r2_ > 0) && __any(inb != 0u)) {
                unsigned zb = 0u;
                if (__any(central && inb != 0u)) { unsigned UZ = wave_or(central ? inb : 0u);
                    while (UZ) { const int e = __builtin_ctz(UZ); UZ &= UZ - 1u; const float x = (e < 16) ? s0v[e & 15] : s1v[e & 15];
                        if (central && ((inb >> e) & 1u) && x == 0.f) zb |= (1u << e); }
                    if (zb) lds_add(&zc[r32 * 128 + kt], (unsigned)__builtin_popcount(zb)); wz = zb; }
                const unsigned cb = inb & ~zb; const int cnt = __builtin_popcount(cb); int pos = 0;
                if (cnt) { pos = (int)lds_add((unsigned*)&par[P_CCNT * 32 + r32], (unsigned)cnt); if (pos + cnt > CAP) par[P_OVF * 32 + r32] = 1; }
                unsigned m = cb; int slot = pos;
                while (__any(m != 0u)) { const int e = (int)__builtin_ctz(m | 0x80000000u); const float x = sel32(s0v, s1v, e);
                    if (m != 0u && slot < CAP) { cand_s[r32 * CAP + slot] = __float_as_uint(x); cand_i[r32 * CAP + slot] = (unsigned)(kt * 64 + 32 * (e >> 4) + ((e & 3) + 8 * ((e & 15) >> 2) + 4 * hi)); }
                    m &= m - 1u; ++slot; }
            }
        }
        MK[((size_t)(b * 256 + qt) * 128 + kt) * 64 + lane] = word; ZW[kt * 64 + lane] = wz;
      } } }
#if IDX_PRIO
    __builtin_amdgcn_s_setprio(0);
#endif
    asm volatile("s_waitcnt vmcnt(0)" ::: "memory");
    __syncthreads();
    for (int rk_ = 0; rk_ < REP_RANK; ++rk_) { if (rk_) __syncthreads(); asm volatile("" ::: "memory");
    { const int q = tid >> 4, j = tid & 15, mode = par[P_MODE * 32 + q], kk = par[P_KK * 32 + q], bq = par[P_BSTAR * 32 + q];
        const int n = par[P_CCNT * 32 + q] < CAP ? par[P_CCNT * 32 + q] : CAP, n4 = (n + 3) & ~3;
        if (mode == 1 && par[P_OVF * 32 + q]) { if (j == 0) par[P_MODE * 32 + q] = 3; }
        else if (mode == 1 && kk <= n) {
            if (j < n4 - n) { cand_s[q * CAP + n + j] = 0xFF800000u; cand_i[q * CAP + n + j] = 0xFFFFFFFFu; }
            if (j == 0) { par[P_NRANK * 32 + q] = n; par[P_TSTAR * 32 + q] = -1; } }
        else if (mode == 1 && bq == 0) {
            const int need = kk - n; int zl[8], c = 0;
#pragma unroll
            for (int u = 0; u < 8; ++u) { zl[u] = (int)zc[q * 128 + 8 * j + u]; c += zl[u]; }
            int incl = c;
#pragma unroll
            for (int o = 1; o < 16; o <<= 1) { const int v = __builtin_amdgcn_ds_bpermute(((lane - o) & 63) << 2, incl); if (j >= o) incl += v; }
            int cum = incl - c;
            if (j == 0) { par[P_TAU * 32 + q] = (int)0xFF800000u; par[P_CUT * 32 + q] = -1; }
            if (cum < need && need <= incl) { int ts = 8 * j + 7, rs = 1; bool done = false;
#pragma unroll
                for (int u = 0; u < 8; ++u) { if (!done && cum + zl[u] >= need) { ts = 8 * j + u; rs = need - cum; done = true; } cum += zl[u]; }
                par[P_TSTAR * 32 + q] = ts; par[P_RSTAR * 32 + q] = rs; } }
        else if (mode == 1) { if (j == 0) par[P_MODE * 32 + q] = 3; }
    }
    __syncthreads();
    if (tid < 64) { const int q = lane & 31; int incl = par[P_NRANK * 32 + q];
#pragma unroll
        for (int o = 1; o < 32; o <<= 1) { const int v = __builtin_amdgcn_ds_bpermute(((lane - o) & 63) << 2, incl); if (q >= o) incl += v; }
        if (lane < 32) par[P_PRE * 32 + q] = incl; }
    __syncthreads();
    { typedef unsigned u32x4v __attribute__((ext_vector_type(4)));
        const int total = par[P_PRE * 32 + 31];
        for (int g = tid; g < total; g += NTHR) {
            int q = 0;
#pragma unroll
            for (int st = 16; st >= 1; st >>= 1) { if (par[P_PRE * 32 + q + st - 1] <= g) q += st; }
            const int i = g - (q ? par[P_PRE * 32 + q - 1] : 0), n = par[P_NRANK * 32 + q], n4 = (n + 3) & ~3, kk = par[P_KK * 32 + q];
            const unsigned cix = cand_s[q * CAP + i], ciy = cand_i[q * CAP + i]; const float si = __uint_as_float(cix); int rank = 0;
#pragma unroll 2
            for (int m2 = 0; m2 < n4; m2 += 4) { const u32x4v sv = *(const u32x4v*)&cand_s[q * CAP + m2], iv = *(const u32x4v*)&cand_i[q * CAP + m2];
#pragma unroll
                for (int u = 0; u < 4; ++u) { const float sm = __uint_as_float(sv[u]); rank += (sm > si || (sm == si && iv[u] < ciy)) ? 1 : 0; } }
            if (rank == kk - 1) { par[P_TAU * 32 + q] = (int)cix; par[P_CUT * 32 + q] = (int)ciy; } } }
    __syncthreads(); }
    for (int rpp = 0; rpp < REP_PATCH; ++rpp)
    { const int q = tid >> 4, j = tid & 15, mode = par[P_MODE * 32 + q];
        if (mode == 1) { const int n = par[P_CCNT * 32 + q]; const float tau = __uint_as_float((unsigned)par[P_TAU * 32 + q]); const unsigned cut = (unsigned)par[P_CUT * 32 + q]; const int ts = par[P_TSTAR * 32 + q], rs = par[P_RSTAR * 32 + q];
            unsigned* mq = MK + (size_t)(b * 256 + qt) * 128 * 64 + q;
#pragma unroll 1
            for (int i = j; i < n; i += 16) { const float sc = __uint_as_float(cand_s[q * CAP + i]); const unsigned s = cand_i[q * CAP + i];
                if (sc > tau || (sc == tau && s <= cut)) { const int kap = s & 63, k5 = kap & 31, hh = (k5 >> 2) & 1, e = (k5 & 3) + 4 * (k5 >> 3) + 16 * (kap >> 5);
                    __hip_atomic_fetch_or(mq + (s >> 6) * 64 + 32 * hh, 1u << e, __ATOMIC_RELAXED, __HIP_MEMORY_SCOPE_AGENT); } }
            if (ts >= 0) {
                unsigned zw0[8], zw1[8];
#pragma unroll
                for (int u = 0; u < 8; ++u) { const int kt = j + 16 * u; zw0[u] = 0u; zw1[u] = 0u; if (kt <= ts) { zw0[u] = __hip_atomic_load(ZW + kt * 64 + q, __ATOMIC_RELAXED, __HIP_MEMORY_SCOPE_AGENT); zw1[u] = __hip_atomic_load(ZW + kt * 64 + 32 + q, __ATOMIC_RELAXED, __HIP_MEMORY_SCOPE_AGENT); } }
#pragma unroll
                for (int u = 0; u < 8; ++u) { const int kt = j + 16 * u; if (kt <= ts) { const unsigned w0 = zw0[u], w1 = zw1[u]; unsigned a0 = w0, a1 = w1;
                    if (kt == ts) { const unsigned lo32 = spread_nib(w0 & 0xffffu) | (spread_nib(w1 & 0xffffu) << 4), hi32 = spread_nib(w0 >> 16) | (spread_nib(w1 >> 16) << 4);
                        const unsigned long long ord = (unsigned long long)lo32 | ((unsigned long long)hi32 << 32);
                        int nn = rs, kap = 0; unsigned w = (unsigned)ord; int c = __builtin_popcount(w);
                        if (nn > c) { nn -= c; w = (unsigned)(ord >> 32); kap = 32; }
                        c = __builtin_popcount(w & 0xffffu); if (nn > c) { nn -= c; w >>= 16; kap += 16; }
                        c = __builtin_popcount(w & 0xffu); if (nn > c) { nn -= c; w >>= 8; kap += 8; }
                        c = __builtin_popcount(w & 0xfu); if (nn > c) { nn -= c; w >>= 4; kap += 4; }
                        c = __builtin_popcount(w & 0x3u); if (nn > c) { nn -= c; w >>= 2; kap += 2; }
                        c = (int)(w & 1u); if (nn > c) kap += 1;
                        unsigned k0 = 0u, k1 = 0u;
#pragma unroll
                        for (int e = 0; e < 32; ++e) { const int pos0 = 32 * (e >> 4) + crow(e & 15, 0), pos1 = 32 * (e >> 4) + crow(e & 15, 1); if (pos0 <= kap) k0 |= (1u << e); if (pos1 <= kap) k1 |= (1u << e); }
                        a0 &= k0; a1 &= k1; }
                    if (a0) __hip_atomic_fetch_or(mq + kt * 64, a0, __ATOMIC_RELAXED, __HIP_MEMORY_SCOPE_AGENT);
                    if (a1) __hip_atomic_fetch_or(mq + kt * 64 + 32, a1, __ATOMIC_RELAXED, __HIP_MEMORY_SCOPE_AGENT); } } }
        }
    }
    __syncthreads();
}
#undef IDX_KISSUE
#undef IDX_KTAKE
#undef IDX_KREAD
}
namespace glab {
typedef short bf16x8 __attribute__((ext_vector_type(8)));
typedef short s16x4 __attribute__((ext_vector_type(4)));
typedef float f32x16 __attribute__((ext_vector_type(16)));
typedef float f32x4 __attribute__((ext_vector_type(4)));
typedef unsigned u32x4 __attribute__((ext_vector_type(4)));
typedef unsigned u32x2 __attribute__((ext_vector_type(2)));
typedef float f32x2_t __attribute__((ext_vector_type(2))); typedef __bf16 bf16x2_t __attribute__((ext_vector_type(2)));
#define GLAS __attribute__((address_space(3)))
constexpr int RAW_Q = 0, RAW_K = 6144, RAW_V = 12288, RAW_Z = 24576, OP_QE = 26624, OP_KE = 33792, OP_KDT = 40960, OP_VT = 47872, OP_DEC = 61696, OP_BLK_BYTES = 35328  ,
              OP_BLK1 = 61952  , OP_ST = 97280, ST_BYTES = 10752;
__device__ __forceinline__ unsigned cvtpk(float lo, float hi) { f32x2_t v = {lo, hi}; bf16x2_t b = __builtin_convertvector(v, bf16x2_t); return __builtin_bit_cast(unsigned, b); }
__device__ __forceinline__ int crow(int r, int hi) { return (r & 3) + 8 * (r >> 2) + 4 * hi; }
__device__ __forceinline__ float bfl(unsigned short b) { return __uint_as_float((unsigned)b << 16); }


__device__ __forceinline__ void gla_prep_item(const unsigned short* P, unsigned char* GOP, const float* w2, const float* gb, unsigned char* ldsg, int item, int tid) {
    GLAS unsigned char* lds = (GLAS unsigned char*)ldsg;
    const int lane = tid & 63; const int b = item >> 9, h = (item >> 7) & 3, n = item & 127;
    const size_t m0 = (size_t)b * SEQ + (size_t)n * 64;
    __syncthreads();
#define GLA_PCOL(c) (((c) < 6) ? (N_GQ + h * 48 + (c) * 8) : ((c) < 12) ? (N_GK + h * 48 + ((c) - 6) * 8) : ((c) < 24) ? (N_GV + h * 96 + ((c) - 12) * 8) : (N_GZ + ((c) - 24) * 8))
#define GLA_PDST(row, c) (((c) < 6) ? (RAW_Q + (row) * 96 + (c) * 16) : ((c) < 12) ? (RAW_K + (row) * 96 + ((c) - 6) * 16) : ((c) < 24) ? (RAW_V + (row) * 192 + ((c) - 12) * 16) : (RAW_Z + (row) * 32 + ((c) - 24) * 16))
#pragma unroll
    for (int k = 0; k < 4; ++k) { const int p = tid + 512 * k; if (p < 1664) { const int row = p / 26, c = p % 26; *(GLAS u32x4*)(lds + GLA_PDST(row, c)) = *(const u32x4*)(P + (m0 + row) * NP + GLA_PCOL(c)); } }
    __syncthreads();
    const int sd = tid >> 3, tg = tid & 7;
    if (tid < 384) {
            float c[8], w2c[16]; const float bc = gb[h * 48 + sd];
#pragma unroll
            for (int r = 0; r < 16; ++r) w2c[r] = w2[(size_t)r * 192 + h * 48 + sd];
#pragma unroll
            for (int tt = 0; tt < 8; ++tt) { const int t = 8 * tg + tt; const u32x4 z0 = *(GLAS u32x4*)(lds + RAW_Z + t * 32), z1 = *(GLAS u32x4*)(lds + RAW_Z + t * 32 + 16); float z = bc;
#pragma unroll
                for (int k = 0; k < 4; ++k) { z += w2c[2 * k] * __uint_as_float(z0[k] << 16) + w2c[2 * k + 1] * __uint_as_float(z0[k] & 0xffff0000u); z += w2c[8 + 2 * k] * __uint_as_float(z1[k] << 16) + w2c[8 + 2 * k + 1] * __uint_as_float(z1[k] & 0xffff0000u); }
                const float ls = fminf(z, 0.f) - __logf(1.0f + __expf(-fabsf(z)));
                c[tt] = ls * (1.0f / 16.0f) + (tt ? c[tt - 1] : 0.f); }
            float incl = c[7];
#pragma unroll
            for (int o = 1; o < 8; o <<= 1) { const float v = __builtin_bit_cast(float, __builtin_amdgcn_ds_bpermute(((lane - o) & 63) << 2, __builtin_bit_cast(int, incl))); if (tg >= o) incl += v; }
            const float off = incl - c[7];
            const float bl = __builtin_bit_cast(float, __builtin_amdgcn_ds_bpermute((lane | 7) << 2, __builtin_bit_cast(int, incl)));
            unsigned kdp[4];
#pragma unroll
            for (int tt = 0; tt < 8; tt += 2) { float kdv[2];
#pragma unroll
                for (int u = 0; u < 2; ++u) { const int t = 8 * tg + tt + u; const float bb = off + c[tt + u];
                    const float q = bfl(*(GLAS unsigned short*)(lds + RAW_Q + (t * 48 + sd) * 2)), kx = bfl(*(GLAS unsigned short*)(lds + RAW_K + (t * 48 + sd) * 2));
                    const float e1 = __expf(bb), e2 = __expf(-bb), e3 = __expf(bl - bb);
                    *(GLAS unsigned short*)(lds + OP_QE + (t * 56 + sd) * 2) = (unsigned short)(cvtpk(q * e1, 0.f) & 0xffffu);
                    *(GLAS unsigned short*)(lds + OP_KE + (t * 56 + sd) * 2) = (unsigned short)(cvtpk(kx * e2, 0.f) & 0xffffu);
                    kdv[u] = kx * e3; }
                kdp[tt >> 1] = cvtpk(kdv[0], kdv[1]); }
            *(GLAS u32x4*)(lds + OP_KDT + (sd * 72 + 8 * tg) * 2) = (u32x4){kdp[0], kdp[1], kdp[2], kdp[3]};
            if (tg == 7) ((GLAS float*)(lds + OP_DEC))[sd] = __expf(bl);
    } else {
            for (int idx = tid - 384; idx < 96 * 8; idx += 128) { const int v = idx % 96, t8 = idx / 96; unsigned pk[4];
#pragma unroll
                for (int tt = 0; tt < 8; tt += 2) { const unsigned a0 = *(GLAS unsigned short*)(lds + RAW_V + ((8 * t8 + tt) * 96 + v) * 2), a1 = *(GLAS unsigned short*)(lds + RAW_V + ((8 * t8 + tt + 1) * 96 + v) * 2); pk[tt >> 1] = a0 | (a1 << 16); }
                *(GLAS u32x4*)(lds + OP_VT + (v * 72 + 8 * t8) * 2) = (u32x4){pk[0], pk[1], pk[2], pk[3]}; }
    }
    __syncthreads();
    unsigned char* dst = GOP + (size_t)item * OP_BLK_BYTES;
    for (int i = tid; i < (OP_DEC + 192 - OP_QE) / 16; i += NTHR) *(u32x4*)(dst + i * 16) = *(GLAS u32x4*)(lds + OP_QE + i * 16);
}
__device__ __forceinline__ void gla_prep_loop(const unsigned short* P, unsigned char* GOP, const float* w2, const float* gb, unsigned char* ldsg, int wg, int G, int tid) {
    GLAS unsigned char* lds = (GLAS unsigned char*)ldsg;
    const int lane = tid & 63;
#define GLA_PCOLH(c, hh) (((c) < 6) ? (N_GQ + (hh) * 48 + (c) * 8) : ((c) < 12) ? (N_GK + (hh) * 48 + ((c) - 6) * 8) : ((c) < 24) ? (N_GV + (hh) * 96 + ((c) - 12) * 8) : (N_GZ + ((c) - 24) * 8))
#define GLA_PDST(row, c) (((c) < 6) ? (RAW_Q + (row) * 96 + (c) * 16) : ((c) < 12) ? (RAW_K + (row) * 96 + ((c) - 6) * 16) : ((c) < 24) ? (RAW_V + (row) * 192 + ((c) - 12) * 16) : (RAW_Z + (row) * 32 + ((c) - 24) * 16))
#define GLA_FETCH(it_) do { const int b_ = (it_) >> 9, h_ = ((it_) >> 7) & 3, n_ = (it_) & 127; const size_t mr_ = (size_t)b_ * SEQ + (size_t)n_ * 64; \
        _Pragma("unroll") for (int k = 0; k < 4; ++k) { const int p = tid + 512 * k; if (p < 1664) { const int row = p / 26, c = p % 26; rawr[k] = *(const u32x4*)(P + (mr_ + row) * NP + GLA_PCOLH(c, h_)); } } } while (0)
    u32x4 rawr[4];
    if (wg < BATCH * 4 * 128) GLA_FETCH(wg);
    for (int item = wg; item < BATCH * 4 * 128; item += G) {
    const int h = (item >> 7) & 3;
    __syncthreads();
#pragma unroll
    for (int k = 0; k < 4; ++k) { const int p = tid + 512 * k; if (p < 1664) { const int row = p / 26, c = p % 26; *(GLAS u32x4*)(lds + GLA_PDST(row, c)) = rawr[k]; } }
    if (item + G < BATCH * 4 * 128) GLA_FETCH(item + G);
    __syncthreads();
    const int sd = tid >> 3, tg = tid & 7;
    if (tid < 384) {
            float c[8], w2c[16]; const float bc = gb[h * 48 + sd];
#pragma unroll
            for (int r = 0; r < 16; ++r) w2c[r] = w2[(size_t)r * 192 + h * 48 + sd];
#pragma unroll
            for (int tt = 0; tt < 8; ++tt) { const int t = 8 * tg + tt; const u32x4 z0 = *(GLAS u32x4*)(lds + RAW_Z + t * 32), z1 = *(GLAS u32x4*)(lds + RAW_Z + t * 32 + 16); float z = bc;
#pragma unroll
                for (int k = 0; k < 4; ++k) { z += w2c[2 * k] * __uint_as_float(z0[k] << 16) + w2c[2 * k + 1] * __uint_as_float(z0[k] & 0xffff0000u); z += w2c[8 + 2 * k] * __uint_as_float(z1[k] << 16) + w2c[8 + 2 * k + 1] * __uint_as_float(z1[k] & 0xffff0000u); }
                const float ls = fminf(z, 0.f) - __logf(1.0f + __expf(-fabsf(z)));
                c[tt] = ls * (1.0f / 16.0f) + (tt ? c[tt - 1] : 0.f); }
            float incl = c[7];
#pragma unroll
            for (int o = 1; o < 8; o <<= 1) { const float v = __builtin_bit_cast(float, __builtin_amdgcn_ds_bpermute(((lane - o) & 63) << 2, __builtin_bit_cast(int, incl))); if (tg >= o) incl += v; }
            const float off = incl - c[7];
            const float bl = __builtin_bit_cast(float, __builtin_amdgcn_ds_bpermute((lane | 7) << 2, __builtin_bit_cast(int, incl)));
            unsigned kdp[4];
#pragma unroll
            for (int tt = 0; tt < 8; tt += 2) { float kdv[2];
#pragma unroll
                for (int u = 0; u < 2; ++u) { const int t = 8 * tg + tt + u; const float bb = off + c[tt + u];
                    const float q = bfl(*(GLAS unsigned short*)(lds + RAW_Q + (t * 48 + sd) * 2)), kx = bfl(*(GLAS unsigned short*)(lds + RAW_K + (t * 48 + sd) * 2));
                    const float e1 = __expf(bb), e2 = __expf(-bb), e3 = __expf(bl - bb);
                    *(GLAS unsigned short*)(lds + OP_QE + (t * 56 + sd) * 2) = (unsigned short)(cvtpk(q * e1, 0.f) & 0xffffu);
                    *(GLAS unsigned short*)(lds + OP_KE + (t * 56 + sd) * 2) = (unsigned short)(cvtpk(kx * e2, 0.f) & 0xffffu);
                    kdv[u] = kx * e3; }
                kdp[tt >> 1] = cvtpk(kdv[0], kdv[1]); }
            *(GLAS u32x4*)(lds + OP_KDT + (sd * 72 + 8 * tg) * 2) = (u32x4){kdp[0], kdp[1], kdp[2], kdp[3]};
            if (tg == 7) ((GLAS float*)(lds + OP_DEC))[sd] = __expf(bl);
    } else {
            for (int idx = tid - 384; idx < 96 * 8; idx += 128) { const int v = idx % 96, t8 = idx / 96; unsigned pk[4];
#pragma unroll
                for (int tt = 0; tt < 8; tt += 2) { const unsigned a0 = *(GLAS unsigned short*)(lds + RAW_V + ((8 * t8 + tt) * 96 + v) * 2), a1 = *(GLAS unsigned short*)(lds + RAW_V + ((8 * t8 + tt + 1) * 96 + v) * 2); pk[tt >> 1] = a0 | (a1 << 16); }
                *(GLAS u32x4*)(lds + OP_VT + (v * 72 + 8 * t8) * 2) = (u32x4){pk[0], pk[1], pk[2], pk[3]}; }
    }
    __syncthreads();
    unsigned char* dst = GOP + (size_t)item * OP_BLK_BYTES;
    for (int i = tid; i < (OP_DEC + 192 - OP_QE) / 16; i += NTHR) *(u32x4*)(dst + i * 16) = *(GLAS u32x4*)(lds + OP_QE + i * 16);
    }
#undef GLA_FETCH
#undef GLA_PCOLH
}
__device__ __forceinline__ void gla_seq_unit(const unsigned short* P, unsigned short* Y, const unsigned char* GOP, const float* ng, unsigned char* ldsg, int b, int h, int tid) {
    GLAS unsigned char* lds = (GLAS unsigned char*)ldsg;
    const int lane = tid & 63, wave = __builtin_amdgcn_readfirstlane(tid >> 6), r32 = lane & 31, hi = lane >> 5, l15 = lane & 15, quad = lane >> 4;
    const size_t rowbase = (size_t)b * SEQ; const unsigned char* gsrc = GOP + (size_t)((b * 4 + h) * 128) * OP_BLK_BYTES;
    constexpr int NPC = (OP_DEC + 192 - OP_QE) / 16;
    constexpr int SQ_BLK0 = 0, SQ_BLK1 = OP_BLK_BYTES, SQ_ST = 2 * OP_BLK_BYTES  , SQ_OB = SQ_ST + 2 * ST_BYTES  , SQ_OB_BYTES = 64 * 96 * 2, SQ_NG = SQ_OB + 2 * SQ_OB_BYTES  ;
    __syncthreads();
    for (int i = tid; i < 2 * ST_BYTES / 4; i += NTHR) ((GLAS unsigned*)(lds + SQ_ST))[i] = 0u;
    if (tid < 96) ((GLAS float*)(lds + SQ_NG))[tid] = ng[tid];
    u32x4 rg[5];
#pragma unroll
    for (int k = 0; k < 5; ++k) { const int i = tid + 512 * k; if (i < NPC) rg[k] = *(const u32x4*)(gsrc + (size_t)i * 16); }
#pragma unroll
    for (int k = 0; k < 5; ++k) { const int i = tid + 512 * k; if (i < NPC) *(GLAS u32x4*)(lds + SQ_BLK0 + i * 16) = rg[k]; }
#pragma unroll
    for (int k = 0; k < 5; ++k) { const int i = tid + 512 * k; if (i < NPC) rg[k] = *(const u32x4*)(gsrc + OP_BLK_BYTES + (size_t)i * 16); }
    __syncthreads();
    f32x4 S[2][3];
#pragma unroll
    for (int mt = 0; mt < 2; ++mt)
#pragma unroll
        for (int nt = 0; nt < 3; ++nt) S[mt][nt] = (f32x4){0.f, 0.f, 0.f, 0.f};
#define GLA_EPILOGUE(nn) do { const int cc_ = (nn) & 1; const size_t mm_ = rowbase + (size_t)(nn) * 64; \
        _Pragma("unroll") for (int k_ = 0; k_ < 4; ++k_) { const int vec_ = (tid - 320) + 192 * k_, t_ = vec_ / 12, v_ = (vec_ % 12) * 8; \
            const u32x4 ov_ = *(GLAS u32x4*)(lds + SQ_OB + cc_ * SQ_OB_BYTES + t_ * 192 + v_ * 2); const u32x4 gv_ = *(const u32x4*)(P + (mm_ + t_) * NP + N_GG + h * 96 + v_); \
            const f32x4 n0_ = *(GLAS f32x4*)(lds + SQ_NG + v_ * 4), n1_ = *(GLAS f32x4*)(lds + SQ_NG + v_ * 4 + 16); u32x4 yo_; \
            _Pragma("unroll") for (int e_ = 0; e_ < 4; ++e_) { const float ga_ = __uint_as_float(gv_[e_] << 16), gb_ = __uint_as_float(gv_[e_] & 0xffff0000u); \
                const float na_ = (e_ < 2) ? n0_[2 * e_] : n1_[2 * e_ - 4], nb_ = (e_ < 2) ? n0_[2 * e_ + 1] : n1_[2 * e_ - 3]; \
                yo_[e_] = cvtpk(__uint_as_float(ov_[e_] << 16) * na_ * (ga_ / (1.0f + __expf(-ga_))), __uint_as_float(ov_[e_] & 0xffff0000u) * nb_ * (gb_ / (1.0f + __expf(-gb_)))); } \
            *(u32x4*)(Y + (mm_ + t_) * DM + h * 96 + v_) = yo_; } } while (0)
    for (int n = 0; n < SEQ / 64; ++n) {
        const int cur = n & 1, nxt = cur ^ 1; const size_t m0 = rowbase + (size_t)n * 64;
        const int BO = (cur ? SQ_BLK1 : SQ_BLK0) - OP_QE;
        if (n + 1 < SEQ / 64) { const int BN = (cur ? SQ_BLK0 : SQ_BLK1) - OP_QE;
#pragma unroll
            for (int k = 0; k < 5; ++k) { const int i = tid + 512 * k; if (i < NPC) *(GLAS u32x4*)(lds + OP_QE + BN + i * 16) = rg[k]; }
            if (n + 2 < SEQ / 64) {
#pragma unroll
                for (int k = 0; k < 5; ++k) { const int i = tid + 512 * k; if (i < NPC) rg[k] = *(const u32x4*)(gsrc + (size_t)(n + 2) * OP_BLK_BYTES + (size_t)i * 16); } } }
        if (wave < 2) {
            const int it = wave; bf16x8 qf[3];
#pragma unroll
            for (int ks = 0; ks < 3; ++ks) qf[ks] = *(GLAS bf16x8*)(lds + BO + OP_QE + (32 * it + r32) * 112 + (16 * ks + 8 * hi) * 2);
            f32x16 acc[3];
#pragma unroll
            for (int vt = 0; vt < 3; ++vt)
#pragma unroll
                for (int r = 0; r < 16; ++r) acc[vt][r] = 0.f;
#pragma unroll
            for (int jt = 0; jt < 2; ++jt) if (jt <= it) {
                f32x16 X;
#pragma unroll
                for (int r = 0; r < 16; ++r) X[r] = 0.f;
#pragma unroll
                for (int ks = 0; ks < 3; ++ks) { const bf16x8 kf = *(GLAS bf16x8*)(lds + BO + OP_KE + (32 * jt + r32) * 112 + (16 * ks + 8 * hi) * 2); X = __builtin_amdgcn_mfma_f32_32x32x16_bf16(kf, qf[ks], X, 0, 0, 0); }
                if (jt == it) {
#pragma unroll
                    for (int r = 0; r < 16; ++r) if (crow(r, hi) > r32) X[r] = 0.f; }
                u32x4 p0, p1;
#pragma unroll
                for (int k = 0; k < 4; ++k) { p0[k] = cvtpk(X[2 * k], X[2 * k + 1]); p1[k] = cvtpk(X[8 + 2 * k], X[8 + 2 * k + 1]); }
                const bf16x8 pa0 = __builtin_bit_cast(bf16x8, p0), pa1 = __builtin_bit_cast(bf16x8, p1);
#pragma unroll
                for (int vt = 0; vt < 3; ++vt)
#pragma unroll
                    for (int s = 0; s < 2; ++s) { const int vo = BO + OP_VT + (32 * vt + r32) * 144 + (32 * jt + 16 * s + 4 * hi) * 2;
                        const s16x4 lo = *(GLAS s16x4*)(lds + vo), hi4 = *(GLAS s16x4*)(lds + vo + 16);
                        const bf16x8 a2 = (bf16x8){lo[0], lo[1], lo[2], lo[3], hi4[0], hi4[1], hi4[2], hi4[3]};
                        acc[vt] = __builtin_amdgcn_mfma_f32_32x32x16_bf16(a2, s ? pa1 : pa0, acc[vt], 0, 0, 0); }
            }
#pragma unroll
            for (int vt = 0; vt < 3; ++vt)
#pragma unroll
                for (int ks = 0; ks < 3; ++ks) { const bf16x8 sf = *(GLAS bf16x8*)(lds + SQ_ST + cur * ST_BYTES + (32 * vt + r32) * 112 + (16 * ks + 8 * hi) * 2); acc[vt] = __builtin_amdgcn_mfma_f32_32x32x16_bf16(sf, qf[ks], acc[vt], 0, 0, 0); }
            float ss = 0.f;
#pragma unroll
            for (int vt = 0; vt < 3; ++vt)
#pragma unroll
                for (int r = 0; r < 16; ++r) ss += acc[vt][r] * acc[vt][r];
            ss += __builtin_bit_cast(float, __builtin_amdgcn_ds_bpermute((lane ^ 32) << 2, __builtin_bit_cast(int, ss)));
            const float rn = 1.0f / sqrtf(ss * (1.0f / 96.0f) + EPS);
            GLAS unsigned char* ob = lds + SQ_OB + cur * SQ_OB_BYTES + (32 * it + r32) * 192;
#pragma unroll
            for (int vt = 0; vt < 3; ++vt)
#pragma unroll
                for (int g = 0; g < 4; ++g) { const int v0 = 32 * vt + 8 * g + 4 * hi;
                    *(GLAS u32x2*)(ob + v0 * 2) = (u32x2){cvtpk(acc[vt][4 * g] * rn, acc[vt][4 * g + 1] * rn), cvtpk(acc[vt][4 * g + 2] * rn, acc[vt][4 * g + 3] * rn)}; }
        } else if (wave < 5) {
            const int sw = wave - 2;
#pragma unroll
            for (int mt = 0; mt < 2; ++mt)
#pragma unroll
                for (int nt = 0; nt < 3; ++nt) { const int d = 16 * nt + l15; const float dec = ((GLAS float*)(lds + BO + OP_DEC))[d]; f32x4 a = S[mt][nt] * dec;
#pragma unroll
                    for (int ks = 0; ks < 2; ++ks) { const bf16x8 va = *(GLAS bf16x8*)(lds + BO + OP_VT + (32 * sw + 16 * mt + l15) * 144 + (32 * ks + 8 * quad) * 2), kb = *(GLAS bf16x8*)(lds + BO + OP_KDT + d * 144 + (32 * ks + 8 * quad) * 2);
                        a = __builtin_amdgcn_mfma_f32_16x16x32_bf16(va, kb, a, 0, 0, 0); }
                    S[mt][nt] = a;
#pragma unroll
                    for (int jj = 0; jj < 4; jj += 2) { const unsigned pk = cvtpk(a[jj], a[jj + 1]);
                        *(GLAS unsigned short*)(lds + SQ_ST + nxt * ST_BYTES + ((32 * sw + 16 * mt + 4 * quad + jj) * 56 + d) * 2) = (unsigned short)(pk & 0xffffu);
                        *(GLAS unsigned short*)(lds + SQ_ST + nxt * ST_BYTES + ((32 * sw + 16 * mt + 4 * quad + jj + 1) * 56 + d) * 2) = (unsigned short)(pk >> 16); } }
        } else if (n > 0) {
            GLA_EPILOGUE(n - 1);
        }
        __syncthreads();
    }
    if (wave >= 5) { GLA_EPILOGUE(SEQ / 64 - 1); }
    __syncthreads();
}
#undef GLA_EPILOGUE
#undef GLA_PCOL
#undef GLA_PDST
#undef GLAS
}
namespace poolb {
typedef short bf16x8 __attribute__((ext_vector_type(8)));
typedef float f32x16 __attribute__((ext_vector_type(16)));
typedef unsigned u32x4 __attribute__((ext_vector_type(4)));
typedef unsigned u32x2 __attribute__((ext_vector_type(2)));
typedef float f32x2_t __attribute__((ext_vector_type(2))); typedef __bf16 bf16x2_t __attribute__((ext_vector_type(2)));
#define PLAS __attribute__((address_space(3)))
constexpr int US_PITCH = 528  , US = 0, US_BYTES = 79 * US_PITCH  , PS = 41728, PS_PITCH = 144  , PS_WAVE = 32 * PS_PITCH  ,
              WT = PS + 8 * PS_WAVE  , WT_PITCH = 144, WT_GROUP = 64 * WT_PITCH  ;
__device__ __forceinline__ unsigned cvtpk(float lo, float hi) { f32x2_t v = {lo, hi}; bf16x2_t b = __builtin_convertvector(v, bf16x2_t); return __builtin_bit_cast(unsigned, b); }
__device__ __forceinline__ void pool_phase(const unsigned short* P, unsigned short* Y, const float* pw, const float* pscale, unsigned char* ldsg, int wg, int G, int tid) {
    PLAS unsigned char* lds = (PLAS unsigned char*)ldsg;
    const int lane = tid & 63, wave = __builtin_amdgcn_readfirstlane(tid >> 6), r32 = lane & 31, hi = lane >> 5, g = wave & 3, th = wave >> 2;
    __syncthreads();
    for (int i = tid; i < 4 * 64 * 64; i += NTHR) { const int gg = i >> 12, c = (i >> 6) & 63, d = i & 63; const float v = pw[i] * pscale[gg * 64 + d];
        *(PLAS unsigned short*)(lds + WT + gg * WT_GROUP + d * WT_PITCH + c * 2) = (unsigned short)(cvtpk(v, 0.f) & 0xffffu); }
    const int w = 2 << g;
    for (int tile = wg; tile < M / 64; tile += G) {
        const int m0 = tile * 64, t0 = m0 % SEQ;
        __syncthreads();
        for (int i = tid; i < 79 * 32; i += NTHR) { const int row = i >> 5, pc = i & 31; u32x4 v = {0u, 0u, 0u, 0u};
            if (t0 + row - 15 >= 0) v = *(const u32x4*)(P + (size_t)(m0 - 15 + row) * NP + N_PU + pc * 8);
            *(PLAS u32x4*)(lds + US + row * US_PITCH + pc * 16) = v; }
        __syncthreads();
        { float sum[32];
#pragma unroll
            for (int c = 0; c < 32; ++c) sum[c] = 0.f;
            const int tl = 32 * th + r32; const PLAS unsigned char* base = lds + US + (tl + 15) * US_PITCH + (g * 64 + 32 * hi) * 2;
            for (int j = 0; j < w; ++j) {
#pragma unroll
                for (int q4 = 0; q4 < 4; ++q4) { const u32x4 v = *(const PLAS u32x4*)(base - j * US_PITCH + q4 * 16);
#pragma unroll
                    for (int k = 0; k < 4; ++k) { const float lo = __uint_as_float(v[k] << 16), hh = __uint_as_float(v[k] & 0xffff0000u); sum[8 * q4 + 2 * k] += lo; sum[8 * q4 + 2 * k + 1] += hh; } } }
            const int pos = t0 + tl; const float inv = 1.0f / (float)((pos + 1 < w) ? pos + 1 : w);
            PLAS unsigned char* pd = lds + PS + wave * PS_WAVE + r32 * PS_PITCH + 32 * hi * 2;
#pragma unroll
            for (int q4 = 0; q4 < 4; ++q4) { u32x4 o; const u32x4 sv = *(const PLAS u32x4*)(base + q4 * 16);
#pragma unroll
                for (int k = 0; k < 4; ++k) o[k] = cvtpk(sum[8 * q4 + 2 * k] * inv - __uint_as_float(sv[k] << 16), sum[8 * q4 + 2 * k + 1] * inv - __uint_as_float(sv[k] & 0xffff0000u));
                *(PLAS u32x4*)(pd + q4 * 16) = o; } }
        asm volatile("s_waitcnt lgkmcnt(0)" ::: "memory");
        f32x16 acc[2];
#pragma unroll
        for (int dt = 0; dt < 2; ++dt) {
#pragma unroll
            for (int r = 0; r < 16; ++r) acc[dt][r] = 0.f;
#pragma unroll
            for (int ks = 0; ks < 4; ++ks) { const bf16x8 a = *(const PLAS bf16x8*)(lds + WT + g * WT_GROUP + (32 * dt + r32) * WT_PITCH + (16 * ks + 8 * hi) * 2), bq = *(const PLAS bf16x8*)(lds + PS + wave * PS_WAVE + r32 * PS_PITCH + (16 * ks + 8 * hi) * 2);
                acc[dt] = __builtin_amdgcn_mfma_f32_32x32x16_bf16(a, bq, acc[dt], 0, 0, 0); } }
        { const size_t m = (size_t)m0 + 32 * th + r32; const unsigned short* gp = P + m * NP + N_PG + g * 64; unsigned short* yp = Y + m * DM + 768 + g * 64;
#pragma unroll
            for (int dt = 0; dt < 2; ++dt)
#pragma unroll
                for (int g4 = 0; g4 < 4; ++g4) { const int d0 = 32 * dt + 8 * g4 + 4 * hi; const u32x2 gw = *(const u32x2*)(gp + d0);
                    const float g0 = __uint_as_float(gw[0] << 16), g1 = __uint_as_float(gw[0] & 0xffff0000u), g2 = __uint_as_float(gw[1] << 16), g3 = __uint_as_float(gw[1] & 0xffff0000u);
                    const float y0 = acc[dt][4 * g4] * (g0 / (1.0f + __expf(-g0))), y1 = acc[dt][4 * g4 + 1] * (g1 / (1.0f + __expf(-g1))), y2 = acc[dt][4 * g4 + 2] * (g2 / (1.0f + __expf(-g2))), y3 = acc[dt][4 * g4 + 3] * (g3 / (1.0f + __expf(-g3)));
                    *(u32x2*)(yp + d0) = (u32x2){cvtpk(y0, y1), cvtpk(y2, y3)}; } }
    }
    __syncthreads();
}
#undef PLAS
}
struct Args {
    const float* x; const float* norm_g; const float* w_in; const float* gate_w2; const float* gate_b; const float* gla_norm_g;
    const float* rel_bias; const float* pool_w; const float* pool_scale; const float* w_out; const float* final_g;
    float* out; unsigned char* ws;
    int l_lo, l_hi, ph_lo, ph_hi, single, pad;
};

__device__ __forceinline__ int src_col(int n, float& sc) {
    sc = 1.f;
    if (n < 192) { sc = 0.14433756729740643f; return n; }
    if (n < 768) return n;
    if (n < 1152) return 784 + (n - 768);
    if (n < 1536) { sc = 0.125f * LOG2E; return 1168 + (n - 1152); }
    if (n < 1920) return 1552 + (n - 1536);
    if (n < 2304) return 1936 + (n - 1920);
    if (n < 2688) return 2320 + (n - 2304);
    if (n < 2944) return 2868 + (n - 2688);
    if (n < 3200) return 3124 + (n - 2944);
    if (n < 3328) { sc = 0.17677669529663687f; return 2704 + (n - 3200); }
    if (n < 3360) return 2832 + (n - 3328);
    if (n < 3376) return 768 + (n - 3360);
    if (n < 3380) { sc = 0.5f; return 2864 + (n - 3376); }
    return -1;
}
__device__ __forceinline__ void prologue_phase(const Args& a, int wg, int G, int tid) {
    bf16* WIN = (bf16*)(a.ws + WS_WIN); bf16* WOUT = (bf16*)(a.ws + WS_WOUT);
    const long gt = (long)wg * NTHR + tid, gs = (long)G * NTHR;
    for (long i = gt; i < 4L * NP * 128; i += gs) {
        const int n = (int)(i % NP), k8 = (int)((i / NP) % 128), l = (int)(i / ((long)NP * 128));
        float sc; const int c = src_col(n, sc);
        v4u o = {0u, 0u, 0u, 0u};
        if (c >= 0) { const float* w = a.w_in + ((size_t)l * 1024 + k8 * 8) * IN_COLS + c; float v[8];
#pragma unroll
            for (int j = 0; j < 8; ++j) v[j] = w[(size_t)j * IN_COLS] * sc * a.norm_g[l * 1024 + k8 * 8 + j];
            o.x = pk2(v[0], v[1]); o.y = pk2(v[2], v[3]); o.z = pk2(v[4], v[5]); o.w = pk2(v[6], v[7]); }
        *(v4u*)(WIN + ((size_t)l * NP + n) * 1024 + k8 * 8) = o;
    }
    for (long i = gt; i < 4L * 1024 * 128; i += gs) {
        const int n = (int)(i % 1024), k8 = (int)((i / 1024) % 128), l = (int)(i / (1024L * 128));
        const float* w = a.w_out + ((size_t)l * 1024 + k8 * 8) * 1024 + n; float v[8];
#pragma unroll
        for (int j = 0; j < 8; ++j) v[j] = w[(size_t)j * 1024];
        v4u o; o.x = pk2(v[0], v[1]); o.y = pk2(v[2], v[3]); o.z = pk2(v[4], v[5]); o.w = pk2(v[6], v[7]);
        *(v4u*)(WOUT + ((size_t)l * 1024 + n) * 1024 + k8 * 8) = o;
    }
    { bf16* XA = (bf16*)(a.ws + WS_XA); float* RS = (float*)(a.ws + WS_RS); const int lane = tid & 63;
        for (int m = wg * NWAVES + (tid >> 6); m < M; m += G * NWAVES) { const f32x4* xr = (const f32x4*)(a.x + (size_t)m * DM) + lane; v2u* o = (v2u*)(XA + (size_t)m * DM) + lane; float s = 0.f;
#pragma unroll
            for (int j = 0; j < 4; ++j) { const f32x4 v = xr[64 * j]; v2u w; w.x = pk2(v.x, v.y); w.y = pk2(v.z, v.w); o[64 * j] = w; s += (bflo(w.x) * bflo(w.x) + bfhi(w.x) * bfhi(w.x)) + (bflo(w.y) * bflo(w.y) + bfhi(w.y) * bfhi(w.y)); }
            s = wave_sum(s, lane); if (lane < 16) RS[(size_t)m * 16 + lane] = (lane == 0) ? s : 0.f; } }
}
__device__ __forceinline__ void norm_phase(const float* src, const float* g, bf16* dst, int gw, int NGW, int lane) {
    for (int m = gw; m < M; m += NGW) {
        const f32x4* xr = (const f32x4*)(src + (size_t)m * DM) + lane; f32x4 v[4]; float s = 0.f;
#pragma unroll
        for (int j = 0; j < 4; ++j) { v[j] = xr[64 * j]; s += (v[j].x * v[j].x + v[j].y * v[j].y) + (v[j].z * v[j].z + v[j].w * v[j].w); }
        const float r = 1.0f / sqrtf(wave_sum(s, lane) * (1.f / DM) + EPS);
        const f32x4* gr = (const f32x4*)g + lane; v2u* o = (v2u*)(dst + (size_t)m * DM) + lane;
#pragma unroll
        for (int j = 0; j < 4; ++j) { const f32x4 gv = gr[64 * j]; v2u w; w.x = pk2(v[j].x * r * gv.x, v[j].y * r * gv.y); w.y = pk2(v[j].z * r * gv.z, v[j].w * r * gv.w); o[64 * j] = w; }
    }
}
__device__ __forceinline__ void final_norm_phase(const bf16* xa, float* out, const float* g, const float* RS, int gw, int NGW, int lane) {
    for (int m = gw; m < M; m += NGW) {
        const v2u* xr = (const v2u*)(xa + (size_t)m * DM) + lane; f32x4* orow = (f32x4*)(out + (size_t)m * DM) + lane;
        const f32x4* rs = (const f32x4*)(RS + (size_t)m * 16); const f32x4 s0 = rs[0], s1 = rs[1], s2 = rs[2], s3 = rs[3];
        const float ss = (((s0[0] + s0[1]) + (s0[2] + s0[3])) + ((s1[0] + s1[1]) + (s1[2] + s1[3]))) + (((s2[0] + s2[1]) + (s2[2] + s2[3])) + ((s3[0] + s3[1]) + (s3[2] + s3[3])));
        const float r = 1.0f / sqrtf(ss * (1.f / DM) + EPS);
        const f32x4* gr = (const f32x4*)g + lane;
#pragma unroll
        for (int j = 0; j < 4; ++j) { const f32x4 gv = gr[64 * j]; const v2u w = xr[64 * j]; orow[64 * j] = (f32x4){bflo(w.x) * r * gv.x, bfhi(w.x) * r * gv.y, bflo(w.y) * r * gv.z, bfhi(w.y) * r * gv.w}; }
    }
}
__device__ __forceinline__ void rowscale_phase(const float* RS, float* RSC, int wg, int G, int tid) {
    for (int m = wg * NTHR + tid; m < M; m += G * NTHR) { const f32x4* rs = (const f32x4*)(RS + (size_t)m * 16); const f32x4 s0 = rs[0], s1 = rs[1], s2 = rs[2], s3 = rs[3];
        const float ss = (((s0[0] + s0[1]) + (s0[2] + s0[3])) + ((s1[0] + s1[1]) + (s1[2] + s1[3]))) + (((s2[0] + s2[1]) + (s2[2] + s2[3])) + ((s3[0] + s3[1]) + (s3[2] + s3[3])));
        RSC[m] = 1.0f / sqrtf(ss * (1.0f / 1024.0f) + EPS); }
}
__device__ __forceinline__ void pool_phase(const Args& a, int l, unsigned char* lds, int wg, int G, int tid) {
    float* wsm = (float*)lds; float* us = (float*)(lds + 16384); float* ps = (float*)(lds + 32768);
    const bf16* P = (const bf16*)(a.ws + WS_P); bf16* Y = (bf16*)(a.ws + WS_XB);
    for (int g = 0; g < 4; ++g) {
        __syncthreads();
        const float* pw = a.pool_w + (size_t)(l * 4 + g) * 4096;
        for (int i = tid; i < 4096; i += NTHR) wsm[i] = pw[i];
        const int w = 2 << g;
        for (int tile = wg; tile < M / 32; tile += G) {
            __syncthreads();
            const int m0 = tile * 32, t0 = m0 % SEQ;
            for (int i = tid; i < 47 * 64; i += NTHR) { const int r = i >> 6, c = i & 63; float v = 0.f;
                if (t0 + r - 15 >= 0) v = bf2f(P[(size_t)(m0 - 15 + r) * NP + N_PU + g * 64 + c]);
                us[i] = v; }
            __syncthreads();
            { const int t = tid >> 4, c4 = (tid & 15) * 4, pos = t0 + t; const int cnt = (pos + 1 < w) ? pos + 1 : w; const float inv = 1.0f / (float)cnt;
#pragma unroll
                for (int k = 0; k < 4; ++k) { const int c = c4 + k; float s = 0.f; for (int j = 0; j < w; ++j) s += us[(t + 15 - j) * 64 + c]; ps[t * 64 + c] = s * inv - us[(t + 15) * 64 + c]; } }
            __syncthreads();
            { const int t = tid >> 4, d4 = (tid & 15) * 4; float a0 = 0.f, a1 = 0.f, a2 = 0.f, a3 = 0.f;
                for (int c = 0; c < 64; ++c) { const float p = ps[t * 64 + c]; const f32x4 wv = *(const f32x4*)&wsm[c * 64 + d4]; a0 += p * wv.x; a1 += p * wv.y; a2 += p * wv.z; a3 += p * wv.w; }
                const size_t m = (size_t)m0 + t; const v2u gw2 = *(const v2u*)(P + m * NP + N_PG + g * 64 + d4);
                const float* scl = a.pool_scale + l * 256 + g * 64 + d4;
                const float y0 = a0 * scl[0] * silu_f(bflo(gw2.x)), y1 = a1 * scl[1] * silu_f(bfhi(gw2.x)), y2 = a2 * scl[2] * silu_f(bflo(gw2.y)), y3 = a3 * scl[3] * silu_f(bfhi(gw2.y));
                v2u o; o.x = pk2(y0, y1); o.y = pk2(y2, y3); *(v2u*)(Y + m * DM + 768 + g * 64 + d4) = o; }
        }
    }
    __syncthreads();
}
__device__ __forceinline__ void gla_rec_phase(const Args& a, int l, unsigned char* lds, int unit, int tid) {
    const int b = unit >> 2, h = unit & 3;
    float* qs = (float*)lds; float* ks = (float*)(lds + 12288); float* es = (float*)(lds + 24576); float* vs = (float*)(lds + 36864); float* os = (float*)(lds + 61440);
    float* w2s = (float*)(lds + 86016); float* bs = (float*)(lds + 89088); float* gzs = (float*)(lds + 89280);
    const bf16* P = (const bf16*)(a.ws + WS_P); bf16* Y = (bf16*)(a.ws + WS_XB);
    __syncthreads();
    for (int i = tid; i < 16 * 48; i += NTHR) { const int r = i / 48, d = i % 48; w2s[i] = a.gate_w2[(size_t)(l * 16 + r) * 192 + h * 48 + d]; }
    if (tid < 48) bs[tid] = a.gate_b[l * 192 + h * 48 + tid];
    float S[48];
#pragma unroll
    for (int d = 0; d < 48; ++d) S[d] = 0.f;
    for (int blk = 0; blk < SEQ / 64; ++blk) {
        const size_t m0 = (size_t)b * SEQ + (size_t)blk * 64;
        __syncthreads();
        for (int i = tid; i < 64 * 48; i += NTHR) { const int t = i / 48, d = i % 48; const bf16* row = P + (m0 + t) * NP; qs[i] = bf2f(row[N_GQ + h * 48 + d]); ks[i] = bf2f(row[N_GK + h * 48 + d]); }
        for (int i = tid; i < 64 * 96; i += NTHR) { const int t = i / 96, v = i % 96; vs[i] = bf2f(P[(m0 + t) * NP + N_GV + h * 96 + v]); }
        for (int i = tid; i < 64 * 16; i += NTHR) { const int t = i >> 4, r = i & 15; gzs[i] = bf2f(P[(m0 + t) * NP + N_GZ + r]); }
        __syncthreads();
        for (int i = tid; i < 64 * 48; i += NTHR) { const int t = i / 48, d = i % 48; float z = bs[d];
#pragma unroll
            for (int r = 0; r < 16; ++r) z += gzs[t * 16 + r] * w2s[r * 48 + d];
            const float ls = fminf(z, 0.f) - log1pf(__expf(-fabsf(z)));
            es[i] = __expf(ls * (1.0f / 16.0f)); }
        __syncthreads();
        if (tid < 96) { const int v = tid;
            for (int t = 0; t < 64; ++t) { const float vv = vs[t * 96 + v]; float o = 0.f;
#pragma unroll
                for (int d = 0; d < 48; ++d) { S[d] = es[t * 48 + d] * S[d] + ks[t * 48 + d] * vv; o += qs[t * 48 + d] * S[d]; }
                os[t * 96 + v] = o; } }
        __syncthreads();
        { const int t = tid >> 3, part = tid & 7; float ov[12]; float ss = 0.f;
#pragma unroll
            for (int k = 0; k < 12; ++k) { ov[k] = os[t * 96 + part * 12 + k]; ss += ov[k] * ov[k]; }
            { const int ln = tid & 63; ss += shx(ss, 1, ln); ss += shx(ss, 2, ln); ss += shx(ss, 4, ln); }
            const float r = 1.0f / sqrtf(ss * (1.0f / 96.0f) + EPS);
            const size_t m = m0 + t; const bf16* gp = P + m * NP + N_GG + h * 96 + part * 12; const float* ng = a.gla_norm_g + l * 96 + part * 12;
            unsigned* yo = (unsigned*)(Y + m * DM + h * 96 + part * 12);
#pragma unroll
            for (int k = 0; k < 12; k += 2) { const float y0 = ov[k] * r * ng[k] * silu_f(bf2f(gp[k])), y1 = ov[k + 1] * r * ng[k + 1] * silu_f(bf2f(gp[k + 1])); yo[k >> 1] = pk2(y0, y1); } }
    }
    __syncthreads();
}
template <bool BITS_ONLY> __device__ __forceinline__ void dsa_slow_query(const Args& a, unsigned char* lds, int b, int t, int tid) {
    const int lane = tid & 63, wave = tid >> 6;
    unsigned* sc = (unsigned*)lds; int* hist = (int*)(lds + 32768); int* sel = (int*)(lds + 33792); float* qf = (float*)(lds + 34816); float* wq = (float*)(lds + 35328);
    int* misc = (int*)(lds + 35344); float* qh = (float*)(lds + 35456); float* lg = (float*)(lds + 36992); float* inv = (float*)(lds + 43136);
    const bf16* P = (const bf16*)(a.ws + WS_P); bf16* Y = (bf16*)(a.ws + WS_XB);
    {
        const size_t m = (size_t)b * SEQ + t; const int N = t + 1;
        __syncthreads();
        if (tid < 128) qf[tid] = bf2f(P[m * NP + N_QI + tid]);
        if (tid >= 128 && tid < 132) wq[tid - 128] = bf2f(P[m * NP + N_WI + tid - 128]);
        for (int i = tid; i < 384; i += NTHR) qh[i] = bf2f(P[m * NP + N_DQ + i]);
        __syncthreads();
        for (int s = tid; s < N; s += NTHR) {
            const v4u* kr = (const v4u*)(P + ((size_t)b * SEQ + s) * NP + N_KI); float kf[32];
#pragma unroll
            for (int c = 0; c < 4; ++c) { const v4u w = kr[c]; kf[8 * c] = bflo(w.x); kf[8 * c + 1] = bfhi(w.x); kf[8 * c + 2] = bflo(w.y); kf[8 * c + 3] = bfhi(w.y); kf[8 * c + 4] = bflo(w.z); kf[8 * c + 5] = bfhi(w.z); kf[8 * c + 6] = bflo(w.w); kf[8 * c + 7] = bfhi(w.w); }
            float score = 0.f;
#pragma unroll
            for (int hh = 0; hh < 4; ++hh) { float dot = 0.f;
#pragma unroll
                for (int d = 0; d < 32; ++d) dot += qf[hh * 32 + d] * kf[d];
                score += wq[hh] * fmaxf(dot, 0.f); }
            const unsigned u = __builtin_bit_cast(unsigned, score);
            sc[s] = (u & 0x80000000u) ? ~u : (u | 0x80000000u);
        }
        __syncthreads();
        int L;
        if (N <= 256) { if (tid < N) sel[tid] = tid; L = N; }
        else {
            unsigned prefix = 0u; int kk = 256;
            for (int pass = 0; pass < 4; ++pass) {
                const int shift = 24 - 8 * pass;
                if (tid < 256) hist[tid] = 0;
                __syncthreads();
                for (int s = tid; s < N; s += NTHR) { const unsigned key = sc[s]; const bool match = (pass == 0) ? true : ((key >> ((shift + 8) & 31)) == prefix); if (match) atomicAdd(&hist[(key >> shift) & 255u], 1); }
                __syncthreads();
                if (wave == 0) {
                    const int c0 = hist[4 * lane], c1 = hist[4 * lane + 1], c2 = hist[4 * lane + 2], c3 = hist[4 * lane + 3]; const int tot = c0 + c1 + c2 + c3;
                    int incl = tot;
#pragma unroll
                    for (int o = 1; o < 64; o <<= 1) { const int tt = shdn(incl, o, lane); if (lane + o < 64) incl += tt; }
                    const int excl = incl - tot;
                    if (excl < kk && kk <= incl) { int above = excl, D;
                        if (above + c3 >= kk) D = 4 * lane + 3;
                        else { above += c3; if (above + c2 >= kk) D = 4 * lane + 2; else { above += c2; if (above + c1 >= kk) D = 4 * lane + 1; else { above += c1; D = 4 * lane; } } }
                        misc[1] = D; misc[2] = above; }
                }
                __syncthreads();
                prefix = (prefix << 8) | (unsigned)misc[1]; kk -= misc[2];
            }
            const unsigned tau = prefix;
            const int seg = (((N + 7) >> 3) + 63) & ~63; const int s_lo = wave * seg, s_hi = (s_lo + seg < N) ? s_lo + seg : N;
            { int cg = 0, ce = 0;
                for (int base = s_lo; base < s_hi; base += 64) { const int s = base + lane; const bool in = s < s_hi; const unsigned key = in ? sc[s] : 0u;
                    cg += __popcll(__ballot(in && key > tau)); ce += __popcll(__ballot(in && key == tau)); }
                if (lane == 0) { misc[4 + wave] = cg; misc[12 + wave] = ce; } }
            __syncthreads();
            { int bg = 0, be = 0;
                for (int w2 = 0; w2 < 8; ++w2) if (w2 < wave) { bg += misc[4 + w2]; be += misc[12 + w2]; }
                int run_sel = bg + (be < kk ? be : kk), run_eq = be;
                for (int base = s_lo; base < s_hi; base += 64) { const int s = base + lane; const bool in = s < s_hi; const unsigned key = in ? sc[s] : 0u;
                    const bool gt = in && key > tau, eq = in && key == tau; const unsigned long long me = __ballot(eq); const unsigned long long lt = (1ull << lane) - 1ull;
                    const bool take = gt || (eq && (run_eq + __popcll(me & lt) < kk)); const unsigned long long mt = __ballot(take);
                    if (take) sel[run_sel + __popcll(mt & lt)] = s;
                    run_sel += __popcll(mt); run_eq += __popcll(me); } }
            L = 256;
        }
        __syncthreads();
        if constexpr (BITS_ONLY) {
            unsigned* bm = (unsigned*)lg; unsigned* MK = (unsigned*)(a.ws + WS_MASK);
            if (tid < 256) bm[tid] = 0u;
            __syncthreads();
            if (tid < L) { const int s = sel[tid]; const int kt = s >> 6, kap = s & 63, half = kap >> 5, k5 = kap & 31, hi = (k5 >> 2) & 1, r = (k5 & 3) + 4 * (k5 >> 3);
                atomicOr(&bm[kt * 2 + hi], 1u << (r + 16 * half)); }
            __syncthreads();
            const int ntw = ((t >> 8) + 1) * 8;
            if (tid < ntw) { const int kt = tid >> 1, hi = tid & 1; MK[((size_t)(b * 256 + (t >> 5)) * 128 + kt) * 64 + (t & 31) + 32 * hi] = bm[tid]; }
            __syncthreads();
            return;
        }
        { const int j = tid >> 1, h0 = (tid & 1) * 3;
            if (j < L) { const int s = sel[j]; const size_t srow = (size_t)b * SEQ + s; const int bk = t5_bucket(t - s);
#pragma unroll
                for (int hh = 0; hh < 3; ++hh) { const int h = h0 + hh; const v4u* kr = (const v4u*)(P + srow * NP + N_DK + h * 64); const float* q = qh + h * 64; float dot = 0.f;
#pragma unroll
                    for (int c = 0; c < 8; ++c) { const v4u w = kr[c]; dot += q[8 * c] * bflo(w.x) + q[8 * c + 1] * bfhi(w.x) + q[8 * c + 2] * bflo(w.y) + q[8 * c + 3] * bfhi(w.y) + q[8 * c + 4] * bflo(w.z) + q[8 * c + 5] * bfhi(w.z) + q[8 * c + 6] * bflo(w.w) + q[8 * c + 7] * bfhi(w.w); }
                    lg[h * 256 + j] = dot + a.rel_bias[bk * 6 + h] * LOG2E; } }
            else {
#pragma unroll
                for (int hh = 0; hh < 3; ++hh) lg[(h0 + hh) * 256 + j] = -INFINITY; } }
        __syncthreads();
        if (wave < 6) { float* row = lg + wave * 256; float v0 = row[lane], v1 = row[lane + 64], v2 = row[lane + 128], v3 = row[lane + 192];
            float mx = fmaxf(fmaxf(v0, v1), fmaxf(v2, v3));
#pragma unroll
            for (int o = 1; o < 64; o <<= 1) mx = fmaxf(mx, shx(mx, o, lane));
            v0 = exp2f(v0 - mx); v1 = exp2f(v1 - mx); v2 = exp2f(v2 - mx); v3 = exp2f(v3 - mx);
            const float sm = wave_sum((v0 + v1) + (v2 + v3), lane);
            row[lane] = v0; row[lane + 64] = v1; row[lane + 128] = v2; row[lane + 192] = v3;
            if (lane == 0) inv[wave] = 1.0f / sm; }
        __syncthreads();
        if (tid < 384) { const int h = tid >> 6, d = tid & 63; float acc = 0.f; const bf16* vb = P + (size_t)b * SEQ * NP + N_DV + h * 64 + d;
            for (int j = 0; j < L; ++j) acc += lg[h * 256 + j] * bf2f(vb[(size_t)sel[j] * NP]);
            const float o = acc * inv[h]; const float gate = bf2f(P[m * NP + N_DG + h * 64 + d]);
            Y[m * DM + 384 + h * 64 + d] = (bf16)f2bf(o * silu_f(gate)); }
    }
    __syncthreads();
}
template <bool BITS_ONLY> __device__ __forceinline__ void dsa_slow_phase(const Args& a, int l, unsigned char* lds, int wg, int G, int tid) {
    for (int qi = wg; qi < M; qi += G) { asm volatile("" : "+v"(tid)); dsa_slow_query<BITS_ONLY>(a, lds, qi & 7, qi >> 3, tid); }
}
__device__ __forceinline__ void index_phase(const Args& a, unsigned char* lds, unsigned* qctr, volatile LAS unsigned* MISC, int tid) {
    const unsigned short* P = (const unsigned short*)(a.ws + WS_P); unsigned* MK = (unsigned*)(a.ws + WS_MASK);
    __syncthreads();
    if (tid <= 256) ((float*)(lds + idxb::L_XT))[tid] = tid < 256 ? idxb::xthr(tid) : __builtin_inff();
    int bq = blockIdx.x & 7, tries = 0;
    for (;;) {
        asm volatile("" : "+v"(tid));
        __syncthreads();
        if (tid == 0) MISC[17] = __hip_atomic_fetch_add(qctr + 64 * bq, 1u, __ATOMIC_RELAXED, __HIP_MEMORY_SCOPE_AGENT);
        __syncthreads();
        const int k = (int)MISC[17];
        if (k >= 256) { if (++tries == 8) break; bq = (bq + 1) & 7; continue; }
        const int b = bq, qt = 255 - k;
        idxb::index_unit(P, (const unsigned short*)(a.ws + WS_KC), MK, (unsigned*)(a.ws + WS_ZW) + (size_t)blockIdx.x * 128 * 64, lds, b, qt, tid);
        const int* par = (const int*)(lds + idxb::L_PAR);
        for (int q = 0; q < 32; ++q) if (par[idxb::P_MODE * 32 + q] == 3) dsa_slow_query<true>(a, lds, b, qt * 32 + q, tid);
    }
}
#ifndef REP_POOL
#define REP_POOL 1
#endif
#ifndef REP_IDX
#define REP_IDX 1
#endif
#ifndef REP_GLA
#define REP_GLA 1
#endif
#ifndef REP_ATT
#define REP_ATT 1
#endif
#ifndef REP_PREP
#define REP_PREP 1
#endif
#ifndef REP_PRO
#define REP_PRO 1
#endif
#ifndef REP_NORM
#define REP_NORM 1
#endif
#ifndef REP_ALL
#define REP_ALL 1
#endif
#ifndef REP_BAR
#define REP_BAR 1
#endif
#ifndef REP_OUT
#define REP_OUT 1
#endif
#ifndef REP_INP
#define REP_INP 1
#endif
#ifndef GLA_MODE
#define GLA_MODE 1
#endif
#ifndef DSA_MODE
#define DSA_MODE 2
#endif
#ifndef MK_SINGLE
#define MK_SINGLE 1
#endif
__global__ void __launch_bounds__(NTHR, 2) fwd(Args a) {
    extern __shared__ __attribute__((aligned(16))) unsigned char lds[];
    int tid = threadIdx.x, lane = tid & 63, wave = __builtin_amdgcn_readfirstlane(tid >> 6);
    int G = gridDim.x, wg = blockIdx.x;
    const int wave0 = __builtin_amdgcn_readfirstlane(tid >> 6);
#define LAUNDER() do { { int wv_ = wave0; asm volatile("" : "+s"(wv_)); unsigned on_ = ~0u; asm volatile("" : "+s"(on_)); tid = wv_ * 64 + (int)__builtin_amdgcn_mbcnt_hi(on_, __builtin_amdgcn_mbcnt_lo(on_, 0u)); asm volatile("" : "+v"(tid)); } wg = blockIdx.x; G = gridDim.x; asm volatile("" : "+s"(wg), "+s"(G));     \
    lane = tid & 63; wave = __builtin_amdgcn_readfirstlane(tid >> 6); gw = wg * NWAVES + wave; NGW = G * NWAVES; } while (0)
    volatile LAS unsigned* MISC = (volatile LAS unsigned*)((LAS unsigned char*)lds + MISC_OFF);
    for (int u = tid; u < (LDS_BYTES - LDSCTL_OFF) / 4; u += NTHR) ((LAS unsigned*)((LAS unsigned char*)lds + LDSCTL_OFF))[u] = 0u;
    __syncthreads();
    XcdBarrier bar; bar.bar = (unsigned*)(a.ws + WS_CTL) + CW_BAR; bar.x = 0; bar.st = nullptr;
    const bool one = a.single != 0;
    if (one) bar = xcd_barrier_post((unsigned*)(a.ws + WS_CTL) + CW_BAR, MISC + 8);
#define IN(k) (a.ph_lo <= (k) && (k) < a.ph_hi)
#define SEAM() do { if (one) { unsigned* bp_ = (unsigned*)(a.ws + WS_CTL) + CW_BAR; asm volatile("" : "+s"(bp_)); XcdBarrier bb_; bb_.bar = bp_; bb_.x = bar.x; bb_.st = bar.st; xcd_barrier(bb_); if (REP_BAR == 2) xcd_barrier(bb_); } } while (0)
    int gw = wg * NWAVES + wave, NGW = G * NWAVES;
    bf16* XB = (bf16*)(a.ws + WS_XB); bf16* PB = (bf16*)(a.ws + WS_P);
    for (int rpw = 0; rpw < REP_ALL; ++rpw) {
    LAUNDER();
    if (IN(0)) { for (int rp = 0; rp < REP_PRO; ++rp) prologue_phase(a, wg, G, tid); SEAM(); }
    for (int l = a.l_lo; l < a.l_hi; ++l) {
        LAUNDER();
        if (IN(1)) { rowscale_phase((const float*)(a.ws + WS_RS), (float*)(a.ws + WS_RSC), wg, G, tid); SEAM(); }
        LAUNDER();
        if (IN(2)) {
            pg8::Gemm g{(const bf16*)(a.ws + WS_XA), (const bf16*)(a.ws + WS_WIN) + (size_t)l * NP * 1024, M, NP, DM}; pg8::StaticOrder S; S.init(M, NP, G, wg);
            pg8::EpiP E{PB, NP, (const float*)(a.ws + WS_RSC), (pg8::bf16_t*)(a.ws + WS_KC)};
            pg8::gemm_phase<pg8::EpiP, pg8::StaticOrder, true, true>((PG8_LAS unsigned char*)lds, g, S, E, tid);
#if REP_INP == 2
            asm volatile("" : "+v"(tid)); __syncthreads(); pg8::gemm_phase<pg8::EpiP, pg8::StaticOrder, true, true>((PG8_LAS unsigned char*)lds, g, S, E, tid);
#endif
            SEAM();
        }
        LAUNDER();
        if (IN(3)) {
#if GLA_MODE == 0
            if (wg < 32) gla_rec_phase(a, l, lds, wg, tid);
#endif
            for (int rp = 0; rp < REP_POOL; ++rp) { asm volatile("" : "+v"(tid)); poolb::pool_phase(PB, XB, a.pool_w + (size_t)l * 4 * 4096, a.pool_scale + l * 256, lds, wg, G, tid); }
#if GLA_MODE == 1
            glab::gla_prep_loop(PB, a.ws + WS_GOP, a.gate_w2 + (size_t)l * 16 * 192, a.gate_b + l * 192, lds, wg, G, tid);
#if REP_PREP == 2
            __syncthreads(); asm volatile("" : "+v"(tid), "+s"(wg));
            for (int item = wg; item < BATCH * 4 * 128; item += G) { asm volatile("" : "+v"(tid)); glab::gla_prep_item(PB, a.ws + WS_GOP, a.gate_w2 + (size_t)l * 16 * 192, a.gate_b + l * 192, lds, item, tid); }
#endif
            __syncthreads();
#endif
#if DSA_MODE == 0
            dsa_slow_phase<false>(a, l, lds, wg, G, tid);
#elif DSA_MODE == 1
            dsa_slow_phase<true>(a, l, lds, wg, G, tid);
#else
            for (int rp = 0; rp < REP_IDX; ++rp) { asm volatile("" : "+v"(tid)); index_phase(a, lds, (unsigned*)(a.ws + WS_CTL) + CW_QUEUE + 64 * (32 + 8 * (l + 4 * rp + 8 * rpw)), MISC, tid); }
#endif
            SEAM();
        }
        LAUNDER();
        if (IN(4)) {
#if DSA_MODE >= 1
            { float* dl = (float*)(lds + 86016);
                for (int i = tid; i < 1032; i += NTHR) { const int rel = i >> 3, h = i & 7; dl[i] = (h < 6 && rel < 128) ? (a.rel_bias[(int)T5B[rel] * 6 + h] - a.rel_bias[31 * 6 + h]) * LOG2E : 0.f; }
                __syncthreads();
                const attn_body::AttnTensors AT{(const attn_body::bf16*)(PB + N_DQ), (const attn_body::bf16*)(PB + N_DK), (const attn_body::bf16*)(PB + N_DV), (attn_body::bf16*)(XB + 384), (const attn_body::bf16*)(PB + N_DG), (const unsigned*)(a.ws + WS_MASK)};
#if GLA_MODE == 1
                if (wg < 32) { glab::gla_seq_unit(PB, XB, a.ws + WS_GOP, a.gla_norm_g + l * 96, lds, wg >> 2, wg & 3, tid);
#if REP_GLA == 2
                    asm volatile("" : "+v"(tid)); glab::gla_seq_unit(PB, XB, a.ws + WS_GOP, a.gla_norm_g + l * 96, lds, wg >> 2, wg & 3, tid);
#endif
                    for (int i = tid; i < 1032; i += NTHR) { const int rel = i >> 3, h = i & 7; dl[i] = (h < 6 && rel < 128) ? (a.rel_bias[(int)T5B[rel] * 6 + h] - a.rel_bias[31 * 6 + h]) * LOG2E : 0.f; }
                    __syncthreads(); }
#endif
                for (int rp = 0; rp < REP_ATT; ++rp) { unsigned* qctr = (unsigned*)(a.ws + WS_CTL) + CW_QUEUE + 64 * (l * 4 + rp + 2 * rpw);
                for (;;) { asm volatile("" : "+v"(tid));
                    __syncthreads();
                    if (tid == 0) MISC[16] = __hip_atomic_fetch_add(qctr, 1u, __ATOMIC_RELAXED, __HIP_MEMORY_SCOPE_AGENT);
                    __syncthreads();
                    const int k = (int)MISC[16];
                    if (k >= 48 * 32) break;
                    const int qb = 31 - k / 48, bh = k % 48;
                    attn_body::attn_unit<8>(bh / 6, bh % 6, qb, AT.Q, AT.K, AT.V, AT.O, AT.GT, AT.MK, (attn_body::lds_cfptr)(LAS const float*)((LAS unsigned char*)lds + 86016), (char*)lds, tid); } } }
#endif
            SEAM();
        }
        LAUNDER();
        if (IN(5)) {
            pg8::Gemm g{XB, (const bf16*)(a.ws + WS_WOUT) + (size_t)l * 1024 * 1024, M, DM, DM}; pg8::StaticOrder S; S.init(M, DM, G, wg);
            pg8::EpiRes E{(bf16*)(a.ws + WS_XA), DM, (float*)(a.ws + WS_RS)};
            pg8::gemm_phase<pg8::EpiRes, pg8::StaticOrder, true, true>((PG8_LAS unsigned char*)lds, g, S, E, tid);
#if REP_OUT == 2
            { asm volatile("" : "+v"(tid)); __syncthreads(); pg8::EpiRes E2{(bf16*)(a.ws + WS_P), DM, (float*)(a.ws + WS_P) + (size_t)M * DM}; pg8::gemm_phase<pg8::EpiRes, pg8::StaticOrder, true, true>((PG8_LAS unsigned char*)lds, g, S, E2, tid); }
#endif
            SEAM();
        }
    }
    }
    LAUNDER();
    if (IN(6)) final_norm_phase((const bf16*)(a.ws + WS_XA), a.out, a.final_g, (const float*)(a.ws + WS_RS), gw, NGW, lane);
#undef IN
#undef SEAM
}

extern "C" void kernel_launch(void* const* d_in, const int* in_sizes, int n_in, void* d_out, int out_size, void* d_ws, size_t ws_size, hipStream_t stream) {
    static int grid = 0;
    if (grid == 0) {
        if (n_in != 11 || in_sizes[0] != M * DM || out_size != M * DM || ws_size < WS_END) { fprintf(stderr, "kernel_launch: unexpected shapes (n_in %d, in0 %d, out %d, ws %zu); nothing launched\n", n_in, n_in > 0 ? in_sizes[0] : -1, out_size, ws_size); grid = -1; return; }
        int dev = 0, cus = 0, per_cu = 0;
        if (hipGetDevice(&dev) != hipSuccess || hipDeviceGetAttribute(&cus, hipDeviceAttributeMultiprocessorCount, dev) != hipSuccess) { grid = -1; return; }
        if (hipFuncSetAttribute((const void*)fwd, hipFuncAttributeMaxDynamicSharedMemorySize, LDS_BYTES) != hipSuccess) { fprintf(stderr, "kernel_launch: hipFuncSetAttribute failed\n"); grid = -1; return; }
        if (hipOccupancyMaxActiveBlocksPerMultiprocessor(&per_cu, (const void*)fwd, NTHR, LDS_BYTES) != hipSuccess || per_cu < 1) fprintf(stderr, "kernel_launch: occupancy query reports %d\n", per_cu);
        (void)hipGetLastError();
        grid = cus;
    }
    if (grid < 0) return;
    if (hipMemsetAsync((char*)d_ws + WS_CTL, 0, CTL_ZERO_BYTES, stream) != hipSuccess) return;
    Args a{};
    a.x = (const float*)d_in[0]; a.norm_g = (const float*)d_in[1]; a.w_in = (const float*)d_in[2]; a.gate_w2 = (const float*)d_in[3]; a.gate_b = (const float*)d_in[4]; a.gla_norm_g = (const float*)d_in[5];
    a.rel_bias = (const float*)d_in[6]; a.pool_w = (const float*)d_in[7]; a.pool_scale = (const float*)d_in[8]; a.w_out = (const float*)d_in[9]; a.final_g = (const float*)d_in[10];
    a.out = (float*)d_out; a.ws = (unsigned char*)d_ws; a.pad = 0;
#if MK_SINGLE
    a.l_lo = 0; a.l_hi = DEPTH; a.ph_lo = 0; a.ph_hi = 7; a.single = 1;
    hipLaunchKernelGGL(fwd, dim3(grid), dim3(NTHR), LDS_BYTES, stream, a);
#else
    a.single = 0;
    a.l_lo = 0; a.l_hi = 0; a.ph_lo = 0; a.ph_hi = 1; hipLaunchKernelGGL(fwd, dim3(grid), dim3(NTHR), LDS_BYTES, stream, a);
    for (int l = 0; l < DEPTH; ++l) for (int ph = 1; ph <= 5; ++ph) { a.l_lo = l; a.l_hi = l + 1; a.ph_lo = ph; a.ph_hi = ph + 1; hipLaunchKernelGGL(fwd, dim3(grid), dim3(NTHR), LDS_BYTES, stream, a); }
    a.l_lo = 0; a.l_hi = 0; a.ph_lo = 6; a.ph_hi = 7; hipLaunchKernelGGL(fwd, dim3(grid), dim3(NTHR), LDS_BYTES, stream, a);
#endif
    const hipError_t le = hipPeekAtLastError();
    if (le != hipSuccess) fprintf(stderr, "kernel_launch: launch failed: %s\n", hipGetErrorName(le));
}
```

```cpp
#include <hip/hip_runtime.h>
#include <cstdio>
#include <cstdint>
namespace pg8 {
#define PG8_LAS __attribute__((address_space(3)))
typedef unsigned short bf16_t;
typedef short bf16x8 __attribute__((ext_vector_type(8)));
typedef float f32x4 __attribute__((ext_vector_type(4)));
typedef unsigned u32x4 __attribute__((ext_vector_type(4)));
constexpr int BM = 256, BK = 64, HALF = 128, HTB = HALF * BK * 2  , STAGE_BYTES = 8 * HTB, NXCD = 8, WGM = 8;

__host__ __device__ __forceinline__ int lds_byte(int r, int c) { const int st = (r >> 4) * 2 + (c >> 5), rr = r & 15, cc = c & 31, ob = rr * 64 + cc * 2; return st * 1024 + (ob ^ (((ob >> 9) & 1) << 5)); }
__host__ __device__ __forceinline__ void stage_rc(int b, int& R, int& C) { const int st = b / 1024, sb = b % 1024, swz = sb ^ (((sb >> 9) & 1) << 5); R = (st >> 1) * 16 + swz / 64; C = (st & 1) * 32 + (swz % 64) / 2; }
__host__ __device__ __forceinline__ int perm32(int rho) { const int n = rho >> 4, i = rho & 15; return 8 * (i >> 2) + 4 * n + (i & 3); }

struct Unit { int pm, pn; };
struct Gemm { const bf16_t* A; const bf16_t* Bt; int M, N, K; };

struct StaticOrder {
    int nM, nN, nwg, G, c;
    __host__ __device__ void init(int M, int N, int G_, int c_) { nM = M / BM; nN = N / BM; nwg = nM * nN; G = G_; c = c_; }
    __host__ __device__ bool next(int i, Unit& u) const {
        const long L = (long)i * G + c; if (L >= nwg) return false;
        int wgid = (int)L; { const int q = nwg / NXCD, r = nwg % NXCD, xcd = wgid % NXCD, off = wgid / NXCD; wgid = (xcd < r ? xcd * (q + 1) : r * (q + 1) + (xcd - r) * q) + off; }
        const int nig = WGM * nN, gid = wgid / nig, fm = gid * WGM, gsz = (nM - fm) < WGM ? (nM - fm) : WGM;
        u.pm = fm + ((wgid % nig) % gsz); u.pn = (wgid % nig) / gsz; return true;
    }
    __device__ __forceinline__ void a_ready(const Unit&) const {}
    __device__ __forceinline__ void done(const Unit&) const {}
};

__device__ __forceinline__ unsigned cvt_pk_bf16(float lo, float hi) { unsigned r; asm volatile("v_cvt_pk_bf16_f32 %0, %1, %2" : "=v"(r) : "v"(lo), "v"(hi)); return r; }
typedef float f32x2 __attribute__((ext_vector_type(2)));
struct EpiP {
    static constexpr bool PERM = true, AFTER_DRAIN = false;
    bf16_t* O; int ldc; const float* RS; bf16_t* KC;
    __device__ __forceinline__ void operator()(const f32x4 (&acc)[2][2][4][2], const Unit& u, int wr, int wc, int fr, int fq) const {
        const int row0 = u.pm * BM + wr * 64 + fr, col0 = u.pn * BM + wc * 32 + 8 * fq;
#pragma unroll
        for (int ai = 0; ai < 2; ++ai)
#pragma unroll
            for (int m = 0; m < 4; ++m) { const int row = row0 + ai * HALF + m * 16; bf16_t* rowp = O + (size_t)row * ldc + col0;
                const float r = RS[row];
#pragma unroll
                for (int bj = 0; bj < 2; ++bj) { const f32x4 v0 = acc[ai][bj][m][0] * r, v1 = acc[ai][bj][m][1] * r;
                    u32x4 w; w.x = cvt_pk_bf16(v0[0], v0[1]); w.y = cvt_pk_bf16(v0[2], v0[3]); w.z = cvt_pk_bf16(v1[0], v1[1]); w.w = cvt_pk_bf16(v1[2], v1[3]);
                    if (col0 + bj * HALF < 3384) *(u32x4*)(rowp + bj * HALF) = w;
                    if (bj == 0 && wc == 0 && u.pn == 13) *(u32x4*)(KC + (size_t)row * 32 + 8 * fq) = w; } }
    }
};
struct EpiRes {
    static constexpr bool PERM = true, AFTER_DRAIN = false;
    bf16_t* XA; int ldc; float* RS;
    __device__ __forceinline__ void operator()(const f32x4 (&acc)[2][2][4][2], const Unit& u, int wr, int wc, int fr, int fq) const {
        const int row0 = u.pm * BM + wr * 64 + fr, col0 = u.pn * BM + wc * 32 + 8 * fq, lane = fr + 16 * fq;
#pragma unroll
        for (int ai = 0; ai < 2; ++ai)
#pragma unroll
            for (int m = 0; m < 4; ++m) { const int row = row0 + ai * HALF + m * 16; const size_t off = (size_t)row * ldc + col0; float s = 0.f;
#pragma unroll
                for (int bj = 0; bj < 2; ++bj) { const u32x4 b = *(const u32x4*)(XA + off + bj * HALF); u32x4 w;
#pragma unroll
                    for (int k = 0; k < 4; ++k) { const float lo = __uint_as_float(b[k] << 16) + acc[ai][bj][m][k >> 1][2 * (k & 1)], hi = __uint_as_float(b[k] & 0xffff0000u) + acc[ai][bj][m][k >> 1][2 * (k & 1) + 1];
                        w[k] = cvt_pk_bf16(lo, hi); const float rl = __uint_as_float(w[k] << 16), rh = __uint_as_float(w[k] & 0xffff0000u); s += rl * rl + rh * rh; }
                    *(u32x4*)(XA + off + bj * HALF) = w; }
                s += __builtin_bit_cast(float, __builtin_amdgcn_ds_bpermute((lane ^ 16) << 2, __builtin_bit_cast(int, s)));
                s += __builtin_bit_cast(float, __builtin_amdgcn_ds_bpermute((lane ^ 32) << 2, __builtin_bit_cast(int, s)));
                if (fq == 0) RS[(size_t)row * 16 + u.pn * 4 + wc] = s; }
    }
};
template <class Epi, class Sched, bool ALIGN_EPI = false, bool SP2 = false>
__device__ __forceinline__ void gemm_phase(PG8_LAS unsigned char* lds, const Gemm g, const Sched& S, const Epi& E, const int tid) {
    const int wid = __builtin_amdgcn_readfirstlane(tid >> 6), lane = tid & 63, wr = wid >> 2, wc = wid & 3, fr = lane & 15, fq = lane >> 4;
    const int K = g.K, nt = K / BK;
    unsigned voffA[2], voffB[2];
#pragma unroll
    for (int i = 0; i < 2; ++i) { int R, C; stage_rc(tid * 16 + i * 8192, R, C); const int Rb = Epi::PERM ? ((R & ~31) + perm32(R & 31)) : R;
        voffA[i] = (unsigned)(R * K + C) * 2u; voffB[i] = (unsigned)(Rb * K + C) * 2u; }
    const size_t kstep = (size_t)(BK * 2);
    const size_t hstep = (size_t)HALF * K * 2;
    const size_t tstep = 2 * hstep;
    const unsigned ldsw = (unsigned)wid * 1024u;
    const int aoff = lds_byte(wr * 64 + fr, fq * 8), boff = lds_byte(wc * 32 + fr, fq * 8);
#define PG8_SA(b, h) (((b) * 2 + (h)) * HTB)
#define PG8_SB(b, h) ((4 + (b) * 2 + (h)) * HTB)
#define PG8_STAGE(bufoff, gbase, voff) do { _Pragma("unroll") for (int _i = 0; _i < 2; ++_i) \
        __builtin_amdgcn_global_load_lds((const unsigned*)((const char*)(gbase) + (voff)[_i]), (PG8_LAS unsigned*)(lds + (bufoff) + ldsw + _i * 8192), 16, 0, 0); } while (0)
#define PG8_LDA(dst, b, h) do { _Pragma("unroll") for (int m = 0; m < 4; ++m) _Pragma("unroll") for (int k = 0; k < 2; ++k) dst[m][k] = *(const PG8_LAS bf16x8*)(lds + PG8_SA(b, h) + aoff + m * 2048 + k * 1024); } while (0)
#define PG8_LDB(dst, b, h) do { _Pragma("unroll") for (int n = 0; n < 2; ++n) _Pragma("unroll") for (int k = 0; k < 2; ++k) dst[n][k] = *(const PG8_LAS bf16x8*)(lds + PG8_SB(b, h) + boff + n * 2048 + k * 1024); } while (0)
#define PG8_MMA(ai, bj, At, Bt) do { __builtin_amdgcn_s_setprio(1); _Pragma("unroll") for (int m = 0; m < 4; ++m) _Pragma("unroll") for (int n = 0; n < 2; ++n) _Pragma("unroll") for (int k = 0; k < 2; ++k) \
        acc[ai][bj][m][n] = __builtin_amdgcn_mfma_f32_16x16x32_bf16(Bt[n][k], At[m][k], acc[ai][bj][m][n], 0, 0, 0); __builtin_amdgcn_s_setprio(0); } while (0)
#define PG8_WAIT_V(n) asm volatile("s_waitcnt vmcnt(" #n ")" ::: "memory")
#define PG8_WAIT_L(n) asm volatile("s_waitcnt lgkmcnt(" #n ")" ::: "memory")
#define PG8_BAR __builtin_amdgcn_s_barrier()
#define PG8_SCHED __builtin_amdgcn_sched_barrier(0)
    Unit cur, nxt; int ui = 0;
    if (!S.next(0, cur)) return;
    f32x4 acc[2][2][4][2];
#pragma unroll
    for (int a = 0; a < 2; ++a)
#pragma unroll
        for (int b = 0; b < 2; ++b)
#pragma unroll
            for (int m = 0; m < 4; ++m)
#pragma unroll
                for (int n = 0; n < 2; ++n) acc[a][b][m][n] = (f32x4){0.f, 0.f, 0.f, 0.f};
    bf16x8 At[4][2], B0[2][2], B1[2][2];
    const char* cA = (const char*)g.A + (size_t)cur.pm * tstep; const char* cB = (const char*)g.Bt + (size_t)cur.pn * tstep;
    S.a_ready(cur);
    if constexpr (SP2) {
        PG8_STAGE(PG8_SB(0, 0), cB, voffB); PG8_STAGE(PG8_SB(0, 1), cB + hstep, voffB); PG8_STAGE(PG8_SA(0, 0), cA, voffA); PG8_STAGE(PG8_SA(0, 1), cA + hstep, voffA);
        if (wr == 1) PG8_BAR;
        PG8_WAIT_V(2); PG8_BAR;
        PG8_STAGE(PG8_SB(1, 0), cB + kstep, voffB); PG8_STAGE(PG8_SA(1, 0), cA + kstep, voffA); PG8_STAGE(PG8_SB(1, 1), cB + hstep + kstep, voffB);
        PG8_WAIT_V(6); PG8_BAR;
    } else {
        PG8_STAGE(PG8_SB(0, 0), cB, voffB); PG8_STAGE(PG8_SA(0, 0), cA, voffA); PG8_STAGE(PG8_SB(0, 1), cB + hstep, voffB); PG8_STAGE(PG8_SA(0, 1), cA + hstep, voffA);
        if (wr == 1) PG8_BAR;
        PG8_WAIT_V(4); PG8_BAR;
        PG8_STAGE(PG8_SB(1, 0), cB + kstep, voffB); PG8_STAGE(PG8_SA(1, 0), cA + kstep, voffA); PG8_STAGE(PG8_SB(1, 1), cB + hstep + kstep, voffB);
        PG8_WAIT_V(6); PG8_BAR;
    }
    for (;;) {
        const bool has_next = S.next(ui + 1, nxt);
        const char* nA = has_next ? (const char*)g.A + (size_t)nxt.pm * tstep : cA; const char* nB = has_next ? (const char*)g.Bt + (size_t)nxt.pn * tstep : cB;
        for (int t = 0; t < nt; t += 2) {
            const bool last = (t == nt - 2);
            const char* a1 = cA + (size_t)(t + 1) * kstep;
            const char* a2 = last ? nA : cA + (size_t)(t + 2) * kstep; const char* b2 = last ? nB : cB + (size_t)(t + 2) * kstep;
            const char* a3 = a2 + kstep; const char* b3 = b2 + kstep;
            if (last && has_next) S.a_ready(nxt);
            if constexpr (SP2) {
            PG8_LDB(B0, 0, 0); PG8_LDB(B1, 0, 1); PG8_SCHED; PG8_LDA(At, 0, 0); PG8_STAGE(PG8_SA(1, 1), a1 + hstep, voffA);
            PG8_WAIT_V(8); PG8_WAIT_L(0); PG8_BAR; PG8_MMA(0, 0, At, B0); PG8_MMA(0, 1, At, B1); PG8_BAR; PG8_SCHED;
            PG8_LDA(At, 0, 1); PG8_STAGE(PG8_SB(0, 0), b2, voffB); PG8_STAGE(PG8_SB(0, 1), b2 + hstep, voffB); PG8_STAGE(PG8_SA(0, 0), a2, voffA);
            PG8_WAIT_V(8); PG8_WAIT_L(0); PG8_BAR; PG8_MMA(1, 0, At, B0); PG8_MMA(1, 1, At, B1); PG8_BAR; PG8_SCHED;
            PG8_LDB(B0, 1, 0); PG8_LDB(B1, 1, 1); PG8_SCHED; PG8_LDA(At, 1, 0); PG8_STAGE(PG8_SA(0, 1), a2 + hstep, voffA);
            PG8_WAIT_V(8); PG8_WAIT_L(0); PG8_BAR; PG8_MMA(0, 0, At, B0); PG8_MMA(0, 1, At, B1); PG8_BAR; PG8_SCHED;
            PG8_LDA(At, 1, 1); PG8_STAGE(PG8_SB(1, 0), b3, voffB); PG8_STAGE(PG8_SB(1, 1), b3 + hstep, voffB); PG8_STAGE(PG8_SA(1, 0), a3, voffA);
            PG8_WAIT_V(8); PG8_WAIT_L(0); PG8_BAR; PG8_MMA(1, 0, At, B0); PG8_MMA(1, 1, At, B1); PG8_BAR; PG8_SCHED;
            } else {
            PG8_LDB(B0, 0, 0); PG8_SCHED; PG8_LDA(At, 0, 0); PG8_STAGE(PG8_SA(1, 1), a1 + hstep, voffA);
            PG8_WAIT_L(8); PG8_BAR; PG8_WAIT_L(0); PG8_MMA(0, 0, At, B0); PG8_BAR; PG8_SCHED;
            PG8_LDB(B1, 0, 1); PG8_STAGE(PG8_SB(0, 0), b2, voffB);
            PG8_BAR; PG8_WAIT_L(0); PG8_MMA(0, 1, At, B1); PG8_BAR;
            PG8_LDA(At, 0, 1); PG8_STAGE(PG8_SA(0, 0), a2, voffA);
            PG8_BAR; PG8_WAIT_L(0); PG8_MMA(1, 0, At, B0); PG8_BAR; PG8_SCHED;
            PG8_STAGE(PG8_SB(0, 1), b2 + hstep, voffB);
            PG8_WAIT_V(6); PG8_BAR; PG8_MMA(1, 1, At, B1); PG8_BAR;
            PG8_LDB(B0, 1, 0); PG8_SCHED; PG8_LDA(At, 1, 0); PG8_STAGE(PG8_SA(0, 1), a2 + hstep, voffA);
            PG8_WAIT_L(8); PG8_BAR; PG8_WAIT_L(0); PG8_MMA(0, 0, At, B0); PG8_BAR; PG8_SCHED;
            PG8_LDB(B1, 1, 1); PG8_STAGE(PG8_SB(1, 0), b3, voffB);
            PG8_BAR; PG8_WAIT_L(0); PG8_MMA(0, 1, At, B1); PG8_BAR;
            PG8_LDA(At, 1, 1); PG8_STAGE(PG8_SA(1, 0), a3, voffA);
            PG8_BAR; PG8_WAIT_L(0); PG8_MMA(1, 0, At, B0); PG8_BAR; PG8_SCHED;
            PG8_STAGE(PG8_SB(1, 1), b3 + hstep, voffB);
            PG8_WAIT_V(6); PG8_BAR; PG8_MMA(1, 1, At, B1); PG8_BAR;
            }
        }
        if constexpr (ALIGN_EPI) { if (wr == 0) PG8_BAR; }
        if constexpr (!Epi::AFTER_DRAIN) { E(acc, cur, wr, wc, fr, fq); S.done(cur); }
        if (!has_next) break;
#pragma unroll
        for (int a = 0; a < 2; ++a)
#pragma unroll
            for (int b = 0; b < 2; ++b)
#pragma unroll
                for (int m = 0; m < 4; ++m)
#pragma unroll
                    for (int n = 0; n < 2; ++n) acc[a][b][m][n] = (f32x4){0.f, 0.f, 0.f, 0.f};
        cur = nxt; cA = nA; cB = nB; ++ui;
        if constexpr (ALIGN_EPI) { if (wr == 1) PG8_BAR; }
    }
    PG8_WAIT_V(0);
    if constexpr (!ALIGN_EPI) { if (wr == 0) PG8_BAR; }
    PG8_BAR;
    if constexpr (Epi::AFTER_DRAIN) { E.fused(acc, cur, wr, wc, fr, fq, lds, wid, lane); S.done(cur); }
#undef PG8_SA
#undef PG8_SB
#undef PG8_STAGE
#undef PG8_LDA
#undef PG8_LDB
#undef PG8_MMA
#undef PG8_WAIT_V
#undef PG8_WAIT_L
#undef PG8_BAR
#undef PG8_SCHED
}
}
#include <hip/hip_bf16.h>
#include <cmath>
namespace attn_body {
using bf16=__hip_bfloat16;
using bf16x8=__attribute__((ext_vector_type(8)))short;
using s16x4=__attribute__((ext_vector_type(4)))short;
using f32x16=__attribute__((ext_vector_type(16)))float;
using u32x4=__attribute__((ext_vector_type(4)))unsigned;
constexpr int BATCH=8,NHEAD=6,SEQ=8192,D=64,DM=3584,DMO=1024;
constexpr int NW=8,QBLK=32,QB=QBLK*NW,KVBLK=64,NQB=SEQ/QB;
constexpr int ATTN_UNIT_ROWS=QB;
__device__ __forceinline__ int crow(int r,int hi){return (r&3)+8*(r>>2)+4*hi;}
#define SBAR() __builtin_amdgcn_sched_barrier(0)
typedef __attribute__((address_space(3))) const float* lds_cfptr;
__device__ __forceinline__ void biasadd(f32x16&p0,f32x16&p1,int tt,int tq,int hi,lds_cfptr dl,int h){
  const int rb=tq-64*tt-4*hi; const lds_cfptr dh=dl+h;
  #pragma unroll
  for(int r=0;r<16;++r){ const unsigned i0=(unsigned)(rb-(r&3)-8*(r>>2)), i1=i0-32u;
    float a0=dh[(i0<128u?i0:128u)*8], a1=dh[(i1<128u?i1:128u)*8];
    asm volatile("s_waitcnt lgkmcnt(0)":"+v"(a0),"+v"(a1)::"memory");
    p0[r]+=a0; p1[r]+=a1; }
}
typedef unsigned u32x2m __attribute__((ext_vector_type(2)));
template<int K> __device__ __forceinline__ float mands(float p,unsigned md){ return __uint_as_float(__float_as_uint(p)&(unsigned)(K==3?((int)md>>24):(int)(signed char)(md>>(8*K)))); }
template<int K> __device__ __forceinline__ float mandk(float p,unsigned bits){ unsigned m; asm("v_bfe_i32 %0, %1, %2, 1":"=v"(m):"v"(bits),"n"(K)); return __uint_as_float(__float_as_uint(p)&m); }
__device__ __forceinline__ float mand(float p,unsigned bits,int k){ return __uint_as_float(__float_as_uint(p)&(unsigned)__builtin_amdgcn_sbfe((int)bits,k,1)); }

constexpr int NSLOT=3, SLOTB=8192;
constexpr int LDS_K=0, LDS_V=NSLOT*SLOTB, LDS_TAB=2*NSLOT*SLOTB, LDS_OST=LDS_TAB+2048, LDS_WS=LDS_OST+NW*4096, LDS_BYTES=LDS_WS+NW*64*4, LDS_QST=90624;
constexpr float C2=0.125f*1.4426950408889634f;
__device__ __forceinline__ void glds16(const void*gsrc,unsigned lds_dst){unsigned keep;
  asm volatile("s_mov_b32 %0, m0\n\ts_mov_b32 m0, %2\n\ts_nop 0\n\tglobal_load_lds_dwordx4 %1, off\n\ts_mov_b32 m0, %0":"=&s"(keep):"v"(gsrc),"s"(lds_dst):"memory");}
__device__ __forceinline__ float max3f(float a,float b,float c){float r;asm("v_max3_f32 %0, %1, %2, %3":"=v"(r):"v"(a),"v"(b),"v"(c));return r;}
__device__ __forceinline__ float max2f(float a,float b){float r;asm("v_max_f32_e32 %0, %1, %2":"=v"(r):"v"(a),"v"(b));return r;}
__device__ __forceinline__ float fadd_s(float a,float b){float r;asm("v_add_f32_e32 %0, %1, %2":"=v"(r):"v"(a),"v"(b));return r;}
__device__ __forceinline__ float fsub_s(float a,float b){float r;asm("v_sub_f32_e32 %0, %1, %2":"=v"(r):"v"(a),"v"(b));return r;}
typedef float f32x2_t __attribute__((ext_vector_type(2))); typedef __bf16 bf16x2_t __attribute__((ext_vector_type(2)));
__device__ __forceinline__ unsigned cvtpk_s(float lo,float hi){f32x2_t v={lo,hi};bf16x2_t b=__builtin_convertvector(v,bf16x2_t);return __builtin_bit_cast(unsigned,b);}
#define WAIT_BAR(N) asm volatile("s_waitcnt vmcnt(" #N ") lgkmcnt(0)\n\ts_barrier":::"memory")

__device__ __forceinline__ void qkt(f32x16&p0,f32x16&p1,const char*Kslot,const bf16x8*qr,const f32x16&negm,int r32,int hi){
  const char*kb=Kslot+hi*1024+r32*16;
  #pragma unroll
  for(int d0=0;d0<4;++d0){
    const bf16x8 b0=*reinterpret_cast<const bf16x8*>(kb+d0*2048);
    const bf16x8 b1=*reinterpret_cast<const bf16x8*>(kb+d0*2048+512);
    if(d0==0){p0=__builtin_amdgcn_mfma_f32_32x32x16_bf16(b0,qr[0],negm,0,0,0);p1=__builtin_amdgcn_mfma_f32_32x32x16_bf16(b1,qr[0],negm,0,0,0);}
    else{p0=__builtin_amdgcn_mfma_f32_32x32x16_bf16(b0,qr[d0],p0,0,0,0);p1=__builtin_amdgcn_mfma_f32_32x32x16_bf16(b1,qr[d0],p1,0,0,0);}}
}
typedef __attribute__((address_space(3))) const char* lds_cptr;
typedef short v4i16_t __attribute__((ext_vector_type(4)));
__device__ __forceinline__ void kload8(bf16x8*kf,lds_cptr kp){
  kf[0]=*(const __attribute__((address_space(3))) bf16x8*)(kp);      kf[1]=*(const __attribute__((address_space(3))) bf16x8*)(kp+512);
  kf[2]=*(const __attribute__((address_space(3))) bf16x8*)(kp+2048); kf[3]=*(const __attribute__((address_space(3))) bf16x8*)(kp+2560);
  kf[4]=*(const __attribute__((address_space(3))) bf16x8*)(kp+4096); kf[5]=*(const __attribute__((address_space(3))) bf16x8*)(kp+4608);
  kf[6]=*(const __attribute__((address_space(3))) bf16x8*)(kp+6144); kf[7]=*(const __attribute__((address_space(3))) bf16x8*)(kp+6656);
}
__device__ __forceinline__ void kload2(bf16x8*kf,lds_cptr kp,int j){ kf[2*j]=*(const __attribute__((address_space(3))) bf16x8*)(kp+j*2048); kf[2*j+1]=*(const __attribute__((address_space(3))) bf16x8*)(kp+j*2048+512); }
__device__ __forceinline__ s16x4 vtr(lds_cptr p){ return __builtin_bit_cast(s16x4,__builtin_amdgcn_ds_read_tr16_b64_v4i16((__attribute__((address_space(3))) v4i16_t*)p)); }
__device__ __forceinline__ float rowmax(const f32x16&p0,const f32x16&p1){
  float a=max3f(p0[0],p0[1],p1[0]),b=max3f(p0[2],p0[3],p1[1]);a=max3f(a,p1[2],p1[3]);
  #pragma unroll
  for(int r=4;r<16;r+=4){a=max3f(a,p0[r],p0[r+1]);b=max3f(b,p0[r+2],p0[r+3]);a=max3f(a,p1[r],p1[r+1]);b=max3f(b,p1[r+2],p1[r+3]);}
  const float m=max2f(a,b);
  auto rr=__builtin_amdgcn_permlane32_swap(__float_as_uint(m),__float_as_uint(m),false,false);
  return max2f(__uint_as_float(rr[0]),__uint_as_float(rr[1]));
}
__device__ __forceinline__ void pv(f32x16*o,int vb,bf16x8 pa0,bf16x8 pa1,bf16x8 pa2,bf16x8 pa3){
  #pragma unroll
  for(int d0=0;d0<2;++d0){s16x4 lo[4],hi[4];
    #pragma unroll
    for(int ks=0;ks<4;++ks){
      asm volatile("ds_read_b64_tr_b16 %0,%1 offset:%c2":"=&v"(lo[ks]):"v"(vb),"i"(d0*4096+ks*1024):"memory");
      asm volatile("ds_read_b64_tr_b16 %0,%1 offset:%c2":"=&v"(hi[ks]):"v"(vb),"i"(d0*4096+ks*1024+512):"memory");}
    asm volatile("s_waitcnt lgkmcnt(0)":::"memory");SBAR();
    #define PK(k) (bf16x8){lo[k][0],lo[k][1],lo[k][2],lo[k][3],hi[k][0],hi[k][1],hi[k][2],hi[k][3]}
    o[d0]=__builtin_amdgcn_mfma_f32_32x32x16_bf16(pa0,PK(0),o[d0],0,0,0);
    o[d0]=__builtin_amdgcn_mfma_f32_32x32x16_bf16(pa1,PK(1),o[d0],0,0,0);
    o[d0]=__builtin_amdgcn_mfma_f32_32x32x16_bf16(pa2,PK(2),o[d0],0,0,0);
    o[d0]=__builtin_amdgcn_mfma_f32_32x32x16_bf16(pa3,PK(3),o[d0],0,0,0);
    #undef PK
  }
}

#ifndef ATTN_STORE16
#define ATTN_STORE16(p,v) (*(u32x4*)(p)=(v))
#endif
template<int THRL> __device__ __forceinline__ void attn_unit(int b,int h,int qb,const bf16*Q,const bf16*__restrict__ K,const bf16*__restrict__ V,bf16*O,const bf16*GT,const unsigned*MK,lds_cfptr dl,char*shm,const int tid){
  const int lane=tid&63,r32=lane&31,hi=lane>>5; const int wid=__builtin_amdgcn_readfirstlane(tid>>6);
  const long rowbase=(long)b*SEQ; const int q0=qb*QB;
  const bf16*Qw=Q+(rowbase+q0+wid*QBLK)*DM+h*D;
  const bf16*Kh=K+rowbase*DM+h*D,*Vh=V+rowbase*DM+h*D;
  const unsigned lds0=(unsigned)(uintptr_t)shm;
  float*wsf=(float*)(shm+LDS_WS)+wid*64;
  const bf16*ksrc=Kh+(long)lane*DM+wid*8;
  const bf16*vsrc=Vh+(long)(16*(wid&3)+(lane>>2))*DM+(wid>>2)*32+(lane&3)*8;
  const unsigned kdst=lds0+LDS_K+wid*1024, vdst=lds0+LDS_V+wid*1024;
  #define DMA_K(t,slot) glds16(ksrc+(long)(t)*KVBLK*DM,(unsigned)__builtin_amdgcn_readfirstlane(kdst+(slot)))
  #define DMA_V(t,slot) glds16(vsrc+(long)(t)*KVBLK*DM,(unsigned)__builtin_amdgcn_readfirstlane(vdst+(slot)))
  const int vb0=(int)(lds0+LDS_V)+((lane>>4)&1)*32+(lane&3)*8+(4*hi+((lane&15)>>2))*64;
  const char*Kbase=shm+LDS_K; bf16x8 kf[8];
  const lds_cptr shm3=(lds_cptr)shm; const lds_cptr kp0=shm3+LDS_K+hi*1024+r32*16; const lds_cptr vp0=shm3+LDS_V+((lane>>4)&1)*32+(lane&3)*8+(4*hi+((lane&15)>>2))*64;
  const int NT=(q0+QB)/KVBLK;
  DMA_K(0,0);DMA_V(0,0);DMA_K(1,SLOTB);
  const __attribute__((address_space(3))) char* shm3q=(const __attribute__((address_space(3))) char*)shm;
  bf16x8 qr[4];
  #pragma unroll
  for(int d0=0;d0<4;++d0)qr[d0]=*reinterpret_cast<const bf16x8*>(&Qw[(long)r32*DM+d0*16+hi*8]);
  const __attribute__((address_space(3))) bf16x8* qls=(const __attribute__((address_space(3))) bf16x8*)(shm3q+LDS_QST+wid*4096)+lane;
  #pragma unroll
  for(int d0=0;d0<4;++d0)((__attribute__((address_space(3))) bf16x8*)qls)[64*d0]=qr[d0];
  float mhat=0.f,l_reg=0.f;f32x16 o[2];o[0]=f32x16{};o[1]=f32x16{};float nmh=0.f;
  const int tq=q0+wid*QBLK+r32;
  const unsigned*mbase=MK+((size_t)(b*256+(q0>>5)+wid)*128)*64;
  unsigned bits_cur=mbase[lane],bits_next=mbase[64+lane];
  #define CMASK(P0,P1,t) do{ if((t)>=NT-6)biasadd(P0,P1,(t),tq,hi,dl,h);}while(0)
  bool resc=false;
  #define START(P0,P1) do{ const float rm=rowmax(P0,P1); resc=false; \
    { const float dl=rm; mhat=fadd_s(mhat,dl); \
      _Pragma("unroll") for(int r=0;r<16;++r){P0[r]=fsub_s(P0[r],dl);P1[r]=fsub_s(P1[r],dl);} \
      nmh=-mhat; } \
    _Pragma("unroll") for(int r=0;r<16;++r)P0[r]=mand(__builtin_amdgcn_exp2f(P0[r]),bits_cur,r); }while(0)
  #define RESC() do{ if(resc){ asm volatile("s_waitcnt lgkmcnt(0)":::"memory"); \
      _Pragma("unroll") for(int d_=0;d_<2;++d_) _Pragma("unroll") for(int r=0;r<16;++r)o[d_][r]*=wsf[crow(r,hi)]; } }while(0)
  f32x16 pA0,pA1,pB0,pB1;
  int sl_prev=0,sl_cur=0,sl_next=SLOTB;
  #define ROT() do{sl_prev=sl_cur;sl_cur=sl_next;sl_next=(sl_next==(NSLOT-1)*SLOTB)?0:sl_next+SLOTB;}while(0)
  DMA_K(2,2*SLOTB);
  WAIT_BAR(3);
  { const f32x16 zc=f32x16{}; qkt(pA0,pA1,Kbase,qr,zc,r32,hi); }asm volatile("s_nop 15\n\ts_nop 7":"+v"(pA0),"+v"(pA1));CMASK(pA0,pA1,0);
  START(pA0,pA1);
  _Pragma("unroll") for(int r=0;r<16;++r)pA1[r]=mand(__builtin_amdgcn_exp2f(pA1[r]),bits_cur,16+r);
  WAIT_BAR(0);
  DMA_K(3,0);DMA_V(1,SLOTB);
  ROT();
  kload8(kf,kp0+sl_cur);
  WAIT_BAR(2);
  u32x2m mk01,mk23,mk45,mk67;
  s16x4 vlo[8],vhi[8]; u32x4 pw0,pw1,pw2,pw3; bf16x8 qa_=qls[0],qb_;
  #define PKW(P,B) cvtpk_s(P[B],P[B+1])
  #define PAF(k) __builtin_bit_cast(bf16x8,pw##k)
  #define VFR(i) (bf16x8){vlo[i][0],vlo[i][1],vlo[i][2],vlo[i][3],vhi[i][0],vhi[i][1],vhi[i][2],vhi[i][3]}
  #define PIN(x) asm volatile("":"+v"(x))
  #define MX3(a,b,c) __builtin_fmaxf(__builtin_fmaxf((a),(b)),(c))
  #define GAPA(MF,A0,A1,A2,A3,W0,W1,PW) do{ MF; sacc+=A0; sacc+=A1; sacc+=A2; sacc+=A3; PIN(sacc); W0; W1; PIN(PW); SBAR(); }while(0)
  #define EX(v) __builtin_amdgcn_exp2f(v)
  #define MKD(e) (((e)>>2)==0?mk01[0]:((e)>>2)==1?mk01[1]:((e)>>2)==2?mk23[0]:((e)>>2)==3?mk23[1]:((e)>>2)==4?mk45[0]:((e)>>2)==5?mk45[1]:((e)>>2)==6?mk67[0]:mk67[1])
  #define GAPB(MF,X,B,MB) do{ MF; { const unsigned md_=MKD((MB)+(B)); X[B]=mands<0>(EX(X[B]),md_); X[B+1]=mands<1>(EX(X[B+1]),md_); X[B+2]=mands<2>(EX(X[B+2]),md_); X[B+3]=mands<3>(EX(X[B+3]),md_); } PIN(X); SBAR(); }while(0)
  #define VRD(i) do{ vlo[i]=vtr(vp_+(((i)>>2)*4096+((i)&3)*1024)); vhi[i]=vtr(vp_+(((i)>>2)*4096+((i)&3)*1024+512)); }while(0)
  #define KRD(G,j) do{ if(G){ kload2(kf,kp0+sl_next,j); SBAR(); } }while(0)
  #define STEP(C0,C1,P0,P1,t,GK,GV,GL) do{ SBAR(); \
    bits_cur=bits_next; if(GV){ bits_next=mbase[64*((t)+1)+lane]; } \
    { const lds_cptr tb_=shm3+LDS_TAB; mk01=*(const __attribute__((address_space(3))) u32x2m*)(tb_+((bits_cur&0xffu)<<3)); mk23=*(const __attribute__((address_space(3))) u32x2m*)(tb_+(((bits_cur>>8)&0xffu)<<3)); \
      mk45=*(const __attribute__((address_space(3))) u32x2m*)(tb_+(((bits_cur>>16)&0xffu)<<3)); mk67=*(const __attribute__((address_space(3))) u32x2m*)(tb_+((bits_cur>>24)<<3)); } \
    f32x16 negm; { float nm_=nmh; asm volatile("":"+v"(nm_)); _Pragma("unroll") for(int r=0;r<16;++r)negm[r]=nm_; } \
    const lds_cptr vp_=vp0+sl_prev; \
    VRD(0); qb_=qls[64]; SBAR(); float sacc=(P0[0]+P0[1]); \
    GAPA(C0=__builtin_amdgcn_mfma_f32_32x32x16_bf16(kf[0],qa_,negm,0,0,0), P0[2],P0[3],P0[4],P0[5],     pw0[0]=PKW(P0,0), pw0[1]=PKW(P0,2), pw0); \
    VRD(4); SBAR(); GAPA(C1=__builtin_amdgcn_mfma_f32_32x32x16_bf16(kf[1],qa_,negm,0,0,0), P0[6],P0[7],P0[8],P0[9],     pw0[2]=PKW(P0,4), pw0[3]=PKW(P0,6), pw0); \
    VRD(1); qa_=qls[128]; SBAR(); GAPA(C0=__builtin_amdgcn_mfma_f32_32x32x16_bf16(kf[2],qb_,C0,0,0,0),   P0[10],P0[11],P0[12],P0[13], pw1[0]=PKW(P0,8), pw1[1]=PKW(P0,10), pw1); \
    VRD(5); SBAR(); GAPA(C1=__builtin_amdgcn_mfma_f32_32x32x16_bf16(kf[3],qb_,C1,0,0,0),   P0[14],P0[15],P1[0],P1[1],   pw1[2]=PKW(P0,12),pw1[3]=PKW(P0,14), pw1); \
    VRD(2); qb_=qls[192]; SBAR(); GAPA(C0=__builtin_amdgcn_mfma_f32_32x32x16_bf16(kf[4],qa_,C0,0,0,0),   P1[2],P1[3],P1[4],P1[5],     pw2[0]=PKW(P1,0), pw2[1]=PKW(P1,2), pw2); \
    VRD(6); SBAR(); GAPA(C1=__builtin_amdgcn_mfma_f32_32x32x16_bf16(kf[5],qa_,C1,0,0,0),   P1[6],P1[7],P1[8],P1[9],     pw2[2]=PKW(P1,4), pw2[3]=PKW(P1,6), pw2); \
    VRD(3); qa_=qls[0]; SBAR(); GAPA(C0=__builtin_amdgcn_mfma_f32_32x32x16_bf16(kf[6],qb_,C0,0,0,0),   P1[10],P1[11],P1[12],P1[13], pw3[0]=PKW(P1,8), pw3[1]=PKW(P1,10), pw3); \
    VRD(7); SBAR(); GAPA(C1=__builtin_amdgcn_mfma_f32_32x32x16_bf16(kf[7],qb_,C1,0,0,0),   P1[14],P1[15],0.f,0.f,       pw3[2]=PKW(P1,12),pw3[3]=PKW(P1,14), pw3); \
    l_reg+=sacc; \
    if(GK){DMA_K((t)+3,sl_cur);} if(GV){DMA_V((t)+1,sl_next);} \
    CMASK(C0,C1,t); \
    { float a=MX3(C0[0],C0[1],C1[0]),b=MX3(C0[2],C0[3],C1[1]); a=MX3(a,C1[2],C1[3]); \
      _Pragma("unroll") for(int r=4;r<16;r+=4){a=MX3(a,C0[r],C0[r+1]);b=MX3(b,C0[r+2],C0[r+3]);a=MX3(a,C1[r],C1[r+1]);b=MX3(b,C1[r+2],C1[r+3]);} \
      float rm=__builtin_fmaxf(a,b); { auto rr=__builtin_amdgcn_permlane32_swap(__float_as_uint(rm),__float_as_uint(rm),false,false); rm=__builtin_fmaxf(__uint_as_float(rr[0]),__uint_as_float(rr[1])); } \
      resc=false; \
      if(__builtin_expect(__any(rm>(float)THRL),0)){ const float dl=__builtin_fmaxf(rm,0.f); mhat+=dl; \
        _Pragma("unroll") for(int r=0;r<16;++r){C0[r]-=dl;C1[r]-=dl;} \
        nmh=-mhat; \
        const float f=__builtin_amdgcn_exp2f(-dl); l_reg*=f; if(hi==0)wsf[r32]=f; resc=true; } } \
    SBAR(); \
    GAPB(o[0]=__builtin_amdgcn_mfma_f32_32x32x16_bf16(PAF(0),VFR(0),o[0],0,0,0), C0,0,0); \
    GAPB(o[1]=__builtin_amdgcn_mfma_f32_32x32x16_bf16(PAF(0),VFR(4),o[1],0,0,0), C0,4,0); \
    KRD(GL,0); GAPB(o[0]=__builtin_amdgcn_mfma_f32_32x32x16_bf16(PAF(1),VFR(1),o[0],0,0,0), C0,8,0); \
    KRD(GL,1); GAPB(o[1]=__builtin_amdgcn_mfma_f32_32x32x16_bf16(PAF(1),VFR(5),o[1],0,0,0), C0,12,0); \
    KRD(GL,2); GAPB(o[0]=__builtin_amdgcn_mfma_f32_32x32x16_bf16(PAF(2),VFR(2),o[0],0,0,0), C1,0,16); \
    KRD(GL,3); GAPB(o[1]=__builtin_amdgcn_mfma_f32_32x32x16_bf16(PAF(2),VFR(6),o[1],0,0,0), C1,4,16); \
    GAPB(o[0]=__builtin_amdgcn_mfma_f32_32x32x16_bf16(PAF(3),VFR(3),o[0],0,0,0), C1,8,16); \
    GAPB(o[1]=__builtin_amdgcn_mfma_f32_32x32x16_bf16(PAF(3),VFR(7),o[1],0,0,0), C1,12,16); \
    }while(0)
  int t=1;
  #undef CMASK
  #define CMASK(P0,P1,t) do{}while(0)
  for(;t+7<NT;t+=2){
    STEP(pB0,pB1,pA0,pA1,t,true,true,true);     WAIT_BAR(2); RESC(); ROT();
    STEP(pA0,pA1,pB0,pB1,t+1,true,true,true);   WAIT_BAR(2); RESC(); ROT();
  }
  #undef CMASK
  #define CMASK(P0,P1,t) do{ if((t)>=NT-6)biasadd(P0,P1,(t),tq,hi,dl,h);}while(0)
  #define ENDW(tt) do{ if((tt)+3<NT){WAIT_BAR(2);} else if((tt)+2<NT){WAIT_BAR(1);} else {WAIT_BAR(0);} }while(0)
  for(;t+1<NT;t+=2){
    STEP(pB0,pB1,pA0,pA1,t,(t+3<NT),(t+1<NT),(t+1<NT));       ENDW(t);   RESC(); ROT();
    STEP(pA0,pA1,pB0,pB1,t+1,(t+4<NT),(t+2<NT),(t+2<NT));     ENDW(t+1); RESC(); ROT();
  }
  STEP(pB0,pB1,pA0,pA1,NT-1,false,false,false); RESC();
  { float sacc=pB0[0]+pB0[1]; _Pragma("unroll") for(int r=2;r<16;++r)sacc+=pB0[r]; _Pragma("unroll") for(int r=0;r<16;++r)sacc+=pB1[r]; l_reg+=sacc;
    pw0=(u32x4){PKW(pB0,0),PKW(pB0,2),PKW(pB0,4),PKW(pB0,6)};pw1=(u32x4){PKW(pB0,8),PKW(pB0,10),PKW(pB0,12),PKW(pB0,14)};pw2=(u32x4){PKW(pB1,0),PKW(pB1,2),PKW(pB1,4),PKW(pB1,6)};pw3=(u32x4){PKW(pB1,8),PKW(pB1,10),PKW(pB1,12),PKW(pB1,14)};
    SBAR(); pv(o,vb0+sl_cur,PAF(0),PAF(1),PAF(2),PAF(3)); }
  #undef PKW
  #undef PAF
  #undef VFR
  #undef PIN
  #undef MX3
  #undef GAPA
  #undef GAPB
  #undef EX
  #undef VRD
  #undef KRD
  #undef STEP
  #undef ENDW
  {auto rr=__builtin_amdgcn_permlane32_swap(__float_as_uint(l_reg),__float_as_uint(l_reg),false,false);l_reg=__uint_as_float(rr[0])+__uint_as_float(rr[1]);}
  if(hi==0)wsf[32+r32]=l_reg;asm volatile("s_waitcnt lgkmcnt(0)":::"memory");
  float rli[16];
  #pragma unroll
  for(int r=0;r<16;++r)rli[r]=__builtin_amdgcn_rcpf(wsf[32+crow(r,hi)]);
  bf16*Ow=O+(rowbase+q0+wid*QBLK)*DMO+h*D; const bf16*Gw=GT+(rowbase+q0+wid*QBLK)*DM+h*D;
  { bf16*stg=(bf16*)(shm+LDS_OST)+wid*2048;
    #pragma unroll
    for(int r=0;r<16;++r){const int orow=crow(r,hi);
      #pragma unroll
      for(int d0=0;d0<2;++d0)stg[orow*64+d0*32+r32]=__float2bfloat16(o[d0][r]*rli[r]);}
    asm volatile("s_waitcnt lgkmcnt(0)":::"memory");
    #pragma unroll
    for(int i=0;i<4;++i){const int row=i*8+(lane>>3),ch=lane&7; const u32x4 v=*(const u32x4*)(stg+row*64+ch*8); const u32x4 g=*(const u32x4*)(Gw+(long)row*DM+ch*8); u32x4 w;
      #pragma unroll
      for(int k=0;k<4;++k){ const float g0=__uint_as_float(g[k]<<16),g1=__uint_as_float(g[k]&0xffff0000u); const float v0=__uint_as_float(v[k]<<16),v1=__uint_as_float(v[k]&0xffff0000u);
        w[k]=cvtpk_s(v0*(g0/(1.0f+__expf(-g0))),v1*(g1/(1.0f+__expf(-g1)))); }
      ATTN_STORE16(Ow+(long)row*DMO+ch*8,w);} }
  asm volatile("s_waitcnt lgkmcnt(0)\n\ts_barrier":::"memory");
  #undef DMA_K
  #undef DMA_V
  #undef CMASK
  #undef START
  #undef RESC
  #undef ROT
}
constexpr int ATTN_LDS_BYTES=LDS_BYTES;
struct AttnTensors { const bf16* Q; const bf16* K; const bf16* V; bf16* O; const bf16* GT; const unsigned* MK; };
struct AttnUnit { int bh; int qb; };
struct StaticOrder {
  int wg,G;
  __device__ __forceinline__ explicit StaticOrder(int grid,int block):wg(block),G(grid){}
  __device__ __forceinline__ bool next(int i,AttnUnit&u)const{ const int p=wg+(i>>1)*G; if(p>=768)return false; const int s=p&15; u.bh=p>>4; u.qb=(i&1)?31-s:s; return true; }
  __device__ __forceinline__ void a_ready(const AttnUnit&)const{}
  __device__ __forceinline__ void done(const AttnUnit&)const{}
};
template<class Sched,int THRL=8> __device__ __forceinline__ void attn_phase(char*lds,const AttnTensors&T,lds_cfptr dl,const Sched&S,int tid){
  AttnUnit u;
  for(int i=0;S.next(i,u);++i){ asm volatile("":"+v"(tid)); S.a_ready(u); attn_unit<THRL>(u.bh/NHEAD,u.bh%NHEAD,u.qb,T.Q,T.K,T.V,T.O,T.GT,T.MK,dl,lds,tid); S.done(u); }
}
#undef SBAR
#undef WAIT_BAR
}

constexpr int NWAVES = 8, NTHR = 512;
constexpr int BATCH = 8, SEQ = 8192, DM = 1024, DEPTH = 4, M = BATCH * SEQ;
constexpr int IN_COLS = 3380, NP = 3584;
constexpr float EPS = 1e-6f;
constexpr int N_GQ = 0, N_GK = 192, N_GV = 384, N_GG = 768, N_DQ = 1152, N_DK = 1536, N_DV = 1920, N_DG = 2304, N_PU = 2688, N_PG = 2944, N_QI = 3200, N_KI = 3328, N_GZ = 3360, N_WI = 3376;
constexpr float LOG2E = 1.4426950408889634f;
constexpr size_t MiB = 1u << 20;
constexpr size_t WS_CTL = 0, CTL_ZERO_BYTES = 1 * MiB;
constexpr size_t WS_WIN = 2 * MiB;
constexpr size_t WS_WOUT = 32 * MiB;
constexpr size_t WS_XB = 48 * MiB;
constexpr size_t WS_P = 176 * MiB;
constexpr size_t WS_MASK = 624 * MiB;
constexpr size_t WS_GOP = 688 * MiB;
constexpr size_t WS_XA = 832 * MiB;
constexpr size_t WS_RSC = 44 * MiB;
constexpr size_t WS_RS = 40 * MiB;
constexpr size_t WS_ZW = 960 * MiB;
constexpr size_t WS_KC = 968 * MiB;
constexpr size_t WS_END = 972 * MiB;
constexpr int CW_BAR = 4096, CW_QUEUE = 8192;
constexpr int RING_BYTES = 131072, LDSCTL_OFF = RING_BYTES, MISC_OFF = LDSCTL_OFF + 320, LDS_BYTES = 147456;

#define GAS __attribute__((address_space(1)))
#define LAS __attribute__((address_space(3)))
typedef unsigned short bf16;
typedef unsigned v4u __attribute__((ext_vector_type(4)));
typedef unsigned v2u __attribute__((ext_vector_type(2)));
typedef float f32x4 __attribute__((ext_vector_type(4)));
typedef GAS unsigned gu32;
#define RLX_AGENT __ATOMIC_RELAXED, __HIP_MEMORY_SCOPE_AGENT
__device__ __forceinline__ unsigned f2bf(float f) { unsigned u = __builtin_bit_cast(unsigned, f); return (u + 0x7fffu + ((u >> 16) & 1u)) >> 16; }
__device__ __forceinline__ unsigned pk2(float lo, float hi) { return f2bf(lo) | (f2bf(hi) << 16); }
__device__ __forceinline__ float bf2f(unsigned short b) { return __builtin_bit_cast(float, (unsigned)b << 16); }
__device__ __forceinline__ float bflo(unsigned w) { return __builtin_bit_cast(float, w << 16); }
__device__ __forceinline__ float bfhi(unsigned w) { return __builtin_bit_cast(float, w & 0xffff0000u); }
__device__ __forceinline__ float shx(float v, int o, int lane) { return __builtin_bit_cast(float, __builtin_amdgcn_ds_bpermute((lane ^ o) << 2, __builtin_bit_cast(int, v))); }
__device__ __forceinline__ int shdn(int v, int o, int lane) { return __builtin_amdgcn_ds_bpermute(((lane + o) & 63) << 2, v); }
__device__ __forceinline__ float wave_sum(float v, int lane) {
#pragma unroll
    for (int o = 1; o < 64; o <<= 1) v += shx(v, o, lane);
    return v;
}
__device__ __forceinline__ float silu_f(float x) { return x / (1.0f + __expf(-x)); }

__constant__ unsigned char T5B[128] = {0, 1, 2, 3, 4, 5, 6, 7, 8, 9, 10, 11, 12, 13, 14, 15, 16, 16, 16, 17, 17, 18, 18, 18, 19, 19, 19, 20, 20, 20, 20, 21, 21, 21, 21, 22, 22, 22, 22, 22, 23, 23, 23, 23, 23, 23, 24, 24, 24, 24, 24, 24, 25, 25, 25, 25, 25, 25, 25, 26, 26, 26, 26, 26, 26, 26, 26, 27, 27, 27, 27, 27, 27, 27, 27, 27, 27, 28, 28, 28, 28, 28, 28, 28, 28, 28, 28, 29, 29, 29, 29, 29, 29, 29, 29, 29, 29, 29, 29, 30, 30, 30, 30, 30, 30, 30, 30, 30, 30, 30, 30, 30, 30, 31, 31, 31, 31, 31, 31, 31, 31, 31, 31, 31, 31, 31, 31, 31};
__device__ __forceinline__ int t5_bucket(int rel) { return rel >= 128 ? 31 : (int)T5B[rel]; }

#define XB_TMO      128
#define XB_XCNT(j)  (256  + 64 * (j))
#define XB_XSUB(j)  (1280 + 64 * (j))
#define XB_XGEN(j)  (2304 + 64 * (j))
#define XB_TOP      3328
#define XB_TOPGEN   3392
#define XCD_BAR_WORDS 3456
#define XB_SPIN_CAP (1u << 22)

__device__ __forceinline__ unsigned xb_ld(unsigned* p)              { return __hip_atomic_load(p, __ATOMIC_RELAXED, __HIP_MEMORY_SCOPE_AGENT); }
__device__ __forceinline__ unsigned xb_add(unsigned* p, unsigned v) { return __hip_atomic_fetch_add(p, v, __ATOMIC_RELAXED, __HIP_MEMORY_SCOPE_AGENT); }
__device__ __forceinline__ unsigned xb_xcc_id() { return (unsigned)__builtin_amdgcn_s_getreg((3 << 11) | 20) & 0xFu; }
#define XB_SPIN(cond, bar) do { unsigned _sp = 0; while (cond) { __builtin_amdgcn_s_sleep(1); \
    if ((++_sp & 255u) == 0u) { if (xb_ld(&(bar)[XB_TMO])) break; if (_sp > XB_SPIN_CAP) { atomicAdd(&(bar)[XB_TMO], 1u); break; } } } } while (0)

struct XcdBarrier {
    unsigned* bar; unsigned x;
    volatile LAS unsigned* st;
};

__device__ __forceinline__ XcdBarrier xcd_barrier_post(unsigned* bar, volatile LAS unsigned* st) {
    XcdBarrier b; b.bar = bar; b.x = xb_xcc_id(); b.st = st;
    if (threadIdx.x == 0) (void)xb_add(&bar[XB_XCNT(b.x)], 1u);
    return b;
}
__device__ __forceinline__ void xcd_barrier_complete(unsigned* bar, unsigned x, unsigned& nloc, unsigned& nx) {
    const unsigned G = gridDim.x * gridDim.y * gridDim.z;
    unsigned sum, cnt, mine, sp = 0u;
    for (;;) {
        sum = 0u; cnt = 0u; mine = 0u;
#pragma unroll
        for (unsigned j = 0; j < 16; ++j) { const unsigned c = xb_ld(&bar[XB_XCNT(j)]); sum += c; cnt += (c > 0u) ? 1u : 0u; mine = (j == x) ? c : mine; }
        if (sum == G) break;
        __builtin_amdgcn_s_sleep(1);
        if ((++sp & 255u) == 0u) { if (xb_ld(&bar[XB_TMO])) break; if (sp > XB_SPIN_CAP) { atomicAdd(&bar[XB_TMO], 1u); break; } }
    }
    nloc = mine > 0u ? mine : 1u; nx = cnt > 0u ? cnt : 1u;
}

__device__ __forceinline__ void xcd_barrier(const XcdBarrier& b) {
    asm volatile("s_waitcnt vmcnt(0)" ::: "memory");
    __syncthreads();
    if (threadIdx.x == 0) {
        unsigned* bar = b.bar;
        __builtin_amdgcn_s_waitcnt(0);
        unsigned nloc = b.st[0], nx = b.st[1];
        if (nloc == 0u) { xcd_barrier_complete(bar, b.x, nloc, nx); b.st[0] = nloc; b.st[1] = nx; }
        const unsigned old = xb_add(&bar[XB_XSUB(b.x)], 1u);
        const unsigned gen = old / nloc;
        if (old + 1u == (gen + 1u) * nloc) {
            __builtin_amdgcn_fence(__ATOMIC_RELEASE, "agent");
            asm volatile("s_waitcnt vmcnt(0)" ::: "memory");
            const unsigned og = xb_add(&bar[XB_TOP], 1u);
            const unsigned tg = og / nx;
            if (og + 1u == (tg + 1u) * nx) xb_add(&bar[XB_TOPGEN], 1u);
            else XB_SPIN(xb_ld(&bar[XB_TOPGEN]) == tg, bar);
            __builtin_amdgcn_fence(__ATOMIC_ACQUIRE, "agent");
            xb_add(&bar[XB_XGEN(b.x)], 1u);
            asm volatile("s_waitcnt vmcnt(0)" ::: "memory");
        } else {
            XB_SPIN(xb_ld(&bar[XB_XGEN(b.x)]) == gen, bar);
            __builtin_amdgcn_fence(__ATOMIC_ACQUIRE, "agent");
            asm volatile("s_waitcnt vmcnt(0)" ::: "memory");
        }
    }
    __syncthreads();
}
#ifndef IDX_NOFALLBACK
#define IDX_NOFALLBACK 0
#endif
#ifndef REP_RES
#define REP_RES 1
#endif
#ifndef REP_PATCH
#define REP_PATCH 1
#endif
#ifndef REP_P1
#define REP_P1 1
#endif
#ifndef REP_P3
#define REP_P3 1
#endif
#ifndef REP_HEAD
#define REP_HEAD 1
#endif
#ifndef REP_RES
#define REP_RES 1
#endif
#ifndef REP_P2
#define REP_P2 1
#endif
#ifndef REP_RANK
#define REP_RANK 1
#endif
#ifndef IDX_PRIO
#define IDX_PRIO 1
#endif
#ifndef IDX_PKFMA
#define IDX_PKFMA 0
#endif
#ifndef PROBE_MFMA2
#define PROBE_MFMA2 0
#endif
#ifndef PROBE_ADD2
#define PROBE_ADD2 0
#endif
#ifndef IDX_ASMFMA
#define IDX_ASMFMA 0
#endif
#ifndef IDX_ASMBIN
#define IDX_ASMBIN 0
#endif
namespace idxb {
typedef short bf16x8 __attribute__((ext_vector_type(8)));
typedef float f32x16 __attribute__((ext_vector_type(16)));
constexpr int ZBIN = 0, NBINS = 512, CAP = 256;
constexpr int L_HIST = 0, L_ZC = 65536, L_PAR = 81920, L_KBUF = 83968, L_XT = 116736;
enum { P_BSTAR = 0, P_KK, P_CCNT, P_TAU, P_CUT, P_MODE, P_TSTAR, P_RSTAR, P_OVF, P_NRANK, P_PRE, P_XL, P_XU };
__device__ __forceinline__ unsigned lds_add(unsigned* p, unsigned v) { return __hip_atomic_fetch_add((__attribute__((address_space(3))) unsigned*)p, v, __ATOMIC_RELAXED, __HIP_MEMORY_SCOPE_WORKGROUP); }
__device__ __forceinline__ int crow(int r, int hi) { return (r & 3) + 8 * (r >> 2) + 4 * hi; }
struct QFrag { bf16x8 q[4][2]; float w[4]; };
__device__ __forceinline__ f32x16 score_sub(const bf16x8 k0, const bf16x8 k1, const QFrag& Q) {
    f32x16 acc;
#pragma unroll
    for (int r = 0; r < 16; ++r) acc[r] = 0.f;
    const f32x16 zz = {0.f, 0.f, 0.f, 0.f, 0.f, 0.f, 0.f, 0.f, 0.f, 0.f, 0.f, 0.f, 0.f, 0.f, 0.f, 0.f};
    float INFV; asm("s_mov_b32 %0, 0x7f800000" : "=s"(INFV));
#pragma unroll
    for (int hp = 0; hp < 2; ++hp) {
        f32x16 d0 = __builtin_amdgcn_mfma_f32_32x32x16_bf16(k0, Q.q[2 * hp][0], zz, 0, 0, 0), d1 = __builtin_amdgcn_mfma_f32_32x32x16_bf16(k0, Q.q[2 * hp + 1][0], zz, 0, 0, 0);
        d0 = __builtin_amdgcn_mfma_f32_32x32x16_bf16(k1, Q.q[2 * hp][1], d0, 0, 0, 0); d1 = __builtin_amdgcn_mfma_f32_32x32x16_bf16(k1, Q.q[2 * hp + 1][1], d1, 0, 0, 0);
#if PROBE_MFMA2
        { f32x16 e0 = __builtin_amdgcn_mfma_f32_32x32x16_bf16(k0, Q.q[2 * hp][1], zz, 0, 0, 0); e0 = __builtin_amdgcn_mfma_f32_32x32x16_bf16(k1, Q.q[2 * hp][0], e0, 0, 0, 0);
          e0 = __builtin_amdgcn_mfma_f32_32x32x16_bf16(k0, Q.q[2 * hp + 1][1], e0, 0, 0, 0); e0 = __builtin_amdgcn_mfma_f32_32x32x16_bf16(k1, Q.q[2 * hp + 1][0], e0, 0, 0, 0); asm volatile("" :: "v"(e0)); }
#endif
#if IDX_PKFMA
        { typedef float f32x2 __attribute__((ext_vector_type(2)));
            const f32x2 wa = {Q.w[2 * hp], Q.w[2 * hp]}, wb = {Q.w[2 * hp + 1], Q.w[2 * hp + 1]};
#pragma unroll
            for (int r = 0; r < 16; r += 2) { const f32x2 ra = {__builtin_amdgcn_fmed3f(d0[r], 0.f, INFV), __builtin_amdgcn_fmed3f(d0[r + 1], 0.f, INFV)}, rb = {__builtin_amdgcn_fmed3f(d1[r], 0.f, INFV), __builtin_amdgcn_fmed3f(d1[r + 1], 0.f, INFV)};
                f32x2 ac = {acc[r], acc[r + 1]}; ac = __builtin_elementwise_fma(wa, ra, ac); ac = __builtin_elementwise_fma(wb, rb, ac); acc[r] = ac[0]; acc[r + 1] = ac[1]; } }
#else
#pragma unroll
        for (int r = 0; r < 16; ++r) {
#if IDX_ASMFMA
            const float r0 = __builtin_amdgcn_fmed3f(d0[r], 0.f, INFV), r1 = __builtin_amdgcn_fmed3f(d1[r], 0.f, INFV); float a0 = acc[r], a1;
            if (hp == 0) asm("v_mul_f32 %0, %1, %2" : "=v"(a0) : "v"(Q.w[0]), "v"(r0)); else asm("v_fma_f32 %0, %1, %2, %3" : "=v"(a0) : "v"(Q.w[2]), "v"(r0), "v"(acc[r]));
            asm("v_fma_f32 %0, %1, %2, %3" : "=v"(a1) : "v"(Q.w[2 * hp + 1]), "v"(r1), "v"(a0)); acc[r] = a1;
#else
            acc[r] = __builtin_fmaf(Q.w[2 * hp + 1], __builtin_amdgcn_fmed3f(d1[r], 0.f, INFV), __builtin_fmaf(Q.w[2 * hp], __builtin_amdgcn_fmed3f(d0[r], 0.f, INFV), acc[r]));
#endif
        }
#endif
    }
    return acc;
}
constexpr int G0 = (int)(0x3F800000u >> 18);
typedef __attribute__((address_space(3))) unsigned lds_u32;
__device__ __forceinline__ void hist_add(unsigned hb, float x, unsigned inc) {
    const float xc = __builtin_amdgcn_fmed3f(x, -254.0f, 254.0f);
#if IDX_ASMBIN
    float os, y; const unsigned m = 0x7fffffffu;
    asm("v_bfi_b32 %0, %1, 1.0, %2" : "=v"(os) : "s"(m), "v"(xc));
    asm("v_add_f32 %0, %1, %2" : "=v"(y) : "v"(xc), "v"(os));
    unsigned sh; asm("v_lshrrev_b32 %0, 18, %1" : "=v"(sh) : "v"(y));
    const unsigned a = hb + (sh << 2);
#else
    const float y = xc + __uint_as_float((__float_as_uint(xc) & 0x80000000u) | 0x3F800000u);
    const unsigned a = hb + ((__float_as_uint(y) >> 18) << 2);
#endif
    __hip_atomic_fetch_add((lds_u32*)a, inc, __ATOMIC_RELAXED, __HIP_MEMORY_SCOPE_WORKGROUP);
#if PROBE_ADD2
    __hip_atomic_fetch_add((lds_u32*)(a ^ 64u), 0u, __ATOMIC_RELAXED, __HIP_MEMORY_SCOPE_WORKGROUP);
#endif
}
__device__ __forceinline__ int hword(int q, int h) { return ((h >> 8) << 13) + q * 256 + (h & 255); }
__device__ __forceinline__ int rank_to_bin(int k) { return k < 256 ? 255 - k : k; }
__device__ __forceinline__ float xthr(int ot) { if (ot == 0) return 0.f;
    const unsigned B = (unsigned)(G0 + ot) << 18; unsigned hi = __float_as_uint(__uint_as_float(B) - 1.0f), lo = 0u;
#pragma unroll 1
    for (int i = 0; i < 32; ++i) { const unsigned mid = lo + ((hi - lo) >> 1); if (__float_as_uint(__uint_as_float(mid) + 1.0f) >= B) hi = mid; else lo = mid; }
    return __uint_as_float(hi); }
__device__ __forceinline__ unsigned wave_or(unsigned v) { int x = (int)v;
    x |= __builtin_amdgcn_update_dpp(0, x, 0x111, 0xf, 0xf, true); x |= __builtin_amdgcn_update_dpp(0, x, 0x112, 0xf, 0xf, true);
    x |= __builtin_amdgcn_update_dpp(0, x, 0x114, 0xf, 0xf, true); x |= __builtin_amdgcn_update_dpp(0, x, 0x118, 0xf, 0xf, true);
    x |= __builtin_amdgcn_update_dpp(0, x, 0x142, 0xf, 0xf, true); x |= __builtin_amdgcn_update_dpp(0, x, 0x143, 0xf, 0xf, true);
    return (unsigned)__builtin_amdgcn_readlane(x, 63); }
__device__ __forceinline__ float sel32(const f32x16& a, const f32x16& b, int e) {
    const bool b0 = e & 1, b1 = e & 2, b2 = e & 4, b3 = e & 8, b4 = e & 16;
    float v0 = a[0], v1 = a[1], v2 = a[2], v3 = a[3], v4 = a[4], v5 = a[5], v6 = a[6], v7 = a[7], v8 = a[8], v9 = a[9], v10 = a[10], v11 = a[11], v12 = a[12], v13 = a[13], v14 = a[14], v15 = a[15], v16 = b[0], v17 = b[1], v18 = b[2], v19 = b[3], v20 = b[4], v21 = b[5], v22 = b[6], v23 = b[7], v24 = b[8], v25 = b[9], v26 = b[10], v27 = b[11], v28 = b[12], v29 = b[13], v30 = b[14], v31 = b[15];
    asm("" : "+v"(v0)); asm("" : "+v"(v1)); asm("" : "+v"(v2)); asm("" : "+v"(v3)); asm("" : "+v"(v4)); asm("" : "+v"(v5)); asm("" : "+v"(v6)); asm("" : "+v"(v7)); asm("" : "+v"(v8)); asm("" : "+v"(v9)); asm("" : "+v"(v10)); asm("" : "+v"(v11)); asm("" : "+v"(v12)); asm("" : "+v"(v13)); asm("" : "+v"(v14)); asm("" : "+v"(v15)); asm("" : "+v"(v16)); asm("" : "+v"(v17)); asm("" : "+v"(v18)); asm("" : "+v"(v19)); asm("" : "+v"(v20)); asm("" : "+v"(v21)); asm("" : "+v"(v22)); asm("" : "+v"(v23)); asm("" : "+v"(v24)); asm("" : "+v"(v25)); asm("" : "+v"(v26)); asm("" : "+v"(v27)); asm("" : "+v"(v28)); asm("" : "+v"(v29)); asm("" : "+v"(v30)); asm("" : "+v"(v31));
    const float p0 = b0 ? v1 : v0, p1 = b0 ? v3 : v2, p2 = b0 ? v5 : v4, p3 = b0 ? v7 : v6, p4 = b0 ? v9 : v8, p5 = b0 ? v11 : v10, p6 = b0 ? v13 : v12, p7 = b0 ? v15 : v14, p8 = b0 ? v17 : v16, p9 = b0 ? v19 : v18, p10 = b0 ? v21 : v20, p11 = b0 ? v23 : v22, p12 = b0 ? v25 : v24, p13 = b0 ? v27 : v26, p14 = b0 ? v29 : v28, p15 = b0 ? v31 : v30;
    const float q0 = b1 ? p1 : p0, q1 = b1 ? p3 : p2, q2 = b1 ? p5 : p4, q3 = b1 ? p7 : p6, q4 = b1 ? p9 : p8, q5 = b1 ? p11 : p10, q6 = b1 ? p13 : p12, q7 = b1 ? p15 : p14;
    const float r0 = b2 ? q1 : q0, r1 = b2 ? q3 : q2, r2 = b2 ? q5 : q4, r3 = b2 ? q7 : q6;
    const float s0 = b3 ? r1 : r0, s1 = b3 ? r3 : r2;
    return b4 ? s1 : s0; }
__device__ __forceinline__ unsigned spread_nib(unsigned x) { x = (x | (x << 8)) & 0x00FF00FFu; return (x | (x << 4)) & 0x0F0F0F0Fu; }


template <int HP, int MODE, bool NEXT>
__device__ __forceinline__ void pstage(f32x16& acc, const f32x16& dc0, const f32x16& dc1, f32x16& dn0, f32x16& dn1, const bf16x8 ka, const bf16x8 kb,
                                       const bf16x8 qa0, const bf16x8 qa1, const bf16x8 qb0, const bf16x8 qb1, const float wA, const float wB,
                                       const unsigned hb, const unsigned inc, const int s0, const int t, const int hi, const float XU, const float XL, unsigned& wn, unsigned& wl) {
    const f32x16 zz = {0.f, 0.f, 0.f, 0.f, 0.f, 0.f, 0.f, 0.f, 0.f, 0.f, 0.f, 0.f, 0.f, 0.f, 0.f, 0.f};
    float INFV; asm("s_mov_b32 %0, 0x7f800000" : "=s"(INFV));
#pragma unroll
    for (int c = 3; c >= 0; --c) {
        if (NEXT) {
            if (c == 3) dn0 = __builtin_amdgcn_mfma_f32_32x32x16_bf16(ka, qa0, zz, 0, 0, 0);
            else if (c == 2) dn1 = __builtin_amdgcn_mfma_f32_32x32x16_bf16(ka, qb0, zz, 0, 0, 0);
            else if (c == 1) dn0 = __builtin_amdgcn_mfma_f32_32x32x16_bf16(kb, qa1, dn0, 0, 0, 0);
            else dn1 = __builtin_amdgcn_mfma_f32_32x32x16_bf16(kb, qb1, dn1, 0, 0, 0);
            __builtin_amdgcn_sched_barrier(0);
        }
#pragma unroll
        for (int r = 4 * c + 3; r >= 4 * c; --r) {
            const float r0 = __builtin_amdgcn_fmed3f(dc0[r], 0.f, INFV), r1 = __builtin_amdgcn_fmed3f(dc1[r], 0.f, INFV);
            float x = __builtin_fmaf(wB, r1, __builtin_fmaf(wA, r0, HP == 0 ? 0.f : acc[r]));
            if (MODE == 4) { if (s0 + crow(r, hi) > t) x = -__builtin_inff(); }
            acc[r] = x;
            if (MODE == 1) hist_add(hb, x, inc);
            if (MODE == 2) { if (s0 + crow(r, hi) <= t) hist_add(hb, x, inc); }
            if (MODE == 3 || MODE == 4) { const float t1 = x - XU, t2 = x - XL; wn = __builtin_amdgcn_alignbit(wn, __float_as_uint(t1), 31); wl = __builtin_amdgcn_alignbit(wl, __float_as_uint(t2), 31); }
        }
        if (NEXT) __builtin_amdgcn_sched_barrier(0);
    }
}
__device__ __forceinline__ void index_unit(const unsigned short* P, const unsigned short* KC, unsigned* MK, unsigned* ZWg, unsigned char* lds, int b, int qt, int tid) {
    const int lane = tid & 63, wave = __builtin_amdgcn_readfirstlane(tid >> 6), r32 = lane & 31, hi = lane >> 5;
    unsigned* hist32 = (unsigned*)(lds + L_HIST); unsigned* cand_s = (unsigned*)(lds + L_HIST); unsigned* cand_i = (unsigned*)(lds + L_HIST + 32768);     unsigned* zc = (unsigned*)(lds + L_ZC); int* par = (int*)(lds + L_PAR);
    const int t = qt * 32 + r32; const size_t qrow = (size_t)b * SEQ + t;
    const int kt_max = (qt * 32 + 31) >> 6, NTW = ((qt >> 3) + 1) * 4;
    const unsigned short* KI = KC + (size_t)b * SEQ * 32;
    QFrag Q; float invw;
    for (int rh_ = 0; rh_ < REP_HEAD; ++rh_) { asm volatile("" ::: "memory");
    { const unsigned short* qp = P + qrow * NP + N_QI + hi * 8; float var = 0.f;
#pragma unroll
        for (int h = 0; h < 4; ++h) { float s = 0.f;
#pragma unroll
            for (int ks = 0; ks < 2; ++ks) { Q.q[h][ks] = *(const bf16x8*)(qp + h * 32 + ks * 16);
#pragma unroll
                for (int j = 0; j < 8; ++j) { const float v = bf2f((unsigned short)Q.q[h][ks][j]); s += v * v; } }
            s += shx(s, 32, lane); Q.w[h] = bf2f(P[qrow * NP + N_WI + h]); var += Q.w[h] * Q.w[h] * s; }
        invw = 82.7f / sqrtf(var > 1e-20f ? var : 1e-20f);
#pragma unroll
        for (int h = 0; h < 4; ++h) Q.w[h] *= invw; }
    __syncthreads();
    { typedef unsigned u32x4z __attribute__((ext_vector_type(4))); for (int i = tid; i < (L_PAR + 2048) / 16; i += NTHR) ((__attribute__((address_space(3))) u32x4z*)lds)[i] = (u32x4z){0u, 0u, 0u, 0u}; }
    __syncthreads(); }
    __attribute__((address_space(3))) unsigned char* kbuf = (__attribute__((address_space(3))) unsigned char*)lds + L_KBUF + wave * 4096;
#define IDX_KISSUE(kt_) do { const unsigned short* kp_ = KI + (size_t)(kt_) * 2048 + lane * 8;        \
        __builtin_amdgcn_global_load_lds((const unsigned*)kp_, (__attribute__((address_space(3))) unsigned*)kbuf, 16, 0, 0); \
        __builtin_amdgcn_global_load_lds((const unsigned*)(kp_ + 512), (__attribute__((address_space(3))) unsigned*)(kbuf + 1024), 16, 0, 0); \
        __builtin_amdgcn_global_load_lds((const unsigned*)(kp_ + 1024), (__attribute__((address_space(3))) unsigned*)(kbuf + 2048), 16, 0, 0); \
        __builtin_amdgcn_global_load_lds((const unsigned*)(kp_ + 1536), (__attribute__((address_space(3))) unsigned*)(kbuf + 3072), 16, 0, 0); } while (0)
#define IDX_KREAD(dst) do { const int ko_ = r32 * 64 + hi * 16;                                     \
        dst[0] = *(__attribute__((address_space(3))) bf16x8*)(kbuf + ko_); dst[1] = *(__attribute__((address_space(3))) bf16x8*)(kbuf + ko_ + 32); \
        dst[2] = *(__attribute__((address_space(3))) bf16x8*)(kbuf + ko_ + 2048); dst[3] = *(__attribute__((address_space(3))) bf16x8*)(kbuf + ko_ + 2080); } while (0)
#define IDX_KTAKE(dst, cnt_) do { asm volatile("s_waitcnt vmcnt(" cnt_ ")" ::: "memory"); IDX_KREAD(dst); asm volatile("s_waitcnt lgkmcnt(0)" ::: "memory"); } while (0)
    const unsigned hb = (unsigned)(size_t)((__attribute__((address_space(3))) unsigned char*)lds) + L_HIST + r32 * 1024 - 4 * G0;
#if IDX_PRIO
    if (wave >= 4) __builtin_amdgcn_s_setprio(1);
#endif
    const int qlo = qt * 32;
#define IDX_PRO(dA, dB) do { const f32x16 zz_ = {0.f, 0.f, 0.f, 0.f, 0.f, 0.f, 0.f, 0.f, 0.f, 0.f, 0.f, 0.f, 0.f, 0.f, 0.f, 0.f}; \
        dA = __builtin_amdgcn_mfma_f32_32x32x16_bf16(kc[0], Q.q[0][0], zz_, 0, 0, 0); dB = __builtin_amdgcn_mfma_f32_32x32x16_bf16(kc[0], Q.q[1][0], zz_, 0, 0, 0); \
        dA = __builtin_amdgcn_mfma_f32_32x32x16_bf16(kc[1], Q.q[0][1], dA, 0, 0, 0); dB = __builtin_amdgcn_mfma_f32_32x32x16_bf16(kc[1], Q.q[1][1], dB, 0, 0, 0); } while (0)
#define IDX_QHI Q.q[2][0], Q.q[2][1], Q.q[3][0], Q.q[3][1]
#define IDX_QLO Q.q[0][0], Q.q[0][1], Q.q[1][0], Q.q[1][1]
    for (int rp1 = 0; rp1 < REP_P1; ++rp1) { bf16x8 kc[4]; const unsigned inc1 = (rp1 & 1) ? 0xffffffffu : 1u; if (wave <= kt_max) IDX_KISSUE(wave);
      for (int kt = wave; kt <= kt_max; kt += 8) {
        IDX_KTAKE(kc, "0"); if (kt + 8 <= kt_max) IDX_KISSUE(kt + 8);
        if (kt * 64 + 63 <= qlo) {
#pragma unroll
            for (int sub = 0; sub < 2; ++sub) { const f32x16 sc = score_sub(kc[2 * sub], kc[2 * sub + 1], Q);
#pragma unroll
                for (int r = 0; r < 16; ++r) hist_add(hb, sc[r], inc1); }
        } else {
#pragma unroll
            for (int sub = 0; sub < 2; ++sub) { const f32x16 sc = score_sub(kc[2 * sub], kc[2 * sub + 1], Q); const int s0 = kt * 64 + sub * 32;
#pragma unroll
                for (int r = 0; r < 16; ++r) { if (s0 + crow(r, hi) <= t) hist_add(hb, sc[r], inc1); } }
        }
      } }
    __syncthreads();
    for (int rr_ = 0; rr_ < REP_RES; ++rr_) { __syncthreads(); asm volatile("" ::: "memory");
    { typedef unsigned u32x4r __attribute__((ext_vector_type(4)));
        const int q = tid >> 4, j = tid & 15, N = qt * 32 + q + 1; const bool neg = j >= 8;
        const unsigned* hs = hist32 + (neg ? 8192 + q * 256 + 32 * (j - 8) : q * 256 + 224 - 32 * j); int c = 0;
#pragma unroll
        for (int u = 0; u < 8; ++u) { const u32x4r v = *(const u32x4r*)(hs + 4 * ((u + (j >> 1)) & 7)); c += (int)(v[0] + v[1] + v[2] + v[3]); }
        int incl = c;
#pragma unroll
        for (int o = 1; o < 16; o <<= 1) { const int v = __builtin_amdgcn_ds_bpermute(((lane - o) & 63) << 2, incl); if (j >= o) incl += v; }
        const int excl = incl - c;
        if (N <= 256) { if (j == 0) par[P_MODE * 32 + q] = 0; }
        else if (excl < 256 && 256 <= incl) { u32x4r w[8];
#pragma unroll
            for (int u = 0; u < 8; ++u) w[u] = *(const u32x4r*)(hs + 4 * u);
            int above = excl, isel = -1, cntb = 0, ab = 0;
#pragma unroll
            for (int i = 0; i < 32; ++i) { const int cb = (int)(neg ? w[i >> 2][i & 3] : w[(31 - i) >> 2][(31 - i) & 3]); if (isel < 0 && above + cb >= 256) { isel = i; cntb = cb; ab = above; } above += cb; }
            const int bsel = rank_to_bin(32 * j + isel), ot = bsel & 255; const float* XT = (const float*)(lds + L_XT);
            par[P_BSTAR * 32 + q] = bsel; par[P_KK * 32 + q] = 256 - ab; par[P_MODE * 32 + q] = (bsel != 0 && cntb > CAP) ? 3 : 1;
            const float xa = XT[ot], xb = XT[ot + 1];
            const float XL = neg ? -__uint_as_float(__float_as_uint(xb) - 1u) : xa;
            const float XU = neg ? (xa > 0.f ? -__uint_as_float(__float_as_uint(xa) - 1u) : 0.f) : xb;
            par[P_XL * 32 + q] = (int)__float_as_uint(XL); par[P_XU * 32 + q] = (int)__float_as_uint(XU); }
    } }
    __syncthreads();
    const int my_mode = par[P_MODE * 32 + r32], my_b = par[P_BSTAR * 32 + r32];
    __syncthreads();
    float XL = __uint_as_float((unsigned)par[P_XL * 32 + r32]), XU = __uint_as_float((unsigned)par[P_XU * 32 + r32]);
    if (my_mode == 0) { XL = -3.0e38f; XU = -3.0e38f; }
    if (my_mode == 3) { XL = __builtin_inff(); XU = __builtin_inff(); }
    const bool central = (my_mode == 1 && my_b == 0);
    unsigned* ZW = ZWg;
    for (int r2_ = 0; r2_ < REP_P2; ++r2_) { if (r2_) { __syncthreads(); for (int i = tid; i < 32 * 128; i += NTHR) zc[i] = 0u; if (tid < 32) { par[P_CCNT * 32 + tid] = 0; par[P_OVF * 32 + tid] = 0; } __syncthreads(); }
    { bf16x8 kc[4]; if (wave <= kt_max) IDX_KISSUE(wave);
      for (int kt = wave; kt < NTW; kt += 8) {
        unsigned word = 0u, wz = 0u;
        if (kt <= kt_max) {
            if (kt == wave) { IDX_KTAKE(kc, "0"); } else { IDX_KTAKE(kc, "2"); }
            if (kt + 8 <= kt_max) IDX_KISSUE(kt + 8);
            asm volatile("" ::: "memory");
            f32x16 s0v = score_sub(kc[0], kc[1], Q), s1v = score_sub(kc[2], kc[3], Q);
            const bool diag = kt * 64 + 63 > qlo;
            if (diag) {
#pragma unroll
                for (int r = 0; r < 16; ++r) { const int s = kt * 64 + crow(r, hi); if (s > t) s0v[r] = -__builtin_inff(); if (s + 32 > t) s1v[r] = -__builtin_inff(); } }
            unsigned wn = 0u, wl = 0u;
#pragma unroll
            for (int e = 31; e >= 0; --e) { const float x = (e < 16) ? s0v[e & 15] : s1v[e & 15]; float t1, t2;
#if IDX_ASMBIN
                asm("v_sub_f32 %0, %1, %2" : "=v"(t1) : "v"(x), "v"(XU)); asm("v_sub_f32 %0, %1, %2" : "=v"(t2) : "v"(x), "v"(XL));
#else
                t1 = x - XU; t2 = x - XL;
#endif
                wn = __builtin_amdgcn_alignbit(wn, __float_as_uint(t1), 31); wl = __builtin_amdgcn_alignbit(wl, __float_as_uint(t2), 31); }
            word = ~wn; const unsigned inb = wn & ~wl;
            if ((REP_P2 == 1 || r2_ > 0) && __any(inb != 0u)) {
                unsigned zb = 0u;
                if (__any(central && inb != 0u)) { unsigned UZ = wave_or(central ? inb : 0u);
                    while (UZ) { const int e = __builtin_ctz(UZ); UZ &= UZ - 1u; const float x = (e < 16) ? s0v[e & 15] : s1v[e & 15];
                        if (central && ((inb >> e) & 1u) && x == 0.f) zb |= (1u << e); }
                    if (zb) lds_add(&zc[r32 * 128 + kt], (unsigned)__builtin_popcount(zb)); wz = zb; }
                const unsigned cb = inb & ~zb; const int cnt = __builtin_popcount(cb); int pos = 0;
                if (cnt) { pos = (int)lds_add((unsigned*)&par[P_CCNT * 32 + r32], (unsigned)cnt); if (pos + cnt > CAP) par[P_OVF * 32 + r32] = 1; }
                unsigned m = cb; int slot = pos;
                while (__any(m != 0u)) { const int e = (int)__builtin_ctz(m | 0x80000000u); const float x = sel32(s0v, s1v, e);
                    if (m != 0u && slot < CAP) { cand_s[r32 * CAP + slot] = __float_as_uint(x); cand_i[r32 * CAP + slot] = (unsigned)(kt * 64 + 32 * (e >> 4) + ((e & 3) + 8 * ((e & 15) >> 2) + 4 * hi)); }
                    m &= m - 1u; ++slot; }
            }
        }
        MK[((size_t)(b * 256 + qt) * 128 + kt) * 64 + lane] = word; ZW[kt * 64 + lane] = wz;
      } } }
#if IDX_PRIO
    __builtin_amdgcn_s_setprio(0);
#endif
    asm volatile("s_waitcnt vmcnt(0)" ::: "memory");
    __syncthreads();
    for (int rk_ = 0; rk_ < REP_RANK; ++rk_) { if (rk_) __syncthreads(); asm volatile("" ::: "memory");
    { const int q = tid >> 4, j = tid & 15, mode = par[P_MODE * 32 + q], kk = par[P_KK * 32 + q], bq = par[P_BSTAR * 32 + q];
        const int n = par[P_CCNT * 32 + q] < CAP ? par[P_CCNT * 32 + q] : CAP, n4 = (n + 3) & ~3;
        if (mode == 1 && par[P_OVF * 32 + q]) { if (j == 0) par[P_MODE * 32 + q] = 3; }
        else if (mode == 1 && kk <= n) {
            if (j < n4 - n) { cand_s[q * CAP + n + j] = 0xFF800000u; cand_i[q * CAP + n + j] = 0xFFFFFFFFu; }
            if (j == 0) { par[P_NRANK * 32 + q] = n; par[P_TSTAR * 32 + q] = -1; } }
        else if (mode == 1 && bq == 0) {
            const int need = kk - n; int zl[8], c = 0;
#pragma unroll
            for (int u = 0; u < 8; ++u) { zl[u] = (int)zc[q * 128 + 8 * j + u]; c += zl[u]; }
            int incl = c;
#pragma unroll
            for (int o = 1; o < 16; o <<= 1) { const int v = __builtin_amdgcn_ds_bpermute(((lane - o) & 63) << 2, incl); if (j >= o) incl += v; }
            int cum = incl - c;
            if (j == 0) { par[P_TAU * 32 + q] = (int)0xFF800000u; par[P_CUT * 32 + q] = -1; }
            if (cum < need && need <= incl) { int ts = 8 * j + 7, rs = 1; bool done = false;
#pragma unroll
                for (int u = 0; u < 8; ++u) { if (!done && cum + zl[u] >= need) { ts = 8 * j + u; rs = need - cum; done = true; } cum += zl[u]; }
                par[P_TSTAR * 32 + q] = ts; par[P_RSTAR * 32 + q] = rs; } }
        else if (mode == 1) { if (j == 0) par[P_MODE * 32 + q] = 3; }
    }
    __syncthreads();
    if (tid < 64) { const int q = lane & 31; int incl = par[P_NRANK * 32 + q];
#pragma unroll
        for (int o = 1; o < 32; o <<= 1) { const int v = __builtin_amdgcn_ds_bpermute(((lane - o) & 63) << 2, incl); if (q >= o) incl += v; }
        if (lane < 32) par[P_PRE * 32 + q] = incl; }
    __syncthreads();
    { typedef unsigned u32x4v __attribute__((ext_vector_type(4)));
        const int total = par[P_PRE * 32 + 31];
        for (int g = tid; g < total; g += NTHR) {
            int q = 0;
#pragma unroll
            for (int st = 16; st >= 1; st >>= 1) { if (par[P_PRE * 32 + q + st - 1] <= g) q += st; }
            const int i = g - (q ? par[P_PRE * 32 + q - 1] : 0), n = par[P_NRANK * 32 + q], n4 = (n + 3) & ~3, kk = par[P_KK * 32 + q];
            const unsigned cix = cand_s[q * CAP + i], ciy = cand_i[q * CAP + i]; const float si = __uint_as_float(cix); int rank = 0;
#pragma unroll 2
            for (int m2 = 0; m2 < n4; m2 += 4) { const u32x4v sv = *(const u32x4v*)&cand_s[q * CAP + m2], iv = *(const u32x4v*)&cand_i[q * CAP + m2];
#pragma unroll
                for (int u = 0; u < 4; ++u) { const float sm = __uint_as_float(sv[u]); rank += (sm > si || (sm == si && iv[u] < ciy)) ? 1 : 0; } }
            if (rank == kk - 1) { par[P_TAU * 32 + q] = (int)cix; par[P_CUT * 32 + q] = (int)ciy; } } }
    __syncthreads(); }
    for (int rpp = 0; rpp < REP_PATCH; ++rpp)
    { const int q = tid >> 4, j = tid & 15, mode = par[P_MODE * 32 + q];
        if (mode == 1) { const int n = par[P_CCNT * 32 + q]; const float tau = __uint_as_float((unsigned)par[P_TAU * 32 + q]); const unsigned cut = (unsigned)par[P_CUT * 32 + q]; const int ts = par[P_TSTAR * 32 + q], rs = par[P_RSTAR * 32 + q];
            unsigned* mq = MK + (size_t)(b * 256 + qt) * 128 * 64 + q;
#pragma unroll 1
            for (int i = j; i < n; i += 16) { const float sc = __uint_as_float(cand_s[q * CAP + i]); const unsigned s = cand_i[q * CAP + i];
                if (sc > tau || (sc == tau && s <= cut)) { const int kap = s & 63, k5 = kap & 31, hh = (k5 >> 2) & 1, e = (k5 & 3) + 4 * (k5 >> 3) + 16 * (kap >> 5);
                    __hip_atomic_fetch_or(mq + (s >> 6) * 64 + 32 * hh, 1u << e, __ATOMIC_RELAXED, __HIP_MEMORY_SCOPE_AGENT); } }
            if (ts >= 0) {
                unsigned zw0[8], zw1[8];
#pragma unroll
                for (int u = 0; u < 8; ++u) { const int kt = j + 16 * u; zw0[u] = 0u; zw1[u] = 0u; if (kt <= ts) { zw0[u] = __hip_atomic_load(ZW + kt * 64 + q, __ATOMIC_RELAXED, __HIP_MEMORY_SCOPE_AGENT); zw1[u] = __hip_atomic_load(ZW + kt * 64 + 32 + q, __ATOMIC_RELAXED, __HIP_MEMORY_SCOPE_AGENT); } }
#pragma unroll
                for (int u = 0; u < 8; ++u) { const int kt = j + 16 * u; if (kt <= ts) { const unsigned w0 = zw0[u], w1 = zw1[u]; unsigned a0 = w0, a1 = w1;
                    if (kt == ts) { const unsigned lo32 = spread_nib(w0 & 0xffffu) | (spread_nib(w1 & 0xffffu) << 4), hi32 = spread_nib(w0 >> 16) | (spread_nib(w1 >> 16) << 4);
                        const unsigned long long ord = (unsigned long long)lo32 | ((unsigned long long)hi32 << 32);
                        int nn = rs, kap = 0; unsigned w = (unsigned)ord; int c = __builtin_popcount(w);
                        if (nn > c) { nn -= c; w = (unsigned)(ord >> 32); kap = 32; }
                        c = __builtin_popcount(w & 0xffffu); if (nn > c) { nn -= c; w >>= 16; kap += 16; }
                        c = __builtin_popcount(w & 0xffu); if (nn > c) { nn -= c; w >>= 8; kap += 8; }
                        c = __builtin_popcount(w & 0xfu); if (nn > c) { nn -= c; w >>= 4; kap += 4; }
                        c = __builtin_popcount(w & 0x3u); if (nn > c) { nn -= c; w >>= 2; kap += 2; }
                        c = (int)(w & 1u); if (nn > c) kap += 1;
                        unsigned k0 = 0u, k1 = 0u;
#pragma unroll
                        for (int e = 0; e < 32; ++e) { const int pos0 = 32 * (e >> 4) + crow(e & 15, 0), pos1 = 32 * (e >> 4) + crow(e & 15, 1); if (pos0 <= kap) k0 |= (1u << e); if (pos1 <= kap) k1 |= (1u << e); }
                        a0 &= k0; a1 &= k1; }
                    if (a0) __hip_atomic_fetch_or(mq + kt * 64, a0, __ATOMIC_RELAXED, __HIP_MEMORY_SCOPE_AGENT);
                    if (a1) __hip_atomic_fetch_or(mq + kt * 64 + 32, a1, __ATOMIC_RELAXED, __HIP_MEMORY_SCOPE_AGENT); } } }
        }
    }
    __syncthreads();
}
#undef IDX_KISSUE
#undef IDX_KTAKE
#undef IDX_KREAD
}
namespace glab {
typedef short bf16x8 __attribute__((ext_vector_type(8)));
typedef short s16x4 __attribute__((ext_vector_type(4)));
typedef float f32x16 __attribute__((ext_vector_type(16)));
typedef float f32x4 __attribute__((ext_vector_type(4)));
typedef unsigned u32x4 __attribute__((ext_vector_type(4)));
typedef unsigned u32x2 __attribute__((ext_vector_type(2)));
typedef float f32x2_t __attribute__((ext_vector_type(2))); typedef __bf16 bf16x2_t __attribute__((ext_vector_type(2)));
#define GLAS __attribute__((address_space(3)))
constexpr int RAW_Q = 0, RAW_K = 6144, RAW_V = 12288, RAW_Z = 24576, OP_QE = 26624, OP_KE = 33792, OP_KDT = 40960, OP_VT = 47872, OP_DEC = 61696, OP_BLK_BYTES = 35328  ,
              OP_BLK1 = 61952  , OP_ST = 97280, ST_BYTES = 10752;
__device__ __forceinline__ unsigned cvtpk(float lo, float hi) { f32x2_t v = {lo, hi}; bf16x2_t b = __builtin_convertvector(v, bf16x2_t); return __builtin_bit_cast(unsigned, b); }
__device__ __forceinline__ int crow(int r, int hi) { return (r & 3) + 8 * (r >> 2) + 4 * hi; }
__device__ __forceinline__ float bfl(unsigned short b) { return __uint_as_float((unsigned)b << 16); }


__device__ __forceinline__ void gla_prep_item(const unsigned short* P, unsigned char* GOP, const float* w2, const float* gb, unsigned char* ldsg, int item, int tid) {
    GLAS unsigned char* lds = (GLAS unsigned char*)ldsg;
    const int lane = tid & 63; const int b = item >> 9, h = (item >> 7) & 3, n = item & 127;
    const size_t m0 = (size_t)b * SEQ + (size_t)n * 64;
    __syncthreads();
#define GLA_PCOL(c) (((c) < 6) ? (N_GQ + h * 48 + (c) * 8) : ((c) < 12) ? (N_GK + h * 48 + ((c) - 6) * 8) : ((c) < 24) ? (N_GV + h * 96 + ((c) - 12) * 8) : (N_GZ + ((c) - 24) * 8))
#define GLA_PDST(row, c) (((c) < 6) ? (RAW_Q + (row) * 96 + (c) * 16) : ((c) < 12) ? (RAW_K + (row) * 96 + ((c) - 6) * 16) : ((c) < 24) ? (RAW_V + (row) * 192 + ((c) - 12) * 16) : (RAW_Z + (row) * 32 + ((c) - 24) * 16))
#pragma unroll
    for (int k = 0; k < 4; ++k) { const int p = tid + 512 * k; if (p < 1664) { const int row = p / 26, c = p % 26; *(GLAS u32x4*)(lds + GLA_PDST(row, c)) = *(const u32x4*)(P + (m0 + row) * NP + GLA_PCOL(c)); } }
    __syncthreads();
    const int sd = tid >> 3, tg = tid & 7;
    if (tid < 384) {
            float c[8], w2c[16]; const float bc = gb[h * 48 + sd];
#pragma unroll
            for (int r = 0; r < 16; ++r) w2c[r] = w2[(size_t)r * 192 + h * 48 + sd];
#pragma unroll
            for (int tt = 0; tt < 8; ++tt) { const int t = 8 * tg + tt; const u32x4 z0 = *(GLAS u32x4*)(lds + RAW_Z + t * 32), z1 = *(GLAS u32x4*)(lds + RAW_Z + t * 32 + 16); float z = bc;
#pragma unroll
                for (int k = 0; k < 4; ++k) { z += w2c[2 * k] * __uint_as_float(z0[k] << 16) + w2c[2 * k + 1] * __uint_as_float(z0[k] & 0xffff0000u); z += w2c[8 + 2 * k] * __uint_as_float(z1[k] << 16) + w2c[8 + 2 * k + 1] * __uint_as_float(z1[k] & 0xffff0000u); }
                const float ls = fminf(z, 0.f) - __logf(1.0f + __expf(-fabsf(z)));
                c[tt] = ls * (1.0f / 16.0f) + (tt ? c[tt - 1] : 0.f); }
            float incl = c[7];
#pragma unroll
            for (int o = 1; o < 8; o <<= 1) { const float v = __builtin_bit_cast(float, __builtin_amdgcn_ds_bpermute(((lane - o) & 63) << 2, __builtin_bit_cast(int, incl))); if (tg >= o) incl += v; }
            const float off = incl - c[7];
            const float bl = __builtin_bit_cast(float, __builtin_amdgcn_ds_bpermute((lane | 7) << 2, __builtin_bit_cast(int, incl)));
            unsigned kdp[4];
#pragma unroll
            for (int tt = 0; tt < 8; tt += 2) { float kdv[2];
#pragma unroll
                for (int u = 0; u < 2; ++u) { const int t = 8 * tg + tt + u; const float bb = off + c[tt + u];
                    const float q = bfl(*(GLAS unsigned short*)(lds + RAW_Q + (t * 48 + sd) * 2)), kx = bfl(*(GLAS unsigned short*)(lds + RAW_K + (t * 48 + sd) * 2));
                    const float e1 = __expf(bb), e2 = __expf(-bb), e3 = __expf(bl - bb);
                    *(GLAS unsigned short*)(lds + OP_QE + (t * 56 + sd) * 2) = (unsigned short)(cvtpk(q * e1, 0.f) & 0xffffu);
                    *(GLAS unsigned short*)(lds + OP_KE + (t * 56 + sd) * 2) = (unsigned short)(cvtpk(kx * e2, 0.f) & 0xffffu);
                    kdv[u] = kx * e3; }
                kdp[tt >> 1] = cvtpk(kdv[0], kdv[1]); }
            *(GLAS u32x4*)(lds + OP_KDT + (sd * 72 + 8 * tg) * 2) = (u32x4){kdp[0], kdp[1], kdp[2], kdp[3]};
            if (tg == 7) ((GLAS float*)(lds + OP_DEC))[sd] = __expf(bl);
    } else {
            for (int idx = tid - 384; idx < 96 * 8; idx += 128) { const int v = idx % 96, t8 = idx / 96; unsigned pk[4];
#pragma unroll
                for (int tt = 0; tt < 8; tt += 2) { const unsigned a0 = *(GLAS unsigned short*)(lds + RAW_V + ((8 * t8 + tt) * 96 + v) * 2), a1 = *(GLAS unsigned short*)(lds + RAW_V + ((8 * t8 + tt + 1) * 96 + v) * 2); pk[tt >> 1] = a0 | (a1 << 16); }
                *(GLAS u32x4*)(lds + OP_VT + (v * 72 + 8 * t8) * 2) = (u32x4){pk[0], pk[1], pk[2], pk[3]}; }
    }
    __syncthreads();
    unsigned char* dst = GOP + (size_t)item * OP_BLK_BYTES;
    for (int i = tid; i < (OP_DEC + 192 - OP_QE) / 16; i += NTHR) *(u32x4*)(dst + i * 16) = *(GLAS u32x4*)(lds + OP_QE + i * 16);
}
__device__ __forceinline__ void gla_prep_loop(const unsigned short* P, unsigned char* GOP, const float* w2, const float* gb, unsigned char* ldsg, int wg, int G, int tid) {
    GLAS unsigned char* lds = (GLAS unsigned char*)ldsg;
    const int lane = tid & 63;
#define GLA_PCOLH(c, hh) (((c) < 6) ? (N_GQ + (hh) * 48 + (c) * 8) : ((c) < 12) ? (N_GK + (hh) * 48 + ((c) - 6) * 8) : ((c) < 24) ? (N_GV + (hh) * 96 + ((c) - 12) * 8) : (N_GZ + ((c) - 24) * 8))
#define GLA_PDST(row, c) (((c) < 6) ? (RAW_Q + (row) * 96 + (c) * 16) : ((c) < 12) ? (RAW_K + (row) * 96 + ((c) - 6) * 16) : ((c) < 24) ? (RAW_V + (row) * 192 + ((c) - 12) * 16) : (RAW_Z + (row) * 32 + ((c) - 24) * 16))
#define GLA_FETCH(it_) do { const int b_ = (it_) >> 9, h_ = ((it_) >> 7) & 3, n_ = (it_) & 127; const size_t mr_ = (size_t)b_ * SEQ + (size_t)n_ * 64; \
        _Pragma("unroll") for (int k = 0; k < 4; ++k) { const int p = tid + 512 * k; if (p < 1664) { const int row = p / 26, c = p % 26; rawr[k] = *(const u32x4*)(P + (mr_ + row) * NP + GLA_PCOLH(c, h_)); } } } while (0)
    u32x4 rawr[4];
    if (wg < BATCH * 4 * 128) GLA_FETCH(wg);
    for (int item = wg; item < BATCH * 4 * 128; item += G) {
    const int h = (item >> 7) & 3;
    __syncthreads();
#pragma unroll
    for (int k = 0; k < 4; ++k) { const int p = tid + 512 * k; if (p < 1664) { const int row = p / 26, c = p % 26; *(GLAS u32x4*)(lds + GLA_PDST(row, c)) = rawr[k]; } }
    if (item + G < BATCH * 4 * 128) GLA_FETCH(item + G);
    __syncthreads();
    const int sd = tid >> 3, tg = tid & 7;
    if (tid < 384) {
            float c[8], w2c[16]; const float bc = gb[h * 48 + sd];
#pragma unroll
            for (int r = 0; r < 16; ++r) w2c[r] = w2[(size_t)r * 192 + h * 48 + sd];
#pragma unroll
            for (int tt = 0; tt < 8; ++tt) { const int t = 8 * tg + tt; const u32x4 z0 = *(GLAS u32x4*)(lds + RAW_Z + t * 32), z1 = *(GLAS u32x4*)(lds + RAW_Z + t * 32 + 16); float z = bc;
#pragma unroll
                for (int k = 0; k < 4; ++k) { z += w2c[2 * k] * __uint_as_float(z0[k] << 16) + w2c[2 * k + 1] * __uint_as_float(z0[k] & 0xffff0000u); z += w2c[8 + 2 * k] * __uint_as_float(z1[k] << 16) + w2c[8 + 2 * k + 1] * __uint_as_float(z1[k] & 0xffff0000u); }
                const float ls = fminf(z, 0.f) - __logf(1.0f + __expf(-fabsf(z)));
                c[tt] = ls * (1.0f / 16.0f) + (tt ? c[tt - 1] : 0.f); }
            float incl = c[7];
#pragma unroll
            for (int o = 1; o < 8; o <<= 1) { const float v = __builtin_bit_cast(float, __builtin_amdgcn_ds_bpermute(((lane - o) & 63) << 2, __builtin_bit_cast(int, incl))); if (tg >= o) incl += v; }
            const float off = incl - c[7];
            const float bl = __builtin_bit_cast(float, __builtin_amdgcn_ds_bpermute((lane | 7) << 2, __builtin_bit_cast(int, incl)));
            unsigned kdp[4];
#pragma unroll
            for (int tt = 0; tt < 8; tt += 2) { float kdv[2];
#pragma unroll
                for (int u = 0; u < 2; ++u) { const int t = 8 * tg + tt + u; const float bb = off + c[tt + u];
                    const float q = bfl(*(GLAS unsigned short*)(lds + RAW_Q + (t * 48 + sd) * 2)), kx = bfl(*(GLAS unsigned short*)(lds + RAW_K + (t * 48 + sd) * 2));
                    const float e1 = __expf(bb), e2 = __expf(-bb), e3 = __expf(bl - bb);
                    *(GLAS unsigned short*)(lds + OP_QE + (t * 56 + sd) * 2) = (unsigned short)(cvtpk(q * e1, 0.f) & 0xffffu);
                    *(GLAS unsigned short*)(lds + OP_KE + (t * 56 + sd) * 2) = (unsigned short)(cvtpk(kx * e2, 0.f) & 0xffffu);
                    kdv[u] = kx * e3; }
                kdp[tt >> 1] = cvtpk(kdv[0], kdv[1]); }
            *(GLAS u32x4*)(lds + OP_KDT + (sd * 72 + 8 * tg) * 2) = (u32x4){kdp[0], kdp[1], kdp[2], kdp[3]};
            if (tg == 7) ((GLAS float*)(lds + OP_DEC))[sd] = __expf(bl);
    } else {
            for (int idx = tid - 384; idx < 96 * 8; idx += 128) { const int v = idx % 96, t8 = idx / 96; unsigned pk[4];
#pragma unroll
                for (int tt = 0; tt < 8; tt += 2) { const unsigned a0 = *(GLAS unsigned short*)(lds + RAW_V + ((8 * t8 + tt) * 96 + v) * 2), a1 = *(GLAS unsigned short*)(lds + RAW_V + ((8 * t8 + tt + 1) * 96 + v) * 2); pk[tt >> 1] = a0 | (a1 << 16); }
                *(GLAS u32x4*)(lds + OP_VT + (v * 72 + 8 * t8) * 2) = (u32x4){pk[0], pk[1], pk[2], pk[3]}; }
    }
    __syncthreads();
    unsigned char* dst = GOP + (size_t)item * OP_BLK_BYTES;
    for (int i = tid; i < (OP_DEC + 192 - OP_QE) / 16; i += NTHR) *(u32x4*)(dst + i * 16) = *(GLAS u32x4*)(lds + OP_QE + i * 16);
    }
#undef GLA_FETCH
#undef GLA_PCOLH
}
__device__ __forceinline__ void gla_seq_unit(const unsigned short* P, unsigned short* Y, const unsigned char* GOP, const float* ng, unsigned char* ldsg, int b, int h, int tid) {
    GLAS unsigned char* lds = (GLAS unsigned char*)ldsg;
    const int lane = tid & 63, wave = __builtin_amdgcn_readfirstlane(tid >> 6), r32 = lane & 31, hi = lane >> 5, l15 = lane & 15, quad = lane >> 4;
    const size_t rowbase = (size_t)b * SEQ; const unsigned char* gsrc = GOP + (size_t)((b * 4 + h) * 128) * OP_BLK_BYTES;
    constexpr int NPC = (OP_DEC + 192 - OP_QE) / 16;
    constexpr int SQ_BLK0 = 0, SQ_BLK1 = OP_BLK_BYTES, SQ_ST = 2 * OP_BLK_BYTES  , SQ_OB = SQ_ST + 2 * ST_BYTES  , SQ_OB_BYTES = 64 * 96 * 2, SQ_NG = SQ_OB + 2 * SQ_OB_BYTES  ;
    __syncthreads();
    for (int i = tid; i < 2 * ST_BYTES / 4; i += NTHR) ((GLAS unsigned*)(lds + SQ_ST))[i] = 0u;
    if (tid < 96) ((GLAS float*)(lds + SQ_NG))[tid] = ng[tid];
    u32x4 rg[5];
#pragma unroll
    for (int k = 0; k < 5; ++k) { const int i = tid + 512 * k; if (i < NPC) rg[k] = *(const u32x4*)(gsrc + (size_t)i * 16); }
#pragma unroll
    for (int k = 0; k < 5; ++k) { const int i = tid + 512 * k; if (i < NPC) *(GLAS u32x4*)(lds + SQ_BLK0 + i * 16) = rg[k]; }
#pragma unroll
    for (int k = 0; k < 5; ++k) { const int i = tid + 512 * k; if (i < NPC) rg[k] = *(const u32x4*)(gsrc + OP_BLK_BYTES + (size_t)i * 16); }
    __syncthreads();
    f32x4 S[2][3];
#pragma unroll
    for (int mt = 0; mt < 2; ++mt)
#pragma unroll
        for (int nt = 0; nt < 3; ++nt) S[mt][nt] = (f32x4){0.f, 0.f, 0.f, 0.f};
#define GLA_EPILOGUE(nn) do { const int cc_ = (nn) & 1; const size_t mm_ = rowbase + (size_t)(nn) * 64; \
        _Pragma("unroll") for (int k_ = 0; k_ < 4; ++k_) { const int vec_ = (tid - 320) + 192 * k_, t_ = vec_ / 12, v_ = (vec_ % 12) * 8; \
            const u32x4 ov_ = *(GLAS u32x4*)(lds + SQ_OB + cc_ * SQ_OB_BYTES + t_ * 192 + v_ * 2); const u32x4 gv_ = *(const u32x4*)(P + (mm_ + t_) * NP + N_GG + h * 96 + v_); \
            const f32x4 n0_ = *(GLAS f32x4*)(lds + SQ_NG + v_ * 4), n1_ = *(GLAS f32x4*)(lds + SQ_NG + v_ * 4 + 16); u32x4 yo_; \
            _Pragma("unroll") for (int e_ = 0; e_ < 4; ++e_) { const float ga_ = __uint_as_float(gv_[e_] << 16), gb_ = __uint_as_float(gv_[e_] & 0xffff0000u); \
                const float na_ = (e_ < 2) ? n0_[2 * e_] : n1_[2 * e_ - 4], nb_ = (e_ < 2) ? n0_[2 * e_ + 1] : n1_[2 * e_ - 3]; \
                yo_[e_] = cvtpk(__uint_as_float(ov_[e_] << 16) * na_ * (ga_ / (1.0f + __expf(-ga_))), __uint_as_float(ov_[e_] & 0xffff0000u) * nb_ * (gb_ / (1.0f + __expf(-gb_)))); } \
            *(u32x4*)(Y + (mm_ + t_) * DM + h * 96 + v_) = yo_; } } while (0)
    for (int n = 0; n < SEQ / 64; ++n) {
        const int cur = n & 1, nxt = cur ^ 1; const size_t m0 = rowbase + (size_t)n * 64;
        const int BO = (cur ? SQ_BLK1 : SQ_BLK0) - OP_QE;
        if (n + 1 < SEQ / 64) { const int BN = (cur ? SQ_BLK0 : SQ_BLK1) - OP_QE;
#pragma unroll
            for (int k = 0; k < 5; ++k) { const int i = tid + 512 * k; if (i < NPC) *(GLAS u32x4*)(lds + OP_QE + BN + i * 16) = rg[k]; }
            if (n + 2 < SEQ / 64) {
#pragma unroll
                for (int k = 0; k < 5; ++k) { const int i = tid + 512 * k; if (i < NPC) rg[k] = *(const u32x4*)(gsrc + (size_t)(n + 2) * OP_BLK_BYTES + (size_t)i * 16); } } }
        if (wave < 2) {
            const int it = wave; bf16x8 qf[3];
#pragma unroll
            for (int ks = 0; ks < 3; ++ks) qf[ks] = *(GLAS bf16x8*)(lds + BO + OP_QE + (32 * it + r32) * 112 + (16 * ks + 8 * hi) * 2);
            f32x16 acc[3];
#pragma unroll
            for (int vt = 0; vt < 3; ++vt)
#pragma unroll
                for (int r = 0; r < 16; ++r) acc[vt][r] = 0.f;
#pragma unroll
            for (int jt = 0; jt < 2; ++jt) if (jt <= it) {
                f32x16 X;
#pragma unroll
                for (int r = 0; r < 16; ++r) X[r] = 0.f;
#pragma unroll
                for (int ks = 0; ks < 3; ++ks) { const bf16x8 kf = *(GLAS bf16x8*)(lds + BO + OP_KE + (32 * jt + r32) * 112 + (16 * ks + 8 * hi) * 2); X = __builtin_amdgcn_mfma_f32_32x32x16_bf16(kf, qf[ks], X, 0, 0, 0); }
                if (jt == it) {
#pragma unroll
                    for (int r = 0; r < 16; ++r) if (crow(r, hi) > r32) X[r] = 0.f; }
                u32x4 p0, p1;
#pragma unroll
                for (int k = 0; k < 4; ++k) { p0[k] = cvtpk(X[2 * k], X[2 * k + 1]); p1[k] = cvtpk(X[8 + 2 * k], X[8 + 2 * k + 1]); }
                const bf16x8 pa0 = __builtin_bit_cast(bf16x8, p0), pa1 = __builtin_bit_cast(bf16x8, p1);
#pragma unroll
                for (int vt = 0; vt < 3; ++vt)
#pragma unroll
                    for (int s = 0; s < 2; ++s) { const int vo = BO + OP_VT + (32 * vt + r32) * 144 + (32 * jt + 16 * s + 4 * hi) * 2;
                        const s16x4 lo = *(GLAS s16x4*)(lds + vo), hi4 = *(GLAS s16x4*)(lds + vo + 16);
                        const bf16x8 a2 = (bf16x8){lo[0], lo[1], lo[2], lo[3], hi4[0], hi4[1], hi4[2], hi4[3]};
                        acc[vt] = __builtin_amdgcn_mfma_f32_32x32x16_bf16(a2, s ? pa1 : pa0, acc[vt], 0, 0, 0); }
            }
#pragma unroll
            for (int vt = 0; vt < 3; ++vt)
#pragma unroll
                for (int ks = 0; ks < 3; ++ks) { const bf16x8 sf = *(GLAS bf16x8*)(lds + SQ_ST + cur * ST_BYTES + (32 * vt + r32) * 112 + (16 * ks + 8 * hi) * 2); acc[vt] = __builtin_amdgcn_mfma_f32_32x32x16_bf16(sf, qf[ks], acc[vt], 0, 0, 0); }
            float ss = 0.f;
#pragma unroll
            for (int vt = 0; vt < 3; ++vt)
#pragma unroll
                for (int r = 0; r < 16; ++r) ss += acc[vt][r] * acc[vt][r];
            ss += __builtin_bit_cast(float, __builtin_amdgcn_ds_bpermute((lane ^ 32) << 2, __builtin_bit_cast(int, ss)));
            const float rn = 1.0f / sqrtf(ss * (1.0f / 96.0f) + EPS);
            GLAS unsigned char* ob = lds + SQ_OB + cur * SQ_OB_BYTES + (32 * it + r32) * 192;
#pragma unroll
            for (int vt = 0; vt < 3; ++vt)
#pragma unroll
                for (int g = 0; g < 4; ++g) { const int v0 = 32 * vt + 8 * g + 4 * hi;
                    *(GLAS u32x2*)(ob + v0 * 2) = (u32x2){cvtpk(acc[vt][4 * g] * rn, acc[vt][4 * g + 1] * rn), cvtpk(acc[vt][4 * g + 2] * rn, acc[vt][4 * g + 3] * rn)}; }
        } else if (wave < 5) {
            const int sw = wave - 2;
#pragma unroll
            for (int mt = 0; mt < 2; ++mt)
#pragma unroll
                for (int nt = 0; nt < 3; ++nt) { const int d = 16 * nt + l15; const float dec = ((GLAS float*)(lds + BO + OP_DEC))[d]; f32x4 a = S[mt][nt] * dec;
#pragma unroll
                    for (int ks = 0; ks < 2; ++ks) { const bf16x8 va = *(GLAS bf16x8*)(lds + BO + OP_VT + (32 * sw + 16 * mt + l15) * 144 + (32 * ks + 8 * quad) * 2), kb = *(GLAS bf16x8*)(lds + BO + OP_KDT + d * 144 + (32 * ks + 8 * quad) * 2);
                        a = __builtin_amdgcn_mfma_f32_16x16x32_bf16(va, kb, a, 0, 0, 0); }
                    S[mt][nt] = a;
#pragma unroll
                    for (int jj = 0; jj < 4; jj += 2) { const unsigned pk = cvtpk(a[jj], a[jj + 1]);
                        *(GLAS unsigned short*)(lds + SQ_ST + nxt * ST_BYTES + ((32 * sw + 16 * mt + 4 * quad + jj) * 56 + d) * 2) = (unsigned short)(pk & 0xffffu);
                        *(GLAS unsigned short*)(lds + SQ_ST + nxt * ST_BYTES + ((32 * sw + 16 * mt + 4 * quad + jj + 1) * 56 + d) * 2) = (unsigned short)(pk >> 16); } }
        } else if (n > 0) {
            GLA_EPILOGUE(n - 1);
        }
        __syncthreads();
    }
    if (wave >= 5) { GLA_EPILOGUE(SEQ / 64 - 1); }
    __syncthreads();
}
#undef GLA_EPILOGUE
#undef GLA_PCOL
#undef GLA_PDST
#undef GLAS
}
namespace poolb {
typedef short bf16x8 __attribute__((ext_vector_type(8)));
typedef float f32x16 __attribute__((ext_vector_type(16)));
typedef unsigned u32x4 __attribute__((ext_vector_type(4)));
typedef unsigned u32x2 __attribute__((ext_vector_type(2)));
typedef float f32x2_t __attribute__((ext_vector_type(2))); typedef __bf16 bf16x2_t __attribute__((ext_vector_type(2)));
#define PLAS __attribute__((address_space(3)))
constexpr int US_PITCH = 528  , US = 0, US_BYTES = 79 * US_PITCH  , PS = 41728, PS_PITCH = 144  , PS_WAVE = 32 * PS_PITCH  ,
              WT = PS + 8 * PS_WAVE  , WT_PITCH = 144, WT_GROUP = 64 * WT_PITCH  ;
__device__ __forceinline__ unsigned cvtpk(float lo, float hi) { f32x2_t v = {lo, hi}; bf16x2_t b = __builtin_convertvector(v, bf16x2_t); return __builtin_bit_cast(unsigned, b); }
__device__ __forceinline__ void pool_phase(const unsigned short* P, unsigned short* Y, const float* pw, const float* pscale, unsigned char* ldsg, int wg, int G, int tid) {
    PLAS unsigned char* lds = (PLAS unsigned char*)ldsg;
    const int lane = tid & 63, wave = __builtin_amdgcn_readfirstlane(tid >> 6), r32 = lane & 31, hi = lane >> 5, g = wave & 3, th = wave >> 2;
    __syncthreads();
    for (int i = tid; i < 4 * 64 * 64; i += NTHR) { const int gg = i >> 12, c = (i >> 6) & 63, d = i & 63; const float v = pw[i] * pscale[gg * 64 + d];
        *(PLAS unsigned short*)(lds + WT + gg * WT_GROUP + d * WT_PITCH + c * 2) = (unsigned short)(cvtpk(v, 0.f) & 0xffffu); }
    const int w = 2 << g;
    for (int tile = wg; tile < M / 64; tile += G) {
        const int m0 = tile * 64, t0 = m0 % SEQ;
        __syncthreads();
        for (int i = tid; i < 79 * 32; i += NTHR) { const int row = i >> 5, pc = i & 31; u32x4 v = {0u, 0u, 0u, 0u};
            if (t0 + row - 15 >= 0) v = *(const u32x4*)(P + (size_t)(m0 - 15 + row) * NP + N_PU + pc * 8);
            *(PLAS u32x4*)(lds + US + row * US_PITCH + pc * 16) = v; }
        __syncthreads();
        { float sum[32];
#pragma unroll
            for (int c = 0; c < 32; ++c) sum[c] = 0.f;
            const int tl = 32 * th + r32; const PLAS unsigned char* base = lds + US + (tl + 15) * US_PITCH + (g * 64 + 32 * hi) * 2;
            for (int j = 0; j < w; ++j) {
#pragma unroll
                for (int q4 = 0; q4 < 4; ++q4) { const u32x4 v = *(const PLAS u32x4*)(base - j * US_PITCH + q4 * 16);
#pragma unroll
                    for (int k = 0; k < 4; ++k) { const float lo = __uint_as_float(v[k] << 16), hh = __uint_as_float(v[k] & 0xffff0000u); sum[8 * q4 + 2 * k] += lo; sum[8 * q4 + 2 * k + 1] += hh; } } }
            const int pos = t0 + tl; const float inv = 1.0f / (float)((pos + 1 < w) ? pos + 1 : w);
            PLAS unsigned char* pd = lds + PS + wave * PS_WAVE + r32 * PS_PITCH + 32 * hi * 2;
#pragma unroll
            for (int q4 = 0; q4 < 4; ++q4) { u32x4 o; const u32x4 sv = *(const PLAS u32x4*)(base + q4 * 16);
#pragma unroll
                for (int k = 0; k < 4; ++k) o[k] = cvtpk(sum[8 * q4 + 2 * k] * inv - __uint_as_float(sv[k] << 16), sum[8 * q4 + 2 * k + 1] * inv - __uint_as_float(sv[k] & 0xffff0000u));
                *(PLAS u32x4*)(pd + q4 * 16) = o; } }
        asm volatile("s_waitcnt lgkmcnt(0)" ::: "memory");
        f32x16 acc[2];
#pragma unroll
        for (int dt = 0; dt < 2; ++dt) {
#pragma unroll
            for (int r = 0; r < 16; ++r) acc[dt][r] = 0.f;
#pragma unroll
            for (int ks = 0; ks < 4; ++ks) { const bf16x8 a = *(const PLAS bf16x8*)(lds + WT + g * WT_GROUP + (32 * dt + r32) * WT_PITCH + (16 * ks + 8 * hi) * 2), bq = *(const PLAS bf16x8*)(lds + PS + wave * PS_WAVE + r32 * PS_PITCH + (16 * ks + 8 * hi) * 2);
                acc[dt] = __builtin_amdgcn_mfma_f32_32x32x16_bf16(a, bq, acc[dt], 0, 0, 0); } }
        { const size_t m = (size_t)m0 + 32 * th + r32; const unsigned short* gp = P + m * NP + N_PG + g * 64; unsigned short* yp = Y + m * DM + 768 + g * 64;
#pragma unroll
            for (int dt = 0; dt < 2; ++dt)
#pragma unroll
                for (int g4 = 0; g4 < 4; ++g4) { const int d0 = 32 * dt + 8 * g4 + 4 * hi; const u32x2 gw = *(const u32x2*)(gp + d0);
                    const float g0 = __uint_as_float(gw[0] << 16), g1 = __uint_as_float(gw[0] & 0xffff0000u), g2 = __uint_as_float(gw[1] << 16), g3 = __uint_as_float(gw[1] & 0xffff0000u);
                    const float y0 = acc[dt][4 * g4] * (g0 / (1.0f + __expf(-g0))), y1 = acc[dt][4 * g4 + 1] * (g1 / (1.0f + __expf(-g1))), y2 = acc[dt][4 * g4 + 2] * (g2 / (1.0f + __expf(-g2))), y3 = acc[dt][4 * g4 + 3] * (g3 / (1.0f + __expf(-g3)));
                    *(u32x2*)(yp + d0) = (u32x2){cvtpk(y0, y1), cvtpk(y2, y3)}; } }
    }
    __syncthreads();
}
#undef PLAS
}
struct Args {
    const float* x; const float* norm_g; const float* w_in; const float* gate_w2; const float* gate_b; const float* gla_norm_g;
    const float* rel_bias; const float* pool_w; const float* pool_scale; const float* w_out; const float* final_g;
    float* out; unsigned char* ws;
    int l_lo, l_hi, ph_lo, ph_hi, single, pad;
};

__device__ __forceinline__ int src_col(int n, float& sc) {
    sc = 1.f;
    if (n < 192) { sc = 0.14433756729740643f; return n; }
    if (n < 768) return n;
    if (n < 1152) return 784 + (n - 768);
    if (n < 1536) { sc = 0.125f * LOG2E; return 1168 + (n - 1152); }
    if (n < 1920) return 1552 + (n - 1536);
    if (n < 2304) return 1936 + (n - 1920);
    if (n < 2688) return 2320 + (n - 2304);
    if (n < 2944) return 2868 + (n - 2688);
    if (n < 3200) return 3124 + (n - 2944);
    if (n < 3328) { sc = 0.17677669529663687f; return 2704 + (n - 3200); }
    if (n < 3360) return 2832 + (n - 3328);
    if (n < 3376) return 768 + (n - 3360);
    if (n < 3380) { sc = 0.5f; return 2864 + (n - 3376); }
    return -1;
}
__device__ __forceinline__ void prologue_phase(const Args& a, int wg, int G, int tid) {
    bf16* WIN = (bf16*)(a.ws + WS_WIN); bf16* WOUT = (bf16*)(a.ws + WS_WOUT);
    const long gt = (long)wg * NTHR + tid, gs = (long)G * NTHR;
    for (long i = gt; i < 4L * NP * 128; i += gs) {
        const int n = (int)(i % NP), k8 = (int)((i / NP) % 128), l = (int)(i / ((long)NP * 128));
        float sc; const int c = src_col(n, sc);
        v4u o = {0u, 0u, 0u, 0u};
        if (c >= 0) { const float* w = a.w_in + ((size_t)l * 1024 + k8 * 8) * IN_COLS + c; float v[8];
#pragma unroll
            for (int j = 0; j < 8; ++j) v[j] = w[(size_t)j * IN_COLS] * sc * a.norm_g[l * 1024 + k8 * 8 + j];
            o.x = pk2(v[0], v[1]); o.y = pk2(v[2], v[3]); o.z = pk2(v[4], v[5]); o.w = pk2(v[6], v[7]); }
        *(v4u*)(WIN + ((size_t)l * NP + n) * 1024 + k8 * 8) = o;
    }
    for (long i = gt; i < 4L * 1024 * 128; i += gs) {
        const int n = (int)(i % 1024), k8 = (int)((i / 1024) % 128), l = (int)(i / (1024L * 128));
        const float* w = a.w_out + ((size_t)l * 1024 + k8 * 8) * 1024 + n; float v[8];
#pragma unroll
        for (int j = 0; j < 8; ++j) v[j] = w[(size_t)j * 1024];
        v4u o; o.x = pk2(v[0], v[1]); o.y = pk2(v[2], v[3]); o.z = pk2(v[4], v[5]); o.w = pk2(v[6], v[7]);
        *(v4u*)(WOUT + ((size_t)l * 1024 + n) * 1024 + k8 * 8) = o;
    }
    { bf16* XA = (bf16*)(a.ws + WS_XA); float* RS = (float*)(a.ws + WS_RS); const int lane = tid & 63;
        for (int m = wg * NWAVES + (tid >> 6); m < M; m += G * NWAVES) { const f32x4* xr = (const f32x4*)(a.x + (size_t)m * DM) + lane; v2u* o = (v2u*)(XA + (size_t)m * DM) + lane; float s = 0.f;
#pragma unroll
            for (int j = 0; j < 4; ++j) { const f32x4 v = xr[64 * j]; v2u w; w.x = pk2(v.x, v.y); w.y = pk2(v.z, v.w); o[64 * j] = w; s += (bflo(w.x) * bflo(w.x) + bfhi(w.x) * bfhi(w.x)) + (bflo(w.y) * bflo(w.y) + bfhi(w.y) * bfhi(w.y)); }
            s = wave_sum(s, lane); if (lane < 16) RS[(size_t)m * 16 + lane] = (lane == 0) ? s : 0.f; } }
}
__device__ __forceinline__ void norm_phase(const float* src, const float* g, bf16* dst, int gw, int NGW, int lane) {
    for (int m = gw; m < M; m += NGW) {
        const f32x4* xr = (const f32x4*)(src + (size_t)m * DM) + lane; f32x4 v[4]; float s = 0.f;
#pragma unroll
        for (int j = 0; j < 4; ++j) { v[j] = xr[64 * j]; s += (v[j].x * v[j].x + v[j].y * v[j].y) + (v[j].z * v[j].z + v[j].w * v[j].w); }
        const float r = 1.0f / sqrtf(wave_sum(s, lane) * (1.f / DM) + EPS);
        const f32x4* gr = (const f32x4*)g + lane; v2u* o = (v2u*)(dst + (size_t)m * DM) + lane;
#pragma unroll
        for (int j = 0; j < 4; ++j) { const f32x4 gv = gr[64 * j]; v2u w; w.x = pk2(v[j].x * r * gv.x, v[j].y * r * gv.y); w.y = pk2(v[j].z * r * gv.z, v[j].w * r * gv.w); o[64 * j] = w; }
    }
}
__device__ __forceinline__ void final_norm_phase(const bf16* xa, float* out, const float* g, const float* RS, int gw, int NGW, int lane) {
    for (int m = gw; m < M; m += NGW) {
        const v2u* xr = (const v2u*)(xa + (size_t)m * DM) + lane; f32x4* orow = (f32x4*)(out + (size_t)m * DM) + lane;
        const f32x4* rs = (const f32x4*)(RS + (size_t)m * 16); const f32x4 s0 = rs[0], s1 = rs[1], s2 = rs[2], s3 = rs[3];
        const float ss = (((s0[0] + s0[1]) + (s0[2] + s0[3])) + ((s1[0] + s1[1]) + (s1[2] + s1[3]))) + (((s2[0] + s2[1]) + (s2[2] + s2[3])) + ((s3[0] + s3[1]) + (s3[2] + s3[3])));
        const float r = 1.0f / sqrtf(ss * (1.f / DM) + EPS);
        const f32x4* gr = (const f32x4*)g + lane;
#pragma unroll
        for (int j = 0; j < 4; ++j) { const f32x4 gv = gr[64 * j]; const v2u w = xr[64 * j]; orow[64 * j] = (f32x4){bflo(w.x) * r * gv.x, bfhi(w.x) * r * gv.y, bflo(w.y) * r * gv.z, bfhi(w.y) * r * gv.w}; }
    }
}
__device__ __forceinline__ void rowscale_phase(const float* RS, float* RSC, int wg, int G, int tid) {
    for (int m = wg * NTHR + tid; m < M; m += G * NTHR) { const f32x4* rs = (const f32x4*)(RS + (size_t)m * 16); const f32x4 s0 = rs[0], s1 = rs[1], s2 = rs[2], s3 = rs[3];
        const float ss = (((s0[0] + s0[1]) + (s0[2] + s0[3])) + ((s1[0] + s1[1]) + (s1[2] + s1[3]))) + (((s2[0] + s2[1]) + (s2[2] + s2[3])) + ((s3[0] + s3[1]) + (s3[2] + s3[3])));
        RSC[m] = 1.0f / sqrtf(ss * (1.0f / 1024.0f) + EPS); }
}
__device__ __forceinline__ void pool_phase(const Args& a, int l, unsigned char* lds, int wg, int G, int tid) {
    float* wsm = (float*)lds; float* us = (float*)(lds + 16384); float* ps = (float*)(lds + 32768);
    const bf16* P = (const bf16*)(a.ws + WS_P); bf16* Y = (bf16*)(a.ws + WS_XB);
    for (int g = 0; g < 4; ++g) {
        __syncthreads();
        const float* pw = a.pool_w + (size_t)(l * 4 + g) * 4096;
        for (int i = tid; i < 4096; i += NTHR) wsm[i] = pw[i];
        const int w = 2 << g;
        for (int tile = wg; tile < M / 32; tile += G) {
            __syncthreads();
            const int m0 = tile * 32, t0 = m0 % SEQ;
            for (int i = tid; i < 47 * 64; i += NTHR) { const int r = i >> 6, c = i & 63; float v = 0.f;
                if (t0 + r - 15 >= 0) v = bf2f(P[(size_t)(m0 - 15 + r) * NP + N_PU + g * 64 + c]);
                us[i] = v; }
            __syncthreads();
            { const int t = tid >> 4, c4 = (tid & 15) * 4, pos = t0 + t; const int cnt = (pos + 1 < w) ? pos + 1 : w; const float inv = 1.0f / (float)cnt;
#pragma unroll
                for (int k = 0; k < 4; ++k) { const int c = c4 + k; float s = 0.f; for (int j = 0; j < w; ++j) s += us[(t + 15 - j) * 64 + c]; ps[t * 64 + c] = s * inv - us[(t + 15) * 64 + c]; } }
            __syncthreads();
            { const int t = tid >> 4, d4 = (tid & 15) * 4; float a0 = 0.f, a1 = 0.f, a2 = 0.f, a3 = 0.f;
                for (int c = 0; c < 64; ++c) { const float p = ps[t * 64 + c]; const f32x4 wv = *(const f32x4*)&wsm[c * 64 + d4]; a0 += p * wv.x; a1 += p * wv.y; a2 += p * wv.z; a3 += p * wv.w; }
                const size_t m = (size_t)m0 + t; const v2u gw2 = *(const v2u*)(P + m * NP + N_PG + g * 64 + d4);
                const float* scl = a.pool_scale + l * 256 + g * 64 + d4;
                const float y0 = a0 * scl[0] * silu_f(bflo(gw2.x)), y1 = a1 * scl[1] * silu_f(bfhi(gw2.x)), y2 = a2 * scl[2] * silu_f(bflo(gw2.y)), y3 = a3 * scl[3] * silu_f(bfhi(gw2.y));
                v2u o; o.x = pk2(y0, y1); o.y = pk2(y2, y3); *(v2u*)(Y + m * DM + 768 + g * 64 + d4) = o; }
        }
    }
    __syncthreads();
}
__device__ __forceinline__ void gla_rec_phase(const Args& a, int l, unsigned char* lds, int unit, int tid) {
    const int b = unit >> 2, h = unit & 3;
    float* qs = (float*)lds; float* ks = (float*)(lds + 12288); float* es = (float*)(lds + 24576); float* vs = (float*)(lds + 36864); float* os = (float*)(lds + 61440);
    float* w2s = (float*)(lds + 86016); float* bs = (float*)(lds + 89088); float* gzs = (float*)(lds + 89280);
    const bf16* P = (const bf16*)(a.ws + WS_P); bf16* Y = (bf16*)(a.ws + WS_XB);
    __syncthreads();
    for (int i = tid; i < 16 * 48; i += NTHR) { const int r = i / 48, d = i % 48; w2s[i] = a.gate_w2[(size_t)(l * 16 + r) * 192 + h * 48 + d]; }
    if (tid < 48) bs[tid] = a.gate_b[l * 192 + h * 48 + tid];
    float S[48];
#pragma unroll
    for (int d = 0; d < 48; ++d) S[d] = 0.f;
    for (int blk = 0; blk < SEQ / 64; ++blk) {
        const size_t m0 = (size_t)b * SEQ + (size_t)blk * 64;
        __syncthreads();
        for (int i = tid; i < 64 * 48; i += NTHR) { const int t = i / 48, d = i % 48; const bf16* row = P + (m0 + t) * NP; qs[i] = bf2f(row[N_GQ + h * 48 + d]); ks[i] = bf2f(row[N_GK + h * 48 + d]); }
        for (int i = tid; i < 64 * 96; i += NTHR) { const int t = i / 96, v = i % 96; vs[i] = bf2f(P[(m0 + t) * NP + N_GV + h * 96 + v]); }
        for (int i = tid; i < 64 * 16; i += NTHR) { const int t = i >> 4, r = i & 15; gzs[i] = bf2f(P[(m0 + t) * NP + N_GZ + r]); }
        __syncthreads();
        for (int i = tid; i < 64 * 48; i += NTHR) { const int t = i / 48, d = i % 48; float z = bs[d];
#pragma unroll
            for (int r = 0; r < 16; ++r) z += gzs[t * 16 + r] * w2s[r * 48 + d];
            const float ls = fminf(z, 0.f) - log1pf(__expf(-fabsf(z)));
            es[i] = __expf(ls * (1.0f / 16.0f)); }
        __syncthreads();
        if (tid < 96) { const int v = tid;
            for (int t = 0; t < 64; ++t) { const float vv = vs[t * 96 + v]; float o = 0.f;
#pragma unroll
                for (int d = 0; d < 48; ++d) { S[d] = es[t * 48 + d] * S[d] + ks[t * 48 + d] * vv; o += qs[t * 48 + d] * S[d]; }
                os[t * 96 + v] = o; } }
        __syncthreads();
        { const int t = tid >> 3, part = tid & 7; float ov[12]; float ss = 0.f;
#pragma unroll
            for (int k = 0; k < 12; ++k) { ov[k] = os[t * 96 + part * 12 + k]; ss += ov[k] * ov[k]; }
            { const int ln = tid & 63; ss += shx(ss, 1, ln); ss += shx(ss, 2, ln); ss += shx(ss, 4, ln); }
            const float r = 1.0f / sqrtf(ss * (1.0f / 96.0f) + EPS);
            const size_t m = m0 + t; const bf16* gp = P + m * NP + N_GG + h * 96 + part * 12; const float* ng = a.gla_norm_g + l * 96 + part * 12;
            unsigned* yo = (unsigned*)(Y + m * DM + h * 96 + part * 12);
#pragma unroll
            for (int k = 0; k < 12; k += 2) { const float y0 = ov[k] * r * ng[k] * silu_f(bf2f(gp[k])), y1 = ov[k + 1] * r * ng[k + 1] * silu_f(bf2f(gp[k + 1])); yo[k >> 1] = pk2(y0, y1); } }
    }
    __syncthreads();
}
template <bool BITS_ONLY> __device__ __forceinline__ void dsa_slow_query(const Args& a, unsigned char* lds, int b, int t, int tid) {
    const int lane = tid & 63, wave = tid >> 6;
    unsigned* sc = (unsigned*)lds; int* hist = (int*)(lds + 32768); int* sel = (int*)(lds + 33792); float* qf = (float*)(lds + 34816); float* wq = (float*)(lds + 35328);
    int* misc = (int*)(lds + 35344); float* qh = (float*)(lds + 35456); float* lg = (float*)(lds + 36992); float* inv = (float*)(lds + 43136);
    const bf16* P = (const bf16*)(a.ws + WS_P); bf16* Y = (bf16*)(a.ws + WS_XB);
    {
        const size_t m = (size_t)b * SEQ + t; const int N = t + 1;
        __syncthreads();
        if (tid < 128) qf[tid] = bf2f(P[m * NP + N_QI + tid]);
        if (tid >= 128 && tid < 132) wq[tid - 128] = bf2f(P[m * NP + N_WI + tid - 128]);
        for (int i = tid; i < 384; i += NTHR) qh[i] = bf2f(P[m * NP + N_DQ + i]);
        __syncthreads();
        for (int s = tid; s < N; s += NTHR) {
            const v4u* kr = (const v4u*)(P + ((size_t)b * SEQ + s) * NP + N_KI); float kf[32];
#pragma unroll
            for (int c = 0; c < 4; ++c) { const v4u w = kr[c]; kf[8 * c] = bflo(w.x); kf[8 * c + 1] = bfhi(w.x); kf[8 * c + 2] = bflo(w.y); kf[8 * c + 3] = bfhi(w.y); kf[8 * c + 4] = bflo(w.z); kf[8 * c + 5] = bfhi(w.z); kf[8 * c + 6] = bflo(w.w); kf[8 * c + 7] = bfhi(w.w); }
            float score = 0.f;
#pragma unroll
            for (int hh = 0; hh < 4; ++hh) { float dot = 0.f;
#pragma unroll
                for (int d = 0; d < 32; ++d) dot += qf[hh * 32 + d] * kf[d];
                score += wq[hh] * fmaxf(dot, 0.f); }
            const unsigned u = __builtin_bit_cast(unsigned, score);
            sc[s] = (u & 0x80000000u) ? ~u : (u | 0x80000000u);
        }
        __syncthreads();
        int L;
        if (N <= 256) { if (tid < N) sel[tid] = tid; L = N; }
        else {
            unsigned prefix = 0u; int kk = 256;
            for (int pass = 0; pass < 4; ++pass) {
                const int shift = 24 - 8 * pass;
                if (tid < 256) hist[tid] = 0;
                __syncthreads();
                for (int s = tid; s < N; s += NTHR) { const unsigned key = sc[s]; const bool match = (pass == 0) ? true : ((key >> ((shift + 8) & 31)) == prefix); if (match) atomicAdd(&hist[(key >> shift) & 255u], 1); }
                __syncthreads();
                if (wave == 0) {
                    const int c0 = hist[4 * lane], c1 = hist[4 * lane + 1], c2 = hist[4 * lane + 2], c3 = hist[4 * lane + 3]; const int tot = c0 + c1 + c2 + c3;
                    int incl = tot;
#pragma unroll
                    for (int o = 1; o < 64; o <<= 1) { const int tt = shdn(incl, o, lane); if (lane + o < 64) incl += tt; }
                    const int excl = incl - tot;
                    if (excl < kk && kk <= incl) { int above = excl, D;
                        if (above + c3 >= kk) D = 4 * lane + 3;
                        else { above += c3; if (above + c2 >= kk) D = 4 * lane + 2; else { above += c2; if (above + c1 >= kk) D = 4 * lane + 1; else { above += c1; D = 4 * lane; } } }
                        misc[1] = D; misc[2] = above; }
                }
                __syncthreads();
                prefix = (prefix << 8) | (unsigned)misc[1]; kk -= misc[2];
            }
            const unsigned tau = prefix;
            const int seg = (((N + 7) >> 3) + 63) & ~63; const int s_lo = wave * seg, s_hi = (s_lo + seg < N) ? s_lo + seg : N;
            { int cg = 0, ce = 0;
                for (int base = s_lo; base < s_hi; base += 64) { const int s = base + lane; const bool in = s < s_hi; const unsigned key = in ? sc[s] : 0u;
                    cg += __popcll(__ballot(in && key > tau)); ce += __popcll(__ballot(in && key == tau)); }
                if (lane == 0) { misc[4 + wave] = cg; misc[12 + wave] = ce; } }
            __syncthreads();
            { int bg = 0, be = 0;
                for (int w2 = 0; w2 < 8; ++w2) if (w2 < wave) { bg += misc[4 + w2]; be += misc[12 + w2]; }
                int run_sel = bg + (be < kk ? be : kk), run_eq = be;
                for (int base = s_lo; base < s_hi; base += 64) { const int s = base + lane; const bool in = s < s_hi; const unsigned key = in ? sc[s] : 0u;
                    const bool gt = in && key > tau, eq = in && key == tau; const unsigned long long me = __ballot(eq); const unsigned long long lt = (1ull << lane) - 1ull;
                    const bool take = gt || (eq && (run_eq + __popcll(me & lt) < kk)); const unsigned long long mt = __ballot(take);
                    if (take) sel[run_sel + __popcll(mt & lt)] = s;
                    run_sel += __popcll(mt); run_eq += __popcll(me); } }
            L = 256;
        }
        __syncthreads();
        if constexpr (BITS_ONLY) {
            unsigned* bm = (unsigned*)lg; unsigned* MK = (unsigned*)(a.ws + WS_MASK);
            if (tid < 256) bm[tid] = 0u;
            __syncthreads();
            if (tid < L) { const int s = sel[tid]; const int kt = s >> 6, kap = s & 63, half = kap >> 5, k5 = kap & 31, hi = (k5 >> 2) & 1, r = (k5 & 3) + 4 * (k5 >> 3);
                atomicOr(&bm[kt * 2 + hi], 1u << (r + 16 * half)); }
            __syncthreads();
            const int ntw = ((t >> 8) + 1) * 8;
            if (tid < ntw) { const int kt = tid >> 1, hi = tid & 1; MK[((size_t)(b * 256 + (t >> 5)) * 128 + kt) * 64 + (t & 31) + 32 * hi] = bm[tid]; }
            __syncthreads();
            return;
        }
        { const int j = tid >> 1, h0 = (tid & 1) * 3;
            if (j < L) { const int s = sel[j]; const size_t srow = (size_t)b * SEQ + s; const int bk = t5_bucket(t - s);
#pragma unroll
                for (int hh = 0; hh < 3; ++hh) { const int h = h0 + hh; const v4u* kr = (const v4u*)(P + srow * NP + N_DK + h * 64); const float* q = qh + h * 64; float dot = 0.f;
#pragma unroll
                    for (int c = 0; c < 8; ++c) { const v4u w = kr[c]; dot += q[8 * c] * bflo(w.x) + q[8 * c + 1] * bfhi(w.x) + q[8 * c + 2] * bflo(w.y) + q[8 * c + 3] * bfhi(w.y) + q[8 * c + 4] * bflo(w.z) + q[8 * c + 5] * bfhi(w.z) + q[8 * c + 6] * bflo(w.w) + q[8 * c + 7] * bfhi(w.w); }
                    lg[h * 256 + j] = dot + a.rel_bias[bk * 6 + h] * LOG2E; } }
            else {
#pragma unroll
                for (int hh = 0; hh < 3; ++hh) lg[(h0 + hh) * 256 + j] = -INFINITY; } }
        __syncthreads();
        if (wave < 6) { float* row = lg + wave * 256; float v0 = row[lane], v1 = row[lane + 64], v2 = row[lane + 128], v3 = row[lane + 192];
            float mx = fmaxf(fmaxf(v0, v1), fmaxf(v2, v3));
#pragma unroll
            for (int o = 1; o < 64; o <<= 1) mx = fmaxf(mx, shx(mx, o, lane));
            v0 = exp2f(v0 - mx); v1 = exp2f(v1 - mx); v2 = exp2f(v2 - mx); v3 = exp2f(v3 - mx);
            const float sm = wave_sum((v0 + v1) + (v2 + v3), lane);
            row[lane] = v0; row[lane + 64] = v1; row[lane + 128] = v2; row[lane + 192] = v3;
            if (lane == 0) inv[wave] = 1.0f / sm; }
        __syncthreads();
        if (tid < 384) { const int h = tid >> 6, d = tid & 63; float acc = 0.f; const bf16* vb = P + (size_t)b * SEQ * NP + N_DV + h * 64 + d;
            for (int j = 0; j < L; ++j) acc += lg[h * 256 + j] * bf2f(vb[(size_t)sel[j] * NP]);
            const float o = acc * inv[h]; const float gate = bf2f(P[m * NP + N_DG + h * 64 + d]);
            Y[m * DM + 384 + h * 64 + d] = (bf16)f2bf(o * silu_f(gate)); }
    }
    __syncthreads();
}
template <bool BITS_ONLY> __device__ __forceinline__ void dsa_slow_phase(const Args& a, int l, unsigned char* lds, int wg, int G, int tid) {
    for (int qi = wg; qi < M; qi += G) { asm volatile("" : "+v"(tid)); dsa_slow_query<BITS_ONLY>(a, lds, qi & 7, qi >> 3, tid); }
}
__device__ __forceinline__ void index_phase(const Args& a, unsigned char* lds, unsigned* qctr, volatile LAS unsigned* MISC, int tid) {
    const unsigned short* P = (const unsigned short*)(a.ws + WS_P); unsigned* MK = (unsigned*)(a.ws + WS_MASK);
    __syncthreads();
    if (tid <= 256) ((float*)(lds + idxb::L_XT))[tid] = tid < 256 ? idxb::xthr(tid) : __builtin_inff();
    int bq = blockIdx.x & 7, tries = 0;
    for (;;) {
        asm volatile("" : "+v"(tid));
        __syncthreads();
        if (tid == 0) MISC[17] = __hip_atomic_fetch_add(qctr + 64 * bq, 1u, __ATOMIC_RELAXED, __HIP_MEMORY_SCOPE_AGENT);
        __syncthreads();
        const int k = (int)MISC[17];
        if (k >= 256) { if (++tries == 8) break; bq = (bq + 1) & 7; continue; }
        const int b = bq, qt = 255 - k;
        idxb::index_unit(P, (const unsigned short*)(a.ws + WS_KC), MK, (unsigned*)(a.ws + WS_ZW) + (size_t)blockIdx.x * 128 * 64, lds, b, qt, tid);
        const int* par = (const int*)(lds + idxb::L_PAR);
        for (int q = 0; q < 32; ++q) if (par[idxb::P_MODE * 32 + q] == 3) dsa_slow_query<true>(a, lds, b, qt * 32 + q, tid);
    }
}
#ifndef REP_POOL
#define REP_POOL 1
#endif
#ifndef ATT_PRIO
#define ATT_PRIO 0
#endif
#ifndef REP_IDX
#define REP_IDX 1
#endif
#ifndef REP_GLA
#define REP_GLA 1
#endif
#ifndef REP_ATT
#define REP_ATT 1
#endif
#ifndef REP_PREP
#define REP_PREP 1
#endif
#ifndef REP_PRO
#define REP_PRO 1
#endif
#ifndef REP_NORM
#define REP_NORM 1
#endif
#ifndef REP_ALL
#define REP_ALL 1
#endif
#ifndef REP_BAR
#define REP_BAR 1
#endif
#ifndef REP_OUT
#define REP_OUT 1
#endif
#ifndef REP_INP
#define REP_INP 1
#endif
#ifndef GLA_MODE
#define GLA_MODE 1
#endif
#ifndef DSA_MODE
#define DSA_MODE 2
#endif
#ifndef MK_SINGLE
#define MK_SINGLE 1
#endif
__global__ void __launch_bounds__(NTHR, 2) fwd(Args a) {
    extern __shared__ __attribute__((aligned(16))) unsigned char lds[];
    int tid = threadIdx.x, lane = tid & 63, wave = __builtin_amdgcn_readfirstlane(tid >> 6);
    int G = gridDim.x, wg = blockIdx.x;
    const int wave0 = __builtin_amdgcn_readfirstlane(tid >> 6);
#define LAUNDER() do { { int wv_ = wave0; asm volatile("" : "+s"(wv_)); unsigned on_ = ~0u; asm volatile("" : "+s"(on_)); tid = wv_ * 64 + (int)__builtin_amdgcn_mbcnt_hi(on_, __builtin_amdgcn_mbcnt_lo(on_, 0u)); asm volatile("" : "+v"(tid)); } wg = blockIdx.x; G = gridDim.x; asm volatile("" : "+s"(wg), "+s"(G));     \
    lane = tid & 63; wave = __builtin_amdgcn_readfirstlane(tid >> 6); gw = wg * NWAVES + wave; NGW = G * NWAVES; } while (0)
    volatile LAS unsigned* MISC = (volatile LAS unsigned*)((LAS unsigned char*)lds + MISC_OFF);
    for (int u = tid; u < (LDS_BYTES - LDSCTL_OFF) / 4; u += NTHR) ((LAS unsigned*)((LAS unsigned char*)lds + LDSCTL_OFF))[u] = 0u;
    __syncthreads();
    XcdBarrier bar; bar.bar = (unsigned*)(a.ws + WS_CTL) + CW_BAR; bar.x = 0; bar.st = nullptr;
    const bool one = a.single != 0;
    if (one) bar = xcd_barrier_post((unsigned*)(a.ws + WS_CTL) + CW_BAR, MISC + 8);
#define IN(k) (a.ph_lo <= (k) && (k) < a.ph_hi)
#define SEAM() do { if (one) { unsigned* bp_ = (unsigned*)(a.ws + WS_CTL) + CW_BAR; asm volatile("" : "+s"(bp_)); XcdBarrier bb_; bb_.bar = bp_; bb_.x = bar.x; bb_.st = bar.st; xcd_barrier(bb_); if (REP_BAR == 2) xcd_barrier(bb_); } } while (0)
    int gw = wg * NWAVES + wave, NGW = G * NWAVES;
    bf16* XB = (bf16*)(a.ws + WS_XB); bf16* PB = (bf16*)(a.ws + WS_P);
    for (int rpw = 0; rpw < REP_ALL; ++rpw) {
    LAUNDER();
    if (IN(0)) { for (int rp = 0; rp < REP_PRO; ++rp) prologue_phase(a, wg, G, tid); SEAM(); }
    for (int l = a.l_lo; l < a.l_hi; ++l) {
        LAUNDER();
        if (IN(1)) { rowscale_phase((const float*)(a.ws + WS_RS), (float*)(a.ws + WS_RSC), wg, G, tid); SEAM(); }
        LAUNDER();
        if (IN(2)) {
            pg8::Gemm g{(const bf16*)(a.ws + WS_XA), (const bf16*)(a.ws + WS_WIN) + (size_t)l * NP * 1024, M, NP, DM}; pg8::StaticOrder S; S.init(M, NP, G, wg);
            pg8::EpiP E{PB, NP, (const float*)(a.ws + WS_RSC), (pg8::bf16_t*)(a.ws + WS_KC)};
            pg8::gemm_phase<pg8::EpiP, pg8::StaticOrder, true, true>((PG8_LAS unsigned char*)lds, g, S, E, tid);
#if REP_INP == 2
            asm volatile("" : "+v"(tid)); __syncthreads(); pg8::gemm_phase<pg8::EpiP, pg8::StaticOrder, true, true>((PG8_LAS unsigned char*)lds, g, S, E, tid);
#endif
            SEAM();
        }
        LAUNDER();
        if (IN(3)) {
#if GLA_MODE == 0
            if (wg < 32) gla_rec_phase(a, l, lds, wg, tid);
#endif
            for (int rp = 0; rp < REP_POOL; ++rp) { asm volatile("" : "+v"(tid)); poolb::pool_phase(PB, XB, a.pool_w + (size_t)l * 4 * 4096, a.pool_scale + l * 256, lds, wg, G, tid); }
#if GLA_MODE == 1
            glab::gla_prep_loop(PB, a.ws + WS_GOP, a.gate_w2 + (size_t)l * 16 * 192, a.gate_b + l * 192, lds, wg, G, tid);
#if REP_PREP == 2
            __syncthreads(); asm volatile("" : "+v"(tid), "+s"(wg));
            for (int item = wg; item < BATCH * 4 * 128; item += G) { asm volatile("" : "+v"(tid)); glab::gla_prep_item(PB, a.ws + WS_GOP, a.gate_w2 + (size_t)l * 16 * 192, a.gate_b + l * 192, lds, item, tid); }
#endif
            __syncthreads();
#endif
#if DSA_MODE == 0
            dsa_slow_phase<false>(a, l, lds, wg, G, tid);
#elif DSA_MODE == 1
            dsa_slow_phase<true>(a, l, lds, wg, G, tid);
#else
            for (int rp = 0; rp < REP_IDX; ++rp) { asm volatile("" : "+v"(tid)); index_phase(a, lds, (unsigned*)(a.ws + WS_CTL) + CW_QUEUE + 64 * (32 + 8 * (l + 4 * rp + 8 * rpw)), MISC, tid); }
#endif
            SEAM();
        }
        LAUNDER();
        if (IN(4)) {
#if DSA_MODE >= 1
            { float* dl = (float*)(lds + 86016);
                for (int i = tid; i < 1032; i += NTHR) { const int rel = i >> 3, h = i & 7; dl[i] = (h < 6 && rel < 128) ? (a.rel_bias[(int)T5B[rel] * 6 + h] - a.rel_bias[31 * 6 + h]) * LOG2E : 0.f; } for (int i = tid; i < 512; i += NTHR) { const unsigned nb = ((unsigned)(i >> 1) >> (4 * (i & 1))) & 15u; ((unsigned*)(lds + attn_body::LDS_TAB))[i] = (nb & 1u ? 0xffu : 0u) | (nb & 2u ? 0xff00u : 0u) | (nb & 4u ? 0xff0000u : 0u) | (nb & 8u ? 0xff000000u : 0u); }
                __syncthreads();
                const attn_body::AttnTensors AT{(const attn_body::bf16*)(PB + N_DQ), (const attn_body::bf16*)(PB + N_DK), (const attn_body::bf16*)(PB + N_DV), (attn_body::bf16*)(XB + 384), (const attn_body::bf16*)(PB + N_DG), (const unsigned*)(a.ws + WS_MASK)};
#if GLA_MODE == 1
                if (wg < 32) { glab::gla_seq_unit(PB, XB, a.ws + WS_GOP, a.gla_norm_g + l * 96, lds, wg >> 2, wg & 3, tid);
#if REP_GLA == 2
                    asm volatile("" : "+v"(tid)); glab::gla_seq_unit(PB, XB, a.ws + WS_GOP, a.gla_norm_g + l * 96, lds, wg >> 2, wg & 3, tid);
#endif
                    for (int i = tid; i < 1032; i += NTHR) { const int rel = i >> 3, h = i & 7; dl[i] = (h < 6 && rel < 128) ? (a.rel_bias[(int)T5B[rel] * 6 + h] - a.rel_bias[31 * 6 + h]) * LOG2E : 0.f; } for (int i = tid; i < 512; i += NTHR) { const unsigned nb = ((unsigned)(i >> 1) >> (4 * (i & 1))) & 15u; ((unsigned*)(lds + attn_body::LDS_TAB))[i] = (nb & 1u ? 0xffu : 0u) | (nb & 2u ? 0xff00u : 0u) | (nb & 4u ? 0xff0000u : 0u) | (nb & 8u ? 0xff000000u : 0u); }
                    __syncthreads(); }
#endif
#if ATT_PRIO
                if (__builtin_amdgcn_readfirstlane(tid) >= 256) __builtin_amdgcn_s_setprio(1);
#endif
                for (int rp = 0; rp < REP_ATT; ++rp) { unsigned* qctr = (unsigned*)(a.ws + WS_CTL) + CW_QUEUE + 64 * (l * 4 + rp + 2 * rpw);
                for (;;) { asm volatile("" : "+v"(tid));
                    __syncthreads();
                    if (tid == 0) MISC[16] = __hip_atomic_fetch_add(qctr, 1u, __ATOMIC_RELAXED, __HIP_MEMORY_SCOPE_AGENT);
                    __syncthreads();
                    const int k = (int)MISC[16];
                    if (k >= 48 * 32) break;
                    const int qb = 31 - k / 48, bh = k % 48;
                    attn_body::attn_unit<8>(bh / 6, bh % 6, qb, AT.Q, AT.K, AT.V, AT.O, AT.GT, AT.MK, (attn_body::lds_cfptr)(LAS const float*)((LAS unsigned char*)lds + 86016), (char*)lds, tid); } }
#if ATT_PRIO
                __builtin_amdgcn_s_setprio(0);
#endif
            }
#endif
            SEAM();
        }
        LAUNDER();
        if (IN(5)) {
            pg8::Gemm g{XB, (const bf16*)(a.ws + WS_WOUT) + (size_t)l * 1024 * 1024, M, DM, DM}; pg8::StaticOrder S; S.init(M, DM, G, wg);
            pg8::EpiRes E{(bf16*)(a.ws + WS_XA), DM, (float*)(a.ws + WS_RS)};
            pg8::gemm_phase<pg8::EpiRes, pg8::StaticOrder, true, true>((PG8_LAS unsigned char*)lds, g, S, E, tid);
#if REP_OUT == 2
            { asm volatile("" : "+v"(tid)); __syncthreads(); pg8::EpiRes E2{(bf16*)(a.ws + WS_P), DM, (float*)(a.ws + WS_P) + (size_t)M * DM}; pg8::gemm_phase<pg8::EpiRes, pg8::StaticOrder, true, true>((PG8_LAS unsigned char*)lds, g, S, E2, tid); }
#endif
            SEAM();
        }
    }
    }
    LAUNDER();
    if (IN(6)) final_norm_phase((const bf16*)(a.ws + WS_XA), a.out, a.final_g, (const float*)(a.ws + WS_RS), gw, NGW, lane);
#undef IN
#undef SEAM
}

extern "C" void kernel_launch(void* const* d_in, const int* in_sizes, int n_in, void* d_out, int out_size, void* d_ws, size_t ws_size, hipStream_t stream) {
    static int grid = 0;
    if (grid == 0) {
        if (n_in != 11 || in_sizes[0] != M * DM || out_size != M * DM || ws_size < WS_END) { fprintf(stderr, "kernel_launch: unexpected shapes (n_in %d, in0 %d, out %d, ws %zu); nothing launched\n", n_in, n_in > 0 ? in_sizes[0] : -1, out_size, ws_size); grid = -1; return; }
        int dev = 0, cus = 0, per_cu = 0;
        if (hipGetDevice(&dev) != hipSuccess || hipDeviceGetAttribute(&cus, hipDeviceAttributeMultiprocessorCount, dev) != hipSuccess) { grid = -1; return; }
        if (hipFuncSetAttribute((const void*)fwd, hipFuncAttributeMaxDynamicSharedMemorySize, LDS_BYTES) != hipSuccess) { fprintf(stderr, "kernel_launch: hipFuncSetAttribute failed\n"); grid = -1; return; }
        if (hipOccupancyMaxActiveBlocksPerMultiprocessor(&per_cu, (const void*)fwd, NTHR, LDS_BYTES) != hipSuccess || per_cu < 1) fprintf(stderr, "kernel_launch: occupancy query reports %d\n", per_cu);
        (void)hipGetLastError();
        grid = cus;
    }
    if (grid < 0) return;
    if (hipMemsetAsync((char*)d_ws + WS_CTL, 0, CTL_ZERO_BYTES, stream) != hipSuccess) return;
    Args a{};
    a.x = (const float*)d_in[0]; a.norm_g = (const float*)d_in[1]; a.w_in = (const float*)d_in[2]; a.gate_w2 = (const float*)d_in[3]; a.gate_b = (const float*)d_in[4]; a.gla_norm_g = (const float*)d_in[5];
    a.rel_bias = (const float*)d_in[6]; a.pool_w = (const float*)d_in[7]; a.pool_scale = (const float*)d_in[8]; a.w_out = (const float*)d_in[9]; a.final_g = (const float*)d_in[10];
    a.out = (float*)d_out; a.ws = (unsigned char*)d_ws; a.pad = 0;
#if MK_SINGLE
    a.l_lo = 0; a.l_hi = DEPTH; a.ph_lo = 0; a.ph_hi = 7; a.single = 1;
    hipLaunchKernelGGL(fwd, dim3(grid), dim3(NTHR), LDS_BYTES, stream, a);
#else
    a.single = 0;
    a.l_lo = 0; a.l_hi = 0; a.ph_lo = 0; a.ph_hi = 1; hipLaunchKernelGGL(fwd, dim3(grid), dim3(NTHR), LDS_BYTES, stream, a);
    for (int l = 0; l < DEPTH; ++l) for (int ph = 1; ph <= 5; ++ph) { a.l_lo = l; a.l_hi = l + 1; a.ph_lo = ph; a.ph_hi = ph + 1; hipLaunchKernelGGL(fwd, dim3(grid), dim3(NTHR), LDS_BYTES, stream, a); }
    a.l_lo = 0; a.l_hi = 0; a.ph_lo = 6; a.ph_hi = 7; hipLaunchKernelGGL(fwd, dim3(grid), dim3(NTHR), LDS_BYTES, stream, a);
#endif
    const hipError_t le = hipPeekAtLastError();
    if (le != hipSuccess) fprintf(stderr, "kernel_launch: launch failed: %s\n", hipGetErrorName(le));
}
```

```cpp
#include <hip/hip_runtime.h>
#include <cstdio>
#include <cstdint>
namespace pg8 {
#define PG8_LAS __attribute__((address_space(3)))
typedef unsigned short bf16_t;
typedef short bf16x8 __attribute__((ext_vector_type(8)));
typedef float f32x4 __attribute__((ext_vector_type(4)));
typedef unsigned u32x4 __attribute__((ext_vector_type(4)));
constexpr int BM = 256, BK = 64, HALF = 128, HTB = HALF * BK * 2  , STAGE_BYTES = 8 * HTB, NXCD = 8, WGM = 8;

__host__ __device__ __forceinline__ int lds_byte(int r, int c) { const int st = (r >> 4) * 2 + (c >> 5), rr = r & 15, cc = c & 31, ob = rr * 64 + cc * 2; return st * 1024 + (ob ^ (((ob >> 9) & 1) << 5)); }
__host__ __device__ __forceinline__ void stage_rc(int b, int& R, int& C) { const int st = b / 1024, sb = b % 1024, swz = sb ^ (((sb >> 9) & 1) << 5); R = (st >> 1) * 16 + swz / 64; C = (st & 1) * 32 + (swz % 64) / 2; }
__host__ __device__ __forceinline__ int perm32(int rho) { const int n = rho >> 4, i = rho & 15; return 8 * (i >> 2) + 4 * n + (i & 3); }

struct Unit { int pm, pn; };
struct Gemm { const bf16_t* A; const bf16_t* Bt; int M, N, K; };

struct StaticOrder {
    int nM, nN, nwg, G, c;
    __host__ __device__ void init(int M, int N, int G_, int c_) { nM = M / BM; nN = N / BM; nwg = nM * nN; G = G_; c = c_; }
    __host__ __device__ bool next(int i, Unit& u) const {
        const long L = (long)i * G + c; if (L >= nwg) return false;
        int wgid = (int)L; { const int q = nwg / NXCD, r = nwg % NXCD, xcd = wgid % NXCD, off = wgid / NXCD; wgid = (xcd < r ? xcd * (q + 1) : r * (q + 1) + (xcd - r) * q) + off; }
        const int nig = WGM * nN, gid = wgid / nig, fm = gid * WGM, gsz = (nM - fm) < WGM ? (nM - fm) : WGM;
        u.pm = fm + ((wgid % nig) % gsz); u.pn = (wgid % nig) / gsz; return true;
    }
    __device__ __forceinline__ void a_ready(const Unit&) const {}
    __device__ __forceinline__ void done(const Unit&) const {}
};

__device__ __forceinline__ unsigned cvt_pk_bf16(float lo, float hi) { unsigned r; asm volatile("v_cvt_pk_bf16_f32 %0, %1, %2" : "=v"(r) : "v"(lo), "v"(hi)); return r; }
typedef float f32x2 __attribute__((ext_vector_type(2)));
struct EpiP {
    static constexpr bool PERM = true, AFTER_DRAIN = false;
    bf16_t* O; int ldc; const float* RS; bf16_t* KC;
    __device__ __forceinline__ void operator()(const f32x4 (&acc)[2][2][4][2], const Unit& u, int wr, int wc, int fr, int fq) const {
        const int row0 = u.pm * BM + wr * 64 + fr, col0 = u.pn * BM + wc * 32 + 8 * fq;
#pragma unroll
        for (int ai = 0; ai < 2; ++ai)
#pragma unroll
            for (int m = 0; m < 4; ++m) { const int row = row0 + ai * HALF + m * 16; bf16_t* rowp = O + (size_t)row * ldc + col0;
                const float r = RS[row];
#pragma unroll
                for (int bj = 0; bj < 2; ++bj) { const f32x4 v0 = acc[ai][bj][m][0] * r, v1 = acc[ai][bj][m][1] * r;
                    u32x4 w; w.x = cvt_pk_bf16(v0[0], v0[1]); w.y = cvt_pk_bf16(v0[2], v0[3]); w.z = cvt_pk_bf16(v1[0], v1[1]); w.w = cvt_pk_bf16(v1[2], v1[3]);
                    if (col0 + bj * HALF < 3384) *(u32x4*)(rowp + bj * HALF) = w;
                    if (bj == 0 && wc == 0 && u.pn == 13) *(u32x4*)(KC + (size_t)row * 32 + 8 * fq) = w; } }
    }
};
struct EpiRes {
    static constexpr bool PERM = true, AFTER_DRAIN = false;
    bf16_t* XA; int ldc; float* RS;
    __device__ __forceinline__ void operator()(const f32x4 (&acc)[2][2][4][2], const Unit& u, int wr, int wc, int fr, int fq) const {
        const int row0 = u.pm * BM + wr * 64 + fr, col0 = u.pn * BM + wc * 32 + 8 * fq, lane = fr + 16 * fq;
#pragma unroll
        for (int ai = 0; ai < 2; ++ai)
#pragma unroll
            for (int m = 0; m < 4; ++m) { const int row = row0 + ai * HALF + m * 16; const size_t off = (size_t)row * ldc + col0; float s = 0.f;
#pragma unroll
                for (int bj = 0; bj < 2; ++bj) { const u32x4 b = *(const u32x4*)(XA + off + bj * HALF); u32x4 w;
#pragma unroll
                    for (int k = 0; k < 4; ++k) { const float lo = __uint_as_float(b[k] << 16) + acc[ai][bj][m][k >> 1][2 * (k & 1)], hi = __uint_as_float(b[k] & 0xffff0000u) + acc[ai][bj][m][k >> 1][2 * (k & 1) + 1];
                        w[k] = cvt_pk_bf16(lo, hi); const float rl = __uint_as_float(w[k] << 16), rh = __uint_as_float(w[k] & 0xffff0000u); s += rl * rl + rh * rh; }
                    *(u32x4*)(XA + off + bj * HALF) = w; }
                s += __builtin_bit_cast(float, __builtin_amdgcn_ds_bpermute((lane ^ 16) << 2, __builtin_bit_cast(int, s)));
                s += __builtin_bit_cast(float, __builtin_amdgcn_ds_bpermute((lane ^ 32) << 2, __builtin_bit_cast(int, s)));
                if (fq == 0) RS[(size_t)row * 16 + u.pn * 4 + wc] = s; }
    }
};
template <class Epi, class Sched, bool ALIGN_EPI = false, bool SP2 = false>
__device__ __forceinline__ void gemm_phase(PG8_LAS unsigned char* lds, const Gemm g, const Sched& S, const Epi& E, const int tid) {
    const int wid = __builtin_amdgcn_readfirstlane(tid >> 6), lane = tid & 63, wr = wid >> 2, wc = wid & 3, fr = lane & 15, fq = lane >> 4;
    const int K = g.K, nt = K / BK;
    unsigned voffA[2], voffB[2];
#pragma unroll
    for (int i = 0; i < 2; ++i) { int R, C; stage_rc(tid * 16 + i * 8192, R, C); const int Rb = Epi::PERM ? ((R & ~31) + perm32(R & 31)) : R;
        voffA[i] = (unsigned)(R * K + C) * 2u; voffB[i] = (unsigned)(Rb * K + C) * 2u; }
    const size_t kstep = (size_t)(BK * 2);
    const size_t hstep = (size_t)HALF * K * 2;
    const size_t tstep = 2 * hstep;
    const unsigned ldsw = (unsigned)wid * 1024u;
    const int aoff = lds_byte(wr * 64 + fr, fq * 8), boff = lds_byte(wc * 32 + fr, fq * 8);
#define PG8_SA(b, h) (((b) * 2 + (h)) * HTB)
#define PG8_SB(b, h) ((4 + (b) * 2 + (h)) * HTB)
#define PG8_STAGE(bufoff, gbase, voff) do { _Pragma("unroll") for (int _i = 0; _i < 2; ++_i) \
        __builtin_amdgcn_global_load_lds((const unsigned*)((const char*)(gbase) + (voff)[_i]), (PG8_LAS unsigned*)(lds + (bufoff) + ldsw + _i * 8192), 16, 0, 0); } while (0)
#define PG8_LDA(dst, b, h) do { _Pragma("unroll") for (int m = 0; m < 4; ++m) _Pragma("unroll") for (int k = 0; k < 2; ++k) dst[m][k] = *(const PG8_LAS bf16x8*)(lds + PG8_SA(b, h) + aoff + m * 2048 + k * 1024); } while (0)
#define PG8_LDB(dst, b, h) do { _Pragma("unroll") for (int n = 0; n < 2; ++n) _Pragma("unroll") for (int k = 0; k < 2; ++k) dst[n][k] = *(const PG8_LAS bf16x8*)(lds + PG8_SB(b, h) + boff + n * 2048 + k * 1024); } while (0)
#define PG8_MMA(ai, bj, At, Bt) do { __builtin_amdgcn_s_setprio(1); _Pragma("unroll") for (int m = 0; m < 4; ++m) _Pragma("unroll") for (int n = 0; n < 2; ++n) _Pragma("unroll") for (int k = 0; k < 2; ++k) \
        acc[ai][bj][m][n] = __builtin_amdgcn_mfma_f32_16x16x32_bf16(Bt[n][k], At[m][k], acc[ai][bj][m][n], 0, 0, 0); __builtin_amdgcn_s_setprio(0); } while (0)
#define PG8_WAIT_V(n) asm volatile("s_waitcnt vmcnt(" #n ")" ::: "memory")
#define PG8_WAIT_L(n) asm volatile("s_waitcnt lgkmcnt(" #n ")" ::: "memory")
#define PG8_BAR __builtin_amdgcn_s_barrier()
#define PG8_SCHED __builtin_amdgcn_sched_barrier(0)
    Unit cur, nxt; int ui = 0;
    if (!S.next(0, cur)) return;
    f32x4 acc[2][2][4][2];
#pragma unroll
    for (int a = 0; a < 2; ++a)
#pragma unroll
        for (int b = 0; b < 2; ++b)
#pragma unroll
            for (int m = 0; m < 4; ++m)
#pragma unroll
                for (int n = 0; n < 2; ++n) acc[a][b][m][n] = (f32x4){0.f, 0.f, 0.f, 0.f};
    bf16x8 At[4][2], B0[2][2], B1[2][2];
    const char* cA = (const char*)g.A + (size_t)cur.pm * tstep; const char* cB = (const char*)g.Bt + (size_t)cur.pn * tstep;
    S.a_ready(cur);
    if constexpr (SP2) {
        PG8_STAGE(PG8_SB(0, 0), cB, voffB); PG8_STAGE(PG8_SB(0, 1), cB + hstep, voffB); PG8_STAGE(PG8_SA(0, 0), cA, voffA); PG8_STAGE(PG8_SA(0, 1), cA + hstep, voffA);
        if (wr == 1) PG8_BAR;
        PG8_WAIT_V(2); PG8_BAR;
        PG8_STAGE(PG8_SB(1, 0), cB + kstep, voffB); PG8_STAGE(PG8_SA(1, 0), cA + kstep, voffA); PG8_STAGE(PG8_SB(1, 1), cB + hstep + kstep, voffB);
        PG8_WAIT_V(6); PG8_BAR;
    } else {
        PG8_STAGE(PG8_SB(0, 0), cB, voffB); PG8_STAGE(PG8_SA(0, 0), cA, voffA); PG8_STAGE(PG8_SB(0, 1), cB + hstep, voffB); PG8_STAGE(PG8_SA(0, 1), cA + hstep, voffA);
        if (wr == 1) PG8_BAR;
        PG8_WAIT_V(4); PG8_BAR;
        PG8_STAGE(PG8_SB(1, 0), cB + kstep, voffB); PG8_STAGE(PG8_SA(1, 0), cA + kstep, voffA); PG8_STAGE(PG8_SB(1, 1), cB + hstep + kstep, voffB);
        PG8_WAIT_V(6); PG8_BAR;
    }
    for (;;) {
        const bool has_next = S.next(ui + 1, nxt);
        const char* nA = has_next ? (const char*)g.A + (size_t)nxt.pm * tstep : cA; const char* nB = has_next ? (const char*)g.Bt + (size_t)nxt.pn * tstep : cB;
        for (int t = 0; t < nt; t += 2) {
            const bool last = (t == nt - 2);
            const char* a1 = cA + (size_t)(t + 1) * kstep;
            const char* a2 = last ? nA : cA + (size_t)(t + 2) * kstep; const char* b2 = last ? nB : cB + (size_t)(t + 2) * kstep;
            const char* a3 = a2 + kstep; const char* b3 = b2 + kstep;
            if (last && has_next) S.a_ready(nxt);
            if constexpr (SP2) {
            PG8_LDB(B0, 0, 0); PG8_LDB(B1, 0, 1); PG8_SCHED; PG8_LDA(At, 0, 0); PG8_STAGE(PG8_SA(1, 1), a1 + hstep, voffA);
            PG8_WAIT_V(8); PG8_WAIT_L(0); PG8_BAR; PG8_MMA(0, 0, At, B0); PG8_MMA(0, 1, At, B1); PG8_BAR; PG8_SCHED;
            PG8_LDA(At, 0, 1); PG8_STAGE(PG8_SB(0, 0), b2, voffB); PG8_STAGE(PG8_SB(0, 1), b2 + hstep, voffB); PG8_STAGE(PG8_SA(0, 0), a2, voffA);
            PG8_WAIT_V(8); PG8_WAIT_L(0); PG8_BAR; PG8_MMA(1, 0, At, B0); PG8_MMA(1, 1, At, B1); PG8_BAR; PG8_SCHED;
            PG8_LDB(B0, 1, 0); PG8_LDB(B1, 1, 1); PG8_SCHED; PG8_LDA(At, 1, 0); PG8_STAGE(PG8_SA(0, 1), a2 + hstep, voffA);
            PG8_WAIT_V(8); PG8_WAIT_L(0); PG8_BAR; PG8_MMA(0, 0, At, B0); PG8_MMA(0, 1, At, B1); PG8_BAR; PG8_SCHED;
            PG8_LDA(At, 1, 1); PG8_STAGE(PG8_SB(1, 0), b3, voffB); PG8_STAGE(PG8_SB(1, 1), b3 + hstep, voffB); PG8_STAGE(PG8_SA(1, 0), a3, voffA);
            PG8_WAIT_V(8); PG8_WAIT_L(0); PG8_BAR; PG8_MMA(1, 0, At, B0); PG8_MMA(1, 1, At, B1); PG8_BAR; PG8_SCHED;
            } else {
            PG8_LDB(B0, 0, 0); PG8_SCHED; PG8_LDA(At, 0, 0); PG8_STAGE(PG8_SA(1, 1), a1 + hstep, voffA);
            PG8_WAIT_L(8); PG8_BAR; PG8_WAIT_L(0); PG8_MMA(0, 0, At, B0); PG8_BAR; PG8_SCHED;
            PG8_LDB(B1, 0, 1); PG8_STAGE(PG8_SB(0, 0), b2, voffB);
            PG8_BAR; PG8_WAIT_L(0); PG8_MMA(0, 1, At, B1); PG8_BAR;
            PG8_LDA(At, 0, 1); PG8_STAGE(PG8_SA(0, 0), a2, voffA);
            PG8_BAR; PG8_WAIT_L(0); PG8_MMA(1, 0, At, B0); PG8_BAR; PG8_SCHED;
            PG8_STAGE(PG8_SB(0, 1), b2 + hstep, voffB);
            PG8_WAIT_V(6); PG8_BAR; PG8_MMA(1, 1, At, B1); PG8_BAR;
            PG8_LDB(B0, 1, 0); PG8_SCHED; PG8_LDA(At, 1, 0); PG8_STAGE(PG8_SA(0, 1), a2 + hstep, voffA);
            PG8_WAIT_L(8); PG8_BAR; PG8_WAIT_L(0); PG8_MMA(0, 0, At, B0); PG8_BAR; PG8_SCHED;
            PG8_LDB(B1, 1, 1); PG8_STAGE(PG8_SB(1, 0), b3, voffB);
            PG8_BAR; PG8_WAIT_L(0); PG8_MMA(0, 1, At, B1); PG8_BAR;
            PG8_LDA(At, 1, 1); PG8_STAGE(PG8_SA(1, 0), a3, voffA);
            PG8_BAR; PG8_WAIT_L(0); PG8_MMA(1, 0, At, B0); PG8_BAR; PG8_SCHED;
            PG8_STAGE(PG8_SB(1, 1), b3 + hstep, voffB);
            PG8_WAIT_V(6); PG8_BAR; PG8_MMA(1, 1, At, B1); PG8_BAR;
            }
        }
        if constexpr (ALIGN_EPI) { if (wr == 0) PG8_BAR; }
        if constexpr (!Epi::AFTER_DRAIN) { E(acc, cur, wr, wc, fr, fq); S.done(cur); }
        if (!has_next) break;
#pragma unroll
        for (int a = 0; a < 2; ++a)
#pragma unroll
            for (int b = 0; b < 2; ++b)
#pragma unroll
                for (int m = 0; m < 4; ++m)
#pragma unroll
                    for (int n = 0; n < 2; ++n) acc[a][b][m][n] = (f32x4){0.f, 0.f, 0.f, 0.f};
        cur = nxt; cA = nA; cB = nB; ++ui;
        if constexpr (ALIGN_EPI) { if (wr == 1) PG8_BAR; }
    }
    PG8_WAIT_V(0);
    if constexpr (!ALIGN_EPI) { if (wr == 0) PG8_BAR; }
    PG8_BAR;
    if constexpr (Epi::AFTER_DRAIN) { E.fused(acc, cur, wr, wc, fr, fq, lds, wid, lane); S.done(cur); }
#undef PG8_SA
#undef PG8_SB
#undef PG8_STAGE
#undef PG8_LDA
#undef PG8_LDB
#undef PG8_MMA
#undef PG8_WAIT_V
#undef PG8_WAIT_L
#undef PG8_BAR
#undef PG8_SCHED
}
}
#include <hip/hip_bf16.h>
#include <cmath>
namespace attn_body {
using bf16=__hip_bfloat16;
using bf16x8=__attribute__((ext_vector_type(8)))short;
using s16x4=__attribute__((ext_vector_type(4)))short;
using f32x16=__attribute__((ext_vector_type(16)))float;
using u32x4=__attribute__((ext_vector_type(4)))unsigned;
constexpr int BATCH=8,NHEAD=6,SEQ=8192,D=64,DM=3584,DMO=1024;
constexpr int NW=8,QBLK=32,QB=QBLK*NW,KVBLK=64,NQB=SEQ/QB;
constexpr int ATTN_UNIT_ROWS=QB;
__device__ __forceinline__ int crow(int r,int hi){return (r&3)+8*(r>>2)+4*hi;}
#define SBAR() __builtin_amdgcn_sched_barrier(0)
typedef __attribute__((address_space(3))) const float* lds_cfptr;
__device__ __forceinline__ void biasadd(f32x16&p0,f32x16&p1,int tt,int tq,int hi,lds_cfptr dl,int h){
  const int rb=tq-64*tt-4*hi; const lds_cfptr dh=dl+h;
  #pragma unroll
  for(int r=0;r<16;++r){ const unsigned i0=(unsigned)(rb-(r&3)-8*(r>>2)), i1=i0-32u;
    float a0=dh[(i0<128u?i0:128u)*8], a1=dh[(i1<128u?i1:128u)*8];
    asm volatile("s_waitcnt lgkmcnt(0)":"+v"(a0),"+v"(a1)::"memory");
    p0[r]+=a0; p1[r]+=a1; }
}
typedef unsigned u32x2m __attribute__((ext_vector_type(2)));
template<int K> __device__ __forceinline__ float mands(float p,unsigned md){ return __uint_as_float(__float_as_uint(p)&(unsigned)(K==3?((int)md>>24):(int)(signed char)(md>>(8*K)))); }
template<int K> __device__ __forceinline__ float mandk(float p,unsigned bits){ unsigned m; asm("v_bfe_i32 %0, %1, %2, 1":"=v"(m):"v"(bits),"n"(K)); return __uint_as_float(__float_as_uint(p)&m); }
__device__ __forceinline__ float mand(float p,unsigned bits,int k){ return __uint_as_float(__float_as_uint(p)&(unsigned)__builtin_amdgcn_sbfe((int)bits,k,1)); }

constexpr int NSLOT=3, SLOTB=8192;
constexpr int LDS_K=0, LDS_V=NSLOT*SLOTB, LDS_TAB=2*NSLOT*SLOTB, LDS_OST=LDS_TAB+2048, LDS_WS=LDS_OST+NW*4096, LDS_BYTES=LDS_WS+NW*64*4, LDS_QST=90624;
constexpr float C2=0.125f*1.4426950408889634f;
__device__ __forceinline__ void glds16(const void*gsrc,unsigned lds_dst){unsigned keep;
  asm volatile("s_mov_b32 %0, m0\n\ts_mov_b32 m0, %2\n\ts_nop 0\n\tglobal_load_lds_dwordx4 %1, off\n\ts_mov_b32 m0, %0":"=&s"(keep):"v"(gsrc),"s"(lds_dst):"memory");}
__device__ __forceinline__ float max3f(float a,float b,float c){float r;asm("v_max3_f32 %0, %1, %2, %3":"=v"(r):"v"(a),"v"(b),"v"(c));return r;}
__device__ __forceinline__ float max2f(float a,float b){float r;asm("v_max_f32_e32 %0, %1, %2":"=v"(r):"v"(a),"v"(b));return r;}
__device__ __forceinline__ float fadd_s(float a,float b){float r;asm("v_add_f32_e32 %0, %1, %2":"=v"(r):"v"(a),"v"(b));return r;}
__device__ __forceinline__ float fsub_s(float a,float b){float r;asm("v_sub_f32_e32 %0, %1, %2":"=v"(r):"v"(a),"v"(b));return r;}
typedef float f32x2_t __attribute__((ext_vector_type(2))); typedef __bf16 bf16x2_t __attribute__((ext_vector_type(2)));
__device__ __forceinline__ unsigned cvtpk_s(float lo,float hi){f32x2_t v={lo,hi};bf16x2_t b=__builtin_convertvector(v,bf16x2_t);return __builtin_bit_cast(unsigned,b);}
#define WAIT_BAR(N) asm volatile("s_waitcnt vmcnt(" #N ") lgkmcnt(0)\n\ts_barrier":::"memory")

__device__ __forceinline__ void qkt(f32x16&p0,f32x16&p1,const char*Kslot,const bf16x8*qr,const f32x16&negm,int r32,int hi){
  const char*kb=Kslot+hi*1024+r32*16;
  #pragma unroll
  for(int d0=0;d0<4;++d0){
    const bf16x8 b0=*reinterpret_cast<const bf16x8*>(kb+d0*2048);
    const bf16x8 b1=*reinterpret_cast<const bf16x8*>(kb+d0*2048+512);
    if(d0==0){p0=__builtin_amdgcn_mfma_f32_32x32x16_bf16(b0,qr[0],negm,0,0,0);p1=__builtin_amdgcn_mfma_f32_32x32x16_bf16(b1,qr[0],negm,0,0,0);}
    else{p0=__builtin_amdgcn_mfma_f32_32x32x16_bf16(b0,qr[d0],p0,0,0,0);p1=__builtin_amdgcn_mfma_f32_32x32x16_bf16(b1,qr[d0],p1,0,0,0);}}
}
typedef __attribute__((address_space(3))) const char* lds_cptr;
typedef short v4i16_t __attribute__((ext_vector_type(4)));
__device__ __forceinline__ void kload8(bf16x8*kf,lds_cptr kp){
  kf[0]=*(const __attribute__((address_space(3))) bf16x8*)(kp);      kf[1]=*(const __attribute__((address_space(3))) bf16x8*)(kp+512);
  kf[2]=*(const __attribute__((address_space(3))) bf16x8*)(kp+2048); kf[3]=*(const __attribute__((address_space(3))) bf16x8*)(kp+2560);
  kf[4]=*(const __attribute__((address_space(3))) bf16x8*)(kp+4096); kf[5]=*(const __attribute__((address_space(3))) bf16x8*)(kp+4608);
  kf[6]=*(const __attribute__((address_space(3))) bf16x8*)(kp+6144); kf[7]=*(const __attribute__((address_space(3))) bf16x8*)(kp+6656);
}
__device__ __forceinline__ void kload2(bf16x8*kf,lds_cptr kp,int j){ kf[2*j]=*(const __attribute__((address_space(3))) bf16x8*)(kp+j*2048); kf[2*j+1]=*(const __attribute__((address_space(3))) bf16x8*)(kp+j*2048+512); }
__device__ __forceinline__ s16x4 vtr(lds_cptr p){ return __builtin_bit_cast(s16x4,__builtin_amdgcn_ds_read_tr16_b64_v4i16((__attribute__((address_space(3))) v4i16_t*)p)); }
__device__ __forceinline__ float rowmax(const f32x16&p0,const f32x16&p1){
  float a=max3f(p0[0],p0[1],p1[0]),b=max3f(p0[2],p0[3],p1[1]);a=max3f(a,p1[2],p1[3]);
  #pragma unroll
  for(int r=4;r<16;r+=4){a=max3f(a,p0[r],p0[r+1]);b=max3f(b,p0[r+2],p0[r+3]);a=max3f(a,p1[r],p1[r+1]);b=max3f(b,p1[r+2],p1[r+3]);}
  const float m=max2f(a,b);
  auto rr=__builtin_amdgcn_permlane32_swap(__float_as_uint(m),__float_as_uint(m),false,false);
  return max2f(__uint_as_float(rr[0]),__uint_as_float(rr[1]));
}
__device__ __forceinline__ void pv(f32x16*o,int vb,bf16x8 pa0,bf16x8 pa1,bf16x8 pa2,bf16x8 pa3){
  #pragma unroll
  for(int d0=0;d0<2;++d0){s16x4 lo[4],hi[4];
    #pragma unroll
    for(int ks=0;ks<4;++ks){
      asm volatile("ds_read_b64_tr_b16 %0,%1 offset:%c2":"=&v"(lo[ks]):"v"(vb),"i"(d0*4096+ks*1024):"memory");
      asm volatile("ds_read_b64_tr_b16 %0,%1 offset:%c2":"=&v"(hi[ks]):"v"(vb),"i"(d0*4096+ks*1024+512):"memory");}
    asm volatile("s_waitcnt lgkmcnt(0)":::"memory");SBAR();
    #define PK(k) (bf16x8){lo[k][0],lo[k][1],lo[k][2],lo[k][3],hi[k][0],hi[k][1],hi[k][2],hi[k][3]}
    o[d0]=__builtin_amdgcn_mfma_f32_32x32x16_bf16(pa0,PK(0),o[d0],0,0,0);
    o[d0]=__builtin_amdgcn_mfma_f32_32x32x16_bf16(pa1,PK(1),o[d0],0,0,0);
    o[d0]=__builtin_amdgcn_mfma_f32_32x32x16_bf16(pa2,PK(2),o[d0],0,0,0);
    o[d0]=__builtin_amdgcn_mfma_f32_32x32x16_bf16(pa3,PK(3),o[d0],0,0,0);
    #undef PK
  }
}

#ifndef ATTN_STORE16
#define ATTN_STORE16(p,v) (*(u32x4*)(p)=(v))
#endif
template<int THRL> __device__ __forceinline__ void attn_unit(int b,int h,int qb,const bf16*Q,const bf16*__restrict__ K,const bf16*__restrict__ V,bf16*O,const bf16*GT,const unsigned*MK,lds_cfptr dl,char*shm,const int tid){
  const int lane=tid&63,r32=lane&31,hi=lane>>5; const int wid=__builtin_amdgcn_readfirstlane(tid>>6);
  const long rowbase=(long)b*SEQ; const int q0=qb*QB;
  const bf16*Qw=Q+(rowbase+q0+wid*QBLK)*DM+h*D;
  const bf16*Kh=K+rowbase*DM+h*D,*Vh=V+rowbase*DM+h*D;
  const unsigned lds0=(unsigned)(uintptr_t)shm;
  float*wsf=(float*)(shm+LDS_WS)+wid*64;
  const bf16*ksrc=Kh+(long)lane*DM+wid*8;
  const bf16*vsrc=Vh+(long)(16*(wid&3)+(lane>>2))*DM+(wid>>2)*32+(lane&3)*8;
  const unsigned kdst=lds0+LDS_K+wid*1024, vdst=lds0+LDS_V+wid*1024;
  #define DMA_K(t,slot) glds16(ksrc+(long)(t)*KVBLK*DM,(unsigned)__builtin_amdgcn_readfirstlane(kdst+(slot)))
  #define DMA_V(t,slot) glds16(vsrc+(long)(t)*KVBLK*DM,(unsigned)__builtin_amdgcn_readfirstlane(vdst+(slot)))
  const int vb0=(int)(lds0+LDS_V)+((lane>>4)&1)*32+(lane&3)*8+(4*hi+((lane&15)>>2))*64;
  const char*Kbase=shm+LDS_K; bf16x8 kf[8];
  const lds_cptr shm3=(lds_cptr)shm; const lds_cptr kp0=shm3+LDS_K+hi*1024+r32*16; const lds_cptr vp0=shm3+LDS_V+((lane>>4)&1)*32+(lane&3)*8+(4*hi+((lane&15)>>2))*64;
  const int NT=(q0+QB)/KVBLK;
  DMA_K(0,0);DMA_V(0,0);DMA_K(1,SLOTB);
  const __attribute__((address_space(3))) char* shm3q=(const __attribute__((address_space(3))) char*)shm;
  bf16x8 qr[4];
  #pragma unroll
  for(int d0=0;d0<4;++d0)qr[d0]=*reinterpret_cast<const bf16x8*>(&Qw[(long)r32*DM+d0*16+hi*8]);
  const __attribute__((address_space(3))) bf16x8* qls=(const __attribute__((address_space(3))) bf16x8*)(shm3q+LDS_QST+wid*4096)+lane;
  #pragma unroll
  for(int d0=0;d0<4;++d0)((__attribute__((address_space(3))) bf16x8*)qls)[64*d0]=qr[d0];
  float mhat=0.f,l_reg=0.f;f32x16 o[2];o[0]=f32x16{};o[1]=f32x16{};float nmh=0.f;
  const int tq=q0+wid*QBLK+r32;
  const unsigned*mbase=MK+((size_t)(b*256+(q0>>5)+wid)*128)*64;
  unsigned bits_cur=mbase[lane],bits_next=mbase[64+lane];
  #define CMASK(P0,P1,t) do{ if((t)>=NT-6)biasadd(P0,P1,(t),tq,hi,dl,h);}while(0)
  bool resc=false;
  #define START(P0,P1) do{ const float rm=rowmax(P0,P1); resc=false; \
    { const float dl=(rm>(float)THRL||rm<-(float)THRL)?rm:0.f; mhat=fadd_s(mhat,dl);     \
      _Pragma("unroll") for(int r=0;r<16;++r){P0[r]=fsub_s(P0[r],dl);P1[r]=fsub_s(P1[r],dl);} \
      nmh=-mhat; } \
    _Pragma("unroll") for(int r=0;r<16;++r)P0[r]=mand(__builtin_amdgcn_exp2f(P0[r]),bits_cur,r); }while(0)
  #define RESC() do{ if(resc){ asm volatile("s_waitcnt lgkmcnt(0)":::"memory"); \
      _Pragma("unroll") for(int d_=0;d_<2;++d_) _Pragma("unroll") for(int r=0;r<16;++r)o[d_][r]*=wsf[crow(r,hi)]; } }while(0)
  f32x16 pA0,pA1,pB0,pB1;
  int sl_prev=0,sl_cur=0,sl_next=SLOTB;
  #define ROT() do{sl_prev=sl_cur;sl_cur=sl_next;sl_next=(sl_next==(NSLOT-1)*SLOTB)?0:sl_next+SLOTB;}while(0)
  DMA_K(2,2*SLOTB);
  WAIT_BAR(3);
  { const f32x16 zc=f32x16{}; qkt(pA0,pA1,Kbase,qr,zc,r32,hi); }asm volatile("s_nop 15\n\ts_nop 7":"+v"(pA0),"+v"(pA1));CMASK(pA0,pA1,0);
  START(pA0,pA1);
  _Pragma("unroll") for(int r=0;r<16;++r)pA1[r]=mand(__builtin_amdgcn_exp2f(pA1[r]),bits_cur,16+r);
  WAIT_BAR(0);
  DMA_K(3,0);DMA_V(1,SLOTB);
  ROT();
  kload8(kf,kp0+sl_cur);
  WAIT_BAR(2);
  u32x2m mk01,mk23,mk45,mk67;
  s16x4 vlo[8],vhi[8]; u32x4 pw0,pw1,pw2,pw3; bf16x8 qa_=qls[0],qb_;
  #define PKW(P,B) cvtpk_s(P[B],P[B+1])
  #define PAF(k) __builtin_bit_cast(bf16x8,pw##k)
  #define VFR(i) (bf16x8){vlo[i][0],vlo[i][1],vlo[i][2],vlo[i][3],vhi[i][0],vhi[i][1],vhi[i][2],vhi[i][3]}
  #define PIN(x) asm volatile("":"+v"(x))
  #define MX3(a,b,c) __builtin_fmaxf(__builtin_fmaxf((a),(b)),(c))
  #define GAPA(MF,A0,A1,A2,A3,W0,W1,PW) do{ MF; sacc+=A0; sacc+=A1; sacc+=A2; sacc+=A3; PIN(sacc); W0; W1; PIN(PW); SBAR(); }while(0)
  #define EX(v) __builtin_amdgcn_exp2f(v)
  #define MKD(e) (((e)>>2)==0?mk01[0]:((e)>>2)==1?mk01[1]:((e)>>2)==2?mk23[0]:((e)>>2)==3?mk23[1]:((e)>>2)==4?mk45[0]:((e)>>2)==5?mk45[1]:((e)>>2)==6?mk67[0]:mk67[1])
  #define GAPB(MF,X,B,MB) do{ MF; { const unsigned md_=MKD((MB)+(B)); X[B]=mands<0>(EX(X[B]),md_); X[B+1]=mands<1>(EX(X[B+1]),md_); X[B+2]=mands<2>(EX(X[B+2]),md_); X[B+3]=mands<3>(EX(X[B+3]),md_); } PIN(X); SBAR(); }while(0)
  #define VRD(i) do{ vlo[i]=vtr(vp_+(((i)>>2)*4096+((i)&3)*1024)); vhi[i]=vtr(vp_+(((i)>>2)*4096+((i)&3)*1024+512)); }while(0)
  #define KRD(G,j) do{ if(G){ kload2(kf,kp0+sl_next,j); SBAR(); } }while(0)
  #define STEP(C0,C1,P0,P1,t,GK,GV,GL) do{ SBAR(); \
    bits_cur=bits_next; if(GV){ bits_next=mbase[64*((t)+1)+lane]; } \
    { const lds_cptr tb_=shm3+LDS_TAB; mk01=*(const __attribute__((address_space(3))) u32x2m*)(tb_+((bits_cur&0xffu)<<3)); mk23=*(const __attribute__((address_space(3))) u32x2m*)(tb_+(((bits_cur>>8)&0xffu)<<3)); \
      mk45=*(const __attribute__((address_space(3))) u32x2m*)(tb_+(((bits_cur>>16)&0xffu)<<3)); mk67=*(const __attribute__((address_space(3))) u32x2m*)(tb_+((bits_cur>>24)<<3)); } \
    const lds_cptr vp_=vp0+sl_prev; \
    VRD(0); qb_=qls[64]; SBAR(); float sacc=(P0[0]+P0[1]); \
    if(!__any(nmh!=0.f)){ const f32x16 zc_=f32x16{}; \
      GAPA(C0=__builtin_amdgcn_mfma_f32_32x32x16_bf16(kf[0],qa_,zc_,0,0,0), P0[2],P0[3],P0[4],P0[5],     pw0[0]=PKW(P0,0), pw0[1]=PKW(P0,2), pw0); \
      VRD(4); SBAR(); GAPA(C1=__builtin_amdgcn_mfma_f32_32x32x16_bf16(kf[1],qa_,zc_,0,0,0), P0[6],P0[7],P0[8],P0[9],     pw0[2]=PKW(P0,4), pw0[3]=PKW(P0,6), pw0); \
    }else{ f32x16 negm; { float nm_=nmh; asm volatile("":"+v"(nm_)); _Pragma("unroll") for(int r=0;r<16;++r)negm[r]=nm_; } \
      GAPA(C0=__builtin_amdgcn_mfma_f32_32x32x16_bf16(kf[0],qa_,negm,0,0,0), P0[2],P0[3],P0[4],P0[5],     pw0[0]=PKW(P0,0), pw0[1]=PKW(P0,2), pw0); \
      VRD(4); SBAR(); GAPA(C1=__builtin_amdgcn_mfma_f32_32x32x16_bf16(kf[1],qa_,negm,0,0,0), P0[6],P0[7],P0[8],P0[9],     pw0[2]=PKW(P0,4), pw0[3]=PKW(P0,6), pw0); } \
    VRD(1); qa_=qls[128]; SBAR(); GAPA(C0=__builtin_amdgcn_mfma_f32_32x32x16_bf16(kf[2],qb_,C0,0,0,0),   P0[10],P0[11],P0[12],P0[13], pw1[0]=PKW(P0,8), pw1[1]=PKW(P0,10), pw1); \
    VRD(5); SBAR(); GAPA(C1=__builtin_amdgcn_mfma_f32_32x32x16_bf16(kf[3],qb_,C1,0,0,0),   P0[14],P0[15],P1[0],P1[1],   pw1[2]=PKW(P0,12),pw1[3]=PKW(P0,14), pw1); \
    VRD(2); qb_=qls[192]; SBAR(); GAPA(C0=__builtin_amdgcn_mfma_f32_32x32x16_bf16(kf[4],qa_,C0,0,0,0),   P1[2],P1[3],P1[4],P1[5],     pw2[0]=PKW(P1,0), pw2[1]=PKW(P1,2), pw2); \
    VRD(6); SBAR(); GAPA(C1=__builtin_amdgcn_mfma_f32_32x32x16_bf16(kf[5],qa_,C1,0,0,0),   P1[6],P1[7],P1[8],P1[9],     pw2[2]=PKW(P1,4), pw2[3]=PKW(P1,6), pw2); \
    VRD(3); qa_=qls[0]; SBAR(); GAPA(C0=__builtin_amdgcn_mfma_f32_32x32x16_bf16(kf[6],qb_,C0,0,0,0),   P1[10],P1[11],P1[12],P1[13], pw3[0]=PKW(P1,8), pw3[1]=PKW(P1,10), pw3); \
    VRD(7); SBAR(); GAPA(C1=__builtin_amdgcn_mfma_f32_32x32x16_bf16(kf[7],qb_,C1,0,0,0),   P1[14],P1[15],0.f,0.f,       pw3[2]=PKW(P1,12),pw3[3]=PKW(P1,14), pw3); \
    l_reg+=sacc; \
    if(GK){DMA_K((t)+3,sl_cur);} if(GV){DMA_V((t)+1,sl_next);} \
    CMASK(C0,C1,t); \
    { float a=MX3(C0[0],C0[1],C1[0]),b=MX3(C0[2],C0[3],C1[1]); a=MX3(a,C1[2],C1[3]); \
      _Pragma("unroll") for(int r=4;r<16;r+=4){a=MX3(a,C0[r],C0[r+1]);b=MX3(b,C0[r+2],C0[r+3]);a=MX3(a,C1[r],C1[r+1]);b=MX3(b,C1[r+2],C1[r+3]);} \
      float rm=__builtin_fmaxf(a,b); { auto rr=__builtin_amdgcn_permlane32_swap(__float_as_uint(rm),__float_as_uint(rm),false,false); rm=__builtin_fmaxf(__uint_as_float(rr[0]),__uint_as_float(rr[1])); } \
      resc=false; \
      if(__builtin_expect(__any(rm>(float)THRL),0)){ const float dl=__builtin_fmaxf(rm,0.f); mhat+=dl; \
        _Pragma("unroll") for(int r=0;r<16;++r){C0[r]-=dl;C1[r]-=dl;} \
        nmh=-mhat; \
        const float f=__builtin_amdgcn_exp2f(-dl); l_reg*=f; if(hi==0)wsf[r32]=f; resc=true; } } \
    SBAR(); \
    GAPB(o[0]=__builtin_amdgcn_mfma_f32_32x32x16_bf16(PAF(0),VFR(0),o[0],0,0,0), C0,0,0); \
    GAPB(o[1]=__builtin_amdgcn_mfma_f32_32x32x16_bf16(PAF(0),VFR(4),o[1],0,0,0), C0,4,0); \
    KRD(GL,0); GAPB(o[0]=__builtin_amdgcn_mfma_f32_32x32x16_bf16(PAF(1),VFR(1),o[0],0,0,0), C0,8,0); \
    KRD(GL,1); GAPB(o[1]=__builtin_amdgcn_mfma_f32_32x32x16_bf16(PAF(1),VFR(5),o[1],0,0,0), C0,12,0); \
    KRD(GL,2); GAPB(o[0]=__builtin_amdgcn_mfma_f32_32x32x16_bf16(PAF(2),VFR(2),o[0],0,0,0), C1,0,16); \
    KRD(GL,3); GAPB(o[1]=__builtin_amdgcn_mfma_f32_32x32x16_bf16(PAF(2),VFR(6),o[1],0,0,0), C1,4,16); \
    GAPB(o[0]=__builtin_amdgcn_mfma_f32_32x32x16_bf16(PAF(3),VFR(3),o[0],0,0,0), C1,8,16); \
    GAPB(o[1]=__builtin_amdgcn_mfma_f32_32x32x16_bf16(PAF(3),VFR(7),o[1],0,0,0), C1,12,16); \
    }while(0)
  int t=1;
  #undef CMASK
  #define CMASK(P0,P1,t) do{}while(0)
  for(;t+7<NT;t+=2){
    STEP(pB0,pB1,pA0,pA1,t,true,true,true);     WAIT_BAR(2); RESC(); ROT();
    STEP(pA0,pA1,pB0,pB1,t+1,true,true,true);   WAIT_BAR(2); RESC(); ROT();
  }
  #undef CMASK
  #define CMASK(P0,P1,t) do{ if((t)>=NT-6)biasadd(P0,P1,(t),tq,hi,dl,h);}while(0)
  #define ENDW(tt) do{ if((tt)+3<NT){WAIT_BAR(2);} else if((tt)+2<NT){WAIT_BAR(1);} else {WAIT_BAR(0);} }while(0)
  for(;t+1<NT;t+=2){
    STEP(pB0,pB1,pA0,pA1,t,(t+3<NT),(t+1<NT),(t+1<NT));       ENDW(t);   RESC(); ROT();
    STEP(pA0,pA1,pB0,pB1,t+1,(t+4<NT),(t+2<NT),(t+2<NT));     ENDW(t+1); RESC(); ROT();
  }
  STEP(pB0,pB1,pA0,pA1,NT-1,false,false,false); RESC();
  { float sacc=pB0[0]+pB0[1]; _Pragma("unroll") for(int r=2;r<16;++r)sacc+=pB0[r]; _Pragma("unroll") for(int r=0;r<16;++r)sacc+=pB1[r]; l_reg+=sacc;
    pw0=(u32x4){PKW(pB0,0),PKW(pB0,2),PKW(pB0,4),PKW(pB0,6)};pw1=(u32x4){PKW(pB0,8),PKW(pB0,10),PKW(pB0,12),PKW(pB0,14)};pw2=(u32x4){PKW(pB1,0),PKW(pB1,2),PKW(pB1,4),PKW(pB1,6)};pw3=(u32x4){PKW(pB1,8),PKW(pB1,10),PKW(pB1,12),PKW(pB1,14)};
    SBAR(); pv(o,vb0+sl_cur,PAF(0),PAF(1),PAF(2),PAF(3)); }
  #undef PKW
  #undef PAF
  #undef VFR
  #undef PIN
  #undef MX3
  #undef GAPA
  #undef GAPB
  #undef EX
  #undef VRD
  #undef KRD
  #undef STEP
  #undef ENDW
  {auto rr=__builtin_amdgcn_permlane32_swap(__float_as_uint(l_reg),__float_as_uint(l_reg),false,false);l_reg=__uint_as_float(rr[0])+__uint_as_float(rr[1]);}
  if(hi==0)wsf[32+r32]=l_reg;asm volatile("s_waitcnt lgkmcnt(0)":::"memory");
  float rli[16];
  #pragma unroll
  for(int r=0;r<16;++r)rli[r]=__builtin_amdgcn_rcpf(wsf[32+crow(r,hi)]);
  bf16*Ow=O+(rowbase+q0+wid*QBLK)*DMO+h*D; const bf16*Gw=GT+(rowbase+q0+wid*QBLK)*DM+h*D;
  { bf16*stg=(bf16*)(shm+LDS_OST)+wid*2048;
    #pragma unroll
    for(int r=0;r<16;++r){const int orow=crow(r,hi);
      #pragma unroll
      for(int d0=0;d0<2;++d0)stg[orow*64+d0*32+r32]=__float2bfloat16(o[d0][r]*rli[r]);}
    asm volatile("s_waitcnt lgkmcnt(0)":::"memory");
    #pragma unroll
    for(int i=0;i<4;++i){const int row=i*8+(lane>>3),ch=lane&7; const u32x4 v=*(const u32x4*)(stg+row*64+ch*8); const u32x4 g=*(const u32x4*)(Gw+(long)row*DM+ch*8); u32x4 w;
      #pragma unroll
      for(int k=0;k<4;++k){ const float g0=__uint_as_float(g[k]<<16),g1=__uint_as_float(g[k]&0xffff0000u); const float v0=__uint_as_float(v[k]<<16),v1=__uint_as_float(v[k]&0xffff0000u);
        w[k]=cvtpk_s(v0*(g0/(1.0f+__expf(-g0))),v1*(g1/(1.0f+__expf(-g1)))); }
      ATTN_STORE16(Ow+(long)row*DMO+ch*8,w);} }
  asm volatile("s_waitcnt lgkmcnt(0)\n\ts_barrier":::"memory");
  #undef DMA_K
  #undef DMA_V
  #undef CMASK
  #undef START
  #undef RESC
  #undef ROT
}
constexpr int ATTN_LDS_BYTES=LDS_BYTES;
struct AttnTensors { const bf16* Q; const bf16* K; const bf16* V; bf16* O; const bf16* GT; const unsigned* MK; };
struct AttnUnit { int bh; int qb; };
struct StaticOrder {
  int wg,G;
  __device__ __forceinline__ explicit StaticOrder(int grid,int block):wg(block),G(grid){}
  __device__ __forceinline__ bool next(int i,AttnUnit&u)const{ const int p=wg+(i>>1)*G; if(p>=768)return false; const int s=p&15; u.bh=p>>4; u.qb=(i&1)?31-s:s; return true; }
  __device__ __forceinline__ void a_ready(const AttnUnit&)const{}
  __device__ __forceinline__ void done(const AttnUnit&)const{}
};
template<class Sched,int THRL=8> __device__ __forceinline__ void attn_phase(char*lds,const AttnTensors&T,lds_cfptr dl,const Sched&S,int tid){
  AttnUnit u;
  for(int i=0;S.next(i,u);++i){ asm volatile("":"+v"(tid)); S.a_ready(u); attn_unit<THRL>(u.bh/NHEAD,u.bh%NHEAD,u.qb,T.Q,T.K,T.V,T.O,T.GT,T.MK,dl,lds,tid); S.done(u); }
}
#undef SBAR
#undef WAIT_BAR
}

constexpr int NWAVES = 8, NTHR = 512;
constexpr int BATCH = 8, SEQ = 8192, DM = 1024, DEPTH = 4, M = BATCH * SEQ;
constexpr int IN_COLS = 3380, NP = 3584;
constexpr float EPS = 1e-6f;
constexpr int N_GQ = 0, N_GK = 192, N_GV = 384, N_GG = 768, N_DQ = 1152, N_DK = 1536, N_DV = 1920, N_DG = 2304, N_PU = 2688, N_PG = 2944, N_QI = 3200, N_KI = 3328, N_GZ = 3360, N_WI = 3376;
constexpr float LOG2E = 1.4426950408889634f;
constexpr size_t MiB = 1u << 20;
constexpr size_t WS_CTL = 0, CTL_ZERO_BYTES = 1 * MiB;
constexpr size_t WS_WIN = 2 * MiB;
constexpr size_t WS_WOUT = 32 * MiB;
constexpr size_t WS_XB = 48 * MiB;
constexpr size_t WS_P = 176 * MiB;
constexpr size_t WS_MASK = 624 * MiB;
constexpr size_t WS_GOP = 688 * MiB;
constexpr size_t WS_XA = 832 * MiB;
constexpr size_t WS_RSC = 44 * MiB;
constexpr size_t WS_RS = 40 * MiB;
constexpr size_t WS_ZW = 960 * MiB;
constexpr size_t WS_KC = 968 * MiB;
constexpr size_t WS_END = 972 * MiB;
constexpr int CW_BAR = 4096, CW_QUEUE = 8192;
constexpr int RING_BYTES = 131072, LDSCTL_OFF = RING_BYTES, MISC_OFF = LDSCTL_OFF + 320, LDS_BYTES = 147456;

#define GAS __attribute__((address_space(1)))
#define LAS __attribute__((address_space(3)))
typedef unsigned short bf16;
typedef unsigned v4u __attribute__((ext_vector_type(4)));
typedef unsigned v2u __attribute__((ext_vector_type(2)));
typedef float f32x4 __attribute__((ext_vector_type(4)));
typedef GAS unsigned gu32;
#define RLX_AGENT __ATOMIC_RELAXED, __HIP_MEMORY_SCOPE_AGENT
__device__ __forceinline__ unsigned f2bf(float f) { unsigned u = __builtin_bit_cast(unsigned, f); return (u + 0x7fffu + ((u >> 16) & 1u)) >> 16; }
__device__ __forceinline__ unsigned pk2(float lo, float hi) { return f2bf(lo) | (f2bf(hi) << 16); }
__device__ __forceinline__ float bf2f(unsigned short b) { return __builtin_bit_cast(float, (unsigned)b << 16); }
__device__ __forceinline__ float bflo(unsigned w) { return __builtin_bit_cast(float, w << 16); }
__device__ __forceinline__ float bfhi(unsigned w) { return __builtin_bit_cast(float, w & 0xffff0000u); }
__device__ __forceinline__ float shx(float v, int o, int lane) { return __builtin_bit_cast(float, __builtin_amdgcn_ds_bpermute((lane ^ o) << 2, __builtin_bit_cast(int, v))); }
__device__ __forceinline__ int shdn(int v, int o, int lane) { return __builtin_amdgcn_ds_bpermute(((lane + o) & 63) << 2, v); }
__device__ __forceinline__ float wave_sum(float v, int lane) {
#pragma unroll
    for (int o = 1; o < 64; o <<= 1) v += shx(v, o, lane);
    return v;
}
__device__ __forceinline__ float silu_f(float x) { return x / (1.0f + __expf(-x)); }

__constant__ unsigned char T5B[128] = {0, 1, 2, 3, 4, 5, 6, 7, 8, 9, 10, 11, 12, 13, 14, 15, 16, 16, 16, 17, 17, 18, 18, 18, 19, 19, 19, 20, 20, 20, 20, 21, 21, 21, 21, 22, 22, 22, 22, 22, 23, 23, 23, 23, 23, 23, 24, 24, 24, 24, 24, 24, 25, 25, 25, 25, 25, 25, 25, 26, 26, 26, 26, 26, 26, 26, 26, 27, 27, 27, 27, 27, 27, 27, 27, 27, 27, 28, 28, 28, 28, 28, 28, 28, 28, 28, 28, 29, 29, 29, 29, 29, 29, 29, 29, 29, 29, 29, 29, 30, 30, 30, 30, 30, 30, 30, 30, 30, 30, 30, 30, 30, 30, 31, 31, 31, 31, 31, 31, 31, 31, 31, 31, 31, 31, 31, 31, 31};
__device__ __forceinline__ int t5_bucket(int rel) { return rel >= 128 ? 31 : (int)T5B[rel]; }

#define XB_TMO      128
#define XB_XCNT(j)  (256  + 64 * (j))
#define XB_XSUB(j)  (1280 + 64 * (j))
#define XB_XGEN(j)  (2304 + 64 * (j))
#define XB_TOP      3328
#define XB_TOPGEN   3392
#define XCD_BAR_WORDS 3456
#define XB_SPIN_CAP (1u << 22)

__device__ __forceinline__ unsigned xb_ld(unsigned* p)              { return __hip_atomic_load(p, __ATOMIC_RELAXED, __HIP_MEMORY_SCOPE_AGENT); }
__device__ __forceinline__ unsigned xb_add(unsigned* p, unsigned v) { return __hip_atomic_fetch_add(p, v, __ATOMIC_RELAXED, __HIP_MEMORY_SCOPE_AGENT); }
__device__ __forceinline__ unsigned xb_xcc_id() { return (unsigned)__builtin_amdgcn_s_getreg((3 << 11) | 20) & 0xFu; }
#define XB_SPIN(cond, bar) do { unsigned _sp = 0; while (cond) { __builtin_amdgcn_s_sleep(1); \
    if ((++_sp & 255u) == 0u) { if (xb_ld(&(bar)[XB_TMO])) break; if (_sp > XB_SPIN_CAP) { atomicAdd(&(bar)[XB_TMO], 1u); break; } } } } while (0)

struct XcdBarrier {
    unsigned* bar; unsigned x;
    volatile LAS unsigned* st;
};

__device__ __forceinline__ XcdBarrier xcd_barrier_post(unsigned* bar, volatile LAS unsigned* st) {
    XcdBarrier b; b.bar = bar; b.x = xb_xcc_id(); b.st = st;
    if (threadIdx.x == 0) (void)xb_add(&bar[XB_XCNT(b.x)], 1u);
    return b;
}
__device__ __forceinline__ void xcd_barrier_complete(unsigned* bar, unsigned x, unsigned& nloc, unsigned& nx) {
    const unsigned G = gridDim.x * gridDim.y * gridDim.z;
    unsigned sum, cnt, mine, sp = 0u;
    for (;;) {
        sum = 0u; cnt = 0u; mine = 0u;
#pragma unroll
        for (unsigned j = 0; j < 16; ++j) { const unsigned c = xb_ld(&bar[XB_XCNT(j)]); sum += c; cnt += (c > 0u) ? 1u : 0u; mine = (j == x) ? c : mine; }
        if (sum == G) break;
        __builtin_amdgcn_s_sleep(1);
        if ((++sp & 255u) == 0u) { if (xb_ld(&bar[XB_TMO])) break; if (sp > XB_SPIN_CAP) { atomicAdd(&bar[XB_TMO], 1u); break; } }
    }
    nloc = mine > 0u ? mine : 1u; nx = cnt > 0u ? cnt : 1u;
}

__device__ __forceinline__ void xcd_barrier(const XcdBarrier& b) {
    asm volatile("s_waitcnt vmcnt(0)" ::: "memory");
    __syncthreads();
    if (threadIdx.x == 0) {
        unsigned* bar = b.bar;
        __builtin_amdgcn_s_waitcnt(0);
        unsigned nloc = b.st[0], nx = b.st[1];
        if (nloc == 0u) { xcd_barrier_complete(bar, b.x, nloc, nx); b.st[0] = nloc; b.st[1] = nx; }
        const unsigned old = xb_add(&bar[XB_XSUB(b.x)], 1u);
        const unsigned gen = old / nloc;
        if (old + 1u == (gen + 1u) * nloc) {
            __builtin_amdgcn_fence(__ATOMIC_RELEASE, "agent");
            asm volatile("s_waitcnt vmcnt(0)" ::: "memory");
            const unsigned og = xb_add(&bar[XB_TOP], 1u);
            const unsigned tg = og / nx;
            if (og + 1u == (tg + 1u) * nx) xb_add(&bar[XB_TOPGEN], 1u);
            else XB_SPIN(xb_ld(&bar[XB_TOPGEN]) == tg, bar);
            __builtin_amdgcn_fence(__ATOMIC_ACQUIRE, "agent");
            xb_add(&bar[XB_XGEN(b.x)], 1u);
            asm volatile("s_waitcnt vmcnt(0)" ::: "memory");
        } else {
            XB_SPIN(xb_ld(&bar[XB_XGEN(b.x)]) == gen, bar);
            __builtin_amdgcn_fence(__ATOMIC_ACQUIRE, "agent");
            asm volatile("s_waitcnt vmcnt(0)" ::: "memory");
        }
    }
    __syncthreads();
}
#ifndef IDX_NOFALLBACK
#define IDX_NOFALLBACK 0
#endif
#ifndef REP_RES
#define REP_RES 1
#endif
#ifndef REP_PATCH
#define REP_PATCH 1
#endif
#ifndef REP_P1
#define REP_P1 1
#endif
#ifndef REP_P3
#define REP_P3 1
#endif
#ifndef REP_HEAD
#define REP_HEAD 1
#endif
#ifndef REP_RES
#define REP_RES 1
#endif
#ifndef REP_P2
#define REP_P2 1
#endif
#ifndef REP_RANK
#define REP_RANK 1
#endif
#ifndef IDX_PRIO
#define IDX_PRIO 1
#endif
#ifndef IDX_PKFMA
#define IDX_PKFMA 0
#endif
#ifndef PROBE_MFMA2
#define PROBE_MFMA2 0
#endif
#ifndef PROBE_ADD2
#define PROBE_ADD2 0
#endif
#ifndef IDX_ASMFMA
#define IDX_ASMFMA 0
#endif
#ifndef IDX_ASMBIN
#define IDX_ASMBIN 0
#endif
namespace idxb {
typedef short bf16x8 __attribute__((ext_vector_type(8)));
typedef float f32x16 __attribute__((ext_vector_type(16)));
constexpr int ZBIN = 0, NBINS = 512, CAP = 256;
constexpr int L_HIST = 0, L_ZC = 65536, L_PAR = 81920, L_KBUF = 83968, L_XT = 116736;
enum { P_BSTAR = 0, P_KK, P_CCNT, P_TAU, P_CUT, P_MODE, P_TSTAR, P_RSTAR, P_OVF, P_NRANK, P_PRE, P_XL, P_XU };
__device__ __forceinline__ unsigned lds_add(unsigned* p, unsigned v) { return __hip_atomic_fetch_add((__attribute__((address_space(3))) unsigned*)p, v, __ATOMIC_RELAXED, __HIP_MEMORY_SCOPE_WORKGROUP); }
__device__ __forceinline__ int crow(int r, int hi) { return (r & 3) + 8 * (r >> 2) + 4 * hi; }
struct QFrag { bf16x8 q[4][2]; float w[4]; };
__device__ __forceinline__ f32x16 score_sub(const bf16x8 k0, const bf16x8 k1, const QFrag& Q) {
    f32x16 acc;
#pragma unroll
    for (int r = 0; r < 16; ++r) acc[r] = 0.f;
    const f32x16 zz = {0.f, 0.f, 0.f, 0.f, 0.f, 0.f, 0.f, 0.f, 0.f, 0.f, 0.f, 0.f, 0.f, 0.f, 0.f, 0.f};
    float INFV; asm("s_mov_b32 %0, 0x7f800000" : "=s"(INFV));
#pragma unroll
    for (int hp = 0; hp < 2; ++hp) {
        f32x16 d0 = __builtin_amdgcn_mfma_f32_32x32x16_bf16(k0, Q.q[2 * hp][0], zz, 0, 0, 0), d1 = __builtin_amdgcn_mfma_f32_32x32x16_bf16(k0, Q.q[2 * hp + 1][0], zz, 0, 0, 0);
        d0 = __builtin_amdgcn_mfma_f32_32x32x16_bf16(k1, Q.q[2 * hp][1], d0, 0, 0, 0); d1 = __builtin_amdgcn_mfma_f32_32x32x16_bf16(k1, Q.q[2 * hp + 1][1], d1, 0, 0, 0);
#if PROBE_MFMA2
        { f32x16 e0 = __builtin_amdgcn_mfma_f32_32x32x16_bf16(k0, Q.q[2 * hp][1], zz, 0, 0, 0); e0 = __builtin_amdgcn_mfma_f32_32x32x16_bf16(k1, Q.q[2 * hp][0], e0, 0, 0, 0);
          e0 = __builtin_amdgcn_mfma_f32_32x32x16_bf16(k0, Q.q[2 * hp + 1][1], e0, 0, 0, 0); e0 = __builtin_amdgcn_mfma_f32_32x32x16_bf16(k1, Q.q[2 * hp + 1][0], e0, 0, 0, 0); asm volatile("" :: "v"(e0)); }
#endif
#if IDX_PKFMA
        { typedef float f32x2 __attribute__((ext_vector_type(2)));
            const f32x2 wa = {Q.w[2 * hp], Q.w[2 * hp]}, wb = {Q.w[2 * hp + 1], Q.w[2 * hp + 1]};
#pragma unroll
            for (int r = 0; r < 16; r += 2) { const f32x2 ra = {__builtin_amdgcn_fmed3f(d0[r], 0.f, INFV), __builtin_amdgcn_fmed3f(d0[r + 1], 0.f, INFV)}, rb = {__builtin_amdgcn_fmed3f(d1[r], 0.f, INFV), __builtin_amdgcn_fmed3f(d1[r + 1], 0.f, INFV)};
                f32x2 ac = {acc[r], acc[r + 1]}; ac = __builtin_elementwise_fma(wa, ra, ac); ac = __builtin_elementwise_fma(wb, rb, ac); acc[r] = ac[0]; acc[r + 1] = ac[1]; } }
#else
#pragma unroll
        for (int r = 0; r < 16; ++r) {
#if IDX_ASMFMA
            const float r0 = __builtin_amdgcn_fmed3f(d0[r], 0.f, INFV), r1 = __builtin_amdgcn_fmed3f(d1[r], 0.f, INFV); float a0 = acc[r], a1;
            if (hp == 0) asm("v_mul_f32 %0, %1, %2" : "=v"(a0) : "v"(Q.w[0]), "v"(r0)); else asm("v_fma_f32 %0, %1, %2, %3" : "=v"(a0) : "v"(Q.w[2]), "v"(r0), "v"(acc[r]));
            asm("v_fma_f32 %0, %1, %2, %3" : "=v"(a1) : "v"(Q.w[2 * hp + 1]), "v"(r1), "v"(a0)); acc[r] = a1;
#else
            acc[r] = __builtin_fmaf(Q.w[2 * hp + 1], __builtin_amdgcn_fmed3f(d1[r], 0.f, INFV), __builtin_fmaf(Q.w[2 * hp], __builtin_amdgcn_fmed3f(d0[r], 0.f, INFV), acc[r]));
#endif
        }
#endif
    }
    return acc;
}
constexpr int G0 = (int)(0x3F800000u >> 18);
typedef __attribute__((address_space(3))) unsigned lds_u32;
__device__ __forceinline__ void hist_add(unsigned hb, float x, unsigned inc) {
    const float xc = __builtin_amdgcn_fmed3f(x, -254.0f, 254.0f);
#if IDX_ASMBIN
    float os, y; const unsigned m = 0x7fffffffu;
    asm("v_bfi_b32 %0, %1, 1.0, %2" : "=v"(os) : "s"(m), "v"(xc));
    asm("v_add_f32 %0, %1, %2" : "=v"(y) : "v"(xc), "v"(os));
    unsigned sh; asm("v_lshrrev_b32 %0, 18, %1" : "=v"(sh) : "v"(y));
    const unsigned a = hb + (sh << 2);
#else
    const float y = xc + __uint_as_float((__float_as_uint(xc) & 0x80000000u) | 0x3F800000u);
    const unsigned a = hb + ((__float_as_uint(y) >> 18) << 2);
#endif
    __hip_atomic_fetch_add((lds_u32*)a, inc, __ATOMIC_RELAXED, __HIP_MEMORY_SCOPE_WORKGROUP);
#if PROBE_ADD2
    __hip_atomic_fetch_add((lds_u32*)(a ^ 64u), 0u, __ATOMIC_RELAXED, __HIP_MEMORY_SCOPE_WORKGROUP);
#endif
}
__device__ __forceinline__ int hword(int q, int h) { return ((h >> 8) << 13) + q * 256 + (h & 255); }
__device__ __forceinline__ int rank_to_bin(int k) { return k < 256 ? 255 - k : k; }
__device__ __forceinline__ float xthr(int ot) { if (ot == 0) return 0.f;
    const unsigned B = (unsigned)(G0 + ot) << 18; unsigned hi = __float_as_uint(__uint_as_float(B) - 1.0f), lo = 0u;
#pragma unroll 1
    for (int i = 0; i < 32; ++i) { const unsigned mid = lo + ((hi - lo) >> 1); if (__float_as_uint(__uint_as_float(mid) + 1.0f) >= B) hi = mid; else lo = mid; }
    return __uint_as_float(hi); }
__device__ __forceinline__ unsigned wave_or(unsigned v) { int x = (int)v;
    x |= __builtin_amdgcn_update_dpp(0, x, 0x111, 0xf, 0xf, true); x |= __builtin_amdgcn_update_dpp(0, x, 0x112, 0xf, 0xf, true);
    x |= __builtin_amdgcn_update_dpp(0, x, 0x114, 0xf, 0xf, true); x |= __builtin_amdgcn_update_dpp(0, x, 0x118, 0xf, 0xf, true);
    x |= __builtin_amdgcn_update_dpp(0, x, 0x142, 0xf, 0xf, true); x |= __builtin_amdgcn_update_dpp(0, x, 0x143, 0xf, 0xf, true);
    return (unsigned)__builtin_amdgcn_readlane(x, 63); }
__device__ __forceinline__ float sel32(const f32x16& a, const f32x16& b, int e) {
    const bool b0 = e & 1, b1 = e & 2, b2 = e & 4, b3 = e & 8, b4 = e & 16;
    float v0 = a[0], v1 = a[1], v2 = a[2], v3 = a[3], v4 = a[4], v5 = a[5], v6 = a[6], v7 = a[7], v8 = a[8], v9 = a[9], v10 = a[10], v11 = a[11], v12 = a[12], v13 = a[13], v14 = a[14], v15 = a[15], v16 = b[0], v17 = b[1], v18 = b[2], v19 = b[3], v20 = b[4], v21 = b[5], v22 = b[6], v23 = b[7], v24 = b[8], v25 = b[9], v26 = b[10], v27 = b[11], v28 = b[12], v29 = b[13], v30 = b[14], v31 = b[15];
    asm("" : "+v"(v0)); asm("" : "+v"(v1)); asm("" : "+v"(v2)); asm("" : "+v"(v3)); asm("" : "+v"(v4)); asm("" : "+v"(v5)); asm("" : "+v"(v6)); asm("" : "+v"(v7)); asm("" : "+v"(v8)); asm("" : "+v"(v9)); asm("" : "+v"(v10)); asm("" : "+v"(v11)); asm("" : "+v"(v12)); asm("" : "+v"(v13)); asm("" : "+v"(v14)); asm("" : "+v"(v15)); asm("" : "+v"(v16)); asm("" : "+v"(v17)); asm("" : "+v"(v18)); asm("" : "+v"(v19)); asm("" : "+v"(v20)); asm("" : "+v"(v21)); asm("" : "+v"(v22)); asm("" : "+v"(v23)); asm("" : "+v"(v24)); asm("" : "+v"(v25)); asm("" : "+v"(v26)); asm("" : "+v"(v27)); asm("" : "+v"(v28)); asm("" : "+v"(v29)); asm("" : "+v"(v30)); asm("" : "+v"(v31));
    const float p0 = b0 ? v1 : v0, p1 = b0 ? v3 : v2, p2 = b0 ? v5 : v4, p3 = b0 ? v7 : v6, p4 = b0 ? v9 : v8, p5 = b0 ? v11 : v10, p6 = b0 ? v13 : v12, p7 = b0 ? v15 : v14, p8 = b0 ? v17 : v16, p9 = b0 ? v19 : v18, p10 = b0 ? v21 : v20, p11 = b0 ? v23 : v22, p12 = b0 ? v25 : v24, p13 = b0 ? v27 : v26, p14 = b0 ? v29 : v28, p15 = b0 ? v31 : v30;
    const float q0 = b1 ? p1 : p0, q1 = b1 ? p3 : p2, q2 = b1 ? p5 : p4, q3 = b1 ? p7 : p6, q4 = b1 ? p9 : p8, q5 = b1 ? p11 : p10, q6 = b1 ? p13 : p12, q7 = b1 ? p15 : p14;
    const float r0 = b2 ? q1 : q0, r1 = b2 ? q3 : q2, r2 = b2 ? q5 : q4, r3 = b2 ? q7 : q6;
    const float s0 = b3 ? r1 : r0, s1 = b3 ? r3 : r2;
    return b4 ? s1 : s0; }
__device__ __forceinline__ unsigned spread_nib(unsigned x) { x = (x | (x << 8)) & 0x00FF00FFu; return (x | (x << 4)) & 0x0F0F0F0Fu; }


template <int HP, int MODE, bool NEXT>
__device__ __forceinline__ void pstage(f32x16& acc, const f32x16& dc0, const f32x16& dc1, f32x16& dn0, f32x16& dn1, const bf16x8 ka, const bf16x8 kb,
                                       const bf16x8 qa0, const bf16x8 qa1, const bf16x8 qb0, const bf16x8 qb1, const float wA, const float wB,
                                       const unsigned hb, const unsigned inc, const int s0, const int t, const int hi, const float XU, const float XL, unsigned& wn, unsigned& wl) {
    const f32x16 zz = {0.f, 0.f, 0.f, 0.f, 0.f, 0.f, 0.f, 0.f, 0.f, 0.f, 0.f, 0.f, 0.f, 0.f, 0.f, 0.f};
    float INFV; asm("s_mov_b32 %0, 0x7f800000" : "=s"(INFV));
#pragma unroll
    for (int c = 3; c >= 0; --c) {
        if (NEXT) {
            if (c == 3) dn0 = __builtin_amdgcn_mfma_f32_32x32x16_bf16(ka, qa0, zz, 0, 0, 0);
            else if (c == 2) dn1 = __builtin_amdgcn_mfma_f32_32x32x16_bf16(ka, qb0, zz, 0, 0, 0);
            else if (c == 1) dn0 = __builtin_amdgcn_mfma_f32_32x32x16_bf16(kb, qa1, dn0, 0, 0, 0);
            else dn1 = __builtin_amdgcn_mfma_f32_32x32x16_bf16(kb, qb1, dn1, 0, 0, 0);
            __builtin_amdgcn_sched_barrier(0);
        }
#pragma unroll
        for (int r = 4 * c + 3; r >= 4 * c; --r) {
            const float r0 = __builtin_amdgcn_fmed3f(dc0[r], 0.f, INFV), r1 = __builtin_amdgcn_fmed3f(dc1[r], 0.f, INFV);
            float x = __builtin_fmaf(wB, r1, __builtin_fmaf(wA, r0, HP == 0 ? 0.f : acc[r]));
            if (MODE == 4) { if (s0 + crow(r, hi) > t) x = -__builtin_inff(); }
            acc[r] = x;
            if (MODE == 1) hist_add(hb, x, inc);
            if (MODE == 2) { if (s0 + crow(r, hi) <= t) hist_add(hb, x, inc); }
            if (MODE == 3 || MODE == 4) { const float t1 = x - XU, t2 = x - XL; wn = __builtin_amdgcn_alignbit(wn, __float_as_uint(t1), 31); wl = __builtin_amdgcn_alignbit(wl, __float_as_uint(t2), 31); }
        }
        if (NEXT) __builtin_amdgcn_sched_barrier(0);
    }
}
__device__ __forceinline__ void index_unit(const unsigned short* P, const unsigned short* KC, unsigned* MK, unsigned* ZWg, unsigned char* lds, int b, int qt, int tid) {
    const int lane = tid & 63, wave = __builtin_amdgcn_readfirstlane(tid >> 6), r32 = lane & 31, hi = lane >> 5;
    unsigned* hist32 = (unsigned*)(lds + L_HIST); unsigned* cand_s = (unsigned*)(lds + L_HIST); unsigned* cand_i = (unsigned*)(lds + L_HIST + 32768);     unsigned* zc = (unsigned*)(lds + L_ZC); int* par = (int*)(lds + L_PAR);
    const int t = qt * 32 + r32; const size_t qrow = (size_t)b * SEQ + t;
    const int kt_max = (qt * 32 + 31) >> 6, NTW = ((qt >> 3) + 1) * 4;
    const unsigned short* KI = KC + (size_t)b * SEQ * 32;
    QFrag Q; float invw;
    for (int rh_ = 0; rh_ < REP_HEAD; ++rh_) { asm volatile("" ::: "memory");
    { const unsigned short* qp = P + qrow * NP + N_QI + hi * 8; float var = 0.f;
#pragma unroll
        for (int h = 0; h < 4; ++h) { float s = 0.f;
#pragma unroll
            for (int ks = 0; ks < 2; ++ks) { Q.q[h][ks] = *(const bf16x8*)(qp + h * 32 + ks * 16);
#pragma unroll
                for (int j = 0; j < 8; ++j) { const float v = bf2f((unsigned short)Q.q[h][ks][j]); s += v * v; } }
            s += shx(s, 32, lane); Q.w[h] = bf2f(P[qrow * NP + N_WI + h]); var += Q.w[h] * Q.w[h] * s; }
        invw = 82.7f / sqrtf(var > 1e-20f ? var : 1e-20f);
#pragma unroll
        for (int h = 0; h < 4; ++h) Q.w[h] *= invw; }
    __syncthreads();
    { typedef unsigned u32x4z __attribute__((ext_vector_type(4))); for (int i = tid; i < (L_PAR + 2048) / 16; i += NTHR) ((__attribute__((address_space(3))) u32x4z*)lds)[i] = (u32x4z){0u, 0u, 0u, 0u}; }
    __syncthreads(); }
    __attribute__((address_space(3))) unsigned char* kbuf = (__attribute__((address_space(3))) unsigned char*)lds + L_KBUF + wave * 4096;
#define IDX_KISSUE(kt_) do { const unsigned short* kp_ = KI + (size_t)(kt_) * 2048 + lane * 8;        \
        __builtin_amdgcn_global_load_lds((const unsigned*)kp_, (__attribute__((address_space(3))) unsigned*)kbuf, 16, 0, 0); \
        __builtin_amdgcn_global_load_lds((const unsigned*)(kp_ + 512), (__attribute__((address_space(3))) unsigned*)(kbuf + 1024), 16, 0, 0); \
        __builtin_amdgcn_global_load_lds((const unsigned*)(kp_ + 1024), (__attribute__((address_space(3))) unsigned*)(kbuf + 2048), 16, 0, 0); \
        __builtin_amdgcn_global_load_lds((const unsigned*)(kp_ + 1536), (__attribute__((address_space(3))) unsigned*)(kbuf + 3072), 16, 0, 0); } while (0)
#define IDX_KREAD(dst) do { const int ko_ = r32 * 64 + hi * 16;                                     \
        dst[0] = *(__attribute__((address_space(3))) bf16x8*)(kbuf + ko_); dst[1] = *(__attribute__((address_space(3))) bf16x8*)(kbuf + ko_ + 32); \
        dst[2] = *(__attribute__((address_space(3))) bf16x8*)(kbuf + ko_ + 2048); dst[3] = *(__attribute__((address_space(3))) bf16x8*)(kbuf + ko_ + 2080); } while (0)
#define IDX_KTAKE(dst, cnt_) do { asm volatile("s_waitcnt vmcnt(" cnt_ ")" ::: "memory"); IDX_KREAD(dst); asm volatile("s_waitcnt lgkmcnt(0)" ::: "memory"); } while (0)
    const unsigned hb = (unsigned)(size_t)((__attribute__((address_space(3))) unsigned char*)lds) + L_HIST + r32 * 1024 - 4 * G0;
#if IDX_PRIO
    if (wave >= 4) __builtin_amdgcn_s_setprio(1);
#endif
    const int qlo = qt * 32;
#define IDX_PRO(dA, dB) do { const f32x16 zz_ = {0.f, 0.f, 0.f, 0.f, 0.f, 0.f, 0.f, 0.f, 0.f, 0.f, 0.f, 0.f, 0.f, 0.f, 0.f, 0.f}; \
        dA = __builtin_amdgcn_mfma_f32_32x32x16_bf16(kc[0], Q.q[0][0], zz_, 0, 0, 0); dB = __builtin_amdgcn_mfma_f32_32x32x16_bf16(kc[0], Q.q[1][0], zz_, 0, 0, 0); \
        dA = __builtin_amdgcn_mfma_f32_32x32x16_bf16(kc[1], Q.q[0][1], dA, 0, 0, 0); dB = __builtin_amdgcn_mfma_f32_32x32x16_bf16(kc[1], Q.q[1][1], dB, 0, 0, 0); } while (0)
#define IDX_QHI Q.q[2][0], Q.q[2][1], Q.q[3][0], Q.q[3][1]
#define IDX_QLO Q.q[0][0], Q.q[0][1], Q.q[1][0], Q.q[1][1]
    for (int rp1 = 0; rp1 < REP_P1; ++rp1) { bf16x8 kc[4]; const unsigned inc1 = (rp1 & 1) ? 0xffffffffu : 1u; if (wave <= kt_max) IDX_KISSUE(wave);
      for (int kt = wave; kt <= kt_max; kt += 8) {
        IDX_KTAKE(kc, "0"); if (kt + 8 <= kt_max) IDX_KISSUE(kt + 8);
        if (kt * 64 + 63 <= qlo) {
#pragma unroll
            for (int sub = 0; sub < 2; ++sub) { const f32x16 sc = score_sub(kc[2 * sub], kc[2 * sub + 1], Q);
#pragma unroll
                for (int r = 0; r < 16; ++r) hist_add(hb, sc[r], inc1); }
        } else {
#pragma unroll
            for (int sub = 0; sub < 2; ++sub) { const f32x16 sc = score_sub(kc[2 * sub], kc[2 * sub + 1], Q); const int s0 = kt * 64 + sub * 32;
#pragma unroll
                for (int r = 0; r < 16; ++r) { if (s0 + crow(r, hi) <= t) hist_add(hb, sc[r], inc1); } }
        }
      } }
    __syncthreads();
    for (int rr_ = 0; rr_ < REP_RES; ++rr_) { __syncthreads(); asm volatile("" ::: "memory");
    { typedef unsigned u32x4r __attribute__((ext_vector_type(4)));
        const int q = tid >> 4, j = tid & 15, N = qt * 32 + q + 1; const bool neg = j >= 8;
        const unsigned* hs = hist32 + (neg ? 8192 + q * 256 + 32 * (j - 8) : q * 256 + 224 - 32 * j); int c = 0;
#pragma unroll
        for (int u = 0; u < 8; ++u) { const u32x4r v = *(const u32x4r*)(hs + 4 * ((u + (j >> 1)) & 7)); c += (int)(v[0] + v[1] + v[2] + v[3]); }
        int incl = c;
#pragma unroll
        for (int o = 1; o < 16; o <<= 1) { const int v = __builtin_amdgcn_ds_bpermute(((lane - o) & 63) << 2, incl); if (j >= o) incl += v; }
        const int excl = incl - c;
        if (N <= 256) { if (j == 0) par[P_MODE * 32 + q] = 0; }
        else if (excl < 256 && 256 <= incl) { u32x4r w[8];
#pragma unroll
            for (int u = 0; u < 8; ++u) w[u] = *(const u32x4r*)(hs + 4 * u);
            int above = excl, isel = -1, cntb = 0, ab = 0;
#pragma unroll
            for (int i = 0; i < 32; ++i) { const int cb = (int)(neg ? w[i >> 2][i & 3] : w[(31 - i) >> 2][(31 - i) & 3]); if (isel < 0 && above + cb >= 256) { isel = i; cntb = cb; ab = above; } above += cb; }
            const int bsel = rank_to_bin(32 * j + isel), ot = bsel & 255; const float* XT = (const float*)(lds + L_XT);
            par[P_BSTAR * 32 + q] = bsel; par[P_KK * 32 + q] = 256 - ab; par[P_MODE * 32 + q] = (bsel != 0 && cntb > CAP) ? 3 : 1;
            const float xa = XT[ot], xb = XT[ot + 1];
            const float XL = neg ? -__uint_as_float(__float_as_uint(xb) - 1u) : xa;
            const float XU = neg ? (xa > 0.f ? -__uint_as_float(__float_as_uint(xa) - 1u) : 0.f) : xb;
            par[P_XL * 32 + q] = (int)__float_as_uint(XL); par[P_XU * 32 + q] = (int)__float_as_uint(XU); }
    } }
    __syncthreads();
    const int my_mode = par[P_MODE * 32 + r32], my_b = par[P_BSTAR * 32 + r32];
    __syncthreads();
    float XL = __uint_as_float((unsigned)par[P_XL * 32 + r32]), XU = __uint_as_float((unsigned)par[P_XU * 32 + r32]);
    if (my_mode == 0) { XL = -3.0e38f; XU = -3.0e38f; }
    if (my_mode == 3) { XL = __builtin_inff(); XU = __builtin_inff(); }
    const bool central = (my_mode == 1 && my_b == 0);
    unsigned* ZW = ZWg;
    for (int r2_ = 0; r2_ < REP_P2; ++r2_) { if (r2_) { __syncthreads(); for (int i = tid; i < 32 * 128; i += NTHR) zc[i] = 0u; if (tid < 32) { par[P_CCNT * 32 + tid] = 0; par[P_OVF * 32 + tid] = 0; } __syncthreads(); }
    { bf16x8 kc[4]; if (wave <= kt_max) IDX_KISSUE(wave);
      for (int kt = wave; kt < NTW; kt += 8) {
        unsigned word = 0u, wz = 0u;
        if (kt <= kt_max) {
            if (kt == wave) { IDX_KTAKE(kc, "0"); } else { IDX_KTAKE(kc, "2"); }
            if (kt + 8 <= kt_max) IDX_KISSUE(kt + 8);
            asm volatile("" ::: "memory");
            f32x16 s0v = score_sub(kc[0], kc[1], Q), s1v = score_sub(kc[2], kc[3], Q);
            const bool diag = kt * 64 + 63 > qlo;
            if (diag) {
#pragma unroll
                for (int r = 0; r < 16; ++r) { const int s = kt * 64 + crow(r, hi); if (s > t) s0v[r] = -__builtin_inff(); if (s + 32 > t) s1v[r] = -__builtin_inff(); } }
            unsigned wn = 0u, wl = 0u;
#pragma unroll
            for (int e = 31; e >= 0; --e) { const float x = (e < 16) ? s0v[e & 15] : s1v[e & 15]; float t1, t2;
#if IDX_ASMBIN
                asm("v_sub_f32 %0, %1, %2" : "=v"(t1) : "v"(x), "v"(XU)); asm("v_sub_f32 %0, %1, %2" : "=v"(t2) : "v"(x), "v"(XL));
#else
                t1 = x - XU; t2 = x - XL;
#endif
                wn = __builtin_amdgcn_alignbit(wn, __float_as_uint(t1), 31); wl = __builtin_amdgcn_alignbit(wl, __float_as_uint(t2), 31); }
            word = ~wn; const unsigned inb = wn & ~wl;
            if ((REP_P2 == 1 || r2_ > 0) && __any(inb != 0u)) {
                unsigned zb = 0u;
                if (__any(central && inb != 0u)) { unsigned UZ = wave_or(central ? inb : 0u);
                    while (UZ) { const int e = __builtin_ctz(UZ); UZ &= UZ - 1u; const float x = (e < 16) ? s0v[e & 15] : s1v[e & 15];
                        if (central && ((inb >> e) & 1u) && x == 0.f) zb |= (1u << e); }
                    if (zb) lds_add(&zc[r32 * 128 + kt], (unsigned)__builtin_popcount(zb)); wz = zb; }
                const unsigned cb = inb & ~zb; const int cnt = __builtin_popcount(cb); int pos = 0;
                if (cnt) { pos = (int)lds_add((unsigned*)&par[P_CCNT * 32 + r32], (unsigned)cnt); if (pos + cnt > CAP) par[P_OVF * 32 + r32] = 1; }
                unsigned m = cb; int slot = pos;
                while (__any(m != 0u)) { const int e = (int)__builtin_ctz(m | 0x80000000u); const float x = sel32(s0v, s1v, e);
                    if (m != 0u && slot < CAP) { cand_s[r32 * CAP + slot] = __float_as_uint(x); cand_i[r32 * CAP + slot] = (unsigned)(kt * 64 + 32 * (e >> 4) + ((e & 3) + 8 * ((e & 15) >> 2) + 4 * hi)); }
                    m &= m - 1u; ++slot; }
            }
        }
        MK[((size_t)(b * 256 + qt) * 128 + kt) * 64 + lane] = word; ZW[kt * 64 + lane] = wz;
      } } }
#if IDX_PRIO
    __builtin_amdgcn_s_setprio(0);
#endif
    asm volatile("s_waitcnt vmcnt(0)" ::: "memory");
    __syncthreads();
    for (int rk_ = 0; rk_ < REP_RANK; ++rk_) { if (rk_) __syncthreads(); asm volatile("" ::: "memory");
    { const int q = tid >> 4, j = tid & 15, mode = par[P_MODE * 32 + q], kk = par[P_KK * 32 + q], bq = par[P_BSTAR * 32 + q];
        const int n = par[P_CCNT * 32 + q] < CAP ? par[P_CCNT * 32 + q] : CAP, n4 = (n + 3) & ~3;
        if (mode == 1 && par[P_OVF * 32 + q]) { if (j == 0) par[P_MODE * 32 + q] = 3; }
        else if (mode == 1 && kk <= n) {
            if (j < n4 - n) { cand_s[q * CAP + n + j] = 0xFF800000u; cand_i[q * CAP + n + j] = 0xFFFFFFFFu; }
            if (j == 0) { par[P_NRANK * 32 + q] = n; par[P_TSTAR * 32 + q] = -1; } }
        else if (mode == 1 && bq == 0) {
            const int need = kk - n; int zl[8], c = 0;
#pragma unroll
            for (int u = 0; u < 8; ++u) { zl[u] = (int)zc[q * 128 + 8 * j + u]; c += zl[u]; }
            int incl = c;
#pragma unroll
            for (int o = 1; o < 16; o <<= 1) { const int v = __builtin_amdgcn_ds_bpermute(((lane - o) & 63) << 2, incl); if (j >= o) incl += v; }
            int cum = incl - c;
            if (j == 0) { par[P_TAU * 32 + q] = (int)0xFF800000u; par[P_CUT * 32 + q] = -1; }
            if (cum < need && need <= incl) { int ts = 8 * j + 7, rs = 1; bool done = false;
#pragma unroll
                for (int u = 0; u < 8; ++u) { if (!done && cum + zl[u] >= need) { ts = 8 * j + u; rs = need - cum; done = true; } cum += zl[u]; }
                par[P_TSTAR * 32 + q] = ts; par[P_RSTAR * 32 + q] = rs; } }
        else if (mode == 1) { if (j == 0) par[P_MODE * 32 + q] = 3; }
    }
    __syncthreads();
    if (tid < 64) { const int q = lane & 31; int incl = par[P_NRANK * 32 + q];
#pragma unroll
        for (int o = 1; o < 32; o <<= 1) { const int v = __builtin_amdgcn_ds_bpermute(((lane - o) & 63) << 2, incl); if (q >= o) incl += v; }
        if (lane < 32) par[P_PRE * 32 + q] = incl; }
    __syncthreads();
    { typedef unsigned u32x4v __attribute__((ext_vector_type(4)));
        const int total = par[P_PRE * 32 + 31];
        for (int g = tid; g < total; g += NTHR) {
            int q = 0;
#pragma unroll
            for (int st = 16; st >= 1; st >>= 1) { if (par[P_PRE * 32 + q + st - 1] <= g) q += st; }
            const int i = g - (q ? par[P_PRE * 32 + q - 1] : 0), n = par[P_NRANK * 32 + q], n4 = (n + 3) & ~3, kk = par[P_KK * 32 + q];
            const unsigned cix = cand_s[q * CAP + i], ciy = cand_i[q * CAP + i]; const float si = __uint_as_float(cix); int rank = 0;
#pragma unroll 2
            for (int m2 = 0; m2 < n4; m2 += 4) { const u32x4v sv = *(const u32x4v*)&cand_s[q * CAP + m2], iv = *(const u32x4v*)&cand_i[q * CAP + m2];
#pragma unroll
                for (int u = 0; u < 4; ++u) { const float sm = __uint_as_float(sv[u]); rank += (sm > si || (sm == si && iv[u] < ciy)) ? 1 : 0; } }
            if (rank == kk - 1) { par[P_TAU * 32 + q] = (int)cix; par[P_CUT * 32 + q] = (int)ciy; } } }
    __syncthreads(); }
    for (int rpp = 0; rpp < REP_PATCH; ++rpp)
    { const int q = tid >> 4, j = tid & 15, mode = par[P_MODE * 32 + q];
        if (mode == 1) { const int n = par[P_CCNT * 32 + q]; const float tau = __uint_as_float((unsigned)par[P_TAU * 32 + q]); const unsigned cut = (unsigned)par[P_CUT * 32 + q]; const int ts = par[P_TSTAR * 32 + q], rs = par[P_RSTAR * 32 + q];
            unsigned* mq = MK + (size_t)(b * 256 + qt) * 128 * 64 + q;
#pragma unroll 1
            for (int i = j; i < n; i += 16) { const float sc = __uint_as_float(cand_s[q * CAP + i]); const unsigned s = cand_i[q * CAP + i];
                if (sc > tau || (sc == tau && s <= cut)) { const int kap = s & 63, k5 = kap & 31, hh = (k5 >> 2) & 1, e = (k5 & 3) + 4 * (k5 >> 3) + 16 * (kap >> 5);
                    __hip_atomic_fetch_or(mq + (s >> 6) * 64 + 32 * hh, 1u << e, __ATOMIC_RELAXED, __HIP_MEMORY_SCOPE_AGENT); } }
            if (ts >= 0) {
                unsigned zw0[8], zw1[8];
#pragma unroll
                for (int u = 0; u < 8; ++u) { const int kt = j + 16 * u; zw0[u] = 0u; zw1[u] = 0u; if (kt <= ts) { zw0[u] = __hip_atomic_load(ZW + kt * 64 + q, __ATOMIC_RELAXED, __HIP_MEMORY_SCOPE_AGENT); zw1[u] = __hip_atomic_load(ZW + kt * 64 + 32 + q, __ATOMIC_RELAXED, __HIP_MEMORY_SCOPE_AGENT); } }
#pragma unroll
                for (int u = 0; u < 8; ++u) { const int kt = j + 16 * u; if (kt <= ts) { const unsigned w0 = zw0[u], w1 = zw1[u]; unsigned a0 = w0, a1 = w1;
                    if (kt == ts) { const unsigned lo32 = spread_nib(w0 & 0xffffu) | (spread_nib(w1 & 0xffffu) << 4), hi32 = spread_nib(w0 >> 16) | (spread_nib(w1 >> 16) << 4);
                        const unsigned long long ord = (unsigned long long)lo32 | ((unsigned long long)hi32 << 32);
                        int nn = rs, kap = 0; unsigned w = (unsigned)ord; int c = __builtin_popcount(w);
                        if (nn > c) { nn -= c; w = (unsigned)(ord >> 32); kap = 32; }
                        c = __builtin_popcount(w & 0xffffu); if (nn > c) { nn -= c; w >>= 16; kap += 16; }
                        c = __builtin_popcount(w & 0xffu); if (nn > c) { nn -= c; w >>= 8; kap += 8; }
                        c = __builtin_popcount(w & 0xfu); if (nn > c) { nn -= c; w >>= 4; kap += 4; }
                        c = __builtin_popcount(w & 0x3u); if (nn > c) { nn -= c; w >>= 2; kap += 2; }
                        c = (int)(w & 1u); if (nn > c) kap += 1;
                        unsigned k0 = 0u, k1 = 0u;
#pragma unroll
                        for (int e = 0; e < 32; ++e) { const int pos0 = 32 * (e >> 4) + crow(e & 15, 0), pos1 = 32 * (e >> 4) + crow(e & 15, 1); if (pos0 <= kap) k0 |= (1u << e); if (pos1 <= kap) k1 |= (1u << e); }
                        a0 &= k0; a1 &= k1; }
                    if (a0) __hip_atomic_fetch_or(mq + kt * 64, a0, __ATOMIC_RELAXED, __HIP_MEMORY_SCOPE_AGENT);
                    if (a1) __hip_atomic_fetch_or(mq + kt * 64 + 32, a1, __ATOMIC_RELAXED, __HIP_MEMORY_SCOPE_AGENT); } } }
        }
    }
    __syncthreads();
}
#undef IDX_KISSUE
#undef IDX_KTAKE
#undef IDX_KREAD
}
namespace glab {
typedef short bf16x8 __attribute__((ext_vector_type(8)));
typedef short s16x4 __attribute__((ext_vector_type(4)));
typedef float f32x16 __attribute__((ext_vector_type(16)));
typedef float f32x4 __attribute__((ext_vector_type(4)));
typedef unsigned u32x4 __attribute__((ext_vector_type(4)));
typedef unsigned u32x2 __attribute__((ext_vector_type(2)));
typedef float f32x2_t __attribute__((ext_vector_type(2))); typedef __bf16 bf16x2_t __attribute__((ext_vector_type(2)));
#define GLAS __attribute__((address_space(3)))
constexpr int RAW_Q = 0, RAW_K = 6144, RAW_V = 12288, RAW_Z = 24576, OP_QE = 26624, OP_KE = 33792, OP_KDT = 40960, OP_VT = 47872, OP_DEC = 61696, OP_BLK_BYTES = 35328  ,
              OP_BLK1 = 61952  , OP_ST = 97280, ST_BYTES = 10752;
__device__ __forceinline__ unsigned cvtpk(float lo, float hi) { f32x2_t v = {lo, hi}; bf16x2_t b = __builtin_convertvector(v, bf16x2_t); return __builtin_bit_cast(unsigned, b); }
__device__ __forceinline__ int crow(int r, int hi) { return (r & 3) + 8 * (r >> 2) + 4 * hi; }
__device__ __forceinline__ float bfl(unsigned short b) { return __uint_as_float((unsigned)b << 16); }


__device__ __forceinline__ void gla_prep_item(const unsigned short* P, unsigned char* GOP, const float* w2, const float* gb, unsigned char* ldsg, int item, int tid) {
    GLAS unsigned char* lds = (GLAS unsigned char*)ldsg;
    const int lane = tid & 63; const int b = item >> 9, h = (item >> 7) & 3, n = item & 127;
    const size_t m0 = (size_t)b * SEQ + (size_t)n * 64;
    __syncthreads();
#define GLA_PCOL(c) (((c) < 6) ? (N_GQ + h * 48 + (c) * 8) : ((c) < 12) ? (N_GK + h * 48 + ((c) - 6) * 8) : ((c) < 24) ? (N_GV + h * 96 + ((c) - 12) * 8) : (N_GZ + ((c) - 24) * 8))
#define GLA_PDST(row, c) (((c) < 6) ? (RAW_Q + (row) * 96 + (c) * 16) : ((c) < 12) ? (RAW_K + (row) * 96 + ((c) - 6) * 16) : ((c) < 24) ? (RAW_V + (row) * 192 + ((c) - 12) * 16) : (RAW_Z + (row) * 32 + ((c) - 24) * 16))
#pragma unroll
    for (int k = 0; k < 4; ++k) { const int p = tid + 512 * k; if (p < 1664) { const int row = p / 26, c = p % 26; *(GLAS u32x4*)(lds + GLA_PDST(row, c)) = *(const u32x4*)(P + (m0 + row) * NP + GLA_PCOL(c)); } }
    __syncthreads();
    const int sd = tid >> 3, tg = tid & 7;
    if (tid < 384) {
            float c[8], w2c[16]; const float bc = gb[h * 48 + sd];
#pragma unroll
            for (int r = 0; r < 16; ++r) w2c[r] = w2[(size_t)r * 192 + h * 48 + sd];
#pragma unroll
            for (int tt = 0; tt < 8; ++tt) { const int t = 8 * tg + tt; const u32x4 z0 = *(GLAS u32x4*)(lds + RAW_Z + t * 32), z1 = *(GLAS u32x4*)(lds + RAW_Z + t * 32 + 16); float z = bc;
#pragma unroll
                for (int k = 0; k < 4; ++k) { z += w2c[2 * k] * __uint_as_float(z0[k] << 16) + w2c[2 * k + 1] * __uint_as_float(z0[k] & 0xffff0000u); z += w2c[8 + 2 * k] * __uint_as_float(z1[k] << 16) + w2c[8 + 2 * k + 1] * __uint_as_float(z1[k] & 0xffff0000u); }
                const float ls = fminf(z, 0.f) - __logf(1.0f + __expf(-fabsf(z)));
                c[tt] = ls * (1.0f / 16.0f) + (tt ? c[tt - 1] : 0.f); }
            float incl = c[7];
#pragma unroll
            for (int o = 1; o < 8; o <<= 1) { const float v = __builtin_bit_cast(float, __builtin_amdgcn_ds_bpermute(((lane - o) & 63) << 2, __builtin_bit_cast(int, incl))); if (tg >= o) incl += v; }
            const float off = incl - c[7];
            const float bl = __builtin_bit_cast(float, __builtin_amdgcn_ds_bpermute((lane | 7) << 2, __builtin_bit_cast(int, incl)));
            unsigned kdp[4];
#pragma unroll
            for (int tt = 0; tt < 8; tt += 2) { float kdv[2];
#pragma unroll
                for (int u = 0; u < 2; ++u) { const int t = 8 * tg + tt + u; const float bb = off + c[tt + u];
                    const float q = bfl(*(GLAS unsigned short*)(lds + RAW_Q + (t * 48 + sd) * 2)), kx = bfl(*(GLAS unsigned short*)(lds + RAW_K + (t * 48 + sd) * 2));
                    const float e1 = __expf(bb), e2 = __expf(-bb), e3 = __expf(bl - bb);
                    *(GLAS unsigned short*)(lds + OP_QE + (t * 56 + sd) * 2) = (unsigned short)(cvtpk(q * e1, 0.f) & 0xffffu);
                    *(GLAS unsigned short*)(lds + OP_KE + (t * 56 + sd) * 2) = (unsigned short)(cvtpk(kx * e2, 0.f) & 0xffffu);
                    kdv[u] = kx * e3; }
                kdp[tt >> 1] = cvtpk(kdv[0], kdv[1]); }
            *(GLAS u32x4*)(lds + OP_KDT + (sd * 72 + 8 * tg) * 2) = (u32x4){kdp[0], kdp[1], kdp[2], kdp[3]};
            if (tg == 7) ((GLAS float*)(lds + OP_DEC))[sd] = __expf(bl);
    } else {
            for (int idx = tid - 384; idx < 96 * 8; idx += 128) { const int v = idx % 96, t8 = idx / 96; unsigned pk[4];
#pragma unroll
                for (int tt = 0; tt < 8; tt += 2) { const unsigned a0 = *(GLAS unsigned short*)(lds + RAW_V + ((8 * t8 + tt) * 96 + v) * 2), a1 = *(GLAS unsigned short*)(lds + RAW_V + ((8 * t8 + tt + 1) * 96 + v) * 2); pk[tt >> 1] = a0 | (a1 << 16); }
                *(GLAS u32x4*)(lds + OP_VT + (v * 72 + 8 * t8) * 2) = (u32x4){pk[0], pk[1], pk[2], pk[3]}; }
    }
    __syncthreads();
    unsigned char* dst = GOP + (size_t)item * OP_BLK_BYTES;
    for (int i = tid; i < (OP_DEC + 192 - OP_QE) / 16; i += NTHR) *(u32x4*)(dst + i * 16) = *(GLAS u32x4*)(lds + OP_QE + i * 16);
}
__device__ __forceinline__ void gla_prep_loop(const unsigned short* P, unsigned char* GOP, const float* w2, const float* gb, unsigned char* ldsg, int wg, int G, int tid) {
    GLAS unsigned char* lds = (GLAS unsigned char*)ldsg;
    const int lane = tid & 63;
#define GLA_PCOLH(c, hh) (((c) < 6) ? (N_GQ + (hh) * 48 + (c) * 8) : ((c) < 12) ? (N_GK + (hh) * 48 + ((c) - 6) * 8) : ((c) < 24) ? (N_GV + (hh) * 96 + ((c) - 12) * 8) : (N_GZ + ((c) - 24) * 8))
#define GLA_PDST(row, c) (((c) < 6) ? (RAW_Q + (row) * 96 + (c) * 16) : ((c) < 12) ? (RAW_K + (row) * 96 + ((c) - 6) * 16) : ((c) < 24) ? (RAW_V + (row) * 192 + ((c) - 12) * 16) : (RAW_Z + (row) * 32 + ((c) - 24) * 16))
#define GLA_FETCH(it_) do { const int b_ = (it_) >> 9, h_ = ((it_) >> 7) & 3, n_ = (it_) & 127; const size_t mr_ = (size_t)b_ * SEQ + (size_t)n_ * 64; \
        _Pragma("unroll") for (int k = 0; k < 4; ++k) { const int p = tid + 512 * k; if (p < 1664) { const int row = p / 26, c = p % 26; rawr[k] = *(const u32x4*)(P + (mr_ + row) * NP + GLA_PCOLH(c, h_)); } } } while (0)
    u32x4 rawr[4];
    if (wg < BATCH * 4 * 128) GLA_FETCH(wg);
    for (int item = wg; item < BATCH * 4 * 128; item += G) {
    const int h = (item >> 7) & 3;
    __syncthreads();
#pragma unroll
    for (int k = 0; k < 4; ++k) { const int p = tid + 512 * k; if (p < 1664) { const int row = p / 26, c = p % 26; *(GLAS u32x4*)(lds + GLA_PDST(row, c)) = rawr[k]; } }
    if (item + G < BATCH * 4 * 128) GLA_FETCH(item + G);
    __syncthreads();
    const int sd = tid >> 3, tg = tid & 7;
    if (tid < 384) {
            float c[8], w2c[16]; const float bc = gb[h * 48 + sd];
#pragma unroll
            for (int r = 0; r < 16; ++r) w2c[r] = w2[(size_t)r * 192 + h * 48 + sd];
#pragma unroll
            for (int tt = 0; tt < 8; ++tt) { const int t = 8 * tg + tt; const u32x4 z0 = *(GLAS u32x4*)(lds + RAW_Z + t * 32), z1 = *(GLAS u32x4*)(lds + RAW_Z + t * 32 + 16); float z = bc;
#pragma unroll
                for (int k = 0; k < 4; ++k) { z += w2c[2 * k] * __uint_as_float(z0[k] << 16) + w2c[2 * k + 1] * __uint_as_float(z0[k] & 0xffff0000u); z += w2c[8 + 2 * k] * __uint_as_float(z1[k] << 16) + w2c[8 + 2 * k + 1] * __uint_as_float(z1[k] & 0xffff0000u); }
                const float ls = fminf(z, 0.f) - __logf(1.0f + __expf(-fabsf(z)));
                c[tt] = ls * (1.0f / 16.0f) + (tt ? c[tt - 1] : 0.f); }
            float incl = c[7];
#pragma unroll
            for (int o = 1; o < 8; o <<= 1) { const float v = __builtin_bit_cast(float, __builtin_amdgcn_ds_bpermute(((lane - o) & 63) << 2, __builtin_bit_cast(int, incl))); if (tg >= o) incl += v; }
            const float off = incl - c[7];
            const float bl = __builtin_bit_cast(float, __builtin_amdgcn_ds_bpermute((lane | 7) << 2, __builtin_bit_cast(int, incl)));
            unsigned kdp[4];
#pragma unroll
            for (int tt = 0; tt < 8; tt += 2) { float kdv[2];
#pragma unroll
                for (int u = 0; u < 2; ++u) { const int t = 8 * tg + tt + u; const float bb = off + c[tt + u];
                    const float q = bfl(*(GLAS unsigned short*)(lds + RAW_Q + (t * 48 + sd) * 2)), kx = bfl(*(GLAS unsigned short*)(lds + RAW_K + (t * 48 + sd) * 2));
                    const float e1 = __expf(bb), e2 = __expf(-bb), e3 = __expf(bl - bb);
                    *(GLAS unsigned short*)(lds + OP_QE + (t * 56 + sd) * 2) = (unsigned short)(cvtpk(q * e1, 0.f) & 0xffffu);
                    *(GLAS unsigned short*)(lds + OP_KE + (t * 56 + sd) * 2) = (unsigned short)(cvtpk(kx * e2, 0.f) & 0xffffu);
                    kdv[u] = kx * e3; }
                kdp[tt >> 1] = cvtpk(kdv[0], kdv[1]); }
            *(GLAS u32x4*)(lds + OP_KDT + (sd * 72 + 8 * tg) * 2) = (u32x4){kdp[0], kdp[1], kdp[2], kdp[3]};
            if (tg == 7) ((GLAS float*)(lds + OP_DEC))[sd] = __expf(bl);
    } else {
            for (int idx = tid - 384; idx < 96 * 8; idx += 128) { const int v = idx % 96, t8 = idx / 96; unsigned pk[4];
#pragma unroll
                for (int tt = 0; tt < 8; tt += 2) { const unsigned a0 = *(GLAS unsigned short*)(lds + RAW_V + ((8 * t8 + tt) * 96 + v) * 2), a1 = *(GLAS unsigned short*)(lds + RAW_V + ((8 * t8 + tt + 1) * 96 + v) * 2); pk[tt >> 1] = a0 | (a1 << 16); }
                *(GLAS u32x4*)(lds + OP_VT + (v * 72 + 8 * t8) * 2) = (u32x4){pk[0], pk[1], pk[2], pk[3]}; }
    }
    __syncthreads();
    unsigned char* dst = GOP + (size_t)item * OP_BLK_BYTES;
    for (int i = tid; i < (OP_DEC + 192 - OP_QE) / 16; i += NTHR) *(u32x4*)(dst + i * 16) = *(GLAS u32x4*)(lds + OP_QE + i * 16);
    }
#undef GLA_FETCH
#undef GLA_PCOLH
}
__device__ __forceinline__ void gla_seq_unit(const unsigned short* P, unsigned short* Y, const unsigned char* GOP, const float* ng, unsigned char* ldsg, int b, int h, int tid) {
    GLAS unsigned char* lds = (GLAS unsigned char*)ldsg;
    const int lane = tid & 63, wave = __builtin_amdgcn_readfirstlane(tid >> 6), r32 = lane & 31, hi = lane >> 5, l15 = lane & 15, quad = lane >> 4;
    const size_t rowbase = (size_t)b * SEQ; const unsigned char* gsrc = GOP + (size_t)((b * 4 + h) * 128) * OP_BLK_BYTES;
    constexpr int NPC = (OP_DEC + 192 - OP_QE) / 16;
    constexpr int SQ_BLK0 = 0, SQ_BLK1 = OP_BLK_BYTES, SQ_ST = 2 * OP_BLK_BYTES  , SQ_OB = SQ_ST + 2 * ST_BYTES  , SQ_OB_BYTES = 64 * 96 * 2, SQ_NG = SQ_OB + 2 * SQ_OB_BYTES  ;
    __syncthreads();
    for (int i = tid; i < 2 * ST_BYTES / 4; i += NTHR) ((GLAS unsigned*)(lds + SQ_ST))[i] = 0u;
    if (tid < 96) ((GLAS float*)(lds + SQ_NG))[tid] = ng[tid];
    u32x4 rg[5];
#pragma unroll
    for (int k = 0; k < 5; ++k) { const int i = tid + 512 * k; if (i < NPC) rg[k] = *(const u32x4*)(gsrc + (size_t)i * 16); }
#pragma unroll
    for (int k = 0; k < 5; ++k) { const int i = tid + 512 * k; if (i < NPC) *(GLAS u32x4*)(lds + SQ_BLK0 + i * 16) = rg[k]; }
#pragma unroll
    for (int k = 0; k < 5; ++k) { const int i = tid + 512 * k; if (i < NPC) rg[k] = *(const u32x4*)(gsrc + OP_BLK_BYTES + (size_t)i * 16); }
    __syncthreads();
    f32x4 S[2][3];
#pragma unroll
    for (int mt = 0; mt < 2; ++mt)
#pragma unroll
        for (int nt = 0; nt < 3; ++nt) S[mt][nt] = (f32x4){0.f, 0.f, 0.f, 0.f};
#define GLA_EPILOGUE(nn) do { const int cc_ = (nn) & 1; const size_t mm_ = rowbase + (size_t)(nn) * 64; \
        _Pragma("unroll") for (int k_ = 0; k_ < 4; ++k_) { const int vec_ = (tid - 320) + 192 * k_, t_ = vec_ / 12, v_ = (vec_ % 12) * 8; \
            const u32x4 ov_ = *(GLAS u32x4*)(lds + SQ_OB + cc_ * SQ_OB_BYTES + t_ * 192 + v_ * 2); const u32x4 gv_ = *(const u32x4*)(P + (mm_ + t_) * NP + N_GG + h * 96 + v_); \
            const f32x4 n0_ = *(GLAS f32x4*)(lds + SQ_NG + v_ * 4), n1_ = *(GLAS f32x4*)(lds + SQ_NG + v_ * 4 + 16); u32x4 yo_; \
            _Pragma("unroll") for (int e_ = 0; e_ < 4; ++e_) { const float ga_ = __uint_as_float(gv_[e_] << 16), gb_ = __uint_as_float(gv_[e_] & 0xffff0000u); \
                const float na_ = (e_ < 2) ? n0_[2 * e_] : n1_[2 * e_ - 4], nb_ = (e_ < 2) ? n0_[2 * e_ + 1] : n1_[2 * e_ - 3]; \
                yo_[e_] = cvtpk(__uint_as_float(ov_[e_] << 16) * na_ * (ga_ / (1.0f + __expf(-ga_))), __uint_as_float(ov_[e_] & 0xffff0000u) * nb_ * (gb_ / (1.0f + __expf(-gb_)))); } \
            *(u32x4*)(Y + (mm_ + t_) * DM + h * 96 + v_) = yo_; } } while (0)
    for (int n = 0; n < SEQ / 64; ++n) {
        const int cur = n & 1, nxt = cur ^ 1; const size_t m0 = rowbase + (size_t)n * 64;
        const int BO = (cur ? SQ_BLK1 : SQ_BLK0) - OP_QE;
        if (n + 1 < SEQ / 64) { const int BN = (cur ? SQ_BLK0 : SQ_BLK1) - OP_QE;
#pragma unroll
            for (int k = 0; k < 5; ++k) { const int i = tid + 512 * k; if (i < NPC) *(GLAS u32x4*)(lds + OP_QE + BN + i * 16) = rg[k]; }
            if (n + 2 < SEQ / 64) {
#pragma unroll
                for (int k = 0; k < 5; ++k) { const int i = tid + 512 * k; if (i < NPC) rg[k] = *(const u32x4*)(gsrc + (size_t)(n + 2) * OP_BLK_BYTES + (size_t)i * 16); } } }
        if (wave < 2) {
            const int it = wave; bf16x8 qf[3];
#pragma unroll
            for (int ks = 0; ks < 3; ++ks) qf[ks] = *(GLAS bf16x8*)(lds + BO + OP_QE + (32 * it + r32) * 112 + (16 * ks + 8 * hi) * 2);
            f32x16 acc[3];
#pragma unroll
            for (int vt = 0; vt < 3; ++vt)
#pragma unroll
                for (int r = 0; r < 16; ++r) acc[vt][r] = 0.f;
#pragma unroll
            for (int jt = 0; jt < 2; ++jt) if (jt <= it) {
                f32x16 X;
#pragma unroll
                for (int r = 0; r < 16; ++r) X[r] = 0.f;
#pragma unroll
                for (int ks = 0; ks < 3; ++ks) { const bf16x8 kf = *(GLAS bf16x8*)(lds + BO + OP_KE + (32 * jt + r32) * 112 + (16 * ks + 8 * hi) * 2); X = __builtin_amdgcn_mfma_f32_32x32x16_bf16(kf, qf[ks], X, 0, 0, 0); }
                if (jt == it) {
#pragma unroll
                    for (int r = 0; r < 16; ++r) if (crow(r, hi) > r32) X[r] = 0.f; }
                u32x4 p0, p1;
#pragma unroll
                for (int k = 0; k < 4; ++k) { p0[k] = cvtpk(X[2 * k], X[2 * k + 1]); p1[k] = cvtpk(X[8 + 2 * k], X[8 + 2 * k + 1]); }
                const bf16x8 pa0 = __builtin_bit_cast(bf16x8, p0), pa1 = __builtin_bit_cast(bf16x8, p1);
#pragma unroll
                for (int vt = 0; vt < 3; ++vt)
#pragma unroll
                    for (int s = 0; s < 2; ++s) { const int vo = BO + OP_VT + (32 * vt + r32) * 144 + (32 * jt + 16 * s + 4 * hi) * 2;
                        const s16x4 lo = *(GLAS s16x4*)(lds + vo), hi4 = *(GLAS s16x4*)(lds + vo + 16);
                        const bf16x8 a2 = (bf16x8){lo[0], lo[1], lo[2], lo[3], hi4[0], hi4[1], hi4[2], hi4[3]};
                        acc[vt] = __builtin_amdgcn_mfma_f32_32x32x16_bf16(a2, s ? pa1 : pa0, acc[vt], 0, 0, 0); }
            }
#pragma unroll
            for (int vt = 0; vt < 3; ++vt)
#pragma unroll
                for (int ks = 0; ks < 3; ++ks) { const bf16x8 sf = *(GLAS bf16x8*)(lds + SQ_ST + cur * ST_BYTES + (32 * vt + r32) * 112 + (16 * ks + 8 * hi) * 2); acc[vt] = __builtin_amdgcn_mfma_f32_32x32x16_bf16(sf, qf[ks], acc[vt], 0, 0, 0); }
            float ss = 0.f;
#pragma unroll
            for (int vt = 0; vt < 3; ++vt)
#pragma unroll
                for (int r = 0; r < 16; ++r) ss += acc[vt][r] * acc[vt][r];
            ss += __builtin_bit_cast(float, __builtin_amdgcn_ds_bpermute((lane ^ 32) << 2, __builtin_bit_cast(int, ss)));
            const float rn = 1.0f / sqrtf(ss * (1.0f / 96.0f) + EPS);
            GLAS unsigned char* ob = lds + SQ_OB + cur * SQ_OB_BYTES + (32 * it + r32) * 192;
#pragma unroll
            for (int vt = 0; vt < 3; ++vt)
#pragma unroll
                for (int g = 0; g < 4; ++g) { const int v0 = 32 * vt + 8 * g + 4 * hi;
                    *(GLAS u32x2*)(ob + v0 * 2) = (u32x2){cvtpk(acc[vt][4 * g] * rn, acc[vt][4 * g + 1] * rn), cvtpk(acc[vt][4 * g + 2] * rn, acc[vt][4 * g + 3] * rn)}; }
        } else if (wave < 5) {
            const int sw = wave - 2;
#pragma unroll
            for (int mt = 0; mt < 2; ++mt)
#pragma unroll
                for (int nt = 0; nt < 3; ++nt) { const int d = 16 * nt + l15; const float dec = ((GLAS float*)(lds + BO + OP_DEC))[d]; f32x4 a = S[mt][nt] * dec;
#pragma unroll
                    for (int ks = 0; ks < 2; ++ks) { const bf16x8 va = *(GLAS bf16x8*)(lds + BO + OP_VT + (32 * sw + 16 * mt + l15) * 144 + (32 * ks + 8 * quad) * 2), kb = *(GLAS bf16x8*)(lds + BO + OP_KDT + d * 144 + (32 * ks + 8 * quad) * 2);
                        a = __builtin_amdgcn_mfma_f32_16x16x32_bf16(va, kb, a, 0, 0, 0); }
                    S[mt][nt] = a;
#pragma unroll
                    for (int jj = 0; jj < 4; jj += 2) { const unsigned pk = cvtpk(a[jj], a[jj + 1]);
                        *(GLAS unsigned short*)(lds + SQ_ST + nxt * ST_BYTES + ((32 * sw + 16 * mt + 4 * quad + jj) * 56 + d) * 2) = (unsigned short)(pk & 0xffffu);
                        *(GLAS unsigned short*)(lds + SQ_ST + nxt * ST_BYTES + ((32 * sw + 16 * mt + 4 * quad + jj + 1) * 56 + d) * 2) = (unsigned short)(pk >> 16); } }
        } else if (n > 0) {
            GLA_EPILOGUE(n - 1);
        }
        __syncthreads();
    }
    if (wave >= 5) { GLA_EPILOGUE(SEQ / 64 - 1); }
    __syncthreads();
}
#undef GLA_EPILOGUE
#undef GLA_PCOL
#undef GLA_PDST
#undef GLAS
}
namespace poolb {
typedef short bf16x8 __attribute__((ext_vector_type(8)));
typedef float f32x16 __attribute__((ext_vector_type(16)));
typedef unsigned u32x4 __attribute__((ext_vector_type(4)));
typedef unsigned u32x2 __attribute__((ext_vector_type(2)));
typedef float f32x2_t __attribute__((ext_vector_type(2))); typedef __bf16 bf16x2_t __attribute__((ext_vector_type(2)));
#define PLAS __attribute__((address_space(3)))
constexpr int US_PITCH = 528  , US = 0, US_BYTES = 79 * US_PITCH  , PS = 41728, PS_PITCH = 144  , PS_WAVE = 32 * PS_PITCH  ,
              WT = PS + 8 * PS_WAVE  , WT_PITCH = 144, WT_GROUP = 64 * WT_PITCH  ;
__device__ __forceinline__ unsigned cvtpk(float lo, float hi) { f32x2_t v = {lo, hi}; bf16x2_t b = __builtin_convertvector(v, bf16x2_t); return __builtin_bit_cast(unsigned, b); }
__device__ __forceinline__ void pool_phase(const unsigned short* P, unsigned short* Y, const float* pw, const float* pscale, unsigned char* ldsg, int wg, int G, int tid) {
    PLAS unsigned char* lds = (PLAS unsigned char*)ldsg;
    const int lane = tid & 63, wave = __builtin_amdgcn_readfirstlane(tid >> 6), r32 = lane & 31, hi = lane >> 5, g = wave & 3, th = wave >> 2;
    __syncthreads();
    for (int i = tid; i < 4 * 64 * 64; i += NTHR) { const int gg = i >> 12, c = (i >> 6) & 63, d = i & 63; const float v = pw[i] * pscale[gg * 64 + d];
        *(PLAS unsigned short*)(lds + WT + gg * WT_GROUP + d * WT_PITCH + c * 2) = (unsigned short)(cvtpk(v, 0.f) & 0xffffu); }
    const int w = 2 << g;
    for (int tile = wg; tile < M / 64; tile += G) {
        const int m0 = tile * 64, t0 = m0 % SEQ;
        __syncthreads();
        for (int i = tid; i < 79 * 32; i += NTHR) { const int row = i >> 5, pc = i & 31; u32x4 v = {0u, 0u, 0u, 0u};
            if (t0 + row - 15 >= 0) v = *(const u32x4*)(P + (size_t)(m0 - 15 + row) * NP + N_PU + pc * 8);
            *(PLAS u32x4*)(lds + US + row * US_PITCH + pc * 16) = v; }
        __syncthreads();
        { float sum[32];
#pragma unroll
            for (int c = 0; c < 32; ++c) sum[c] = 0.f;
            const int tl = 32 * th + r32; const PLAS unsigned char* base = lds + US + (tl + 15) * US_PITCH + (g * 64 + 32 * hi) * 2;
            for (int j = 0; j < w; ++j) {
#pragma unroll
                for (int q4 = 0; q4 < 4; ++q4) { const u32x4 v = *(const PLAS u32x4*)(base - j * US_PITCH + q4 * 16);
#pragma unroll
                    for (int k = 0; k < 4; ++k) { const float lo = __uint_as_float(v[k] << 16), hh = __uint_as_float(v[k] & 0xffff0000u); sum[8 * q4 + 2 * k] += lo; sum[8 * q4 + 2 * k + 1] += hh; } } }
            const int pos = t0 + tl; const float inv = 1.0f / (float)((pos + 1 < w) ? pos + 1 : w);
            PLAS unsigned char* pd = lds + PS + wave * PS_WAVE + r32 * PS_PITCH + 32 * hi * 2;
#pragma unroll
            for (int q4 = 0; q4 < 4; ++q4) { u32x4 o; const u32x4 sv = *(const PLAS u32x4*)(base + q4 * 16);
#pragma unroll
                for (int k = 0; k < 4; ++k) o[k] = cvtpk(sum[8 * q4 + 2 * k] * inv - __uint_as_float(sv[k] << 16), sum[8 * q4 + 2 * k + 1] * inv - __uint_as_float(sv[k] & 0xffff0000u));
                *(PLAS u32x4*)(pd + q4 * 16) = o; } }
        asm volatile("s_waitcnt lgkmcnt(0)" ::: "memory");
        f32x16 acc[2];
#pragma unroll
        for (int dt = 0; dt < 2; ++dt) {
#pragma unroll
            for (int r = 0; r < 16; ++r) acc[dt][r] = 0.f;
#pragma unroll
            for (int ks = 0; ks < 4; ++ks) { const bf16x8 a = *(const PLAS bf16x8*)(lds + WT + g * WT_GROUP + (32 * dt + r32) * WT_PITCH + (16 * ks + 8 * hi) * 2), bq = *(const PLAS bf16x8*)(lds + PS + wave * PS_WAVE + r32 * PS_PITCH + (16 * ks + 8 * hi) * 2);
                acc[dt] = __builtin_amdgcn_mfma_f32_32x32x16_bf16(a, bq, acc[dt], 0, 0, 0); } }
        { const size_t m = (size_t)m0 + 32 * th + r32; const unsigned short* gp = P + m * NP + N_PG + g * 64; unsigned short* yp = Y + m * DM + 768 + g * 64;
#pragma unroll
            for (int dt = 0; dt < 2; ++dt)
#pragma unroll
                for (int g4 = 0; g4 < 4; ++g4) { const int d0 = 32 * dt + 8 * g4 + 4 * hi; const u32x2 gw = *(const u32x2*)(gp + d0);
                    const float g0 = __uint_as_float(gw[0] << 16), g1 = __uint_as_float(gw[0] & 0xffff0000u), g2 = __uint_as_float(gw[1] << 16), g3 = __uint_as_float(gw[1] & 0xffff0000u);
                    const float y0 = acc[dt][4 * g4] * (g0 / (1.0f + __expf(-g0))), y1 = acc[dt][4 * g4 + 1] * (g1 / (1.0f + __expf(-g1))), y2 = acc[dt][4 * g4 + 2] * (g2 / (1.0f + __expf(-g2))), y3 = acc[dt][4 * g4 + 3] * (g3 / (1.0f + __expf(-g3)));
                    *(u32x2*)(yp + d0) = (u32x2){cvtpk(y0, y1), cvtpk(y2, y3)}; } }
    }
    __syncthreads();
}
#undef PLAS
}
struct Args {
    const float* x; const float* norm_g; const float* w_in; const float* gate_w2; const float* gate_b; const float* gla_norm_g;
    const float* rel_bias; const float* pool_w; const float* pool_scale; const float* w_out; const float* final_g;
    float* out; unsigned char* ws;
    int l_lo, l_hi, ph_lo, ph_hi, single, pad;
};

__device__ __forceinline__ int src_col(int n, float& sc) {
    sc = 1.f;
    if (n < 192) { sc = 0.14433756729740643f; return n; }
    if (n < 768) return n;
    if (n < 1152) return 784 + (n - 768);
    if (n < 1536) { sc = 0.125f * LOG2E; return 1168 + (n - 1152); }
    if (n < 1920) return 1552 + (n - 1536);
    if (n < 2304) return 1936 + (n - 1920);
    if (n < 2688) return 2320 + (n - 2304);
    if (n < 2944) return 2868 + (n - 2688);
    if (n < 3200) return 3124 + (n - 2944);
    if (n < 3328) { sc = 0.17677669529663687f; return 2704 + (n - 3200); }
    if (n < 3360) return 2832 + (n - 3328);
    if (n < 3376) return 768 + (n - 3360);
    if (n < 3380) { sc = 0.5f; return 2864 + (n - 3376); }
    return -1;
}
__device__ __forceinline__ void prologue_phase(const Args& a, int wg, int G, int tid) {
    bf16* WIN = (bf16*)(a.ws + WS_WIN); bf16* WOUT = (bf16*)(a.ws + WS_WOUT);
    const long gt = (long)wg * NTHR + tid, gs = (long)G * NTHR;
    for (long i = gt; i < 4L * NP * 128; i += gs) {
        const int n = (int)(i % NP), k8 = (int)((i / NP) % 128), l = (int)(i / ((long)NP * 128));
        float sc; const int c = src_col(n, sc);
        v4u o = {0u, 0u, 0u, 0u};
        if (c >= 0) { const float* w = a.w_in + ((size_t)l * 1024 + k8 * 8) * IN_COLS + c; float v[8];
#pragma unroll
            for (int j = 0; j < 8; ++j) v[j] = w[(size_t)j * IN_COLS] * sc * a.norm_g[l * 1024 + k8 * 8 + j];
            o.x = pk2(v[0], v[1]); o.y = pk2(v[2], v[3]); o.z = pk2(v[4], v[5]); o.w = pk2(v[6], v[7]); }
        *(v4u*)(WIN + ((size_t)l * NP + n) * 1024 + k8 * 8) = o;
    }
    for (long i = gt; i < 4L * 1024 * 128; i += gs) {
        const int n = (int)(i % 1024), k8 = (int)((i / 1024) % 128), l = (int)(i / (1024L * 128));
        const float* w = a.w_out + ((size_t)l * 1024 + k8 * 8) * 1024 + n; float v[8];
#pragma unroll
        for (int j = 0; j < 8; ++j) v[j] = w[(size_t)j * 1024];
        v4u o; o.x = pk2(v[0], v[1]); o.y = pk2(v[2], v[3]); o.z = pk2(v[4], v[5]); o.w = pk2(v[6], v[7]);
        *(v4u*)(WOUT + ((size_t)l * 1024 + n) * 1024 + k8 * 8) = o;
    }
    { bf16* XA = (bf16*)(a.ws + WS_XA); float* RS = (float*)(a.ws + WS_RS); const int lane = tid & 63;
        for (int m = wg * NWAVES + (tid >> 6); m < M; m += G * NWAVES) { const f32x4* xr = (const f32x4*)(a.x + (size_t)m * DM) + lane; v2u* o = (v2u*)(XA + (size_t)m * DM) + lane; float s = 0.f;
#pragma unroll
            for (int j = 0; j < 4; ++j) { const f32x4 v = xr[64 * j]; v2u w; w.x = pk2(v.x, v.y); w.y = pk2(v.z, v.w); o[64 * j] = w; s += (bflo(w.x) * bflo(w.x) + bfhi(w.x) * bfhi(w.x)) + (bflo(w.y) * bflo(w.y) + bfhi(w.y) * bfhi(w.y)); }
            s = wave_sum(s, lane); if (lane < 16) RS[(size_t)m * 16 + lane] = (lane == 0) ? s : 0.f; } }
}
__device__ __forceinline__ void norm_phase(const float* src, const float* g, bf16* dst, int gw, int NGW, int lane) {
    for (int m = gw; m < M; m += NGW) {
        const f32x4* xr = (const f32x4*)(src + (size_t)m * DM) + lane; f32x4 v[4]; float s = 0.f;
#pragma unroll
        for (int j = 0; j < 4; ++j) { v[j] = xr[64 * j]; s += (v[j].x * v[j].x + v[j].y * v[j].y) + (v[j].z * v[j].z + v[j].w * v[j].w); }
        const float r = 1.0f / sqrtf(wave_sum(s, lane) * (1.f / DM) + EPS);
        const f32x4* gr = (const f32x4*)g + lane; v2u* o = (v2u*)(dst + (size_t)m * DM) + lane;
#pragma unroll
        for (int j = 0; j < 4; ++j) { const f32x4 gv = gr[64 * j]; v2u w; w.x = pk2(v[j].x * r * gv.x, v[j].y * r * gv.y); w.y = pk2(v[j].z * r * gv.z, v[j].w * r * gv.w); o[64 * j] = w; }
    }
}
__device__ __forceinline__ void final_norm_phase(const bf16* xa, float* out, const float* g, const float* RS, int gw, int NGW, int lane) {
    for (int m = gw; m < M; m += NGW) {
        const v2u* xr = (const v2u*)(xa + (size_t)m * DM) + lane; f32x4* orow = (f32x4*)(out + (size_t)m * DM) + lane;
        const f32x4* rs = (const f32x4*)(RS + (size_t)m * 16); const f32x4 s0 = rs[0], s1 = rs[1], s2 = rs[2], s3 = rs[3];
        const float ss = (((s0[0] + s0[1]) + (s0[2] + s0[3])) + ((s1[0] + s1[1]) + (s1[2] + s1[3]))) + (((s2[0] + s2[1]) + (s2[2] + s2[3])) + ((s3[0] + s3[1]) + (s3[2] + s3[3])));
        const float r = 1.0f / sqrtf(ss * (1.f / DM) + EPS);
        const f32x4* gr = (const f32x4*)g + lane;
#pragma unroll
        for (int j = 0; j < 4; ++j) { const f32x4 gv = gr[64 * j]; const v2u w = xr[64 * j]; orow[64 * j] = (f32x4){bflo(w.x) * r * gv.x, bfhi(w.x) * r * gv.y, bflo(w.y) * r * gv.z, bfhi(w.y) * r * gv.w}; }
    }
}
__device__ __forceinline__ void rowscale_phase(const float* RS, float* RSC, int wg, int G, int tid) {
    for (int m = wg * NTHR + tid; m < M; m += G * NTHR) { const f32x4* rs = (const f32x4*)(RS + (size_t)m * 16); const f32x4 s0 = rs[0], s1 = rs[1], s2 = rs[2], s3 = rs[3];
        const float ss = (((s0[0] + s0[1]) + (s0[2] + s0[3])) + ((s1[0] + s1[1]) + (s1[2] + s1[3]))) + (((s2[0] + s2[1]) + (s2[2] + s2[3])) + ((s3[0] + s3[1]) + (s3[2] + s3[3])));
        RSC[m] = 1.0f / sqrtf(ss * (1.0f / 1024.0f) + EPS); }
}
__device__ __forceinline__ void pool_phase(const Args& a, int l, unsigned char* lds, int wg, int G, int tid) {
    float* wsm = (float*)lds; float* us = (float*)(lds + 16384); float* ps = (float*)(lds + 32768);
    const bf16* P = (const bf16*)(a.ws + WS_P); bf16* Y = (bf16*)(a.ws + WS_XB);
    for (int g = 0; g < 4; ++g) {
        __syncthreads();
        const float* pw = a.pool_w + (size_t)(l * 4 + g) * 4096;
        for (int i = tid; i < 4096; i += NTHR) wsm[i] = pw[i];
        const int w = 2 << g;
        for (int tile = wg; tile < M / 32; tile += G) {
            __syncthreads();
            const int m0 = tile * 32, t0 = m0 % SEQ;
            for (int i = tid; i < 47 * 64; i += NTHR) { const int r = i >> 6, c = i & 63; float v = 0.f;
                if (t0 + r - 15 >= 0) v = bf2f(P[(size_t)(m0 - 15 + r) * NP + N_PU + g * 64 + c]);
                us[i] = v; }
            __syncthreads();
            { const int t = tid >> 4, c4 = (tid & 15) * 4, pos = t0 + t; const int cnt = (pos + 1 < w) ? pos + 1 : w; const float inv = 1.0f / (float)cnt;
#pragma unroll
                for (int k = 0; k < 4; ++k) { const int c = c4 + k; float s = 0.f; for (int j = 0; j < w; ++j) s += us[(t + 15 - j) * 64 + c]; ps[t * 64 + c] = s * inv - us[(t + 15) * 64 + c]; } }
            __syncthreads();
            { const int t = tid >> 4, d4 = (tid & 15) * 4; float a0 = 0.f, a1 = 0.f, a2 = 0.f, a3 = 0.f;
                for (int c = 0; c < 64; ++c) { const float p = ps[t * 64 + c]; const f32x4 wv = *(const f32x4*)&wsm[c * 64 + d4]; a0 += p * wv.x; a1 += p * wv.y; a2 += p * wv.z; a3 += p * wv.w; }
                const size_t m = (size_t)m0 + t; const v2u gw2 = *(const v2u*)(P + m * NP + N_PG + g * 64 + d4);
                const float* scl = a.pool_scale + l * 256 + g * 64 + d4;
                const float y0 = a0 * scl[0] * silu_f(bflo(gw2.x)), y1 = a1 * scl[1] * silu_f(bfhi(gw2.x)), y2 = a2 * scl[2] * silu_f(bflo(gw2.y)), y3 = a3 * scl[3] * silu_f(bfhi(gw2.y));
                v2u o; o.x = pk2(y0, y1); o.y = pk2(y2, y3); *(v2u*)(Y + m * DM + 768 + g * 64 + d4) = o; }
        }
    }
    __syncthreads();
}
__device__ __forceinline__ void gla_rec_phase(const Args& a, int l, unsigned char* lds, int unit, int tid) {
    const int b = unit >> 2, h = unit & 3;
    float* qs = (float*)lds; float* ks = (float*)(lds + 12288); float* es = (float*)(lds + 24576); float* vs = (float*)(lds + 36864); float* os = (float*)(lds + 61440);
    float* w2s = (float*)(lds + 86016); float* bs = (float*)(lds + 89088); float* gzs = (float*)(lds + 89280);
    const bf16* P = (const bf16*)(a.ws + WS_P); bf16* Y = (bf16*)(a.ws + WS_XB);
    __syncthreads();
    for (int i = tid; i < 16 * 48; i += NTHR) { const int r = i / 48, d = i % 48; w2s[i] = a.gate_w2[(size_t)(l * 16 + r) * 192 + h * 48 + d]; }
    if (tid < 48) bs[tid] = a.gate_b[l * 192 + h * 48 + tid];
    float S[48];
#pragma unroll
    for (int d = 0; d < 48; ++d) S[d] = 0.f;
    for (int blk = 0; blk < SEQ / 64; ++blk) {
        const size_t m0 = (size_t)b * SEQ + (size_t)blk * 64;
        __syncthreads();
        for (int i = tid; i < 64 * 48; i += NTHR) { const int t = i / 48, d = i % 48; const bf16* row = P + (m0 + t) * NP; qs[i] = bf2f(row[N_GQ + h * 48 + d]); ks[i] = bf2f(row[N_GK + h * 48 + d]); }
        for (int i = tid; i < 64 * 96; i += NTHR) { const int t = i / 96, v = i % 96; vs[i] = bf2f(P[(m0 + t) * NP + N_GV + h * 96 + v]); }
        for (int i = tid; i < 64 * 16; i += NTHR) { const int t = i >> 4, r = i & 15; gzs[i] = bf2f(P[(m0 + t) * NP + N_GZ + r]); }
        __syncthreads();
        for (int i = tid; i < 64 * 48; i += NTHR) { const int t = i / 48, d = i % 48; float z = bs[d];
#pragma unroll
            for (int r = 0; r < 16; ++r) z += gzs[t * 16 + r] * w2s[r * 48 + d];
            const float ls = fminf(z, 0.f) - log1pf(__expf(-fabsf(z)));
            es[i] = __expf(ls * (1.0f / 16.0f)); }
        __syncthreads();
        if (tid < 96) { const int v = tid;
            for (int t = 0; t < 64; ++t) { const float vv = vs[t * 96 + v]; float o = 0.f;
#pragma unroll
                for (int d = 0; d < 48; ++d) { S[d] = es[t * 48 + d] * S[d] + ks[t * 48 + d] * vv; o += qs[t * 48 + d] * S[d]; }
                os[t * 96 + v] = o; } }
        __syncthreads();
        { const int t = tid >> 3, part = tid & 7; float ov[12]; float ss = 0.f;
#pragma unroll
            for (int k = 0; k < 12; ++k) { ov[k] = os[t * 96 + part * 12 + k]; ss += ov[k] * ov[k]; }
            { const int ln = tid & 63; ss += shx(ss, 1, ln); ss += shx(ss, 2, ln); ss += shx(ss, 4, ln); }
            const float r = 1.0f / sqrtf(ss * (1.0f / 96.0f) + EPS);
            const size_t m = m0 + t; const bf16* gp = P + m * NP + N_GG + h * 96 + part * 12; const float* ng = a.gla_norm_g + l * 96 + part * 12;
            unsigned* yo = (unsigned*)(Y + m * DM + h * 96 + part * 12);
#pragma unroll
            for (int k = 0; k < 12; k += 2) { const float y0 = ov[k] * r * ng[k] * silu_f(bf2f(gp[k])), y1 = ov[k + 1] * r * ng[k + 1] * silu_f(bf2f(gp[k + 1])); yo[k >> 1] = pk2(y0, y1); } }
    }
    __syncthreads();
}
template <bool BITS_ONLY> __device__ __forceinline__ void dsa_slow_query(const Args& a, unsigned char* lds, int b, int t, int tid) {
    const int lane = tid & 63, wave = tid >> 6;
    unsigned* sc = (unsigned*)lds; int* hist = (int*)(lds + 32768); int* sel = (int*)(lds + 33792); float* qf = (float*)(lds + 34816); float* wq = (float*)(lds + 35328);
    int* misc = (int*)(lds + 35344); float* qh = (float*)(lds + 35456); float* lg = (float*)(lds + 36992); float* inv = (float*)(lds + 43136);
    const bf16* P = (const bf16*)(a.ws + WS_P); bf16* Y = (bf16*)(a.ws + WS_XB);
    {
        const size_t m = (size_t)b * SEQ + t; const int N = t + 1;
        __syncthreads();
        if (tid < 128) qf[tid] = bf2f(P[m * NP + N_QI + tid]);
        if (tid >= 128 && tid < 132) wq[tid - 128] = bf2f(P[m * NP + N_WI + tid - 128]);
        for (int i = tid; i < 384; i += NTHR) qh[i] = bf2f(P[m * NP + N_DQ + i]);
        __syncthreads();
        for (int s = tid; s < N; s += NTHR) {
            const v4u* kr = (const v4u*)(P + ((size_t)b * SEQ + s) * NP + N_KI); float kf[32];
#pragma unroll
            for (int c = 0; c < 4; ++c) { const v4u w = kr[c]; kf[8 * c] = bflo(w.x); kf[8 * c + 1] = bfhi(w.x); kf[8 * c + 2] = bflo(w.y); kf[8 * c + 3] = bfhi(w.y); kf[8 * c + 4] = bflo(w.z); kf[8 * c + 5] = bfhi(w.z); kf[8 * c + 6] = bflo(w.w); kf[8 * c + 7] = bfhi(w.w); }
            float score = 0.f;
#pragma unroll
            for (int hh = 0; hh < 4; ++hh) { float dot = 0.f;
#pragma unroll
                for (int d = 0; d < 32; ++d) dot += qf[hh * 32 + d] * kf[d];
                score += wq[hh] * fmaxf(dot, 0.f); }
            const unsigned u = __builtin_bit_cast(unsigned, score);
            sc[s] = (u & 0x80000000u) ? ~u : (u | 0x80000000u);
        }
        __syncthreads();
        int L;
        if (N <= 256) { if (tid < N) sel[tid] = tid; L = N; }
        else {
            unsigned prefix = 0u; int kk = 256;
            for (int pass = 0; pass < 4; ++pass) {
                const int shift = 24 - 8 * pass;
                if (tid < 256) hist[tid] = 0;
                __syncthreads();
                for (int s = tid; s < N; s += NTHR) { const unsigned key = sc[s]; const bool match = (pass == 0) ? true : ((key >> ((shift + 8) & 31)) == prefix); if (match) atomicAdd(&hist[(key >> shift) & 255u], 1); }
                __syncthreads();
                if (wave == 0) {
                    const int c0 = hist[4 * lane], c1 = hist[4 * lane + 1], c2 = hist[4 * lane + 2], c3 = hist[4 * lane + 3]; const int tot = c0 + c1 + c2 + c3;
                    int incl = tot;
#pragma unroll
                    for (int o = 1; o < 64; o <<= 1) { const int tt = shdn(incl, o, lane); if (lane + o < 64) incl += tt; }
                    const int excl = incl - tot;
                    if (excl < kk && kk <= incl) { int above = excl, D;
                        if (above + c3 >= kk) D = 4 * lane + 3;
                        else { above += c3; if (above + c2 >= kk) D = 4 * lane + 2; else { above += c2; if (above + c1 >= kk) D = 4 * lane + 1; else { above += c1; D = 4 * lane; } } }
                        misc[1] = D; misc[2] = above; }
                }
                __syncthreads();
                prefix = (prefix << 8) | (unsigned)misc[1]; kk -= misc[2];
            }
            const unsigned tau = prefix;
            const int seg = (((N + 7) >> 3) + 63) & ~63; const int s_lo = wave * seg, s_hi = (s_lo + seg < N) ? s_lo + seg : N;
            { int cg = 0, ce = 0;
                for (int base = s_lo; base < s_hi; base += 64) { const int s = base + lane; const bool in = s < s_hi; const unsigned key = in ? sc[s] : 0u;
                    cg += __popcll(__ballot(in && key > tau)); ce += __popcll(__ballot(in && key == tau)); }
                if (lane == 0) { misc[4 + wave] = cg; misc[12 + wave] = ce; } }
            __syncthreads();
            { int bg = 0, be = 0;
                for (int w2 = 0; w2 < 8; ++w2) if (w2 < wave) { bg += misc[4 + w2]; be += misc[12 + w2]; }
                int run_sel = bg + (be < kk ? be : kk), run_eq = be;
                for (int base = s_lo; base < s_hi; base += 64) { const int s = base + lane; const bool in = s < s_hi; const unsigned key = in ? sc[s] : 0u;
                    const bool gt = in && key > tau, eq = in && key == tau; const unsigned long long me = __ballot(eq); const unsigned long long lt = (1ull << lane) - 1ull;
                    const bool take = gt || (eq && (run_eq + __popcll(me & lt) < kk)); const unsigned long long mt = __ballot(take);
                    if (take) sel[run_sel + __popcll(mt & lt)] = s;
                    run_sel += __popcll(mt); run_eq += __popcll(me); } }
            L = 256;
        }
        __syncthreads();
        if constexpr (BITS_ONLY) {
            unsigned* bm = (unsigned*)lg; unsigned* MK = (unsigned*)(a.ws + WS_MASK);
            if (tid < 256) bm[tid] = 0u;
            __syncthreads();
            if (tid < L) { const int s = sel[tid]; const int kt = s >> 6, kap = s & 63, half = kap >> 5, k5 = kap & 31, hi = (k5 >> 2) & 1, r = (k5 & 3) + 4 * (k5 >> 3);
                atomicOr(&bm[kt * 2 + hi], 1u << (r + 16 * half)); }
            __syncthreads();
            const int ntw = ((t >> 8) + 1) * 8;
            if (tid < ntw) { const int kt = tid >> 1, hi = tid & 1; MK[((size_t)(b * 256 + (t >> 5)) * 128 + kt) * 64 + (t & 31) + 32 * hi] = bm[tid]; }
            __syncthreads();
            return;
        }
        { const int j = tid >> 1, h0 = (tid & 1) * 3;
            if (j < L) { const int s = sel[j]; const size_t srow = (size_t)b * SEQ + s; const int bk = t5_bucket(t - s);
#pragma unroll
                for (int hh = 0; hh < 3; ++hh) { const int h = h0 + hh; const v4u* kr = (const v4u*)(P + srow * NP + N_DK + h * 64); const float* q = qh + h * 64; float dot = 0.f;
#pragma unroll
                    for (int c = 0; c < 8; ++c) { const v4u w = kr[c]; dot += q[8 * c] * bflo(w.x) + q[8 * c + 1] * bfhi(w.x) + q[8 * c + 2] * bflo(w.y) + q[8 * c + 3] * bfhi(w.y) + q[8 * c + 4] * bflo(w.z) + q[8 * c + 5] * bfhi(w.z) + q[8 * c + 6] * bflo(w.w) + q[8 * c + 7] * bfhi(w.w); }
                    lg[h * 256 + j] = dot + a.rel_bias[bk * 6 + h] * LOG2E; } }
            else {
#pragma unroll
                for (int hh = 0; hh < 3; ++hh) lg[(h0 + hh) * 256 + j] = -INFINITY; } }
        __syncthreads();
        if (wave < 6) { float* row = lg + wave * 256; float v0 = row[lane], v1 = row[lane + 64], v2 = row[lane + 128], v3 = row[lane + 192];
            float mx = fmaxf(fmaxf(v0, v1), fmaxf(v2, v3));
#pragma unroll
            for (int o = 1; o < 64; o <<= 1) mx = fmaxf(mx, shx(mx, o, lane));
            v0 = exp2f(v0 - mx); v1 = exp2f(v1 - mx); v2 = exp2f(v2 - mx); v3 = exp2f(v3 - mx);
            const float sm = wave_sum((v0 + v1) + (v2 + v3), lane);
            row[lane] = v0; row[lane + 64] = v1; row[lane + 128] = v2; row[lane + 192] = v3;
            if (lane == 0) inv[wave] = 1.0f / sm; }
        __syncthreads();
        if (tid < 384) { const int h = tid >> 6, d = tid & 63; float acc = 0.f; const bf16* vb = P + (size_t)b * SEQ * NP + N_DV + h * 64 + d;
            for (int j = 0; j < L; ++j) acc += lg[h * 256 + j] * bf2f(vb[(size_t)sel[j] * NP]);
            const float o = acc * inv[h]; const float gate = bf2f(P[m * NP + N_DG + h * 64 + d]);
            Y[m * DM + 384 + h * 64 + d] = (bf16)f2bf(o * silu_f(gate)); }
    }
    __syncthreads();
}
template <bool BITS_ONLY> __device__ __forceinline__ void dsa_slow_phase(const Args& a, int l, unsigned char* lds, int wg, int G, int tid) {
    for (int qi = wg; qi < M; qi += G) { asm volatile("" : "+v"(tid)); dsa_slow_query<BITS_ONLY>(a, lds, qi & 7, qi >> 3, tid); }
}
__device__ __forceinline__ void index_phase(const Args& a, unsigned char* lds, unsigned* qctr, volatile LAS unsigned* MISC, int tid) {
    const unsigned short* P = (const unsigned short*)(a.ws + WS_P); unsigned* MK = (unsigned*)(a.ws + WS_MASK);
    __syncthreads();
    if (tid <= 256) ((float*)(lds + idxb::L_XT))[tid] = tid < 256 ? idxb::xthr(tid) : __builtin_inff();
    int bq = blockIdx.x & 7, tries = 0;
    for (;;) {
        asm volatile("" : "+v"(tid));
        __syncthreads();
        if (tid == 0) MISC[17] = __hip_atomic_fetch_add(qctr + 64 * bq, 1u, __ATOMIC_RELAXED, __HIP_MEMORY_SCOPE_AGENT);
        __syncthreads();
        const int k = (int)MISC[17];
        if (k >= 256) { if (++tries == 8) break; bq = (bq + 1) & 7; continue; }
        const int b = bq, qt = 255 - k;
        idxb::index_unit(P, (const unsigned short*)(a.ws + WS_KC), MK, (unsigned*)(a.ws + WS_ZW) + (size_t)blockIdx.x * 128 * 64, lds, b, qt, tid);
        const int* par = (const int*)(lds + idxb::L_PAR);
        for (int q = 0; q < 32; ++q) if (par[idxb::P_MODE * 32 + q] == 3) dsa_slow_query<true>(a, lds, b, qt * 32 + q, tid);
    }
}
#ifndef REP_POOL
#define REP_POOL 1
#endif
#ifndef ATT_PRIO
#define ATT_PRIO 0
#endif
#ifndef REP_IDX
#define REP_IDX 1
#endif
#ifndef REP_GLA
#define REP_GLA 1
#endif
#ifndef REP_ATT
#define REP_ATT 1
#endif
#ifndef REP_PREP
#define REP_PREP 1
#endif
#ifndef REP_PRO
#define REP_PRO 1
#endif
#ifndef REP_NORM
#define REP_NORM 1
#endif
#ifndef REP_ALL
#define REP_ALL 1
#endif
#ifndef REP_BAR
#define REP_BAR 1
#endif
#ifndef REP_OUT
#define REP_OUT 1
#endif
#ifndef REP_INP
#define REP_INP 1
#endif
#ifndef GLA_MODE
#define GLA_MODE 1
#endif
#ifndef DSA_MODE
#define DSA_MODE 2
#endif
#ifndef MK_SINGLE
#define MK_SINGLE 1
#endif
__global__ void __launch_bounds__(NTHR, 2) fwd(Args a) {
    extern __shared__ __attribute__((aligned(16))) unsigned char lds[];
    int tid = threadIdx.x, lane = tid & 63, wave = __builtin_amdgcn_readfirstlane(tid >> 6);
    int G = gridDim.x, wg = blockIdx.x;
    const int wave0 = __builtin_amdgcn_readfirstlane(tid >> 6);
#define LAUNDER() do { { int wv_ = wave0; asm volatile("" : "+s"(wv_)); unsigned on_ = ~0u; asm volatile("" : "+s"(on_)); tid = wv_ * 64 + (int)__builtin_amdgcn_mbcnt_hi(on_, __builtin_amdgcn_mbcnt_lo(on_, 0u)); asm volatile("" : "+v"(tid)); } wg = blockIdx.x; G = gridDim.x; asm volatile("" : "+s"(wg), "+s"(G));     \
    lane = tid & 63; wave = __builtin_amdgcn_readfirstlane(tid >> 6); gw = wg * NWAVES + wave; NGW = G * NWAVES; } while (0)
    volatile LAS unsigned* MISC = (volatile LAS unsigned*)((LAS unsigned char*)lds + MISC_OFF);
    for (int u = tid; u < (LDS_BYTES - LDSCTL_OFF) / 4; u += NTHR) ((LAS unsigned*)((LAS unsigned char*)lds + LDSCTL_OFF))[u] = 0u;
    __syncthreads();
    XcdBarrier bar; bar.bar = (unsigned*)(a.ws + WS_CTL) + CW_BAR; bar.x = 0; bar.st = nullptr;
    const bool one = a.single != 0;
    if (one) bar = xcd_barrier_post((unsigned*)(a.ws + WS_CTL) + CW_BAR, MISC + 8);
#define IN(k) (a.ph_lo <= (k) && (k) < a.ph_hi)
#define SEAM() do { if (one) { unsigned* bp_ = (unsigned*)(a.ws + WS_CTL) + CW_BAR; asm volatile("" : "+s"(bp_)); XcdBarrier bb_; bb_.bar = bp_; bb_.x = bar.x; bb_.st = bar.st; xcd_barrier(bb_); if (REP_BAR == 2) xcd_barrier(bb_); } } while (0)
    int gw = wg * NWAVES + wave, NGW = G * NWAVES;
    bf16* XB = (bf16*)(a.ws + WS_XB); bf16* PB = (bf16*)(a.ws + WS_P);
    for (int rpw = 0; rpw < REP_ALL; ++rpw) {
    LAUNDER();
    if (IN(0)) { for (int rp = 0; rp < REP_PRO; ++rp) prologue_phase(a, wg, G, tid); SEAM(); }
    for (int l = a.l_lo; l < a.l_hi; ++l) {
        LAUNDER();
        if (IN(1)) { rowscale_phase((const float*)(a.ws + WS_RS), (float*)(a.ws + WS_RSC), wg, G, tid); SEAM(); }
        LAUNDER();
        if (IN(2)) {
            pg8::Gemm g{(const bf16*)(a.ws + WS_XA), (const bf16*)(a.ws + WS_WIN) + (size_t)l * NP * 1024, M, NP, DM}; pg8::StaticOrder S; S.init(M, NP, G, wg);
            pg8::EpiP E{PB, NP, (const float*)(a.ws + WS_RSC), (pg8::bf16_t*)(a.ws + WS_KC)};
            pg8::gemm_phase<pg8::EpiP, pg8::StaticOrder, true, true>((PG8_LAS unsigned char*)lds, g, S, E, tid);
#if REP_INP == 2
            asm volatile("" : "+v"(tid)); __syncthreads(); pg8::gemm_phase<pg8::EpiP, pg8::StaticOrder, true, true>((PG8_LAS unsigned char*)lds, g, S, E, tid);
#endif
            SEAM();
        }
        LAUNDER();
        if (IN(3)) {
#if GLA_MODE == 0
            if (wg < 32) gla_rec_phase(a, l, lds, wg, tid);
#endif
            for (int rp = 0; rp < REP_POOL; ++rp) { asm volatile("" : "+v"(tid)); poolb::pool_phase(PB, XB, a.pool_w + (size_t)l * 4 * 4096, a.pool_scale + l * 256, lds, wg, G, tid); }
#if GLA_MODE == 1
            glab::gla_prep_loop(PB, a.ws + WS_GOP, a.gate_w2 + (size_t)l * 16 * 192, a.gate_b + l * 192, lds, wg, G, tid);
#if REP_PREP == 2
            __syncthreads(); asm volatile("" : "+v"(tid), "+s"(wg));
            for (int item = wg; item < BATCH * 4 * 128; item += G) { asm volatile("" : "+v"(tid)); glab::gla_prep_item(PB, a.ws + WS_GOP, a.gate_w2 + (size_t)l * 16 * 192, a.gate_b + l * 192, lds, item, tid); }
#endif
            __syncthreads();
#endif
#if DSA_MODE == 0
            dsa_slow_phase<false>(a, l, lds, wg, G, tid);
#elif DSA_MODE == 1
            dsa_slow_phase<true>(a, l, lds, wg, G, tid);
#else
            for (int rp = 0; rp < REP_IDX; ++rp) { asm volatile("" : "+v"(tid)); index_phase(a, lds, (unsigned*)(a.ws + WS_CTL) + CW_QUEUE + 64 * (32 + 8 * (l + 4 * rp + 8 * rpw)), MISC, tid); }
#endif
            SEAM();
        }
        LAUNDER();
        if (IN(4)) {
#if DSA_MODE >= 1
            { float* dl = (float*)(lds + 86016);
                for (int i = tid; i < 1032; i += NTHR) { const int rel = i >> 3, h = i & 7; dl[i] = (h < 6 && rel < 128) ? (a.rel_bias[(int)T5B[rel] * 6 + h] - a.rel_bias[31 * 6 + h]) * LOG2E : 0.f; } for (int i = tid; i < 512; i += NTHR) { const unsigned nb = ((unsigned)(i >> 1) >> (4 * (i & 1))) & 15u; ((unsigned*)(lds + attn_body::LDS_TAB))[i] = (nb & 1u ? 0xffu : 0u) | (nb & 2u ? 0xff00u : 0u) | (nb & 4u ? 0xff0000u : 0u) | (nb & 8u ? 0xff000000u : 0u); }
                __syncthreads();
                const attn_body::AttnTensors AT{(const attn_body::bf16*)(PB + N_DQ), (const attn_body::bf16*)(PB + N_DK), (const attn_body::bf16*)(PB + N_DV), (attn_body::bf16*)(XB + 384), (const attn_body::bf16*)(PB + N_DG), (const unsigned*)(a.ws + WS_MASK)};
#if GLA_MODE == 1
                if (wg < 32) { glab::gla_seq_unit(PB, XB, a.ws + WS_GOP, a.gla_norm_g + l * 96, lds, wg >> 2, wg & 3, tid);
#if REP_GLA == 2
                    asm volatile("" : "+v"(tid)); glab::gla_seq_unit(PB, XB, a.ws + WS_GOP, a.gla_norm_g + l * 96, lds, wg >> 2, wg & 3, tid);
#endif
                    for (int i = tid; i < 1032; i += NTHR) { const int rel = i >> 3, h = i & 7; dl[i] = (h < 6 && rel < 128) ? (a.rel_bias[(int)T5B[rel] * 6 + h] - a.rel_bias[31 * 6 + h]) * LOG2E : 0.f; } for (int i = tid; i < 512; i += NTHR) { const unsigned nb = ((unsigned)(i >> 1) >> (4 * (i & 1))) & 15u; ((unsigned*)(lds + attn_body::LDS_TAB))[i] = (nb & 1u ? 0xffu : 0u) | (nb & 2u ? 0xff00u : 0u) | (nb & 4u ? 0xff0000u : 0u) | (nb & 8u ? 0xff000000u : 0u); }
                    __syncthreads(); }
#endif
#if ATT_PRIO
                if (__builtin_amdgcn_readfirstlane(tid) >= 256) __builtin_amdgcn_s_setprio(1);
#endif
                for (int rp = 0; rp < REP_ATT; ++rp) { unsigned* qctr = (unsigned*)(a.ws + WS_CTL) + CW_QUEUE + 64 * (l * 4 + rp + 2 * rpw);
                for (;;) { asm volatile("" : "+v"(tid));
                    __syncthreads();
                    if (tid == 0) MISC[16] = __hip_atomic_fetch_add(qctr, 1u, __ATOMIC_RELAXED, __HIP_MEMORY_SCOPE_AGENT);
                    __syncthreads();
                    const int k = (int)MISC[16];
                    if (k >= 48 * 32) break;
                    const int qb = 31 - k / 48, bh = k % 48;
                    attn_body::attn_unit<8>(bh / 6, bh % 6, qb, AT.Q, AT.K, AT.V, AT.O, AT.GT, AT.MK, (attn_body::lds_cfptr)(LAS const float*)((LAS unsigned char*)lds + 86016), (char*)lds, tid); } }
#if ATT_PRIO
                __builtin_amdgcn_s_setprio(0);
#endif
            }
#endif
            SEAM();
        }
        LAUNDER();
        if (IN(5)) {
            pg8::Gemm g{XB, (const bf16*)(a.ws + WS_WOUT) + (size_t)l * 1024 * 1024, M, DM, DM}; pg8::StaticOrder S; S.init(M, DM, G, wg);
            pg8::EpiRes E{(bf16*)(a.ws + WS_XA), DM, (float*)(a.ws + WS_RS)};
            pg8::gemm_phase<pg8::EpiRes, pg8::StaticOrder, true, true>((PG8_LAS unsigned char*)lds, g, S, E, tid);
#if REP_OUT == 2
            { asm volatile("" : "+v"(tid)); __syncthreads(); pg8::EpiRes E2{(bf16*)(a.ws + WS_P), DM, (float*)(a.ws + WS_P) + (size_t)M * DM}; pg8::gemm_phase<pg8::EpiRes, pg8::StaticOrder, true, true>((PG8_LAS unsigned char*)lds, g, S, E2, tid); }
#endif
            SEAM();
        }
    }
    }
    LAUNDER();
    if (IN(6)) final_norm_phase((const bf16*)(a.ws + WS_XA), a.out, a.final_g, (const float*)(a.ws + WS_RS), gw, NGW, lane);
#undef IN
#undef SEAM
}

extern "C" void kernel_launch(void* const* d_in, const int* in_sizes, int n_in, void* d_out, int out_size, void* d_ws, size_t ws_size, hipStream_t stream) {
    static int grid = 0;
    if (grid == 0) {
        if (n_in != 11 || in_sizes[0] != M * DM || out_size != M * DM || ws_size < WS_END) { fprintf(stderr, "kernel_launch: unexpected shapes (n_in %d, in0 %d, out %d, ws %zu); nothing launched\n", n_in, n_in > 0 ? in_sizes[0] : -1, out_size, ws_size); grid = -1; return; }
        int dev = 0, cus = 0, per_cu = 0;
        if (hipGetDevice(&dev) != hipSuccess || hipDeviceGetAttribute(&cus, hipDeviceAttributeMultiprocessorCount, dev) != hipSuccess) { grid = -1; return; }
        if (hipFuncSetAttribute((const void*)fwd, hipFuncAttributeMaxDynamicSharedMemorySize, LDS_BYTES) != hipSuccess) { fprintf(stderr, "kernel_launch: hipFuncSetAttribute failed\n"); grid = -1; return; }
        if (hipOccupancyMaxActiveBlocksPerMultiprocessor(&per_cu, (const void*)fwd, NTHR, LDS_BYTES) != hipSuccess || per_cu < 1) fprintf(stderr, "kernel_launch: occupancy query reports %d\n", per_cu);
        (void)hipGetLastError();
        grid = cus;
    }
    if (grid < 0) return;
    if (hipMemsetAsync((char*)d_ws + WS_CTL, 0, CTL_ZERO_BYTES, stream) != hipSuccess) return;
    Args a{};
    a.x = (const float*)d_in[0]; a.norm_g = (const float*)d_in[1]; a.w_in = (const float*)d_in[2]; a.gate_w2 = (const float*)d_in[3]; a.gate_b = (const float*)d_in[4]; a.gla_norm_g = (const float*)d_in[5];
    a.rel_bias = (const float*)d_in[6]; a.pool_w = (const float*)d_in[7]; a.pool_scale = (const float*)d_in[8]; a.w_out = (const float*)d_in[9]; a.final_g = (const float*)d_in[10];
    a.out = (float*)d_out; a.ws = (unsigned char*)d_ws; a.pad = 0;
#if MK_SINGLE
    a.l_lo = 0; a.l_hi = DEPTH; a.ph_lo = 0; a.ph_hi = 7; a.single = 1;
    hipLaunchKernelGGL(fwd, dim3(grid), dim3(NTHR), LDS_BYTES, stream, a);
#else
    a.single = 0;
    a.l_lo = 0; a.l_hi = 0; a.ph_lo = 0; a.ph_hi = 1; hipLaunchKernelGGL(fwd, dim3(grid), dim3(NTHR), LDS_BYTES, stream, a);
    for (int l = 0; l < DEPTH; ++l) for (int ph = 1; ph <= 5; ++ph) { a.l_lo = l; a.l_hi = l + 1; a.ph_lo = ph; a.ph_hi = ph + 1; hipLaunchKernelGGL(fwd, dim3(grid), dim3(NTHR), LDS_BYTES, stream, a); }
    a.l_lo = 0; a.l_hi = 0; a.ph_lo = 6; a.ph_hi = 7; hipLaunchKernelGGL(fwd, dim3(grid), dim3(NTHR), LDS_BYTES, stream, a);
#endif
    const hipError_t le = hipPeekAtLastError();
    if (le != hipSuccess) fprintf(stderr, "kernel_launch: launch failed: %s\n", hipGetErrorName(le));
}
```

```cpp
#include <hip/hip_runtime.h>
#include <cstdio>
#include <cstdint>
namespace pg8 {
#define PG8_LAS __attribute__((address_space(3)))
typedef unsigned short bf16_t;
typedef short bf16x8 __attribute__((ext_vector_type(8)));
typedef float f32x4 __attribute__((ext_vector_type(4)));
typedef unsigned u32x4 __attribute__((ext_vector_type(4)));
constexpr int BM = 256, BK = 64, HALF = 128, HTB = HALF * BK * 2  , STAGE_BYTES = 8 * HTB, NXCD = 8, WGM = 8;

__host__ __device__ __forceinline__ int lds_byte(int r, int c) { const int st = (r >> 4) * 2 + (c >> 5), rr = r & 15, cc = c & 31, ob = rr * 64 + cc * 2; return st * 1024 + (ob ^ (((ob >> 9) & 1) << 5)); }
__host__ __device__ __forceinline__ void stage_rc(int b, int& R, int& C) { const int st = b / 1024, sb = b % 1024, swz = sb ^ (((sb >> 9) & 1) << 5); R = (st >> 1) * 16 + swz / 64; C = (st & 1) * 32 + (swz % 64) / 2; }
__host__ __device__ __forceinline__ int perm32(int rho) { const int n = rho >> 4, i = rho & 15; return 8 * (i >> 2) + 4 * n + (i & 3); }

struct Unit { int pm, pn; };
struct Gemm { const bf16_t* A; const bf16_t* Bt; int M, N, K; };

struct StaticOrder {
    int nM, nN, nwg, G, c;
    __host__ __device__ void init(int M, int N, int G_, int c_) { nM = M / BM; nN = N / BM; nwg = nM * nN; G = G_; c = c_; }
    __host__ __device__ bool next(int i, Unit& u) const {
        const long L = (long)i * G + c; if (L >= nwg) return false;
        int wgid = (int)L; { const int q = nwg / NXCD, r = nwg % NXCD, xcd = wgid % NXCD, off = wgid / NXCD; wgid = (xcd < r ? xcd * (q + 1) : r * (q + 1) + (xcd - r) * q) + off; }
        const int nig = WGM * nN, gid = wgid / nig, fm = gid * WGM, gsz = (nM - fm) < WGM ? (nM - fm) : WGM;
        u.pm = fm + ((wgid % nig) % gsz); u.pn = (wgid % nig) / gsz; return true;
    }
    __device__ __forceinline__ void a_ready(const Unit&) const {}
    __device__ __forceinline__ void done(const Unit&) const {}
};

__device__ __forceinline__ unsigned cvt_pk_bf16(float lo, float hi) { unsigned r; asm volatile("v_cvt_pk_bf16_f32 %0, %1, %2" : "=v"(r) : "v"(lo), "v"(hi)); return r; }
typedef float f32x2 __attribute__((ext_vector_type(2)));
struct EpiP {
    static constexpr bool PERM = true, AFTER_DRAIN = false;
    bf16_t* O; int ldc; const float* RS; bf16_t* KC;
    __device__ __forceinline__ void operator()(const f32x4 (&acc)[2][2][4][2], const Unit& u, int wr, int wc, int fr, int fq) const {
        const int row0 = u.pm * BM + wr * 64 + fr, col0 = u.pn * BM + wc * 32 + 8 * fq;
#pragma unroll
        for (int ai = 0; ai < 2; ++ai)
#pragma unroll
            for (int m = 0; m < 4; ++m) { const int row = row0 + ai * HALF + m * 16; bf16_t* rowp = O + (size_t)row * ldc + col0;
                const float r = RS[row];
#pragma unroll
                for (int bj = 0; bj < 2; ++bj) { const f32x4 v0 = acc[ai][bj][m][0] * r, v1 = acc[ai][bj][m][1] * r;
                    u32x4 w; w.x = cvt_pk_bf16(v0[0], v0[1]); w.y = cvt_pk_bf16(v0[2], v0[3]); w.z = cvt_pk_bf16(v1[0], v1[1]); w.w = cvt_pk_bf16(v1[2], v1[3]);
                    if (col0 + bj * HALF < 3384) *(u32x4*)(rowp + bj * HALF) = w;
                    if (bj == 0 && wc == 0 && u.pn == 13) *(u32x4*)(KC + (size_t)row * 32 + 8 * fq) = w; } }
    }
};
struct EpiRes {
    static constexpr bool PERM = true, AFTER_DRAIN = false;
    bf16_t* XA; int ldc; float* RS;
    __device__ __forceinline__ void operator()(const f32x4 (&acc)[2][2][4][2], const Unit& u, int wr, int wc, int fr, int fq) const {
        const int row0 = u.pm * BM + wr * 64 + fr, col0 = u.pn * BM + wc * 32 + 8 * fq, lane = fr + 16 * fq;
#pragma unroll
        for (int ai = 0; ai < 2; ++ai)
#pragma unroll
            for (int m = 0; m < 4; ++m) { const int row = row0 + ai * HALF + m * 16; const size_t off = (size_t)row * ldc + col0; float s = 0.f;
#pragma unroll
                for (int bj = 0; bj < 2; ++bj) { const u32x4 b = *(const u32x4*)(XA + off + bj * HALF); u32x4 w;
#pragma unroll
                    for (int k = 0; k < 4; ++k) { const float lo = __uint_as_float(b[k] << 16) + acc[ai][bj][m][k >> 1][2 * (k & 1)], hi = __uint_as_float(b[k] & 0xffff0000u) + acc[ai][bj][m][k >> 1][2 * (k & 1) + 1];
                        w[k] = cvt_pk_bf16(lo, hi); const float rl = __uint_as_float(w[k] << 16), rh = __uint_as_float(w[k] & 0xffff0000u); s += rl * rl + rh * rh; }
                    *(u32x4*)(XA + off + bj * HALF) = w; }
                s += __builtin_bit_cast(float, __builtin_amdgcn_ds_bpermute((lane ^ 16) << 2, __builtin_bit_cast(int, s)));
                s += __builtin_bit_cast(float, __builtin_amdgcn_ds_bpermute((lane ^ 32) << 2, __builtin_bit_cast(int, s)));
                if (fq == 0) RS[(size_t)row * 16 + u.pn * 4 + wc] = s; }
    }
};
template <class Epi, class Sched, bool ALIGN_EPI = false, bool SP2 = false>
__device__ __forceinline__ void gemm_phase(PG8_LAS unsigned char* lds, const Gemm g, const Sched& S, const Epi& E, const int tid) {
    const int wid = __builtin_amdgcn_readfirstlane(tid >> 6), lane = tid & 63, wr = wid >> 2, wc = wid & 3, fr = lane & 15, fq = lane >> 4;
    const int K = g.K, nt = K / BK;
    unsigned voffA[2], voffB[2];
#pragma unroll
    for (int i = 0; i < 2; ++i) { int R, C; stage_rc(tid * 16 + i * 8192, R, C); const int Rb = Epi::PERM ? ((R & ~31) + perm32(R & 31)) : R;
        voffA[i] = (unsigned)(R * K + C) * 2u; voffB[i] = (unsigned)(Rb * K + C) * 2u; }
    const size_t kstep = (size_t)(BK * 2);
    const size_t hstep = (size_t)HALF * K * 2;
    const size_t tstep = 2 * hstep;
    const unsigned ldsw = (unsigned)wid * 1024u;
    const int aoff = lds_byte(wr * 64 + fr, fq * 8), boff = lds_byte(wc * 32 + fr, fq * 8);
#define PG8_SA(b, h) (((b) * 2 + (h)) * HTB)
#define PG8_SB(b, h) ((4 + (b) * 2 + (h)) * HTB)
#define PG8_STAGE(bufoff, gbase, voff) do { _Pragma("unroll") for (int _i = 0; _i < 2; ++_i) \
        __builtin_amdgcn_global_load_lds((const unsigned*)((const char*)(gbase) + (voff)[_i]), (PG8_LAS unsigned*)(lds + (bufoff) + ldsw + _i * 8192), 16, 0, 0); } while (0)
#define PG8_LDA(dst, b, h) do { _Pragma("unroll") for (int m = 0; m < 4; ++m) _Pragma("unroll") for (int k = 0; k < 2; ++k) dst[m][k] = *(const PG8_LAS bf16x8*)(lds + PG8_SA(b, h) + aoff + m * 2048 + k * 1024); } while (0)
#define PG8_LDB(dst, b, h) do { _Pragma("unroll") for (int n = 0; n < 2; ++n) _Pragma("unroll") for (int k = 0; k < 2; ++k) dst[n][k] = *(const PG8_LAS bf16x8*)(lds + PG8_SB(b, h) + boff + n * 2048 + k * 1024); } while (0)
#define PG8_MMA(ai, bj, At, Bt) do { __builtin_amdgcn_s_setprio(1); _Pragma("unroll") for (int m = 0; m < 4; ++m) _Pragma("unroll") for (int n = 0; n < 2; ++n) _Pragma("unroll") for (int k = 0; k < 2; ++k) \
        acc[ai][bj][m][n] = __builtin_amdgcn_mfma_f32_16x16x32_bf16(Bt[n][k], At[m][k], acc[ai][bj][m][n], 0, 0, 0); __builtin_amdgcn_s_setprio(0); } while (0)
#define PG8_WAIT_V(n) asm volatile("s_waitcnt vmcnt(" #n ")" ::: "memory")
#define PG8_WAIT_L(n) asm volatile("s_waitcnt lgkmcnt(" #n ")" ::: "memory")
#define PG8_BAR __builtin_amdgcn_s_barrier()
#define PG8_SCHED __builtin_amdgcn_sched_barrier(0)
    Unit cur, nxt; int ui = 0;
    if (!S.next(0, cur)) return;
    f32x4 acc[2][2][4][2];
#pragma unroll
    for (int a = 0; a < 2; ++a)
#pragma unroll
        for (int b = 0; b < 2; ++b)
#pragma unroll
            for (int m = 0; m < 4; ++m)
#pragma unroll
                for (int n = 0; n < 2; ++n) acc[a][b][m][n] = (f32x4){0.f, 0.f, 0.f, 0.f};
    bf16x8 At[4][2], B0[2][2], B1[2][2];
    const char* cA = (const char*)g.A + (size_t)cur.pm * tstep; const char* cB = (const char*)g.Bt + (size_t)cur.pn * tstep;
    S.a_ready(cur);
    if constexpr (SP2) {
        PG8_STAGE(PG8_SB(0, 0), cB, voffB); PG8_STAGE(PG8_SB(0, 1), cB + hstep, voffB); PG8_STAGE(PG8_SA(0, 0), cA, voffA); PG8_STAGE(PG8_SA(0, 1), cA + hstep, voffA);
        if (wr == 1) PG8_BAR;
        PG8_WAIT_V(2); PG8_BAR;
        PG8_STAGE(PG8_SB(1, 0), cB + kstep, voffB); PG8_STAGE(PG8_SA(1, 0), cA + kstep, voffA); PG8_STAGE(PG8_SB(1, 1), cB + hstep + kstep, voffB);
        PG8_WAIT_V(6); PG8_BAR;
    } else {
        PG8_STAGE(PG8_SB(0, 0), cB, voffB); PG8_STAGE(PG8_SA(0, 0), cA, voffA); PG8_STAGE(PG8_SB(0, 1), cB + hstep, voffB); PG8_STAGE(PG8_SA(0, 1), cA + hstep, voffA);
        if (wr == 1) PG8_BAR;
        PG8_WAIT_V(4); PG8_BAR;
        PG8_STAGE(PG8_SB(1, 0), cB + kstep, voffB); PG8_STAGE(PG8_SA(1, 0), cA + kstep, voffA); PG8_STAGE(PG8_SB(1, 1), cB + hstep + kstep, voffB);
        PG8_WAIT_V(6); PG8_BAR;
    }
    for (;;) {
        const bool has_next = S.next(ui + 1, nxt);
        const char* nA = has_next ? (const char*)g.A + (size_t)nxt.pm * tstep : cA; const char* nB = has_next ? (const char*)g.Bt + (size_t)nxt.pn * tstep : cB;
        for (int t = 0; t < nt; t += 2) {
            const bool last = (t == nt - 2);
            const char* a1 = cA + (size_t)(t + 1) * kstep;
            const char* a2 = last ? nA : cA + (size_t)(t + 2) * kstep; const char* b2 = last ? nB : cB + (size_t)(t + 2) * kstep;
            const char* a3 = a2 + kstep; const char* b3 = b2 + kstep;
            if (last && has_next) S.a_ready(nxt);
            if constexpr (SP2) {
            PG8_LDB(B0, 0, 0); PG8_LDB(B1, 0, 1); PG8_SCHED; PG8_LDA(At, 0, 0); PG8_STAGE(PG8_SA(1, 1), a1 + hstep, voffA);
            PG8_WAIT_V(8); PG8_WAIT_L(0); PG8_BAR; PG8_MMA(0, 0, At, B0); PG8_MMA(0, 1, At, B1); PG8_BAR; PG8_SCHED;
            PG8_LDA(At, 0, 1); PG8_STAGE(PG8_SB(0, 0), b2, voffB); PG8_STAGE(PG8_SB(0, 1), b2 + hstep, voffB); PG8_STAGE(PG8_SA(0, 0), a2, voffA);
            PG8_WAIT_V(8); PG8_WAIT_L(0); PG8_BAR; PG8_MMA(1, 0, At, B0); PG8_MMA(1, 1, At, B1); PG8_BAR; PG8_SCHED;
            PG8_LDB(B0, 1, 0); PG8_LDB(B1, 1, 1); PG8_SCHED; PG8_LDA(At, 1, 0); PG8_STAGE(PG8_SA(0, 1), a2 + hstep, voffA);
            PG8_WAIT_V(8); PG8_WAIT_L(0); PG8_BAR; PG8_MMA(0, 0, At, B0); PG8_MMA(0, 1, At, B1); PG8_BAR; PG8_SCHED;
            PG8_LDA(At, 1, 1); PG8_STAGE(PG8_SB(1, 0), b3, voffB); PG8_STAGE(PG8_SB(1, 1), b3 + hstep, voffB); PG8_STAGE(PG8_SA(1, 0), a3, voffA);
            PG8_WAIT_V(8); PG8_WAIT_L(0); PG8_BAR; PG8_MMA(1, 0, At, B0); PG8_MMA(1, 1, At, B1); PG8_BAR; PG8_SCHED;
            } else {
            PG8_LDB(B0, 0, 0); PG8_SCHED; PG8_LDA(At, 0, 0); PG8_STAGE(PG8_SA(1, 1), a1 + hstep, voffA);
            PG8_WAIT_L(8); PG8_BAR; PG8_WAIT_L(0); PG8_MMA(0, 0, At, B0); PG8_BAR; PG8_SCHED;
            PG8_LDB(B1, 0, 1); PG8_STAGE(PG8_SB(0, 0), b2, voffB);
            PG8_BAR; PG8_WAIT_L(0); PG8_MMA(0, 1, At, B1); PG8_BAR;
            PG8_LDA(At, 0, 1); PG8_STAGE(PG8_SA(0, 0), a2, voffA);
            PG8_BAR; PG8_WAIT_L(0); PG8_MMA(1, 0, At, B0); PG8_BAR; PG8_SCHED;
            PG8_STAGE(PG8_SB(0, 1), b2 + hstep, voffB);
            PG8_WAIT_V(6); PG8_BAR; PG8_MMA(1, 1, At, B1); PG8_BAR;
            PG8_LDB(B0, 1, 0); PG8_SCHED; PG8_LDA(At, 1, 0); PG8_STAGE(PG8_SA(0, 1), a2 + hstep, voffA);
            PG8_WAIT_L(8); PG8_BAR; PG8_WAIT_L(0); PG8_MMA(0, 0, At, B0); PG8_BAR; PG8_SCHED;
            PG8_LDB(B1, 1, 1); PG8_STAGE(PG8_SB(1, 0), b3, voffB);
            PG8_BAR; PG8_WAIT_L(0); PG8_MMA(0, 1, At, B1); PG8_BAR;
            PG8_LDA(At, 1, 1); PG8_STAGE(PG8_SA(1, 0), a3, voffA);
            PG8_BAR; PG8_WAIT_L(0); PG8_MMA(1, 0, At, B0); PG8_BAR; PG8_SCHED;
            PG8_STAGE(PG8_SB(1, 1), b3 + hstep, voffB);
            PG8_WAIT_V(6); PG8_BAR; PG8_MMA(1, 1, At, B1); PG8_BAR;
            }
        }
        if constexpr (ALIGN_EPI) { if (wr == 0) PG8_BAR; }
        if constexpr (!Epi::AFTER_DRAIN) { E(acc, cur, wr, wc, fr, fq); S.done(cur); }
        if (!has_next) break;
#pragma unroll
        for (int a = 0; a < 2; ++a)
#pragma unroll
            for (int b = 0; b < 2; ++b)
#pragma unroll
                for (int m = 0; m < 4; ++m)
#pragma unroll
                    for (int n = 0; n < 2; ++n) acc[a][b][m][n] = (f32x4){0.f, 0.f, 0.f, 0.f};
        cur = nxt; cA = nA; cB = nB; ++ui;
        if constexpr (ALIGN_EPI) { if (wr == 1) PG8_BAR; }
    }
    PG8_WAIT_V(0);
    if constexpr (!ALIGN_EPI) { if (wr == 0) PG8_BAR; }
    PG8_BAR;
    if constexpr (Epi::AFTER_DRAIN) { E.fused(acc, cur, wr, wc, fr, fq, lds, wid, lane); S.done(cur); }
#undef PG8_SA
#undef PG8_SB
#undef PG8_STAGE
#undef PG8_LDA
#undef PG8_LDB
#undef PG8_MMA
#undef PG8_WAIT_V
#undef PG8_WAIT_L
#undef PG8_BAR
#undef PG8_SCHED
}
}
#include <hip/hip_bf16.h>
#include <cmath>
namespace attn_body {
using bf16=__hip_bfloat16;
using bf16x8=__attribute__((ext_vector_type(8)))short;
using s16x4=__attribute__((ext_vector_type(4)))short;
using f32x16=__attribute__((ext_vector_type(16)))float;
using u32x4=__attribute__((ext_vector_type(4)))unsigned;
constexpr int BATCH=8,NHEAD=6,SEQ=8192,D=64,DM=3584,DMO=1024;
constexpr int NW=8,QBLK=32,QB=QBLK*NW,KVBLK=64,NQB=SEQ/QB;
constexpr int ATTN_UNIT_ROWS=QB;
__device__ __forceinline__ int crow(int r,int hi){return (r&3)+8*(r>>2)+4*hi;}
#define SBAR() __builtin_amdgcn_sched_barrier(0)
typedef __attribute__((address_space(3))) const float* lds_cfptr;
__device__ __forceinline__ void biasadd(f32x16&p0,f32x16&p1,int tt,int tq,int hi,lds_cfptr dl,int h){
  const int rb=tq-64*tt-4*hi; const lds_cfptr dh=dl+h;
  #pragma unroll
  for(int r=0;r<16;++r){ const unsigned i0=(unsigned)(rb-(r&3)-8*(r>>2)), i1=i0-32u;
    float a0=dh[(i0<128u?i0:128u)*8], a1=dh[(i1<128u?i1:128u)*8];
    asm volatile("s_waitcnt lgkmcnt(0)":"+v"(a0),"+v"(a1)::"memory");
    p0[r]+=a0; p1[r]+=a1; }
}
typedef unsigned u32x2m __attribute__((ext_vector_type(2)));
template<int K> __device__ __forceinline__ float mands(float p,unsigned md){ return __uint_as_float(__float_as_uint(p)&(unsigned)(K==3?((int)md>>24):(int)(signed char)(md>>(8*K)))); }
template<int K> __device__ __forceinline__ float mandk(float p,unsigned bits){ unsigned m; asm("v_bfe_i32 %0, %1, %2, 1":"=v"(m):"v"(bits),"n"(K)); return __uint_as_float(__float_as_uint(p)&m); }
__device__ __forceinline__ float mand(float p,unsigned bits,int k){ return __uint_as_float(__float_as_uint(p)&(unsigned)__builtin_amdgcn_sbfe((int)bits,k,1)); }

constexpr int NSLOT=3, SLOTB=8192;
constexpr int LDS_K=0, LDS_V=NSLOT*SLOTB, LDS_TAB=2*NSLOT*SLOTB, LDS_OST=LDS_TAB+2048, LDS_WS=LDS_OST+NW*4096, LDS_BYTES=LDS_WS+NW*64*4, LDS_QST=90624;
constexpr float C2=0.125f*1.4426950408889634f;
__device__ __forceinline__ void glds16(const void*gsrc,unsigned lds_dst){unsigned keep;
  asm volatile("s_mov_b32 %0, m0\n\ts_mov_b32 m0, %2\n\ts_nop 0\n\tglobal_load_lds_dwordx4 %1, off\n\ts_mov_b32 m0, %0":"=&s"(keep):"v"(gsrc),"s"(lds_dst):"memory");}
__device__ __forceinline__ float max3f(float a,float b,float c){float r;asm("v_max3_f32 %0, %1, %2, %3":"=v"(r):"v"(a),"v"(b),"v"(c));return r;}
__device__ __forceinline__ float max2f(float a,float b){float r;asm("v_max_f32_e32 %0, %1, %2":"=v"(r):"v"(a),"v"(b));return r;}
__device__ __forceinline__ float fadd_s(float a,float b){float r;asm("v_add_f32_e32 %0, %1, %2":"=v"(r):"v"(a),"v"(b));return r;}
__device__ __forceinline__ float fsub_s(float a,float b){float r;asm("v_sub_f32_e32 %0, %1, %2":"=v"(r):"v"(a),"v"(b));return r;}
typedef float f32x2_t __attribute__((ext_vector_type(2))); typedef __bf16 bf16x2_t __attribute__((ext_vector_type(2)));
__device__ __forceinline__ unsigned cvtpk_s(float lo,float hi){f32x2_t v={lo,hi};bf16x2_t b=__builtin_convertvector(v,bf16x2_t);return __builtin_bit_cast(unsigned,b);}
#define WAIT_BAR(N) asm volatile("s_waitcnt vmcnt(" #N ") lgkmcnt(0)\n\ts_barrier":::"memory")

__device__ __forceinline__ void qkt(f32x16&p0,f32x16&p1,const char*Kslot,const bf16x8*qr,const f32x16&negm,int r32,int hi){
  const char*kb=Kslot+hi*1024+r32*16;
  #pragma unroll
  for(int d0=0;d0<4;++d0){
    const bf16x8 b0=*reinterpret_cast<const bf16x8*>(kb+d0*2048);
    const bf16x8 b1=*reinterpret_cast<const bf16x8*>(kb+d0*2048+512);
    if(d0==0){p0=__builtin_amdgcn_mfma_f32_32x32x16_bf16(b0,qr[0],negm,0,0,0);p1=__builtin_amdgcn_mfma_f32_32x32x16_bf16(b1,qr[0],negm,0,0,0);}
    else{p0=__builtin_amdgcn_mfma_f32_32x32x16_bf16(b0,qr[d0],p0,0,0,0);p1=__builtin_amdgcn_mfma_f32_32x32x16_bf16(b1,qr[d0],p1,0,0,0);}}
}
typedef __attribute__((address_space(3))) const char* lds_cptr;
typedef short v4i16_t __attribute__((ext_vector_type(4)));
__device__ __forceinline__ void kload8(bf16x8*kf,lds_cptr kp){
  kf[0]=*(const __attribute__((address_space(3))) bf16x8*)(kp);      kf[1]=*(const __attribute__((address_space(3))) bf16x8*)(kp+512);
  kf[2]=*(const __attribute__((address_space(3))) bf16x8*)(kp+2048); kf[3]=*(const __attribute__((address_space(3))) bf16x8*)(kp+2560);
  kf[4]=*(const __attribute__((address_space(3))) bf16x8*)(kp+4096); kf[5]=*(const __attribute__((address_space(3))) bf16x8*)(kp+4608);
  kf[6]=*(const __attribute__((address_space(3))) bf16x8*)(kp+6144); kf[7]=*(const __attribute__((address_space(3))) bf16x8*)(kp+6656);
}
__device__ __forceinline__ void kload2(bf16x8*kf,lds_cptr kp,int j){ kf[2*j]=*(const __attribute__((address_space(3))) bf16x8*)(kp+j*2048); kf[2*j+1]=*(const __attribute__((address_space(3))) bf16x8*)(kp+j*2048+512); }
__device__ __forceinline__ s16x4 vtr(lds_cptr p){ return __builtin_bit_cast(s16x4,__builtin_amdgcn_ds_read_tr16_b64_v4i16((__attribute__((address_space(3))) v4i16_t*)p)); }
__device__ __forceinline__ float rowmax(const f32x16&p0,const f32x16&p1){
  float a=max3f(p0[0],p0[1],p1[0]),b=max3f(p0[2],p0[3],p1[1]);a=max3f(a,p1[2],p1[3]);
  #pragma unroll
  for(int r=4;r<16;r+=4){a=max3f(a,p0[r],p0[r+1]);b=max3f(b,p0[r+2],p0[r+3]);a=max3f(a,p1[r],p1[r+1]);b=max3f(b,p1[r+2],p1[r+3]);}
  const float m=max2f(a,b);
  auto rr=__builtin_amdgcn_permlane32_swap(__float_as_uint(m),__float_as_uint(m),false,false);
  return max2f(__uint_as_float(rr[0]),__uint_as_float(rr[1]));
}
__device__ __forceinline__ void pv(f32x16*o,int vb,bf16x8 pa0,bf16x8 pa1,bf16x8 pa2,bf16x8 pa3){
  #pragma unroll
  for(int d0=0;d0<2;++d0){s16x4 lo[4],hi[4];
    #pragma unroll
    for(int ks=0;ks<4;++ks){
      asm volatile("ds_read_b64_tr_b16 %0,%1 offset:%c2":"=&v"(lo[ks]):"v"(vb),"i"(d0*4096+ks*1024):"memory");
      asm volatile("ds_read_b64_tr_b16 %0,%1 offset:%c2":"=&v"(hi[ks]):"v"(vb),"i"(d0*4096+ks*1024+512):"memory");}
    asm volatile("s_waitcnt lgkmcnt(0)":::"memory");SBAR();
    #define PK(k) (bf16x8){lo[k][0],lo[k][1],lo[k][2],lo[k][3],hi[k][0],hi[k][1],hi[k][2],hi[k][3]}
    o[d0]=__builtin_amdgcn_mfma_f32_32x32x16_bf16(pa0,PK(0),o[d0],0,0,0);
    o[d0]=__builtin_amdgcn_mfma_f32_32x32x16_bf16(pa1,PK(1),o[d0],0,0,0);
    o[d0]=__builtin_amdgcn_mfma_f32_32x32x16_bf16(pa2,PK(2),o[d0],0,0,0);
    o[d0]=__builtin_amdgcn_mfma_f32_32x32x16_bf16(pa3,PK(3),o[d0],0,0,0);
    #undef PK
  }
}

#ifndef ATTN_STORE16
#define ATTN_STORE16(p,v) (*(u32x4*)(p)=(v))
#endif
template<int THRL> __device__ __forceinline__ void attn_unit(int b,int h,int qb,const bf16*Q,const bf16*__restrict__ K,const bf16*__restrict__ V,bf16*O,const bf16*GT,const unsigned*MK,lds_cfptr dl,char*shm,const int tid){
  const int lane=tid&63,r32=lane&31,hi=lane>>5; const int wid=__builtin_amdgcn_readfirstlane(tid>>6);
  const long rowbase=(long)b*SEQ; const int q0=qb*QB;
  const bf16*Qw=Q+(rowbase+q0+wid*QBLK)*DM+h*D;
  const bf16*Kh=K+rowbase*DM+h*D,*Vh=V+rowbase*DM+h*D;
  const unsigned lds0=(unsigned)(uintptr_t)shm;
  float*wsf=(float*)(shm+LDS_WS)+wid*64;
  const bf16*ksrc=Kh+(long)lane*DM+wid*8;
  const bf16*vsrc=Vh+(long)(16*(wid&3)+(lane>>2))*DM+(wid>>2)*32+(lane&3)*8;
  const unsigned kdst=lds0+LDS_K+wid*1024, vdst=lds0+LDS_V+wid*1024;
  #define DMA_K(t,slot) glds16(ksrc+(long)(t)*KVBLK*DM,(unsigned)__builtin_amdgcn_readfirstlane(kdst+(slot)))
  #define DMA_V(t,slot) glds16(vsrc+(long)(t)*KVBLK*DM,(unsigned)__builtin_amdgcn_readfirstlane(vdst+(slot)))
  const int vb0=(int)(lds0+LDS_V)+((lane>>4)&1)*32+(lane&3)*8+(4*hi+((lane&15)>>2))*64;
  const char*Kbase=shm+LDS_K; bf16x8 kf[8];
  const lds_cptr shm3=(lds_cptr)shm; const lds_cptr kp0=shm3+LDS_K+hi*1024+r32*16; const lds_cptr vp0=shm3+LDS_V+((lane>>4)&1)*32+(lane&3)*8+(4*hi+((lane&15)>>2))*64;
  const int NT=(q0+QB)/KVBLK;
  DMA_K(0,0);DMA_V(0,0);DMA_K(1,SLOTB);
  const __attribute__((address_space(3))) char* shm3q=(const __attribute__((address_space(3))) char*)shm;
  bf16x8 qr[4];
  #pragma unroll
  for(int d0=0;d0<4;++d0)qr[d0]=*reinterpret_cast<const bf16x8*>(&Qw[(long)r32*DM+d0*16+hi*8]);
  const __attribute__((address_space(3))) bf16x8* qls=(const __attribute__((address_space(3))) bf16x8*)(shm3q+LDS_QST+wid*4096)+lane;
  #pragma unroll
  for(int d0=0;d0<4;++d0)((__attribute__((address_space(3))) bf16x8*)qls)[64*d0]=qr[d0];
  float mhat=0.f,l_reg=0.f;f32x16 o[2];o[0]=f32x16{};o[1]=f32x16{};float nmh=0.f;
  const int tq=q0+wid*QBLK+r32;
  const unsigned*mbase=MK+((size_t)(b*256+(q0>>5)+wid)*128)*64;
  unsigned bits_cur=mbase[lane],bits_next=mbase[64+lane];
  #define CMASK(P0,P1,t) do{ if((t)>=NT-6)biasadd(P0,P1,(t),tq,hi,dl,h);}while(0)
  bool resc=false;
  #define START(P0,P1) do{ const float rm=rowmax(P0,P1); resc=false; \
    { const float dl=(rm>(float)THRL||rm<-(float)THRL)?rm:0.f; mhat=fadd_s(mhat,dl);     \
      _Pragma("unroll") for(int r=0;r<16;++r){P0[r]=fsub_s(P0[r],dl);P1[r]=fsub_s(P1[r],dl);} \
      nmh=-mhat; } \
    _Pragma("unroll") for(int r=0;r<16;++r)P0[r]=mand(__builtin_amdgcn_exp2f(P0[r]),bits_cur,r); }while(0)
  #define RESC() do{ if(resc){ asm volatile("s_waitcnt lgkmcnt(0)":::"memory"); \
      _Pragma("unroll") for(int d_=0;d_<2;++d_) _Pragma("unroll") for(int r=0;r<16;++r)o[d_][r]*=wsf[crow(r,hi)]; } }while(0)
  f32x16 pA0,pA1,pB0,pB1;
  int sl_prev=0,sl_cur=0,sl_next=SLOTB;
  #define ROT() do{sl_prev=sl_cur;sl_cur=sl_next;sl_next=(sl_next==(NSLOT-1)*SLOTB)?0:sl_next+SLOTB;}while(0)
  DMA_K(2,2*SLOTB);
  WAIT_BAR(3);
  { const f32x16 zc=f32x16{}; qkt(pA0,pA1,Kbase,qr,zc,r32,hi); }asm volatile("s_nop 15\n\ts_nop 7":"+v"(pA0),"+v"(pA1));CMASK(pA0,pA1,0);
  START(pA0,pA1);
  _Pragma("unroll") for(int r=0;r<16;++r)pA1[r]=mand(__builtin_amdgcn_exp2f(pA1[r]),bits_cur,16+r);
  WAIT_BAR(0);
  DMA_K(3,0);DMA_V(1,SLOTB);
  ROT();
  kload8(kf,kp0+sl_cur);
  WAIT_BAR(2);
  u32x2m mk01,mk23,mk45,mk67;
  s16x4 vlo[8],vhi[8]; u32x4 pw0,pw1,pw2,pw3; bf16x8 qa_=qls[0],qb_;
  #define PKW(P,B) cvtpk_s(P[B],P[B+1])
  #define PAF(k) __builtin_bit_cast(bf16x8,pw##k)
  #define VFR(i) (bf16x8){vlo[i][0],vlo[i][1],vlo[i][2],vlo[i][3],vhi[i][0],vhi[i][1],vhi[i][2],vhi[i][3]}
  #define PIN(x) asm volatile("":"+v"(x))
  #define MX3(a,b,c) __builtin_fmaxf(__builtin_fmaxf((a),(b)),(c))
  #define GAPA(MF,A0,A1,A2,A3,W0,W1,PW) do{ MF; sacc+=A0; sacc+=A1; sacc+=A2; sacc+=A3; PIN(sacc); W0; W1; PIN(PW); SBAR(); }while(0)
  #define EX(v) __builtin_amdgcn_exp2f(v)
  #define MKD(e) (((e)>>2)==0?mk01[0]:((e)>>2)==1?mk01[1]:((e)>>2)==2?mk23[0]:((e)>>2)==3?mk23[1]:((e)>>2)==4?mk45[0]:((e)>>2)==5?mk45[1]:((e)>>2)==6?mk67[0]:mk67[1])
  #define GAPB(MF,X,B,MB) do{ MF; { const unsigned md_=MKD((MB)+(B)); X[B]=mands<0>(EX(X[B]),md_); X[B+1]=mands<1>(EX(X[B+1]),md_); X[B+2]=mands<2>(EX(X[B+2]),md_); X[B+3]=mands<3>(EX(X[B+3]),md_); } PIN(X); SBAR(); }while(0)
  #define VRD(i) do{ vlo[i]=vtr(vp_+(((i)>>2)*4096+((i)&3)*1024)); vhi[i]=vtr(vp_+(((i)>>2)*4096+((i)&3)*1024+512)); }while(0)
  #define KRD(G,j) do{ if(G){ kload2(kf,kp0+sl_next,j); SBAR(); } }while(0)
  #define STEP(C0,C1,P0,P1,t,GK,GV,GL) do{ SBAR(); \
    bits_cur=bits_next; if(GV){ bits_next=mbase[64*((t)+1)+lane]; } \
    { const lds_cptr tb_=shm3+LDS_TAB; mk01=*(const __attribute__((address_space(3))) u32x2m*)(tb_+((bits_cur&0xffu)<<3)); mk23=*(const __attribute__((address_space(3))) u32x2m*)(tb_+(((bits_cur>>8)&0xffu)<<3)); \
      mk45=*(const __attribute__((address_space(3))) u32x2m*)(tb_+(((bits_cur>>16)&0xffu)<<3)); mk67=*(const __attribute__((address_space(3))) u32x2m*)(tb_+((bits_cur>>24)<<3)); } \
    const lds_cptr vp_=vp0+sl_prev; \
    VRD(0); qb_=qls[64]; SBAR(); float sacc=(P0[0]+P0[1]); \
    if(!__any(nmh!=0.f)){ const f32x16 zc_=f32x16{}; \
      GAPA(C0=__builtin_amdgcn_mfma_f32_32x32x16_bf16(kf[0],qa_,zc_,0,0,0), P0[2],P0[3],P0[4],P0[5],     pw0[0]=PKW(P0,0), pw0[1]=PKW(P0,2), pw0); \
      VRD(4); SBAR(); GAPA(C1=__builtin_amdgcn_mfma_f32_32x32x16_bf16(kf[1],qa_,zc_,0,0,0), P0[6],P0[7],P0[8],P0[9],     pw0[2]=PKW(P0,4), pw0[3]=PKW(P0,6), pw0); \
    }else{ f32x16 negm; { float nm_=nmh; asm volatile("":"+v"(nm_)); _Pragma("unroll") for(int r=0;r<16;++r)negm[r]=nm_; } \
      GAPA(C0=__builtin_amdgcn_mfma_f32_32x32x16_bf16(kf[0],qa_,negm,0,0,0), P0[2],P0[3],P0[4],P0[5],     pw0[0]=PKW(P0,0), pw0[1]=PKW(P0,2), pw0); \
      VRD(4); SBAR(); GAPA(C1=__builtin_amdgcn_mfma_f32_32x32x16_bf16(kf[1],qa_,negm,0,0,0), P0[6],P0[7],P0[8],P0[9],     pw0[2]=PKW(P0,4), pw0[3]=PKW(P0,6), pw0); } \
    VRD(1); qa_=qls[128]; SBAR(); GAPA(C0=__builtin_amdgcn_mfma_f32_32x32x16_bf16(kf[2],qb_,C0,0,0,0),   P0[10],P0[11],P0[12],P0[13], pw1[0]=PKW(P0,8), pw1[1]=PKW(P0,10), pw1); \
    VRD(5); SBAR(); GAPA(C1=__builtin_amdgcn_mfma_f32_32x32x16_bf16(kf[3],qb_,C1,0,0,0),   P0[14],P0[15],P1[0],P1[1],   pw1[2]=PKW(P0,12),pw1[3]=PKW(P0,14), pw1); \
    VRD(2); qb_=qls[192]; SBAR(); GAPA(C0=__builtin_amdgcn_mfma_f32_32x32x16_bf16(kf[4],qa_,C0,0,0,0),   P1[2],P1[3],P1[4],P1[5],     pw2[0]=PKW(P1,0), pw2[1]=PKW(P1,2), pw2); \
    VRD(6); SBAR(); GAPA(C1=__builtin_amdgcn_mfma_f32_32x32x16_bf16(kf[5],qa_,C1,0,0,0),   P1[6],P1[7],P1[8],P1[9],     pw2[2]=PKW(P1,4), pw2[3]=PKW(P1,6), pw2); \
    VRD(3); qa_=qls[0]; SBAR(); GAPA(C0=__builtin_amdgcn_mfma_f32_32x32x16_bf16(kf[6],qb_,C0,0,0,0),   P1[10],P1[11],P1[12],P1[13], pw3[0]=PKW(P1,8), pw3[1]=PKW(P1,10), pw3); \
    VRD(7); SBAR(); GAPA(C1=__builtin_amdgcn_mfma_f32_32x32x16_bf16(kf[7],qb_,C1,0,0,0),   P1[14],P1[15],0.f,0.f,       pw3[2]=PKW(P1,12),pw3[3]=PKW(P1,14), pw3); \
    l_reg+=sacc; \
    if(GK){DMA_K((t)+3,sl_cur);} if(GV){DMA_V((t)+1,sl_next);} \
    CMASK(C0,C1,t); \
    { float a=MX3(C0[0],C0[1],C1[0]),b=MX3(C0[2],C0[3],C1[1]); a=MX3(a,C1[2],C1[3]); \
      _Pragma("unroll") for(int r=4;r<16;r+=4){a=MX3(a,C0[r],C0[r+1]);b=MX3(b,C0[r+2],C0[r+3]);a=MX3(a,C1[r],C1[r+1]);b=MX3(b,C1[r+2],C1[r+3]);} \
      float rm=__builtin_fmaxf(a,b); { auto rr=__builtin_amdgcn_permlane32_swap(__float_as_uint(rm),__float_as_uint(rm),false,false); rm=__builtin_fmaxf(__uint_as_float(rr[0]),__uint_as_float(rr[1])); } \
      resc=false; \
      if(__builtin_expect(__any(rm>(float)THRL),0)){ const float dl=__builtin_fmaxf(rm,0.f); mhat+=dl; \
        _Pragma("unroll") for(int r=0;r<16;++r){C0[r]-=dl;C1[r]-=dl;} \
        nmh=-mhat; \
        const float f=__builtin_amdgcn_exp2f(-dl); l_reg*=f; if(hi==0)wsf[r32]=f; resc=true; } } \
    SBAR(); \
    GAPB(o[0]=__builtin_amdgcn_mfma_f32_32x32x16_bf16(PAF(0),VFR(0),o[0],0,0,0), C0,0,0); \
    GAPB(o[1]=__builtin_amdgcn_mfma_f32_32x32x16_bf16(PAF(0),VFR(4),o[1],0,0,0), C0,4,0); \
    KRD(GL,0); GAPB(o[0]=__builtin_amdgcn_mfma_f32_32x32x16_bf16(PAF(1),VFR(1),o[0],0,0,0), C0,8,0); \
    KRD(GL,1); GAPB(o[1]=__builtin_amdgcn_mfma_f32_32x32x16_bf16(PAF(1),VFR(5),o[1],0,0,0), C0,12,0); \
    KRD(GL,2); GAPB(o[0]=__builtin_amdgcn_mfma_f32_32x32x16_bf16(PAF(2),VFR(2),o[0],0,0,0), C1,0,16); \
    KRD(GL,3); GAPB(o[1]=__builtin_amdgcn_mfma_f32_32x32x16_bf16(PAF(2),VFR(6),o[1],0,0,0), C1,4,16); \
    GAPB(o[0]=__builtin_amdgcn_mfma_f32_32x32x16_bf16(PAF(3),VFR(3),o[0],0,0,0), C1,8,16); \
    GAPB(o[1]=__builtin_amdgcn_mfma_f32_32x32x16_bf16(PAF(3),VFR(7),o[1],0,0,0), C1,12,16); \
    }while(0)
  int t=1;
  #undef CMASK
  #define CMASK(P0,P1,t) do{}while(0)
  for(;t+7<NT;t+=2){
    STEP(pB0,pB1,pA0,pA1,t,true,true,true);     WAIT_BAR(2); RESC(); ROT();
    STEP(pA0,pA1,pB0,pB1,t+1,true,true,true);   WAIT_BAR(2); RESC(); ROT();
  }
  #undef CMASK
  #define CMASK(P0,P1,t) do{ if((t)>=NT-6)biasadd(P0,P1,(t),tq,hi,dl,h);}while(0)
  #define ENDW(tt) do{ if((tt)+3<NT){WAIT_BAR(2);} else if((tt)+2<NT){WAIT_BAR(1);} else {WAIT_BAR(0);} }while(0)
  for(;t+1<NT;t+=2){
    STEP(pB0,pB1,pA0,pA1,t,(t+3<NT),(t+1<NT),(t+1<NT));       ENDW(t);   RESC(); ROT();
    STEP(pA0,pA1,pB0,pB1,t+1,(t+4<NT),(t+2<NT),(t+2<NT));     ENDW(t+1); RESC(); ROT();
  }
  STEP(pB0,pB1,pA0,pA1,NT-1,false,false,false); RESC();
  { float sacc=pB0[0]+pB0[1]; _Pragma("unroll") for(int r=2;r<16;++r)sacc+=pB0[r]; _Pragma("unroll") for(int r=0;r<16;++r)sacc+=pB1[r]; l_reg+=sacc;
    pw0=(u32x4){PKW(pB0,0),PKW(pB0,2),PKW(pB0,4),PKW(pB0,6)};pw1=(u32x4){PKW(pB0,8),PKW(pB0,10),PKW(pB0,12),PKW(pB0,14)};pw2=(u32x4){PKW(pB1,0),PKW(pB1,2),PKW(pB1,4),PKW(pB1,6)};pw3=(u32x4){PKW(pB1,8),PKW(pB1,10),PKW(pB1,12),PKW(pB1,14)};
    SBAR(); pv(o,vb0+sl_cur,PAF(0),PAF(1),PAF(2),PAF(3)); }
  #undef PKW
  #undef PAF
  #undef VFR
  #undef PIN
  #undef MX3
  #undef GAPA
  #undef GAPB
  #undef EX
  #undef VRD
  #undef KRD
  #undef STEP
  #undef ENDW
  {auto rr=__builtin_amdgcn_permlane32_swap(__float_as_uint(l_reg),__float_as_uint(l_reg),false,false);l_reg=__uint_as_float(rr[0])+__uint_as_float(rr[1]);}
  if(hi==0)wsf[32+r32]=l_reg;asm volatile("s_waitcnt lgkmcnt(0)":::"memory");
  float rli[16];
  #pragma unroll
  for(int r=0;r<16;++r)rli[r]=__builtin_amdgcn_rcpf(wsf[32+crow(r,hi)]);
  bf16*Ow=O+(rowbase+q0+wid*QBLK)*DMO+h*D; const bf16*Gw=GT+(rowbase+q0+wid*QBLK)*DM+h*D;
  { bf16*stg=(bf16*)(shm+LDS_OST)+wid*2048;
    #pragma unroll
    for(int r=0;r<16;++r){const int orow=crow(r,hi);
      #pragma unroll
      for(int d0=0;d0<2;++d0)stg[orow*64+d0*32+r32]=__float2bfloat16(o[d0][r]*rli[r]);}
    asm volatile("s_waitcnt lgkmcnt(0)":::"memory");
    #pragma unroll
    for(int i=0;i<4;++i){const int row=i*8+(lane>>3),ch=lane&7; const u32x4 v=*(const u32x4*)(stg+row*64+ch*8); const u32x4 g=*(const u32x4*)(Gw+(long)row*DM+ch*8); u32x4 w;
      #pragma unroll
      for(int k=0;k<4;++k){ const float g0=__uint_as_float(g[k]<<16),g1=__uint_as_float(g[k]&0xffff0000u); const float v0=__uint_as_float(v[k]<<16),v1=__uint_as_float(v[k]&0xffff0000u);
        w[k]=cvtpk_s(v0*(g0/(1.0f+__expf(-g0))),v1*(g1/(1.0f+__expf(-g1)))); }
      ATTN_STORE16(Ow+(long)row*DMO+ch*8,w);} }
  asm volatile("s_waitcnt lgkmcnt(0)\n\ts_barrier":::"memory");
  #undef DMA_K
  #undef DMA_V
  #undef CMASK
  #undef START
  #undef RESC
  #undef ROT
}
constexpr int ATTN_LDS_BYTES=LDS_BYTES;
struct AttnTensors { const bf16* Q; const bf16* K; const bf16* V; bf16* O; const bf16* GT; const unsigned* MK; };
struct AttnUnit { int bh; int qb; };
struct StaticOrder {
  int wg,G;
  __device__ __forceinline__ explicit StaticOrder(int grid,int block):wg(block),G(grid){}
  __device__ __forceinline__ bool next(int i,AttnUnit&u)const{ const int p=wg+(i>>1)*G; if(p>=768)return false; const int s=p&15; u.bh=p>>4; u.qb=(i&1)?31-s:s; return true; }
  __device__ __forceinline__ void a_ready(const AttnUnit&)const{}
  __device__ __forceinline__ void done(const AttnUnit&)const{}
};
template<class Sched,int THRL=8> __device__ __forceinline__ void attn_phase(char*lds,const AttnTensors&T,lds_cfptr dl,const Sched&S,int tid){
  AttnUnit u;
  for(int i=0;S.next(i,u);++i){ asm volatile("":"+v"(tid)); S.a_ready(u); attn_unit<THRL>(u.bh/NHEAD,u.bh%NHEAD,u.qb,T.Q,T.K,T.V,T.O,T.GT,T.MK,dl,lds,tid); S.done(u); }
}
#undef SBAR
#undef WAIT_BAR
}

constexpr int NWAVES = 8, NTHR = 512;
constexpr int BATCH = 8, SEQ = 8192, DM = 1024, DEPTH = 4, M = BATCH * SEQ;
constexpr int IN_COLS = 3380, NP = 3584;
constexpr float EPS = 1e-6f;
constexpr int N_GQ = 0, N_GK = 192, N_GV = 384, N_GG = 768, N_DQ = 1152, N_DK = 1536, N_DV = 1920, N_DG = 2304, N_PU = 2688, N_PG = 2944, N_QI = 3200, N_KI = 3328, N_GZ = 3360, N_WI = 3376;
constexpr float LOG2E = 1.4426950408889634f;
constexpr size_t MiB = 1u << 20;
constexpr size_t WS_CTL = 0, CTL_ZERO_BYTES = 1 * MiB;
constexpr size_t WS_WIN = 2 * MiB;
constexpr size_t WS_WOUT = 32 * MiB;
constexpr size_t WS_XB = 48 * MiB;
constexpr size_t WS_P = 176 * MiB;
constexpr size_t WS_MASK = 624 * MiB;
constexpr size_t WS_GOP = 688 * MiB;
constexpr size_t WS_XA = 832 * MiB;
constexpr size_t WS_RSC = 44 * MiB;
constexpr size_t WS_RS = 40 * MiB;
constexpr size_t WS_ZW = 960 * MiB;
constexpr size_t WS_KC = 968 * MiB;
constexpr size_t WS_END = 972 * MiB;
constexpr int CW_BAR = 4096, CW_QUEUE = 8192;
constexpr int RING_BYTES = 131072, LDSCTL_OFF = RING_BYTES, MISC_OFF = LDSCTL_OFF + 320, LDS_BYTES = 147456;

#define GAS __attribute__((address_space(1)))
#define LAS __attribute__((address_space(3)))
typedef unsigned short bf16;
typedef unsigned v4u __attribute__((ext_vector_type(4)));
typedef unsigned v2u __attribute__((ext_vector_type(2)));
typedef float f32x4 __attribute__((ext_vector_type(4)));
typedef GAS unsigned gu32;
#define RLX_AGENT __ATOMIC_RELAXED, __HIP_MEMORY_SCOPE_AGENT
__device__ __forceinline__ unsigned f2bf(float f) { unsigned u = __builtin_bit_cast(unsigned, f); return (u + 0x7fffu + ((u >> 16) & 1u)) >> 16; }
__device__ __forceinline__ unsigned pk2(float lo, float hi) { return f2bf(lo) | (f2bf(hi) << 16); }
__device__ __forceinline__ float bf2f(unsigned short b) { return __builtin_bit_cast(float, (unsigned)b << 16); }
__device__ __forceinline__ float bflo(unsigned w) { return __builtin_bit_cast(float, w << 16); }
__device__ __forceinline__ float bfhi(unsigned w) { return __builtin_bit_cast(float, w & 0xffff0000u); }
__device__ __forceinline__ float shx(float v, int o, int lane) { return __builtin_bit_cast(float, __builtin_amdgcn_ds_bpermute((lane ^ o) << 2, __builtin_bit_cast(int, v))); }
__device__ __forceinline__ int shdn(int v, int o, int lane) { return __builtin_amdgcn_ds_bpermute(((lane + o) & 63) << 2, v); }
__device__ __forceinline__ float wave_sum(float v, int lane) {
#pragma unroll
    for (int o = 1; o < 64; o <<= 1) v += shx(v, o, lane);
    return v;
}
__device__ __forceinline__ float silu_f(float x) { return x / (1.0f + __expf(-x)); }

__constant__ unsigned char T5B[128] = {0, 1, 2, 3, 4, 5, 6, 7, 8, 9, 10, 11, 12, 13, 14, 15, 16, 16, 16, 17, 17, 18, 18, 18, 19, 19, 19, 20, 20, 20, 20, 21, 21, 21, 21, 22, 22, 22, 22, 22, 23, 23, 23, 23, 23, 23, 24, 24, 24, 24, 24, 24, 25, 25, 25, 25, 25, 25, 25, 26, 26, 26, 26, 26, 26, 26, 26, 27, 27, 27, 27, 27, 27, 27, 27, 27, 27, 28, 28, 28, 28, 28, 28, 28, 28, 28, 28, 29, 29, 29, 29, 29, 29, 29, 29, 29, 29, 29, 29, 30, 30, 30, 30, 30, 30, 30, 30, 30, 30, 30, 30, 30, 30, 31, 31, 31, 31, 31, 31, 31, 31, 31, 31, 31, 31, 31, 31, 31};
__device__ __forceinline__ int t5_bucket(int rel) { return rel >= 128 ? 31 : (int)T5B[rel]; }

#define XB_TMO      128
#define XB_XCNT(j)  (256  + 64 * (j))
#define XB_XSUB(j)  (1280 + 64 * (j))
#define XB_XGEN(j)  (2304 + 64 * (j))
#define XB_TOP      3328
#define XB_TOPGEN   3392
#define XCD_BAR_WORDS 3456
#define XB_SPIN_CAP (1u << 22)

__device__ __forceinline__ unsigned xb_ld(unsigned* p)              { return __hip_atomic_load(p, __ATOMIC_RELAXED, __HIP_MEMORY_SCOPE_AGENT); }
__device__ __forceinline__ unsigned xb_add(unsigned* p, unsigned v) { return __hip_atomic_fetch_add(p, v, __ATOMIC_RELAXED, __HIP_MEMORY_SCOPE_AGENT); }
__device__ __forceinline__ unsigned xb_xcc_id() { return (unsigned)__builtin_amdgcn_s_getreg((3 << 11) | 20) & 0xFu; }
#define XB_SPIN(cond, bar) do { unsigned _sp = 0; while (cond) { __builtin_amdgcn_s_sleep(1); \
    if ((++_sp & 255u) == 0u) { if (xb_ld(&(bar)[XB_TMO])) break; if (_sp > XB_SPIN_CAP) { atomicAdd(&(bar)[XB_TMO], 1u); break; } } } } while (0)

struct XcdBarrier {
    unsigned* bar; unsigned x;
    volatile LAS unsigned* st;
};

__device__ __forceinline__ XcdBarrier xcd_barrier_post(unsigned* bar, volatile LAS unsigned* st) {
    XcdBarrier b; b.bar = bar; b.x = xb_xcc_id(); b.st = st;
    if (threadIdx.x == 0) (void)xb_add(&bar[XB_XCNT(b.x)], 1u);
    return b;
}
__device__ __forceinline__ void xcd_barrier_complete(unsigned* bar, unsigned x, unsigned& nloc, unsigned& nx) {
    const unsigned G = gridDim.x * gridDim.y * gridDim.z;
    unsigned sum, cnt, mine, sp = 0u;
    for (;;) {
        sum = 0u; cnt = 0u; mine = 0u;
#pragma unroll
        for (unsigned j = 0; j < 16; ++j) { const unsigned c = xb_ld(&bar[XB_XCNT(j)]); sum += c; cnt += (c > 0u) ? 1u : 0u; mine = (j == x) ? c : mine; }
        if (sum == G) break;
        __builtin_amdgcn_s_sleep(1);
        if ((++sp & 255u) == 0u) { if (xb_ld(&bar[XB_TMO])) break; if (sp > XB_SPIN_CAP) { atomicAdd(&bar[XB_TMO], 1u); break; } }
    }
    nloc = mine > 0u ? mine : 1u; nx = cnt > 0u ? cnt : 1u;
}

__device__ __forceinline__ void xcd_barrier(const XcdBarrier& b) {
    asm volatile("s_waitcnt vmcnt(0)" ::: "memory");
    __syncthreads();
    if (threadIdx.x == 0) {
        unsigned* bar = b.bar;
        __builtin_amdgcn_s_waitcnt(0);
        unsigned nloc = b.st[0], nx = b.st[1];
        if (nloc == 0u) { xcd_barrier_complete(bar, b.x, nloc, nx); b.st[0] = nloc; b.st[1] = nx; }
        const unsigned old = xb_add(&bar[XB_XSUB(b.x)], 1u);
        const unsigned gen = old / nloc;
        if (old + 1u == (gen + 1u) * nloc) {
            __builtin_amdgcn_fence(__ATOMIC_RELEASE, "agent");
            asm volatile("s_waitcnt vmcnt(0)" ::: "memory");
            const unsigned og = xb_add(&bar[XB_TOP], 1u);
            const unsigned tg = og / nx;
            if (og + 1u == (tg + 1u) * nx) xb_add(&bar[XB_TOPGEN], 1u);
            else XB_SPIN(xb_ld(&bar[XB_TOPGEN]) == tg, bar);
            __builtin_amdgcn_fence(__ATOMIC_ACQUIRE, "agent");
            xb_add(&bar[XB_XGEN(b.x)], 1u);
            asm volatile("s_waitcnt vmcnt(0)" ::: "memory");
        } else {
            XB_SPIN(xb_ld(&bar[XB_XGEN(b.x)]) == gen, bar);
            __builtin_amdgcn_fence(__ATOMIC_ACQUIRE, "agent");
            asm volatile("s_waitcnt vmcnt(0)" ::: "memory");
        }
    }
    __syncthreads();
}
#ifndef IDX_NOFALLBACK
#define IDX_NOFALLBACK 0
#endif
#ifndef REP_RES
#define REP_RES 1
#endif
#ifndef REP_PATCH
#define REP_PATCH 1
#endif
#ifndef REP_P1
#define REP_P1 1
#endif
#ifndef REP_P3
#define REP_P3 1
#endif
#ifndef REP_HEAD
#define REP_HEAD 1
#endif
#ifndef REP_RES
#define REP_RES 1
#endif
#ifndef REP_P2
#define REP_P2 1
#endif
#ifndef REP_RANK
#define REP_RANK 1
#endif
#ifndef IDX_PRIO
#define IDX_PRIO 1
#endif
#ifndef IDX_PKFMA
#define IDX_PKFMA 0
#endif
#ifndef PROBE_MFMA2
#define PROBE_MFMA2 0
#endif
#ifndef PROBE_ADD2
#define PROBE_ADD2 0
#endif
#ifndef IDX_ASMFMA
#define IDX_ASMFMA 0
#endif
#ifndef IDX_ASMBIN
#define IDX_ASMBIN 0
#endif
namespace idxb {
typedef short bf16x8 __attribute__((ext_vector_type(8)));
typedef float f32x16 __attribute__((ext_vector_type(16)));
constexpr int ZBIN = 0, NBINS = 512, CAP = 256;
constexpr int L_HIST = 0, L_ZC = 65536, L_PAR = 81920, L_KBUF = 83968, L_XT = 116736;
enum { P_BSTAR = 0, P_KK, P_CCNT, P_TAU, P_CUT, P_MODE, P_TSTAR, P_RSTAR, P_OVF, P_NRANK, P_PRE, P_XL, P_XU, P_ANY3 };
__device__ __forceinline__ unsigned lds_add(unsigned* p, unsigned v) { return __hip_atomic_fetch_add((__attribute__((address_space(3))) unsigned*)p, v, __ATOMIC_RELAXED, __HIP_MEMORY_SCOPE_WORKGROUP); }
__device__ __forceinline__ int crow(int r, int hi) { return (r & 3) + 8 * (r >> 2) + 4 * hi; }
struct QFrag { bf16x8 q[4][2]; float w[4]; };
__device__ __forceinline__ f32x16 score_sub(const bf16x8 k0, const bf16x8 k1, const QFrag& Q) {
    f32x16 acc;
#pragma unroll
    for (int r = 0; r < 16; ++r) acc[r] = 0.f;
    const f32x16 zz = {0.f, 0.f, 0.f, 0.f, 0.f, 0.f, 0.f, 0.f, 0.f, 0.f, 0.f, 0.f, 0.f, 0.f, 0.f, 0.f};
    float INFV; asm("s_mov_b32 %0, 0x7f800000" : "=s"(INFV));
#pragma unroll
    for (int hp = 0; hp < 2; ++hp) {
        f32x16 d0 = __builtin_amdgcn_mfma_f32_32x32x16_bf16(k0, Q.q[2 * hp][0], zz, 0, 0, 0), d1 = __builtin_amdgcn_mfma_f32_32x32x16_bf16(k0, Q.q[2 * hp + 1][0], zz, 0, 0, 0);
        d0 = __builtin_amdgcn_mfma_f32_32x32x16_bf16(k1, Q.q[2 * hp][1], d0, 0, 0, 0); d1 = __builtin_amdgcn_mfma_f32_32x32x16_bf16(k1, Q.q[2 * hp + 1][1], d1, 0, 0, 0);
#if PROBE_MFMA2
        { f32x16 e0 = __builtin_amdgcn_mfma_f32_32x32x16_bf16(k0, Q.q[2 * hp][1], zz, 0, 0, 0); e0 = __builtin_amdgcn_mfma_f32_32x32x16_bf16(k1, Q.q[2 * hp][0], e0, 0, 0, 0);
          e0 = __builtin_amdgcn_mfma_f32_32x32x16_bf16(k0, Q.q[2 * hp + 1][1], e0, 0, 0, 0); e0 = __builtin_amdgcn_mfma_f32_32x32x16_bf16(k1, Q.q[2 * hp + 1][0], e0, 0, 0, 0); asm volatile("" :: "v"(e0)); }
#endif
#if IDX_PKFMA
        { typedef float f32x2 __attribute__((ext_vector_type(2)));
            const f32x2 wa = {Q.w[2 * hp], Q.w[2 * hp]}, wb = {Q.w[2 * hp + 1], Q.w[2 * hp + 1]};
#pragma unroll
            for (int r = 0; r < 16; r += 2) { const f32x2 ra = {__builtin_amdgcn_fmed3f(d0[r], 0.f, INFV), __builtin_amdgcn_fmed3f(d0[r + 1], 0.f, INFV)}, rb = {__builtin_amdgcn_fmed3f(d1[r], 0.f, INFV), __builtin_amdgcn_fmed3f(d1[r + 1], 0.f, INFV)};
                f32x2 ac = {acc[r], acc[r + 1]}; ac = __builtin_elementwise_fma(wa, ra, ac); ac = __builtin_elementwise_fma(wb, rb, ac); acc[r] = ac[0]; acc[r + 1] = ac[1]; } }
#else
#pragma unroll
        for (int r = 0; r < 16; ++r) {
#if IDX_ASMFMA
            const float r0 = __builtin_amdgcn_fmed3f(d0[r], 0.f, INFV), r1 = __builtin_amdgcn_fmed3f(d1[r], 0.f, INFV); float a0 = acc[r], a1;
            if (hp == 0) asm("v_mul_f32 %0, %1, %2" : "=v"(a0) : "v"(Q.w[0]), "v"(r0)); else asm("v_fma_f32 %0, %1, %2, %3" : "=v"(a0) : "v"(Q.w[2]), "v"(r0), "v"(acc[r]));
            asm("v_fma_f32 %0, %1, %2, %3" : "=v"(a1) : "v"(Q.w[2 * hp + 1]), "v"(r1), "v"(a0)); acc[r] = a1;
#else
            acc[r] = __builtin_fmaf(Q.w[2 * hp + 1], __builtin_amdgcn_fmed3f(d1[r], 0.f, INFV), __builtin_fmaf(Q.w[2 * hp], __builtin_amdgcn_fmed3f(d0[r], 0.f, INFV), acc[r]));
#endif
        }
#endif
    }
    return acc;
}
constexpr int G0 = (int)(0x3F800000u >> 18);
typedef __attribute__((address_space(3))) unsigned lds_u32;
__device__ __forceinline__ void hist_add(unsigned hb, float x, unsigned inc) {
    const float xc = __builtin_amdgcn_fmed3f(x, -254.0f, 254.0f);
#if IDX_ASMBIN
    float os, y; const unsigned m = 0x7fffffffu;
    asm("v_bfi_b32 %0, %1, 1.0, %2" : "=v"(os) : "s"(m), "v"(xc));
    asm("v_add_f32 %0, %1, %2" : "=v"(y) : "v"(xc), "v"(os));
    unsigned sh; asm("v_lshrrev_b32 %0, 18, %1" : "=v"(sh) : "v"(y));
    const unsigned a = hb + (sh << 2);
#else
    const float y = xc + __uint_as_float((__float_as_uint(xc) & 0x80000000u) | 0x3F800000u);
    const unsigned a = hb + ((__float_as_uint(y) >> 18) << 2);
#endif
    __hip_atomic_fetch_add((lds_u32*)a, inc, __ATOMIC_RELAXED, __HIP_MEMORY_SCOPE_WORKGROUP);
#if PROBE_ADD2
    __hip_atomic_fetch_add((lds_u32*)(a ^ 64u), 0u, __ATOMIC_RELAXED, __HIP_MEMORY_SCOPE_WORKGROUP);
#endif
}
__device__ __forceinline__ int hword(int q, int h) { return ((h >> 8) << 13) + q * 256 + (h & 255); }
__device__ __forceinline__ int rank_to_bin(int k) { return k < 256 ? 255 - k : k; }
__device__ __forceinline__ float xthr(int ot) { if (ot == 0) return 0.f;
    const unsigned B = (unsigned)(G0 + ot) << 18; unsigned hi = __float_as_uint(__uint_as_float(B) - 1.0f), lo = 0u;
#pragma unroll 1
    for (int i = 0; i < 32; ++i) { const unsigned mid = lo + ((hi - lo) >> 1); if (__float_as_uint(__uint_as_float(mid) + 1.0f) >= B) hi = mid; else lo = mid; }
    return __uint_as_float(hi); }
__device__ __forceinline__ unsigned wave_or(unsigned v) { int x = (int)v;
    x |= __builtin_amdgcn_update_dpp(0, x, 0x111, 0xf, 0xf, true); x |= __builtin_amdgcn_update_dpp(0, x, 0x112, 0xf, 0xf, true);
    x |= __builtin_amdgcn_update_dpp(0, x, 0x114, 0xf, 0xf, true); x |= __builtin_amdgcn_update_dpp(0, x, 0x118, 0xf, 0xf, true);
    x |= __builtin_amdgcn_update_dpp(0, x, 0x142, 0xf, 0xf, true); x |= __builtin_amdgcn_update_dpp(0, x, 0x143, 0xf, 0xf, true);
    return (unsigned)__builtin_amdgcn_readlane(x, 63); }
__device__ __forceinline__ float sel32(const f32x16& a, const f32x16& b, int e) {
    const bool b0 = e & 1, b1 = e & 2, b2 = e & 4, b3 = e & 8, b4 = e & 16;
    float v0 = a[0], v1 = a[1], v2 = a[2], v3 = a[3], v4 = a[4], v5 = a[5], v6 = a[6], v7 = a[7], v8 = a[8], v9 = a[9], v10 = a[10], v11 = a[11], v12 = a[12], v13 = a[13], v14 = a[14], v15 = a[15], v16 = b[0], v17 = b[1], v18 = b[2], v19 = b[3], v20 = b[4], v21 = b[5], v22 = b[6], v23 = b[7], v24 = b[8], v25 = b[9], v26 = b[10], v27 = b[11], v28 = b[12], v29 = b[13], v30 = b[14], v31 = b[15];
    asm("" : "+v"(v0)); asm("" : "+v"(v1)); asm("" : "+v"(v2)); asm("" : "+v"(v3)); asm("" : "+v"(v4)); asm("" : "+v"(v5)); asm("" : "+v"(v6)); asm("" : "+v"(v7)); asm("" : "+v"(v8)); asm("" : "+v"(v9)); asm("" : "+v"(v10)); asm("" : "+v"(v11)); asm("" : "+v"(v12)); asm("" : "+v"(v13)); asm("" : "+v"(v14)); asm("" : "+v"(v15)); asm("" : "+v"(v16)); asm("" : "+v"(v17)); asm("" : "+v"(v18)); asm("" : "+v"(v19)); asm("" : "+v"(v20)); asm("" : "+v"(v21)); asm("" : "+v"(v22)); asm("" : "+v"(v23)); asm("" : "+v"(v24)); asm("" : "+v"(v25)); asm("" : "+v"(v26)); asm("" : "+v"(v27)); asm("" : "+v"(v28)); asm("" : "+v"(v29)); asm("" : "+v"(v30)); asm("" : "+v"(v31));
    const float p0 = b0 ? v1 : v0, p1 = b0 ? v3 : v2, p2 = b0 ? v5 : v4, p3 = b0 ? v7 : v6, p4 = b0 ? v9 : v8, p5 = b0 ? v11 : v10, p6 = b0 ? v13 : v12, p7 = b0 ? v15 : v14, p8 = b0 ? v17 : v16, p9 = b0 ? v19 : v18, p10 = b0 ? v21 : v20, p11 = b0 ? v23 : v22, p12 = b0 ? v25 : v24, p13 = b0 ? v27 : v26, p14 = b0 ? v29 : v28, p15 = b0 ? v31 : v30;
    const float q0 = b1 ? p1 : p0, q1 = b1 ? p3 : p2, q2 = b1 ? p5 : p4, q3 = b1 ? p7 : p6, q4 = b1 ? p9 : p8, q5 = b1 ? p11 : p10, q6 = b1 ? p13 : p12, q7 = b1 ? p15 : p14;
    const float r0 = b2 ? q1 : q0, r1 = b2 ? q3 : q2, r2 = b2 ? q5 : q4, r3 = b2 ? q7 : q6;
    const float s0 = b3 ? r1 : r0, s1 = b3 ? r3 : r2;
    return b4 ? s1 : s0; }
__device__ __forceinline__ unsigned spread_nib(unsigned x) { x = (x | (x << 8)) & 0x00FF00FFu; return (x | (x << 4)) & 0x0F0F0F0Fu; }


template <int HP, int MODE, bool NEXT>
__device__ __forceinline__ void pstage(f32x16& acc, const f32x16& dc0, const f32x16& dc1, f32x16& dn0, f32x16& dn1, const bf16x8 ka, const bf16x8 kb,
                                       const bf16x8 qa0, const bf16x8 qa1, const bf16x8 qb0, const bf16x8 qb1, const float wA, const float wB,
                                       const unsigned hb, const unsigned inc, const int s0, const int t, const int hi, const float XU, const float XL, unsigned& wn, unsigned& wl) {
    const f32x16 zz = {0.f, 0.f, 0.f, 0.f, 0.f, 0.f, 0.f, 0.f, 0.f, 0.f, 0.f, 0.f, 0.f, 0.f, 0.f, 0.f};
    float INFV; asm("s_mov_b32 %0, 0x7f800000" : "=s"(INFV));
#pragma unroll
    for (int c = 3; c >= 0; --c) {
        if (NEXT) {
            if (c == 3) dn0 = __builtin_amdgcn_mfma_f32_32x32x16_bf16(ka, qa0, zz, 0, 0, 0);
            else if (c == 2) dn1 = __builtin_amdgcn_mfma_f32_32x32x16_bf16(ka, qb0, zz, 0, 0, 0);
            else if (c == 1) dn0 = __builtin_amdgcn_mfma_f32_32x32x16_bf16(kb, qa1, dn0, 0, 0, 0);
            else dn1 = __builtin_amdgcn_mfma_f32_32x32x16_bf16(kb, qb1, dn1, 0, 0, 0);
            __builtin_amdgcn_sched_barrier(0);
        }
#pragma unroll
        for (int r = 4 * c + 3; r >= 4 * c; --r) {
            const float r0 = __builtin_amdgcn_fmed3f(dc0[r], 0.f, INFV), r1 = __builtin_amdgcn_fmed3f(dc1[r], 0.f, INFV);
            float x = __builtin_fmaf(wB, r1, __builtin_fmaf(wA, r0, HP == 0 ? 0.f : acc[r]));
            if (MODE == 4) { if (s0 + crow(r, hi) > t) x = -__builtin_inff(); }
            acc[r] = x;
            if (MODE == 1) hist_add(hb, x, inc);
            if (MODE == 2) { if (s0 + crow(r, hi) <= t) hist_add(hb, x, inc); }
            if (MODE == 3 || MODE == 4) { const float t1 = x - XU, t2 = x - XL; wn = __builtin_amdgcn_alignbit(wn, __float_as_uint(t1), 31); wl = __builtin_amdgcn_alignbit(wl, __float_as_uint(t2), 31); }
        }
        if (NEXT) __builtin_amdgcn_sched_barrier(0);
    }
}
__device__ __forceinline__ void index_unit(const unsigned short* P, const unsigned short* KC, unsigned* MK, unsigned* ZWg, unsigned char* lds, int b, int qt, int tid) {
    const int lane = tid & 63, wave = __builtin_amdgcn_readfirstlane(tid >> 6), r32 = lane & 31, hi = lane >> 5;
    unsigned* hist32 = (unsigned*)(lds + L_HIST); unsigned* cand_s = (unsigned*)(lds + L_HIST); unsigned* cand_i = (unsigned*)(lds + L_HIST + 32768);     unsigned* zc = (unsigned*)(lds + L_ZC); int* par = (int*)(lds + L_PAR);
    const int t = qt * 32 + r32; const size_t qrow = (size_t)b * SEQ + t;
    const int kt_max = (qt * 32 + 31) >> 6, NTW = ((qt >> 3) + 1) * 4;
    const unsigned short* KI = KC + (size_t)b * SEQ * 32;
    QFrag Q; float invw;
    for (int rh_ = 0; rh_ < REP_HEAD; ++rh_) { asm volatile("" ::: "memory");
    { const unsigned short* qp = P + qrow * NP + N_QI + hi * 8; float var = 0.f;
#pragma unroll
        for (int h = 0; h < 4; ++h) { float s = 0.f;
#pragma unroll
            for (int ks = 0; ks < 2; ++ks) { Q.q[h][ks] = *(const bf16x8*)(qp + h * 32 + ks * 16);
#pragma unroll
                for (int j = 0; j < 8; ++j) { const float v = bf2f((unsigned short)Q.q[h][ks][j]); s += v * v; } }
            s += shx(s, 32, lane); Q.w[h] = bf2f(P[qrow * NP + N_WI + h]); var += Q.w[h] * Q.w[h] * s; }
        invw = 82.7f / sqrtf(var > 1e-20f ? var : 1e-20f);
#pragma unroll
        for (int h = 0; h < 4; ++h) Q.w[h] *= invw; }
    __syncthreads();
    { typedef unsigned u32x4z __attribute__((ext_vector_type(4))); for (int i = tid; i < (L_PAR + 2048) / 16; i += NTHR) ((__attribute__((address_space(3))) u32x4z*)lds)[i] = (u32x4z){0u, 0u, 0u, 0u}; }
    __syncthreads(); }
    __attribute__((address_space(3))) unsigned char* kbuf = (__attribute__((address_space(3))) unsigned char*)lds + L_KBUF + wave * 4096;
#define IDX_KISSUE(kt_) do { const unsigned short* kp_ = KI + (size_t)(kt_) * 2048 + lane * 8;        \
        __builtin_amdgcn_global_load_lds((const unsigned*)kp_, (__attribute__((address_space(3))) unsigned*)kbuf, 16, 0, 0); \
        __builtin_amdgcn_global_load_lds((const unsigned*)(kp_ + 512), (__attribute__((address_space(3))) unsigned*)(kbuf + 1024), 16, 0, 0); \
        __builtin_amdgcn_global_load_lds((const unsigned*)(kp_ + 1024), (__attribute__((address_space(3))) unsigned*)(kbuf + 2048), 16, 0, 0); \
        __builtin_amdgcn_global_load_lds((const unsigned*)(kp_ + 1536), (__attribute__((address_space(3))) unsigned*)(kbuf + 3072), 16, 0, 0); } while (0)
#define IDX_KREAD(dst) do { const int ko_ = r32 * 64 + hi * 16;                                     \
        dst[0] = *(__attribute__((address_space(3))) bf16x8*)(kbuf + ko_); dst[1] = *(__attribute__((address_space(3))) bf16x8*)(kbuf + ko_ + 32); \
        dst[2] = *(__attribute__((address_space(3))) bf16x8*)(kbuf + ko_ + 2048); dst[3] = *(__attribute__((address_space(3))) bf16x8*)(kbuf + ko_ + 2080); } while (0)
#define IDX_KTAKE(dst, cnt_) do { asm volatile("s_waitcnt vmcnt(" cnt_ ")" ::: "memory"); IDX_KREAD(dst); asm volatile("s_waitcnt lgkmcnt(0)" ::: "memory"); } while (0)
    const unsigned hb = (unsigned)(size_t)((__attribute__((address_space(3))) unsigned char*)lds) + L_HIST + r32 * 1024 - 4 * G0;
#if IDX_PRIO
    if (wave >= 4) __builtin_amdgcn_s_setprio(1);
#endif
    const int qlo = qt * 32;
#define IDX_PRO(dA, dB) do { const f32x16 zz_ = {0.f, 0.f, 0.f, 0.f, 0.f, 0.f, 0.f, 0.f, 0.f, 0.f, 0.f, 0.f, 0.f, 0.f, 0.f, 0.f}; \
        dA = __builtin_amdgcn_mfma_f32_32x32x16_bf16(kc[0], Q.q[0][0], zz_, 0, 0, 0); dB = __builtin_amdgcn_mfma_f32_32x32x16_bf16(kc[0], Q.q[1][0], zz_, 0, 0, 0); \
        dA = __builtin_amdgcn_mfma_f32_32x32x16_bf16(kc[1], Q.q[0][1], dA, 0, 0, 0); dB = __builtin_amdgcn_mfma_f32_32x32x16_bf16(kc[1], Q.q[1][1], dB, 0, 0, 0); } while (0)
#define IDX_QHI Q.q[2][0], Q.q[2][1], Q.q[3][0], Q.q[3][1]
#define IDX_QLO Q.q[0][0], Q.q[0][1], Q.q[1][0], Q.q[1][1]
    for (int rp1 = 0; rp1 < REP_P1; ++rp1) { bf16x8 kc[4]; const unsigned inc1 = (rp1 & 1) ? 0xffffffffu : 1u; if (wave <= kt_max) IDX_KISSUE(wave);
      for (int kt = wave; kt <= kt_max; kt += 8) {
        IDX_KTAKE(kc, "0"); if (kt + 8 <= kt_max) IDX_KISSUE(kt + 8);
        if (kt * 64 + 63 <= qlo) {
#pragma unroll
            for (int sub = 0; sub < 2; ++sub) { const f32x16 sc = score_sub(kc[2 * sub], kc[2 * sub + 1], Q);
#pragma unroll
                for (int r = 0; r < 16; ++r) hist_add(hb, sc[r], inc1); }
        } else {
#pragma unroll
            for (int sub = 0; sub < 2; ++sub) { const f32x16 sc = score_sub(kc[2 * sub], kc[2 * sub + 1], Q); const int s0 = kt * 64 + sub * 32;
#pragma unroll
                for (int r = 0; r < 16; ++r) { if (s0 + crow(r, hi) <= t) hist_add(hb, sc[r], inc1); } }
        }
      } }
    __syncthreads();
    for (int rr_ = 0; rr_ < REP_RES; ++rr_) { __syncthreads(); asm volatile("" ::: "memory");
    { typedef unsigned u32x4r __attribute__((ext_vector_type(4)));
        const int q = tid >> 4, j = tid & 15, N = qt * 32 + q + 1; const bool neg = j >= 8;
        const unsigned* hs = hist32 + (neg ? 8192 + q * 256 + 32 * (j - 8) : q * 256 + 224 - 32 * j); int c = 0;
#pragma unroll
        for (int u = 0; u < 8; ++u) { const u32x4r v = *(const u32x4r*)(hs + 4 * ((u + (j >> 1)) & 7)); c += (int)(v[0] + v[1] + v[2] + v[3]); }
        int incl = c;
#pragma unroll
        for (int o = 1; o < 16; o <<= 1) { const int v = __builtin_amdgcn_ds_bpermute(((lane - o) & 63) << 2, incl); if (j >= o) incl += v; }
        const int excl = incl - c;
        if (N <= 256) { if (j == 0) par[P_MODE * 32 + q] = 0; }
        else if (excl < 256 && 256 <= incl) { u32x4r w[8];
#pragma unroll
            for (int u = 0; u < 8; ++u) w[u] = *(const u32x4r*)(hs + 4 * u);
            int above = excl, isel = -1, cntb = 0, ab = 0;
#pragma unroll
            for (int i = 0; i < 32; ++i) { const int cb = (int)(neg ? w[i >> 2][i & 3] : w[(31 - i) >> 2][(31 - i) & 3]); if (isel < 0 && above + cb >= 256) { isel = i; cntb = cb; ab = above; } above += cb; }
            const int bsel = rank_to_bin(32 * j + isel), ot = bsel & 255; const float* XT = (const float*)(lds + L_XT);
            par[P_BSTAR * 32 + q] = bsel; par[P_KK * 32 + q] = 256 - ab; par[P_MODE * 32 + q] = (bsel != 0 && cntb > CAP) ? 3 : 1; if (bsel != 0 && cntb > CAP) par[P_ANY3 * 32] = 1;
            const float xa = XT[ot], xb = XT[ot + 1];
            const float XL = neg ? -__uint_as_float(__float_as_uint(xb) - 1u) : xa;
            const float XU = neg ? (xa > 0.f ? -__uint_as_float(__float_as_uint(xa) - 1u) : 0.f) : xb;
            par[P_XL * 32 + q] = (int)__float_as_uint(XL); par[P_XU * 32 + q] = (int)__float_as_uint(XU); }
    } }
    __syncthreads();
    const int my_mode = par[P_MODE * 32 + r32], my_b = par[P_BSTAR * 32 + r32];
    __syncthreads();
    float XL = __uint_as_float((unsigned)par[P_XL * 32 + r32]), XU = __uint_as_float((unsigned)par[P_XU * 32 + r32]);
    if (my_mode == 0) { XL = -3.0e38f; XU = -3.0e38f; }
    if (my_mode == 3) { XL = __builtin_inff(); XU = __builtin_inff(); }
    const bool central = (my_mode == 1 && my_b == 0);
    unsigned* ZW = ZWg;
    for (int r2_ = 0; r2_ < REP_P2; ++r2_) { if (r2_) { __syncthreads(); for (int i = tid; i < 32 * 128; i += NTHR) zc[i] = 0u; if (tid < 32) { par[P_CCNT * 32 + tid] = 0; par[P_OVF * 32 + tid] = 0; } __syncthreads(); }
    { bf16x8 kc[4]; if (wave <= kt_max) IDX_KISSUE(wave);
      for (int kt = wave; kt < NTW; kt += 8) {
        unsigned word = 0u, wz = 0u;
        if (kt <= kt_max) {
            if (kt == wave) { IDX_KTAKE(kc, "0"); } else { IDX_KTAKE(kc, "2"); }
            if (kt + 8 <= kt_max) IDX_KISSUE(kt + 8);
            asm volatile("" ::: "memory");
            f32x16 s0v = score_sub(kc[0], kc[1], Q), s1v = score_sub(kc[2], kc[3], Q);
            const bool diag = kt * 64 + 63 > qlo;
            if (diag) {
#pragma unroll
                for (int r = 0; r < 16; ++r) { const int s = kt * 64 + crow(r, hi); if (s > t) s0v[r] = -__builtin_inff(); if (s + 32 > t) s1v[r] = -__builtin_inff(); } }
            unsigned wn = 0u, wl = 0u;
#pragma unroll
            for (int e = 31; e >= 0; --e) { const float x = (e < 16) ? s0v[e & 15] : s1v[e & 15]; float t1, t2;
#if IDX_ASMBIN
                asm("v_sub_f32 %0, %1, %2" : "=v"(t1) : "v"(x), "v"(XU)); asm("v_sub_f32 %0, %1, %2" : "=v"(t2) : "v"(x), "v"(XL));
#else
                t1 = x - XU; t2 = x - XL;
#endif
                wn = __builtin_amdgcn_alignbit(wn, __float_as_uint(t1), 31); wl = __builtin_amdgcn_alignbit(wl, __float_as_uint(t2), 31); }
            word = ~wn; const unsigned inb = wn & ~wl;
            if ((REP_P2 == 1 || r2_ > 0) && __any(inb != 0u)) {
                unsigned zb = 0u;
                if (__any(central && inb != 0u)) { unsigned UZ = wave_or(central ? inb : 0u);
                    while (UZ) { const int e = __builtin_ctz(UZ); UZ &= UZ - 1u; const float x = (e < 16) ? s0v[e & 15] : s1v[e & 15];
                        if (central && ((inb >> e) & 1u) && x == 0.f) zb |= (1u << e); }
                    if (zb) lds_add(&zc[r32 * 128 + kt], (unsigned)__builtin_popcount(zb)); wz = zb; }
                const unsigned cb = inb & ~zb; const int cnt = __builtin_popcount(cb); int pos = 0;
                if (cnt) { pos = (int)lds_add((unsigned*)&par[P_CCNT * 32 + r32], (unsigned)cnt); if (pos + cnt > CAP) par[P_OVF * 32 + r32] = 1; }
                unsigned m = cb; int slot = pos;
                while (__any(m != 0u)) { const int e = (int)__builtin_ctz(m | 0x80000000u); const float x = sel32(s0v, s1v, e);
                    if (m != 0u && slot < CAP) { cand_s[r32 * CAP + slot] = __float_as_uint(x); cand_i[r32 * CAP + slot] = (unsigned)(kt * 64 + 32 * (e >> 4) + ((e & 3) + 8 * ((e & 15) >> 2) + 4 * hi)); }
                    m &= m - 1u; ++slot; }
            }
        }
        MK[((size_t)(b * 256 + qt) * 128 + kt) * 64 + lane] = word; ZW[kt * 64 + lane] = wz;
      } } }
#if IDX_PRIO
    __builtin_amdgcn_s_setprio(0);
#endif
    asm volatile("s_waitcnt vmcnt(0)" ::: "memory");
    __syncthreads();
    for (int rk_ = 0; rk_ < REP_RANK; ++rk_) { if (rk_) __syncthreads(); asm volatile("" ::: "memory");
    { const int q = tid >> 4, j = tid & 15, mode = par[P_MODE * 32 + q], kk = par[P_KK * 32 + q], bq = par[P_BSTAR * 32 + q];
        const int n = par[P_CCNT * 32 + q] < CAP ? par[P_CCNT * 32 + q] : CAP, n4 = (n + 3) & ~3;
        if (mode == 1 && par[P_OVF * 32 + q]) { if (j == 0) { par[P_MODE * 32 + q] = 3; par[P_ANY3 * 32] = 1; } }
        else if (mode == 1 && kk <= n) {
            if (j < n4 - n) { cand_s[q * CAP + n + j] = 0xFF800000u; cand_i[q * CAP + n + j] = 0xFFFFFFFFu; }
            if (j == 0) { par[P_NRANK * 32 + q] = n; par[P_TSTAR * 32 + q] = -1; } }
        else if (mode == 1 && bq == 0) {
            const int need = kk - n; int zl[8], c = 0;
#pragma unroll
            for (int u = 0; u < 8; ++u) { zl[u] = (int)zc[q * 128 + 8 * j + u]; c += zl[u]; }
            int incl = c;
#pragma unroll
            for (int o = 1; o < 16; o <<= 1) { const int v = __builtin_amdgcn_ds_bpermute(((lane - o) & 63) << 2, incl); if (j >= o) incl += v; }
            int cum = incl - c;
            if (j == 0) { par[P_TAU * 32 + q] = (int)0xFF800000u; par[P_CUT * 32 + q] = -1; }
            if (cum < need && need <= incl) { int ts = 8 * j + 7, rs = 1; bool done = false;
#pragma unroll
                for (int u = 0; u < 8; ++u) { if (!done && cum + zl[u] >= need) { ts = 8 * j + u; rs = need - cum; done = true; } cum += zl[u]; }
                par[P_TSTAR * 32 + q] = ts; par[P_RSTAR * 32 + q] = rs; } }
        else if (mode == 1) { if (j == 0) { par[P_MODE * 32 + q] = 3; par[P_ANY3 * 32] = 1; } }
    }
    __syncthreads();
    if (tid < 64) { const int q = lane & 31; int incl = par[P_NRANK * 32 + q];
#pragma unroll
        for (int o = 1; o < 32; o <<= 1) { const int v = __builtin_amdgcn_ds_bpermute(((lane - o) & 63) << 2, incl); if (q >= o) incl += v; }
        if (lane < 32) par[P_PRE * 32 + q] = incl; }
    __syncthreads();
    { typedef unsigned u32x4v __attribute__((ext_vector_type(4)));
        const int total = par[P_PRE * 32 + 31];
        for (int g = tid; g < total; g += NTHR) {
            int q = 0;
#pragma unroll
            for (int st = 16; st >= 1; st >>= 1) { if (par[P_PRE * 32 + q + st - 1] <= g) q += st; }
            const int i = g - (q ? par[P_PRE * 32 + q - 1] : 0), n = par[P_NRANK * 32 + q], n4 = (n + 3) & ~3, kk = par[P_KK * 32 + q];
            const unsigned cix = cand_s[q * CAP + i], ciy = cand_i[q * CAP + i]; const float si = __uint_as_float(cix); int rank = 0;
#pragma unroll 2
            for (int m2 = 0; m2 < n4; m2 += 4) { const u32x4v sv = *(const u32x4v*)&cand_s[q * CAP + m2], iv = *(const u32x4v*)&cand_i[q * CAP + m2];
#pragma unroll
                for (int u = 0; u < 4; ++u) { const float sm = __uint_as_float(sv[u]); rank += (sm > si || (sm == si && iv[u] < ciy)) ? 1 : 0; } }
            if (rank == kk - 1) { par[P_TAU * 32 + q] = (int)cix; par[P_CUT * 32 + q] = (int)ciy; } } }
    __syncthreads(); }
    for (int rpp = 0; rpp < REP_PATCH; ++rpp)
    { const int q = tid >> 4, j = tid & 15, mode = par[P_MODE * 32 + q];
        if (mode == 1) { const int n = par[P_CCNT * 32 + q]; const float tau = __uint_as_float((unsigned)par[P_TAU * 32 + q]); const unsigned cut = (unsigned)par[P_CUT * 32 + q]; const int ts = par[P_TSTAR * 32 + q], rs = par[P_RSTAR * 32 + q];
            unsigned* mq = MK + (size_t)(b * 256 + qt) * 128 * 64 + q;
#pragma unroll 1
            for (int i = j; i < n; i += 16) { const float sc = __uint_as_float(cand_s[q * CAP + i]); const unsigned s = cand_i[q * CAP + i];
                if (sc > tau || (sc == tau && s <= cut)) { const int kap = s & 63, k5 = kap & 31, hh = (k5 >> 2) & 1, e = (k5 & 3) + 4 * (k5 >> 3) + 16 * (kap >> 5);
                    __hip_atomic_fetch_or(mq + (s >> 6) * 64 + 32 * hh, 1u << e, __ATOMIC_RELAXED, __HIP_MEMORY_SCOPE_AGENT); } }
            if (ts >= 0) {
                unsigned zw0[8], zw1[8];
#pragma unroll
                for (int u = 0; u < 8; ++u) { const int kt = j + 16 * u; zw0[u] = 0u; zw1[u] = 0u; if (kt <= ts) { zw0[u] = __hip_atomic_load(ZW + kt * 64 + q, __ATOMIC_RELAXED, __HIP_MEMORY_SCOPE_AGENT); zw1[u] = __hip_atomic_load(ZW + kt * 64 + 32 + q, __ATOMIC_RELAXED, __HIP_MEMORY_SCOPE_AGENT); } }
#pragma unroll
                for (int u = 0; u < 8; ++u) { const int kt = j + 16 * u; if (kt <= ts) { const unsigned w0 = zw0[u], w1 = zw1[u]; unsigned a0 = w0, a1 = w1;
                    if (kt == ts) { const unsigned lo32 = spread_nib(w0 & 0xffffu) | (spread_nib(w1 & 0xffffu) << 4), hi32 = spread_nib(w0 >> 16) | (spread_nib(w1 >> 16) << 4);
                        const unsigned long long ord = (unsigned long long)lo32 | ((unsigned long long)hi32 << 32);
                        int nn = rs, kap = 0; unsigned w = (unsigned)ord; int c = __builtin_popcount(w);
                        if (nn > c) { nn -= c; w = (unsigned)(ord >> 32); kap = 32; }
                        c = __builtin_popcount(w & 0xffffu); if (nn > c) { nn -= c; w >>= 16; kap += 16; }
                        c = __builtin_popcount(w & 0xffu); if (nn > c) { nn -= c; w >>= 8; kap += 8; }
                        c = __builtin_popcount(w & 0xfu); if (nn > c) { nn -= c; w >>= 4; kap += 4; }
                        c = __builtin_popcount(w & 0x3u); if (nn > c) { nn -= c; w >>= 2; kap += 2; }
                        c = (int)(w & 1u); if (nn > c) kap += 1;
                        unsigned k0 = 0u, k1 = 0u;
#pragma unroll
                        for (int e = 0; e < 32; ++e) { const int pos0 = 32 * (e >> 4) + crow(e & 15, 0), pos1 = 32 * (e >> 4) + crow(e & 15, 1); if (pos0 <= kap) k0 |= (1u << e); if (pos1 <= kap) k1 |= (1u << e); }
                        a0 &= k0; a1 &= k1; }
                    if (a0) __hip_atomic_fetch_or(mq + kt * 64, a0, __ATOMIC_RELAXED, __HIP_MEMORY_SCOPE_AGENT);
                    if (a1) __hip_atomic_fetch_or(mq + kt * 64 + 32, a1, __ATOMIC_RELAXED, __HIP_MEMORY_SCOPE_AGENT); } } }
        }
    }
    __syncthreads();
}
#undef IDX_KISSUE
#undef IDX_KTAKE
#undef IDX_KREAD
}
namespace glab {
typedef short bf16x8 __attribute__((ext_vector_type(8)));
typedef short s16x4 __attribute__((ext_vector_type(4)));
typedef float f32x16 __attribute__((ext_vector_type(16)));
typedef float f32x4 __attribute__((ext_vector_type(4)));
typedef unsigned u32x4 __attribute__((ext_vector_type(4)));
typedef unsigned u32x2 __attribute__((ext_vector_type(2)));
typedef float f32x2_t __attribute__((ext_vector_type(2))); typedef __bf16 bf16x2_t __attribute__((ext_vector_type(2)));
#define GLAS __attribute__((address_space(3)))
constexpr int RAW_Q = 0, RAW_K = 6144, RAW_V = 12288, RAW_Z = 24576, OP_QE = 26624, OP_KE = 33792, OP_KDT = 40960, OP_VT = 47872, OP_DEC = 61696, OP_BLK_BYTES = 35328  ,
              OP_BLK1 = 61952  , OP_ST = 97280, ST_BYTES = 10752;
__device__ __forceinline__ unsigned cvtpk(float lo, float hi) { f32x2_t v = {lo, hi}; bf16x2_t b = __builtin_convertvector(v, bf16x2_t); return __builtin_bit_cast(unsigned, b); }
__device__ __forceinline__ int crow(int r, int hi) { return (r & 3) + 8 * (r >> 2) + 4 * hi; }
__device__ __forceinline__ float bfl(unsigned short b) { return __uint_as_float((unsigned)b << 16); }


__device__ __forceinline__ void gla_prep_item(const unsigned short* P, unsigned char* GOP, const float* w2, const float* gb, unsigned char* ldsg, int item, int tid) {
    GLAS unsigned char* lds = (GLAS unsigned char*)ldsg;
    const int lane = tid & 63; const int b = item >> 9, h = (item >> 7) & 3, n = item & 127;
    const size_t m0 = (size_t)b * SEQ + (size_t)n * 64;
    __syncthreads();
#define GLA_PCOL(c) (((c) < 6) ? (N_GQ + h * 48 + (c) * 8) : ((c) < 12) ? (N_GK + h * 48 + ((c) - 6) * 8) : ((c) < 24) ? (N_GV + h * 96 + ((c) - 12) * 8) : (N_GZ + ((c) - 24) * 8))
#define GLA_PDST(row, c) (((c) < 6) ? (RAW_Q + (row) * 96 + (c) * 16) : ((c) < 12) ? (RAW_K + (row) * 96 + ((c) - 6) * 16) : ((c) < 24) ? (RAW_V + (row) * 192 + ((c) - 12) * 16) : (RAW_Z + (row) * 32 + ((c) - 24) * 16))
#pragma unroll
    for (int k = 0; k < 4; ++k) { const int p = tid + 512 * k; if (p < 1664) { const int row = p / 26, c = p % 26; *(GLAS u32x4*)(lds + GLA_PDST(row, c)) = *(const u32x4*)(P + (m0 + row) * NP + GLA_PCOL(c)); } }
    __syncthreads();
    const int sd = tid >> 3, tg = tid & 7;
    if (tid < 384) {
            float c[8], w2c[16]; const float bc = gb[h * 48 + sd];
#pragma unroll
            for (int r = 0; r < 16; ++r) w2c[r] = w2[(size_t)r * 192 + h * 48 + sd];
#pragma unroll
            for (int tt = 0; tt < 8; ++tt) { const int t = 8 * tg + tt; const u32x4 z0 = *(GLAS u32x4*)(lds + RAW_Z + t * 32), z1 = *(GLAS u32x4*)(lds + RAW_Z + t * 32 + 16); float z = bc;
#pragma unroll
                for (int k = 0; k < 4; ++k) { z += w2c[2 * k] * __uint_as_float(z0[k] << 16) + w2c[2 * k + 1] * __uint_as_float(z0[k] & 0xffff0000u); z += w2c[8 + 2 * k] * __uint_as_float(z1[k] << 16) + w2c[8 + 2 * k + 1] * __uint_as_float(z1[k] & 0xffff0000u); }
                const float ls = fminf(z, 0.f) - __logf(1.0f + __expf(-fabsf(z)));
                c[tt] = ls * (1.0f / 16.0f) + (tt ? c[tt - 1] : 0.f); }
            float incl = c[7];
#pragma unroll
            for (int o = 1; o < 8; o <<= 1) { const float v = __builtin_bit_cast(float, __builtin_amdgcn_ds_bpermute(((lane - o) & 63) << 2, __builtin_bit_cast(int, incl))); if (tg >= o) incl += v; }
            const float off = incl - c[7];
            const float bl = __builtin_bit_cast(float, __builtin_amdgcn_ds_bpermute((lane | 7) << 2, __builtin_bit_cast(int, incl)));
            unsigned kdp[4];
#pragma unroll
            for (int tt = 0; tt < 8; tt += 2) { float kdv[2];
#pragma unroll
                for (int u = 0; u < 2; ++u) { const int t = 8 * tg + tt + u; const float bb = off + c[tt + u];
                    const float q = bfl(*(GLAS unsigned short*)(lds + RAW_Q + (t * 48 + sd) * 2)), kx = bfl(*(GLAS unsigned short*)(lds + RAW_K + (t * 48 + sd) * 2));
                    const float e1 = __expf(bb), e2 = __expf(-bb), e3 = __expf(bl - bb);
                    *(GLAS unsigned short*)(lds + OP_QE + (t * 56 + sd) * 2) = (unsigned short)(cvtpk(q * e1, 0.f) & 0xffffu);
                    *(GLAS unsigned short*)(lds + OP_KE + (t * 56 + sd) * 2) = (unsigned short)(cvtpk(kx * e2, 0.f) & 0xffffu);
                    kdv[u] = kx * e3; }
                kdp[tt >> 1] = cvtpk(kdv[0], kdv[1]); }
            *(GLAS u32x4*)(lds + OP_KDT + (sd * 72 + 8 * tg) * 2) = (u32x4){kdp[0], kdp[1], kdp[2], kdp[3]};
            if (tg == 7) ((GLAS float*)(lds + OP_DEC))[sd] = __expf(bl);
    } else {
            for (int idx = tid - 384; idx < 96 * 8; idx += 128) { const int v = idx % 96, t8 = idx / 96; unsigned pk[4];
#pragma unroll
                for (int tt = 0; tt < 8; tt += 2) { const unsigned a0 = *(GLAS unsigned short*)(lds + RAW_V + ((8 * t8 + tt) * 96 + v) * 2), a1 = *(GLAS unsigned short*)(lds + RAW_V + ((8 * t8 + tt + 1) * 96 + v) * 2); pk[tt >> 1] = a0 | (a1 << 16); }
                *(GLAS u32x4*)(lds + OP_VT + (v * 72 + 8 * t8) * 2) = (u32x4){pk[0], pk[1], pk[2], pk[3]}; }
    }
    __syncthreads();
    unsigned char* dst = GOP + (size_t)item * OP_BLK_BYTES;
    for (int i = tid; i < (OP_DEC + 192 - OP_QE) / 16; i += NTHR) *(u32x4*)(dst + i * 16) = *(GLAS u32x4*)(lds + OP_QE + i * 16);
}
__device__ __forceinline__ void gla_prep_loop(const unsigned short* P, unsigned char* GOP, const float* w2, const float* gb, unsigned char* ldsg, int wg, int G, int tid) {
    GLAS unsigned char* lds = (GLAS unsigned char*)ldsg;
    const int lane = tid & 63;
#define GLA_PCOLH(c, hh) (((c) < 6) ? (N_GQ + (hh) * 48 + (c) * 8) : ((c) < 12) ? (N_GK + (hh) * 48 + ((c) - 6) * 8) : ((c) < 24) ? (N_GV + (hh) * 96 + ((c) - 12) * 8) : (N_GZ + ((c) - 24) * 8))
#define GLA_PDST(row, c) (((c) < 6) ? (RAW_Q + (row) * 96 + (c) * 16) : ((c) < 12) ? (RAW_K + (row) * 96 + ((c) - 6) * 16) : ((c) < 24) ? (RAW_V + (row) * 192 + ((c) - 12) * 16) : (RAW_Z + (row) * 32 + ((c) - 24) * 16))
#define GLA_FETCH(it_) do { const int b_ = (it_) >> 9, h_ = ((it_) >> 7) & 3, n_ = (it_) & 127; const size_t mr_ = (size_t)b_ * SEQ + (size_t)n_ * 64; \
        _Pragma("unroll") for (int k = 0; k < 4; ++k) { const int p = tid + 512 * k; if (p < 1664) { const int row = p / 26, c = p % 26; rawr[k] = *(const u32x4*)(P + (mr_ + row) * NP + GLA_PCOLH(c, h_)); } } } while (0)
    u32x4 rawr[4];
    if (wg < BATCH * 4 * 128) GLA_FETCH(wg);
    for (int item = wg; item < BATCH * 4 * 128; item += G) {
    const int h = (item >> 7) & 3;
    __syncthreads();
#pragma unroll
    for (int k = 0; k < 4; ++k) { const int p = tid + 512 * k; if (p < 1664) { const int row = p / 26, c = p % 26; *(GLAS u32x4*)(lds + GLA_PDST(row, c)) = rawr[k]; } }
    if (item + G < BATCH * 4 * 128) GLA_FETCH(item + G);
    __syncthreads();
    const int sd = tid >> 3, tg = tid & 7;
    if (tid < 384) {
            float c[8], w2c[16]; const float bc = gb[h * 48 + sd];
#pragma unroll
            for (int r = 0; r < 16; ++r) w2c[r] = w2[(size_t)r * 192 + h * 48 + sd];
#pragma unroll
            for (int tt = 0; tt < 8; ++tt) { const int t = 8 * tg + tt; const u32x4 z0 = *(GLAS u32x4*)(lds + RAW_Z + t * 32), z1 = *(GLAS u32x4*)(lds + RAW_Z + t * 32 + 16); float z = bc;
#pragma unroll
                for (int k = 0; k < 4; ++k) { z += w2c[2 * k] * __uint_as_float(z0[k] << 16) + w2c[2 * k + 1] * __uint_as_float(z0[k] & 0xffff0000u); z += w2c[8 + 2 * k] * __uint_as_float(z1[k] << 16) + w2c[8 + 2 * k + 1] * __uint_as_float(z1[k] & 0xffff0000u); }
                const float ls = fminf(z, 0.f) - __logf(1.0f + __expf(-fabsf(z)));
                c[tt] = ls * (1.0f / 16.0f) + (tt ? c[tt - 1] : 0.f); }
            float incl = c[7];
#pragma unroll
            for (int o = 1; o < 8; o <<= 1) { const float v = __builtin_bit_cast(float, __builtin_amdgcn_ds_bpermute(((lane - o) & 63) << 2, __builtin_bit_cast(int, incl))); if (tg >= o) incl += v; }
            const float off = incl - c[7];
            const float bl = __builtin_bit_cast(float, __builtin_amdgcn_ds_bpermute((lane | 7) << 2, __builtin_bit_cast(int, incl)));
            unsigned kdp[4];
#pragma unroll
            for (int tt = 0; tt < 8; tt += 2) { float kdv[2];
#pragma unroll
                for (int u = 0; u < 2; ++u) { const int t = 8 * tg + tt + u; const float bb = off + c[tt + u];
                    const float q = bfl(*(GLAS unsigned short*)(lds + RAW_Q + (t * 48 + sd) * 2)), kx = bfl(*(GLAS unsigned short*)(lds + RAW_K + (t * 48 + sd) * 2));
                    const float e1 = __expf(bb), e2 = __expf(-bb), e3 = __expf(bl - bb);
                    *(GLAS unsigned short*)(lds + OP_QE + (t * 56 + sd) * 2) = (unsigned short)(cvtpk(q * e1, 0.f) & 0xffffu);
                    *(GLAS unsigned short*)(lds + OP_KE + (t * 56 + sd) * 2) = (unsigned short)(cvtpk(kx * e2, 0.f) & 0xffffu);
                    kdv[u] = kx * e3; }
                kdp[tt >> 1] = cvtpk(kdv[0], kdv[1]); }
            *(GLAS u32x4*)(lds + OP_KDT + (sd * 72 + 8 * tg) * 2) = (u32x4){kdp[0], kdp[1], kdp[2], kdp[3]};
            if (tg == 7) ((GLAS float*)(lds + OP_DEC))[sd] = __expf(bl);
    } else {
            for (int idx = tid - 384; idx < 96 * 8; idx += 128) { const int v = idx % 96, t8 = idx / 96; unsigned pk[4];
#pragma unroll
                for (int tt = 0; tt < 8; tt += 2) { const unsigned a0 = *(GLAS unsigned short*)(lds + RAW_V + ((8 * t8 + tt) * 96 + v) * 2), a1 = *(GLAS unsigned short*)(lds + RAW_V + ((8 * t8 + tt + 1) * 96 + v) * 2); pk[tt >> 1] = a0 | (a1 << 16); }
                *(GLAS u32x4*)(lds + OP_VT + (v * 72 + 8 * t8) * 2) = (u32x4){pk[0], pk[1], pk[2], pk[3]}; }
    }
    __syncthreads();
    unsigned char* dst = GOP + (size_t)item * OP_BLK_BYTES;
    for (int i = tid; i < (OP_DEC + 192 - OP_QE) / 16; i += NTHR) *(u32x4*)(dst + i * 16) = *(GLAS u32x4*)(lds + OP_QE + i * 16);
    }
#undef GLA_FETCH
#undef GLA_PCOLH
}
__device__ __forceinline__ void gla_seq_unit(const unsigned short* P, unsigned short* Y, const unsigned char* GOP, const float* ng, unsigned char* ldsg, int b, int h, int tid) {
    GLAS unsigned char* lds = (GLAS unsigned char*)ldsg;
    const int lane = tid & 63, wave = __builtin_amdgcn_readfirstlane(tid >> 6), r32 = lane & 31, hi = lane >> 5, l15 = lane & 15, quad = lane >> 4;
    const size_t rowbase = (size_t)b * SEQ; const unsigned char* gsrc = GOP + (size_t)((b * 4 + h) * 128) * OP_BLK_BYTES;
    constexpr int NPC = (OP_DEC + 192 - OP_QE) / 16;
    constexpr int SQ_BLK0 = 0, SQ_BLK1 = OP_BLK_BYTES, SQ_ST = 2 * OP_BLK_BYTES  , SQ_OB = SQ_ST + 2 * ST_BYTES  , SQ_OB_BYTES = 64 * 96 * 2, SQ_NG = SQ_OB + 2 * SQ_OB_BYTES  ;
    __syncthreads();
    for (int i = tid; i < 2 * ST_BYTES / 4; i += NTHR) ((GLAS unsigned*)(lds + SQ_ST))[i] = 0u;
    if (tid < 96) ((GLAS float*)(lds + SQ_NG))[tid] = ng[tid];
    u32x4 rg[5];
#pragma unroll
    for (int k = 0; k < 5; ++k) { const int i = tid + 512 * k; if (i < NPC) rg[k] = *(const u32x4*)(gsrc + (size_t)i * 16); }
#pragma unroll
    for (int k = 0; k < 5; ++k) { const int i = tid + 512 * k; if (i < NPC) *(GLAS u32x4*)(lds + SQ_BLK0 + i * 16) = rg[k]; }
#pragma unroll
    for (int k = 0; k < 5; ++k) { const int i = tid + 512 * k; if (i < NPC) rg[k] = *(const u32x4*)(gsrc + OP_BLK_BYTES + (size_t)i * 16); }
    __syncthreads();
    f32x4 S[2][3];
#pragma unroll
    for (int mt = 0; mt < 2; ++mt)
#pragma unroll
        for (int nt = 0; nt < 3; ++nt) S[mt][nt] = (f32x4){0.f, 0.f, 0.f, 0.f};
#define GLA_EPILOGUE(nn) do { const int cc_ = (nn) & 1; const size_t mm_ = rowbase + (size_t)(nn) * 64; \
        _Pragma("unroll") for (int k_ = 0; k_ < 4; ++k_) { const int vec_ = (tid - 320) + 192 * k_, t_ = vec_ / 12, v_ = (vec_ % 12) * 8; \
            const u32x4 ov_ = *(GLAS u32x4*)(lds + SQ_OB + cc_ * SQ_OB_BYTES + t_ * 192 + v_ * 2); const u32x4 gv_ = *(const u32x4*)(P + (mm_ + t_) * NP + N_GG + h * 96 + v_); \
            const f32x4 n0_ = *(GLAS f32x4*)(lds + SQ_NG + v_ * 4), n1_ = *(GLAS f32x4*)(lds + SQ_NG + v_ * 4 + 16); u32x4 yo_; \
            _Pragma("unroll") for (int e_ = 0; e_ < 4; ++e_) { const float ga_ = __uint_as_float(gv_[e_] << 16), gb_ = __uint_as_float(gv_[e_] & 0xffff0000u); \
                const float na_ = (e_ < 2) ? n0_[2 * e_] : n1_[2 * e_ - 4], nb_ = (e_ < 2) ? n0_[2 * e_ + 1] : n1_[2 * e_ - 3]; \
                yo_[e_] = cvtpk(__uint_as_float(ov_[e_] << 16) * na_ * (ga_ / (1.0f + __expf(-ga_))), __uint_as_float(ov_[e_] & 0xffff0000u) * nb_ * (gb_ / (1.0f + __expf(-gb_)))); } \
            *(u32x4*)(Y + (mm_ + t_) * DM + h * 96 + v_) = yo_; } } while (0)
    for (int n = 0; n < SEQ / 64; ++n) {
        const int cur = n & 1, nxt = cur ^ 1; const size_t m0 = rowbase + (size_t)n * 64;
        const int BO = (cur ? SQ_BLK1 : SQ_BLK0) - OP_QE;
        if (n + 1 < SEQ / 64) { const int BN = (cur ? SQ_BLK0 : SQ_BLK1) - OP_QE;
#pragma unroll
            for (int k = 0; k < 5; ++k) { const int i = tid + 512 * k; if (i < NPC) *(GLAS u32x4*)(lds + OP_QE + BN + i * 16) = rg[k]; }
            if (n + 2 < SEQ / 64) {
#pragma unroll
                for (int k = 0; k < 5; ++k) { const int i = tid + 512 * k; if (i < NPC) rg[k] = *(const u32x4*)(gsrc + (size_t)(n + 2) * OP_BLK_BYTES + (size_t)i * 16); } } }
        if (wave < 2) {
            const int it = wave; bf16x8 qf[3];
#pragma unroll
            for (int ks = 0; ks < 3; ++ks) qf[ks] = *(GLAS bf16x8*)(lds + BO + OP_QE + (32 * it + r32) * 112 + (16 * ks + 8 * hi) * 2);
            f32x16 acc[3];
#pragma unroll
            for (int vt = 0; vt < 3; ++vt)
#pragma unroll
                for (int r = 0; r < 16; ++r) acc[vt][r] = 0.f;
#pragma unroll
            for (int jt = 0; jt < 2; ++jt) if (jt <= it) {
                f32x16 X;
#pragma unroll
                for (int r = 0; r < 16; ++r) X[r] = 0.f;
#pragma unroll
                for (int ks = 0; ks < 3; ++ks) { const bf16x8 kf = *(GLAS bf16x8*)(lds + BO + OP_KE + (32 * jt + r32) * 112 + (16 * ks + 8 * hi) * 2); X = __builtin_amdgcn_mfma_f32_32x32x16_bf16(kf, qf[ks], X, 0, 0, 0); }
                if (jt == it) {
#pragma unroll
                    for (int r = 0; r < 16; ++r) if (crow(r, hi) > r32) X[r] = 0.f; }
                u32x4 p0, p1;
#pragma unroll
                for (int k = 0; k < 4; ++k) { p0[k] = cvtpk(X[2 * k], X[2 * k + 1]); p1[k] = cvtpk(X[8 + 2 * k], X[8 + 2 * k + 1]); }
                const bf16x8 pa0 = __builtin_bit_cast(bf16x8, p0), pa1 = __builtin_bit_cast(bf16x8, p1);
#pragma unroll
                for (int vt = 0; vt < 3; ++vt)
#pragma unroll
                    for (int s = 0; s < 2; ++s) { const int vo = BO + OP_VT + (32 * vt + r32) * 144 + (32 * jt + 16 * s + 4 * hi) * 2;
                        const s16x4 lo = *(GLAS s16x4*)(lds + vo), hi4 = *(GLAS s16x4*)(lds + vo + 16);
                        const bf16x8 a2 = (bf16x8){lo[0], lo[1], lo[2], lo[3], hi4[0], hi4[1], hi4[2], hi4[3]};
                        acc[vt] = __builtin_amdgcn_mfma_f32_32x32x16_bf16(a2, s ? pa1 : pa0, acc[vt], 0, 0, 0); }
            }
#pragma unroll
            for (int vt = 0; vt < 3; ++vt)
#pragma unroll
                for (int ks = 0; ks < 3; ++ks) { const bf16x8 sf = *(GLAS bf16x8*)(lds + SQ_ST + cur * ST_BYTES + (32 * vt + r32) * 112 + (16 * ks + 8 * hi) * 2); acc[vt] = __builtin_amdgcn_mfma_f32_32x32x16_bf16(sf, qf[ks], acc[vt], 0, 0, 0); }
            float ss = 0.f;
#pragma unroll
            for (int vt = 0; vt < 3; ++vt)
#pragma unroll
                for (int r = 0; r < 16; ++r) ss += acc[vt][r] * acc[vt][r];
            ss += __builtin_bit_cast(float, __builtin_amdgcn_ds_bpermute((lane ^ 32) << 2, __builtin_bit_cast(int, ss)));
            const float rn = 1.0f / sqrtf(ss * (1.0f / 96.0f) + EPS);
            GLAS unsigned char* ob = lds + SQ_OB + cur * SQ_OB_BYTES + (32 * it + r32) * 192;
#pragma unroll
            for (int vt = 0; vt < 3; ++vt)
#pragma unroll
                for (int g = 0; g < 4; ++g) { const int v0 = 32 * vt + 8 * g + 4 * hi;
                    *(GLAS u32x2*)(ob + v0 * 2) = (u32x2){cvtpk(acc[vt][4 * g] * rn, acc[vt][4 * g + 1] * rn), cvtpk(acc[vt][4 * g + 2] * rn, acc[vt][4 * g + 3] * rn)}; }
        } else if (wave < 5) {
            const int sw = wave - 2;
#pragma unroll
            for (int mt = 0; mt < 2; ++mt)
#pragma unroll
                for (int nt = 0; nt < 3; ++nt) { const int d = 16 * nt + l15; const float dec = ((GLAS float*)(lds + BO + OP_DEC))[d]; f32x4 a = S[mt][nt] * dec;
#pragma unroll
                    for (int ks = 0; ks < 2; ++ks) { const bf16x8 va = *(GLAS bf16x8*)(lds + BO + OP_VT + (32 * sw + 16 * mt + l15) * 144 + (32 * ks + 8 * quad) * 2), kb = *(GLAS bf16x8*)(lds + BO + OP_KDT + d * 144 + (32 * ks + 8 * quad) * 2);
                        a = __builtin_amdgcn_mfma_f32_16x16x32_bf16(va, kb, a, 0, 0, 0); }
                    S[mt][nt] = a;
#pragma unroll
                    for (int jj = 0; jj < 4; jj += 2) { const unsigned pk = cvtpk(a[jj], a[jj + 1]);
                        *(GLAS unsigned short*)(lds + SQ_ST + nxt * ST_BYTES + ((32 * sw + 16 * mt + 4 * quad + jj) * 56 + d) * 2) = (unsigned short)(pk & 0xffffu);
                        *(GLAS unsigned short*)(lds + SQ_ST + nxt * ST_BYTES + ((32 * sw + 16 * mt + 4 * quad + jj + 1) * 56 + d) * 2) = (unsigned short)(pk >> 16); } }
        } else if (n > 0) {
            GLA_EPILOGUE(n - 1);
        }
        __syncthreads();
    }
    if (wave >= 5) { GLA_EPILOGUE(SEQ / 64 - 1); }
    __syncthreads();
}
#undef GLA_EPILOGUE
#undef GLA_PCOL
#undef GLA_PDST
#undef GLAS
}
namespace poolb {
typedef short bf16x8 __attribute__((ext_vector_type(8)));
typedef float f32x16 __attribute__((ext_vector_type(16)));
typedef unsigned u32x4 __attribute__((ext_vector_type(4)));
typedef unsigned u32x2 __attribute__((ext_vector_type(2)));
typedef float f32x2_t __attribute__((ext_vector_type(2))); typedef __bf16 bf16x2_t __attribute__((ext_vector_type(2)));
#define PLAS __attribute__((address_space(3)))
constexpr int US_PITCH = 528  , US = 0, US_BYTES = 79 * US_PITCH  , PS = 41728, PS_PITCH = 144  , PS_WAVE = 32 * PS_PITCH  ,
              WT = PS + 8 * PS_WAVE  , WT_PITCH = 144, WT_GROUP = 64 * WT_PITCH  ;
__device__ __forceinline__ unsigned cvtpk(float lo, float hi) { f32x2_t v = {lo, hi}; bf16x2_t b = __builtin_convertvector(v, bf16x2_t); return __builtin_bit_cast(unsigned, b); }
__device__ __forceinline__ void pool_phase(const unsigned short* P, unsigned short* Y, const float* pw, const float* pscale, unsigned char* ldsg, int wg, int G, int tid) {
    PLAS unsigned char* lds = (PLAS unsigned char*)ldsg;
    const int lane = tid & 63, wave = __builtin_amdgcn_readfirstlane(tid >> 6), r32 = lane & 31, hi = lane >> 5, g = wave & 3, th = wave >> 2;
    __syncthreads();
    for (int i = tid; i < 4 * 64 * 64; i += NTHR) { const int gg = i >> 12, c = (i >> 6) & 63, d = i & 63; const float v = pw[i] * pscale[gg * 64 + d];
        *(PLAS unsigned short*)(lds + WT + gg * WT_GROUP + d * WT_PITCH + c * 2) = (unsigned short)(cvtpk(v, 0.f) & 0xffffu); }
    const int w = 2 << g;
    for (int tile = wg; tile < M / 64; tile += G) {
        const int m0 = tile * 64, t0 = m0 % SEQ;
        __syncthreads();
        for (int i = tid; i < 79 * 32; i += NTHR) { const int row = i >> 5, pc = i & 31; u32x4 v = {0u, 0u, 0u, 0u};
            if (t0 + row - 15 >= 0) v = *(const u32x4*)(P + (size_t)(m0 - 15 + row) * NP + N_PU + pc * 8);
            *(PLAS u32x4*)(lds + US + row * US_PITCH + pc * 16) = v; }
        __syncthreads();
        { float sum[32];
#pragma unroll
            for (int c = 0; c < 32; ++c) sum[c] = 0.f;
            const int tl = 32 * th + r32; const PLAS unsigned char* base = lds + US + (tl + 15) * US_PITCH + (g * 64 + 32 * hi) * 2;
            for (int j = 0; j < w; ++j) {
#pragma unroll
                for (int q4 = 0; q4 < 4; ++q4) { const u32x4 v = *(const PLAS u32x4*)(base - j * US_PITCH + q4 * 16);
#pragma unroll
                    for (int k = 0; k < 4; ++k) { const float lo = __uint_as_float(v[k] << 16), hh = __uint_as_float(v[k] & 0xffff0000u); sum[8 * q4 + 2 * k] += lo; sum[8 * q4 + 2 * k + 1] += hh; } } }
            const int pos = t0 + tl; const float inv = 1.0f / (float)((pos + 1 < w) ? pos + 1 : w);
            PLAS unsigned char* pd = lds + PS + wave * PS_WAVE + r32 * PS_PITCH + 32 * hi * 2;
#pragma unroll
            for (int q4 = 0; q4 < 4; ++q4) { u32x4 o; const u32x4 sv = *(const PLAS u32x4*)(base + q4 * 16);
#pragma unroll
                for (int k = 0; k < 4; ++k) o[k] = cvtpk(sum[8 * q4 + 2 * k] * inv - __uint_as_float(sv[k] << 16), sum[8 * q4 + 2 * k + 1] * inv - __uint_as_float(sv[k] & 0xffff0000u));
                *(PLAS u32x4*)(pd + q4 * 16) = o; } }
        asm volatile("s_waitcnt lgkmcnt(0)" ::: "memory");
        f32x16 acc[2];
#pragma unroll
        for (int dt = 0; dt < 2; ++dt) {
#pragma unroll
            for (int r = 0; r < 16; ++r) acc[dt][r] = 0.f;
#pragma unroll
            for (int ks = 0; ks < 4; ++ks) { const bf16x8 a = *(const PLAS bf16x8*)(lds + WT + g * WT_GROUP + (32 * dt + r32) * WT_PITCH + (16 * ks + 8 * hi) * 2), bq = *(const PLAS bf16x8*)(lds + PS + wave * PS_WAVE + r32 * PS_PITCH + (16 * ks + 8 * hi) * 2);
                acc[dt] = __builtin_amdgcn_mfma_f32_32x32x16_bf16(a, bq, acc[dt], 0, 0, 0); } }
        { const size_t m = (size_t)m0 + 32 * th + r32; const unsigned short* gp = P + m * NP + N_PG + g * 64; unsigned short* yp = Y + m * DM + 768 + g * 64;
#pragma unroll
            for (int dt = 0; dt < 2; ++dt)
#pragma unroll
                for (int g4 = 0; g4 < 4; ++g4) { const int d0 = 32 * dt + 8 * g4 + 4 * hi; const u32x2 gw = *(const u32x2*)(gp + d0);
                    const float g0 = __uint_as_float(gw[0] << 16), g1 = __uint_as_float(gw[0] & 0xffff0000u), g2 = __uint_as_float(gw[1] << 16), g3 = __uint_as_float(gw[1] & 0xffff0000u);
                    const float y0 = acc[dt][4 * g4] * (g0 / (1.0f + __expf(-g0))), y1 = acc[dt][4 * g4 + 1] * (g1 / (1.0f + __expf(-g1))), y2 = acc[dt][4 * g4 + 2] * (g2 / (1.0f + __expf(-g2))), y3 = acc[dt][4 * g4 + 3] * (g3 / (1.0f + __expf(-g3)));
                    *(u32x2*)(yp + d0) = (u32x2){cvtpk(y0, y1), cvtpk(y2, y3)}; } }
    }
    __syncthreads();
}
#undef PLAS
}
struct Args {
    const float* x; const float* norm_g; const float* w_in; const float* gate_w2; const float* gate_b; const float* gla_norm_g;
    const float* rel_bias; const float* pool_w; const float* pool_scale; const float* w_out; const float* final_g;
    float* out; unsigned char* ws;
    int l_lo, l_hi, ph_lo, ph_hi, single, pad;
};

__device__ __forceinline__ int src_col(int n, float& sc) {
    sc = 1.f;
    if (n < 192) { sc = 0.14433756729740643f; return n; }
    if (n < 768) return n;
    if (n < 1152) return 784 + (n - 768);
    if (n < 1536) { sc = 0.125f * LOG2E; return 1168 + (n - 1152); }
    if (n < 1920) return 1552 + (n - 1536);
    if (n < 2304) return 1936 + (n - 1920);
    if (n < 2688) return 2320 + (n - 2304);
    if (n < 2944) return 2868 + (n - 2688);
    if (n < 3200) return 3124 + (n - 2944);
    if (n < 3328) { sc = 0.17677669529663687f; return 2704 + (n - 3200); }
    if (n < 3360) return 2832 + (n - 3328);
    if (n < 3376) return 768 + (n - 3360);
    if (n < 3380) { sc = 0.5f; return 2864 + (n - 3376); }
    return -1;
}
__device__ __forceinline__ void prologue_phase(const Args& a, int wg, int G, int tid) {
    bf16* WIN = (bf16*)(a.ws + WS_WIN); bf16* WOUT = (bf16*)(a.ws + WS_WOUT);
    const long gt = (long)wg * NTHR + tid, gs = (long)G * NTHR;
    for (long i = gt; i < 4L * NP * 128; i += gs) {
        const int n = (int)(i % NP), k8 = (int)((i / NP) % 128), l = (int)(i / ((long)NP * 128));
        float sc; const int c = src_col(n, sc);
        v4u o = {0u, 0u, 0u, 0u};
        if (c >= 0) { const float* w = a.w_in + ((size_t)l * 1024 + k8 * 8) * IN_COLS + c; float v[8];
#pragma unroll
            for (int j = 0; j < 8; ++j) v[j] = w[(size_t)j * IN_COLS] * sc * a.norm_g[l * 1024 + k8 * 8 + j];
            o.x = pk2(v[0], v[1]); o.y = pk2(v[2], v[3]); o.z = pk2(v[4], v[5]); o.w = pk2(v[6], v[7]); }
        *(v4u*)(WIN + ((size_t)l * NP + n) * 1024 + k8 * 8) = o;
    }
    for (long i = gt; i < 4L * 1024 * 128; i += gs) {
        const int n = (int)(i % 1024), k8 = (int)((i / 1024) % 128), l = (int)(i / (1024L * 128));
        const float* w = a.w_out + ((size_t)l * 1024 + k8 * 8) * 1024 + n; float v[8];
#pragma unroll
        for (int j = 0; j < 8; ++j) v[j] = w[(size_t)j * 1024];
        v4u o; o.x = pk2(v[0], v[1]); o.y = pk2(v[2], v[3]); o.z = pk2(v[4], v[5]); o.w = pk2(v[6], v[7]);
        *(v4u*)(WOUT + ((size_t)l * 1024 + n) * 1024 + k8 * 8) = o;
    }
    { bf16* XA = (bf16*)(a.ws + WS_XA); float* RS = (float*)(a.ws + WS_RS); const int lane = tid & 63;
        for (int m = wg * NWAVES + (tid >> 6); m < M; m += G * NWAVES) { const f32x4* xr = (const f32x4*)(a.x + (size_t)m * DM) + lane; v2u* o = (v2u*)(XA + (size_t)m * DM) + lane; float s = 0.f;
#pragma unroll
            for (int j = 0; j < 4; ++j) { const f32x4 v = xr[64 * j]; v2u w; w.x = pk2(v.x, v.y); w.y = pk2(v.z, v.w); o[64 * j] = w; s += (bflo(w.x) * bflo(w.x) + bfhi(w.x) * bfhi(w.x)) + (bflo(w.y) * bflo(w.y) + bfhi(w.y) * bfhi(w.y)); }
            s = wave_sum(s, lane); if (lane < 16) RS[(size_t)m * 16 + lane] = (lane == 0) ? s : 0.f; } }
}
__device__ __forceinline__ void norm_phase(const float* src, const float* g, bf16* dst, int gw, int NGW, int lane) {
    for (int m = gw; m < M; m += NGW) {
        const f32x4* xr = (const f32x4*)(src + (size_t)m * DM) + lane; f32x4 v[4]; float s = 0.f;
#pragma unroll
        for (int j = 0; j < 4; ++j) { v[j] = xr[64 * j]; s += (v[j].x * v[j].x + v[j].y * v[j].y) + (v[j].z * v[j].z + v[j].w * v[j].w); }
        const float r = 1.0f / sqrtf(wave_sum(s, lane) * (1.f / DM) + EPS);
        const f32x4* gr = (const f32x4*)g + lane; v2u* o = (v2u*)(dst + (size_t)m * DM) + lane;
#pragma unroll
        for (int j = 0; j < 4; ++j) { const f32x4 gv = gr[64 * j]; v2u w; w.x = pk2(v[j].x * r * gv.x, v[j].y * r * gv.y); w.y = pk2(v[j].z * r * gv.z, v[j].w * r * gv.w); o[64 * j] = w; }
    }
}
__device__ __forceinline__ void final_norm_phase(const bf16* xa, float* out, const float* g, const float* RS, int gw, int NGW, int lane) {
    for (int m = gw; m < M; m += NGW) {
        const v2u* xr = (const v2u*)(xa + (size_t)m * DM) + lane; f32x4* orow = (f32x4*)(out + (size_t)m * DM) + lane;
        const f32x4* rs = (const f32x4*)(RS + (size_t)m * 16); const f32x4 s0 = rs[0], s1 = rs[1], s2 = rs[2], s3 = rs[3];
        const float ss = (((s0[0] + s0[1]) + (s0[2] + s0[3])) + ((s1[0] + s1[1]) + (s1[2] + s1[3]))) + (((s2[0] + s2[1]) + (s2[2] + s2[3])) + ((s3[0] + s3[1]) + (s3[2] + s3[3])));
        const float r = 1.0f / sqrtf(ss * (1.f / DM) + EPS);
        const f32x4* gr = (const f32x4*)g + lane;
#pragma unroll
        for (int j = 0; j < 4; ++j) { const f32x4 gv = gr[64 * j]; const v2u w = xr[64 * j]; orow[64 * j] = (f32x4){bflo(w.x) * r * gv.x, bfhi(w.x) * r * gv.y, bflo(w.y) * r * gv.z, bfhi(w.y) * r * gv.w}; }
    }
}
__device__ __forceinline__ void rowscale_phase(const float* RS, float* RSC, int wg, int G, int tid) {
    for (int m = wg * NTHR + tid; m < M; m += G * NTHR) { const f32x4* rs = (const f32x4*)(RS + (size_t)m * 16); const f32x4 s0 = rs[0], s1 = rs[1], s2 = rs[2], s3 = rs[3];
        const float ss = (((s0[0] + s0[1]) + (s0[2] + s0[3])) + ((s1[0] + s1[1]) + (s1[2] + s1[3]))) + (((s2[0] + s2[1]) + (s2[2] + s2[3])) + ((s3[0] + s3[1]) + (s3[2] + s3[3])));
        RSC[m] = 1.0f / sqrtf(ss * (1.0f / 1024.0f) + EPS); }
}
__device__ __forceinline__ void pool_phase(const Args& a, int l, unsigned char* lds, int wg, int G, int tid) {
    float* wsm = (float*)lds; float* us = (float*)(lds + 16384); float* ps = (float*)(lds + 32768);
    const bf16* P = (const bf16*)(a.ws + WS_P); bf16* Y = (bf16*)(a.ws + WS_XB);
    for (int g = 0; g < 4; ++g) {
        __syncthreads();
        const float* pw = a.pool_w + (size_t)(l * 4 + g) * 4096;
        for (int i = tid; i < 4096; i += NTHR) wsm[i] = pw[i];
        const int w = 2 << g;
        for (int tile = wg; tile < M / 32; tile += G) {
            __syncthreads();
            const int m0 = tile * 32, t0 = m0 % SEQ;
            for (int i = tid; i < 47 * 64; i += NTHR) { const int r = i >> 6, c = i & 63; float v = 0.f;
                if (t0 + r - 15 >= 0) v = bf2f(P[(size_t)(m0 - 15 + r) * NP + N_PU + g * 64 + c]);
                us[i] = v; }
            __syncthreads();
            { const int t = tid >> 4, c4 = (tid & 15) * 4, pos = t0 + t; const int cnt = (pos + 1 < w) ? pos + 1 : w; const float inv = 1.0f / (float)cnt;
#pragma unroll
                for (int k = 0; k < 4; ++k) { const int c = c4 + k; float s = 0.f; for (int j = 0; j < w; ++j) s += us[(t + 15 - j) * 64 + c]; ps[t * 64 + c] = s * inv - us[(t + 15) * 64 + c]; } }
            __syncthreads();
            { const int t = tid >> 4, d4 = (tid & 15) * 4; float a0 = 0.f, a1 = 0.f, a2 = 0.f, a3 = 0.f;
                for (int c = 0; c < 64; ++c) { const float p = ps[t * 64 + c]; const f32x4 wv = *(const f32x4*)&wsm[c * 64 + d4]; a0 += p * wv.x; a1 += p * wv.y; a2 += p * wv.z; a3 += p * wv.w; }
                const size_t m = (size_t)m0 + t; const v2u gw2 = *(const v2u*)(P + m * NP + N_PG + g * 64 + d4);
                const float* scl = a.pool_scale + l * 256 + g * 64 + d4;
                const float y0 = a0 * scl[0] * silu_f(bflo(gw2.x)), y1 = a1 * scl[1] * silu_f(bfhi(gw2.x)), y2 = a2 * scl[2] * silu_f(bflo(gw2.y)), y3 = a3 * scl[3] * silu_f(bfhi(gw2.y));
                v2u o; o.x = pk2(y0, y1); o.y = pk2(y2, y3); *(v2u*)(Y + m * DM + 768 + g * 64 + d4) = o; }
        }
    }
    __syncthreads();
}
__device__ __forceinline__ void gla_rec_phase(const Args& a, int l, unsigned char* lds, int unit, int tid) {
    const int b = unit >> 2, h = unit & 3;
    float* qs = (float*)lds; float* ks = (float*)(lds + 12288); float* es = (float*)(lds + 24576); float* vs = (float*)(lds + 36864); float* os = (float*)(lds + 61440);
    float* w2s = (float*)(lds + 86016); float* bs = (float*)(lds + 89088); float* gzs = (float*)(lds + 89280);
    const bf16* P = (const bf16*)(a.ws + WS_P); bf16* Y = (bf16*)(a.ws + WS_XB);
    __syncthreads();
    for (int i = tid; i < 16 * 48; i += NTHR) { const int r = i / 48, d = i % 48; w2s[i] = a.gate_w2[(size_t)(l * 16 + r) * 192 + h * 48 + d]; }
    if (tid < 48) bs[tid] = a.gate_b[l * 192 + h * 48 + tid];
    float S[48];
#pragma unroll
    for (int d = 0; d < 48; ++d) S[d] = 0.f;
    for (int blk = 0; blk < SEQ / 64; ++blk) {
        const size_t m0 = (size_t)b * SEQ + (size_t)blk * 64;
        __syncthreads();
        for (int i = tid; i < 64 * 48; i += NTHR) { const int t = i / 48, d = i % 48; const bf16* row = P + (m0 + t) * NP; qs[i] = bf2f(row[N_GQ + h * 48 + d]); ks[i] = bf2f(row[N_GK + h * 48 + d]); }
        for (int i = tid; i < 64 * 96; i += NTHR) { const int t = i / 96, v = i % 96; vs[i] = bf2f(P[(m0 + t) * NP + N_GV + h * 96 + v]); }
        for (int i = tid; i < 64 * 16; i += NTHR) { const int t = i >> 4, r = i & 15; gzs[i] = bf2f(P[(m0 + t) * NP + N_GZ + r]); }
        __syncthreads();
        for (int i = tid; i < 64 * 48; i += NTHR) { const int t = i / 48, d = i % 48; float z = bs[d];
#pragma unroll
            for (int r = 0; r < 16; ++r) z += gzs[t * 16 + r] * w2s[r * 48 + d];
            const float ls = fminf(z, 0.f) - log1pf(__expf(-fabsf(z)));
            es[i] = __expf(ls * (1.0f / 16.0f)); }
        __syncthreads();
        if (tid < 96) { const int v = tid;
            for (int t = 0; t < 64; ++t) { const float vv = vs[t * 96 + v]; float o = 0.f;
#pragma unroll
                for (int d = 0; d < 48; ++d) { S[d] = es[t * 48 + d] * S[d] + ks[t * 48 + d] * vv; o += qs[t * 48 + d] * S[d]; }
                os[t * 96 + v] = o; } }
        __syncthreads();
        { const int t = tid >> 3, part = tid & 7; float ov[12]; float ss = 0.f;
#pragma unroll
            for (int k = 0; k < 12; ++k) { ov[k] = os[t * 96 + part * 12 + k]; ss += ov[k] * ov[k]; }
            { const int ln = tid & 63; ss += shx(ss, 1, ln); ss += shx(ss, 2, ln); ss += shx(ss, 4, ln); }
            const float r = 1.0f / sqrtf(ss * (1.0f / 96.0f) + EPS);
            const size_t m = m0 + t; const bf16* gp = P + m * NP + N_GG + h * 96 + part * 12; const float* ng = a.gla_norm_g + l * 96 + part * 12;
            unsigned* yo = (unsigned*)(Y + m * DM + h * 96 + part * 12);
#pragma unroll
            for (int k = 0; k < 12; k += 2) { const float y0 = ov[k] * r * ng[k] * silu_f(bf2f(gp[k])), y1 = ov[k + 1] * r * ng[k + 1] * silu_f(bf2f(gp[k + 1])); yo[k >> 1] = pk2(y0, y1); } }
    }
    __syncthreads();
}
template <bool BITS_ONLY> __device__ __forceinline__ void dsa_slow_query(const Args& a, unsigned char* lds, int b, int t, int tid) {
    const int lane = tid & 63, wave = tid >> 6;
    unsigned* sc = (unsigned*)lds; int* hist = (int*)(lds + 32768); int* sel = (int*)(lds + 33792); float* qf = (float*)(lds + 34816); float* wq = (float*)(lds + 35328);
    int* misc = (int*)(lds + 35344); float* qh = (float*)(lds + 35456); float* lg = (float*)(lds + 36992); float* inv = (float*)(lds + 43136);
    const bf16* P = (const bf16*)(a.ws + WS_P); bf16* Y = (bf16*)(a.ws + WS_XB);
    {
        const size_t m = (size_t)b * SEQ + t; const int N = t + 1;
        __syncthreads();
        if (tid < 128) qf[tid] = bf2f(P[m * NP + N_QI + tid]);
        if (tid >= 128 && tid < 132) wq[tid - 128] = bf2f(P[m * NP + N_WI + tid - 128]);
        for (int i = tid; i < 384; i += NTHR) qh[i] = bf2f(P[m * NP + N_DQ + i]);
        __syncthreads();
        for (int s = tid; s < N; s += NTHR) {
            const v4u* kr = (const v4u*)(P + ((size_t)b * SEQ + s) * NP + N_KI); float kf[32];
#pragma unroll
            for (int c = 0; c < 4; ++c) { const v4u w = kr[c]; kf[8 * c] = bflo(w.x); kf[8 * c + 1] = bfhi(w.x); kf[8 * c + 2] = bflo(w.y); kf[8 * c + 3] = bfhi(w.y); kf[8 * c + 4] = bflo(w.z); kf[8 * c + 5] = bfhi(w.z); kf[8 * c + 6] = bflo(w.w); kf[8 * c + 7] = bfhi(w.w); }
            float score = 0.f;
#pragma unroll
            for (int hh = 0; hh < 4; ++hh) { float dot = 0.f;
#pragma unroll
                for (int d = 0; d < 32; ++d) dot += qf[hh * 32 + d] * kf[d];
                score += wq[hh] * fmaxf(dot, 0.f); }
            const unsigned u = __builtin_bit_cast(unsigned, score);
            sc[s] = (u & 0x80000000u) ? ~u : (u | 0x80000000u);
        }
        __syncthreads();
        int L;
        if (N <= 256) { if (tid < N) sel[tid] = tid; L = N; }
        else {
            unsigned prefix = 0u; int kk = 256;
            for (int pass = 0; pass < 4; ++pass) {
                const int shift = 24 - 8 * pass;
                if (tid < 256) hist[tid] = 0;
                __syncthreads();
                for (int s = tid; s < N; s += NTHR) { const unsigned key = sc[s]; const bool match = (pass == 0) ? true : ((key >> ((shift + 8) & 31)) == prefix); if (match) atomicAdd(&hist[(key >> shift) & 255u], 1); }
                __syncthreads();
                if (wave == 0) {
                    const int c0 = hist[4 * lane], c1 = hist[4 * lane + 1], c2 = hist[4 * lane + 2], c3 = hist[4 * lane + 3]; const int tot = c0 + c1 + c2 + c3;
                    int incl = tot;
#pragma unroll
                    for (int o = 1; o < 64; o <<= 1) { const int tt = shdn(incl, o, lane); if (lane + o < 64) incl += tt; }
                    const int excl = incl - tot;
                    if (excl < kk && kk <= incl) { int above = excl, D;
                        if (above + c3 >= kk) D = 4 * lane + 3;
                        else { above += c3; if (above + c2 >= kk) D = 4 * lane + 2; else { above += c2; if (above + c1 >= kk) D = 4 * lane + 1; else { above += c1; D = 4 * lane; } } }
                        misc[1] = D; misc[2] = above; }
                }
                __syncthreads();
                prefix = (prefix << 8) | (unsigned)misc[1]; kk -= misc[2];
            }
            const unsigned tau = prefix;
            const int seg = (((N + 7) >> 3) + 63) & ~63; const int s_lo = wave * seg, s_hi = (s_lo + seg < N) ? s_lo + seg : N;
            { int cg = 0, ce = 0;
                for (int base = s_lo; base < s_hi; base += 64) { const int s = base + lane; const bool in = s < s_hi; const unsigned key = in ? sc[s] : 0u;
                    cg += __popcll(__ballot(in && key > tau)); ce += __popcll(__ballot(in && key == tau)); }
                if (lane == 0) { misc[4 + wave] = cg; misc[12 + wave] = ce; } }
            __syncthreads();
            { int bg = 0, be = 0;
                for (int w2 = 0; w2 < 8; ++w2) if (w2 < wave) { bg += misc[4 + w2]; be += misc[12 + w2]; }
                int run_sel = bg + (be < kk ? be : kk), run_eq = be;
                for (int base = s_lo; base < s_hi; base += 64) { const int s = base + lane; const bool in = s < s_hi; const unsigned key = in ? sc[s] : 0u;
                    const bool gt = in && key > tau, eq = in && key == tau; const unsigned long long me = __ballot(eq); const unsigned long long lt = (1ull << lane) - 1ull;
                    const bool take = gt || (eq && (run_eq + __popcll(me & lt) < kk)); const unsigned long long mt = __ballot(take);
                    if (take) sel[run_sel + __popcll(mt & lt)] = s;
                    run_sel += __popcll(mt); run_eq += __popcll(me); } }
            L = 256;
        }
        __syncthreads();
        if constexpr (BITS_ONLY) {
            unsigned* bm = (unsigned*)lg; unsigned* MK = (unsigned*)(a.ws + WS_MASK);
            if (tid < 256) bm[tid] = 0u;
            __syncthreads();
            if (tid < L) { const int s = sel[tid]; const int kt = s >> 6, kap = s & 63, half = kap >> 5, k5 = kap & 31, hi = (k5 >> 2) & 1, r = (k5 & 3) + 4 * (k5 >> 3);
                atomicOr(&bm[kt * 2 + hi], 1u << (r + 16 * half)); }
            __syncthreads();
            const int ntw = ((t >> 8) + 1) * 8;
            if (tid < ntw) { const int kt = tid >> 1, hi = tid & 1; MK[((size_t)(b * 256 + (t >> 5)) * 128 + kt) * 64 + (t & 31) + 32 * hi] = bm[tid]; }
            __syncthreads();
            return;
        }
        { const int j = tid >> 1, h0 = (tid & 1) * 3;
            if (j < L) { const int s = sel[j]; const size_t srow = (size_t)b * SEQ + s; const int bk = t5_bucket(t - s);
#pragma unroll
                for (int hh = 0; hh < 3; ++hh) { const int h = h0 + hh; const v4u* kr = (const v4u*)(P + srow * NP + N_DK + h * 64); const float* q = qh + h * 64; float dot = 0.f;
#pragma unroll
                    for (int c = 0; c < 8; ++c) { const v4u w = kr[c]; dot += q[8 * c] * bflo(w.x) + q[8 * c + 1] * bfhi(w.x) + q[8 * c + 2] * bflo(w.y) + q[8 * c + 3] * bfhi(w.y) + q[8 * c + 4] * bflo(w.z) + q[8 * c + 5] * bfhi(w.z) + q[8 * c + 6] * bflo(w.w) + q[8 * c + 7] * bfhi(w.w); }
                    lg[h * 256 + j] = dot + a.rel_bias[bk * 6 + h] * LOG2E; } }
            else {
#pragma unroll
                for (int hh = 0; hh < 3; ++hh) lg[(h0 + hh) * 256 + j] = -INFINITY; } }
        __syncthreads();
        if (wave < 6) { float* row = lg + wave * 256; float v0 = row[lane], v1 = row[lane + 64], v2 = row[lane + 128], v3 = row[lane + 192];
            float mx = fmaxf(fmaxf(v0, v1), fmaxf(v2, v3));
#pragma unroll
            for (int o = 1; o < 64; o <<= 1) mx = fmaxf(mx, shx(mx, o, lane));
            v0 = exp2f(v0 - mx); v1 = exp2f(v1 - mx); v2 = exp2f(v2 - mx); v3 = exp2f(v3 - mx);
            const float sm = wave_sum((v0 + v1) + (v2 + v3), lane);
            row[lane] = v0; row[lane + 64] = v1; row[lane + 128] = v2; row[lane + 192] = v3;
            if (lane == 0) inv[wave] = 1.0f / sm; }
        __syncthreads();
        if (tid < 384) { const int h = tid >> 6, d = tid & 63; float acc = 0.f; const bf16* vb = P + (size_t)b * SEQ * NP + N_DV + h * 64 + d;
            for (int j = 0; j < L; ++j) acc += lg[h * 256 + j] * bf2f(vb[(size_t)sel[j] * NP]);
            const float o = acc * inv[h]; const float gate = bf2f(P[m * NP + N_DG + h * 64 + d]);
            Y[m * DM + 384 + h * 64 + d] = (bf16)f2bf(o * silu_f(gate)); }
    }
    __syncthreads();
}
template <bool BITS_ONLY> __device__ __forceinline__ void dsa_slow_phase(const Args& a, int l, unsigned char* lds, int wg, int G, int tid) {
    for (int qi = wg; qi < M; qi += G) { asm volatile("" : "+v"(tid)); dsa_slow_query<BITS_ONLY>(a, lds, qi & 7, qi >> 3, tid); }
}
__device__ __forceinline__ void index_phase(const Args& a, unsigned char* lds, unsigned* qctr, volatile LAS unsigned* MISC, int tid) {
    const unsigned short* P = (const unsigned short*)(a.ws + WS_P); unsigned* MK = (unsigned*)(a.ws + WS_MASK);
    __syncthreads();
    if (tid <= 256) ((float*)(lds + idxb::L_XT))[tid] = tid < 256 ? idxb::xthr(tid) : __builtin_inff();
    int bq = blockIdx.x & 7, tries = 0;
    for (;;) {
        asm volatile("" : "+v"(tid));
        __syncthreads();
        if (tid == 0) MISC[17] = __hip_atomic_fetch_add(qctr + 64 * bq, 1u, __ATOMIC_RELAXED, __HIP_MEMORY_SCOPE_AGENT);
        __syncthreads();
        const int k = (int)MISC[17];
        if (k >= 256) { if (++tries == 8) break; bq = (bq + 1) & 7; continue; }
        const int b = bq, qt = 255 - k;
        idxb::index_unit(P, (const unsigned short*)(a.ws + WS_KC), MK, (unsigned*)(a.ws + WS_ZW) + (size_t)blockIdx.x * 128 * 64, lds, b, qt, tid);
        const int* par = (const int*)(lds + idxb::L_PAR);
        if (par[idxb::P_ANY3 * 32]) for (int q = 0; q < 32; ++q) if (par[idxb::P_MODE * 32 + q] == 3) dsa_slow_query<true>(a, lds, b, qt * 32 + q, tid);
    }
}
#ifndef REP_POOL
#define REP_POOL 1
#endif
#ifndef ATT_PRIO
#define ATT_PRIO 0
#endif
#ifndef REP_IDX
#define REP_IDX 1
#endif
#ifndef REP_GLA
#define REP_GLA 1
#endif
#ifndef REP_ATT
#define REP_ATT 1
#endif
#ifndef REP_PREP
#define REP_PREP 1
#endif
#ifndef REP_PRO
#define REP_PRO 1
#endif
#ifndef REP_NORM
#define REP_NORM 1
#endif
#ifndef REP_ALL
#define REP_ALL 1
#endif
#ifndef REP_BAR
#define REP_BAR 1
#endif
#ifndef REP_OUT
#define REP_OUT 1
#endif
#ifndef REP_INP
#define REP_INP 1
#endif
#ifndef GLA_MODE
#define GLA_MODE 1
#endif
#ifndef DSA_MODE
#define DSA_MODE 2
#endif
#ifndef MK_SINGLE
#define MK_SINGLE 1
#endif
__global__ void __launch_bounds__(NTHR, 2) fwd(Args a) {
    extern __shared__ __attribute__((aligned(16))) unsigned char lds[];
    int tid = threadIdx.x, lane = tid & 63, wave = __builtin_amdgcn_readfirstlane(tid >> 6);
    int G = gridDim.x, wg = blockIdx.x;
    const int wave0 = __builtin_amdgcn_readfirstlane(tid >> 6);
#define LAUNDER() do { { int wv_ = wave0; asm volatile("" : "+s"(wv_)); unsigned on_ = ~0u; asm volatile("" : "+s"(on_)); tid = wv_ * 64 + (int)__builtin_amdgcn_mbcnt_hi(on_, __builtin_amdgcn_mbcnt_lo(on_, 0u)); asm volatile("" : "+v"(tid)); } wg = blockIdx.x; G = gridDim.x; asm volatile("" : "+s"(wg), "+s"(G));     \
    lane = tid & 63; wave = __builtin_amdgcn_readfirstlane(tid >> 6); gw = wg * NWAVES + wave; NGW = G * NWAVES; } while (0)
    volatile LAS unsigned* MISC = (volatile LAS unsigned*)((LAS unsigned char*)lds + MISC_OFF);
    for (int u = tid; u < (LDS_BYTES - LDSCTL_OFF) / 4; u += NTHR) ((LAS unsigned*)((LAS unsigned char*)lds + LDSCTL_OFF))[u] = 0u;
    __syncthreads();
    XcdBarrier bar; bar.bar = (unsigned*)(a.ws + WS_CTL) + CW_BAR; bar.x = 0; bar.st = nullptr;
    const bool one = a.single != 0;
    if (one) bar = xcd_barrier_post((unsigned*)(a.ws + WS_CTL) + CW_BAR, MISC + 8);
#define IN(k) (a.ph_lo <= (k) && (k) < a.ph_hi)
#define SEAM() do { if (one) { unsigned* bp_ = (unsigned*)(a.ws + WS_CTL) + CW_BAR; asm volatile("" : "+s"(bp_)); XcdBarrier bb_; bb_.bar = bp_; bb_.x = bar.x; bb_.st = bar.st; xcd_barrier(bb_); if (REP_BAR == 2) xcd_barrier(bb_); } } while (0)
    int gw = wg * NWAVES + wave, NGW = G * NWAVES;
    bf16* XB = (bf16*)(a.ws + WS_XB); bf16* PB = (bf16*)(a.ws + WS_P);
    for (int rpw = 0; rpw < REP_ALL; ++rpw) {
    LAUNDER();
    if (IN(0)) { for (int rp = 0; rp < REP_PRO; ++rp) prologue_phase(a, wg, G, tid); SEAM(); }
    for (int l = a.l_lo; l < a.l_hi; ++l) {
        LAUNDER();
        if (IN(1)) { rowscale_phase((const float*)(a.ws + WS_RS), (float*)(a.ws + WS_RSC), wg, G, tid); SEAM(); }
        LAUNDER();
        if (IN(2)) {
            pg8::Gemm g{(const bf16*)(a.ws + WS_XA), (const bf16*)(a.ws + WS_WIN) + (size_t)l * NP * 1024, M, NP, DM}; pg8::StaticOrder S; S.init(M, NP, G, wg);
            pg8::EpiP E{PB, NP, (const float*)(a.ws + WS_RSC), (pg8::bf16_t*)(a.ws + WS_KC)};
            pg8::gemm_phase<pg8::EpiP, pg8::StaticOrder, true, true>((PG8_LAS unsigned char*)lds, g, S, E, tid);
#if REP_INP == 2
            asm volatile("" : "+v"(tid)); __syncthreads(); pg8::gemm_phase<pg8::EpiP, pg8::StaticOrder, true, true>((PG8_LAS unsigned char*)lds, g, S, E, tid);
#endif
            SEAM();
        }
        LAUNDER();
        if (IN(3)) {
#if GLA_MODE == 0
            if (wg < 32) gla_rec_phase(a, l, lds, wg, tid);
#endif
            for (int rp = 0; rp < REP_POOL; ++rp) { asm volatile("" : "+v"(tid)); poolb::pool_phase(PB, XB, a.pool_w + (size_t)l * 4 * 4096, a.pool_scale + l * 256, lds, wg, G, tid); }
#if GLA_MODE == 1
            glab::gla_prep_loop(PB, a.ws + WS_GOP, a.gate_w2 + (size_t)l * 16 * 192, a.gate_b + l * 192, lds, wg, G, tid);
#if REP_PREP == 2
            __syncthreads(); asm volatile("" : "+v"(tid), "+s"(wg));
            for (int item = wg; item < BATCH * 4 * 128; item += G) { asm volatile("" : "+v"(tid)); glab::gla_prep_item(PB, a.ws + WS_GOP, a.gate_w2 + (size_t)l * 16 * 192, a.gate_b + l * 192, lds, item, tid); }
#endif
            __syncthreads();
#endif
#if DSA_MODE == 0
            dsa_slow_phase<false>(a, l, lds, wg, G, tid);
#elif DSA_MODE == 1
            dsa_slow_phase<true>(a, l, lds, wg, G, tid);
#else
            for (int rp = 0; rp < REP_IDX; ++rp) { asm volatile("" : "+v"(tid)); index_phase(a, lds, (unsigned*)(a.ws + WS_CTL) + CW_QUEUE + 64 * (32 + 8 * (l + 4 * rp + 8 * rpw)), MISC, tid); }
#endif
            SEAM();
        }
        LAUNDER();
        if (IN(4)) {
#if DSA_MODE >= 1
            { float* dl = (float*)(lds + 86016);
                for (int i = tid; i < 1032; i += NTHR) { const int rel = i >> 3, h = i & 7; dl[i] = (h < 6 && rel < 128) ? (a.rel_bias[(int)T5B[rel] * 6 + h] - a.rel_bias[31 * 6 + h]) * LOG2E : 0.f; } for (int i = tid; i < 512; i += NTHR) { const unsigned nb = ((unsigned)(i >> 1) >> (4 * (i & 1))) & 15u; ((unsigned*)(lds + attn_body::LDS_TAB))[i] = (nb & 1u ? 0xffu : 0u) | (nb & 2u ? 0xff00u : 0u) | (nb & 4u ? 0xff0000u : 0u) | (nb & 8u ? 0xff000000u : 0u); }
                __syncthreads();
                const attn_body::AttnTensors AT{(const attn_body::bf16*)(PB + N_DQ), (const attn_body::bf16*)(PB + N_DK), (const attn_body::bf16*)(PB + N_DV), (attn_body::bf16*)(XB + 384), (const attn_body::bf16*)(PB + N_DG), (const unsigned*)(a.ws + WS_MASK)};
#if GLA_MODE == 1
                if (wg < 32) { glab::gla_seq_unit(PB, XB, a.ws + WS_GOP, a.gla_norm_g + l * 96, lds, wg >> 2, wg & 3, tid);
#if REP_GLA == 2
                    asm volatile("" : "+v"(tid)); glab::gla_seq_unit(PB, XB, a.ws + WS_GOP, a.gla_norm_g + l * 96, lds, wg >> 2, wg & 3, tid);
#endif
                    for (int i = tid; i < 1032; i += NTHR) { const int rel = i >> 3, h = i & 7; dl[i] = (h < 6 && rel < 128) ? (a.rel_bias[(int)T5B[rel] * 6 + h] - a.rel_bias[31 * 6 + h]) * LOG2E : 0.f; } for (int i = tid; i < 512; i += NTHR) { const unsigned nb = ((unsigned)(i >> 1) >> (4 * (i & 1))) & 15u; ((unsigned*)(lds + attn_body::LDS_TAB))[i] = (nb & 1u ? 0xffu : 0u) | (nb & 2u ? 0xff00u : 0u) | (nb & 4u ? 0xff0000u : 0u) | (nb & 8u ? 0xff000000u : 0u); }
                    __syncthreads(); }
#endif
#if ATT_PRIO
                if (__builtin_amdgcn_readfirstlane(tid) >= 256) __builtin_amdgcn_s_setprio(1);
#endif
                for (int rp = 0; rp < REP_ATT; ++rp) { unsigned* qctr = (unsigned*)(a.ws + WS_CTL) + CW_QUEUE + 64 * (l * 4 + rp + 2 * rpw);
                for (;;) { asm volatile("" : "+v"(tid));
                    __syncthreads();
                    if (tid == 0) MISC[16] = __hip_atomic_fetch_add(qctr, 1u, __ATOMIC_RELAXED, __HIP_MEMORY_SCOPE_AGENT);
                    __syncthreads();
                    const int k = (int)MISC[16];
                    if (k >= 48 * 32) break;
                    const int qb = 31 - k / 48, bh = k % 48;
                    attn_body::attn_unit<24>(bh / 6, bh % 6, qb, AT.Q, AT.K, AT.V, AT.O, AT.GT, AT.MK, (attn_body::lds_cfptr)(LAS const float*)((LAS unsigned char*)lds + 86016), (char*)lds, tid); } }
#if ATT_PRIO
                __builtin_amdgcn_s_setprio(0);
#endif
            }
#endif
            SEAM();
        }
        LAUNDER();
        if (IN(5)) {
            pg8::Gemm g{XB, (const bf16*)(a.ws + WS_WOUT) + (size_t)l * 1024 * 1024, M, DM, DM}; pg8::StaticOrder S; S.init(M, DM, G, wg);
            pg8::EpiRes E{(bf16*)(a.ws + WS_XA), DM, (float*)(a.ws + WS_RS)};
            pg8::gemm_phase<pg8::EpiRes, pg8::StaticOrder, true, true>((PG8_LAS unsigned char*)lds, g, S, E, tid);
#if REP_OUT == 2
            { asm volatile("" : "+v"(tid)); __syncthreads(); pg8::EpiRes E2{(bf16*)(a.ws + WS_P), DM, (float*)(a.ws + WS_P) + (size_t)M * DM}; pg8::gemm_phase<pg8::EpiRes, pg8::StaticOrder, true, true>((PG8_LAS unsigned char*)lds, g, S, E2, tid); }
#endif
            SEAM();
        }
    }
    }
    LAUNDER();
    if (IN(6)) final_norm_phase((const bf16*)(a.ws + WS_XA), a.out, a.final_g, (const float*)(a.ws + WS_RS), gw, NGW, lane);
#undef IN
#undef SEAM
}

extern "C" void kernel_launch(void* const* d_in, const int* in_sizes, int n_in, void* d_out, int out_size, void* d_ws, size_t ws_size, hipStream_t stream) {
    static int grid = 0;
    if (grid == 0) {
        if (n_in != 11 || in_sizes[0] != M * DM || out_size != M * DM || ws_size < WS_END) { fprintf(stderr, "kernel_launch: unexpected shapes (n_in %d, in0 %d, out %d, ws %zu); nothing launched\n", n_in, n_in > 0 ? in_sizes[0] : -1, out_size, ws_size); grid = -1; return; }
        int dev = 0, cus = 0, per_cu = 0;
        if (hipGetDevice(&dev) != hipSuccess || hipDeviceGetAttribute(&cus, hipDeviceAttributeMultiprocessorCount, dev) != hipSuccess) { grid = -1; return; }
        if (hipFuncSetAttribute((const void*)fwd, hipFuncAttributeMaxDynamicSharedMemorySize, LDS_BYTES) != hipSuccess) { fprintf(stderr, "kernel_launch: hipFuncSetAttribute failed\n"); grid = -1; return; }
        if (hipOccupancyMaxActiveBlocksPerMultiprocessor(&per_cu, (const void*)fwd, NTHR, LDS_BYTES) != hipSuccess || per_cu < 1) fprintf(stderr, "kernel_launch: occupancy query reports %d\n", per_cu);
        (void)hipGetLastError();
        grid = cus;
    }
    if (grid < 0) return;
    if (hipMemsetAsync((char*)d_ws + WS_CTL, 0, CTL_ZERO_BYTES, stream) != hipSuccess) return;
    Args a{};
    a.x = (const float*)d_in[0]; a.norm_g = (const float*)d_in[1]; a.w_in = (const float*)d_in[2]; a.gate_w2 = (const float*)d_in[3]; a.gate_b = (const float*)d_in[4]; a.gla_norm_g = (const float*)d_in[5];
    a.rel_bias = (const float*)d_in[6]; a.pool_w = (const float*)d_in[7]; a.pool_scale = (const float*)d_in[8]; a.w_out = (const float*)d_in[9]; a.final_g = (const float*)d_in[10];
    a.out = (float*)d_out; a.ws = (unsigned char*)d_ws; a.pad = 0;
#if MK_SINGLE
    a.l_lo = 0; a.l_hi = DEPTH; a.ph_lo = 0; a.ph_hi = 7; a.single = 1;
    hipLaunchKernelGGL(fwd, dim3(grid), dim3(NTHR), LDS_BYTES, stream, a);
#else
    a.single = 0;
    a.l_lo = 0; a.l_hi = 0; a.ph_lo = 0; a.ph_hi = 1; hipLaunchKernelGGL(fwd, dim3(grid), dim3(NTHR), LDS_BYTES, stream, a);
    for (int l = 0; l < DEPTH; ++l) for (int ph = 1; ph <= 5; ++ph) { a.l_lo = l; a.l_hi = l + 1; a.ph_lo = ph; a.ph_hi = ph + 1; hipLaunchKernelGGL(fwd, dim3(grid), dim3(NTHR), LDS_BYTES, stream, a); }
    a.l_lo = 0; a.l_hi = 0; a.ph_lo = 6; a.ph_hi = 7; hipLaunchKernelGGL(fwd, dim3(grid), dim3(NTHR), LDS_BYTES, stream, a);
#endif
    const hipError_t le = hipPeekAtLastError();
    if (le != hipSuccess) fprintf(stderr, "kernel_launch: launch failed: %s\n", hipGetErrorName(le));
}
```

```cpp
#include <hip/hip_runtime.h>
#include <cstdio>
#include <cstdint>
namespace pg8 {
#define PG8_LAS __attribute__((address_space(3)))
typedef unsigned short bf16_t;
typedef short bf16x8 __attribute__((ext_vector_type(8)));
typedef float f32x4 __attribute__((ext_vector_type(4)));
typedef unsigned u32x4 __attribute__((ext_vector_type(4)));
constexpr int BM = 256, BK = 64, HALF = 128, HTB = HALF * BK * 2  , STAGE_BYTES = 8 * HTB, NXCD = 8, WGM = 8;

__host__ __device__ __forceinline__ int lds_byte(int r, int c) { const int st = (r >> 4) * 2 + (c >> 5), rr = r & 15, cc = c & 31, ob = rr * 64 + cc * 2; return st * 1024 + (ob ^ (((ob >> 9) & 1) << 5)); }
__host__ __device__ __forceinline__ void stage_rc(int b, int& R, int& C) { const int st = b / 1024, sb = b % 1024, swz = sb ^ (((sb >> 9) & 1) << 5); R = (st >> 1) * 16 + swz / 64; C = (st & 1) * 32 + (swz % 64) / 2; }
__host__ __device__ __forceinline__ int perm32(int rho) { const int n = rho >> 4, i = rho & 15; return 8 * (i >> 2) + 4 * n + (i & 3); }

struct Unit { int pm, pn; };
struct Gemm { const bf16_t* A; const bf16_t* Bt; int M, N, K; };

struct StaticOrder {
    int nM, nN, nwg, G, c;
    __host__ __device__ void init(int M, int N, int G_, int c_) { nM = M / BM; nN = N / BM; nwg = nM * nN; G = G_; c = c_; }
    __host__ __device__ bool next(int i, Unit& u) const {
        const long L = (long)i * G + c; if (L >= nwg) return false;
        int wgid = (int)L; { const int q = nwg / NXCD, r = nwg % NXCD, xcd = wgid % NXCD, off = wgid / NXCD; wgid = (xcd < r ? xcd * (q + 1) : r * (q + 1) + (xcd - r) * q) + off; }
        const int nig = WGM * nN, gid = wgid / nig, fm = gid * WGM, gsz = (nM - fm) < WGM ? (nM - fm) : WGM;
        u.pm = fm + ((wgid % nig) % gsz); u.pn = (wgid % nig) / gsz; return true;
    }
    __device__ __forceinline__ void a_ready(const Unit&) const {}
    __device__ __forceinline__ void done(const Unit&) const {}
};

__device__ __forceinline__ unsigned cvt_pk_bf16(float lo, float hi) { unsigned r; asm volatile("v_cvt_pk_bf16_f32 %0, %1, %2" : "=v"(r) : "v"(lo), "v"(hi)); return r; }
typedef float f32x2 __attribute__((ext_vector_type(2)));
struct EpiP {
    static constexpr bool PERM = true, AFTER_DRAIN = false;
    bf16_t* O; int ldc; const float* RS; bf16_t* KC;
    __device__ __forceinline__ void operator()(const f32x4 (&acc)[2][2][4][2], const Unit& u, int wr, int wc, int fr, int fq) const {
        const int row0 = u.pm * BM + wr * 64 + fr, col0 = u.pn * BM + wc * 32 + 8 * fq;
#pragma unroll
        for (int ai = 0; ai < 2; ++ai)
#pragma unroll
            for (int m = 0; m < 4; ++m) { const int row = row0 + ai * HALF + m * 16; bf16_t* rowp = O + (size_t)row * ldc + col0;
                const float r = RS[row];
#pragma unroll
                for (int bj = 0; bj < 2; ++bj) { const f32x4 v0 = acc[ai][bj][m][0] * r, v1 = acc[ai][bj][m][1] * r;
                    u32x4 w; w.x = cvt_pk_bf16(v0[0], v0[1]); w.y = cvt_pk_bf16(v0[2], v0[3]); w.z = cvt_pk_bf16(v1[0], v1[1]); w.w = cvt_pk_bf16(v1[2], v1[3]);
                    if (col0 + bj * HALF < 3384) *(u32x4*)(rowp + bj * HALF) = w;
                    if (bj == 0 && wc == 0 && u.pn == 13) *(u32x4*)(KC + (size_t)row * 32 + 8 * fq) = w; } }
    }
};
struct EpiRes {
    static constexpr bool PERM = true, AFTER_DRAIN = false;
    bf16_t* XA; int ldc; float* RS;
    __device__ __forceinline__ void operator()(const f32x4 (&acc)[2][2][4][2], const Unit& u, int wr, int wc, int fr, int fq) const {
        const int row0 = u.pm * BM + wr * 64 + fr, col0 = u.pn * BM + wc * 32 + 8 * fq, lane = fr + 16 * fq;
#pragma unroll
        for (int ai = 0; ai < 2; ++ai)
#pragma unroll
            for (int m = 0; m < 4; ++m) { const int row = row0 + ai * HALF + m * 16; const size_t off = (size_t)row * ldc + col0; float s = 0.f;
#pragma unroll
                for (int bj = 0; bj < 2; ++bj) { const u32x4 b = *(const u32x4*)(XA + off + bj * HALF); u32x4 w;
#pragma unroll
                    for (int k = 0; k < 4; ++k) { const float lo = __uint_as_float(b[k] << 16) + acc[ai][bj][m][k >> 1][2 * (k & 1)], hi = __uint_as_float(b[k] & 0xffff0000u) + acc[ai][bj][m][k >> 1][2 * (k & 1) + 1];
                        w[k] = cvt_pk_bf16(lo, hi); const float rl = __uint_as_float(w[k] << 16), rh = __uint_as_float(w[k] & 0xffff0000u); s += rl * rl + rh * rh; }
                    *(u32x4*)(XA + off + bj * HALF) = w; }
                s += __builtin_bit_cast(float, __builtin_amdgcn_ds_bpermute((lane ^ 16) << 2, __builtin_bit_cast(int, s)));
                s += __builtin_bit_cast(float, __builtin_amdgcn_ds_bpermute((lane ^ 32) << 2, __builtin_bit_cast(int, s)));
                if (fq == 0) RS[(size_t)row * 16 + u.pn * 4 + wc] = s; }
    }
};
template <class Epi, class Sched, bool ALIGN_EPI = false, bool SP2 = false>
__device__ __forceinline__ void gemm_phase(PG8_LAS unsigned char* lds, const Gemm g, const Sched& S, const Epi& E, const int tid) {
    const int wid = __builtin_amdgcn_readfirstlane(tid >> 6), lane = tid & 63, wr = wid >> 2, wc = wid & 3, fr = lane & 15, fq = lane >> 4;
    const int K = g.K, nt = K / BK;
    unsigned voffA[2], voffB[2];
#pragma unroll
    for (int i = 0; i < 2; ++i) { int R, C; stage_rc(tid * 16 + i * 8192, R, C); const int Rb = Epi::PERM ? ((R & ~31) + perm32(R & 31)) : R;
        voffA[i] = (unsigned)(R * K + C) * 2u; voffB[i] = (unsigned)(Rb * K + C) * 2u; }
    const size_t kstep = (size_t)(BK * 2);
    const size_t hstep = (size_t)HALF * K * 2;
    const size_t tstep = 2 * hstep;
    const unsigned ldsw = (unsigned)wid * 1024u;
    const int aoff = lds_byte(wr * 64 + fr, fq * 8), boff = lds_byte(wc * 32 + fr, fq * 8);
#define PG8_SA(b, h) (((b) * 2 + (h)) * HTB)
#define PG8_SB(b, h) ((4 + (b) * 2 + (h)) * HTB)
#define PG8_STAGE(bufoff, gbase, voff) do { _Pragma("unroll") for (int _i = 0; _i < 2; ++_i) \
        __builtin_amdgcn_global_load_lds((const unsigned*)((const char*)(gbase) + (voff)[_i]), (PG8_LAS unsigned*)(lds + (bufoff) + ldsw + _i * 8192), 16, 0, 0); } while (0)
#define PG8_LDA(dst, b, h) do { _Pragma("unroll") for (int m = 0; m < 4; ++m) _Pragma("unroll") for (int k = 0; k < 2; ++k) dst[m][k] = *(const PG8_LAS bf16x8*)(lds + PG8_SA(b, h) + aoff + m * 2048 + k * 1024); } while (0)
#define PG8_LDB(dst, b, h) do { _Pragma("unroll") for (int n = 0; n < 2; ++n) _Pragma("unroll") for (int k = 0; k < 2; ++k) dst[n][k] = *(const PG8_LAS bf16x8*)(lds + PG8_SB(b, h) + boff + n * 2048 + k * 1024); } while (0)
#define PG8_MMA(ai, bj, At, Bt) do { __builtin_amdgcn_s_setprio(1); _Pragma("unroll") for (int m = 0; m < 4; ++m) _Pragma("unroll") for (int n = 0; n < 2; ++n) _Pragma("unroll") for (int k = 0; k < 2; ++k) \
        acc[ai][bj][m][n] = __builtin_amdgcn_mfma_f32_16x16x32_bf16(Bt[n][k], At[m][k], acc[ai][bj][m][n], 0, 0, 0); __builtin_amdgcn_s_setprio(0); } while (0)
#define PG8_WAIT_V(n) asm volatile("s_waitcnt vmcnt(" #n ")" ::: "memory")
#define PG8_WAIT_L(n) asm volatile("s_waitcnt lgkmcnt(" #n ")" ::: "memory")
#define PG8_BAR __builtin_amdgcn_s_barrier()
#define PG8_SCHED __builtin_amdgcn_sched_barrier(0)
    Unit cur, nxt; int ui = 0;
    if (!S.next(0, cur)) return;
    f32x4 acc[2][2][4][2];
#pragma unroll
    for (int a = 0; a < 2; ++a)
#pragma unroll
        for (int b = 0; b < 2; ++b)
#pragma unroll
            for (int m = 0; m < 4; ++m)
#pragma unroll
                for (int n = 0; n < 2; ++n) acc[a][b][m][n] = (f32x4){0.f, 0.f, 0.f, 0.f};
    bf16x8 At[4][2], B0[2][2], B1[2][2];
    const char* cA = (const char*)g.A + (size_t)cur.pm * tstep; const char* cB = (const char*)g.Bt + (size_t)cur.pn * tstep;
    S.a_ready(cur);
    if constexpr (SP2) {
        PG8_STAGE(PG8_SB(0, 0), cB, voffB); PG8_STAGE(PG8_SB(0, 1), cB + hstep, voffB); PG8_STAGE(PG8_SA(0, 0), cA, voffA); PG8_STAGE(PG8_SA(0, 1), cA + hstep, voffA);
        if (wr == 1) PG8_BAR;
        PG8_WAIT_V(2); PG8_BAR;
        PG8_STAGE(PG8_SB(1, 0), cB + kstep, voffB); PG8_STAGE(PG8_SA(1, 0), cA + kstep, voffA); PG8_STAGE(PG8_SB(1, 1), cB + hstep + kstep, voffB);
        PG8_WAIT_V(6); PG8_BAR;
    } else {
        PG8_STAGE(PG8_SB(0, 0), cB, voffB); PG8_STAGE(PG8_SA(0, 0), cA, voffA); PG8_STAGE(PG8_SB(0, 1), cB + hstep, voffB); PG8_STAGE(PG8_SA(0, 1), cA + hstep, voffA);
        if (wr == 1) PG8_BAR;
        PG8_WAIT_V(4); PG8_BAR;
        PG8_STAGE(PG8_SB(1, 0), cB + kstep, voffB); PG8_STAGE(PG8_SA(1, 0), cA + kstep, voffA); PG8_STAGE(PG8_SB(1, 1), cB + hstep + kstep, voffB);
        PG8_WAIT_V(6); PG8_BAR;
    }
    for (;;) {
        const bool has_next = S.next(ui + 1, nxt);
        const char* nA = has_next ? (const char*)g.A + (size_t)nxt.pm * tstep : cA; const char* nB = has_next ? (const char*)g.Bt + (size_t)nxt.pn * tstep : cB;
        for (int t = 0; t < nt; t += 2) {
            const bool last = (t == nt - 2);
            const char* a1 = cA + (size_t)(t + 1) * kstep;
            const char* a2 = last ? nA : cA + (size_t)(t + 2) * kstep; const char* b2 = last ? nB : cB + (size_t)(t + 2) * kstep;
            const char* a3 = a2 + kstep; const char* b3 = b2 + kstep;
            if (last && has_next) S.a_ready(nxt);
            if constexpr (SP2) {
            PG8_LDB(B0, 0, 0); PG8_LDB(B1, 0, 1); PG8_SCHED; PG8_LDA(At, 0, 0); PG8_STAGE(PG8_SA(1, 1), a1 + hstep, voffA);
            PG8_WAIT_V(8); PG8_WAIT_L(0); PG8_BAR; PG8_MMA(0, 0, At, B0); PG8_MMA(0, 1, At, B1); PG8_BAR; PG8_SCHED;
            PG8_LDA(At, 0, 1); PG8_STAGE(PG8_SB(0, 0), b2, voffB); PG8_STAGE(PG8_SB(0, 1), b2 + hstep, voffB); PG8_STAGE(PG8_SA(0, 0), a2, voffA);
            PG8_WAIT_V(8); PG8_WAIT_L(0); PG8_BAR; PG8_MMA(1, 0, At, B0); PG8_MMA(1, 1, At, B1); PG8_BAR; PG8_SCHED;
            PG8_LDB(B0, 1, 0); PG8_LDB(B1, 1, 1); PG8_SCHED; PG8_LDA(At, 1, 0); PG8_STAGE(PG8_SA(0, 1), a2 + hstep, voffA);
            PG8_WAIT_V(8); PG8_WAIT_L(0); PG8_BAR; PG8_MMA(0, 0, At, B0); PG8_MMA(0, 1, At, B1); PG8_BAR; PG8_SCHED;
            PG8_LDA(At, 1, 1); PG8_STAGE(PG8_SB(1, 0), b3, voffB); PG8_STAGE(PG8_SB(1, 1), b3 + hstep, voffB); PG8_STAGE(PG8_SA(1, 0), a3, voffA);
            PG8_WAIT_V(8); PG8_WAIT_L(0); PG8_BAR; PG8_MMA(1, 0, At, B0); PG8_MMA(1, 1, At, B1); PG8_BAR; PG8_SCHED;
            } else {
            PG8_LDB(B0, 0, 0); PG8_SCHED; PG8_LDA(At, 0, 0); PG8_STAGE(PG8_SA(1, 1), a1 + hstep, voffA);
            PG8_WAIT_L(8); PG8_BAR; PG8_WAIT_L(0); PG8_MMA(0, 0, At, B0); PG8_BAR; PG8_SCHED;
            PG8_LDB(B1, 0, 1); PG8_STAGE(PG8_SB(0, 0), b2, voffB);
            PG8_BAR; PG8_WAIT_L(0); PG8_MMA(0, 1, At, B1); PG8_BAR;
            PG8_LDA(At, 0, 1); PG8_STAGE(PG8_SA(0, 0), a2, voffA);
            PG8_BAR; PG8_WAIT_L(0); PG8_MMA(1, 0, At, B0); PG8_BAR; PG8_SCHED;
            PG8_STAGE(PG8_SB(0, 1), b2 + hstep, voffB);
            PG8_WAIT_V(6); PG8_BAR; PG8_MMA(1, 1, At, B1); PG8_BAR;
            PG8_LDB(B0, 1, 0); PG8_SCHED; PG8_LDA(At, 1, 0); PG8_STAGE(PG8_SA(0, 1), a2 + hstep, voffA);
            PG8_WAIT_L(8); PG8_BAR; PG8_WAIT_L(0); PG8_MMA(0, 0, At, B0); PG8_BAR; PG8_SCHED;
            PG8_LDB(B1, 1, 1); PG8_STAGE(PG8_SB(1, 0), b3, voffB);
            PG8_BAR; PG8_WAIT_L(0); PG8_MMA(0, 1, At, B1); PG8_BAR;
            PG8_LDA(At, 1, 1); PG8_STAGE(PG8_SA(1, 0), a3, voffA);
            PG8_BAR; PG8_WAIT_L(0); PG8_MMA(1, 0, At, B0); PG8_BAR; PG8_SCHED;
            PG8_STAGE(PG8_SB(1, 1), b3 + hstep, voffB);
            PG8_WAIT_V(6); PG8_BAR; PG8_MMA(1, 1, At, B1); PG8_BAR;
            }
        }
        if constexpr (ALIGN_EPI) { if (wr == 0) PG8_BAR; }
        if constexpr (!Epi::AFTER_DRAIN) { E(acc, cur, wr, wc, fr, fq); S.done(cur); }
        if (!has_next) break;
#pragma unroll
        for (int a = 0; a < 2; ++a)
#pragma unroll
            for (int b = 0; b < 2; ++b)
#pragma unroll
                for (int m = 0; m < 4; ++m)
#pragma unroll
                    for (int n = 0; n < 2; ++n) acc[a][b][m][n] = (f32x4){0.f, 0.f, 0.f, 0.f};
        cur = nxt; cA = nA; cB = nB; ++ui;
        if constexpr (ALIGN_EPI) { if (wr == 1) PG8_BAR; }
    }
    PG8_WAIT_V(0);
    if constexpr (!ALIGN_EPI) { if (wr == 0) PG8_BAR; }
    PG8_BAR;
    if constexpr (Epi::AFTER_DRAIN) { E.fused(acc, cur, wr, wc, fr, fq, lds, wid, lane); S.done(cur); }
#undef PG8_SA
#undef PG8_SB
#undef PG8_STAGE
#undef PG8_LDA
#undef PG8_LDB
#undef PG8_MMA
#undef PG8_WAIT_V
#undef PG8_WAIT_L
#undef PG8_BAR
#undef PG8_SCHED
}
}
#include <hip/hip_bf16.h>
#include <cmath>
namespace attn_body {
using bf16=__hip_bfloat16;
using bf16x8=__attribute__((ext_vector_type(8)))short;
using s16x4=__attribute__((ext_vector_type(4)))short;
using f32x16=__attribute__((ext_vector_type(16)))float;
using u32x4=__attribute__((ext_vector_type(4)))unsigned;
constexpr int BATCH=8,NHEAD=6,SEQ=8192,D=64,DM=3584,DMO=1024;
constexpr int NW=8,QBLK=32,QB=QBLK*NW,KVBLK=64,NQB=SEQ/QB;
constexpr int ATTN_UNIT_ROWS=QB;
__device__ __forceinline__ int crow(int r,int hi){return (r&3)+8*(r>>2)+4*hi;}
#define SBAR() __builtin_amdgcn_sched_barrier(0)
typedef __attribute__((address_space(3))) const float* lds_cfptr;
__device__ __forceinline__ void biasadd(f32x16&p0,f32x16&p1,int tt,int tq,int hi,lds_cfptr dl,int h){
  const int rb=tq-64*tt-4*hi; const lds_cfptr dh=dl+h;
  #pragma unroll
  for(int r=0;r<16;++r){ const unsigned i0=(unsigned)(rb-(r&3)-8*(r>>2)), i1=i0-32u;
    float a0=dh[(i0<128u?i0:128u)*8], a1=dh[(i1<128u?i1:128u)*8];
    asm volatile("s_waitcnt lgkmcnt(0)":"+v"(a0),"+v"(a1)::"memory");
    p0[r]+=a0; p1[r]+=a1; }
}
typedef unsigned u32x2m __attribute__((ext_vector_type(2)));
template<int K> __device__ __forceinline__ float mands(float p,unsigned md){ return __uint_as_float(__float_as_uint(p)&(unsigned)(K==3?((int)md>>24):(int)(signed char)(md>>(8*K)))); }
template<int K> __device__ __forceinline__ float mandk(float p,unsigned bits){ unsigned m; asm("v_bfe_i32 %0, %1, %2, 1":"=v"(m):"v"(bits),"n"(K)); return __uint_as_float(__float_as_uint(p)&m); }
__device__ __forceinline__ float mand(float p,unsigned bits,int k){ return __uint_as_float(__float_as_uint(p)&(unsigned)__builtin_amdgcn_sbfe((int)bits,k,1)); }

constexpr int NSLOT=3, SLOTB=8192;
constexpr int LDS_K=0, LDS_V=NSLOT*SLOTB, LDS_TAB=2*NSLOT*SLOTB, LDS_OST=LDS_TAB+2048, LDS_WS=LDS_OST+NW*4096, LDS_BYTES=LDS_WS+NW*64*4, LDS_QST=90624;
constexpr float C2=0.125f*1.4426950408889634f;
__device__ __forceinline__ void glds16(const void*gsrc,unsigned lds_dst){unsigned keep;
  asm volatile("s_mov_b32 %0, m0\n\ts_mov_b32 m0, %2\n\ts_nop 0\n\tglobal_load_lds_dwordx4 %1, off\n\ts_mov_b32 m0, %0":"=&s"(keep):"v"(gsrc),"s"(lds_dst):"memory");}
__device__ __forceinline__ float max3f(float a,float b,float c){float r;asm("v_max3_f32 %0, %1, %2, %3":"=v"(r):"v"(a),"v"(b),"v"(c));return r;}
__device__ __forceinline__ float max2f(float a,float b){float r;asm("v_max_f32_e32 %0, %1, %2":"=v"(r):"v"(a),"v"(b));return r;}
__device__ __forceinline__ float fadd_s(float a,float b){float r;asm("v_add_f32_e32 %0, %1, %2":"=v"(r):"v"(a),"v"(b));return r;}
__device__ __forceinline__ float fsub_s(float a,float b){float r;asm("v_sub_f32_e32 %0, %1, %2":"=v"(r):"v"(a),"v"(b));return r;}
typedef float f32x2_t __attribute__((ext_vector_type(2))); typedef __bf16 bf16x2_t __attribute__((ext_vector_type(2)));
__device__ __forceinline__ unsigned cvtpk_s(float lo,float hi){f32x2_t v={lo,hi};bf16x2_t b=__builtin_convertvector(v,bf16x2_t);return __builtin_bit_cast(unsigned,b);}
#define WAIT_BAR(N) asm volatile("s_waitcnt vmcnt(" #N ") lgkmcnt(0)\n\ts_barrier":::"memory")

__device__ __forceinline__ void qkt(f32x16&p0,f32x16&p1,const char*Kslot,const bf16x8*qr,const f32x16&negm,int r32,int hi){
  const char*kb=Kslot+hi*1024+r32*16;
  #pragma unroll
  for(int d0=0;d0<4;++d0){
    const bf16x8 b0=*reinterpret_cast<const bf16x8*>(kb+d0*2048);
    const bf16x8 b1=*reinterpret_cast<const bf16x8*>(kb+d0*2048+512);
    if(d0==0){p0=__builtin_amdgcn_mfma_f32_32x32x16_bf16(b0,qr[0],negm,0,0,0);p1=__builtin_amdgcn_mfma_f32_32x32x16_bf16(b1,qr[0],negm,0,0,0);}
    else{p0=__builtin_amdgcn_mfma_f32_32x32x16_bf16(b0,qr[d0],p0,0,0,0);p1=__builtin_amdgcn_mfma_f32_32x32x16_bf16(b1,qr[d0],p1,0,0,0);}}
}
typedef __attribute__((address_space(3))) const char* lds_cptr;
typedef short v4i16_t __attribute__((ext_vector_type(4)));
__device__ __forceinline__ void kload8(bf16x8*kf,lds_cptr kp){
  kf[0]=*(const __attribute__((address_space(3))) bf16x8*)(kp);      kf[1]=*(const __attribute__((address_space(3))) bf16x8*)(kp+512);
  kf[2]=*(const __attribute__((address_space(3))) bf16x8*)(kp+2048); kf[3]=*(const __attribute__((address_space(3))) bf16x8*)(kp+2560);
  kf[4]=*(const __attribute__((address_space(3))) bf16x8*)(kp+4096); kf[5]=*(const __attribute__((address_space(3))) bf16x8*)(kp+4608);
  kf[6]=*(const __attribute__((address_space(3))) bf16x8*)(kp+6144); kf[7]=*(const __attribute__((address_space(3))) bf16x8*)(kp+6656);
}
__device__ __forceinline__ void kload2(bf16x8*kf,lds_cptr kp,int j){ kf[2*j]=*(const __attribute__((address_space(3))) bf16x8*)(kp+j*2048); kf[2*j+1]=*(const __attribute__((address_space(3))) bf16x8*)(kp+j*2048+512); }
__device__ __forceinline__ s16x4 vtr(lds_cptr p){ return __builtin_bit_cast(s16x4,__builtin_amdgcn_ds_read_tr16_b64_v4i16((__attribute__((address_space(3))) v4i16_t*)p)); }
__device__ __forceinline__ float rowmax(const f32x16&p0,const f32x16&p1){
  float a=max3f(p0[0],p0[1],p1[0]),b=max3f(p0[2],p0[3],p1[1]);a=max3f(a,p1[2],p1[3]);
  #pragma unroll
  for(int r=4;r<16;r+=4){a=max3f(a,p0[r],p0[r+1]);b=max3f(b,p0[r+2],p0[r+3]);a=max3f(a,p1[r],p1[r+1]);b=max3f(b,p1[r+2],p1[r+3]);}
  const float m=max2f(a,b);
  auto rr=__builtin_amdgcn_permlane32_swap(__float_as_uint(m),__float_as_uint(m),false,false);
  return max2f(__uint_as_float(rr[0]),__uint_as_float(rr[1]));
}
__device__ __forceinline__ void pv(f32x16*o,int vb,bf16x8 pa0,bf16x8 pa1,bf16x8 pa2,bf16x8 pa3){
  #pragma unroll
  for(int d0=0;d0<2;++d0){s16x4 lo[4],hi[4];
    #pragma unroll
    for(int ks=0;ks<4;++ks){
      asm volatile("ds_read_b64_tr_b16 %0,%1 offset:%c2":"=&v"(lo[ks]):"v"(vb),"i"(d0*4096+ks*1024):"memory");
      asm volatile("ds_read_b64_tr_b16 %0,%1 offset:%c2":"=&v"(hi[ks]):"v"(vb),"i"(d0*4096+ks*1024+512):"memory");}
    asm volatile("s_waitcnt lgkmcnt(0)":::"memory");SBAR();
    #define PK(k) (bf16x8){lo[k][0],lo[k][1],lo[k][2],lo[k][3],hi[k][0],hi[k][1],hi[k][2],hi[k][3]}
    o[d0]=__builtin_amdgcn_mfma_f32_32x32x16_bf16(pa0,PK(0),o[d0],0,0,0);
    o[d0]=__builtin_amdgcn_mfma_f32_32x32x16_bf16(pa1,PK(1),o[d0],0,0,0);
    o[d0]=__builtin_amdgcn_mfma_f32_32x32x16_bf16(pa2,PK(2),o[d0],0,0,0);
    o[d0]=__builtin_amdgcn_mfma_f32_32x32x16_bf16(pa3,PK(3),o[d0],0,0,0);
    #undef PK
  }
}

#ifndef ATTN_STORE16
#define ATTN_STORE16(p,v) (*(u32x4*)(p)=(v))
#endif
template<int THRL> __device__ __forceinline__ void attn_unit(int b,int h,int qb,const bf16*Q,const bf16*__restrict__ K,const bf16*__restrict__ V,bf16*O,const bf16*GT,const unsigned*MK,lds_cfptr dl,char*shm,const int tid){
  const int lane=tid&63,r32=lane&31,hi=lane>>5; const int wid=__builtin_amdgcn_readfirstlane(tid>>6);
  const long rowbase=(long)b*SEQ; const int q0=qb*QB;
  const bf16*Qw=Q+(rowbase+q0+wid*QBLK)*DM+h*D;
  const bf16*Kh=K+rowbase*DM+h*D,*Vh=V+rowbase*DM+h*D;
  const unsigned lds0=(unsigned)(uintptr_t)shm;
  float*wsf=(float*)(shm+LDS_WS)+wid*64;
  const bf16*ksrc=Kh+(long)lane*DM+wid*8;
  const bf16*vsrc=Vh+(long)(16*(wid&3)+(lane>>2))*DM+(wid>>2)*32+(lane&3)*8;
  const unsigned kdst=lds0+LDS_K+wid*1024, vdst=lds0+LDS_V+wid*1024;
  #define DMA_K(t,slot) glds16(ksrc+(long)(t)*KVBLK*DM,(unsigned)__builtin_amdgcn_readfirstlane(kdst+(slot)))
  #define DMA_V(t,slot) glds16(vsrc+(long)(t)*KVBLK*DM,(unsigned)__builtin_amdgcn_readfirstlane(vdst+(slot)))
  const int vb0=(int)(lds0+LDS_V)+((lane>>4)&1)*32+(lane&3)*8+(4*hi+((lane&15)>>2))*64;
  const char*Kbase=shm+LDS_K; bf16x8 kf[8];
  const lds_cptr shm3=(lds_cptr)shm; const lds_cptr kp0=shm3+LDS_K+hi*1024+r32*16; const lds_cptr vp0=shm3+LDS_V+((lane>>4)&1)*32+(lane&3)*8+(4*hi+((lane&15)>>2))*64;
  const int NT=(q0+QB)/KVBLK;
  DMA_K(0,0);DMA_V(0,0);DMA_K(1,SLOTB);
  const __attribute__((address_space(3))) char* shm3q=(const __attribute__((address_space(3))) char*)shm;
  bf16x8 qr[4];
  #pragma unroll
  for(int d0=0;d0<4;++d0)qr[d0]=*reinterpret_cast<const bf16x8*>(&Qw[(long)r32*DM+d0*16+hi*8]);
  const __attribute__((address_space(3))) bf16x8* qls=(const __attribute__((address_space(3))) bf16x8*)(shm3q+LDS_QST+wid*4096)+lane;
  #pragma unroll
  for(int d0=0;d0<4;++d0)((__attribute__((address_space(3))) bf16x8*)qls)[64*d0]=qr[d0];
  float mhat=0.f,l_reg=0.f;f32x16 o[2];o[0]=f32x16{};o[1]=f32x16{};float nmh=0.f;
  const int tq=q0+wid*QBLK+r32;
  const unsigned*mbase=MK+((size_t)(b*256+(q0>>5)+wid)*128)*64;
  unsigned bits_cur=mbase[lane],bits_next=mbase[64+lane];
  #define CMASK(P0,P1,t) do{ if((t)>=NT-6)biasadd(P0,P1,(t),tq,hi,dl,h);}while(0)
  bool resc=false;
  #define START(P0,P1) do{ const float rm=rowmax(P0,P1); resc=false; \
    { const float dl=(rm>(float)THRL||rm<-(float)THRL)?rm:0.f; mhat=fadd_s(mhat,dl);     \
      _Pragma("unroll") for(int r=0;r<16;++r){P0[r]=fsub_s(P0[r],dl);P1[r]=fsub_s(P1[r],dl);} \
      nmh=-mhat; } \
    _Pragma("unroll") for(int r=0;r<16;++r)P0[r]=mand(__builtin_amdgcn_exp2f(P0[r]),bits_cur,r); }while(0)
  #define RESC() do{ if(resc){ asm volatile("s_waitcnt lgkmcnt(0)":::"memory"); \
      _Pragma("unroll") for(int d_=0;d_<2;++d_) _Pragma("unroll") for(int r=0;r<16;++r)o[d_][r]*=wsf[crow(r,hi)]; } }while(0)
  f32x16 pA0,pA1,pB0,pB1;
  int sl_prev=0,sl_cur=0,sl_next=SLOTB;
  #define ROT() do{sl_prev=sl_cur;sl_cur=sl_next;sl_next=(sl_next==(NSLOT-1)*SLOTB)?0:sl_next+SLOTB;}while(0)
  DMA_K(2,2*SLOTB);
  WAIT_BAR(3);
  { const f32x16 zc=f32x16{}; qkt(pA0,pA1,Kbase,qr,zc,r32,hi); }asm volatile("s_nop 15\n\ts_nop 7":"+v"(pA0),"+v"(pA1));CMASK(pA0,pA1,0);
  START(pA0,pA1);
  _Pragma("unroll") for(int r=0;r<16;++r)pA1[r]=mand(__builtin_amdgcn_exp2f(pA1[r]),bits_cur,16+r);
  WAIT_BAR(0);
  DMA_K(3,0);DMA_V(1,SLOTB);
  ROT();
  kload8(kf,kp0+sl_cur);
  WAIT_BAR(2);
  u32x2m mk01,mk23,mk45,mk67;
  s16x4 vlo[8],vhi[8]; u32x4 pw0,pw1,pw2,pw3; bf16x8 qa_=qls[0],qb_;
  #define PKW(P,B) cvtpk_s(P[B],P[B+1])
  #define PAF(k) __builtin_bit_cast(bf16x8,pw##k)
  #define VFR(i) (bf16x8){vlo[i][0],vlo[i][1],vlo[i][2],vlo[i][3],vhi[i][0],vhi[i][1],vhi[i][2],vhi[i][3]}
  #define PIN(x) asm volatile("":"+v"(x))
  #define MX3(a,b,c) __builtin_fmaxf(__builtin_fmaxf((a),(b)),(c))
  #define GAPA(MF,A0,A1,A2,A3,W0,W1,PW) do{ MF; sacc+=A0; sacc+=A1; sacc+=A2; sacc+=A3; PIN(sacc); W0; W1; PIN(PW); SBAR(); }while(0)
  #define EX(v) __builtin_amdgcn_exp2f(v)
  #define MKD(e) (((e)>>2)==0?mk01[0]:((e)>>2)==1?mk01[1]:((e)>>2)==2?mk23[0]:((e)>>2)==3?mk23[1]:((e)>>2)==4?mk45[0]:((e)>>2)==5?mk45[1]:((e)>>2)==6?mk67[0]:mk67[1])
  #define GAPB(MF,X,B,MB) do{ MF; { const unsigned md_=MKD((MB)+(B)); X[B]=mands<0>(EX(X[B]),md_); X[B+1]=mands<1>(EX(X[B+1]),md_); X[B+2]=mands<2>(EX(X[B+2]),md_); X[B+3]=mands<3>(EX(X[B+3]),md_); } PIN(X); SBAR(); }while(0)
  #define VRD(i) do{ vlo[i]=vtr(vp_+(((i)>>2)*4096+((i)&3)*1024)); vhi[i]=vtr(vp_+(((i)>>2)*4096+((i)&3)*1024+512)); }while(0)
  #define KRD(G,j) do{ if(G){ kload2(kf,kp0+sl_next,j); SBAR(); } }while(0)
  #define STEP(C0,C1,P0,P1,t,GK,GV,GL) do{ SBAR(); \
    bits_cur=bits_next; if(GV){ bits_next=mbase[64*((t)+1)+lane]; } \
    { typedef const __attribute__((address_space(3))) u32x2m* tp_;     \
      mk01=*(tp_)(LDS_TAB+(((unsigned)(unsigned char)(bits_cur))<<3)); mk23=*(tp_)(LDS_TAB+(((unsigned)(unsigned char)(bits_cur>>8))<<3)); mk45=*(tp_)(LDS_TAB+(((unsigned)(unsigned char)(bits_cur>>16))<<3)); mk67=*(tp_)(LDS_TAB+((bits_cur>>24)<<3)); } \
    const lds_cptr vp_=vp0+sl_prev; \
    VRD(0); qb_=qls[64]; SBAR(); float sacc=(P0[0]+P0[1]); \
    if(!__any(nmh!=0.f)){ const f32x16 zc_=f32x16{}; \
      GAPA(C0=__builtin_amdgcn_mfma_f32_32x32x16_bf16(kf[0],qa_,zc_,0,0,0), P0[2],P0[3],P0[4],P0[5],     pw0[0]=PKW(P0,0), pw0[1]=PKW(P0,2), pw0); \
      VRD(4); SBAR(); GAPA(C1=__builtin_amdgcn_mfma_f32_32x32x16_bf16(kf[1],qa_,zc_,0,0,0), P0[6],P0[7],P0[8],P0[9],     pw0[2]=PKW(P0,4), pw0[3]=PKW(P0,6), pw0); \
    }else{ f32x16 negm; { float nm_=nmh; asm volatile("":"+v"(nm_)); _Pragma("unroll") for(int r=0;r<16;++r)negm[r]=nm_; } \
      GAPA(C0=__builtin_amdgcn_mfma_f32_32x32x16_bf16(kf[0],qa_,negm,0,0,0), P0[2],P0[3],P0[4],P0[5],     pw0[0]=PKW(P0,0), pw0[1]=PKW(P0,2), pw0); \
      VRD(4); SBAR(); GAPA(C1=__builtin_amdgcn_mfma_f32_32x32x16_bf16(kf[1],qa_,negm,0,0,0), P0[6],P0[7],P0[8],P0[9],     pw0[2]=PKW(P0,4), pw0[3]=PKW(P0,6), pw0); } \
    VRD(1); qa_=qls[128]; SBAR(); GAPA(C0=__builtin_amdgcn_mfma_f32_32x32x16_bf16(kf[2],qb_,C0,0,0,0),   P0[10],P0[11],P0[12],P0[13], pw1[0]=PKW(P0,8), pw1[1]=PKW(P0,10), pw1); \
    VRD(5); SBAR(); GAPA(C1=__builtin_amdgcn_mfma_f32_32x32x16_bf16(kf[3],qb_,C1,0,0,0),   P0[14],P0[15],P1[0],P1[1],   pw1[2]=PKW(P0,12),pw1[3]=PKW(P0,14), pw1); \
    VRD(2); qb_=qls[192]; SBAR(); GAPA(C0=__builtin_amdgcn_mfma_f32_32x32x16_bf16(kf[4],qa_,C0,0,0,0),   P1[2],P1[3],P1[4],P1[5],     pw2[0]=PKW(P1,0), pw2[1]=PKW(P1,2), pw2); \
    VRD(6); SBAR(); GAPA(C1=__builtin_amdgcn_mfma_f32_32x32x16_bf16(kf[5],qa_,C1,0,0,0),   P1[6],P1[7],P1[8],P1[9],     pw2[2]=PKW(P1,4), pw2[3]=PKW(P1,6), pw2); \
    VRD(3); qa_=qls[0]; SBAR(); GAPA(C0=__builtin_amdgcn_mfma_f32_32x32x16_bf16(kf[6],qb_,C0,0,0,0),   P1[10],P1[11],P1[12],P1[13], pw3[0]=PKW(P1,8), pw3[1]=PKW(P1,10), pw3); \
    VRD(7); SBAR(); GAPA(C1=__builtin_amdgcn_mfma_f32_32x32x16_bf16(kf[7],qb_,C1,0,0,0),   P1[14],P1[15],0.f,0.f,       pw3[2]=PKW(P1,12),pw3[3]=PKW(P1,14), pw3); \
    l_reg+=sacc; \
    if(GK){DMA_K((t)+3,sl_cur);} if(GV){DMA_V((t)+1,sl_next);} \
    CMASK(C0,C1,t); \
    { float a=MX3(C0[0],C0[1],C1[0]),b=MX3(C0[2],C0[3],C1[1]); a=MX3(a,C1[2],C1[3]); \
      _Pragma("unroll") for(int r=4;r<16;r+=4){a=MX3(a,C0[r],C0[r+1]);b=MX3(b,C0[r+2],C0[r+3]);a=MX3(a,C1[r],C1[r+1]);b=MX3(b,C1[r+2],C1[r+3]);} \
      float rm=__builtin_fmaxf(a,b); { auto rr=__builtin_amdgcn_permlane32_swap(__float_as_uint(rm),__float_as_uint(rm),false,false); rm=__builtin_fmaxf(__uint_as_float(rr[0]),__uint_as_float(rr[1])); } \
      resc=false; \
      if(__builtin_expect(__any(rm>(float)THRL),0)){ const float dl=__builtin_fmaxf(rm,0.f); mhat+=dl; \
        _Pragma("unroll") for(int r=0;r<16;++r){C0[r]-=dl;C1[r]-=dl;} \
        nmh=-mhat; \
        const float f=__builtin_amdgcn_exp2f(-dl); l_reg*=f; if(hi==0)wsf[r32]=f; resc=true; } } \
    SBAR(); \
    GAPB(o[0]=__builtin_amdgcn_mfma_f32_32x32x16_bf16(PAF(0),VFR(0),o[0],0,0,0), C0,0,0); \
    GAPB(o[1]=__builtin_amdgcn_mfma_f32_32x32x16_bf16(PAF(0),VFR(4),o[1],0,0,0), C0,4,0); \
    KRD(GL,0); GAPB(o[0]=__builtin_amdgcn_mfma_f32_32x32x16_bf16(PAF(1),VFR(1),o[0],0,0,0), C0,8,0); \
    KRD(GL,1); GAPB(o[1]=__builtin_amdgcn_mfma_f32_32x32x16_bf16(PAF(1),VFR(5),o[1],0,0,0), C0,12,0); \
    KRD(GL,2); GAPB(o[0]=__builtin_amdgcn_mfma_f32_32x32x16_bf16(PAF(2),VFR(2),o[0],0,0,0), C1,0,16); \
    KRD(GL,3); GAPB(o[1]=__builtin_amdgcn_mfma_f32_32x32x16_bf16(PAF(2),VFR(6),o[1],0,0,0), C1,4,16); \
    GAPB(o[0]=__builtin_amdgcn_mfma_f32_32x32x16_bf16(PAF(3),VFR(3),o[0],0,0,0), C1,8,16); \
    GAPB(o[1]=__builtin_amdgcn_mfma_f32_32x32x16_bf16(PAF(3),VFR(7),o[1],0,0,0), C1,12,16); \
    }while(0)
  int t=1;
  #undef CMASK
  #define CMASK(P0,P1,t) do{}while(0)
  for(;t+7<NT;t+=2){
    STEP(pB0,pB1,pA0,pA1,t,true,true,true);     WAIT_BAR(2); RESC(); ROT();
    STEP(pA0,pA1,pB0,pB1,t+1,true,true,true);   WAIT_BAR(2); RESC(); ROT();
  }
  #undef CMASK
  #define CMASK(P0,P1,t) do{ if((t)>=NT-6)biasadd(P0,P1,(t),tq,hi,dl,h);}while(0)
  #define ENDW(tt) do{ if((tt)+3<NT){WAIT_BAR(2);} else if((tt)+2<NT){WAIT_BAR(1);} else {WAIT_BAR(0);} }while(0)
  for(;t+1<NT;t+=2){
    STEP(pB0,pB1,pA0,pA1,t,(t+3<NT),(t+1<NT),(t+1<NT));       ENDW(t);   RESC(); ROT();
    STEP(pA0,pA1,pB0,pB1,t+1,(t+4<NT),(t+2<NT),(t+2<NT));     ENDW(t+1); RESC(); ROT();
  }
  STEP(pB0,pB1,pA0,pA1,NT-1,false,false,false); RESC();
  { float sacc=pB0[0]+pB0[1]; _Pragma("unroll") for(int r=2;r<16;++r)sacc+=pB0[r]; _Pragma("unroll") for(int r=0;r<16;++r)sacc+=pB1[r]; l_reg+=sacc;
    pw0=(u32x4){PKW(pB0,0),PKW(pB0,2),PKW(pB0,4),PKW(pB0,6)};pw1=(u32x4){PKW(pB0,8),PKW(pB0,10),PKW(pB0,12),PKW(pB0,14)};pw2=(u32x4){PKW(pB1,0),PKW(pB1,2),PKW(pB1,4),PKW(pB1,6)};pw3=(u32x4){PKW(pB1,8),PKW(pB1,10),PKW(pB1,12),PKW(pB1,14)};
    SBAR(); pv(o,vb0+sl_cur,PAF(0),PAF(1),PAF(2),PAF(3)); }
  #undef PKW
  #undef PAF
  #undef VFR
  #undef PIN
  #undef MX3
  #undef GAPA
  #undef GAPB
  #undef EX
  #undef VRD
  #undef KRD
  #undef STEP
  #undef ENDW
  {auto rr=__builtin_amdgcn_permlane32_swap(__float_as_uint(l_reg),__float_as_uint(l_reg),false,false);l_reg=__uint_as_float(rr[0])+__uint_as_float(rr[1]);}
  if(hi==0)wsf[32+r32]=l_reg;asm volatile("s_waitcnt lgkmcnt(0)":::"memory");
  float rli[16];
  #pragma unroll
  for(int r=0;r<16;++r)rli[r]=__builtin_amdgcn_rcpf(wsf[32+crow(r,hi)]);
  bf16*Ow=O+(rowbase+q0+wid*QBLK)*DMO+h*D; const bf16*Gw=GT+(rowbase+q0+wid*QBLK)*DM+h*D;
  { bf16*stg=(bf16*)(shm+LDS_OST)+wid*2048;
    #pragma unroll
    for(int r=0;r<16;++r){const int orow=crow(r,hi);
      #pragma unroll
      for(int d0=0;d0<2;++d0)stg[orow*64+d0*32+r32]=__float2bfloat16(o[d0][r]*rli[r]);}
    asm volatile("s_waitcnt lgkmcnt(0)":::"memory");
    #pragma unroll
    for(int i=0;i<4;++i){const int row=i*8+(lane>>3),ch=lane&7; const u32x4 v=*(const u32x4*)(stg+row*64+ch*8); const u32x4 g=*(const u32x4*)(Gw+(long)row*DM+ch*8); u32x4 w;
      #pragma unroll
      for(int k=0;k<4;++k){ const float g0=__uint_as_float(g[k]<<16),g1=__uint_as_float(g[k]&0xffff0000u); const float v0=__uint_as_float(v[k]<<16),v1=__uint_as_float(v[k]&0xffff0000u);
        w[k]=cvtpk_s(v0*(g0/(1.0f+__expf(-g0))),v1*(g1/(1.0f+__expf(-g1)))); }
      ATTN_STORE16(Ow+(long)row*DMO+ch*8,w);} }
  asm volatile("s_waitcnt lgkmcnt(0)\n\ts_barrier":::"memory");
  #undef DMA_K
  #undef DMA_V
  #undef CMASK
  #undef START
  #undef RESC
  #undef ROT
}
constexpr int ATTN_LDS_BYTES=LDS_BYTES;
struct AttnTensors { const bf16* Q; const bf16* K; const bf16* V; bf16* O; const bf16* GT; const unsigned* MK; };
struct AttnUnit { int bh; int qb; };
struct StaticOrder {
  int wg,G;
  __device__ __forceinline__ explicit StaticOrder(int grid,int block):wg(block),G(grid){}
  __device__ __forceinline__ bool next(int i,AttnUnit&u)const{ const int p=wg+(i>>1)*G; if(p>=768)return false; const int s=p&15; u.bh=p>>4; u.qb=(i&1)?31-s:s; return true; }
  __device__ __forceinline__ void a_ready(const AttnUnit&)const{}
  __device__ __forceinline__ void done(const AttnUnit&)const{}
};
template<class Sched,int THRL=8> __device__ __forceinline__ void attn_phase(char*lds,const AttnTensors&T,lds_cfptr dl,const Sched&S,int tid){
  AttnUnit u;
  for(int i=0;S.next(i,u);++i){ asm volatile("":"+v"(tid)); S.a_ready(u); attn_unit<THRL>(u.bh/NHEAD,u.bh%NHEAD,u.qb,T.Q,T.K,T.V,T.O,T.GT,T.MK,dl,lds,tid); S.done(u); }
}
#undef SBAR
#undef WAIT_BAR
}

constexpr int NWAVES = 8, NTHR = 512;
constexpr int BATCH = 8, SEQ = 8192, DM = 1024, DEPTH = 4, M = BATCH * SEQ;
constexpr int IN_COLS = 3380, NP = 3584;
constexpr float EPS = 1e-6f;
constexpr int N_GQ = 0, N_GK = 192, N_GV = 384, N_GG = 768, N_DQ = 1152, N_DK = 1536, N_DV = 1920, N_DG = 2304, N_PU = 2688, N_PG = 2944, N_QI = 3200, N_KI = 3328, N_GZ = 3360, N_WI = 3376;
constexpr float LOG2E = 1.4426950408889634f;
constexpr size_t MiB = 1u << 20;
constexpr size_t WS_CTL = 0, CTL_ZERO_BYTES = 1 * MiB;
constexpr size_t WS_WIN = 2 * MiB;
constexpr size_t WS_WOUT = 32 * MiB;
constexpr size_t WS_XB = 48 * MiB;
constexpr size_t WS_P = 176 * MiB;
constexpr size_t WS_MASK = 624 * MiB;
constexpr size_t WS_GOP = 688 * MiB;
constexpr size_t WS_XA = 832 * MiB;
constexpr size_t WS_RSC = 44 * MiB;
constexpr size_t WS_RS = 40 * MiB;
constexpr size_t WS_ZW = 960 * MiB;
constexpr size_t WS_KC = 968 * MiB;
constexpr size_t WS_END = 972 * MiB;
constexpr int CW_BAR = 4096, CW_QUEUE = 8192;
constexpr int RING_BYTES = 131072, LDSCTL_OFF = RING_BYTES, MISC_OFF = LDSCTL_OFF + 320, LDS_BYTES = 147456;

#define GAS __attribute__((address_space(1)))
#define LAS __attribute__((address_space(3)))
typedef unsigned short bf16;
typedef unsigned v4u __attribute__((ext_vector_type(4)));
typedef unsigned v2u __attribute__((ext_vector_type(2)));
typedef float f32x4 __attribute__((ext_vector_type(4)));
typedef GAS unsigned gu32;
#define RLX_AGENT __ATOMIC_RELAXED, __HIP_MEMORY_SCOPE_AGENT
__device__ __forceinline__ unsigned f2bf(float f) { unsigned u = __builtin_bit_cast(unsigned, f); return (u + 0x7fffu + ((u >> 16) & 1u)) >> 16; }
__device__ __forceinline__ unsigned pk2(float lo, float hi) { return f2bf(lo) | (f2bf(hi) << 16); }
__device__ __forceinline__ float bf2f(unsigned short b) { return __builtin_bit_cast(float, (unsigned)b << 16); }
__device__ __forceinline__ float bflo(unsigned w) { return __builtin_bit_cast(float, w << 16); }
__device__ __forceinline__ float bfhi(unsigned w) { return __builtin_bit_cast(float, w & 0xffff0000u); }
__device__ __forceinline__ float shx(float v, int o, int lane) { return __builtin_bit_cast(float, __builtin_amdgcn_ds_bpermute((lane ^ o) << 2, __builtin_bit_cast(int, v))); }
__device__ __forceinline__ int shdn(int v, int o, int lane) { return __builtin_amdgcn_ds_bpermute(((lane + o) & 63) << 2, v); }
__device__ __forceinline__ float wave_sum(float v, int lane) {
#pragma unroll
    for (int o = 1; o < 64; o <<= 1) v += shx(v, o, lane);
    return v;
}
__device__ __forceinline__ float silu_f(float x) { return x / (1.0f + __expf(-x)); }

__constant__ unsigned char T5B[128] = {0, 1, 2, 3, 4, 5, 6, 7, 8, 9, 10, 11, 12, 13, 14, 15, 16, 16, 16, 17, 17, 18, 18, 18, 19, 19, 19, 20, 20, 20, 20, 21, 21, 21, 21, 22, 22, 22, 22, 22, 23, 23, 23, 23, 23, 23, 24, 24, 24, 24, 24, 24, 25, 25, 25, 25, 25, 25, 25, 26, 26, 26, 26, 26, 26, 26, 26, 27, 27, 27, 27, 27, 27, 27, 27, 27, 27, 28, 28, 28, 28, 28, 28, 28, 28, 28, 28, 29, 29, 29, 29, 29, 29, 29, 29, 29, 29, 29, 29, 30, 30, 30, 30, 30, 30, 30, 30, 30, 30, 30, 30, 30, 30, 31, 31, 31, 31, 31, 31, 31, 31, 31, 31, 31, 31, 31, 31, 31};
__device__ __forceinline__ int t5_bucket(int rel) { return rel >= 128 ? 31 : (int)T5B[rel]; }

#define XB_TMO      128
#define XB_XCNT(j)  (256  + 64 * (j))
#define XB_XSUB(j)  (1280 + 64 * (j))
#define XB_XGEN(j)  (2304 + 64 * (j))
#define XB_TOP      3328
#define XB_TOPGEN   3392
#define XCD_BAR_WORDS 3456
#define XB_SPIN_CAP (1u << 22)

__device__ __forceinline__ unsigned xb_ld(unsigned* p)              { return __hip_atomic_load(p, __ATOMIC_RELAXED, __HIP_MEMORY_SCOPE_AGENT); }
__device__ __forceinline__ unsigned xb_add(unsigned* p, unsigned v) { return __hip_atomic_fetch_add(p, v, __ATOMIC_RELAXED, __HIP_MEMORY_SCOPE_AGENT); }
__device__ __forceinline__ unsigned xb_xcc_id() { return (unsigned)__builtin_amdgcn_s_getreg((3 << 11) | 20) & 0xFu; }
#define XB_SPIN(cond, bar) do { unsigned _sp = 0; while (cond) { __builtin_amdgcn_s_sleep(1); \
    if ((++_sp & 255u) == 0u) { if (xb_ld(&(bar)[XB_TMO])) break; if (_sp > XB_SPIN_CAP) { atomicAdd(&(bar)[XB_TMO], 1u); break; } } } } while (0)

struct XcdBarrier {
    unsigned* bar; unsigned x;
    volatile LAS unsigned* st;
};

__device__ __forceinline__ XcdBarrier xcd_barrier_post(unsigned* bar, volatile LAS unsigned* st) {
    XcdBarrier b; b.bar = bar; b.x = xb_xcc_id(); b.st = st;
    if (threadIdx.x == 0) (void)xb_add(&bar[XB_XCNT(b.x)], 1u);
    return b;
}
__device__ __forceinline__ void xcd_barrier_complete(unsigned* bar, unsigned x, unsigned& nloc, unsigned& nx) {
    const unsigned G = gridDim.x * gridDim.y * gridDim.z;
    unsigned sum, cnt, mine, sp = 0u;
    for (;;) {
        sum = 0u; cnt = 0u; mine = 0u;
#pragma unroll
        for (unsigned j = 0; j < 16; ++j) { const unsigned c = xb_ld(&bar[XB_XCNT(j)]); sum += c; cnt += (c > 0u) ? 1u : 0u; mine = (j == x) ? c : mine; }
        if (sum == G) break;
        __builtin_amdgcn_s_sleep(1);
        if ((++sp & 255u) == 0u) { if (xb_ld(&bar[XB_TMO])) break; if (sp > XB_SPIN_CAP) { atomicAdd(&bar[XB_TMO], 1u); break; } }
    }
    nloc = mine > 0u ? mine : 1u; nx = cnt > 0u ? cnt : 1u;
}

__device__ __forceinline__ void xcd_barrier(const XcdBarrier& b) {
    asm volatile("s_waitcnt vmcnt(0)" ::: "memory");
    __syncthreads();
    if (threadIdx.x == 0) {
        unsigned* bar = b.bar;
        __builtin_amdgcn_s_waitcnt(0);
        unsigned nloc = b.st[0], nx = b.st[1];
        if (nloc == 0u) { xcd_barrier_complete(bar, b.x, nloc, nx); b.st[0] = nloc; b.st[1] = nx; }
        const unsigned old = xb_add(&bar[XB_XSUB(b.x)], 1u);
        const unsigned gen = old / nloc;
        if (old + 1u == (gen + 1u) * nloc) {
            __builtin_amdgcn_fence(__ATOMIC_RELEASE, "agent");
            asm volatile("s_waitcnt vmcnt(0)" ::: "memory");
            const unsigned og = xb_add(&bar[XB_TOP], 1u);
            const unsigned tg = og / nx;
            if (og + 1u == (tg + 1u) * nx) xb_add(&bar[XB_TOPGEN], 1u);
            else XB_SPIN(xb_ld(&bar[XB_TOPGEN]) == tg, bar);
            __builtin_amdgcn_fence(__ATOMIC_ACQUIRE, "agent");
            xb_add(&bar[XB_XGEN(b.x)], 1u);
            asm volatile("s_waitcnt vmcnt(0)" ::: "memory");
        } else {
            XB_SPIN(xb_ld(&bar[XB_XGEN(b.x)]) == gen, bar);
            __builtin_amdgcn_fence(__ATOMIC_ACQUIRE, "agent");
            asm volatile("s_waitcnt vmcnt(0)" ::: "memory");
        }
    }
    __syncthreads();
}
#ifndef IDX_NOFALLBACK
#define IDX_NOFALLBACK 0
#endif
#ifndef REP_RES
#define REP_RES 1
#endif
#ifndef REP_PATCH
#define REP_PATCH 1
#endif
#ifndef REP_P1
#define REP_P1 1
#endif
#ifndef REP_P3
#define REP_P3 1
#endif
#ifndef REP_HEAD
#define REP_HEAD 1
#endif
#ifndef REP_RES
#define REP_RES 1
#endif
#ifndef REP_P2
#define REP_P2 1
#endif
#ifndef REP_RANK
#define REP_RANK 1
#endif
#ifndef IDX_PRIO
#define IDX_PRIO 1
#endif
#ifndef IDX_PKFMA
#define IDX_PKFMA 0
#endif
#ifndef PROBE_MFMA2
#define PROBE_MFMA2 0
#endif
#ifndef PROBE_ADD2
#define PROBE_ADD2 0
#endif
#ifndef IDX_ASMFMA
#define IDX_ASMFMA 0
#endif
#ifndef IDX_ASMBIN
#define IDX_ASMBIN 0
#endif
namespace idxb {
typedef short bf16x8 __attribute__((ext_vector_type(8)));
typedef float f32x16 __attribute__((ext_vector_type(16)));
constexpr int ZBIN = 0, NBINS = 512, CAP = 256;
constexpr int L_HIST = 0, L_ZC = 65536, L_PAR = 81920, L_KBUF = 83968, L_XT = 116736;
enum { P_BSTAR = 0, P_KK, P_CCNT, P_TAU, P_CUT, P_MODE, P_TSTAR, P_RSTAR, P_OVF, P_NRANK, P_PRE, P_XL, P_XU, P_ANY3 };
__device__ __forceinline__ unsigned lds_add(unsigned* p, unsigned v) { return __hip_atomic_fetch_add((__attribute__((address_space(3))) unsigned*)p, v, __ATOMIC_RELAXED, __HIP_MEMORY_SCOPE_WORKGROUP); }
__device__ __forceinline__ int crow(int r, int hi) { return (r & 3) + 8 * (r >> 2) + 4 * hi; }
struct QFrag { bf16x8 q[4][2]; float w[4]; };
__device__ __forceinline__ f32x16 score_sub(const bf16x8 k0, const bf16x8 k1, const QFrag& Q) {
    f32x16 acc;
#pragma unroll
    for (int r = 0; r < 16; ++r) acc[r] = 0.f;
    const f32x16 zz = {0.f, 0.f, 0.f, 0.f, 0.f, 0.f, 0.f, 0.f, 0.f, 0.f, 0.f, 0.f, 0.f, 0.f, 0.f, 0.f};
    float INFV; asm("s_mov_b32 %0, 0x7f800000" : "=s"(INFV));
#pragma unroll
    for (int hp = 0; hp < 2; ++hp) {
        f32x16 d0 = __builtin_amdgcn_mfma_f32_32x32x16_bf16(k0, Q.q[2 * hp][0], zz, 0, 0, 0), d1 = __builtin_amdgcn_mfma_f32_32x32x16_bf16(k0, Q.q[2 * hp + 1][0], zz, 0, 0, 0);
        d0 = __builtin_amdgcn_mfma_f32_32x32x16_bf16(k1, Q.q[2 * hp][1], d0, 0, 0, 0); d1 = __builtin_amdgcn_mfma_f32_32x32x16_bf16(k1, Q.q[2 * hp + 1][1], d1, 0, 0, 0);
#if PROBE_MFMA2
        { f32x16 e0 = __builtin_amdgcn_mfma_f32_32x32x16_bf16(k0, Q.q[2 * hp][1], zz, 0, 0, 0); e0 = __builtin_amdgcn_mfma_f32_32x32x16_bf16(k1, Q.q[2 * hp][0], e0, 0, 0, 0);
          e0 = __builtin_amdgcn_mfma_f32_32x32x16_bf16(k0, Q.q[2 * hp + 1][1], e0, 0, 0, 0); e0 = __builtin_amdgcn_mfma_f32_32x32x16_bf16(k1, Q.q[2 * hp + 1][0], e0, 0, 0, 0); asm volatile("" :: "v"(e0)); }
#endif
#if IDX_PKFMA
        { typedef float f32x2 __attribute__((ext_vector_type(2)));
            const f32x2 wa = {Q.w[2 * hp], Q.w[2 * hp]}, wb = {Q.w[2 * hp + 1], Q.w[2 * hp + 1]};
#pragma unroll
            for (int r = 0; r < 16; r += 2) { const f32x2 ra = {__builtin_amdgcn_fmed3f(d0[r], 0.f, INFV), __builtin_amdgcn_fmed3f(d0[r + 1], 0.f, INFV)}, rb = {__builtin_amdgcn_fmed3f(d1[r], 0.f, INFV), __builtin_amdgcn_fmed3f(d1[r + 1], 0.f, INFV)};
                f32x2 ac = {acc[r], acc[r + 1]}; ac = __builtin_elementwise_fma(wa, ra, ac); ac = __builtin_elementwise_fma(wb, rb, ac); acc[r] = ac[0]; acc[r + 1] = ac[1]; } }
#else
#pragma unroll
        for (int r = 0; r < 16; ++r) {
#if IDX_ASMFMA
            const float r0 = __builtin_amdgcn_fmed3f(d0[r], 0.f, INFV), r1 = __builtin_amdgcn_fmed3f(d1[r], 0.f, INFV); float a0 = acc[r], a1;
            if (hp == 0) asm("v_mul_f32 %0, %1, %2" : "=v"(a0) : "v"(Q.w[0]), "v"(r0)); else asm("v_fma_f32 %0, %1, %2, %3" : "=v"(a0) : "v"(Q.w[2]), "v"(r0), "v"(acc[r]));
            asm("v_fma_f32 %0, %1, %2, %3" : "=v"(a1) : "v"(Q.w[2 * hp + 1]), "v"(r1), "v"(a0)); acc[r] = a1;
#else
            acc[r] = __builtin_fmaf(Q.w[2 * hp + 1], __builtin_amdgcn_fmed3f(d1[r], 0.f, INFV), __builtin_fmaf(Q.w[2 * hp], __builtin_amdgcn_fmed3f(d0[r], 0.f, INFV), acc[r]));
#endif
        }
#endif
    }
    return acc;
}
constexpr int G0 = (int)(0x3F800000u >> 18);
typedef __attribute__((address_space(3))) unsigned lds_u32;
__device__ __forceinline__ void hist_add(unsigned hb, float x, unsigned inc) {
    const float xc = __builtin_amdgcn_fmed3f(x, -254.0f, 254.0f);
#if IDX_ASMBIN
    float os, y; const unsigned m = 0x7fffffffu;
    asm("v_bfi_b32 %0, %1, 1.0, %2" : "=v"(os) : "s"(m), "v"(xc));
    asm("v_add_f32 %0, %1, %2" : "=v"(y) : "v"(xc), "v"(os));
    unsigned sh; asm("v_lshrrev_b32 %0, 18, %1" : "=v"(sh) : "v"(y));
    const unsigned a = hb + (sh << 2);
#else
    const float y = xc + __uint_as_float((__float_as_uint(xc) & 0x80000000u) | 0x3F800000u);
    const unsigned a = hb + ((__float_as_uint(y) >> 18) << 2);
#endif
    __hip_atomic_fetch_add((lds_u32*)a, inc, __ATOMIC_RELAXED, __HIP_MEMORY_SCOPE_WORKGROUP);
#if PROBE_ADD2
    __hip_atomic_fetch_add((lds_u32*)(a ^ 64u), 0u, __ATOMIC_RELAXED, __HIP_MEMORY_SCOPE_WORKGROUP);
#endif
}
__device__ __forceinline__ int hword(int q, int h) { return ((h >> 8) << 13) + q * 256 + (h & 255); }
__device__ __forceinline__ int rank_to_bin(int k) { return k < 256 ? 255 - k : k; }
__device__ __forceinline__ float xthr(int ot) { if (ot == 0) return 0.f;
    const unsigned B = (unsigned)(G0 + ot) << 18; unsigned hi = __float_as_uint(__uint_as_float(B) - 1.0f), lo = 0u;
#pragma unroll 1
    for (int i = 0; i < 32; ++i) { const unsigned mid = lo + ((hi - lo) >> 1); if (__float_as_uint(__uint_as_float(mid) + 1.0f) >= B) hi = mid; else lo = mid; }
    return __uint_as_float(hi); }
__device__ __forceinline__ unsigned wave_or(unsigned v) { int x = (int)v;
    x |= __builtin_amdgcn_update_dpp(0, x, 0x111, 0xf, 0xf, true); x |= __builtin_amdgcn_update_dpp(0, x, 0x112, 0xf, 0xf, true);
    x |= __builtin_amdgcn_update_dpp(0, x, 0x114, 0xf, 0xf, true); x |= __builtin_amdgcn_update_dpp(0, x, 0x118, 0xf, 0xf, true);
    x |= __builtin_amdgcn_update_dpp(0, x, 0x142, 0xf, 0xf, true); x |= __builtin_amdgcn_update_dpp(0, x, 0x143, 0xf, 0xf, true);
    return (unsigned)__builtin_amdgcn_readlane(x, 63); }
__device__ __forceinline__ float sel32(const f32x16& a, const f32x16& b, int e) {
    const bool b0 = e & 1, b1 = e & 2, b2 = e & 4, b3 = e & 8, b4 = e & 16;
    float v0 = a[0], v1 = a[1], v2 = a[2], v3 = a[3], v4 = a[4], v5 = a[5], v6 = a[6], v7 = a[7], v8 = a[8], v9 = a[9], v10 = a[10], v11 = a[11], v12 = a[12], v13 = a[13], v14 = a[14], v15 = a[15], v16 = b[0], v17 = b[1], v18 = b[2], v19 = b[3], v20 = b[4], v21 = b[5], v22 = b[6], v23 = b[7], v24 = b[8], v25 = b[9], v26 = b[10], v27 = b[11], v28 = b[12], v29 = b[13], v30 = b[14], v31 = b[15];
    asm("" : "+v"(v0)); asm("" : "+v"(v1)); asm("" : "+v"(v2)); asm("" : "+v"(v3)); asm("" : "+v"(v4)); asm("" : "+v"(v5)); asm("" : "+v"(v6)); asm("" : "+v"(v7)); asm("" : "+v"(v8)); asm("" : "+v"(v9)); asm("" : "+v"(v10)); asm("" : "+v"(v11)); asm("" : "+v"(v12)); asm("" : "+v"(v13)); asm("" : "+v"(v14)); asm("" : "+v"(v15)); asm("" : "+v"(v16)); asm("" : "+v"(v17)); asm("" : "+v"(v18)); asm("" : "+v"(v19)); asm("" : "+v"(v20)); asm("" : "+v"(v21)); asm("" : "+v"(v22)); asm("" : "+v"(v23)); asm("" : "+v"(v24)); asm("" : "+v"(v25)); asm("" : "+v"(v26)); asm("" : "+v"(v27)); asm("" : "+v"(v28)); asm("" : "+v"(v29)); asm("" : "+v"(v30)); asm("" : "+v"(v31));
    const float p0 = b0 ? v1 : v0, p1 = b0 ? v3 : v2, p2 = b0 ? v5 : v4, p3 = b0 ? v7 : v6, p4 = b0 ? v9 : v8, p5 = b0 ? v11 : v10, p6 = b0 ? v13 : v12, p7 = b0 ? v15 : v14, p8 = b0 ? v17 : v16, p9 = b0 ? v19 : v18, p10 = b0 ? v21 : v20, p11 = b0 ? v23 : v22, p12 = b0 ? v25 : v24, p13 = b0 ? v27 : v26, p14 = b0 ? v29 : v28, p15 = b0 ? v31 : v30;
    const float q0 = b1 ? p1 : p0, q1 = b1 ? p3 : p2, q2 = b1 ? p5 : p4, q3 = b1 ? p7 : p6, q4 = b1 ? p9 : p8, q5 = b1 ? p11 : p10, q6 = b1 ? p13 : p12, q7 = b1 ? p15 : p14;
    const float r0 = b2 ? q1 : q0, r1 = b2 ? q3 : q2, r2 = b2 ? q5 : q4, r3 = b2 ? q7 : q6;
    const float s0 = b3 ? r1 : r0, s1 = b3 ? r3 : r2;
    return b4 ? s1 : s0; }
__device__ __forceinline__ unsigned spread_nib(unsigned x) { x = (x | (x << 8)) & 0x00FF00FFu; return (x | (x << 4)) & 0x0F0F0F0Fu; }


template <int HP, int MODE, bool NEXT>
__device__ __forceinline__ void pstage(f32x16& acc, const f32x16& dc0, const f32x16& dc1, f32x16& dn0, f32x16& dn1, const bf16x8 ka, const bf16x8 kb,
                                       const bf16x8 qa0, const bf16x8 qa1, const bf16x8 qb0, const bf16x8 qb1, const float wA, const float wB,
                                       const unsigned hb, const unsigned inc, const int s0, const int t, const int hi, const float XU, const float XL, unsigned& wn, unsigned& wl) {
    const f32x16 zz = {0.f, 0.f, 0.f, 0.f, 0.f, 0.f, 0.f, 0.f, 0.f, 0.f, 0.f, 0.f, 0.f, 0.f, 0.f, 0.f};
    float INFV; asm("s_mov_b32 %0, 0x7f800000" : "=s"(INFV));
#pragma unroll
    for (int c = 3; c >= 0; --c) {
        if (NEXT) {
            if (c == 3) dn0 = __builtin_amdgcn_mfma_f32_32x32x16_bf16(ka, qa0, zz, 0, 0, 0);
            else if (c == 2) dn1 = __builtin_amdgcn_mfma_f32_32x32x16_bf16(ka, qb0, zz, 0, 0, 0);
            else if (c == 1) dn0 = __builtin_amdgcn_mfma_f32_32x32x16_bf16(kb, qa1, dn0, 0, 0, 0);
            else dn1 = __builtin_amdgcn_mfma_f32_32x32x16_bf16(kb, qb1, dn1, 0, 0, 0);
            __builtin_amdgcn_sched_barrier(0);
        }
#pragma unroll
        for (int r = 4 * c + 3; r >= 4 * c; --r) {
            const float r0 = __builtin_amdgcn_fmed3f(dc0[r], 0.f, INFV), r1 = __builtin_amdgcn_fmed3f(dc1[r], 0.f, INFV);
            float x = __builtin_fmaf(wB, r1, __builtin_fmaf(wA, r0, HP == 0 ? 0.f : acc[r]));
            if (MODE == 4) { if (s0 + crow(r, hi) > t) x = -__builtin_inff(); }
            acc[r] = x;
            if (MODE == 1) hist_add(hb, x, inc);
            if (MODE == 2) { if (s0 + crow(r, hi) <= t) hist_add(hb, x, inc); }
            if (MODE == 3 || MODE == 4) { const float t1 = x - XU, t2 = x - XL; wn = __builtin_amdgcn_alignbit(wn, __float_as_uint(t1), 31); wl = __builtin_amdgcn_alignbit(wl, __float_as_uint(t2), 31); }
        }
        if (NEXT) __builtin_amdgcn_sched_barrier(0);
    }
}
__device__ __forceinline__ void index_unit(const unsigned short* P, const unsigned short* KC, unsigned* MK, unsigned* ZWg, unsigned char* lds, int b, int qt, int tid) {
    const int lane = tid & 63, wave = __builtin_amdgcn_readfirstlane(tid >> 6), r32 = lane & 31, hi = lane >> 5;
    unsigned* hist32 = (unsigned*)(lds + L_HIST); unsigned* cand_s = (unsigned*)(lds + L_HIST); unsigned* cand_i = (unsigned*)(lds + L_HIST + 32768);     unsigned* zc = (unsigned*)(lds + L_ZC); int* par = (int*)(lds + L_PAR);
    const int t = qt * 32 + r32; const size_t qrow = (size_t)b * SEQ + t;
    const int kt_max = (qt * 32 + 31) >> 6, NTW = ((qt >> 3) + 1) * 4;
    const unsigned short* KI = KC + (size_t)b * SEQ * 32;
    QFrag Q; float invw;
    for (int rh_ = 0; rh_ < REP_HEAD; ++rh_) { asm volatile("" ::: "memory");
    { const unsigned short* qp = P + qrow * NP + N_QI + hi * 8; float var = 0.f;
#pragma unroll
        for (int h = 0; h < 4; ++h) { float s = 0.f;
#pragma unroll
            for (int ks = 0; ks < 2; ++ks) { Q.q[h][ks] = *(const bf16x8*)(qp + h * 32 + ks * 16);
#pragma unroll
                for (int j = 0; j < 8; ++j) { const float v = bf2f((unsigned short)Q.q[h][ks][j]); s += v * v; } }
            s += shx(s, 32, lane); Q.w[h] = bf2f(P[qrow * NP + N_WI + h]); var += Q.w[h] * Q.w[h] * s; }
        invw = 82.7f / sqrtf(var > 1e-20f ? var : 1e-20f);
#pragma unroll
        for (int h = 0; h < 4; ++h) Q.w[h] *= invw; }
    __syncthreads();
    { typedef unsigned u32x4z __attribute__((ext_vector_type(4))); for (int i = tid; i < (L_PAR + 2048) / 16; i += NTHR) ((__attribute__((address_space(3))) u32x4z*)lds)[i] = (u32x4z){0u, 0u, 0u, 0u}; }
    __syncthreads(); }
    __attribute__((address_space(3))) unsigned char* kbuf = (__attribute__((address_space(3))) unsigned char*)lds + L_KBUF + wave * 4096;
#define IDX_KISSUE(kt_) do { const unsigned short* kp_ = KI + (size_t)(kt_) * 2048 + lane * 8;        \
        __builtin_amdgcn_global_load_lds((const unsigned*)kp_, (__attribute__((address_space(3))) unsigned*)kbuf, 16, 0, 0); \
        __builtin_amdgcn_global_load_lds((const unsigned*)(kp_ + 512), (__attribute__((address_space(3))) unsigned*)(kbuf + 1024), 16, 0, 0); \
        __builtin_amdgcn_global_load_lds((const unsigned*)(kp_ + 1024), (__attribute__((address_space(3))) unsigned*)(kbuf + 2048), 16, 0, 0); \
        __builtin_amdgcn_global_load_lds((const unsigned*)(kp_ + 1536), (__attribute__((address_space(3))) unsigned*)(kbuf + 3072), 16, 0, 0); } while (0)
#define IDX_KREAD(dst) do { const int ko_ = r32 * 64 + hi * 16;                                     \
        dst[0] = *(__attribute__((address_space(3))) bf16x8*)(kbuf + ko_); dst[1] = *(__attribute__((address_space(3))) bf16x8*)(kbuf + ko_ + 32); \
        dst[2] = *(__attribute__((address_space(3))) bf16x8*)(kbuf + ko_ + 2048); dst[3] = *(__attribute__((address_space(3))) bf16x8*)(kbuf + ko_ + 2080); } while (0)
#define IDX_KTAKE(dst, cnt_) do { asm volatile("s_waitcnt vmcnt(" cnt_ ")" ::: "memory"); IDX_KREAD(dst); asm volatile("s_waitcnt lgkmcnt(0)" ::: "memory"); } while (0)
    const unsigned hb = (unsigned)(size_t)((__attribute__((address_space(3))) unsigned char*)lds) + L_HIST + r32 * 1024 - 4 * G0;
#if IDX_PRIO
    if (wave >= 4) __builtin_amdgcn_s_setprio(1);
#endif
    const int qlo = qt * 32;
#define IDX_PRO(dA, dB) do { const f32x16 zz_ = {0.f, 0.f, 0.f, 0.f, 0.f, 0.f, 0.f, 0.f, 0.f, 0.f, 0.f, 0.f, 0.f, 0.f, 0.f, 0.f}; \
        dA = __builtin_amdgcn_mfma_f32_32x32x16_bf16(kc[0], Q.q[0][0], zz_, 0, 0, 0); dB = __builtin_amdgcn_mfma_f32_32x32x16_bf16(kc[0], Q.q[1][0], zz_, 0, 0, 0); \
        dA = __builtin_amdgcn_mfma_f32_32x32x16_bf16(kc[1], Q.q[0][1], dA, 0, 0, 0); dB = __builtin_amdgcn_mfma_f32_32x32x16_bf16(kc[1], Q.q[1][1], dB, 0, 0, 0); } while (0)
#define IDX_QHI Q.q[2][0], Q.q[2][1], Q.q[3][0], Q.q[3][1]
#define IDX_QLO Q.q[0][0], Q.q[0][1], Q.q[1][0], Q.q[1][1]
    for (int rp1 = 0; rp1 < REP_P1; ++rp1) { bf16x8 kc[4]; const unsigned inc1 = (rp1 & 1) ? 0xffffffffu : 1u; if (wave <= kt_max) IDX_KISSUE(wave);
      for (int kt = wave; kt <= kt_max; kt += 8) {
        IDX_KTAKE(kc, "0"); if (kt + 8 <= kt_max) IDX_KISSUE(kt + 8);
        if (kt * 64 + 63 <= qlo) {
#pragma unroll
            for (int sub = 0; sub < 2; ++sub) { const f32x16 sc = score_sub(kc[2 * sub], kc[2 * sub + 1], Q);
#pragma unroll
                for (int r = 0; r < 16; ++r) hist_add(hb, sc[r], inc1); }
        } else {
#pragma unroll
            for (int sub = 0; sub < 2; ++sub) { const f32x16 sc = score_sub(kc[2 * sub], kc[2 * sub + 1], Q); const int s0 = kt * 64 + sub * 32;
#pragma unroll
                for (int r = 0; r < 16; ++r) { if (s0 + crow(r, hi) <= t) hist_add(hb, sc[r], inc1); } }
        }
      } }
    __syncthreads();
    for (int rr_ = 0; rr_ < REP_RES; ++rr_) { __syncthreads(); asm volatile("" ::: "memory");
    { typedef unsigned u32x4r __attribute__((ext_vector_type(4)));
        const int q = tid >> 4, j = tid & 15, N = qt * 32 + q + 1; const bool neg = j >= 8;
        const unsigned* hs = hist32 + (neg ? 8192 + q * 256 + 32 * (j - 8) : q * 256 + 224 - 32 * j); int c = 0;
#pragma unroll
        for (int u = 0; u < 8; ++u) { const u32x4r v = *(const u32x4r*)(hs + 4 * ((u + (j >> 1)) & 7)); c += (int)(v[0] + v[1] + v[2] + v[3]); }
        int incl = c;
#pragma unroll
        for (int o = 1; o < 16; o <<= 1) { const int v = __builtin_amdgcn_ds_bpermute(((lane - o) & 63) << 2, incl); if (j >= o) incl += v; }
        const int excl = incl - c;
        if (N <= 256) { if (j == 0) par[P_MODE * 32 + q] = 0; }
        else if (excl < 256 && 256 <= incl) { u32x4r w[8];
#pragma unroll
            for (int u = 0; u < 8; ++u) w[u] = *(const u32x4r*)(hs + 4 * u);
            int above = excl, isel = -1, cntb = 0, ab = 0;
#pragma unroll
            for (int i = 0; i < 32; ++i) { const int cb = (int)(neg ? w[i >> 2][i & 3] : w[(31 - i) >> 2][(31 - i) & 3]); if (isel < 0 && above + cb >= 256) { isel = i; cntb = cb; ab = above; } above += cb; }
            const int bsel = rank_to_bin(32 * j + isel), ot = bsel & 255; const float* XT = (const float*)(lds + L_XT);
            par[P_BSTAR * 32 + q] = bsel; par[P_KK * 32 + q] = 256 - ab; par[P_MODE * 32 + q] = (bsel != 0 && cntb > CAP) ? 3 : 1; if (bsel != 0 && cntb > CAP) par[P_ANY3 * 32] = 1;
            const float xa = XT[ot], xb = XT[ot + 1];
            const float XL = neg ? -__uint_as_float(__float_as_uint(xb) - 1u) : xa;
            const float XU = neg ? (xa > 0.f ? -__uint_as_float(__float_as_uint(xa) - 1u) : 0.f) : xb;
            par[P_XL * 32 + q] = (int)__float_as_uint(XL); par[P_XU * 32 + q] = (int)__float_as_uint(XU); }
    } }
    __syncthreads();
    const int my_mode = par[P_MODE * 32 + r32], my_b = par[P_BSTAR * 32 + r32];
    __syncthreads();
    float XL = __uint_as_float((unsigned)par[P_XL * 32 + r32]), XU = __uint_as_float((unsigned)par[P_XU * 32 + r32]);
    if (my_mode == 0) { XL = -3.0e38f; XU = -3.0e38f; }
    if (my_mode == 3) { XL = __builtin_inff(); XU = __builtin_inff(); }
    const bool central = (my_mode == 1 && my_b == 0);
    unsigned* ZW = ZWg;
    for (int r2_ = 0; r2_ < REP_P2; ++r2_) { if (r2_) { __syncthreads(); for (int i = tid; i < 32 * 128; i += NTHR) zc[i] = 0u; if (tid < 32) { par[P_CCNT * 32 + tid] = 0; par[P_OVF * 32 + tid] = 0; } __syncthreads(); }
    { bf16x8 kc[4]; if (wave <= kt_max) IDX_KISSUE(wave);
      for (int kt = wave; kt < NTW; kt += 8) {
        unsigned word = 0u, wz = 0u;
        if (kt <= kt_max) {
            if (kt == wave) { IDX_KTAKE(kc, "0"); } else { IDX_KTAKE(kc, "2"); }
            if (kt + 8 <= kt_max) IDX_KISSUE(kt + 8);
            asm volatile("" ::: "memory");
            f32x16 s0v = score_sub(kc[0], kc[1], Q), s1v = score_sub(kc[2], kc[3], Q);
            const bool diag = kt * 64 + 63 > qlo;
            if (diag) {
#pragma unroll
                for (int r = 0; r < 16; ++r) { const int s = kt * 64 + crow(r, hi); if (s > t) s0v[r] = -__builtin_inff(); if (s + 32 > t) s1v[r] = -__builtin_inff(); } }
            unsigned wn = 0u, wl = 0u;
#pragma unroll
            for (int e = 31; e >= 0; --e) { const float x = (e < 16) ? s0v[e & 15] : s1v[e & 15]; float t1, t2;
#if IDX_ASMBIN
                asm("v_sub_f32 %0, %1, %2" : "=v"(t1) : "v"(x), "v"(XU)); asm("v_sub_f32 %0, %1, %2" : "=v"(t2) : "v"(x), "v"(XL));
#else
                t1 = x - XU; t2 = x - XL;
#endif
                wn = __builtin_amdgcn_alignbit(wn, __float_as_uint(t1), 31); wl = __builtin_amdgcn_alignbit(wl, __float_as_uint(t2), 31); }
            word = ~wn; const unsigned inb = wn & ~wl;
            if ((REP_P2 == 1 || r2_ > 0) && __any(inb != 0u)) {
                unsigned zb = 0u;
                if (__any(central && inb != 0u)) { unsigned UZ = wave_or(central ? inb : 0u);
                    while (UZ) { const int e = __builtin_ctz(UZ); UZ &= UZ - 1u; const float x = (e < 16) ? s0v[e & 15] : s1v[e & 15];
                        if (central && ((inb >> e) & 1u) && x == 0.f) zb |= (1u << e); }
                    if (zb) lds_add(&zc[r32 * 128 + kt], (unsigned)__builtin_popcount(zb)); wz = zb; }
                const unsigned cb = inb & ~zb; const int cnt = __builtin_popcount(cb); int pos = 0;
                if (cnt) { pos = (int)lds_add((unsigned*)&par[P_CCNT * 32 + r32], (unsigned)cnt); if (pos + cnt > CAP) par[P_OVF * 32 + r32] = 1; }
                unsigned m = cb; int slot = pos;
                while (__any(m != 0u)) { const int e = (int)__builtin_ctz(m | 0x80000000u); const float x = sel32(s0v, s1v, e);
                    if (m != 0u && slot < CAP) { cand_s[r32 * CAP + slot] = __float_as_uint(x); cand_i[r32 * CAP + slot] = (unsigned)(kt * 64 + 32 * (e >> 4) + ((e & 3) + 8 * ((e & 15) >> 2) + 4 * hi)); }
                    m &= m - 1u; ++slot; }
            }
        }
        MK[((size_t)(b * 256 + qt) * 128 + kt) * 64 + lane] = word; ZW[kt * 64 + lane] = wz;
      } } }
#if IDX_PRIO
    __builtin_amdgcn_s_setprio(0);
#endif
    asm volatile("s_waitcnt vmcnt(0)" ::: "memory");
    __syncthreads();
    for (int rk_ = 0; rk_ < REP_RANK; ++rk_) { if (rk_) __syncthreads(); asm volatile("" ::: "memory");
    { const int q = tid >> 4, j = tid & 15, mode = par[P_MODE * 32 + q], kk = par[P_KK * 32 + q], bq = par[P_BSTAR * 32 + q];
        const int n = par[P_CCNT * 32 + q] < CAP ? par[P_CCNT * 32 + q] : CAP, n4 = (n + 3) & ~3;
        if (mode == 1 && par[P_OVF * 32 + q]) { if (j == 0) { par[P_MODE * 32 + q] = 3; par[P_ANY3 * 32] = 1; } }
        else if (mode == 1 && kk <= n) {
            if (j < n4 - n) { cand_s[q * CAP + n + j] = 0xFF800000u; cand_i[q * CAP + n + j] = 0xFFFFFFFFu; }
            if (j == 0) { par[P_NRANK * 32 + q] = n; par[P_TSTAR * 32 + q] = -1; } }
        else if (mode == 1 && bq == 0) {
            const int need = kk - n; int zl[8], c = 0;
#pragma unroll
            for (int u = 0; u < 8; ++u) { zl[u] = (int)zc[q * 128 + 8 * j + u]; c += zl[u]; }
            int incl = c;
#pragma unroll
            for (int o = 1; o < 16; o <<= 1) { const int v = __builtin_amdgcn_ds_bpermute(((lane - o) & 63) << 2, incl); if (j >= o) incl += v; }
            int cum = incl - c;
            if (j == 0) { par[P_TAU * 32 + q] = (int)0xFF800000u; par[P_CUT * 32 + q] = -1; }
            if (cum < need && need <= incl) { int ts = 8 * j + 7, rs = 1; bool done = false;
#pragma unroll
                for (int u = 0; u < 8; ++u) { if (!done && cum + zl[u] >= need) { ts = 8 * j + u; rs = need - cum; done = true; } cum += zl[u]; }
                par[P_TSTAR * 32 + q] = ts; par[P_RSTAR * 32 + q] = rs; } }
        else if (mode == 1) { if (j == 0) { par[P_MODE * 32 + q] = 3; par[P_ANY3 * 32] = 1; } }
    }
    __syncthreads();
    if (tid < 64) { const int q = lane & 31; int incl = par[P_NRANK * 32 + q];
#pragma unroll
        for (int o = 1; o < 32; o <<= 1) { const int v = __builtin_amdgcn_ds_bpermute(((lane - o) & 63) << 2, incl); if (q >= o) incl += v; }
        if (lane < 32) par[P_PRE * 32 + q] = incl; }
    __syncthreads();
    { typedef unsigned u32x4v __attribute__((ext_vector_type(4)));
        const int total = par[P_PRE * 32 + 31];
        for (int g = tid; g < total; g += NTHR) {
            int q = 0;
#pragma unroll
            for (int st = 16; st >= 1; st >>= 1) { if (par[P_PRE * 32 + q + st - 1] <= g) q += st; }
            const int i = g - (q ? par[P_PRE * 32 + q - 1] : 0), n = par[P_NRANK * 32 + q], n4 = (n + 3) & ~3, kk = par[P_KK * 32 + q];
            const unsigned cix = cand_s[q * CAP + i], ciy = cand_i[q * CAP + i]; const float si = __uint_as_float(cix); int rank = 0;
#pragma unroll 2
            for (int m2 = 0; m2 < n4; m2 += 4) { const u32x4v sv = *(const u32x4v*)&cand_s[q * CAP + m2], iv = *(const u32x4v*)&cand_i[q * CAP + m2];
#pragma unroll
                for (int u = 0; u < 4; ++u) { const float sm = __uint_as_float(sv[u]); rank += (sm > si || (sm == si && iv[u] < ciy)) ? 1 : 0; } }
            if (rank == kk - 1) { par[P_TAU * 32 + q] = (int)cix; par[P_CUT * 32 + q] = (int)ciy; } } }
    __syncthreads(); }
    for (int rpp = 0; rpp < REP_PATCH; ++rpp)
    { const int q = tid >> 4, j = tid & 15, mode = par[P_MODE * 32 + q];
        if (mode == 1) { const int n = par[P_CCNT * 32 + q]; const float tau = __uint_as_float((unsigned)par[P_TAU * 32 + q]); const unsigned cut = (unsigned)par[P_CUT * 32 + q]; const int ts = par[P_TSTAR * 32 + q], rs = par[P_RSTAR * 32 + q];
            unsigned* mq = MK + (size_t)(b * 256 + qt) * 128 * 64 + q;
#pragma unroll 1
            for (int i = j; i < n; i += 16) { const float sc = __uint_as_float(cand_s[q * CAP + i]); const unsigned s = cand_i[q * CAP + i];
                if (sc > tau || (sc == tau && s <= cut)) { const int kap = s & 63, k5 = kap & 31, hh = (k5 >> 2) & 1, e = (k5 & 3) + 4 * (k5 >> 3) + 16 * (kap >> 5);
                    __hip_atomic_fetch_or(mq + (s >> 6) * 64 + 32 * hh, 1u << e, __ATOMIC_RELAXED, __HIP_MEMORY_SCOPE_AGENT); } }
            if (ts >= 0) {
                unsigned zw0[8], zw1[8];
#pragma unroll
                for (int u = 0; u < 8; ++u) { const int kt = j + 16 * u; zw0[u] = 0u; zw1[u] = 0u; if (kt <= ts) { zw0[u] = __hip_atomic_load(ZW + kt * 64 + q, __ATOMIC_RELAXED, __HIP_MEMORY_SCOPE_AGENT); zw1[u] = __hip_atomic_load(ZW + kt * 64 + 32 + q, __ATOMIC_RELAXED, __HIP_MEMORY_SCOPE_AGENT); } }
#pragma unroll
                for (int u = 0; u < 8; ++u) { const int kt = j + 16 * u; if (kt <= ts) { const unsigned w0 = zw0[u], w1 = zw1[u]; unsigned a0 = w0, a1 = w1;
                    if (kt == ts) { const unsigned lo32 = spread_nib(w0 & 0xffffu) | (spread_nib(w1 & 0xffffu) << 4), hi32 = spread_nib(w0 >> 16) | (spread_nib(w1 >> 16) << 4);
                        const unsigned long long ord = (unsigned long long)lo32 | ((unsigned long long)hi32 << 32);
                        int nn = rs, kap = 0; unsigned w = (unsigned)ord; int c = __builtin_popcount(w);
                        if (nn > c) { nn -= c; w = (unsigned)(ord >> 32); kap = 32; }
                        c = __builtin_popcount(w & 0xffffu); if (nn > c) { nn -= c; w >>= 16; kap += 16; }
                        c = __builtin_popcount(w & 0xffu); if (nn > c) { nn -= c; w >>= 8; kap += 8; }
                        c = __builtin_popcount(w & 0xfu); if (nn > c) { nn -= c; w >>= 4; kap += 4; }
                        c = __builtin_popcount(w & 0x3u); if (nn > c) { nn -= c; w >>= 2; kap += 2; }
                        c = (int)(w & 1u); if (nn > c) kap += 1;
                        unsigned k0 = 0u, k1 = 0u;
#pragma unroll
                        for (int e = 0; e < 32; ++e) { const int pos0 = 32 * (e >> 4) + crow(e & 15, 0), pos1 = 32 * (e >> 4) + crow(e & 15, 1); if (pos0 <= kap) k0 |= (1u << e); if (pos1 <= kap) k1 |= (1u << e); }
                        a0 &= k0; a1 &= k1; }
                    if (a0) __hip_atomic_fetch_or(mq + kt * 64, a0, __ATOMIC_RELAXED, __HIP_MEMORY_SCOPE_AGENT);
                    if (a1) __hip_atomic_fetch_or(mq + kt * 64 + 32, a1, __ATOMIC_RELAXED, __HIP_MEMORY_SCOPE_AGENT); } } }
        }
    }
    __syncthreads();
}
#undef IDX_KISSUE
#undef IDX_KTAKE
#undef IDX_KREAD
}
namespace glab {
typedef short bf16x8 __attribute__((ext_vector_type(8)));
typedef short s16x4 __attribute__((ext_vector_type(4)));
typedef float f32x16 __attribute__((ext_vector_type(16)));
typedef float f32x4 __attribute__((ext_vector_type(4)));
typedef unsigned u32x4 __attribute__((ext_vector_type(4)));
typedef unsigned u32x2 __attribute__((ext_vector_type(2)));
typedef float f32x2_t __attribute__((ext_vector_type(2))); typedef __bf16 bf16x2_t __attribute__((ext_vector_type(2)));
#define GLAS __attribute__((address_space(3)))
constexpr int RAW_Q = 0, RAW_K = 6144, RAW_V = 12288, RAW_Z = 24576, OP_QE = 26624, OP_KE = 33792, OP_KDT = 40960, OP_VT = 47872, OP_DEC = 61696, OP_BLK_BYTES = 35328  ,
              OP_BLK1 = 61952  , OP_ST = 97280, ST_BYTES = 10752;
__device__ __forceinline__ unsigned cvtpk(float lo, float hi) { f32x2_t v = {lo, hi}; bf16x2_t b = __builtin_convertvector(v, bf16x2_t); return __builtin_bit_cast(unsigned, b); }
__device__ __forceinline__ int crow(int r, int hi) { return (r & 3) + 8 * (r >> 2) + 4 * hi; }
__device__ __forceinline__ float bfl(unsigned short b) { return __uint_as_float((unsigned)b << 16); }


__device__ __forceinline__ void gla_prep_item(const unsigned short* P, unsigned char* GOP, const float* w2, const float* gb, unsigned char* ldsg, int item, int tid) {
    GLAS unsigned char* lds = (GLAS unsigned char*)ldsg;
    const int lane = tid & 63; const int b = item >> 9, h = (item >> 7) & 3, n = item & 127;
    const size_t m0 = (size_t)b * SEQ + (size_t)n * 64;
    __syncthreads();
#define GLA_PCOL(c) (((c) < 6) ? (N_GQ + h * 48 + (c) * 8) : ((c) < 12) ? (N_GK + h * 48 + ((c) - 6) * 8) : ((c) < 24) ? (N_GV + h * 96 + ((c) - 12) * 8) : (N_GZ + ((c) - 24) * 8))
#define GLA_PDST(row, c) (((c) < 6) ? (RAW_Q + (row) * 96 + (c) * 16) : ((c) < 12) ? (RAW_K + (row) * 96 + ((c) - 6) * 16) : ((c) < 24) ? (RAW_V + (row) * 192 + ((c) - 12) * 16) : (RAW_Z + (row) * 32 + ((c) - 24) * 16))
#pragma unroll
    for (int k = 0; k < 4; ++k) { const int p = tid + 512 * k; if (p < 1664) { const int row = p / 26, c = p % 26; *(GLAS u32x4*)(lds + GLA_PDST(row, c)) = *(const u32x4*)(P + (m0 + row) * NP + GLA_PCOL(c)); } }
    __syncthreads();
    const int sd = tid >> 3, tg = tid & 7;
    if (tid < 384) {
            float c[8], w2c[16]; const float bc = gb[h * 48 + sd];
#pragma unroll
            for (int r = 0; r < 16; ++r) w2c[r] = w2[(size_t)r * 192 + h * 48 + sd];
#pragma unroll
            for (int tt = 0; tt < 8; ++tt) { const int t = 8 * tg + tt; const u32x4 z0 = *(GLAS u32x4*)(lds + RAW_Z + t * 32), z1 = *(GLAS u32x4*)(lds + RAW_Z + t * 32 + 16); float z = bc;
#pragma unroll
                for (int k = 0; k < 4; ++k) { z += w2c[2 * k] * __uint_as_float(z0[k] << 16) + w2c[2 * k + 1] * __uint_as_float(z0[k] & 0xffff0000u); z += w2c[8 + 2 * k] * __uint_as_float(z1[k] << 16) + w2c[8 + 2 * k + 1] * __uint_as_float(z1[k] & 0xffff0000u); }
                const float ls = fminf(z, 0.f) - __logf(1.0f + __expf(-fabsf(z)));
                c[tt] = ls * (1.0f / 16.0f) + (tt ? c[tt - 1] : 0.f); }
            float incl = c[7];
#pragma unroll
            for (int o = 1; o < 8; o <<= 1) { const float v = __builtin_bit_cast(float, __builtin_amdgcn_ds_bpermute(((lane - o) & 63) << 2, __builtin_bit_cast(int, incl))); if (tg >= o) incl += v; }
            const float off = incl - c[7];
            const float bl = __builtin_bit_cast(float, __builtin_amdgcn_ds_bpermute((lane | 7) << 2, __builtin_bit_cast(int, incl)));
            unsigned kdp[4];
#pragma unroll
            for (int tt = 0; tt < 8; tt += 2) { float kdv[2];
#pragma unroll
                for (int u = 0; u < 2; ++u) { const int t = 8 * tg + tt + u; const float bb = off + c[tt + u];
                    const float q = bfl(*(GLAS unsigned short*)(lds + RAW_Q + (t * 48 + sd) * 2)), kx = bfl(*(GLAS unsigned short*)(lds + RAW_K + (t * 48 + sd) * 2));
                    const float e1 = __expf(bb), e2 = __expf(-bb), e3 = __expf(bl - bb);
                    *(GLAS unsigned short*)(lds + OP_QE + (t * 56 + sd) * 2) = (unsigned short)(cvtpk(q * e1, 0.f) & 0xffffu);
                    *(GLAS unsigned short*)(lds + OP_KE + (t * 56 + sd) * 2) = (unsigned short)(cvtpk(kx * e2, 0.f) & 0xffffu);
                    kdv[u] = kx * e3; }
                kdp[tt >> 1] = cvtpk(kdv[0], kdv[1]); }
            *(GLAS u32x4*)(lds + OP_KDT + (sd * 72 + 8 * tg) * 2) = (u32x4){kdp[0], kdp[1], kdp[2], kdp[3]};
            if (tg == 7) ((GLAS float*)(lds + OP_DEC))[sd] = __expf(bl);
    } else {
            for (int idx = tid - 384; idx < 96 * 8; idx += 128) { const int v = idx % 96, t8 = idx / 96; unsigned pk[4];
#pragma unroll
                for (int tt = 0; tt < 8; tt += 2) { const unsigned a0 = *(GLAS unsigned short*)(lds + RAW_V + ((8 * t8 + tt) * 96 + v) * 2), a1 = *(GLAS unsigned short*)(lds + RAW_V + ((8 * t8 + tt + 1) * 96 + v) * 2); pk[tt >> 1] = a0 | (a1 << 16); }
                *(GLAS u32x4*)(lds + OP_VT + (v * 72 + 8 * t8) * 2) = (u32x4){pk[0], pk[1], pk[2], pk[3]}; }
    }
    __syncthreads();
    unsigned char* dst = GOP + (size_t)item * OP_BLK_BYTES;
    for (int i = tid; i < (OP_DEC + 192 - OP_QE) / 16; i += NTHR) *(u32x4*)(dst + i * 16) = *(GLAS u32x4*)(lds + OP_QE + i * 16);
}
__device__ __forceinline__ void gla_prep_loop(const unsigned short* P, unsigned char* GOP, const float* w2, const float* gb, unsigned char* ldsg, int wg, int G, int tid) {
    GLAS unsigned char* lds = (GLAS unsigned char*)ldsg;
    const int lane = tid & 63;
#define GLA_PCOLH(c, hh) (((c) < 6) ? (N_GQ + (hh) * 48 + (c) * 8) : ((c) < 12) ? (N_GK + (hh) * 48 + ((c) - 6) * 8) : ((c) < 24) ? (N_GV + (hh) * 96 + ((c) - 12) * 8) : (N_GZ + ((c) - 24) * 8))
#define GLA_PDST(row, c) (((c) < 6) ? (RAW_Q + (row) * 96 + (c) * 16) : ((c) < 12) ? (RAW_K + (row) * 96 + ((c) - 6) * 16) : ((c) < 24) ? (RAW_V + (row) * 192 + ((c) - 12) * 16) : (RAW_Z + (row) * 32 + ((c) - 24) * 16))
#define GLA_FETCH(it_) do { const int b_ = (it_) >> 9, h_ = ((it_) >> 7) & 3, n_ = (it_) & 127; const size_t mr_ = (size_t)b_ * SEQ + (size_t)n_ * 64; \
        _Pragma("unroll") for (int k = 0; k < 4; ++k) { const int p = tid + 512 * k; if (p < 1664) { const int row = p / 26, c = p % 26; rawr[k] = *(const u32x4*)(P + (mr_ + row) * NP + GLA_PCOLH(c, h_)); } } } while (0)
    u32x4 rawr[4];
    if (wg < BATCH * 4 * 128) GLA_FETCH(wg);
    for (int item = wg; item < BATCH * 4 * 128; item += G) {
    const int h = (item >> 7) & 3;
    __syncthreads();
#pragma unroll
    for (int k = 0; k < 4; ++k) { const int p = tid + 512 * k; if (p < 1664) { const int row = p / 26, c = p % 26; *(GLAS u32x4*)(lds + GLA_PDST(row, c)) = rawr[k]; } }
    if (item + G < BATCH * 4 * 128) GLA_FETCH(item + G);
    __syncthreads();
    const int sd = tid >> 3, tg = tid & 7;
    if (tid < 384) {
            float c[8], w2c[16]; const float bc = gb[h * 48 + sd];
#pragma unroll
            for (int r = 0; r < 16; ++r) w2c[r] = w2[(size_t)r * 192 + h * 48 + sd];
#pragma unroll
            for (int tt = 0; tt < 8; ++tt) { const int t = 8 * tg + tt; const u32x4 z0 = *(GLAS u32x4*)(lds + RAW_Z + t * 32), z1 = *(GLAS u32x4*)(lds + RAW_Z + t * 32 + 16); float z = bc;
#pragma unroll
                for (int k = 0; k < 4; ++k) { z += w2c[2 * k] * __uint_as_float(z0[k] << 16) + w2c[2 * k + 1] * __uint_as_float(z0[k] & 0xffff0000u); z += w2c[8 + 2 * k] * __uint_as_float(z1[k] << 16) + w2c[8 + 2 * k + 1] * __uint_as_float(z1[k] & 0xffff0000u); }
                const float ls = fminf(z, 0.f) - __logf(1.0f + __expf(-fabsf(z)));
                c[tt] = ls * (1.0f / 16.0f) + (tt ? c[tt - 1] : 0.f); }
            float incl = c[7];
#pragma unroll
            for (int o = 1; o < 8; o <<= 1) { const float v = __builtin_bit_cast(float, __builtin_amdgcn_ds_bpermute(((lane - o) & 63) << 2, __builtin_bit_cast(int, incl))); if (tg >= o) incl += v; }
            const float off = incl - c[7];
            const float bl = __builtin_bit_cast(float, __builtin_amdgcn_ds_bpermute((lane | 7) << 2, __builtin_bit_cast(int, incl)));
            unsigned kdp[4];
#pragma unroll
            for (int tt = 0; tt < 8; tt += 2) { float kdv[2];
#pragma unroll
                for (int u = 0; u < 2; ++u) { const int t = 8 * tg + tt + u; const float bb = off + c[tt + u];
                    const float q = bfl(*(GLAS unsigned short*)(lds + RAW_Q + (t * 48 + sd) * 2)), kx = bfl(*(GLAS unsigned short*)(lds + RAW_K + (t * 48 + sd) * 2));
                    const float e1 = __expf(bb), e2 = __expf(-bb), e3 = __expf(bl - bb);
                    *(GLAS unsigned short*)(lds + OP_QE + (t * 56 + sd) * 2) = (unsigned short)(cvtpk(q * e1, 0.f) & 0xffffu);
                    *(GLAS unsigned short*)(lds + OP_KE + (t * 56 + sd) * 2) = (unsigned short)(cvtpk(kx * e2, 0.f) & 0xffffu);
                    kdv[u] = kx * e3; }
                kdp[tt >> 1] = cvtpk(kdv[0], kdv[1]); }
            *(GLAS u32x4*)(lds + OP_KDT + (sd * 72 + 8 * tg) * 2) = (u32x4){kdp[0], kdp[1], kdp[2], kdp[3]};
            if (tg == 7) ((GLAS float*)(lds + OP_DEC))[sd] = __expf(bl);
    } else {
            for (int idx = tid - 384; idx < 96 * 8; idx += 128) { const int v = idx % 96, t8 = idx / 96; unsigned pk[4];
#pragma unroll
                for (int tt = 0; tt < 8; tt += 2) { const unsigned a0 = *(GLAS unsigned short*)(lds + RAW_V + ((8 * t8 + tt) * 96 + v) * 2), a1 = *(GLAS unsigned short*)(lds + RAW_V + ((8 * t8 + tt + 1) * 96 + v) * 2); pk[tt >> 1] = a0 | (a1 << 16); }
                *(GLAS u32x4*)(lds + OP_VT + (v * 72 + 8 * t8) * 2) = (u32x4){pk[0], pk[1], pk[2], pk[3]}; }
    }
    __syncthreads();
    unsigned char* dst = GOP + (size_t)item * OP_BLK_BYTES;
    for (int i = tid; i < (OP_DEC + 192 - OP_QE) / 16; i += NTHR) *(u32x4*)(dst + i * 16) = *(GLAS u32x4*)(lds + OP_QE + i * 16);
    }
#undef GLA_FETCH
#undef GLA_PCOLH
}
__device__ __forceinline__ void gla_seq_unit(const unsigned short* P, unsigned short* Y, const unsigned char* GOP, const float* ng, unsigned char* ldsg, int b, int h, int tid) {
    GLAS unsigned char* lds = (GLAS unsigned char*)ldsg;
    const int lane = tid & 63, wave = __builtin_amdgcn_readfirstlane(tid >> 6), r32 = lane & 31, hi = lane >> 5, l15 = lane & 15, quad = lane >> 4;
    const size_t rowbase = (size_t)b * SEQ; const unsigned char* gsrc = GOP + (size_t)((b * 4 + h) * 128) * OP_BLK_BYTES;
    constexpr int NPC = (OP_DEC + 192 - OP_QE) / 16;
    constexpr int SQ_BLK0 = 0, SQ_BLK1 = OP_BLK_BYTES, SQ_ST = 2 * OP_BLK_BYTES  , SQ_OB = SQ_ST + 2 * ST_BYTES  , SQ_OB_BYTES = 64 * 96 * 2, SQ_NG = SQ_OB + 2 * SQ_OB_BYTES  ;
    __syncthreads();
    for (int i = tid; i < 2 * ST_BYTES / 4; i += NTHR) ((GLAS unsigned*)(lds + SQ_ST))[i] = 0u;
    if (tid < 96) ((GLAS float*)(lds + SQ_NG))[tid] = ng[tid];
    u32x4 rg[5];
#pragma unroll
    for (int k = 0; k < 5; ++k) { const int i = tid + 512 * k; if (i < NPC) rg[k] = *(const u32x4*)(gsrc + (size_t)i * 16); }
#pragma unroll
    for (int k = 0; k < 5; ++k) { const int i = tid + 512 * k; if (i < NPC) *(GLAS u32x4*)(lds + SQ_BLK0 + i * 16) = rg[k]; }
#pragma unroll
    for (int k = 0; k < 5; ++k) { const int i = tid + 512 * k; if (i < NPC) rg[k] = *(const u32x4*)(gsrc + OP_BLK_BYTES + (size_t)i * 16); }
    __syncthreads();
    f32x4 S[2][3];
#pragma unroll
    for (int mt = 0; mt < 2; ++mt)
#pragma unroll
        for (int nt = 0; nt < 3; ++nt) S[mt][nt] = (f32x4){0.f, 0.f, 0.f, 0.f};
#define GLA_EPILOGUE(nn) do { const int cc_ = (nn) & 1; const size_t mm_ = rowbase + (size_t)(nn) * 64; \
        _Pragma("unroll") for (int k_ = 0; k_ < 4; ++k_) { const int vec_ = (tid - 320) + 192 * k_, t_ = vec_ / 12, v_ = (vec_ % 12) * 8; \
            const u32x4 ov_ = *(GLAS u32x4*)(lds + SQ_OB + cc_ * SQ_OB_BYTES + t_ * 192 + v_ * 2); const u32x4 gv_ = *(const u32x4*)(P + (mm_ + t_) * NP + N_GG + h * 96 + v_); \
            const f32x4 n0_ = *(GLAS f32x4*)(lds + SQ_NG + v_ * 4), n1_ = *(GLAS f32x4*)(lds + SQ_NG + v_ * 4 + 16); u32x4 yo_; \
            _Pragma("unroll") for (int e_ = 0; e_ < 4; ++e_) { const float ga_ = __uint_as_float(gv_[e_] << 16), gb_ = __uint_as_float(gv_[e_] & 0xffff0000u); \
                const float na_ = (e_ < 2) ? n0_[2 * e_] : n1_[2 * e_ - 4], nb_ = (e_ < 2) ? n0_[2 * e_ + 1] : n1_[2 * e_ - 3]; \
                yo_[e_] = cvtpk(__uint_as_float(ov_[e_] << 16) * na_ * (ga_ / (1.0f + __expf(-ga_))), __uint_as_float(ov_[e_] & 0xffff0000u) * nb_ * (gb_ / (1.0f + __expf(-gb_)))); } \
            *(u32x4*)(Y + (mm_ + t_) * DM + h * 96 + v_) = yo_; } } while (0)
    for (int n = 0; n < SEQ / 64; ++n) {
        const int cur = n & 1, nxt = cur ^ 1; const size_t m0 = rowbase + (size_t)n * 64;
        const int BO = (cur ? SQ_BLK1 : SQ_BLK0) - OP_QE;
        if (n + 1 < SEQ / 64) { const int BN = (cur ? SQ_BLK0 : SQ_BLK1) - OP_QE;
#pragma unroll
            for (int k = 0; k < 5; ++k) { const int i = tid + 512 * k; if (i < NPC) *(GLAS u32x4*)(lds + OP_QE + BN + i * 16) = rg[k]; }
            if (n + 2 < SEQ / 64) {
#pragma unroll
                for (int k = 0; k < 5; ++k) { const int i = tid + 512 * k; if (i < NPC) rg[k] = *(const u32x4*)(gsrc + (size_t)(n + 2) * OP_BLK_BYTES + (size_t)i * 16); } } }
        if (wave < 2) {
            const int it = wave; bf16x8 qf[3];
#pragma unroll
            for (int ks = 0; ks < 3; ++ks) qf[ks] = *(GLAS bf16x8*)(lds + BO + OP_QE + (32 * it + r32) * 112 + (16 * ks + 8 * hi) * 2);
            f32x16 acc[3];
#pragma unroll
            for (int vt = 0; vt < 3; ++vt)
#pragma unroll
                for (int r = 0; r < 16; ++r) acc[vt][r] = 0.f;
#pragma unroll
            for (int jt = 0; jt < 2; ++jt) if (jt <= it) {
                f32x16 X;
#pragma unroll
                for (int r = 0; r < 16; ++r) X[r] = 0.f;
#pragma unroll
                for (int ks = 0; ks < 3; ++ks) { const bf16x8 kf = *(GLAS bf16x8*)(lds + BO + OP_KE + (32 * jt + r32) * 112 + (16 * ks + 8 * hi) * 2); X = __builtin_amdgcn_mfma_f32_32x32x16_bf16(kf, qf[ks], X, 0, 0, 0); }
                if (jt == it) {
#pragma unroll
                    for (int r = 0; r < 16; ++r) if (crow(r, hi) > r32) X[r] = 0.f; }
                u32x4 p0, p1;
#pragma unroll
                for (int k = 0; k < 4; ++k) { p0[k] = cvtpk(X[2 * k], X[2 * k + 1]); p1[k] = cvtpk(X[8 + 2 * k], X[8 + 2 * k + 1]); }
                const bf16x8 pa0 = __builtin_bit_cast(bf16x8, p0), pa1 = __builtin_bit_cast(bf16x8, p1);
#pragma unroll
                for (int vt = 0; vt < 3; ++vt)
#pragma unroll
                    for (int s = 0; s < 2; ++s) { const int vo = BO + OP_VT + (32 * vt + r32) * 144 + (32 * jt + 16 * s + 4 * hi) * 2;
                        const s16x4 lo = *(GLAS s16x4*)(lds + vo), hi4 = *(GLAS s16x4*)(lds + vo + 16);
                        const bf16x8 a2 = (bf16x8){lo[0], lo[1], lo[2], lo[3], hi4[0], hi4[1], hi4[2], hi4[3]};
                        acc[vt] = __builtin_amdgcn_mfma_f32_32x32x16_bf16(a2, s ? pa1 : pa0, acc[vt], 0, 0, 0); }
            }
#pragma unroll
            for (int vt = 0; vt < 3; ++vt)
#pragma unroll
                for (int ks = 0; ks < 3; ++ks) { const bf16x8 sf = *(GLAS bf16x8*)(lds + SQ_ST + cur * ST_BYTES + (32 * vt + r32) * 112 + (16 * ks + 8 * hi) * 2); acc[vt] = __builtin_amdgcn_mfma_f32_32x32x16_bf16(sf, qf[ks], acc[vt], 0, 0, 0); }
            float ss = 0.f;
#pragma unroll
            for (int vt = 0; vt < 3; ++vt)
#pragma unroll
                for (int r = 0; r < 16; ++r) ss += acc[vt][r] * acc[vt][r];
            ss += __builtin_bit_cast(float, __builtin_amdgcn_ds_bpermute((lane ^ 32) << 2, __builtin_bit_cast(int, ss)));
            const float rn = 1.0f / sqrtf(ss * (1.0f / 96.0f) + EPS);
            GLAS unsigned char* ob = lds + SQ_OB + cur * SQ_OB_BYTES + (32 * it + r32) * 192;
#pragma unroll
            for (int vt = 0; vt < 3; ++vt)
#pragma unroll
                for (int g = 0; g < 4; ++g) { const int v0 = 32 * vt + 8 * g + 4 * hi;
                    *(GLAS u32x2*)(ob + v0 * 2) = (u32x2){cvtpk(acc[vt][4 * g] * rn, acc[vt][4 * g + 1] * rn), cvtpk(acc[vt][4 * g + 2] * rn, acc[vt][4 * g + 3] * rn)}; }
        } else if (wave < 5) {
            const int sw = wave - 2;
#pragma unroll
            for (int mt = 0; mt < 2; ++mt)
#pragma unroll
                for (int nt = 0; nt < 3; ++nt) { const int d = 16 * nt + l15; const float dec = ((GLAS float*)(lds + BO + OP_DEC))[d]; f32x4 a = S[mt][nt] * dec;
#pragma unroll
                    for (int ks = 0; ks < 2; ++ks) { const bf16x8 va = *(GLAS bf16x8*)(lds + BO + OP_VT + (32 * sw + 16 * mt + l15) * 144 + (32 * ks + 8 * quad) * 2), kb = *(GLAS bf16x8*)(lds + BO + OP_KDT + d * 144 + (32 * ks + 8 * quad) * 2);
                        a = __builtin_amdgcn_mfma_f32_16x16x32_bf16(va, kb, a, 0, 0, 0); }
                    S[mt][nt] = a;
#pragma unroll
                    for (int jj = 0; jj < 4; jj += 2) { const unsigned pk = cvtpk(a[jj], a[jj + 1]);
                        *(GLAS unsigned short*)(lds + SQ_ST + nxt * ST_BYTES + ((32 * sw + 16 * mt + 4 * quad + jj) * 56 + d) * 2) = (unsigned short)(pk & 0xffffu);
                        *(GLAS unsigned short*)(lds + SQ_ST + nxt * ST_BYTES + ((32 * sw + 16 * mt + 4 * quad + jj + 1) * 56 + d) * 2) = (unsigned short)(pk >> 16); } }
        } else if (n > 0) {
            GLA_EPILOGUE(n - 1);
        }
        __syncthreads();
    }
    if (wave >= 5) { GLA_EPILOGUE(SEQ / 64 - 1); }
    __syncthreads();
}
#undef GLA_EPILOGUE
#undef GLA_PCOL
#undef GLA_PDST
#undef GLAS
}
namespace poolb {
typedef short bf16x8 __attribute__((ext_vector_type(8)));
typedef float f32x16 __attribute__((ext_vector_type(16)));
typedef unsigned u32x4 __attribute__((ext_vector_type(4)));
typedef unsigned u32x2 __attribute__((ext_vector_type(2)));
typedef float f32x2_t __attribute__((ext_vector_type(2))); typedef __bf16 bf16x2_t __attribute__((ext_vector_type(2)));
#define PLAS __attribute__((address_space(3)))
constexpr int US_PITCH = 528  , US = 0, US_BYTES = 79 * US_PITCH  , PS = 41728, PS_PITCH = 144  , PS_WAVE = 32 * PS_PITCH  ,
              WT = PS + 8 * PS_WAVE  , WT_PITCH = 144, WT_GROUP = 64 * WT_PITCH  ;
__device__ __forceinline__ unsigned cvtpk(float lo, float hi) { f32x2_t v = {lo, hi}; bf16x2_t b = __builtin_convertvector(v, bf16x2_t); return __builtin_bit_cast(unsigned, b); }
__device__ __forceinline__ void pool_phase(const unsigned short* P, unsigned short* Y, const float* pw, const float* pscale, unsigned char* ldsg, int wg, int G, int tid) {
    PLAS unsigned char* lds = (PLAS unsigned char*)ldsg;
    const int lane = tid & 63, wave = __builtin_amdgcn_readfirstlane(tid >> 6), r32 = lane & 31, hi = lane >> 5, g = wave & 3, th = wave >> 2;
    __syncthreads();
    for (int i = tid; i < 4 * 64 * 64; i += NTHR) { const int gg = i >> 12, c = (i >> 6) & 63, d = i & 63; const float v = pw[i] * pscale[gg * 64 + d];
        *(PLAS unsigned short*)(lds + WT + gg * WT_GROUP + d * WT_PITCH + c * 2) = (unsigned short)(cvtpk(v, 0.f) & 0xffffu); }
    const int w = 2 << g;
    for (int tile = wg; tile < M / 64; tile += G) {
        const int m0 = tile * 64, t0 = m0 % SEQ;
        __syncthreads();
        for (int i = tid; i < 79 * 32; i += NTHR) { const int row = i >> 5, pc = i & 31; u32x4 v = {0u, 0u, 0u, 0u};
            if (t0 + row - 15 >= 0) v = *(const u32x4*)(P + (size_t)(m0 - 15 + row) * NP + N_PU + pc * 8);
            *(PLAS u32x4*)(lds + US + row * US_PITCH + pc * 16) = v; }
        __syncthreads();
        { float sum[32];
#pragma unroll
            for (int c = 0; c < 32; ++c) sum[c] = 0.f;
            const int tl = 32 * th + r32; const PLAS unsigned char* base = lds + US + (tl + 15) * US_PITCH + (g * 64 + 32 * hi) * 2;
            for (int j = 0; j < w; ++j) {
#pragma unroll
                for (int q4 = 0; q4 < 4; ++q4) { const u32x4 v = *(const PLAS u32x4*)(base - j * US_PITCH + q4 * 16);
#pragma unroll
                    for (int k = 0; k < 4; ++k) { const float lo = __uint_as_float(v[k] << 16), hh = __uint_as_float(v[k] & 0xffff0000u); sum[8 * q4 + 2 * k] += lo; sum[8 * q4 + 2 * k + 1] += hh; } } }
            const int pos = t0 + tl; const float inv = 1.0f / (float)((pos + 1 < w) ? pos + 1 : w);
            PLAS unsigned char* pd = lds + PS + wave * PS_WAVE + r32 * PS_PITCH + 32 * hi * 2;
#pragma unroll
            for (int q4 = 0; q4 < 4; ++q4) { u32x4 o; const u32x4 sv = *(const PLAS u32x4*)(base + q4 * 16);
#pragma unroll
                for (int k = 0; k < 4; ++k) o[k] = cvtpk(sum[8 * q4 + 2 * k] * inv - __uint_as_float(sv[k] << 16), sum[8 * q4 + 2 * k + 1] * inv - __uint_as_float(sv[k] & 0xffff0000u));
                *(PLAS u32x4*)(pd + q4 * 16) = o; } }
        asm volatile("s_waitcnt lgkmcnt(0)" ::: "memory");
        f32x16 acc[2];
#pragma unroll
        for (int dt = 0; dt < 2; ++dt) {
#pragma unroll
            for (int r = 0; r < 16; ++r) acc[dt][r] = 0.f;
#pragma unroll
            for (int ks = 0; ks < 4; ++ks) { const bf16x8 a = *(const PLAS bf16x8*)(lds + WT + g * WT_GROUP + (32 * dt + r32) * WT_PITCH + (16 * ks + 8 * hi) * 2), bq = *(const PLAS bf16x8*)(lds + PS + wave * PS_WAVE + r32 * PS_PITCH + (16 * ks + 8 * hi) * 2);
                acc[dt] = __builtin_amdgcn_mfma_f32_32x32x16_bf16(a, bq, acc[dt], 0, 0, 0); } }
        { const size_t m = (size_t)m0 + 32 * th + r32; const unsigned short* gp = P + m * NP + N_PG + g * 64; unsigned short* yp = Y + m * DM + 768 + g * 64;
#pragma unroll
            for (int dt = 0; dt < 2; ++dt)
#pragma unroll
                for (int g4 = 0; g4 < 4; ++g4) { const int d0 = 32 * dt + 8 * g4 + 4 * hi; const u32x2 gw = *(const u32x2*)(gp + d0);
                    const float g0 = __uint_as_float(gw[0] << 16), g1 = __uint_as_float(gw[0] & 0xffff0000u), g2 = __uint_as_float(gw[1] << 16), g3 = __uint_as_float(gw[1] & 0xffff0000u);
                    const float y0 = acc[dt][4 * g4] * (g0 / (1.0f + __expf(-g0))), y1 = acc[dt][4 * g4 + 1] * (g1 / (1.0f + __expf(-g1))), y2 = acc[dt][4 * g4 + 2] * (g2 / (1.0f + __expf(-g2))), y3 = acc[dt][4 * g4 + 3] * (g3 / (1.0f + __expf(-g3)));
                    *(u32x2*)(yp + d0) = (u32x2){cvtpk(y0, y1), cvtpk(y2, y3)}; } }
    }
    __syncthreads();
}
#undef PLAS
}
struct Args {
    const float* x; const float* norm_g; const float* w_in; const float* gate_w2; const float* gate_b; const float* gla_norm_g;
    const float* rel_bias; const float* pool_w; const float* pool_scale; const float* w_out; const float* final_g;
    float* out; unsigned char* ws;
    int l_lo, l_hi, ph_lo, ph_hi, single, pad;
};

__device__ __forceinline__ int src_col(int n, float& sc) {
    sc = 1.f;
    if (n < 192) { sc = 0.14433756729740643f; return n; }
    if (n < 768) return n;
    if (n < 1152) return 784 + (n - 768);
    if (n < 1536) { sc = 0.125f * LOG2E; return 1168 + (n - 1152); }
    if (n < 1920) return 1552 + (n - 1536);
    if (n < 2304) return 1936 + (n - 1920);
    if (n < 2688) return 2320 + (n - 2304);
    if (n < 2944) return 2868 + (n - 2688);
    if (n < 3200) return 3124 + (n - 2944);
    if (n < 3328) { sc = 0.17677669529663687f; return 2704 + (n - 3200); }
    if (n < 3360) return 2832 + (n - 3328);
    if (n < 3376) return 768 + (n - 3360);
    if (n < 3380) { sc = 0.5f; return 2864 + (n - 3376); }
    return -1;
}
__device__ __forceinline__ void prologue_phase(const Args& a, int wg, int G, int tid) {
    bf16* WIN = (bf16*)(a.ws + WS_WIN); bf16* WOUT = (bf16*)(a.ws + WS_WOUT);
    const long gt = (long)wg * NTHR + tid, gs = (long)G * NTHR;
    for (long i = gt; i < 4L * NP * 128; i += gs) {
        const int n = (int)(i % NP), k8 = (int)((i / NP) % 128), l = (int)(i / ((long)NP * 128));
        float sc; const int c = src_col(n, sc);
        v4u o = {0u, 0u, 0u, 0u};
        if (c >= 0) { const float* w = a.w_in + ((size_t)l * 1024 + k8 * 8) * IN_COLS + c; float v[8];
#pragma unroll
            for (int j = 0; j < 8; ++j) v[j] = w[(size_t)j * IN_COLS] * sc * a.norm_g[l * 1024 + k8 * 8 + j];
            o.x = pk2(v[0], v[1]); o.y = pk2(v[2], v[3]); o.z = pk2(v[4], v[5]); o.w = pk2(v[6], v[7]); }
        *(v4u*)(WIN + ((size_t)l * NP + n) * 1024 + k8 * 8) = o;
    }
    for (long i = gt; i < 4L * 1024 * 128; i += gs) {
        const int n = (int)(i % 1024), k8 = (int)((i / 1024) % 128), l = (int)(i / (1024L * 128));
        const float* w = a.w_out + ((size_t)l * 1024 + k8 * 8) * 1024 + n; float v[8];
#pragma unroll
        for (int j = 0; j < 8; ++j) v[j] = w[(size_t)j * 1024];
        v4u o; o.x = pk2(v[0], v[1]); o.y = pk2(v[2], v[3]); o.z = pk2(v[4], v[5]); o.w = pk2(v[6], v[7]);
        *(v4u*)(WOUT + ((size_t)l * 1024 + n) * 1024 + k8 * 8) = o;
    }
    { bf16* XA = (bf16*)(a.ws + WS_XA); float* RS = (float*)(a.ws + WS_RS); const int lane = tid & 63;
        for (int m = wg * NWAVES + (tid >> 6); m < M; m += G * NWAVES) { const f32x4* xr = (const f32x4*)(a.x + (size_t)m * DM) + lane; v2u* o = (v2u*)(XA + (size_t)m * DM) + lane; float s = 0.f;
#pragma unroll
            for (int j = 0; j < 4; ++j) { const f32x4 v = xr[64 * j]; v2u w; w.x = pk2(v.x, v.y); w.y = pk2(v.z, v.w); o[64 * j] = w; s += (bflo(w.x) * bflo(w.x) + bfhi(w.x) * bfhi(w.x)) + (bflo(w.y) * bflo(w.y) + bfhi(w.y) * bfhi(w.y)); }
            s = wave_sum(s, lane); if (lane < 16) RS[(size_t)m * 16 + lane] = (lane == 0) ? s : 0.f; } }
}
__device__ __forceinline__ void norm_phase(const float* src, const float* g, bf16* dst, int gw, int NGW, int lane) {
    for (int m = gw; m < M; m += NGW) {
        const f32x4* xr = (const f32x4*)(src + (size_t)m * DM) + lane; f32x4 v[4]; float s = 0.f;
#pragma unroll
        for (int j = 0; j < 4; ++j) { v[j] = xr[64 * j]; s += (v[j].x * v[j].x + v[j].y * v[j].y) + (v[j].z * v[j].z + v[j].w * v[j].w); }
        const float r = 1.0f / sqrtf(wave_sum(s, lane) * (1.f / DM) + EPS);
        const f32x4* gr = (const f32x4*)g + lane; v2u* o = (v2u*)(dst + (size_t)m * DM) + lane;
#pragma unroll
        for (int j = 0; j < 4; ++j) { const f32x4 gv = gr[64 * j]; v2u w; w.x = pk2(v[j].x * r * gv.x, v[j].y * r * gv.y); w.y = pk2(v[j].z * r * gv.z, v[j].w * r * gv.w); o[64 * j] = w; }
    }
}
__device__ __forceinline__ void final_norm_phase(const bf16* xa, float* out, const float* g, const float* RS, int gw, int NGW, int lane) {
    for (int m = gw; m < M; m += NGW) {
        const v2u* xr = (const v2u*)(xa + (size_t)m * DM) + lane; f32x4* orow = (f32x4*)(out + (size_t)m * DM) + lane;
        const f32x4* rs = (const f32x4*)(RS + (size_t)m * 16); const f32x4 s0 = rs[0], s1 = rs[1], s2 = rs[2], s3 = rs[3];
        const float ss = (((s0[0] + s0[1]) + (s0[2] + s0[3])) + ((s1[0] + s1[1]) + (s1[2] + s1[3]))) + (((s2[0] + s2[1]) + (s2[2] + s2[3])) + ((s3[0] + s3[1]) + (s3[2] + s3[3])));
        const float r = 1.0f / sqrtf(ss * (1.f / DM) + EPS);
        const f32x4* gr = (const f32x4*)g + lane;
#pragma unroll
        for (int j = 0; j < 4; ++j) { const f32x4 gv = gr[64 * j]; const v2u w = xr[64 * j]; orow[64 * j] = (f32x4){bflo(w.x) * r * gv.x, bfhi(w.x) * r * gv.y, bflo(w.y) * r * gv.z, bfhi(w.y) * r * gv.w}; }
    }
}
__device__ __forceinline__ void rowscale_phase(const float* RS, float* RSC, int wg, int G, int tid) {
    for (int m = wg * NTHR + tid; m < M; m += G * NTHR) { const f32x4* rs = (const f32x4*)(RS + (size_t)m * 16); const f32x4 s0 = rs[0], s1 = rs[1], s2 = rs[2], s3 = rs[3];
        const float ss = (((s0[0] + s0[1]) + (s0[2] + s0[3])) + ((s1[0] + s1[1]) + (s1[2] + s1[3]))) + (((s2[0] + s2[1]) + (s2[2] + s2[3])) + ((s3[0] + s3[1]) + (s3[2] + s3[3])));
        RSC[m] = 1.0f / sqrtf(ss * (1.0f / 1024.0f) + EPS); }
}
__device__ __forceinline__ void pool_phase(const Args& a, int l, unsigned char* lds, int wg, int G, int tid) {
    float* wsm = (float*)lds; float* us = (float*)(lds + 16384); float* ps = (float*)(lds + 32768);
    const bf16* P = (const bf16*)(a.ws + WS_P); bf16* Y = (bf16*)(a.ws + WS_XB);
    for (int g = 0; g < 4; ++g) {
        __syncthreads();
        const float* pw = a.pool_w + (size_t)(l * 4 + g) * 4096;
        for (int i = tid; i < 4096; i += NTHR) wsm[i] = pw[i];
        const int w = 2 << g;
        for (int tile = wg; tile < M / 32; tile += G) {
            __syncthreads();
            const int m0 = tile * 32, t0 = m0 % SEQ;
            for (int i = tid; i < 47 * 64; i += NTHR) { const int r = i >> 6, c = i & 63; float v = 0.f;
                if (t0 + r - 15 >= 0) v = bf2f(P[(size_t)(m0 - 15 + r) * NP + N_PU + g * 64 + c]);
                us[i] = v; }
            __syncthreads();
            { const int t = tid >> 4, c4 = (tid & 15) * 4, pos = t0 + t; const int cnt = (pos + 1 < w) ? pos + 1 : w; const float inv = 1.0f / (float)cnt;
#pragma unroll
                for (int k = 0; k < 4; ++k) { const int c = c4 + k; float s = 0.f; for (int j = 0; j < w; ++j) s += us[(t + 15 - j) * 64 + c]; ps[t * 64 + c] = s * inv - us[(t + 15) * 64 + c]; } }
            __syncthreads();
            { const int t = tid >> 4, d4 = (tid & 15) * 4; float a0 = 0.f, a1 = 0.f, a2 = 0.f, a3 = 0.f;
                for (int c = 0; c < 64; ++c) { const float p = ps[t * 64 + c]; const f32x4 wv = *(const f32x4*)&wsm[c * 64 + d4]; a0 += p * wv.x; a1 += p * wv.y; a2 += p * wv.z; a3 += p * wv.w; }
                const size_t m = (size_t)m0 + t; const v2u gw2 = *(const v2u*)(P + m * NP + N_PG + g * 64 + d4);
                const float* scl = a.pool_scale + l * 256 + g * 64 + d4;
                const float y0 = a0 * scl[0] * silu_f(bflo(gw2.x)), y1 = a1 * scl[1] * silu_f(bfhi(gw2.x)), y2 = a2 * scl[2] * silu_f(bflo(gw2.y)), y3 = a3 * scl[3] * silu_f(bfhi(gw2.y));
                v2u o; o.x = pk2(y0, y1); o.y = pk2(y2, y3); *(v2u*)(Y + m * DM + 768 + g * 64 + d4) = o; }
        }
    }
    __syncthreads();
}
__device__ __forceinline__ void gla_rec_phase(const Args& a, int l, unsigned char* lds, int unit, int tid) {
    const int b = unit >> 2, h = unit & 3;
    float* qs = (float*)lds; float* ks = (float*)(lds + 12288); float* es = (float*)(lds + 24576); float* vs = (float*)(lds + 36864); float* os = (float*)(lds + 61440);
    float* w2s = (float*)(lds + 86016); float* bs = (float*)(lds + 89088); float* gzs = (float*)(lds + 89280);
    const bf16* P = (const bf16*)(a.ws + WS_P); bf16* Y = (bf16*)(a.ws + WS_XB);
    __syncthreads();
    for (int i = tid; i < 16 * 48; i += NTHR) { const int r = i / 48, d = i % 48; w2s[i] = a.gate_w2[(size_t)(l * 16 + r) * 192 + h * 48 + d]; }
    if (tid < 48) bs[tid] = a.gate_b[l * 192 + h * 48 + tid];
    float S[48];
#pragma unroll
    for (int d = 0; d < 48; ++d) S[d] = 0.f;
    for (int blk = 0; blk < SEQ / 64; ++blk) {
        const size_t m0 = (size_t)b * SEQ + (size_t)blk * 64;
        __syncthreads();
        for (int i = tid; i < 64 * 48; i += NTHR) { const int t = i / 48, d = i % 48; const bf16* row = P + (m0 + t) * NP; qs[i] = bf2f(row[N_GQ + h * 48 + d]); ks[i] = bf2f(row[N_GK + h * 48 + d]); }
        for (int i = tid; i < 64 * 96; i += NTHR) { const int t = i / 96, v = i % 96; vs[i] = bf2f(P[(m0 + t) * NP + N_GV + h * 96 + v]); }
        for (int i = tid; i < 64 * 16; i += NTHR) { const int t = i >> 4, r = i & 15; gzs[i] = bf2f(P[(m0 + t) * NP + N_GZ + r]); }
        __syncthreads();
        for (int i = tid; i < 64 * 48; i += NTHR) { const int t = i / 48, d = i % 48; float z = bs[d];
#pragma unroll
            for (int r = 0; r < 16; ++r) z += gzs[t * 16 + r] * w2s[r * 48 + d];
            const float ls = fminf(z, 0.f) - log1pf(__expf(-fabsf(z)));
            es[i] = __expf(ls * (1.0f / 16.0f)); }
        __syncthreads();
        if (tid < 96) { const int v = tid;
            for (int t = 0; t < 64; ++t) { const float vv = vs[t * 96 + v]; float o = 0.f;
#pragma unroll
                for (int d = 0; d < 48; ++d) { S[d] = es[t * 48 + d] * S[d] + ks[t * 48 + d] * vv; o += qs[t * 48 + d] * S[d]; }
                os[t * 96 + v] = o; } }
        __syncthreads();
        { const int t = tid >> 3, part = tid & 7; float ov[12]; float ss = 0.f;
#pragma unroll
            for (int k = 0; k < 12; ++k) { ov[k] = os[t * 96 + part * 12 + k]; ss += ov[k] * ov[k]; }
            { const int ln = tid & 63; ss += shx(ss, 1, ln); ss += shx(ss, 2, ln); ss += shx(ss, 4, ln); }
            const float r = 1.0f / sqrtf(ss * (1.0f / 96.0f) + EPS);
            const size_t m = m0 + t; const bf16* gp = P + m * NP + N_GG + h * 96 + part * 12; const float* ng = a.gla_norm_g + l * 96 + part * 12;
            unsigned* yo = (unsigned*)(Y + m * DM + h * 96 + part * 12);
#pragma unroll
            for (int k = 0; k < 12; k += 2) { const float y0 = ov[k] * r * ng[k] * silu_f(bf2f(gp[k])), y1 = ov[k + 1] * r * ng[k + 1] * silu_f(bf2f(gp[k + 1])); yo[k >> 1] = pk2(y0, y1); } }
    }
    __syncthreads();
}
template <bool BITS_ONLY> __device__ __forceinline__ void dsa_slow_query(const Args& a, unsigned char* lds, int b, int t, int tid) {
    const int lane = tid & 63, wave = tid >> 6;
    unsigned* sc = (unsigned*)lds; int* hist = (int*)(lds + 32768); int* sel = (int*)(lds + 33792); float* qf = (float*)(lds + 34816); float* wq = (float*)(lds + 35328);
    int* misc = (int*)(lds + 35344); float* qh = (float*)(lds + 35456); float* lg = (float*)(lds + 36992); float* inv = (float*)(lds + 43136);
    const bf16* P = (const bf16*)(a.ws + WS_P); bf16* Y = (bf16*)(a.ws + WS_XB);
    {
        const size_t m = (size_t)b * SEQ + t; const int N = t + 1;
        __syncthreads();
        if (tid < 128) qf[tid] = bf2f(P[m * NP + N_QI + tid]);
        if (tid >= 128 && tid < 132) wq[tid - 128] = bf2f(P[m * NP + N_WI + tid - 128]);
        for (int i = tid; i < 384; i += NTHR) qh[i] = bf2f(P[m * NP + N_DQ + i]);
        __syncthreads();
        for (int s = tid; s < N; s += NTHR) {
            const v4u* kr = (const v4u*)(P + ((size_t)b * SEQ + s) * NP + N_KI); float kf[32];
#pragma unroll
            for (int c = 0; c < 4; ++c) { const v4u w = kr[c]; kf[8 * c] = bflo(w.x); kf[8 * c + 1] = bfhi(w.x); kf[8 * c + 2] = bflo(w.y); kf[8 * c + 3] = bfhi(w.y); kf[8 * c + 4] = bflo(w.z); kf[8 * c + 5] = bfhi(w.z); kf[8 * c + 6] = bflo(w.w); kf[8 * c + 7] = bfhi(w.w); }
            float score = 0.f;
#pragma unroll
            for (int hh = 0; hh < 4; ++hh) { float dot = 0.f;
#pragma unroll
                for (int d = 0; d < 32; ++d) dot += qf[hh * 32 + d] * kf[d];
                score += wq[hh] * fmaxf(dot, 0.f); }
            const unsigned u = __builtin_bit_cast(unsigned, score);
            sc[s] = (u & 0x80000000u) ? ~u : (u | 0x80000000u);
        }
        __syncthreads();
        int L;
        if (N <= 256) { if (tid < N) sel[tid] = tid; L = N; }
        else {
            unsigned prefix = 0u; int kk = 256;
            for (int pass = 0; pass < 4; ++pass) {
                const int shift = 24 - 8 * pass;
                if (tid < 256) hist[tid] = 0;
                __syncthreads();
                for (int s = tid; s < N; s += NTHR) { const unsigned key = sc[s]; const bool match = (pass == 0) ? true : ((key >> ((shift + 8) & 31)) == prefix); if (match) atomicAdd(&hist[(key >> shift) & 255u], 1); }
                __syncthreads();
                if (wave == 0) {
                    const int c0 = hist[4 * lane], c1 = hist[4 * lane + 1], c2 = hist[4 * lane + 2], c3 = hist[4 * lane + 3]; const int tot = c0 + c1 + c2 + c3;
                    int incl = tot;
#pragma unroll
                    for (int o = 1; o < 64; o <<= 1) { const int tt = shdn(incl, o, lane); if (lane + o < 64) incl += tt; }
                    const int excl = incl - tot;
                    if (excl < kk && kk <= incl) { int above = excl, D;
                        if (above + c3 >= kk) D = 4 * lane + 3;
                        else { above += c3; if (above + c2 >= kk) D = 4 * lane + 2; else { above += c2; if (above + c1 >= kk) D = 4 * lane + 1; else { above += c1; D = 4 * lane; } } }
                        misc[1] = D; misc[2] = above; }
                }
                __syncthreads();
                prefix = (prefix << 8) | (unsigned)misc[1]; kk -= misc[2];
            }
            const unsigned tau = prefix;
            const int seg = (((N + 7) >> 3) + 63) & ~63; const int s_lo = wave * seg, s_hi = (s_lo + seg < N) ? s_lo + seg : N;
            { int cg = 0, ce = 0;
                for (int base = s_lo; base < s_hi; base += 64) { const int s = base + lane; const bool in = s < s_hi; const unsigned key = in ? sc[s] : 0u;
                    cg += __popcll(__ballot(in && key > tau)); ce += __popcll(__ballot(in && key == tau)); }
                if (lane == 0) { misc[4 + wave] = cg; misc[12 + wave] = ce; } }
            __syncthreads();
            { int bg = 0, be = 0;
                for (int w2 = 0; w2 < 8; ++w2) if (w2 < wave) { bg += misc[4 + w2]; be += misc[12 + w2]; }
                int run_sel = bg + (be < kk ? be : kk), run_eq = be;
                for (int base = s_lo; base < s_hi; base += 64) { const int s = base + lane; const bool in = s < s_hi; const unsigned key = in ? sc[s] : 0u;
                    const bool gt = in && key > tau, eq = in && key == tau; const unsigned long long me = __ballot(eq); const unsigned long long lt = (1ull << lane) - 1ull;
                    const bool take = gt || (eq && (run_eq + __popcll(me & lt) < kk)); const unsigned long long mt = __ballot(take);
                    if (take) sel[run_sel + __popcll(mt & lt)] = s;
                    run_sel += __popcll(mt); run_eq += __popcll(me); } }
            L = 256;
        }
        __syncthreads();
        if constexpr (BITS_ONLY) {
            unsigned* bm = (unsigned*)lg; unsigned* MK = (unsigned*)(a.ws + WS_MASK);
            if (tid < 256) bm[tid] = 0u;
            __syncthreads();
            if (tid < L) { const int s = sel[tid]; const int kt = s >> 6, kap = s & 63, half = kap >> 5, k5 = kap & 31, hi = (k5 >> 2) & 1, r = (k5 & 3) + 4 * (k5 >> 3);
                atomicOr(&bm[kt * 2 + hi], 1u << (r + 16 * half)); }
            __syncthreads();
            const int ntw = ((t >> 8) + 1) * 8;
            if (tid < ntw) { const int kt = tid >> 1, hi = tid & 1; MK[((size_t)(b * 256 + (t >> 5)) * 128 + kt) * 64 + (t & 31) + 32 * hi] = bm[tid]; }
            __syncthreads();
            return;
        }
        { const int j = tid >> 1, h0 = (tid & 1) * 3;
            if (j < L) { const int s = sel[j]; const size_t srow = (size_t)b * SEQ + s; const int bk = t5_bucket(t - s);
#pragma unroll
                for (int hh = 0; hh < 3; ++hh) { const int h = h0 + hh; const v4u* kr = (const v4u*)(P + srow * NP + N_DK + h * 64); const float* q = qh + h * 64; float dot = 0.f;
#pragma unroll
                    for (int c = 0; c < 8; ++c) { const v4u w = kr[c]; dot += q[8 * c] * bflo(w.x) + q[8 * c + 1] * bfhi(w.x) + q[8 * c + 2] * bflo(w.y) + q[8 * c + 3] * bfhi(w.y) + q[8 * c + 4] * bflo(w.z) + q[8 * c + 5] * bfhi(w.z) + q[8 * c + 6] * bflo(w.w) + q[8 * c + 7] * bfhi(w.w); }
                    lg[h * 256 + j] = dot + a.rel_bias[bk * 6 + h] * LOG2E; } }
            else {
#pragma unroll
                for (int hh = 0; hh < 3; ++hh) lg[(h0 + hh) * 256 + j] = -INFINITY; } }
        __syncthreads();
        if (wave < 6) { float* row = lg + wave * 256; float v0 = row[lane], v1 = row[lane + 64], v2 = row[lane + 128], v3 = row[lane + 192];
            float mx = fmaxf(fmaxf(v0, v1), fmaxf(v2, v3));
#pragma unroll
            for (int o = 1; o < 64; o <<= 1) mx = fmaxf(mx, shx(mx, o, lane));
            v0 = exp2f(v0 - mx); v1 = exp2f(v1 - mx); v2 = exp2f(v2 - mx); v3 = exp2f(v3 - mx);
            const float sm = wave_sum((v0 + v1) + (v2 + v3), lane);
            row[lane] = v0; row[lane + 64] = v1; row[lane + 128] = v2; row[lane + 192] = v3;
            if (lane == 0) inv[wave] = 1.0f / sm; }
        __syncthreads();
        if (tid < 384) { const int h = tid >> 6, d = tid & 63; float acc = 0.f; const bf16* vb = P + (size_t)b * SEQ * NP + N_DV + h * 64 + d;
            for (int j = 0; j < L; ++j) acc += lg[h * 256 + j] * bf2f(vb[(size_t)sel[j] * NP]);
            const float o = acc * inv[h]; const float gate = bf2f(P[m * NP + N_DG + h * 64 + d]);
            Y[m * DM + 384 + h * 64 + d] = (bf16)f2bf(o * silu_f(gate)); }
    }
    __syncthreads();
}
template <bool BITS_ONLY> __device__ __forceinline__ void dsa_slow_phase(const Args& a, int l, unsigned char* lds, int wg, int G, int tid) {
    for (int qi = wg; qi < M; qi += G) { asm volatile("" : "+v"(tid)); dsa_slow_query<BITS_ONLY>(a, lds, qi & 7, qi >> 3, tid); }
}
__device__ __forceinline__ void index_phase(const Args& a, unsigned char* lds, unsigned* qctr, volatile LAS unsigned* MISC, int tid) {
    const unsigned short* P = (const unsigned short*)(a.ws + WS_P); unsigned* MK = (unsigned*)(a.ws + WS_MASK);
    __syncthreads();
    if (tid <= 256) ((float*)(lds + idxb::L_XT))[tid] = tid < 256 ? idxb::xthr(tid) : __builtin_inff();
    int bq = blockIdx.x & 7, tries = 0;
    for (;;) {
        asm volatile("" : "+v"(tid));
        __syncthreads();
        if (tid == 0) MISC[17] = __hip_atomic_fetch_add(qctr + 64 * bq, 1u, __ATOMIC_RELAXED, __HIP_MEMORY_SCOPE_AGENT);
        __syncthreads();
        const int k = (int)MISC[17];
        if (k >= 256) { if (++tries == 8) break; bq = (bq + 1) & 7; continue; }
        const int b = bq, qt = 255 - k;
        idxb::index_unit(P, (const unsigned short*)(a.ws + WS_KC), MK, (unsigned*)(a.ws + WS_ZW) + (size_t)blockIdx.x * 128 * 64, lds, b, qt, tid);
        const int* par = (const int*)(lds + idxb::L_PAR);
        if (par[idxb::P_ANY3 * 32]) for (int q = 0; q < 32; ++q) if (par[idxb::P_MODE * 32 + q] == 3) dsa_slow_query<true>(a, lds, b, qt * 32 + q, tid);
    }
}
#ifndef REP_POOL
#define REP_POOL 1
#endif
#ifndef ATT_PRIO
#define ATT_PRIO 0
#endif
#ifndef REP_IDX
#define REP_IDX 1
#endif
#ifndef REP_GLA
#define REP_GLA 1
#endif
#ifndef REP_ATT
#define REP_ATT 1
#endif
#ifndef REP_PREP
#define REP_PREP 1
#endif
#ifndef REP_PRO
#define REP_PRO 1
#endif
#ifndef REP_NORM
#define REP_NORM 1
#endif
#ifndef REP_ALL
#define REP_ALL 1
#endif
#ifndef REP_BAR
#define REP_BAR 1
#endif
#ifndef REP_OUT
#define REP_OUT 1
#endif
#ifndef REP_INP
#define REP_INP 1
#endif
#ifndef GLA_MODE
#define GLA_MODE 1
#endif
#ifndef DSA_MODE
#define DSA_MODE 2
#endif
#ifndef MK_SINGLE
#define MK_SINGLE 1
#endif
__global__ void __launch_bounds__(NTHR, 2) fwd(Args a) {
    extern __shared__ __attribute__((aligned(16))) unsigned char lds[];
    int tid = threadIdx.x, lane = tid & 63, wave = __builtin_amdgcn_readfirstlane(tid >> 6);
    int G = gridDim.x, wg = blockIdx.x;
    const int wave0 = __builtin_amdgcn_readfirstlane(tid >> 6);
#define LAUNDER() do { { int wv_ = wave0; asm volatile("" : "+s"(wv_)); unsigned on_ = ~0u; asm volatile("" : "+s"(on_)); tid = wv_ * 64 + (int)__builtin_amdgcn_mbcnt_hi(on_, __builtin_amdgcn_mbcnt_lo(on_, 0u)); asm volatile("" : "+v"(tid)); } wg = blockIdx.x; G = gridDim.x; asm volatile("" : "+s"(wg), "+s"(G));     \
    lane = tid & 63; wave = __builtin_amdgcn_readfirstlane(tid >> 6); gw = wg * NWAVES + wave; NGW = G * NWAVES; } while (0)
    volatile LAS unsigned* MISC = (volatile LAS unsigned*)((LAS unsigned char*)lds + MISC_OFF);
    for (int u = tid; u < (LDS_BYTES - LDSCTL_OFF) / 4; u += NTHR) ((LAS unsigned*)((LAS unsigned char*)lds + LDSCTL_OFF))[u] = 0u;
    __syncthreads();
    XcdBarrier bar; bar.bar = (unsigned*)(a.ws + WS_CTL) + CW_BAR; bar.x = 0; bar.st = nullptr;
    const bool one = a.single != 0;
    if (one) bar = xcd_barrier_post((unsigned*)(a.ws + WS_CTL) + CW_BAR, MISC + 8);
#define IN(k) (a.ph_lo <= (k) && (k) < a.ph_hi)
#define SEAM() do { if (one) { unsigned* bp_ = (unsigned*)(a.ws + WS_CTL) + CW_BAR; asm volatile("" : "+s"(bp_)); XcdBarrier bb_; bb_.bar = bp_; bb_.x = bar.x; bb_.st = bar.st; xcd_barrier(bb_); if (REP_BAR == 2) xcd_barrier(bb_); } } while (0)
    int gw = wg * NWAVES + wave, NGW = G * NWAVES;
    bf16* XB = (bf16*)(a.ws + WS_XB); bf16* PB = (bf16*)(a.ws + WS_P);
    for (int rpw = 0; rpw < REP_ALL; ++rpw) {
    LAUNDER();
    if (IN(0)) { for (int rp = 0; rp < REP_PRO; ++rp) prologue_phase(a, wg, G, tid); SEAM(); }
    for (int l = a.l_lo; l < a.l_hi; ++l) {
        LAUNDER();
        if (IN(1)) { rowscale_phase((const float*)(a.ws + WS_RS), (float*)(a.ws + WS_RSC), wg, G, tid); SEAM(); }
        LAUNDER();
        if (IN(2)) {
            pg8::Gemm g{(const bf16*)(a.ws + WS_XA), (const bf16*)(a.ws + WS_WIN) + (size_t)l * NP * 1024, M, NP, DM}; pg8::StaticOrder S; S.init(M, NP, G, wg);
            pg8::EpiP E{PB, NP, (const float*)(a.ws + WS_RSC), (pg8::bf16_t*)(a.ws + WS_KC)};
            pg8::gemm_phase<pg8::EpiP, pg8::StaticOrder, true, true>((PG8_LAS unsigned char*)lds, g, S, E, tid);
#if REP_INP == 2
            asm volatile("" : "+v"(tid)); __syncthreads(); pg8::gemm_phase<pg8::EpiP, pg8::StaticOrder, true, true>((PG8_LAS unsigned char*)lds, g, S, E, tid);
#endif
            SEAM();
        }
        LAUNDER();
        if (IN(3)) {
#if GLA_MODE == 0
            if (wg < 32) gla_rec_phase(a, l, lds, wg, tid);
#endif
            for (int rp = 0; rp < REP_POOL; ++rp) { asm volatile("" : "+v"(tid)); poolb::pool_phase(PB, XB, a.pool_w + (size_t)l * 4 * 4096, a.pool_scale + l * 256, lds, wg, G, tid); }
#if GLA_MODE == 1
            glab::gla_prep_loop(PB, a.ws + WS_GOP, a.gate_w2 + (size_t)l * 16 * 192, a.gate_b + l * 192, lds, wg, G, tid);
#if REP_PREP == 2
            __syncthreads(); asm volatile("" : "+v"(tid), "+s"(wg));
            for (int item = wg; item < BATCH * 4 * 128; item += G) { asm volatile("" : "+v"(tid)); glab::gla_prep_item(PB, a.ws + WS_GOP, a.gate_w2 + (size_t)l * 16 * 192, a.gate_b + l * 192, lds, item, tid); }
#endif
            __syncthreads();
#endif
#if DSA_MODE == 0
            dsa_slow_phase<false>(a, l, lds, wg, G, tid);
#elif DSA_MODE == 1
            dsa_slow_phase<true>(a, l, lds, wg, G, tid);
#else
            for (int rp = 0; rp < REP_IDX; ++rp) { asm volatile("" : "+v"(tid)); index_phase(a, lds, (unsigned*)(a.ws + WS_CTL) + CW_QUEUE + 64 * (32 + 8 * (l + 4 * rp + 8 * rpw)), MISC, tid); }
#endif
            SEAM();
        }
        LAUNDER();
        if (IN(4)) {
#if DSA_MODE >= 1
            { float* dl = (float*)(lds + 86016);
                for (int i = tid; i < 1032; i += NTHR) { const int rel = i >> 3, h = i & 7; dl[i] = (h < 6 && rel < 128) ? (a.rel_bias[(int)T5B[rel] * 6 + h] - a.rel_bias[31 * 6 + h]) * LOG2E : 0.f; } for (int i = tid; i < 512; i += NTHR) { const unsigned nb = ((unsigned)(i >> 1) >> (4 * (i & 1))) & 15u; ((unsigned*)(lds + attn_body::LDS_TAB))[i] = (nb & 1u ? 0xffu : 0u) | (nb & 2u ? 0xff00u : 0u) | (nb & 4u ? 0xff0000u : 0u) | (nb & 8u ? 0xff000000u : 0u); }
                __syncthreads();
                const attn_body::AttnTensors AT{(const attn_body::bf16*)(PB + N_DQ), (const attn_body::bf16*)(PB + N_DK), (const attn_body::bf16*)(PB + N_DV), (attn_body::bf16*)(XB + 384), (const attn_body::bf16*)(PB + N_DG), (const unsigned*)(a.ws + WS_MASK)};
#if GLA_MODE == 1
                if (wg < 32) { glab::gla_seq_unit(PB, XB, a.ws + WS_GOP, a.gla_norm_g + l * 96, lds, wg >> 2, wg & 3, tid);
#if REP_GLA == 2
                    asm volatile("" : "+v"(tid)); glab::gla_seq_unit(PB, XB, a.ws + WS_GOP, a.gla_norm_g + l * 96, lds, wg >> 2, wg & 3, tid);
#endif
                    for (int i = tid; i < 1032; i += NTHR) { const int rel = i >> 3, h = i & 7; dl[i] = (h < 6 && rel < 128) ? (a.rel_bias[(int)T5B[rel] * 6 + h] - a.rel_bias[31 * 6 + h]) * LOG2E : 0.f; } for (int i = tid; i < 512; i += NTHR) { const unsigned nb = ((unsigned)(i >> 1) >> (4 * (i & 1))) & 15u; ((unsigned*)(lds + attn_body::LDS_TAB))[i] = (nb & 1u ? 0xffu : 0u) | (nb & 2u ? 0xff00u : 0u) | (nb & 4u ? 0xff0000u : 0u) | (nb & 8u ? 0xff000000u : 0u); }
                    __syncthreads(); }
#endif
#if ATT_PRIO
                if (__builtin_amdgcn_readfirstlane(tid) >= 256) __builtin_amdgcn_s_setprio(1);
#endif
                for (int rp = 0; rp < REP_ATT; ++rp) { unsigned* qctr = (unsigned*)(a.ws + WS_CTL) + CW_QUEUE + 64 * (l * 4 + rp + 2 * rpw);
                for (;;) { asm volatile("" : "+v"(tid));
                    __syncthreads();
                    if (tid == 0) MISC[16] = __hip_atomic_fetch_add(qctr, 1u, __ATOMIC_RELAXED, __HIP_MEMORY_SCOPE_AGENT);
                    __syncthreads();
                    const int k = (int)MISC[16];
                    if (k >= 48 * 32) break;
                    const int qb = 31 - k / 48, bh = k % 48;
                    attn_body::attn_unit<24>(bh / 6, bh % 6, qb, AT.Q, AT.K, AT.V, AT.O, AT.GT, AT.MK, (attn_body::lds_cfptr)(LAS const float*)((LAS unsigned char*)lds + 86016), (char*)lds, tid); } }
#if ATT_PRIO
                __builtin_amdgcn_s_setprio(0);
#endif
            }
#endif
            SEAM();
        }
        LAUNDER();
        if (IN(5)) {
            pg8::Gemm g{XB, (const bf16*)(a.ws + WS_WOUT) + (size_t)l * 1024 * 1024, M, DM, DM}; pg8::StaticOrder S; S.init(M, DM, G, wg);
            pg8::EpiRes E{(bf16*)(a.ws + WS_XA), DM, (float*)(a.ws + WS_RS)};
            pg8::gemm_phase<pg8::EpiRes, pg8::StaticOrder, true, true>((PG8_LAS unsigned char*)lds, g, S, E, tid);
#if REP_OUT == 2
            { asm volatile("" : "+v"(tid)); __syncthreads(); pg8::EpiRes E2{(bf16*)(a.ws + WS_P), DM, (float*)(a.ws + WS_P) + (size_t)M * DM}; pg8::gemm_phase<pg8::EpiRes, pg8::StaticOrder, true, true>((PG8_LAS unsigned char*)lds, g, S, E2, tid); }
#endif
            SEAM();
        }
    }
    }
    LAUNDER();
    if (IN(6)) final_norm_phase((const bf16*)(a.ws + WS_XA), a.out, a.final_g, (const float*)(a.ws + WS_RS), gw, NGW, lane);
#undef IN
#undef SEAM
}

extern "C" void kernel_launch(void* const* d_in, const int* in_sizes, int n_in, void* d_out, int out_size, void* d_ws, size_t ws_size, hipStream_t stream) {
    static int grid = 0;
    if (grid == 0) {
        if (n_in != 11 || in_sizes[0] != M * DM || out_size != M * DM || ws_size < WS_END) { fprintf(stderr, "kernel_launch: unexpected shapes (n_in %d, in0 %d, out %d, ws %zu); nothing launched\n", n_in, n_in > 0 ? in_sizes[0] : -1, out_size, ws_size); grid = -1; return; }
        int dev = 0, cus = 0, per_cu = 0;
        if (hipGetDevice(&dev) != hipSuccess || hipDeviceGetAttribute(&cus, hipDeviceAttributeMultiprocessorCount, dev) != hipSuccess) { grid = -1; return; }
        if (hipFuncSetAttribute((const void*)fwd, hipFuncAttributeMaxDynamicSharedMemorySize, LDS_BYTES) != hipSuccess) { fprintf(stderr, "kernel_launch: hipFuncSetAttribute failed\n"); grid = -1; return; }
        if (hipOccupancyMaxActiveBlocksPerMultiprocessor(&per_cu, (const void*)fwd, NTHR, LDS_BYTES) != hipSuccess || per_cu < 1) fprintf(stderr, "kernel_launch: occupancy query reports %d\n", per_cu);
        (void)hipGetLastError();
        grid = cus;
    }
    if (grid < 0) return;
    if (hipMemsetAsync((char*)d_ws + WS_CTL, 0, CTL_ZERO_BYTES, stream) != hipSuccess) return;
    Args a{};
    a.x = (const float*)d_in[0]; a.norm_g = (const float*)d_in[1]; a.w_in = (const float*)d_in[2]; a.gate_w2 = (const float*)d_in[3]; a.gate_b = (const float*)d_in[4]; a.gla_norm_g = (const float*)d_in[5];
    a.rel_bias = (const float*)d_in[6]; a.pool_w = (const float*)d_in[7]; a.pool_scale = (const float*)d_in[8]; a.w_out = (const float*)d_in[9]; a.final_g = (const float*)d_in[10];
    a.out = (float*)d_out; a.ws = (unsigned char*)d_ws; a.pad = 0;
#if MK_SINGLE
    a.l_lo = 0; a.l_hi = DEPTH; a.ph_lo = 0; a.ph_hi = 7; a.single = 1;
    hipLaunchKernelGGL(fwd, dim3(grid), dim3(NTHR), LDS_BYTES, stream, a);
#else
    a.single = 0;
    a.l_lo = 0; a.l_hi = 0; a.ph_lo = 0; a.ph_hi = 1; hipLaunchKernelGGL(fwd, dim3(grid), dim3(NTHR), LDS_BYTES, stream, a);
    for (int l = 0; l < DEPTH; ++l) for (int ph = 1; ph <= 5; ++ph) { a.l_lo = l; a.l_hi = l + 1; a.ph_lo = ph; a.ph_hi = ph + 1; hipLaunchKernelGGL(fwd, dim3(grid), dim3(NTHR), LDS_BYTES, stream, a); }
    a.l_lo = 0; a.l_hi = 0; a.ph_lo = 6; a.ph_hi = 7; hipLaunchKernelGGL(fwd, dim3(grid), dim3(NTHR), LDS_BYTES, stream, a);
#endif
    const hipError_t le = hipPeekAtLastError();
    if (le != hipSuccess) fprintf(stderr, "kernel_launch: launch failed: %s\n", hipGetErrorName(le));
}
```

```cpp
#include <hip/hip_runtime.h>
#include <cstdio>
#include <cstdint>
namespace pg8 {
#define PG8_LAS __attribute__((address_space(3)))
typedef unsigned short bf16_t;
typedef short bf16x8 __attribute__((ext_vector_type(8)));
typedef float f32x4 __attribute__((ext_vector_type(4)));
typedef unsigned u32x4 __attribute__((ext_vector_type(4)));
constexpr int BM = 256, BK = 64, HALF = 128, HTB = HALF * BK * 2  , STAGE_BYTES = 8 * HTB, NXCD = 8, WGM = 8;

__host__ __device__ __forceinline__ int lds_byte(int r, int c) { const int st = (r >> 4) * 2 + (c >> 5), rr = r & 15, cc = c & 31, ob = rr * 64 + cc * 2; return st * 1024 + (ob ^ (((ob >> 9) & 1) << 5)); }
__host__ __device__ __forceinline__ void stage_rc(int b, int& R, int& C) { const int st = b / 1024, sb = b % 1024, swz = sb ^ (((sb >> 9) & 1) << 5); R = (st >> 1) * 16 + swz / 64; C = (st & 1) * 32 + (swz % 64) / 2; }
__host__ __device__ __forceinline__ int perm32(int rho) { const int n = rho >> 4, i = rho & 15; return 8 * (i >> 2) + 4 * n + (i & 3); }

struct Unit { int pm, pn; };
struct Gemm { const bf16_t* A; const bf16_t* Bt; int M, N, K; };

struct StaticOrder {
    int nM, nN, nwg, G, c;
    __host__ __device__ void init(int M, int N, int G_, int c_) { nM = M / BM; nN = N / BM; nwg = nM * nN; G = G_; c = c_; }
    __host__ __device__ bool next(int i, Unit& u) const {
        const long L = (long)i * G + c; if (L >= nwg) return false;
        int wgid = (int)L; { const int q = nwg / NXCD, r = nwg % NXCD, xcd = wgid % NXCD, off = wgid / NXCD; wgid = (xcd < r ? xcd * (q + 1) : r * (q + 1) + (xcd - r) * q) + off; }
        const int nig = WGM * nN, gid = wgid / nig, fm = gid * WGM, gsz = (nM - fm) < WGM ? (nM - fm) : WGM;
        u.pm = fm + ((wgid % nig) % gsz); u.pn = (wgid % nig) / gsz; return true;
    }
    __device__ __forceinline__ void a_ready(const Unit&) const {}
    __device__ __forceinline__ void done(const Unit&) const {}
};

__device__ __forceinline__ unsigned cvt_pk_bf16(float lo, float hi) { unsigned r; asm volatile("v_cvt_pk_bf16_f32 %0, %1, %2" : "=v"(r) : "v"(lo), "v"(hi)); return r; }
typedef float f32x2 __attribute__((ext_vector_type(2)));
struct EpiP {
    static constexpr bool PERM = true, AFTER_DRAIN = false;
    bf16_t* O; int ldc; const float* RS; bf16_t* KC;
    __device__ __forceinline__ void operator()(const f32x4 (&acc)[2][2][4][2], const Unit& u, int wr, int wc, int fr, int fq) const {
        const int row0 = u.pm * BM + wr * 64 + fr, col0 = u.pn * BM + wc * 32 + 8 * fq;
#pragma unroll
        for (int ai = 0; ai < 2; ++ai)
#pragma unroll
            for (int m = 0; m < 4; ++m) { const int row = row0 + ai * HALF + m * 16; bf16_t* rowp = O + (size_t)row * ldc + col0;
                const float r = RS[row];
#pragma unroll
                for (int bj = 0; bj < 2; ++bj) { const f32x4 v0 = acc[ai][bj][m][0] * r, v1 = acc[ai][bj][m][1] * r;
                    u32x4 w; w.x = cvt_pk_bf16(v0[0], v0[1]); w.y = cvt_pk_bf16(v0[2], v0[3]); w.z = cvt_pk_bf16(v1[0], v1[1]); w.w = cvt_pk_bf16(v1[2], v1[3]);
                    if (col0 + bj * HALF < 3384) *(u32x4*)(rowp + bj * HALF) = w;
                    if (bj == 0 && wc == 0 && u.pn == 13) *(u32x4*)(KC + (size_t)row * 32 + 8 * fq) = w; } }
    }
};
struct EpiRes {
    static constexpr bool PERM = true, AFTER_DRAIN = false;
    bf16_t* XA; int ldc; float* RS;
    __device__ __forceinline__ void operator()(const f32x4 (&acc)[2][2][4][2], const Unit& u, int wr, int wc, int fr, int fq) const {
        const int row0 = u.pm * BM + wr * 64 + fr, col0 = u.pn * BM + wc * 32 + 8 * fq, lane = fr + 16 * fq;
#pragma unroll
        for (int ai = 0; ai < 2; ++ai) { u32x4 rb[4][2];
#pragma unroll
            for (int m = 0; m < 4; ++m)
#pragma unroll
                for (int bj = 0; bj < 2; ++bj) rb[m][bj] = *(const u32x4*)(XA + (size_t)(row0 + ai * HALF + m * 16) * ldc + col0 + bj * HALF);
#pragma unroll
            for (int m = 0; m < 4; ++m) { const int row = row0 + ai * HALF + m * 16; const size_t off = (size_t)row * ldc + col0; float s = 0.f;
#pragma unroll
                for (int bj = 0; bj < 2; ++bj) { const u32x4 b = rb[m][bj]; u32x4 w;
#pragma unroll
                    for (int k = 0; k < 4; ++k) { const float lo = __uint_as_float(b[k] << 16) + acc[ai][bj][m][k >> 1][2 * (k & 1)], hi = __uint_as_float(b[k] & 0xffff0000u) + acc[ai][bj][m][k >> 1][2 * (k & 1) + 1];
                        w[k] = cvt_pk_bf16(lo, hi); const float rl = __uint_as_float(w[k] << 16), rh = __uint_as_float(w[k] & 0xffff0000u); s += rl * rl + rh * rh; }
                    *(u32x4*)(XA + off + bj * HALF) = w; }
                s += __builtin_bit_cast(float, __builtin_amdgcn_ds_bpermute((lane ^ 16) << 2, __builtin_bit_cast(int, s)));
                s += __builtin_bit_cast(float, __builtin_amdgcn_ds_bpermute((lane ^ 32) << 2, __builtin_bit_cast(int, s)));
                if (fq == 0) RS[(size_t)row * 16 + u.pn * 4 + wc] = s; } }
    }
};
template <class Epi, class Sched, bool ALIGN_EPI = false, bool SP2 = false>
__device__ __forceinline__ void gemm_phase(PG8_LAS unsigned char* lds, const Gemm g, const Sched& S, const Epi& E, const int tid) {
    const int wid = __builtin_amdgcn_readfirstlane(tid >> 6), lane = tid & 63, wr = wid >> 2, wc = wid & 3, fr = lane & 15, fq = lane >> 4;
    const int K = g.K, nt = K / BK;
    unsigned voffA[2], voffB[2];
#pragma unroll
    for (int i = 0; i < 2; ++i) { int R, C; stage_rc(tid * 16 + i * 8192, R, C); const int Rb = Epi::PERM ? ((R & ~31) + perm32(R & 31)) : R;
        voffA[i] = (unsigned)(R * K + C) * 2u; voffB[i] = (unsigned)(Rb * K + C) * 2u; }
    const size_t kstep = (size_t)(BK * 2);
    const size_t hstep = (size_t)HALF * K * 2;
    const size_t tstep = 2 * hstep;
    const unsigned ldsw = (unsigned)wid * 1024u;
    const int aoff = lds_byte(wr * 64 + fr, fq * 8), boff = lds_byte(wc * 32 + fr, fq * 8);
#define PG8_SA(b, h) (((b) * 2 + (h)) * HTB)
#define PG8_SB(b, h) ((4 + (b) * 2 + (h)) * HTB)
#define PG8_STAGE(bufoff, gbase, voff) do { _Pragma("unroll") for (int _i = 0; _i < 2; ++_i) \
        __builtin_amdgcn_global_load_lds((const unsigned*)((const char*)(gbase) + (voff)[_i]), (PG8_LAS unsigned*)(lds + (bufoff) + ldsw + _i * 8192), 16, 0, 0); } while (0)
#define PG8_LDA(dst, b, h) do { _Pragma("unroll") for (int m = 0; m < 4; ++m) _Pragma("unroll") for (int k = 0; k < 2; ++k) dst[m][k] = *(const PG8_LAS bf16x8*)(lds + PG8_SA(b, h) + aoff + m * 2048 + k * 1024); } while (0)
#define PG8_LDB(dst, b, h) do { _Pragma("unroll") for (int n = 0; n < 2; ++n) _Pragma("unroll") for (int k = 0; k < 2; ++k) dst[n][k] = *(const PG8_LAS bf16x8*)(lds + PG8_SB(b, h) + boff + n * 2048 + k * 1024); } while (0)
#define PG8_MMA(ai, bj, At, Bt) do { __builtin_amdgcn_s_setprio(1); _Pragma("unroll") for (int m = 0; m < 4; ++m) _Pragma("unroll") for (int n = 0; n < 2; ++n) _Pragma("unroll") for (int k = 0; k < 2; ++k) \
        acc[ai][bj][m][n] = __builtin_amdgcn_mfma_f32_16x16x32_bf16(Bt[n][k], At[m][k], acc[ai][bj][m][n], 0, 0, 0); __builtin_amdgcn_s_setprio(0); } while (0)
#define PG8_WAIT_V(n) asm volatile("s_waitcnt vmcnt(" #n ")" ::: "memory")
#define PG8_WAIT_L(n) asm volatile("s_waitcnt lgkmcnt(" #n ")" ::: "memory")
#define PG8_BAR __builtin_amdgcn_s_barrier()
#define PG8_SCHED __builtin_amdgcn_sched_barrier(0)
    Unit cur, nxt; int ui = 0;
    if (!S.next(0, cur)) return;
    f32x4 acc[2][2][4][2];
#pragma unroll
    for (int a = 0; a < 2; ++a)
#pragma unroll
        for (int b = 0; b < 2; ++b)
#pragma unroll
            for (int m = 0; m < 4; ++m)
#pragma unroll
                for (int n = 0; n < 2; ++n) acc[a][b][m][n] = (f32x4){0.f, 0.f, 0.f, 0.f};
    bf16x8 At[4][2], B0[2][2], B1[2][2];
    const char* cA = (const char*)g.A + (size_t)cur.pm * tstep; const char* cB = (const char*)g.Bt + (size_t)cur.pn * tstep;
    S.a_ready(cur);
    if constexpr (SP2) {
        PG8_STAGE(PG8_SB(0, 0), cB, voffB); PG8_STAGE(PG8_SB(0, 1), cB + hstep, voffB); PG8_STAGE(PG8_SA(0, 0), cA, voffA); PG8_STAGE(PG8_SA(0, 1), cA + hstep, voffA);
        if (wr == 1) PG8_BAR;
        PG8_WAIT_V(2); PG8_BAR;
        PG8_STAGE(PG8_SB(1, 0), cB + kstep, voffB); PG8_STAGE(PG8_SA(1, 0), cA + kstep, voffA); PG8_STAGE(PG8_SB(1, 1), cB + hstep + kstep, voffB);
        PG8_WAIT_V(6); PG8_BAR;
    } else {
        PG8_STAGE(PG8_SB(0, 0), cB, voffB); PG8_STAGE(PG8_SA(0, 0), cA, voffA); PG8_STAGE(PG8_SB(0, 1), cB + hstep, voffB); PG8_STAGE(PG8_SA(0, 1), cA + hstep, voffA);
        if (wr == 1) PG8_BAR;
        PG8_WAIT_V(4); PG8_BAR;
        PG8_STAGE(PG8_SB(1, 0), cB + kstep, voffB); PG8_STAGE(PG8_SA(1, 0), cA + kstep, voffA); PG8_STAGE(PG8_SB(1, 1), cB + hstep + kstep, voffB);
        PG8_WAIT_V(6); PG8_BAR;
    }
    for (;;) {
        const bool has_next = S.next(ui + 1, nxt);
        const char* nA = has_next ? (const char*)g.A + (size_t)nxt.pm * tstep : cA; const char* nB = has_next ? (const char*)g.Bt + (size_t)nxt.pn * tstep : cB;
        for (int t = 0; t < nt; t += 2) {
            const bool last = (t == nt - 2);
            const char* a1 = cA + (size_t)(t + 1) * kstep;
            const char* a2 = last ? nA : cA + (size_t)(t + 2) * kstep; const char* b2 = last ? nB : cB + (size_t)(t + 2) * kstep;
            const char* a3 = a2 + kstep; const char* b3 = b2 + kstep;
            if (last && has_next) S.a_ready(nxt);
            if constexpr (SP2) {
            PG8_LDB(B0, 0, 0); PG8_LDB(B1, 0, 1); PG8_SCHED; PG8_LDA(At, 0, 0); PG8_STAGE(PG8_SA(1, 1), a1 + hstep, voffA);
            PG8_WAIT_V(8); PG8_WAIT_L(0); PG8_BAR; PG8_MMA(0, 0, At, B0); PG8_MMA(0, 1, At, B1); PG8_BAR; PG8_SCHED;
            PG8_LDA(At, 0, 1); PG8_STAGE(PG8_SB(0, 0), b2, voffB); PG8_STAGE(PG8_SB(0, 1), b2 + hstep, voffB); PG8_STAGE(PG8_SA(0, 0), a2, voffA);
            PG8_WAIT_V(8); PG8_WAIT_L(0); PG8_BAR; PG8_MMA(1, 0, At, B0); PG8_MMA(1, 1, At, B1); PG8_BAR; PG8_SCHED;
            PG8_LDB(B0, 1, 0); PG8_LDB(B1, 1, 1); PG8_SCHED; PG8_LDA(At, 1, 0); PG8_STAGE(PG8_SA(0, 1), a2 + hstep, voffA);
            PG8_WAIT_V(8); PG8_WAIT_L(0); PG8_BAR; PG8_MMA(0, 0, At, B0); PG8_MMA(0, 1, At, B1); PG8_BAR; PG8_SCHED;
            PG8_LDA(At, 1, 1); PG8_STAGE(PG8_SB(1, 0), b3, voffB); PG8_STAGE(PG8_SB(1, 1), b3 + hstep, voffB); PG8_STAGE(PG8_SA(1, 0), a3, voffA);
            PG8_WAIT_V(8); PG8_WAIT_L(0); PG8_BAR; PG8_MMA(1, 0, At, B0); PG8_MMA(1, 1, At, B1); PG8_BAR; PG8_SCHED;
            } else {
            PG8_LDB(B0, 0, 0); PG8_SCHED; PG8_LDA(At, 0, 0); PG8_STAGE(PG8_SA(1, 1), a1 + hstep, voffA);
            PG8_WAIT_L(8); PG8_BAR; PG8_WAIT_L(0); PG8_MMA(0, 0, At, B0); PG8_BAR; PG8_SCHED;
            PG8_LDB(B1, 0, 1); PG8_STAGE(PG8_SB(0, 0), b2, voffB);
            PG8_BAR; PG8_WAIT_L(0); PG8_MMA(0, 1, At, B1); PG8_BAR;
            PG8_LDA(At, 0, 1); PG8_STAGE(PG8_SA(0, 0), a2, voffA);
            PG8_BAR; PG8_WAIT_L(0); PG8_MMA(1, 0, At, B0); PG8_BAR; PG8_SCHED;
            PG8_STAGE(PG8_SB(0, 1), b2 + hstep, voffB);
            PG8_WAIT_V(6); PG8_BAR; PG8_MMA(1, 1, At, B1); PG8_BAR;
            PG8_LDB(B0, 1, 0); PG8_SCHED; PG8_LDA(At, 1, 0); PG8_STAGE(PG8_SA(0, 1), a2 + hstep, voffA);
            PG8_WAIT_L(8); PG8_BAR; PG8_WAIT_L(0); PG8_MMA(0, 0, At, B0); PG8_BAR; PG8_SCHED;
            PG8_LDB(B1, 1, 1); PG8_STAGE(PG8_SB(1, 0), b3, voffB);
            PG8_BAR; PG8_WAIT_L(0); PG8_MMA(0, 1, At, B1); PG8_BAR;
            PG8_LDA(At, 1, 1); PG8_STAGE(PG8_SA(1, 0), a3, voffA);
            PG8_BAR; PG8_WAIT_L(0); PG8_MMA(1, 0, At, B0); PG8_BAR; PG8_SCHED;
            PG8_STAGE(PG8_SB(1, 1), b3 + hstep, voffB);
            PG8_WAIT_V(6); PG8_BAR; PG8_MMA(1, 1, At, B1); PG8_BAR;
            }
        }
        if constexpr (ALIGN_EPI) { if (wr == 0) PG8_BAR; }
        if constexpr (!Epi::AFTER_DRAIN) { E(acc, cur, wr, wc, fr, fq); S.done(cur); }
        if (!has_next) break;
#pragma unroll
        for (int a = 0; a < 2; ++a)
#pragma unroll
            for (int b = 0; b < 2; ++b)
#pragma unroll
                for (int m = 0; m < 4; ++m)
#pragma unroll
                    for (int n = 0; n < 2; ++n) acc[a][b][m][n] = (f32x4){0.f, 0.f, 0.f, 0.f};
        cur = nxt; cA = nA; cB = nB; ++ui;
        if constexpr (ALIGN_EPI) { if (wr == 1) PG8_BAR; }
    }
    PG8_WAIT_V(0);
    if constexpr (!ALIGN_EPI) { if (wr == 0) PG8_BAR; }
    PG8_BAR;
    if constexpr (Epi::AFTER_DRAIN) { E.fused(acc, cur, wr, wc, fr, fq, lds, wid, lane); S.done(cur); }
#undef PG8_SA
#undef PG8_SB
#undef PG8_STAGE
#undef PG8_LDA
#undef PG8_LDB
#undef PG8_MMA
#undef PG8_WAIT_V
#undef PG8_WAIT_L
#undef PG8_BAR
#undef PG8_SCHED
}
}
#include <hip/hip_bf16.h>
#include <cmath>
namespace attn_body {
using bf16=__hip_bfloat16;
using bf16x8=__attribute__((ext_vector_type(8)))short;
using s16x4=__attribute__((ext_vector_type(4)))short;
using f32x16=__attribute__((ext_vector_type(16)))float;
using u32x4=__attribute__((ext_vector_type(4)))unsigned;
constexpr int BATCH=8,NHEAD=6,SEQ=8192,D=64,DM=3584,DMO=1024;
constexpr int NW=8,QBLK=32,QB=QBLK*NW,KVBLK=64,NQB=SEQ/QB;
constexpr int ATTN_UNIT_ROWS=QB;
__device__ __forceinline__ int crow(int r,int hi){return (r&3)+8*(r>>2)+4*hi;}
#define SBAR() __builtin_amdgcn_sched_barrier(0)
typedef __attribute__((address_space(3))) const float* lds_cfptr;
__device__ __forceinline__ void biasadd(f32x16&p0,f32x16&p1,int tt,int tq,int hi,lds_cfptr dl,int h){
  const int rb=tq-64*tt-4*hi; const lds_cfptr dh=dl+h;
  #pragma unroll
  for(int r=0;r<16;++r){ const unsigned i0=(unsigned)(rb-(r&3)-8*(r>>2)), i1=i0-32u;
    float a0=dh[(i0<128u?i0:128u)*8], a1=dh[(i1<128u?i1:128u)*8];
    asm volatile("s_waitcnt lgkmcnt(0)":"+v"(a0),"+v"(a1)::"memory");
    p0[r]+=a0; p1[r]+=a1; }
}
typedef unsigned u32x2m __attribute__((ext_vector_type(2)));
template<int K> __device__ __forceinline__ float mands(float p,unsigned md){ return __uint_as_float(__float_as_uint(p)&(unsigned)(K==3?((int)md>>24):(int)(signed char)(md>>(8*K)))); }
template<int K> __device__ __forceinline__ float mandk(float p,unsigned bits){ unsigned m; asm("v_bfe_i32 %0, %1, %2, 1":"=v"(m):"v"(bits),"n"(K)); return __uint_as_float(__float_as_uint(p)&m); }
__device__ __forceinline__ float mand(float p,unsigned bits,int k){ return __uint_as_float(__float_as_uint(p)&(unsigned)__builtin_amdgcn_sbfe((int)bits,k,1)); }

constexpr int NSLOT=3, SLOTB=8192;
constexpr int LDS_K=0, LDS_V=NSLOT*SLOTB, LDS_TAB=2*NSLOT*SLOTB, LDS_OST=LDS_TAB+2048, LDS_WS=LDS_OST+NW*4096, LDS_BYTES=LDS_WS+NW*64*4, LDS_QST=90624;
constexpr float C2=0.125f*1.4426950408889634f;
__device__ __forceinline__ void glds16(const void*gsrc,unsigned lds_dst){unsigned keep;
  asm volatile("s_mov_b32 %0, m0\n\ts_mov_b32 m0, %2\n\ts_nop 0\n\tglobal_load_lds_dwordx4 %1, off\n\ts_mov_b32 m0, %0":"=&s"(keep):"v"(gsrc),"s"(lds_dst):"memory");}
__device__ __forceinline__ float max3f(float a,float b,float c){float r;asm("v_max3_f32 %0, %1, %2, %3":"=v"(r):"v"(a),"v"(b),"v"(c));return r;}
__device__ __forceinline__ float max2f(float a,float b){float r;asm("v_max_f32_e32 %0, %1, %2":"=v"(r):"v"(a),"v"(b));return r;}
__device__ __forceinline__ float fadd_s(float a,float b){float r;asm("v_add_f32_e32 %0, %1, %2":"=v"(r):"v"(a),"v"(b));return r;}
__device__ __forceinline__ float fsub_s(float a,float b){float r;asm("v_sub_f32_e32 %0, %1, %2":"=v"(r):"v"(a),"v"(b));return r;}
typedef float f32x2_t __attribute__((ext_vector_type(2))); typedef __bf16 bf16x2_t __attribute__((ext_vector_type(2)));
__device__ __forceinline__ unsigned cvtpk_s(float lo,float hi){f32x2_t v={lo,hi};bf16x2_t b=__builtin_convertvector(v,bf16x2_t);return __builtin_bit_cast(unsigned,b);}
#define WAIT_BAR(N) asm volatile("s_waitcnt vmcnt(" #N ") lgkmcnt(0)\n\ts_barrier":::"memory")

__device__ __forceinline__ void qkt(f32x16&p0,f32x16&p1,const char*Kslot,const bf16x8*qr,const f32x16&negm,int r32,int hi){
  const char*kb=Kslot+hi*1024+r32*16;
  #pragma unroll
  for(int d0=0;d0<4;++d0){
    const bf16x8 b0=*reinterpret_cast<const bf16x8*>(kb+d0*2048);
    const bf16x8 b1=*reinterpret_cast<const bf16x8*>(kb+d0*2048+512);
    if(d0==0){p0=__builtin_amdgcn_mfma_f32_32x32x16_bf16(b0,qr[0],negm,0,0,0);p1=__builtin_amdgcn_mfma_f32_32x32x16_bf16(b1,qr[0],negm,0,0,0);}
    else{p0=__builtin_amdgcn_mfma_f32_32x32x16_bf16(b0,qr[d0],p0,0,0,0);p1=__builtin_amdgcn_mfma_f32_32x32x16_bf16(b1,qr[d0],p1,0,0,0);}}
}
typedef __attribute__((address_space(3))) const char* lds_cptr;
typedef short v4i16_t __attribute__((ext_vector_type(4)));
__device__ __forceinline__ void kload8(bf16x8*kf,lds_cptr kp){
  kf[0]=*(const __attribute__((address_space(3))) bf16x8*)(kp);      kf[1]=*(const __attribute__((address_space(3))) bf16x8*)(kp+512);
  kf[2]=*(const __attribute__((address_space(3))) bf16x8*)(kp+2048); kf[3]=*(const __attribute__((address_space(3))) bf16x8*)(kp+2560);
  kf[4]=*(const __attribute__((address_space(3))) bf16x8*)(kp+4096); kf[5]=*(const __attribute__((address_space(3))) bf16x8*)(kp+4608);
  kf[6]=*(const __attribute__((address_space(3))) bf16x8*)(kp+6144); kf[7]=*(const __attribute__((address_space(3))) bf16x8*)(kp+6656);
}
__device__ __forceinline__ void kload2(bf16x8*kf,lds_cptr kp,int j){ kf[2*j]=*(const __attribute__((address_space(3))) bf16x8*)(kp+j*2048); kf[2*j+1]=*(const __attribute__((address_space(3))) bf16x8*)(kp+j*2048+512); }
__device__ __forceinline__ s16x4 vtr(lds_cptr p){ return __builtin_bit_cast(s16x4,__builtin_amdgcn_ds_read_tr16_b64_v4i16((__attribute__((address_space(3))) v4i16_t*)p)); }
__device__ __forceinline__ float rowmax(const f32x16&p0,const f32x16&p1){
  float a=max3f(p0[0],p0[1],p1[0]),b=max3f(p0[2],p0[3],p1[1]);a=max3f(a,p1[2],p1[3]);
  #pragma unroll
  for(int r=4;r<16;r+=4){a=max3f(a,p0[r],p0[r+1]);b=max3f(b,p0[r+2],p0[r+3]);a=max3f(a,p1[r],p1[r+1]);b=max3f(b,p1[r+2],p1[r+3]);}
  const float m=max2f(a,b);
  auto rr=__builtin_amdgcn_permlane32_swap(__float_as_uint(m),__float_as_uint(m),false,false);
  return max2f(__uint_as_float(rr[0]),__uint_as_float(rr[1]));
}
__device__ __forceinline__ void pv(f32x16*o,int vb,bf16x8 pa0,bf16x8 pa1,bf16x8 pa2,bf16x8 pa3){
  #pragma unroll
  for(int d0=0;d0<2;++d0){s16x4 lo[4],hi[4];
    #pragma unroll
    for(int ks=0;ks<4;++ks){
      asm volatile("ds_read_b64_tr_b16 %0,%1 offset:%c2":"=&v"(lo[ks]):"v"(vb),"i"(d0*4096+ks*1024):"memory");
      asm volatile("ds_read_b64_tr_b16 %0,%1 offset:%c2":"=&v"(hi[ks]):"v"(vb),"i"(d0*4096+ks*1024+512):"memory");}
    asm volatile("s_waitcnt lgkmcnt(0)":::"memory");SBAR();
    #define PK(k) (bf16x8){lo[k][0],lo[k][1],lo[k][2],lo[k][3],hi[k][0],hi[k][1],hi[k][2],hi[k][3]}
    o[d0]=__builtin_amdgcn_mfma_f32_32x32x16_bf16(pa0,PK(0),o[d0],0,0,0);
    o[d0]=__builtin_amdgcn_mfma_f32_32x32x16_bf16(pa1,PK(1),o[d0],0,0,0);
    o[d0]=__builtin_amdgcn_mfma_f32_32x32x16_bf16(pa2,PK(2),o[d0],0,0,0);
    o[d0]=__builtin_amdgcn_mfma_f32_32x32x16_bf16(pa3,PK(3),o[d0],0,0,0);
    #undef PK
  }
}

#ifndef ATTN_STORE16
#define ATTN_STORE16(p,v) (*(u32x4*)(p)=(v))
#endif
template<int THRL> __device__ __forceinline__ void attn_unit(int b,int h,int qb,const bf16*Q,const bf16*__restrict__ K,const bf16*__restrict__ V,bf16*O,const bf16*GT,const unsigned*MK,lds_cfptr dl,char*shm,const int tid){
  const int lane=tid&63,r32=lane&31,hi=lane>>5; const int wid=__builtin_amdgcn_readfirstlane(tid>>6);
  const long rowbase=(long)b*SEQ; const int q0=qb*QB;
  const bf16*Qw=Q+(rowbase+q0+wid*QBLK)*DM+h*D;
  const bf16*Kh=K+rowbase*DM+h*D,*Vh=V+rowbase*DM+h*D;
  const unsigned lds0=(unsigned)(uintptr_t)shm;
  float*wsf=(float*)(shm+LDS_WS)+wid*64;
  const bf16*ksrc=Kh+(long)lane*DM+wid*8;
  const bf16*vsrc=Vh+(long)(16*(wid&3)+(lane>>2))*DM+(wid>>2)*32+(lane&3)*8;
  const unsigned kdst=lds0+LDS_K+wid*1024, vdst=lds0+LDS_V+wid*1024;
  #define DMA_K(t,slot) glds16(ksrc+(long)(t)*KVBLK*DM,(unsigned)__builtin_amdgcn_readfirstlane(kdst+(slot)))
  #define DMA_V(t,slot) glds16(vsrc+(long)(t)*KVBLK*DM,(unsigned)__builtin_amdgcn_readfirstlane(vdst+(slot)))
  const int vb0=(int)(lds0+LDS_V)+((lane>>4)&1)*32+(lane&3)*8+(4*hi+((lane&15)>>2))*64;
  const char*Kbase=shm+LDS_K; bf16x8 kf[8];
  const lds_cptr shm3=(lds_cptr)shm; const lds_cptr kp0=shm3+LDS_K+hi*1024+r32*16; const lds_cptr vp0=shm3+LDS_V+((lane>>4)&1)*32+(lane&3)*8+(4*hi+((lane&15)>>2))*64;
  const int NT=(q0+QB)/KVBLK;
  DMA_K(0,0);DMA_V(0,0);DMA_K(1,SLOTB);
  const __attribute__((address_space(3))) char* shm3q=(const __attribute__((address_space(3))) char*)shm;
  bf16x8 qr[4];
  #pragma unroll
  for(int d0=0;d0<4;++d0)qr[d0]=*reinterpret_cast<const bf16x8*>(&Qw[(long)r32*DM+d0*16+hi*8]);
  const __attribute__((address_space(3))) bf16x8* qls=(const __attribute__((address_space(3))) bf16x8*)(shm3q+LDS_QST+wid*4096)+lane;
  #pragma unroll
  for(int d0=0;d0<4;++d0)((__attribute__((address_space(3))) bf16x8*)qls)[64*d0]=qr[d0];
  float mhat=0.f,l_reg=0.f;f32x16 o[2];o[0]=f32x16{};o[1]=f32x16{};float nmh=0.f;
  const int tq=q0+wid*QBLK+r32;
  const unsigned*mbase=MK+((size_t)(b*256+(q0>>5)+wid)*128)*64;
  unsigned bits_cur=mbase[lane],bits_next=mbase[64+lane];
  #define CMASK(P0,P1,t) do{ if((t)>=NT-6)biasadd(P0,P1,(t),tq,hi,dl,h);}while(0)
  bool resc=false;
  #define START(P0,P1) do{ const float rm=rowmax(P0,P1); resc=false; \
    { const float dl=(rm>(float)THRL||rm<-(float)THRL)?rm:0.f; mhat=fadd_s(mhat,dl);     \
      _Pragma("unroll") for(int r=0;r<16;++r){P0[r]=fsub_s(P0[r],dl);P1[r]=fsub_s(P1[r],dl);} \
      nmh=-mhat; } \
    _Pragma("unroll") for(int r=0;r<16;++r)P0[r]=mand(__builtin_amdgcn_exp2f(P0[r]),bits_cur,r); }while(0)
  #define RESC() do{ if(resc){ asm volatile("s_waitcnt lgkmcnt(0)":::"memory"); \
      _Pragma("unroll") for(int d_=0;d_<2;++d_) _Pragma("unroll") for(int r=0;r<16;++r)o[d_][r]*=wsf[crow(r,hi)]; } }while(0)
  f32x16 pA0,pA1,pB0,pB1;
  int sl_prev=0,sl_cur=0,sl_next=SLOTB;
  #define ROT() do{sl_prev=sl_cur;sl_cur=sl_next;sl_next=(sl_next==(NSLOT-1)*SLOTB)?0:sl_next+SLOTB;}while(0)
  DMA_K(2,2*SLOTB);
  WAIT_BAR(3);
  { const f32x16 zc=f32x16{}; qkt(pA0,pA1,Kbase,qr,zc,r32,hi); }asm volatile("s_nop 15\n\ts_nop 7":"+v"(pA0),"+v"(pA1));CMASK(pA0,pA1,0);
  START(pA0,pA1);
  _Pragma("unroll") for(int r=0;r<16;++r)pA1[r]=mand(__builtin_amdgcn_exp2f(pA1[r]),bits_cur,16+r);
  WAIT_BAR(0);
  DMA_K(3,0);DMA_V(1,SLOTB);
  ROT();
  kload8(kf,kp0+sl_cur);
  WAIT_BAR(2);
  u32x2m mk01,mk23,mk45,mk67;
  s16x4 vlo[8],vhi[8]; u32x4 pw0,pw1,pw2,pw3; bf16x8 qa_=qls[0],qb_;
  #define PKW(P,B) cvtpk_s(P[B],P[B+1])
  #define PAF(k) __builtin_bit_cast(bf16x8,pw##k)
  #define VFR(i) (bf16x8){vlo[i][0],vlo[i][1],vlo[i][2],vlo[i][3],vhi[i][0],vhi[i][1],vhi[i][2],vhi[i][3]}
  #define PIN(x) asm volatile("":"+v"(x))
  #define MX3(a,b,c) __builtin_fmaxf(__builtin_fmaxf((a),(b)),(c))
  #define GAPA(MF,A0,A1,A2,A3,W0,W1,PW) do{ MF; sacc+=A0; sacc+=A1; sacc+=A2; sacc+=A3; PIN(sacc); W0; W1; PIN(PW); SBAR(); }while(0)
  #define EX(v) __builtin_amdgcn_exp2f(v)
  #define MKD(e) (((e)>>2)==0?mk01[0]:((e)>>2)==1?mk01[1]:((e)>>2)==2?mk23[0]:((e)>>2)==3?mk23[1]:((e)>>2)==4?mk45[0]:((e)>>2)==5?mk45[1]:((e)>>2)==6?mk67[0]:mk67[1])
  #define GAPB(MF,X,B,MB) do{ MF; { const unsigned md_=MKD((MB)+(B)); X[B]=mands<0>(EX(X[B]),md_); X[B+1]=mands<1>(EX(X[B+1]),md_); X[B+2]=mands<2>(EX(X[B+2]),md_); X[B+3]=mands<3>(EX(X[B+3]),md_); } PIN(X); SBAR(); }while(0)
  #define VRD(i) do{ vlo[i]=vtr(vp_+(((i)>>2)*4096+((i)&3)*1024)); vhi[i]=vtr(vp_+(((i)>>2)*4096+((i)&3)*1024+512)); }while(0)
  #define KRD(G,j) do{ if(G){ kload2(kf,kp0+sl_next,j); SBAR(); } }while(0)
  #define STEP(C0,C1,P0,P1,t,GK,GV,GL) do{ SBAR(); \
    bits_cur=bits_next; if(GV){ bits_next=mbase[64*((t)+1)+lane]; } \
    { typedef const __attribute__((address_space(3))) u32x2m* tp_;     \
      mk01=*(tp_)(LDS_TAB+(((unsigned)(unsigned char)(bits_cur))<<3)); mk23=*(tp_)(LDS_TAB+(((unsigned)(unsigned char)(bits_cur>>8))<<3)); mk45=*(tp_)(LDS_TAB+(((unsigned)(unsigned char)(bits_cur>>16))<<3)); mk67=*(tp_)(LDS_TAB+((bits_cur>>24)<<3)); } \
    const lds_cptr vp_=vp0+sl_prev; \
    VRD(0); qb_=qls[64]; SBAR(); float sacc=(P0[0]+P0[1]); \
    if(!__any(nmh!=0.f)){ const f32x16 zc_=f32x16{}; \
      GAPA(C0=__builtin_amdgcn_mfma_f32_32x32x16_bf16(kf[0],qa_,zc_,0,0,0), P0[2],P0[3],P0[4],P0[5],     pw0[0]=PKW(P0,0), pw0[1]=PKW(P0,2), pw0); \
      VRD(4); SBAR(); GAPA(C1=__builtin_amdgcn_mfma_f32_32x32x16_bf16(kf[1],qa_,zc_,0,0,0), P0[6],P0[7],P0[8],P0[9],     pw0[2]=PKW(P0,4), pw0[3]=PKW(P0,6), pw0); \
    }else{ f32x16 negm; { float nm_=nmh; asm volatile("":"+v"(nm_)); _Pragma("unroll") for(int r=0;r<16;++r)negm[r]=nm_; } \
      GAPA(C0=__builtin_amdgcn_mfma_f32_32x32x16_bf16(kf[0],qa_,negm,0,0,0), P0[2],P0[3],P0[4],P0[5],     pw0[0]=PKW(P0,0), pw0[1]=PKW(P0,2), pw0); \
      VRD(4); SBAR(); GAPA(C1=__builtin_amdgcn_mfma_f32_32x32x16_bf16(kf[1],qa_,negm,0,0,0), P0[6],P0[7],P0[8],P0[9],     pw0[2]=PKW(P0,4), pw0[3]=PKW(P0,6), pw0); } \
    VRD(1); qa_=qls[128]; SBAR(); GAPA(C0=__builtin_amdgcn_mfma_f32_32x32x16_bf16(kf[2],qb_,C0,0,0,0),   P0[10],P0[11],P0[12],P0[13], pw1[0]=PKW(P0,8), pw1[1]=PKW(P0,10), pw1); \
    VRD(5); SBAR(); GAPA(C1=__builtin_amdgcn_mfma_f32_32x32x16_bf16(kf[3],qb_,C1,0,0,0),   P0[14],P0[15],P1[0],P1[1],   pw1[2]=PKW(P0,12),pw1[3]=PKW(P0,14), pw1); \
    VRD(2); qb_=qls[192]; SBAR(); GAPA(C0=__builtin_amdgcn_mfma_f32_32x32x16_bf16(kf[4],qa_,C0,0,0,0),   P1[2],P1[3],P1[4],P1[5],     pw2[0]=PKW(P1,0), pw2[1]=PKW(P1,2), pw2); \
    VRD(6); SBAR(); GAPA(C1=__builtin_amdgcn_mfma_f32_32x32x16_bf16(kf[5],qa_,C1,0,0,0),   P1[6],P1[7],P1[8],P1[9],     pw2[2]=PKW(P1,4), pw2[3]=PKW(P1,6), pw2); \
    VRD(3); qa_=qls[0]; SBAR(); GAPA(C0=__builtin_amdgcn_mfma_f32_32x32x16_bf16(kf[6],qb_,C0,0,0,0),   P1[10],P1[11],P1[12],P1[13], pw3[0]=PKW(P1,8), pw3[1]=PKW(P1,10), pw3); \
    VRD(7); SBAR(); GAPA(C1=__builtin_amdgcn_mfma_f32_32x32x16_bf16(kf[7],qb_,C1,0,0,0),   P1[14],P1[15],0.f,0.f,       pw3[2]=PKW(P1,12),pw3[3]=PKW(P1,14), pw3); \
    l_reg+=sacc; \
    if(GK){DMA_K((t)+3,sl_cur);} if(GV){DMA_V((t)+1,sl_next);} \
    CMASK(C0,C1,t); \
    { float a=MX3(C0[0],C0[1],C1[0]),b=MX3(C0[2],C0[3],C1[1]); a=MX3(a,C1[2],C1[3]); \
      _Pragma("unroll") for(int r=4;r<16;r+=4){a=MX3(a,C0[r],C0[r+1]);b=MX3(b,C0[r+2],C0[r+3]);a=MX3(a,C1[r],C1[r+1]);b=MX3(b,C1[r+2],C1[r+3]);} \
      float rm=__builtin_fmaxf(a,b); { auto rr=__builtin_amdgcn_permlane32_swap(__float_as_uint(rm),__float_as_uint(rm),false,false); rm=__builtin_fmaxf(__uint_as_float(rr[0]),__uint_as_float(rr[1])); } \
      resc=false; \
      if(__builtin_expect(__any(rm>(float)THRL),0)){ const float dl=__builtin_fmaxf(rm,0.f); mhat+=dl; \
        _Pragma("unroll") for(int r=0;r<16;++r){C0[r]-=dl;C1[r]-=dl;} \
        nmh=-mhat; \
        const float f=__builtin_amdgcn_exp2f(-dl); l_reg*=f; if(hi==0)wsf[r32]=f; resc=true; } } \
    SBAR(); \
    GAPB(o[0]=__builtin_amdgcn_mfma_f32_32x32x16_bf16(PAF(0),VFR(0),o[0],0,0,0), C0,0,0); \
    GAPB(o[1]=__builtin_amdgcn_mfma_f32_32x32x16_bf16(PAF(0),VFR(4),o[1],0,0,0), C0,4,0); \
    KRD(GL,0); GAPB(o[0]=__builtin_amdgcn_mfma_f32_32x32x16_bf16(PAF(1),VFR(1),o[0],0,0,0), C0,8,0); \
    KRD(GL,1); GAPB(o[1]=__builtin_amdgcn_mfma_f32_32x32x16_bf16(PAF(1),VFR(5),o[1],0,0,0), C0,12,0); \
    KRD(GL,2); GAPB(o[0]=__builtin_amdgcn_mfma_f32_32x32x16_bf16(PAF(2),VFR(2),o[0],0,0,0), C1,0,16); \
    KRD(GL,3); GAPB(o[1]=__builtin_amdgcn_mfma_f32_32x32x16_bf16(PAF(2),VFR(6),o[1],0,0,0), C1,4,16); \
    GAPB(o[0]=__builtin_amdgcn_mfma_f32_32x32x16_bf16(PAF(3),VFR(3),o[0],0,0,0), C1,8,16); \
    GAPB(o[1]=__builtin_amdgcn_mfma_f32_32x32x16_bf16(PAF(3),VFR(7),o[1],0,0,0), C1,12,16); \
    }while(0)
  int t=1;
  #undef CMASK
  #define CMASK(P0,P1,t) do{}while(0)
  for(;t+7<NT;t+=2){
    STEP(pB0,pB1,pA0,pA1,t,true,true,true);     WAIT_BAR(2); RESC(); ROT();
    STEP(pA0,pA1,pB0,pB1,t+1,true,true,true);   WAIT_BAR(2); RESC(); ROT();
  }
  #undef CMASK
  #define CMASK(P0,P1,t) do{ if((t)>=NT-6)biasadd(P0,P1,(t),tq,hi,dl,h);}while(0)
  #define ENDW(tt) do{ if((tt)+3<NT){WAIT_BAR(2);} else if((tt)+2<NT){WAIT_BAR(1);} else {WAIT_BAR(0);} }while(0)
  for(;t+1<NT;t+=2){
    STEP(pB0,pB1,pA0,pA1,t,(t+3<NT),(t+1<NT),(t+1<NT));       ENDW(t);   RESC(); ROT();
    STEP(pA0,pA1,pB0,pB1,t+1,(t+4<NT),(t+2<NT),(t+2<NT));     ENDW(t+1); RESC(); ROT();
  }
  STEP(pB0,pB1,pA0,pA1,NT-1,false,false,false); RESC();
  { float sacc=pB0[0]+pB0[1]; _Pragma("unroll") for(int r=2;r<16;++r)sacc+=pB0[r]; _Pragma("unroll") for(int r=0;r<16;++r)sacc+=pB1[r]; l_reg+=sacc;
    pw0=(u32x4){PKW(pB0,0),PKW(pB0,2),PKW(pB0,4),PKW(pB0,6)};pw1=(u32x4){PKW(pB0,8),PKW(pB0,10),PKW(pB0,12),PKW(pB0,14)};pw2=(u32x4){PKW(pB1,0),PKW(pB1,2),PKW(pB1,4),PKW(pB1,6)};pw3=(u32x4){PKW(pB1,8),PKW(pB1,10),PKW(pB1,12),PKW(pB1,14)};
    SBAR(); pv(o,vb0+sl_cur,PAF(0),PAF(1),PAF(2),PAF(3)); }
  #undef PKW
  #undef PAF
  #undef VFR
  #undef PIN
  #undef MX3
  #undef GAPA
  #undef GAPB
  #undef EX
  #undef VRD
  #undef KRD
  #undef STEP
  #undef ENDW
  {auto rr=__builtin_amdgcn_permlane32_swap(__float_as_uint(l_reg),__float_as_uint(l_reg),false,false);l_reg=__uint_as_float(rr[0])+__uint_as_float(rr[1]);}
  if(hi==0)wsf[32+r32]=l_reg;asm volatile("s_waitcnt lgkmcnt(0)":::"memory");
  float rli[16];
  #pragma unroll
  for(int r=0;r<16;++r)rli[r]=__builtin_amdgcn_rcpf(wsf[32+crow(r,hi)]);
  bf16*Ow=O+(rowbase+q0+wid*QBLK)*DMO+h*D; const bf16*Gw=GT+(rowbase+q0+wid*QBLK)*DM+h*D;
  { bf16*stg=(bf16*)(shm+LDS_OST)+wid*2048;
    #pragma unroll
    for(int r=0;r<16;++r){const int orow=crow(r,hi);
      #pragma unroll
      for(int d0=0;d0<2;++d0)stg[orow*64+d0*32+r32]=__float2bfloat16(o[d0][r]*rli[r]);}
    asm volatile("s_waitcnt lgkmcnt(0)":::"memory");
    #pragma unroll
    for(int i=0;i<4;++i){const int row=i*8+(lane>>3),ch=lane&7; const u32x4 v=*(const u32x4*)(stg+row*64+ch*8); const u32x4 g=*(const u32x4*)(Gw+(long)row*DM+ch*8); u32x4 w;
      #pragma unroll
      for(int k=0;k<4;++k){ const float g0=__uint_as_float(g[k]<<16),g1=__uint_as_float(g[k]&0xffff0000u); const float v0=__uint_as_float(v[k]<<16),v1=__uint_as_float(v[k]&0xffff0000u);
        w[k]=cvtpk_s(v0*(g0/(1.0f+__expf(-g0))),v1*(g1/(1.0f+__expf(-g1)))); }
      ATTN_STORE16(Ow+(long)row*DMO+ch*8,w);} }
  asm volatile("s_waitcnt lgkmcnt(0)\n\ts_barrier":::"memory");
  #undef DMA_K
  #undef DMA_V
  #undef CMASK
  #undef START
  #undef RESC
  #undef ROT
}
constexpr int ATTN_LDS_BYTES=LDS_BYTES;
struct AttnTensors { const bf16* Q; const bf16* K; const bf16* V; bf16* O; const bf16* GT; const unsigned* MK; };
struct AttnUnit { int bh; int qb; };
struct StaticOrder {
  int wg,G;
  __device__ __forceinline__ explicit StaticOrder(int grid,int block):wg(block),G(grid){}
  __device__ __forceinline__ bool next(int i,AttnUnit&u)const{ const int p=wg+(i>>1)*G; if(p>=768)return false; const int s=p&15; u.bh=p>>4; u.qb=(i&1)?31-s:s; return true; }
  __device__ __forceinline__ void a_ready(const AttnUnit&)const{}
  __device__ __forceinline__ void done(const AttnUnit&)const{}
};
template<class Sched,int THRL=8> __device__ __forceinline__ void attn_phase(char*lds,const AttnTensors&T,lds_cfptr dl,const Sched&S,int tid){
  AttnUnit u;
  for(int i=0;S.next(i,u);++i){ asm volatile("":"+v"(tid)); S.a_ready(u); attn_unit<THRL>(u.bh/NHEAD,u.bh%NHEAD,u.qb,T.Q,T.K,T.V,T.O,T.GT,T.MK,dl,lds,tid); S.done(u); }
}
#undef SBAR
#undef WAIT_BAR
}

constexpr int NWAVES = 8, NTHR = 512;
constexpr int BATCH = 8, SEQ = 8192, DM = 1024, DEPTH = 4, M = BATCH * SEQ;
constexpr int IN_COLS = 3380, NP = 3584;
constexpr float EPS = 1e-6f;
constexpr int N_GQ = 0, N_GK = 192, N_GV = 384, N_GG = 768, N_DQ = 1152, N_DK = 1536, N_DV = 1920, N_DG = 2304, N_PU = 2688, N_PG = 2944, N_QI = 3200, N_KI = 3328, N_GZ = 3360, N_WI = 3376;
constexpr float LOG2E = 1.4426950408889634f;
constexpr size_t MiB = 1u << 20;
constexpr size_t WS_CTL = 0, CTL_ZERO_BYTES = 1 * MiB;
constexpr size_t WS_WIN = 2 * MiB;
constexpr size_t WS_WOUT = 32 * MiB;
constexpr size_t WS_XB = 48 * MiB;
constexpr size_t WS_P = 176 * MiB;
constexpr size_t WS_MASK = 624 * MiB;
constexpr size_t WS_GOP = 688 * MiB;
constexpr size_t WS_XA = 832 * MiB;
constexpr size_t WS_RSC = 44 * MiB;
constexpr size_t WS_RS = 40 * MiB;
constexpr size_t WS_ZW = 960 * MiB;
constexpr size_t WS_KC = 968 * MiB;
constexpr size_t WS_END = 972 * MiB;
constexpr int CW_BAR = 4096, CW_QUEUE = 8192;
constexpr int RING_BYTES = 131072, LDSCTL_OFF = RING_BYTES, MISC_OFF = LDSCTL_OFF + 320, LDS_BYTES = 147456;

#define GAS __attribute__((address_space(1)))
#define LAS __attribute__((address_space(3)))
typedef unsigned short bf16;
typedef unsigned v4u __attribute__((ext_vector_type(4)));
typedef unsigned v2u __attribute__((ext_vector_type(2)));
typedef float f32x4 __attribute__((ext_vector_type(4)));
typedef GAS unsigned gu32;
#define RLX_AGENT __ATOMIC_RELAXED, __HIP_MEMORY_SCOPE_AGENT
__device__ __forceinline__ unsigned f2bf(float f) { unsigned u = __builtin_bit_cast(unsigned, f); return (u + 0x7fffu + ((u >> 16) & 1u)) >> 16; }
__device__ __forceinline__ unsigned pk2(float lo, float hi) { return f2bf(lo) | (f2bf(hi) << 16); }
__device__ __forceinline__ float bf2f(unsigned short b) { return __builtin_bit_cast(float, (unsigned)b << 16); }
__device__ __forceinline__ float bflo(unsigned w) { return __builtin_bit_cast(float, w << 16); }
__device__ __forceinline__ float bfhi(unsigned w) { return __builtin_bit_cast(float, w & 0xffff0000u); }
__device__ __forceinline__ float shx(float v, int o, int lane) { return __builtin_bit_cast(float, __builtin_amdgcn_ds_bpermute((lane ^ o) << 2, __builtin_bit_cast(int, v))); }
__device__ __forceinline__ int shdn(int v, int o, int lane) { return __builtin_amdgcn_ds_bpermute(((lane + o) & 63) << 2, v); }
__device__ __forceinline__ float wave_sum(float v, int lane) {
#pragma unroll
    for (int o = 1; o < 64; o <<= 1) v += shx(v, o, lane);
    return v;
}
__device__ __forceinline__ float silu_f(float x) { return x / (1.0f + __expf(-x)); }

__constant__ unsigned char T5B[128] = {0, 1, 2, 3, 4, 5, 6, 7, 8, 9, 10, 11, 12, 13, 14, 15, 16, 16, 16, 17, 17, 18, 18, 18, 19, 19, 19, 20, 20, 20, 20, 21, 21, 21, 21, 22, 22, 22, 22, 22, 23, 23, 23, 23, 23, 23, 24, 24, 24, 24, 24, 24, 25, 25, 25, 25, 25, 25, 25, 26, 26, 26, 26, 26, 26, 26, 26, 27, 27, 27, 27, 27, 27, 27, 27, 27, 27, 28, 28, 28, 28, 28, 28, 28, 28, 28, 28, 29, 29, 29, 29, 29, 29, 29, 29, 29, 29, 29, 29, 30, 30, 30, 30, 30, 30, 30, 30, 30, 30, 30, 30, 30, 30, 31, 31, 31, 31, 31, 31, 31, 31, 31, 31, 31, 31, 31, 31, 31};
__device__ __forceinline__ int t5_bucket(int rel) { return rel >= 128 ? 31 : (int)T5B[rel]; }

#define XB_TMO      128
#define XB_XCNT(j)  (256  + 64 * (j))
#define XB_XSUB(j)  (1280 + 64 * (j))
#define XB_XGEN(j)  (2304 + 64 * (j))
#define XB_TOP      3328
#define XB_TOPGEN   3392
#define XCD_BAR_WORDS 3456
#define XB_SPIN_CAP (1u << 22)

__device__ __forceinline__ unsigned xb_ld(unsigned* p)              { return __hip_atomic_load(p, __ATOMIC_RELAXED, __HIP_MEMORY_SCOPE_AGENT); }
__device__ __forceinline__ unsigned xb_add(unsigned* p, unsigned v) { return __hip_atomic_fetch_add(p, v, __ATOMIC_RELAXED, __HIP_MEMORY_SCOPE_AGENT); }
__device__ __forceinline__ unsigned xb_xcc_id() { return (unsigned)__builtin_amdgcn_s_getreg((3 << 11) | 20) & 0xFu; }
#define XB_SPIN(cond, bar) do { unsigned _sp = 0; while (cond) { __builtin_amdgcn_s_sleep(1); \
    if ((++_sp & 255u) == 0u) { if (xb_ld(&(bar)[XB_TMO])) break; if (_sp > XB_SPIN_CAP) { atomicAdd(&(bar)[XB_TMO], 1u); break; } } } } while (0)

struct XcdBarrier {
    unsigned* bar; unsigned x;
    volatile LAS unsigned* st;
};

__device__ __forceinline__ XcdBarrier xcd_barrier_post(unsigned* bar, volatile LAS unsigned* st) {
    XcdBarrier b; b.bar = bar; b.x = xb_xcc_id(); b.st = st;
    if (threadIdx.x == 0) (void)xb_add(&bar[XB_XCNT(b.x)], 1u);
    return b;
}
__device__ __forceinline__ void xcd_barrier_complete(unsigned* bar, unsigned x, unsigned& nloc, unsigned& nx) {
    const unsigned G = gridDim.x * gridDim.y * gridDim.z;
    unsigned sum, cnt, mine, sp = 0u;
    for (;;) {
        sum = 0u; cnt = 0u; mine = 0u;
#pragma unroll
        for (unsigned j = 0; j < 16; ++j) { const unsigned c = xb_ld(&bar[XB_XCNT(j)]); sum += c; cnt += (c > 0u) ? 1u : 0u; mine = (j == x) ? c : mine; }
        if (sum == G) break;
        __builtin_amdgcn_s_sleep(1);
        if ((++sp & 255u) == 0u) { if (xb_ld(&bar[XB_TMO])) break; if (sp > XB_SPIN_CAP) { atomicAdd(&bar[XB_TMO], 1u); break; } }
    }
    nloc = mine > 0u ? mine : 1u; nx = cnt > 0u ? cnt : 1u;
}

__device__ __forceinline__ void xcd_barrier(const XcdBarrier& b) {
    asm volatile("s_waitcnt vmcnt(0)" ::: "memory");
    __syncthreads();
    if (threadIdx.x == 0) {
        unsigned* bar = b.bar;
        __builtin_amdgcn_s_waitcnt(0);
        unsigned nloc = b.st[0], nx = b.st[1];
        if (nloc == 0u) { xcd_barrier_complete(bar, b.x, nloc, nx); b.st[0] = nloc; b.st[1] = nx; }
        const unsigned old = xb_add(&bar[XB_XSUB(b.x)], 1u);
        const unsigned gen = old / nloc;
        if (old + 1u == (gen + 1u) * nloc) {
            __builtin_amdgcn_fence(__ATOMIC_RELEASE, "agent");
            asm volatile("s_waitcnt vmcnt(0)" ::: "memory");
            const unsigned og = xb_add(&bar[XB_TOP], 1u);
            const unsigned tg = og / nx;
            if (og + 1u == (tg + 1u) * nx) xb_add(&bar[XB_TOPGEN], 1u);
            else XB_SPIN(xb_ld(&bar[XB_TOPGEN]) == tg, bar);
            __builtin_amdgcn_fence(__ATOMIC_ACQUIRE, "agent");
            xb_add(&bar[XB_XGEN(b.x)], 1u);
            asm volatile("s_waitcnt vmcnt(0)" ::: "memory");
        } else {
            XB_SPIN(xb_ld(&bar[XB_XGEN(b.x)]) == gen, bar);
            __builtin_amdgcn_fence(__ATOMIC_ACQUIRE, "agent");
            asm volatile("s_waitcnt vmcnt(0)" ::: "memory");
        }
    }
    __syncthreads();
}
#ifndef IDX_NOFALLBACK
#define IDX_NOFALLBACK 0
#endif
#ifndef REP_RES
#define REP_RES 1
#endif
#ifndef REP_PATCH
#define REP_PATCH 1
#endif
#ifndef REP_P1
#define REP_P1 1
#endif
#ifndef REP_P3
#define REP_P3 1
#endif
#ifndef REP_HEAD
#define REP_HEAD 1
#endif
#ifndef REP_RES
#define REP_RES 1
#endif
#ifndef REP_P2
#define REP_P2 1
#endif
#ifndef REP_RANK
#define REP_RANK 1
#endif
#ifndef IDX_PRIO
#define IDX_PRIO 1
#endif
#ifndef IDX_PKFMA
#define IDX_PKFMA 0
#endif
#ifndef PROBE_MFMA2
#define PROBE_MFMA2 0
#endif
#ifndef PROBE_ADD2
#define PROBE_ADD2 0
#endif
#ifndef IDX_ASMFMA
#define IDX_ASMFMA 0
#endif
#ifndef IDX_ASMBIN
#define IDX_ASMBIN 0
#endif
namespace idxb {
typedef short bf16x8 __attribute__((ext_vector_type(8)));
typedef float f32x16 __attribute__((ext_vector_type(16)));
constexpr int ZBIN = 0, NBINS = 512, CAP = 256;
constexpr int L_HIST = 0, L_ZC = 65536, L_PAR = 81920, L_KBUF = 83968, L_XT = 116736;
enum { P_BSTAR = 0, P_KK, P_CCNT, P_TAU, P_CUT, P_MODE, P_TSTAR, P_RSTAR, P_OVF, P_NRANK, P_PRE, P_XL, P_XU, P_ANY3 };
__device__ __forceinline__ unsigned lds_add(unsigned* p, unsigned v) { return __hip_atomic_fetch_add((__attribute__((address_space(3))) unsigned*)p, v, __ATOMIC_RELAXED, __HIP_MEMORY_SCOPE_WORKGROUP); }
__device__ __forceinline__ int crow(int r, int hi) { return (r & 3) + 8 * (r >> 2) + 4 * hi; }
struct QFrag { bf16x8 q[4][2]; float w[4]; };
__device__ __forceinline__ f32x16 score_sub(const bf16x8 k0, const bf16x8 k1, const QFrag& Q) {
    f32x16 acc;
#pragma unroll
    for (int r = 0; r < 16; ++r) acc[r] = 0.f;
    const f32x16 zz = {0.f, 0.f, 0.f, 0.f, 0.f, 0.f, 0.f, 0.f, 0.f, 0.f, 0.f, 0.f, 0.f, 0.f, 0.f, 0.f};
    float INFV; asm("s_mov_b32 %0, 0x7f800000" : "=s"(INFV));
#pragma unroll
    for (int hp = 0; hp < 2; ++hp) {
        f32x16 d0 = __builtin_amdgcn_mfma_f32_32x32x16_bf16(k0, Q.q[2 * hp][0], zz, 0, 0, 0), d1 = __builtin_amdgcn_mfma_f32_32x32x16_bf16(k0, Q.q[2 * hp + 1][0], zz, 0, 0, 0);
        d0 = __builtin_amdgcn_mfma_f32_32x32x16_bf16(k1, Q.q[2 * hp][1], d0, 0, 0, 0); d1 = __builtin_amdgcn_mfma_f32_32x32x16_bf16(k1, Q.q[2 * hp + 1][1], d1, 0, 0, 0);
#if PROBE_MFMA2
        { f32x16 e0 = __builtin_amdgcn_mfma_f32_32x32x16_bf16(k0, Q.q[2 * hp][1], zz, 0, 0, 0); e0 = __builtin_amdgcn_mfma_f32_32x32x16_bf16(k1, Q.q[2 * hp][0], e0, 0, 0, 0);
          e0 = __builtin_amdgcn_mfma_f32_32x32x16_bf16(k0, Q.q[2 * hp + 1][1], e0, 0, 0, 0); e0 = __builtin_amdgcn_mfma_f32_32x32x16_bf16(k1, Q.q[2 * hp + 1][0], e0, 0, 0, 0); asm volatile("" :: "v"(e0)); }
#endif
#if IDX_PKFMA
        { typedef float f32x2 __attribute__((ext_vector_type(2)));
            const f32x2 wa = {Q.w[2 * hp], Q.w[2 * hp]}, wb = {Q.w[2 * hp + 1], Q.w[2 * hp + 1]};
#pragma unroll
            for (int r = 0; r < 16; r += 2) { const f32x2 ra = {__builtin_amdgcn_fmed3f(d0[r], 0.f, INFV), __builtin_amdgcn_fmed3f(d0[r + 1], 0.f, INFV)}, rb = {__builtin_amdgcn_fmed3f(d1[r], 0.f, INFV), __builtin_amdgcn_fmed3f(d1[r + 1], 0.f, INFV)};
                f32x2 ac = {acc[r], acc[r + 1]}; ac = __builtin_elementwise_fma(wa, ra, ac); ac = __builtin_elementwise_fma(wb, rb, ac); acc[r] = ac[0]; acc[r + 1] = ac[1]; } }
#else
#pragma unroll
        for (int r = 0; r < 16; ++r) {
#if IDX_ASMFMA
            const float r0 = __builtin_amdgcn_fmed3f(d0[r], 0.f, INFV), r1 = __builtin_amdgcn_fmed3f(d1[r], 0.f, INFV); float a0 = acc[r], a1;
            if (hp == 0) asm("v_mul_f32 %0, %1, %2" : "=v"(a0) : "v"(Q.w[0]), "v"(r0)); else asm("v_fma_f32 %0, %1, %2, %3" : "=v"(a0) : "v"(Q.w[2]), "v"(r0), "v"(acc[r]));
            asm("v_fma_f32 %0, %1, %2, %3" : "=v"(a1) : "v"(Q.w[2 * hp + 1]), "v"(r1), "v"(a0)); acc[r] = a1;
#else
            acc[r] = __builtin_fmaf(Q.w[2 * hp + 1], __builtin_amdgcn_fmed3f(d1[r], 0.f, INFV), __builtin_fmaf(Q.w[2 * hp], __builtin_amdgcn_fmed3f(d0[r], 0.f, INFV), acc[r]));
#endif
        }
#endif
    }
    return acc;
}
constexpr int G0 = (int)(0x3F800000u >> 18);
typedef __attribute__((address_space(3))) unsigned lds_u32;
__device__ __forceinline__ void hist_add(unsigned hb, float x, unsigned inc) {
    const float xc = __builtin_amdgcn_fmed3f(x, -254.0f, 254.0f);
#if IDX_ASMBIN
    float os, y; const unsigned m = 0x7fffffffu;
    asm("v_bfi_b32 %0, %1, 1.0, %2" : "=v"(os) : "s"(m), "v"(xc));
    asm("v_add_f32 %0, %1, %2" : "=v"(y) : "v"(xc), "v"(os));
    unsigned sh; asm("v_lshrrev_b32 %0, 18, %1" : "=v"(sh) : "v"(y));
    const unsigned a = hb + (sh << 2);
#else
    const float y = xc + __uint_as_float((__float_as_uint(xc) & 0x80000000u) | 0x3F800000u);
    const unsigned a = hb + ((__float_as_uint(y) >> 18) << 2);
#endif
    __hip_atomic_fetch_add((lds_u32*)a, inc, __ATOMIC_RELAXED, __HIP_MEMORY_SCOPE_WORKGROUP);
#if PROBE_ADD2
    __hip_atomic_fetch_add((lds_u32*)(a ^ 64u), 0u, __ATOMIC_RELAXED, __HIP_MEMORY_SCOPE_WORKGROUP);
#endif
}
__device__ __forceinline__ int hword(int q, int h) { return ((h >> 8) << 13) + q * 256 + (h & 255); }
__device__ __forceinline__ int rank_to_bin(int k) { return k < 256 ? 255 - k : k; }
__device__ __forceinline__ float xthr(int ot) { if (ot == 0) return 0.f;
    const unsigned B = (unsigned)(G0 + ot) << 18; unsigned hi = __float_as_uint(__uint_as_float(B) - 1.0f), lo = 0u;
#pragma unroll 1
    for (int i = 0; i < 32; ++i) { const unsigned mid = lo + ((hi - lo) >> 1); if (__float_as_uint(__uint_as_float(mid) + 1.0f) >= B) hi = mid; else lo = mid; }
    return __uint_as_float(hi); }
__device__ __forceinline__ unsigned wave_or(unsigned v) { int x = (int)v;
    x |= __builtin_amdgcn_update_dpp(0, x, 0x111, 0xf, 0xf, true); x |= __builtin_amdgcn_update_dpp(0, x, 0x112, 0xf, 0xf, true);
    x |= __builtin_amdgcn_update_dpp(0, x, 0x114, 0xf, 0xf, true); x |= __builtin_amdgcn_update_dpp(0, x, 0x118, 0xf, 0xf, true);
    x |= __builtin_amdgcn_update_dpp(0, x, 0x142, 0xf, 0xf, true); x |= __builtin_amdgcn_update_dpp(0, x, 0x143, 0xf, 0xf, true);
    return (unsigned)__builtin_amdgcn_readlane(x, 63); }
__device__ __forceinline__ float sel32(const f32x16& a, const f32x16& b, int e) {
    const bool b0 = e & 1, b1 = e & 2, b2 = e & 4, b3 = e & 8, b4 = e & 16;
    float v0 = a[0], v1 = a[1], v2 = a[2], v3 = a[3], v4 = a[4], v5 = a[5], v6 = a[6], v7 = a[7], v8 = a[8], v9 = a[9], v10 = a[10], v11 = a[11], v12 = a[12], v13 = a[13], v14 = a[14], v15 = a[15], v16 = b[0], v17 = b[1], v18 = b[2], v19 = b[3], v20 = b[4], v21 = b[5], v22 = b[6], v23 = b[7], v24 = b[8], v25 = b[9], v26 = b[10], v27 = b[11], v28 = b[12], v29 = b[13], v30 = b[14], v31 = b[15];
    asm("" : "+v"(v0)); asm("" : "+v"(v1)); asm("" : "+v"(v2)); asm("" : "+v"(v3)); asm("" : "+v"(v4)); asm("" : "+v"(v5)); asm("" : "+v"(v6)); asm("" : "+v"(v7)); asm("" : "+v"(v8)); asm("" : "+v"(v9)); asm("" : "+v"(v10)); asm("" : "+v"(v11)); asm("" : "+v"(v12)); asm("" : "+v"(v13)); asm("" : "+v"(v14)); asm("" : "+v"(v15)); asm("" : "+v"(v16)); asm("" : "+v"(v17)); asm("" : "+v"(v18)); asm("" : "+v"(v19)); asm("" : "+v"(v20)); asm("" : "+v"(v21)); asm("" : "+v"(v22)); asm("" : "+v"(v23)); asm("" : "+v"(v24)); asm("" : "+v"(v25)); asm("" : "+v"(v26)); asm("" : "+v"(v27)); asm("" : "+v"(v28)); asm("" : "+v"(v29)); asm("" : "+v"(v30)); asm("" : "+v"(v31));
    const float p0 = b0 ? v1 : v0, p1 = b0 ? v3 : v2, p2 = b0 ? v5 : v4, p3 = b0 ? v7 : v6, p4 = b0 ? v9 : v8, p5 = b0 ? v11 : v10, p6 = b0 ? v13 : v12, p7 = b0 ? v15 : v14, p8 = b0 ? v17 : v16, p9 = b0 ? v19 : v18, p10 = b0 ? v21 : v20, p11 = b0 ? v23 : v22, p12 = b0 ? v25 : v24, p13 = b0 ? v27 : v26, p14 = b0 ? v29 : v28, p15 = b0 ? v31 : v30;
    const float q0 = b1 ? p1 : p0, q1 = b1 ? p3 : p2, q2 = b1 ? p5 : p4, q3 = b1 ? p7 : p6, q4 = b1 ? p9 : p8, q5 = b1 ? p11 : p10, q6 = b1 ? p13 : p12, q7 = b1 ? p15 : p14;
    const float r0 = b2 ? q1 : q0, r1 = b2 ? q3 : q2, r2 = b2 ? q5 : q4, r3 = b2 ? q7 : q6;
    const float s0 = b3 ? r1 : r0, s1 = b3 ? r3 : r2;
    return b4 ? s1 : s0; }
__device__ __forceinline__ unsigned spread_nib(unsigned x) { x = (x | (x << 8)) & 0x00FF00FFu; return (x | (x << 4)) & 0x0F0F0F0Fu; }


template <int HP, int MODE, bool NEXT>
__device__ __forceinline__ void pstage(f32x16& acc, const f32x16& dc0, const f32x16& dc1, f32x16& dn0, f32x16& dn1, const bf16x8 ka, const bf16x8 kb,
                                       const bf16x8 qa0, const bf16x8 qa1, const bf16x8 qb0, const bf16x8 qb1, const float wA, const float wB,
                                       const unsigned hb, const unsigned inc, const int s0, const int t, const int hi, const float XU, const float XL, unsigned& wn, unsigned& wl) {
    const f32x16 zz = {0.f, 0.f, 0.f, 0.f, 0.f, 0.f, 0.f, 0.f, 0.f, 0.f, 0.f, 0.f, 0.f, 0.f, 0.f, 0.f};
    float INFV; asm("s_mov_b32 %0, 0x7f800000" : "=s"(INFV));
#pragma unroll
    for (int c = 3; c >= 0; --c) {
        if (NEXT) {
            if (c == 3) dn0 = __builtin_amdgcn_mfma_f32_32x32x16_bf16(ka, qa0, zz, 0, 0, 0);
            else if (c == 2) dn1 = __builtin_amdgcn_mfma_f32_32x32x16_bf16(ka, qb0, zz, 0, 0, 0);
            else if (c == 1) dn0 = __builtin_amdgcn_mfma_f32_32x32x16_bf16(kb, qa1, dn0, 0, 0, 0);
            else dn1 = __builtin_amdgcn_mfma_f32_32x32x16_bf16(kb, qb1, dn1, 0, 0, 0);
            __builtin_amdgcn_sched_barrier(0);
        }
#pragma unroll
        for (int r = 4 * c + 3; r >= 4 * c; --r) {
            const float r0 = __builtin_amdgcn_fmed3f(dc0[r], 0.f, INFV), r1 = __builtin_amdgcn_fmed3f(dc1[r], 0.f, INFV);
            float x = __builtin_fmaf(wB, r1, __builtin_fmaf(wA, r0, HP == 0 ? 0.f : acc[r]));
            if (MODE == 4) { if (s0 + crow(r, hi) > t) x = -__builtin_inff(); }
            acc[r] = x;
            if (MODE == 1) hist_add(hb, x, inc);
            if (MODE == 2) { if (s0 + crow(r, hi) <= t) hist_add(hb, x, inc); }
            if (MODE == 3 || MODE == 4) { const float t1 = x - XU, t2 = x - XL; wn = __builtin_amdgcn_alignbit(wn, __float_as_uint(t1), 31); wl = __builtin_amdgcn_alignbit(wl, __float_as_uint(t2), 31); }
        }
        if (NEXT) __builtin_amdgcn_sched_barrier(0);
    }
}
__device__ __forceinline__ void index_unit(const unsigned short* P, const unsigned short* KC, unsigned* MK, unsigned* ZWg, unsigned char* lds, int b, int qt, int tid) {
    const int lane = tid & 63, wave = __builtin_amdgcn_readfirstlane(tid >> 6), r32 = lane & 31, hi = lane >> 5;
    unsigned* hist32 = (unsigned*)(lds + L_HIST); unsigned* cand_s = (unsigned*)(lds + L_HIST); unsigned* cand_i = (unsigned*)(lds + L_HIST + 32768);     unsigned* zc = (unsigned*)(lds + L_ZC); int* par = (int*)(lds + L_PAR);
    const int t = qt * 32 + r32; const size_t qrow = (size_t)b * SEQ + t;
    const int kt_max = (qt * 32 + 31) >> 6, NTW = ((qt >> 3) + 1) * 4;
    const unsigned short* KI = KC + (size_t)b * SEQ * 32;
    QFrag Q; float invw;
    for (int rh_ = 0; rh_ < REP_HEAD; ++rh_) { asm volatile("" ::: "memory");
    { const unsigned short* qp = P + qrow * NP + N_QI + hi * 8; float var = 0.f;
#pragma unroll
        for (int h = 0; h < 4; ++h) { float s = 0.f;
#pragma unroll
            for (int ks = 0; ks < 2; ++ks) { Q.q[h][ks] = *(const bf16x8*)(qp + h * 32 + ks * 16);
#pragma unroll
                for (int j = 0; j < 8; ++j) { const float v = bf2f((unsigned short)Q.q[h][ks][j]); s += v * v; } }
            s += shx(s, 32, lane); Q.w[h] = bf2f(P[qrow * NP + N_WI + h]); var += Q.w[h] * Q.w[h] * s; }
        invw = 82.7f / sqrtf(var > 1e-20f ? var : 1e-20f);
#pragma unroll
        for (int h = 0; h < 4; ++h) Q.w[h] *= invw; }
    __syncthreads();
    { typedef unsigned u32x4z __attribute__((ext_vector_type(4))); for (int i = tid; i < (L_PAR + 2048) / 16; i += NTHR) ((__attribute__((address_space(3))) u32x4z*)lds)[i] = (u32x4z){0u, 0u, 0u, 0u}; }
    __syncthreads(); }
    __attribute__((address_space(3))) unsigned char* kbuf = (__attribute__((address_space(3))) unsigned char*)lds + L_KBUF + wave * 4096;
#define IDX_KISSUE(kt_) do { const unsigned short* kp_ = KI + (size_t)(kt_) * 2048 + lane * 8;        \
        __builtin_amdgcn_global_load_lds((const unsigned*)kp_, (__attribute__((address_space(3))) unsigned*)kbuf, 16, 0, 0); \
        __builtin_amdgcn_global_load_lds((const unsigned*)(kp_ + 512), (__attribute__((address_space(3))) unsigned*)(kbuf + 1024), 16, 0, 0); \
        __builtin_amdgcn_global_load_lds((const unsigned*)(kp_ + 1024), (__attribute__((address_space(3))) unsigned*)(kbuf + 2048), 16, 0, 0); \
        __builtin_amdgcn_global_load_lds((const unsigned*)(kp_ + 1536), (__attribute__((address_space(3))) unsigned*)(kbuf + 3072), 16, 0, 0); } while (0)
#define IDX_KREAD(dst) do { const int ko_ = r32 * 64 + hi * 16;                                     \
        dst[0] = *(__attribute__((address_space(3))) bf16x8*)(kbuf + ko_); dst[1] = *(__attribute__((address_space(3))) bf16x8*)(kbuf + ko_ + 32); \
        dst[2] = *(__attribute__((address_space(3))) bf16x8*)(kbuf + ko_ + 2048); dst[3] = *(__attribute__((address_space(3))) bf16x8*)(kbuf + ko_ + 2080); } while (0)
#define IDX_KTAKE(dst, cnt_) do { asm volatile("s_waitcnt vmcnt(" cnt_ ")" ::: "memory"); IDX_KREAD(dst); asm volatile("s_waitcnt lgkmcnt(0)" ::: "memory"); } while (0)
    const unsigned hb = (unsigned)(size_t)((__attribute__((address_space(3))) unsigned char*)lds) + L_HIST + r32 * 1024 - 4 * G0;
#if IDX_PRIO
    if (wave >= 4) __builtin_amdgcn_s_setprio(1);
#endif
    const int qlo = qt * 32;
#define IDX_PRO(dA, dB) do { const f32x16 zz_ = {0.f, 0.f, 0.f, 0.f, 0.f, 0.f, 0.f, 0.f, 0.f, 0.f, 0.f, 0.f, 0.f, 0.f, 0.f, 0.f}; \
        dA = __builtin_amdgcn_mfma_f32_32x32x16_bf16(kc[0], Q.q[0][0], zz_, 0, 0, 0); dB = __builtin_amdgcn_mfma_f32_32x32x16_bf16(kc[0], Q.q[1][0], zz_, 0, 0, 0); \
        dA = __builtin_amdgcn_mfma_f32_32x32x16_bf16(kc[1], Q.q[0][1], dA, 0, 0, 0); dB = __builtin_amdgcn_mfma_f32_32x32x16_bf16(kc[1], Q.q[1][1], dB, 0, 0, 0); } while (0)
#define IDX_QHI Q.q[2][0], Q.q[2][1], Q.q[3][0], Q.q[3][1]
#define IDX_QLO Q.q[0][0], Q.q[0][1], Q.q[1][0], Q.q[1][1]
    for (int rp1 = 0; rp1 < REP_P1; ++rp1) { bf16x8 kc[4]; const unsigned inc1 = (rp1 & 1) ? 0xffffffffu : 1u; if (wave <= kt_max) IDX_KISSUE(wave);
      for (int kt = wave; kt <= kt_max; kt += 8) {
        IDX_KTAKE(kc, "0"); if (kt + 8 <= kt_max) IDX_KISSUE(kt + 8);
        if (kt * 64 + 63 <= qlo) {
#pragma unroll
            for (int sub = 0; sub < 2; ++sub) { const f32x16 sc = score_sub(kc[2 * sub], kc[2 * sub + 1], Q);
#pragma unroll
                for (int r = 0; r < 16; ++r) hist_add(hb, sc[r], inc1); }
        } else {
#pragma unroll
            for (int sub = 0; sub < 2; ++sub) { const f32x16 sc = score_sub(kc[2 * sub], kc[2 * sub + 1], Q); const int s0 = kt * 64 + sub * 32;
#pragma unroll
                for (int r = 0; r < 16; ++r) { if (s0 + crow(r, hi) <= t) hist_add(hb, sc[r], inc1); } }
        }
      } }
    __syncthreads();
    for (int rr_ = 0; rr_ < REP_RES; ++rr_) { __syncthreads(); asm volatile("" ::: "memory");
    { typedef unsigned u32x4r __attribute__((ext_vector_type(4)));
        const int q = tid >> 4, j = tid & 15, N = qt * 32 + q + 1; const bool neg = j >= 8;
        const unsigned* hs = hist32 + (neg ? 8192 + q * 256 + 32 * (j - 8) : q * 256 + 224 - 32 * j); int c = 0;
#pragma unroll
        for (int u = 0; u < 8; ++u) { const u32x4r v = *(const u32x4r*)(hs + 4 * ((u + (j >> 1)) & 7)); c += (int)(v[0] + v[1] + v[2] + v[3]); }
        int incl = c;
#pragma unroll
        for (int o = 1; o < 16; o <<= 1) { const int v = __builtin_amdgcn_ds_bpermute(((lane - o) & 63) << 2, incl); if (j >= o) incl += v; }
        const int excl = incl - c;
        if (N <= 256) { if (j == 0) par[P_MODE * 32 + q] = 0; }
        else if (excl < 256 && 256 <= incl) { u32x4r w[8];
#pragma unroll
            for (int u = 0; u < 8; ++u) w[u] = *(const u32x4r*)(hs + 4 * u);
            int above = excl, isel = -1, cntb = 0, ab = 0;
#pragma unroll
            for (int i = 0; i < 32; ++i) { const int cb = (int)(neg ? w[i >> 2][i & 3] : w[(31 - i) >> 2][(31 - i) & 3]); if (isel < 0 && above + cb >= 256) { isel = i; cntb = cb; ab = above; } above += cb; }
            const int bsel = rank_to_bin(32 * j + isel), ot = bsel & 255; const float* XT = (const float*)(lds + L_XT);
            par[P_BSTAR * 32 + q] = bsel; par[P_KK * 32 + q] = 256 - ab; par[P_MODE * 32 + q] = (bsel != 0 && cntb > CAP) ? 3 : 1; if (bsel != 0 && cntb > CAP) par[P_ANY3 * 32] = 1;
            const float xa = XT[ot], xb = XT[ot + 1];
            const float XL = neg ? -__uint_as_float(__float_as_uint(xb) - 1u) : xa;
            const float XU = neg ? (xa > 0.f ? -__uint_as_float(__float_as_uint(xa) - 1u) : 0.f) : xb;
            par[P_XL * 32 + q] = (int)__float_as_uint(XL); par[P_XU * 32 + q] = (int)__float_as_uint(XU); }
    } }
    __syncthreads();
    const int my_mode = par[P_MODE * 32 + r32], my_b = par[P_BSTAR * 32 + r32];
    __syncthreads();
    float XL = __uint_as_float((unsigned)par[P_XL * 32 + r32]), XU = __uint_as_float((unsigned)par[P_XU * 32 + r32]);
    if (my_mode == 0) { XL = -3.0e38f; XU = -3.0e38f; }
    if (my_mode == 3) { XL = __builtin_inff(); XU = __builtin_inff(); }
    const bool central = (my_mode == 1 && my_b == 0);
    unsigned* ZW = ZWg;
    for (int r2_ = 0; r2_ < REP_P2; ++r2_) { if (r2_) { __syncthreads(); for (int i = tid; i < 32 * 128; i += NTHR) zc[i] = 0u; if (tid < 32) { par[P_CCNT * 32 + tid] = 0; par[P_OVF * 32 + tid] = 0; } __syncthreads(); }
    { bf16x8 kc[4]; if (wave <= kt_max) IDX_KISSUE(wave);
      for (int kt = wave; kt < NTW; kt += 8) {
        unsigned word = 0u, wz = 0u;
        if (kt <= kt_max) {
            if (kt == wave) { IDX_KTAKE(kc, "0"); } else { IDX_KTAKE(kc, "2"); }
            if (kt + 8 <= kt_max) IDX_KISSUE(kt + 8);
            asm volatile("" ::: "memory");
            f32x16 s0v = score_sub(kc[0], kc[1], Q), s1v = score_sub(kc[2], kc[3], Q);
            const bool diag = kt * 64 + 63 > qlo;
            if (diag) {
#pragma unroll
                for (int r = 0; r < 16; ++r) { const int s = kt * 64 + crow(r, hi); if (s > t) s0v[r] = -__builtin_inff(); if (s + 32 > t) s1v[r] = -__builtin_inff(); } }
            unsigned wn = 0u, wl = 0u;
#pragma unroll
            for (int e = 31; e >= 0; --e) { const float x = (e < 16) ? s0v[e & 15] : s1v[e & 15]; float t1, t2;
#if IDX_ASMBIN
                asm("v_sub_f32 %0, %1, %2" : "=v"(t1) : "v"(x), "v"(XU)); asm("v_sub_f32 %0, %1, %2" : "=v"(t2) : "v"(x), "v"(XL));
#else
                t1 = x - XU; t2 = x - XL;
#endif
                wn = __builtin_amdgcn_alignbit(wn, __float_as_uint(t1), 31); wl = __builtin_amdgcn_alignbit(wl, __float_as_uint(t2), 31); }
            word = ~wn; const unsigned inb = wn & ~wl;
            if ((REP_P2 == 1 || r2_ > 0) && __any(inb != 0u)) {
                unsigned zb = 0u;
                if (__any(central && inb != 0u)) { unsigned UZ = wave_or(central ? inb : 0u);
                    while (UZ) { const int e = __builtin_ctz(UZ); UZ &= UZ - 1u; const float x = (e < 16) ? s0v[e & 15] : s1v[e & 15];
                        if (central && ((inb >> e) & 1u) && x == 0.f) zb |= (1u << e); }
                    if (zb) lds_add(&zc[r32 * 128 + kt], (unsigned)__builtin_popcount(zb)); wz = zb; }
                const unsigned cb = inb & ~zb; const int cnt = __builtin_popcount(cb); int pos = 0;
                if (cnt) { pos = (int)lds_add((unsigned*)&par[P_CCNT * 32 + r32], (unsigned)cnt); if (pos + cnt > CAP) par[P_OVF * 32 + r32] = 1; }
                unsigned m = cb; int slot = pos;
                while (__any(m != 0u)) { const int e = (int)__builtin_ctz(m | 0x80000000u); const float x = sel32(s0v, s1v, e);
                    if (m != 0u && slot < CAP) { cand_s[r32 * CAP + slot] = __float_as_uint(x); cand_i[r32 * CAP + slot] = (unsigned)(kt * 64 + 32 * (e >> 4) + ((e & 3) + 8 * ((e & 15) >> 2) + 4 * hi)); }
                    m &= m - 1u; ++slot; }
            }
        }
        MK[((size_t)(b * 256 + qt) * 128 + kt) * 64 + lane] = word; ZW[kt * 64 + lane] = wz;
      } } }
#if IDX_PRIO
    __builtin_amdgcn_s_setprio(0);
#endif
    asm volatile("s_waitcnt vmcnt(0)" ::: "memory");
    __syncthreads();
    for (int rk_ = 0; rk_ < REP_RANK; ++rk_) { if (rk_) __syncthreads(); asm volatile("" ::: "memory");
    { const int q = tid >> 4, j = tid & 15, mode = par[P_MODE * 32 + q], kk = par[P_KK * 32 + q], bq = par[P_BSTAR * 32 + q];
        const int n = par[P_CCNT * 32 + q] < CAP ? par[P_CCNT * 32 + q] : CAP, n4 = (n + 3) & ~3;
        if (mode == 1 && par[P_OVF * 32 + q]) { if (j == 0) { par[P_MODE * 32 + q] = 3; par[P_ANY3 * 32] = 1; } }
        else if (mode == 1 && kk <= n) {
            if (j < n4 - n) { cand_s[q * CAP + n + j] = 0xFF800000u; cand_i[q * CAP + n + j] = 0xFFFFFFFFu; }
            if (j == 0) { par[P_NRANK * 32 + q] = n; par[P_TSTAR * 32 + q] = -1; } }
        else if (mode == 1 && bq == 0) {
            const int need = kk - n; int zl[8], c = 0;
#pragma unroll
            for (int u = 0; u < 8; ++u) { zl[u] = (int)zc[q * 128 + 8 * j + u]; c += zl[u]; }
            int incl = c;
#pragma unroll
            for (int o = 1; o < 16; o <<= 1) { const int v = __builtin_amdgcn_ds_bpermute(((lane - o) & 63) << 2, incl); if (j >= o) incl += v; }
            int cum = incl - c;
            if (j == 0) { par[P_TAU * 32 + q] = (int)0xFF800000u; par[P_CUT * 32 + q] = -1; }
            if (cum < need && need <= incl) { int ts = 8 * j + 7, rs = 1; bool done = false;
#pragma unroll
                for (int u = 0; u < 8; ++u) { if (!done && cum + zl[u] >= need) { ts = 8 * j + u; rs = need - cum; done = true; } cum += zl[u]; }
                par[P_TSTAR * 32 + q] = ts; par[P_RSTAR * 32 + q] = rs; } }
        else if (mode == 1) { if (j == 0) { par[P_MODE * 32 + q] = 3; par[P_ANY3 * 32] = 1; } }
    }
    __syncthreads();
    if (tid < 64) { const int q = lane & 31; int incl = par[P_NRANK * 32 + q];
#pragma unroll
        for (int o = 1; o < 32; o <<= 1) { const int v = __builtin_amdgcn_ds_bpermute(((lane - o) & 63) << 2, incl); if (q >= o) incl += v; }
        if (lane < 32) par[P_PRE * 32 + q] = incl; }
    __syncthreads();
    { typedef unsigned u32x4v __attribute__((ext_vector_type(4)));
        const int total = par[P_PRE * 32 + 31];
        for (int g = tid; g < total; g += NTHR) {
            int q = 0;
#pragma unroll
            for (int st = 16; st >= 1; st >>= 1) { if (par[P_PRE * 32 + q + st - 1] <= g) q += st; }
            const int i = g - (q ? par[P_PRE * 32 + q - 1] : 0), n = par[P_NRANK * 32 + q], n4 = (n + 3) & ~3, kk = par[P_KK * 32 + q];
            const unsigned cix = cand_s[q * CAP + i], ciy = cand_i[q * CAP + i]; const float si = __uint_as_float(cix); int rank = 0;
#pragma unroll 2
            for (int m2 = 0; m2 < n4; m2 += 4) { const u32x4v sv = *(const u32x4v*)&cand_s[q * CAP + m2], iv = *(const u32x4v*)&cand_i[q * CAP + m2];
#pragma unroll
                for (int u = 0; u < 4; ++u) { const float sm = __uint_as_float(sv[u]); rank += (sm > si || (sm == si && iv[u] < ciy)) ? 1 : 0; } }
            if (rank == kk - 1) { par[P_TAU * 32 + q] = (int)cix; par[P_CUT * 32 + q] = (int)ciy; } } }
    __syncthreads(); }
    for (int rpp = 0; rpp < REP_PATCH; ++rpp)
    { const int q = tid >> 4, j = tid & 15, mode = par[P_MODE * 32 + q];
        if (mode == 1) { const int n = par[P_CCNT * 32 + q]; const float tau = __uint_as_float((unsigned)par[P_TAU * 32 + q]); const unsigned cut = (unsigned)par[P_CUT * 32 + q]; const int ts = par[P_TSTAR * 32 + q], rs = par[P_RSTAR * 32 + q];
            unsigned* mq = MK + (size_t)(b * 256 + qt) * 128 * 64 + q;
#pragma unroll 1
            for (int i = j; i < n; i += 16) { const float sc = __uint_as_float(cand_s[q * CAP + i]); const unsigned s = cand_i[q * CAP + i];
                if (sc > tau || (sc == tau && s <= cut)) { const int kap = s & 63, k5 = kap & 31, hh = (k5 >> 2) & 1, e = (k5 & 3) + 4 * (k5 >> 3) + 16 * (kap >> 5);
                    __hip_atomic_fetch_or(mq + (s >> 6) * 64 + 32 * hh, 1u << e, __ATOMIC_RELAXED, __HIP_MEMORY_SCOPE_AGENT); } }
            if (ts >= 0) {
                unsigned zw0[8], zw1[8];
#pragma unroll
                for (int u = 0; u < 8; ++u) { const int kt = j + 16 * u; zw0[u] = 0u; zw1[u] = 0u; if (kt <= ts) { zw0[u] = __hip_atomic_load(ZW + kt * 64 + q, __ATOMIC_RELAXED, __HIP_MEMORY_SCOPE_AGENT); zw1[u] = __hip_atomic_load(ZW + kt * 64 + 32 + q, __ATOMIC_RELAXED, __HIP_MEMORY_SCOPE_AGENT); } }
#pragma unroll
                for (int u = 0; u < 8; ++u) { const int kt = j + 16 * u; if (kt <= ts) { const unsigned w0 = zw0[u], w1 = zw1[u]; unsigned a0 = w0, a1 = w1;
                    if (kt == ts) { const unsigned lo32 = spread_nib(w0 & 0xffffu) | (spread_nib(w1 & 0xffffu) << 4), hi32 = spread_nib(w0 >> 16) | (spread_nib(w1 >> 16) << 4);
                        const unsigned long long ord = (unsigned long long)lo32 | ((unsigned long long)hi32 << 32);
                        int nn = rs, kap = 0; unsigned w = (unsigned)ord; int c = __builtin_popcount(w);
                        if (nn > c) { nn -= c; w = (unsigned)(ord >> 32); kap = 32; }
                        c = __builtin_popcount(w & 0xffffu); if (nn > c) { nn -= c; w >>= 16; kap += 16; }
                        c = __builtin_popcount(w & 0xffu); if (nn > c) { nn -= c; w >>= 8; kap += 8; }
                        c = __builtin_popcount(w & 0xfu); if (nn > c) { nn -= c; w >>= 4; kap += 4; }
                        c = __builtin_popcount(w & 0x3u); if (nn > c) { nn -= c; w >>= 2; kap += 2; }
                        c = (int)(w & 1u); if (nn > c) kap += 1;
                        unsigned k0 = 0u, k1 = 0u;
#pragma unroll
                        for (int e = 0; e < 32; ++e) { const int pos0 = 32 * (e >> 4) + crow(e & 15, 0), pos1 = 32 * (e >> 4) + crow(e & 15, 1); if (pos0 <= kap) k0 |= (1u << e); if (pos1 <= kap) k1 |= (1u << e); }
                        a0 &= k0; a1 &= k1; }
                    if (a0) __hip_atomic_fetch_or(mq + kt * 64, a0, __ATOMIC_RELAXED, __HIP_MEMORY_SCOPE_AGENT);
                    if (a1) __hip_atomic_fetch_or(mq + kt * 64 + 32, a1, __ATOMIC_RELAXED, __HIP_MEMORY_SCOPE_AGENT); } } }
        }
    }
    __syncthreads();
}
#undef IDX_KISSUE
#undef IDX_KTAKE
#undef IDX_KREAD
}
namespace glab {
typedef short bf16x8 __attribute__((ext_vector_type(8)));
typedef short s16x4 __attribute__((ext_vector_type(4)));
typedef float f32x16 __attribute__((ext_vector_type(16)));
typedef float f32x4 __attribute__((ext_vector_type(4)));
typedef unsigned u32x4 __attribute__((ext_vector_type(4)));
typedef unsigned u32x2 __attribute__((ext_vector_type(2)));
typedef float f32x2_t __attribute__((ext_vector_type(2))); typedef __bf16 bf16x2_t __attribute__((ext_vector_type(2)));
#define GLAS __attribute__((address_space(3)))
constexpr int RAW_Q = 0, RAW_K = 6144, RAW_V = 12288, RAW_Z = 24576, OP_QE = 26624, OP_KE = 33792, OP_KDT = 40960, OP_VT = 47872, OP_DEC = 61696, OP_BLK_BYTES = 35328  ,
              OP_BLK1 = 61952  , OP_ST = 97280, ST_BYTES = 10752;
__device__ __forceinline__ unsigned cvtpk(float lo, float hi) { f32x2_t v = {lo, hi}; bf16x2_t b = __builtin_convertvector(v, bf16x2_t); return __builtin_bit_cast(unsigned, b); }
__device__ __forceinline__ int crow(int r, int hi) { return (r & 3) + 8 * (r >> 2) + 4 * hi; }
__device__ __forceinline__ float bfl(unsigned short b) { return __uint_as_float((unsigned)b << 16); }


__device__ __forceinline__ void gla_prep_item(const unsigned short* P, unsigned char* GOP, const float* w2, const float* gb, unsigned char* ldsg, int item, int tid) {
    GLAS unsigned char* lds = (GLAS unsigned char*)ldsg;
    const int lane = tid & 63; const int b = item >> 9, h = (item >> 7) & 3, n = item & 127;
    const size_t m0 = (size_t)b * SEQ + (size_t)n * 64;
    __syncthreads();
#define GLA_PCOL(c) (((c) < 6) ? (N_GQ + h * 48 + (c) * 8) : ((c) < 12) ? (N_GK + h * 48 + ((c) - 6) * 8) : ((c) < 24) ? (N_GV + h * 96 + ((c) - 12) * 8) : (N_GZ + ((c) - 24) * 8))
#define GLA_PDST(row, c) (((c) < 6) ? (RAW_Q + (row) * 96 + (c) * 16) : ((c) < 12) ? (RAW_K + (row) * 96 + ((c) - 6) * 16) : ((c) < 24) ? (RAW_V + (row) * 192 + ((c) - 12) * 16) : (RAW_Z + (row) * 32 + ((c) - 24) * 16))
#pragma unroll
    for (int k = 0; k < 4; ++k) { const int p = tid + 512 * k; if (p < 1664) { const int row = p / 26, c = p % 26; *(GLAS u32x4*)(lds + GLA_PDST(row, c)) = *(const u32x4*)(P + (m0 + row) * NP + GLA_PCOL(c)); } }
    __syncthreads();
    const int sd = tid >> 3, tg = tid & 7;
    if (tid < 384) {
            float c[8], w2c[16]; const float bc = gb[h * 48 + sd];
#pragma unroll
            for (int r = 0; r < 16; ++r) w2c[r] = w2[(size_t)r * 192 + h * 48 + sd];
#pragma unroll
            for (int tt = 0; tt < 8; ++tt) { const int t = 8 * tg + tt; const u32x4 z0 = *(GLAS u32x4*)(lds + RAW_Z + t * 32), z1 = *(GLAS u32x4*)(lds + RAW_Z + t * 32 + 16); float z = bc;
#pragma unroll
                for (int k = 0; k < 4; ++k) { z += w2c[2 * k] * __uint_as_float(z0[k] << 16) + w2c[2 * k + 1] * __uint_as_float(z0[k] & 0xffff0000u); z += w2c[8 + 2 * k] * __uint_as_float(z1[k] << 16) + w2c[8 + 2 * k + 1] * __uint_as_float(z1[k] & 0xffff0000u); }
                const float ls = fminf(z, 0.f) - __logf(1.0f + __expf(-fabsf(z)));
                c[tt] = ls * (1.0f / 16.0f) + (tt ? c[tt - 1] : 0.f); }
            float incl = c[7];
#pragma unroll
            for (int o = 1; o < 8; o <<= 1) { const float v = __builtin_bit_cast(float, __builtin_amdgcn_ds_bpermute(((lane - o) & 63) << 2, __builtin_bit_cast(int, incl))); if (tg >= o) incl += v; }
            const float off = incl - c[7];
            const float bl = __builtin_bit_cast(float, __builtin_amdgcn_ds_bpermute((lane | 7) << 2, __builtin_bit_cast(int, incl)));
            unsigned kdp[4];
#pragma unroll
            for (int tt = 0; tt < 8; tt += 2) { float kdv[2];
#pragma unroll
                for (int u = 0; u < 2; ++u) { const int t = 8 * tg + tt + u; const float bb = off + c[tt + u];
                    const float q = bfl(*(GLAS unsigned short*)(lds + RAW_Q + (t * 48 + sd) * 2)), kx = bfl(*(GLAS unsigned short*)(lds + RAW_K + (t * 48 + sd) * 2));
                    const float e1 = __expf(bb), e2 = __expf(-bb), e3 = __expf(bl - bb);
                    *(GLAS unsigned short*)(lds + OP_QE + (t * 56 + sd) * 2) = (unsigned short)(cvtpk(q * e1, 0.f) & 0xffffu);
                    *(GLAS unsigned short*)(lds + OP_KE + (t * 56 + sd) * 2) = (unsigned short)(cvtpk(kx * e2, 0.f) & 0xffffu);
                    kdv[u] = kx * e3; }
                kdp[tt >> 1] = cvtpk(kdv[0], kdv[1]); }
            *(GLAS u32x4*)(lds + OP_KDT + (sd * 72 + 8 * tg) * 2) = (u32x4){kdp[0], kdp[1], kdp[2], kdp[3]};
            if (tg == 7) ((GLAS float*)(lds + OP_DEC))[sd] = __expf(bl);
    } else {
            for (int idx = tid - 384; idx < 96 * 8; idx += 128) { const int v = idx % 96, t8 = idx / 96; unsigned pk[4];
#pragma unroll
                for (int tt = 0; tt < 8; tt += 2) { const unsigned a0 = *(GLAS unsigned short*)(lds + RAW_V + ((8 * t8 + tt) * 96 + v) * 2), a1 = *(GLAS unsigned short*)(lds + RAW_V + ((8 * t8 + tt + 1) * 96 + v) * 2); pk[tt >> 1] = a0 | (a1 << 16); }
                *(GLAS u32x4*)(lds + OP_VT + (v * 72 + 8 * t8) * 2) = (u32x4){pk[0], pk[1], pk[2], pk[3]}; }
    }
    __syncthreads();
    unsigned char* dst = GOP + (size_t)item * OP_BLK_BYTES;
    for (int i = tid; i < (OP_DEC + 192 - OP_QE) / 16; i += NTHR) *(u32x4*)(dst + i * 16) = *(GLAS u32x4*)(lds + OP_QE + i * 16);
}
__device__ __forceinline__ void gla_prep_loop(const unsigned short* P, unsigned char* GOP, const float* w2, const float* gb, unsigned char* ldsg, int wg, int G, int tid) {
    GLAS unsigned char* lds = (GLAS unsigned char*)ldsg;
    const int lane = tid & 63;
#define GLA_PCOLH(c, hh) (((c) < 6) ? (N_GQ + (hh) * 48 + (c) * 8) : ((c) < 12) ? (N_GK + (hh) * 48 + ((c) - 6) * 8) : ((c) < 24) ? (N_GV + (hh) * 96 + ((c) - 12) * 8) : (N_GZ + ((c) - 24) * 8))
#define GLA_PDST(row, c) (((c) < 6) ? (RAW_Q + (row) * 96 + (c) * 16) : ((c) < 12) ? (RAW_K + (row) * 96 + ((c) - 6) * 16) : ((c) < 24) ? (RAW_V + (row) * 192 + ((c) - 12) * 16) : (RAW_Z + (row) * 32 + ((c) - 24) * 16))
#define GLA_FETCH(it_) do { const int b_ = (it_) >> 9, h_ = ((it_) >> 7) & 3, n_ = (it_) & 127; const size_t mr_ = (size_t)b_ * SEQ + (size_t)n_ * 64; \
        _Pragma("unroll") for (int k = 0; k < 4; ++k) { const int p = tid + 512 * k; if (p < 1664) { const int row = p / 26, c = p % 26; rawr[k] = *(const u32x4*)(P + (mr_ + row) * NP + GLA_PCOLH(c, h_)); } } } while (0)
    u32x4 rawr[4];
    if (wg < BATCH * 4 * 128) GLA_FETCH(wg);
    for (int item = wg; item < BATCH * 4 * 128; item += G) {
    const int h = (item >> 7) & 3;
    __syncthreads();
#pragma unroll
    for (int k = 0; k < 4; ++k) { const int p = tid + 512 * k; if (p < 1664) { const int row = p / 26, c = p % 26; *(GLAS u32x4*)(lds + GLA_PDST(row, c)) = rawr[k]; } }
    if (item + G < BATCH * 4 * 128) GLA_FETCH(item + G);
    __syncthreads();
    const int sd = tid >> 3, tg = tid & 7;
    if (tid < 384) {
            float c[8], w2c[16]; const float bc = gb[h * 48 + sd];
#pragma unroll
            for (int r = 0; r < 16; ++r) w2c[r] = w2[(size_t)r * 192 + h * 48 + sd];
#pragma unroll
            for (int tt = 0; tt < 8; ++tt) { const int t = 8 * tg + tt; const u32x4 z0 = *(GLAS u32x4*)(lds + RAW_Z + t * 32), z1 = *(GLAS u32x4*)(lds + RAW_Z + t * 32 + 16); float z = bc;
#pragma unroll
                for (int k = 0; k < 4; ++k) { z += w2c[2 * k] * __uint_as_float(z0[k] << 16) + w2c[2 * k + 1] * __uint_as_float(z0[k] & 0xffff0000u); z += w2c[8 + 2 * k] * __uint_as_float(z1[k] << 16) + w2c[8 + 2 * k + 1] * __uint_as_float(z1[k] & 0xffff0000u); }
                const float ls = fminf(z, 0.f) - __logf(1.0f + __expf(-fabsf(z)));
                c[tt] = ls * (1.0f / 16.0f) + (tt ? c[tt - 1] : 0.f); }
            float incl = c[7];
#pragma unroll
            for (int o = 1; o < 8; o <<= 1) { const float v = __builtin_bit_cast(float, __builtin_amdgcn_ds_bpermute(((lane - o) & 63) << 2, __builtin_bit_cast(int, incl))); if (tg >= o) incl += v; }
            const float off = incl - c[7];
            const float bl = __builtin_bit_cast(float, __builtin_amdgcn_ds_bpermute((lane | 7) << 2, __builtin_bit_cast(int, incl)));
            unsigned kdp[4];
#pragma unroll
            for (int tt = 0; tt < 8; tt += 2) { float kdv[2];
#pragma unroll
                for (int u = 0; u < 2; ++u) { const int t = 8 * tg + tt + u; const float bb = off + c[tt + u];
                    const float q = bfl(*(GLAS unsigned short*)(lds + RAW_Q + (t * 48 + sd) * 2)), kx = bfl(*(GLAS unsigned short*)(lds + RAW_K + (t * 48 + sd) * 2));
                    const float e1 = __expf(bb), e2 = __expf(-bb), e3 = __expf(bl - bb);
                    *(GLAS unsigned short*)(lds + OP_QE + (t * 56 + sd) * 2) = (unsigned short)(cvtpk(q * e1, 0.f) & 0xffffu);
                    *(GLAS unsigned short*)(lds + OP_KE + (t * 56 + sd) * 2) = (unsigned short)(cvtpk(kx * e2, 0.f) & 0xffffu);
                    kdv[u] = kx * e3; }
                kdp[tt >> 1] = cvtpk(kdv[0], kdv[1]); }
            *(GLAS u32x4*)(lds + OP_KDT + (sd * 72 + 8 * tg) * 2) = (u32x4){kdp[0], kdp[1], kdp[2], kdp[3]};
            if (tg == 7) ((GLAS float*)(lds + OP_DEC))[sd] = __expf(bl);
    } else {
            for (int idx = tid - 384; idx < 96 * 8; idx += 128) { const int v = idx % 96, t8 = idx / 96; unsigned pk[4];
#pragma unroll
                for (int tt = 0; tt < 8; tt += 2) { const unsigned a0 = *(GLAS unsigned short*)(lds + RAW_V + ((8 * t8 + tt) * 96 + v) * 2), a1 = *(GLAS unsigned short*)(lds + RAW_V + ((8 * t8 + tt + 1) * 96 + v) * 2); pk[tt >> 1] = a0 | (a1 << 16); }
                *(GLAS u32x4*)(lds + OP_VT + (v * 72 + 8 * t8) * 2) = (u32x4){pk[0], pk[1], pk[2], pk[3]}; }
    }
    __syncthreads();
    unsigned char* dst = GOP + (size_t)item * OP_BLK_BYTES;
    for (int i = tid; i < (OP_DEC + 192 - OP_QE) / 16; i += NTHR) *(u32x4*)(dst + i * 16) = *(GLAS u32x4*)(lds + OP_QE + i * 16);
    }
#undef GLA_FETCH
#undef GLA_PCOLH
}
__device__ __forceinline__ void gla_seq_unit(const unsigned short* P, unsigned short* Y, const unsigned char* GOP, const float* ng, unsigned char* ldsg, int b, int h, int tid) {
    GLAS unsigned char* lds = (GLAS unsigned char*)ldsg;
    const int lane = tid & 63, wave = __builtin_amdgcn_readfirstlane(tid >> 6), r32 = lane & 31, hi = lane >> 5, l15 = lane & 15, quad = lane >> 4;
    const size_t rowbase = (size_t)b * SEQ; const unsigned char* gsrc = GOP + (size_t)((b * 4 + h) * 128) * OP_BLK_BYTES;
    constexpr int NPC = (OP_DEC + 192 - OP_QE) / 16;
    constexpr int SQ_BLK0 = 0, SQ_BLK1 = OP_BLK_BYTES, SQ_ST = 2 * OP_BLK_BYTES  , SQ_OB = SQ_ST + 2 * ST_BYTES  , SQ_OB_BYTES = 64 * 96 * 2, SQ_NG = SQ_OB + 2 * SQ_OB_BYTES  ;
    __syncthreads();
    for (int i = tid; i < 2 * ST_BYTES / 4; i += NTHR) ((GLAS unsigned*)(lds + SQ_ST))[i] = 0u;
    if (tid < 96) ((GLAS float*)(lds + SQ_NG))[tid] = ng[tid];
    u32x4 rg[5];
#pragma unroll
    for (int k = 0; k < 5; ++k) { const int i = tid + 512 * k; if (i < NPC) rg[k] = *(const u32x4*)(gsrc + (size_t)i * 16); }
#pragma unroll
    for (int k = 0; k < 5; ++k) { const int i = tid + 512 * k; if (i < NPC) *(GLAS u32x4*)(lds + SQ_BLK0 + i * 16) = rg[k]; }
#pragma unroll
    for (int k = 0; k < 5; ++k) { const int i = tid + 512 * k; if (i < NPC) rg[k] = *(const u32x4*)(gsrc + OP_BLK_BYTES + (size_t)i * 16); }
    __syncthreads();
    f32x4 S[2][3];
#pragma unroll
    for (int mt = 0; mt < 2; ++mt)
#pragma unroll
        for (int nt = 0; nt < 3; ++nt) S[mt][nt] = (f32x4){0.f, 0.f, 0.f, 0.f};
#define GLA_EPILOGUE(nn) do { const int cc_ = (nn) & 1; const size_t mm_ = rowbase + (size_t)(nn) * 64; \
        _Pragma("unroll") for (int k_ = 0; k_ < 4; ++k_) { const int vec_ = (tid - 320) + 192 * k_, t_ = vec_ / 12, v_ = (vec_ % 12) * 8; \
            const u32x4 ov_ = *(GLAS u32x4*)(lds + SQ_OB + cc_ * SQ_OB_BYTES + t_ * 192 + v_ * 2); const u32x4 gv_ = *(const u32x4*)(P + (mm_ + t_) * NP + N_GG + h * 96 + v_); \
            const f32x4 n0_ = *(GLAS f32x4*)(lds + SQ_NG + v_ * 4), n1_ = *(GLAS f32x4*)(lds + SQ_NG + v_ * 4 + 16); u32x4 yo_; \
            _Pragma("unroll") for (int e_ = 0; e_ < 4; ++e_) { const float ga_ = __uint_as_float(gv_[e_] << 16), gb_ = __uint_as_float(gv_[e_] & 0xffff0000u); \
                const float na_ = (e_ < 2) ? n0_[2 * e_] : n1_[2 * e_ - 4], nb_ = (e_ < 2) ? n0_[2 * e_ + 1] : n1_[2 * e_ - 3]; \
                yo_[e_] = cvtpk(__uint_as_float(ov_[e_] << 16) * na_ * (ga_ / (1.0f + __expf(-ga_))), __uint_as_float(ov_[e_] & 0xffff0000u) * nb_ * (gb_ / (1.0f + __expf(-gb_)))); } \
            *(u32x4*)(Y + (mm_ + t_) * DM + h * 96 + v_) = yo_; } } while (0)
    for (int n = 0; n < SEQ / 64; ++n) {
        const int cur = n & 1, nxt = cur ^ 1; const size_t m0 = rowbase + (size_t)n * 64;
        const int BO = (cur ? SQ_BLK1 : SQ_BLK0) - OP_QE;
        if (n + 1 < SEQ / 64) { const int BN = (cur ? SQ_BLK0 : SQ_BLK1) - OP_QE;
#pragma unroll
            for (int k = 0; k < 5; ++k) { const int i = tid + 512 * k; if (i < NPC) *(GLAS u32x4*)(lds + OP_QE + BN + i * 16) = rg[k]; }
            if (n + 2 < SEQ / 64) {
#pragma unroll
                for (int k = 0; k < 5; ++k) { const int i = tid + 512 * k; if (i < NPC) rg[k] = *(const u32x4*)(gsrc + (size_t)(n + 2) * OP_BLK_BYTES + (size_t)i * 16); } } }
        if (wave < 2) {
            const int it = wave; bf16x8 qf[3];
#pragma unroll
            for (int ks = 0; ks < 3; ++ks) qf[ks] = *(GLAS bf16x8*)(lds + BO + OP_QE + (32 * it + r32) * 112 + (16 * ks + 8 * hi) * 2);
            f32x16 acc[3];
#pragma unroll
            for (int vt = 0; vt < 3; ++vt)
#pragma unroll
                for (int r = 0; r < 16; ++r) acc[vt][r] = 0.f;
#pragma unroll
            for (int jt = 0; jt < 2; ++jt) if (jt <= it) {
                f32x16 X;
#pragma unroll
                for (int r = 0; r < 16; ++r) X[r] = 0.f;
#pragma unroll
                for (int ks = 0; ks < 3; ++ks) { const bf16x8 kf = *(GLAS bf16x8*)(lds + BO + OP_KE + (32 * jt + r32) * 112 + (16 * ks + 8 * hi) * 2); X = __builtin_amdgcn_mfma_f32_32x32x16_bf16(kf, qf[ks], X, 0, 0, 0); }
                if (jt == it) {
#pragma unroll
                    for (int r = 0; r < 16; ++r) if (crow(r, hi) > r32) X[r] = 0.f; }
                u32x4 p0, p1;
#pragma unroll
                for (int k = 0; k < 4; ++k) { p0[k] = cvtpk(X[2 * k], X[2 * k + 1]); p1[k] = cvtpk(X[8 + 2 * k], X[8 + 2 * k + 1]); }
                const bf16x8 pa0 = __builtin_bit_cast(bf16x8, p0), pa1 = __builtin_bit_cast(bf16x8, p1);
#pragma unroll
                for (int vt = 0; vt < 3; ++vt)
#pragma unroll
                    for (int s = 0; s < 2; ++s) { const int vo = BO + OP_VT + (32 * vt + r32) * 144 + (32 * jt + 16 * s + 4 * hi) * 2;
                        const s16x4 lo = *(GLAS s16x4*)(lds + vo), hi4 = *(GLAS s16x4*)(lds + vo + 16);
                        const bf16x8 a2 = (bf16x8){lo[0], lo[1], lo[2], lo[3], hi4[0], hi4[1], hi4[2], hi4[3]};
                        acc[vt] = __builtin_amdgcn_mfma_f32_32x32x16_bf16(a2, s ? pa1 : pa0, acc[vt], 0, 0, 0); }
            }
#pragma unroll
            for (int vt = 0; vt < 3; ++vt)
#pragma unroll
                for (int ks = 0; ks < 3; ++ks) { const bf16x8 sf = *(GLAS bf16x8*)(lds + SQ_ST + cur * ST_BYTES + (32 * vt + r32) * 112 + (16 * ks + 8 * hi) * 2); acc[vt] = __builtin_amdgcn_mfma_f32_32x32x16_bf16(sf, qf[ks], acc[vt], 0, 0, 0); }
            float ss = 0.f;
#pragma unroll
            for (int vt = 0; vt < 3; ++vt)
#pragma unroll
                for (int r = 0; r < 16; ++r) ss += acc[vt][r] * acc[vt][r];
            ss += __builtin_bit_cast(float, __builtin_amdgcn_ds_bpermute((lane ^ 32) << 2, __builtin_bit_cast(int, ss)));
            const float rn = 1.0f / sqrtf(ss * (1.0f / 96.0f) + EPS);
            GLAS unsigned char* ob = lds + SQ_OB + cur * SQ_OB_BYTES + (32 * it + r32) * 192;
#pragma unroll
            for (int vt = 0; vt < 3; ++vt)
#pragma unroll
                for (int g = 0; g < 4; ++g) { const int v0 = 32 * vt + 8 * g + 4 * hi;
                    *(GLAS u32x2*)(ob + v0 * 2) = (u32x2){cvtpk(acc[vt][4 * g] * rn, acc[vt][4 * g + 1] * rn), cvtpk(acc[vt][4 * g + 2] * rn, acc[vt][4 * g + 3] * rn)}; }
        } else if (wave < 5) {
            const int sw = wave - 2;
#pragma unroll
            for (int mt = 0; mt < 2; ++mt)
#pragma unroll
                for (int nt = 0; nt < 3; ++nt) { const int d = 16 * nt + l15; const float dec = ((GLAS float*)(lds + BO + OP_DEC))[d]; f32x4 a = S[mt][nt] * dec;
#pragma unroll
                    for (int ks = 0; ks < 2; ++ks) { const bf16x8 va = *(GLAS bf16x8*)(lds + BO + OP_VT + (32 * sw + 16 * mt + l15) * 144 + (32 * ks + 8 * quad) * 2), kb = *(GLAS bf16x8*)(lds + BO + OP_KDT + d * 144 + (32 * ks + 8 * quad) * 2);
                        a = __builtin_amdgcn_mfma_f32_16x16x32_bf16(va, kb, a, 0, 0, 0); }
                    S[mt][nt] = a;
#pragma unroll
                    for (int jj = 0; jj < 4; jj += 2) { const unsigned pk = cvtpk(a[jj], a[jj + 1]);
                        *(GLAS unsigned short*)(lds + SQ_ST + nxt * ST_BYTES + ((32 * sw + 16 * mt + 4 * quad + jj) * 56 + d) * 2) = (unsigned short)(pk & 0xffffu);
                        *(GLAS unsigned short*)(lds + SQ_ST + nxt * ST_BYTES + ((32 * sw + 16 * mt + 4 * quad + jj + 1) * 56 + d) * 2) = (unsigned short)(pk >> 16); } }
        } else if (n > 0) {
            GLA_EPILOGUE(n - 1);
        }
        __syncthreads();
    }
    if (wave >= 5) { GLA_EPILOGUE(SEQ / 64 - 1); }
    __syncthreads();
}
#undef GLA_EPILOGUE
#undef GLA_PCOL
#undef GLA_PDST
#undef GLAS
}
namespace poolb {
typedef short bf16x8 __attribute__((ext_vector_type(8)));
typedef float f32x16 __attribute__((ext_vector_type(16)));
typedef unsigned u32x4 __attribute__((ext_vector_type(4)));
typedef unsigned u32x2 __attribute__((ext_vector_type(2)));
typedef float f32x2_t __attribute__((ext_vector_type(2))); typedef __bf16 bf16x2_t __attribute__((ext_vector_type(2)));
#define PLAS __attribute__((address_space(3)))
constexpr int US_PITCH = 528  , US = 0, US_BYTES = 79 * US_PITCH  , PS = 41728, PS_PITCH = 144  , PS_WAVE = 32 * PS_PITCH  ,
              WT = PS + 8 * PS_WAVE  , WT_PITCH = 144, WT_GROUP = 64 * WT_PITCH  ;
__device__ __forceinline__ unsigned cvtpk(float lo, float hi) { f32x2_t v = {lo, hi}; bf16x2_t b = __builtin_convertvector(v, bf16x2_t); return __builtin_bit_cast(unsigned, b); }
__device__ __forceinline__ void pool_phase(const unsigned short* P, unsigned short* Y, const float* pw, const float* pscale, unsigned char* ldsg, int wg, int G, int tid) {
    PLAS unsigned char* lds = (PLAS unsigned char*)ldsg;
    const int lane = tid & 63, wave = __builtin_amdgcn_readfirstlane(tid >> 6), r32 = lane & 31, hi = lane >> 5, g = wave & 3, th = wave >> 2;
    __syncthreads();
    for (int i = tid; i < 4 * 64 * 64; i += NTHR) { const int gg = i >> 12, c = (i >> 6) & 63, d = i & 63; const float v = pw[i] * pscale[gg * 64 + d];
        *(PLAS unsigned short*)(lds + WT + gg * WT_GROUP + d * WT_PITCH + c * 2) = (unsigned short)(cvtpk(v, 0.f) & 0xffffu); }
    const int w = 2 << g;
    for (int tile = wg; tile < M / 64; tile += G) {
        const int m0 = tile * 64, t0 = m0 % SEQ;
        __syncthreads();
        for (int i = tid; i < 79 * 32; i += NTHR) { const int row = i >> 5, pc = i & 31; u32x4 v = {0u, 0u, 0u, 0u};
            if (t0 + row - 15 >= 0) v = *(const u32x4*)(P + (size_t)(m0 - 15 + row) * NP + N_PU + pc * 8);
            *(PLAS u32x4*)(lds + US + row * US_PITCH + pc * 16) = v; }
        __syncthreads();
        { float sum[32];
#pragma unroll
            for (int c = 0; c < 32; ++c) sum[c] = 0.f;
            const int tl = 32 * th + r32; const PLAS unsigned char* base = lds + US + (tl + 15) * US_PITCH + (g * 64 + 32 * hi) * 2;
            for (int j = 0; j < w; ++j) {
#pragma unroll
                for (int q4 = 0; q4 < 4; ++q4) { const u32x4 v = *(const PLAS u32x4*)(base - j * US_PITCH + q4 * 16);
#pragma unroll
                    for (int k = 0; k < 4; ++k) { const float lo = __uint_as_float(v[k] << 16), hh = __uint_as_float(v[k] & 0xffff0000u); sum[8 * q4 + 2 * k] += lo; sum[8 * q4 + 2 * k + 1] += hh; } } }
            const int pos = t0 + tl; const float inv = 1.0f / (float)((pos + 1 < w) ? pos + 1 : w);
            PLAS unsigned char* pd = lds + PS + wave * PS_WAVE + r32 * PS_PITCH + 32 * hi * 2;
#pragma unroll
            for (int q4 = 0; q4 < 4; ++q4) { u32x4 o; const u32x4 sv = *(const PLAS u32x4*)(base + q4 * 16);
#pragma unroll
                for (int k = 0; k < 4; ++k) o[k] = cvtpk(sum[8 * q4 + 2 * k] * inv - __uint_as_float(sv[k] << 16), sum[8 * q4 + 2 * k + 1] * inv - __uint_as_float(sv[k] & 0xffff0000u));
                *(PLAS u32x4*)(pd + q4 * 16) = o; } }
        asm volatile("s_waitcnt lgkmcnt(0)" ::: "memory");
        f32x16 acc[2];
#pragma unroll
        for (int dt = 0; dt < 2; ++dt) {
#pragma unroll
            for (int r = 0; r < 16; ++r) acc[dt][r] = 0.f;
#pragma unroll
            for (int ks = 0; ks < 4; ++ks) { const bf16x8 a = *(const PLAS bf16x8*)(lds + WT + g * WT_GROUP + (32 * dt + r32) * WT_PITCH + (16 * ks + 8 * hi) * 2), bq = *(const PLAS bf16x8*)(lds + PS + wave * PS_WAVE + r32 * PS_PITCH + (16 * ks + 8 * hi) * 2);
                acc[dt] = __builtin_amdgcn_mfma_f32_32x32x16_bf16(a, bq, acc[dt], 0, 0, 0); } }
        { const size_t m = (size_t)m0 + 32 * th + r32; const unsigned short* gp = P + m * NP + N_PG + g * 64; unsigned short* yp = Y + m * DM + 768 + g * 64;
#pragma unroll
            for (int dt = 0; dt < 2; ++dt)
#pragma unroll
                for (int g4 = 0; g4 < 4; ++g4) { const int d0 = 32 * dt + 8 * g4 + 4 * hi; const u32x2 gw = *(const u32x2*)(gp + d0);
                    const float g0 = __uint_as_float(gw[0] << 16), g1 = __uint_as_float(gw[0] & 0xffff0000u), g2 = __uint_as_float(gw[1] << 16), g3 = __uint_as_float(gw[1] & 0xffff0000u);
                    const float y0 = acc[dt][4 * g4] * (g0 / (1.0f + __expf(-g0))), y1 = acc[dt][4 * g4 + 1] * (g1 / (1.0f + __expf(-g1))), y2 = acc[dt][4 * g4 + 2] * (g2 / (1.0f + __expf(-g2))), y3 = acc[dt][4 * g4 + 3] * (g3 / (1.0f + __expf(-g3)));
                    *(u32x2*)(yp + d0) = (u32x2){cvtpk(y0, y1), cvtpk(y2, y3)}; } }
    }
    __syncthreads();
}
#undef PLAS
}
struct Args {
    const float* x; const float* norm_g; const float* w_in; const float* gate_w2; const float* gate_b; const float* gla_norm_g;
    const float* rel_bias; const float* pool_w; const float* pool_scale; const float* w_out; const float* final_g;
    float* out; unsigned char* ws;
    int l_lo, l_hi, ph_lo, ph_hi, single, pad;
};

__device__ __forceinline__ int src_col(int n, float& sc) {
    sc = 1.f;
    if (n < 192) { sc = 0.14433756729740643f; return n; }
    if (n < 768) return n;
    if (n < 1152) return 784 + (n - 768);
    if (n < 1536) { sc = 0.125f * LOG2E; return 1168 + (n - 1152); }
    if (n < 1920) return 1552 + (n - 1536);
    if (n < 2304) return 1936 + (n - 1920);
    if (n < 2688) return 2320 + (n - 2304);
    if (n < 2944) return 2868 + (n - 2688);
    if (n < 3200) return 3124 + (n - 2944);
    if (n < 3328) { sc = 0.17677669529663687f; return 2704 + (n - 3200); }
    if (n < 3360) return 2832 + (n - 3328);
    if (n < 3376) return 768 + (n - 3360);
    if (n < 3380) { sc = 0.5f; return 2864 + (n - 3376); }
    return -1;
}
__device__ __forceinline__ void prologue_phase(const Args& a, int wg, int G, int tid) {
    bf16* WIN = (bf16*)(a.ws + WS_WIN); bf16* WOUT = (bf16*)(a.ws + WS_WOUT);
    const long gt = (long)wg * NTHR + tid, gs = (long)G * NTHR;
    for (long i = gt; i < 4L * NP * 128; i += gs) {
        const int n = (int)(i % NP), k8 = (int)((i / NP) % 128), l = (int)(i / ((long)NP * 128));
        float sc; const int c = src_col(n, sc);
        v4u o = {0u, 0u, 0u, 0u};
        if (c >= 0) { const float* w = a.w_in + ((size_t)l * 1024 + k8 * 8) * IN_COLS + c; float v[8];
#pragma unroll
            for (int j = 0; j < 8; ++j) v[j] = w[(size_t)j * IN_COLS] * sc * a.norm_g[l * 1024 + k8 * 8 + j];
            o.x = pk2(v[0], v[1]); o.y = pk2(v[2], v[3]); o.z = pk2(v[4], v[5]); o.w = pk2(v[6], v[7]); }
        *(v4u*)(WIN + ((size_t)l * NP + n) * 1024 + k8 * 8) = o;
    }
    for (long i = gt; i < 4L * 1024 * 128; i += gs) {
        const int n = (int)(i % 1024), k8 = (int)((i / 1024) % 128), l = (int)(i / (1024L * 128));
        const float* w = a.w_out + ((size_t)l * 1024 + k8 * 8) * 1024 + n; float v[8];
#pragma unroll
        for (int j = 0; j < 8; ++j) v[j] = w[(size_t)j * 1024];
        v4u o; o.x = pk2(v[0], v[1]); o.y = pk2(v[2], v[3]); o.z = pk2(v[4], v[5]); o.w = pk2(v[6], v[7]);
        *(v4u*)(WOUT + ((size_t)l * 1024 + n) * 1024 + k8 * 8) = o;
    }
    { bf16* XA = (bf16*)(a.ws + WS_XA); float* RS = (float*)(a.ws + WS_RS); const int lane = tid & 63;
        for (int m = wg * NWAVES + (tid >> 6); m < M; m += G * NWAVES) { const f32x4* xr = (const f32x4*)(a.x + (size_t)m * DM) + lane; v2u* o = (v2u*)(XA + (size_t)m * DM) + lane; float s = 0.f;
#pragma unroll
            for (int j = 0; j < 4; ++j) { const f32x4 v = xr[64 * j]; v2u w; w.x = pk2(v.x, v.y); w.y = pk2(v.z, v.w); o[64 * j] = w; s += (bflo(w.x) * bflo(w.x) + bfhi(w.x) * bfhi(w.x)) + (bflo(w.y) * bflo(w.y) + bfhi(w.y) * bfhi(w.y)); }
            s = wave_sum(s, lane); if (lane < 16) RS[(size_t)m * 16 + lane] = (lane == 0) ? s : 0.f; } }
}
__device__ __forceinline__ void norm_phase(const float* src, const float* g, bf16* dst, int gw, int NGW, int lane) {
    for (int m = gw; m < M; m += NGW) {
        const f32x4* xr = (const f32x4*)(src + (size_t)m * DM) + lane; f32x4 v[4]; float s = 0.f;
#pragma unroll
        for (int j = 0; j < 4; ++j) { v[j] = xr[64 * j]; s += (v[j].x * v[j].x + v[j].y * v[j].y) + (v[j].z * v[j].z + v[j].w * v[j].w); }
        const float r = 1.0f / sqrtf(wave_sum(s, lane) * (1.f / DM) + EPS);
        const f32x4* gr = (const f32x4*)g + lane; v2u* o = (v2u*)(dst + (size_t)m * DM) + lane;
#pragma unroll
        for (int j = 0; j < 4; ++j) { const f32x4 gv = gr[64 * j]; v2u w; w.x = pk2(v[j].x * r * gv.x, v[j].y * r * gv.y); w.y = pk2(v[j].z * r * gv.z, v[j].w * r * gv.w); o[64 * j] = w; }
    }
}
__device__ __forceinline__ void final_norm_phase(const bf16* xa, float* out, const float* g, const float* RS, int gw, int NGW, int lane) {
    for (int m = gw; m < M; m += NGW) {
        const v2u* xr = (const v2u*)(xa + (size_t)m * DM) + lane; f32x4* orow = (f32x4*)(out + (size_t)m * DM) + lane;
        const f32x4* rs = (const f32x4*)(RS + (size_t)m * 16); const f32x4 s0 = rs[0], s1 = rs[1], s2 = rs[2], s3 = rs[3];
        const float ss = (((s0[0] + s0[1]) + (s0[2] + s0[3])) + ((s1[0] + s1[1]) + (s1[2] + s1[3]))) + (((s2[0] + s2[1]) + (s2[2] + s2[3])) + ((s3[0] + s3[1]) + (s3[2] + s3[3])));
        const float r = 1.0f / sqrtf(ss * (1.f / DM) + EPS);
        const f32x4* gr = (const f32x4*)g + lane;
#pragma unroll
        for (int j = 0; j < 4; ++j) { const f32x4 gv = gr[64 * j]; const v2u w = xr[64 * j]; orow[64 * j] = (f32x4){bflo(w.x) * r * gv.x, bfhi(w.x) * r * gv.y, bflo(w.y) * r * gv.z, bfhi(w.y) * r * gv.w}; }
    }
}
__device__ __forceinline__ void rowscale_phase(const float* RS, float* RSC, int wg, int G, int tid) {
    for (int m = wg * NTHR + tid; m < M; m += G * NTHR) { const f32x4* rs = (const f32x4*)(RS + (size_t)m * 16); const f32x4 s0 = rs[0], s1 = rs[1], s2 = rs[2], s3 = rs[3];
        const float ss = (((s0[0] + s0[1]) + (s0[2] + s0[3])) + ((s1[0] + s1[1]) + (s1[2] + s1[3]))) + (((s2[0] + s2[1]) + (s2[2] + s2[3])) + ((s3[0] + s3[1]) + (s3[2] + s3[3])));
        RSC[m] = 1.0f / sqrtf(ss * (1.0f / 1024.0f) + EPS); }
}
__device__ __forceinline__ void pool_phase(const Args& a, int l, unsigned char* lds, int wg, int G, int tid) {
    float* wsm = (float*)lds; float* us = (float*)(lds + 16384); float* ps = (float*)(lds + 32768);
    const bf16* P = (const bf16*)(a.ws + WS_P); bf16* Y = (bf16*)(a.ws + WS_XB);
    for (int g = 0; g < 4; ++g) {
        __syncthreads();
        const float* pw = a.pool_w + (size_t)(l * 4 + g) * 4096;
        for (int i = tid; i < 4096; i += NTHR) wsm[i] = pw[i];
        const int w = 2 << g;
        for (int tile = wg; tile < M / 32; tile += G) {
            __syncthreads();
            const int m0 = tile * 32, t0 = m0 % SEQ;
            for (int i = tid; i < 47 * 64; i += NTHR) { const int r = i >> 6, c = i & 63; float v = 0.f;
                if (t0 + r - 15 >= 0) v = bf2f(P[(size_t)(m0 - 15 + r) * NP + N_PU + g * 64 + c]);
                us[i] = v; }
            __syncthreads();
            { const int t = tid >> 4, c4 = (tid & 15) * 4, pos = t0 + t; const int cnt = (pos + 1 < w) ? pos + 1 : w; const float inv = 1.0f / (float)cnt;
#pragma unroll
                for (int k = 0; k < 4; ++k) { const int c = c4 + k; float s = 0.f; for (int j = 0; j < w; ++j) s += us[(t + 15 - j) * 64 + c]; ps[t * 64 + c] = s * inv - us[(t + 15) * 64 + c]; } }
            __syncthreads();
            { const int t = tid >> 4, d4 = (tid & 15) * 4; float a0 = 0.f, a1 = 0.f, a2 = 0.f, a3 = 0.f;
                for (int c = 0; c < 64; ++c) { const float p = ps[t * 64 + c]; const f32x4 wv = *(const f32x4*)&wsm[c * 64 + d4]; a0 += p * wv.x; a1 += p * wv.y; a2 += p * wv.z; a3 += p * wv.w; }
                const size_t m = (size_t)m0 + t; const v2u gw2 = *(const v2u*)(P + m * NP + N_PG + g * 64 + d4);
                const float* scl = a.pool_scale + l * 256 + g * 64 + d4;
                const float y0 = a0 * scl[0] * silu_f(bflo(gw2.x)), y1 = a1 * scl[1] * silu_f(bfhi(gw2.x)), y2 = a2 * scl[2] * silu_f(bflo(gw2.y)), y3 = a3 * scl[3] * silu_f(bfhi(gw2.y));
                v2u o; o.x = pk2(y0, y1); o.y = pk2(y2, y3); *(v2u*)(Y + m * DM + 768 + g * 64 + d4) = o; }
        }
    }
    __syncthreads();
}
__device__ __forceinline__ void gla_rec_phase(const Args& a, int l, unsigned char* lds, int unit, int tid) {
    const int b = unit >> 2, h = unit & 3;
    float* qs = (float*)lds; float* ks = (float*)(lds + 12288); float* es = (float*)(lds + 24576); float* vs = (float*)(lds + 36864); float* os = (float*)(lds + 61440);
    float* w2s = (float*)(lds + 86016); float* bs = (float*)(lds + 89088); float* gzs = (float*)(lds + 89280);
    const bf16* P = (const bf16*)(a.ws + WS_P); bf16* Y = (bf16*)(a.ws + WS_XB);
    __syncthreads();
    for (int i = tid; i < 16 * 48; i += NTHR) { const int r = i / 48, d = i % 48; w2s[i] = a.gate_w2[(size_t)(l * 16 + r) * 192 + h * 48 + d]; }
    if (tid < 48) bs[tid] = a.gate_b[l * 192 + h * 48 + tid];
    float S[48];
#pragma unroll
    for (int d = 0; d < 48; ++d) S[d] = 0.f;
    for (int blk = 0; blk < SEQ / 64; ++blk) {
        const size_t m0 = (size_t)b * SEQ + (size_t)blk * 64;
        __syncthreads();
        for (int i = tid; i < 64 * 48; i += NTHR) { const int t = i / 48, d = i % 48; const bf16* row = P + (m0 + t) * NP; qs[i] = bf2f(row[N_GQ + h * 48 + d]); ks[i] = bf2f(row[N_GK + h * 48 + d]); }
        for (int i = tid; i < 64 * 96; i += NTHR) { const int t = i / 96, v = i % 96; vs[i] = bf2f(P[(m0 + t) * NP + N_GV + h * 96 + v]); }
        for (int i = tid; i < 64 * 16; i += NTHR) { const int t = i >> 4, r = i & 15; gzs[i] = bf2f(P[(m0 + t) * NP + N_GZ + r]); }
        __syncthreads();
        for (int i = tid; i < 64 * 48; i += NTHR) { const int t = i / 48, d = i % 48; float z = bs[d];
#pragma unroll
            for (int r = 0; r < 16; ++r) z += gzs[t * 16 + r] * w2s[r * 48 + d];
            const float ls = fminf(z, 0.f) - log1pf(__expf(-fabsf(z)));
            es[i] = __expf(ls * (1.0f / 16.0f)); }
        __syncthreads();
        if (tid < 96) { const int v = tid;
            for (int t = 0; t < 64; ++t) { const float vv = vs[t * 96 + v]; float o = 0.f;
#pragma unroll
                for (int d = 0; d < 48; ++d) { S[d] = es[t * 48 + d] * S[d] + ks[t * 48 + d] * vv; o += qs[t * 48 + d] * S[d]; }
                os[t * 96 + v] = o; } }
        __syncthreads();
        { const int t = tid >> 3, part = tid & 7; float ov[12]; float ss = 0.f;
#pragma unroll
            for (int k = 0; k < 12; ++k) { ov[k] = os[t * 96 + part * 12 + k]; ss += ov[k] * ov[k]; }
            { const int ln = tid & 63; ss += shx(ss, 1, ln); ss += shx(ss, 2, ln); ss += shx(ss, 4, ln); }
            const float r = 1.0f / sqrtf(ss * (1.0f / 96.0f) + EPS);
            const size_t m = m0 + t; const bf16* gp = P + m * NP + N_GG + h * 96 + part * 12; const float* ng = a.gla_norm_g + l * 96 + part * 12;
            unsigned* yo = (unsigned*)(Y + m * DM + h * 96 + part * 12);
#pragma unroll
            for (int k = 0; k < 12; k += 2) { const float y0 = ov[k] * r * ng[k] * silu_f(bf2f(gp[k])), y1 = ov[k + 1] * r * ng[k + 1] * silu_f(bf2f(gp[k + 1])); yo[k >> 1] = pk2(y0, y1); } }
    }
    __syncthreads();
}
template <bool BITS_ONLY> __device__ __forceinline__ void dsa_slow_query(const Args& a, unsigned char* lds, int b, int t, int tid) {
    const int lane = tid & 63, wave = tid >> 6;
    unsigned* sc = (unsigned*)lds; int* hist = (int*)(lds + 32768); int* sel = (int*)(lds + 33792); float* qf = (float*)(lds + 34816); float* wq = (float*)(lds + 35328);
    int* misc = (int*)(lds + 35344); float* qh = (float*)(lds + 35456); float* lg = (float*)(lds + 36992); float* inv = (float*)(lds + 43136);
    const bf16* P = (const bf16*)(a.ws + WS_P); bf16* Y = (bf16*)(a.ws + WS_XB);
    {
        const size_t m = (size_t)b * SEQ + t; const int N = t + 1;
        __syncthreads();
        if (tid < 128) qf[tid] = bf2f(P[m * NP + N_QI + tid]);
        if (tid >= 128 && tid < 132) wq[tid - 128] = bf2f(P[m * NP + N_WI + tid - 128]);
        for (int i = tid; i < 384; i += NTHR) qh[i] = bf2f(P[m * NP + N_DQ + i]);
        __syncthreads();
        for (int s = tid; s < N; s += NTHR) {
            const v4u* kr = (const v4u*)(P + ((size_t)b * SEQ + s) * NP + N_KI); float kf[32];
#pragma unroll
            for (int c = 0; c < 4; ++c) { const v4u w = kr[c]; kf[8 * c] = bflo(w.x); kf[8 * c + 1] = bfhi(w.x); kf[8 * c + 2] = bflo(w.y); kf[8 * c + 3] = bfhi(w.y); kf[8 * c + 4] = bflo(w.z); kf[8 * c + 5] = bfhi(w.z); kf[8 * c + 6] = bflo(w.w); kf[8 * c + 7] = bfhi(w.w); }
            float score = 0.f;
#pragma unroll
            for (int hh = 0; hh < 4; ++hh) { float dot = 0.f;
#pragma unroll
                for (int d = 0; d < 32; ++d) dot += qf[hh * 32 + d] * kf[d];
                score += wq[hh] * fmaxf(dot, 0.f); }
            const unsigned u = __builtin_bit_cast(unsigned, score);
            sc[s] = (u & 0x80000000u) ? ~u : (u | 0x80000000u);
        }
        __syncthreads();
        int L;
        if (N <= 256) { if (tid < N) sel[tid] = tid; L = N; }
        else {
            unsigned prefix = 0u; int kk = 256;
            for (int pass = 0; pass < 4; ++pass) {
                const int shift = 24 - 8 * pass;
                if (tid < 256) hist[tid] = 0;
                __syncthreads();
                for (int s = tid; s < N; s += NTHR) { const unsigned key = sc[s]; const bool match = (pass == 0) ? true : ((key >> ((shift + 8) & 31)) == prefix); if (match) atomicAdd(&hist[(key >> shift) & 255u], 1); }
                __syncthreads();
                if (wave == 0) {
                    const int c0 = hist[4 * lane], c1 = hist[4 * lane + 1], c2 = hist[4 * lane + 2], c3 = hist[4 * lane + 3]; const int tot = c0 + c1 + c2 + c3;
                    int incl = tot;
#pragma unroll
                    for (int o = 1; o < 64; o <<= 1) { const int tt = shdn(incl, o, lane); if (lane + o < 64) incl += tt; }
                    const int excl = incl - tot;
                    if (excl < kk && kk <= incl) { int above = excl, D;
                        if (above + c3 >= kk) D = 4 * lane + 3;
                        else { above += c3; if (above + c2 >= kk) D = 4 * lane + 2; else { above += c2; if (above + c1 >= kk) D = 4 * lane + 1; else { above += c1; D = 4 * lane; } } }
                        misc[1] = D; misc[2] = above; }
                }
                __syncthreads();
                prefix = (prefix << 8) | (unsigned)misc[1]; kk -= misc[2];
            }
            const unsigned tau = prefix;
            const int seg = (((N + 7) >> 3) + 63) & ~63; const int s_lo = wave * seg, s_hi = (s_lo + seg < N) ? s_lo + seg : N;
            { int cg = 0, ce = 0;
                for (int base = s_lo; base < s_hi; base += 64) { const int s = base + lane; const bool in = s < s_hi; const unsigned key = in ? sc[s] : 0u;
                    cg += __popcll(__ballot(in && key > tau)); ce += __popcll(__ballot(in && key == tau)); }
                if (lane == 0) { misc[4 + wave] = cg; misc[12 + wave] = ce; } }
            __syncthreads();
            { int bg = 0, be = 0;
                for (int w2 = 0; w2 < 8; ++w2) if (w2 < wave) { bg += misc[4 + w2]; be += misc[12 + w2]; }
                int run_sel = bg + (be < kk ? be : kk), run_eq = be;
                for (int base = s_lo; base < s_hi; base += 64) { const int s = base + lane; const bool in = s < s_hi; const unsigned key = in ? sc[s] : 0u;
                    const bool gt = in && key > tau, eq = in && key == tau; const unsigned long long me = __ballot(eq); const unsigned long long lt = (1ull << lane) - 1ull;
                    const bool take = gt || (eq && (run_eq + __popcll(me & lt) < kk)); const unsigned long long mt = __ballot(take);
                    if (take) sel[run_sel + __popcll(mt & lt)] = s;
                    run_sel += __popcll(mt); run_eq += __popcll(me); } }
            L = 256;
        }
        __syncthreads();
        if constexpr (BITS_ONLY) {
            unsigned* bm = (unsigned*)lg; unsigned* MK = (unsigned*)(a.ws + WS_MASK);
            if (tid < 256) bm[tid] = 0u;
            __syncthreads();
            if (tid < L) { const int s = sel[tid]; const int kt = s >> 6, kap = s & 63, half = kap >> 5, k5 = kap & 31, hi = (k5 >> 2) & 1, r = (k5 & 3) + 4 * (k5 >> 3);
                atomicOr(&bm[kt * 2 + hi], 1u << (r + 16 * half)); }
            __syncthreads();
            const int ntw = ((t >> 8) + 1) * 8;
            if (tid < ntw) { const int kt = tid >> 1, hi = tid & 1; MK[((size_t)(b * 256 + (t >> 5)) * 128 + kt) * 64 + (t & 31) + 32 * hi] = bm[tid]; }
            __syncthreads();
            return;
        }
        { const int j = tid >> 1, h0 = (tid & 1) * 3;
            if (j < L) { const int s = sel[j]; const size_t srow = (size_t)b * SEQ + s; const int bk = t5_bucket(t - s);
#pragma unroll
                for (int hh = 0; hh < 3; ++hh) { const int h = h0 + hh; const v4u* kr = (const v4u*)(P + srow * NP + N_DK + h * 64); const float* q = qh + h * 64; float dot = 0.f;
#pragma unroll
                    for (int c = 0; c < 8; ++c) { const v4u w = kr[c]; dot += q[8 * c] * bflo(w.x) + q[8 * c + 1] * bfhi(w.x) + q[8 * c + 2] * bflo(w.y) + q[8 * c + 3] * bfhi(w.y) + q[8 * c + 4] * bflo(w.z) + q[8 * c + 5] * bfhi(w.z) + q[8 * c + 6] * bflo(w.w) + q[8 * c + 7] * bfhi(w.w); }
                    lg[h * 256 + j] = dot + a.rel_bias[bk * 6 + h] * LOG2E; } }
            else {
#pragma unroll
                for (int hh = 0; hh < 3; ++hh) lg[(h0 + hh) * 256 + j] = -INFINITY; } }
        __syncthreads();
        if (wave < 6) { float* row = lg + wave * 256; float v0 = row[lane], v1 = row[lane + 64], v2 = row[lane + 128], v3 = row[lane + 192];
            float mx = fmaxf(fmaxf(v0, v1), fmaxf(v2, v3));
#pragma unroll
            for (int o = 1; o < 64; o <<= 1) mx = fmaxf(mx, shx(mx, o, lane));
            v0 = exp2f(v0 - mx); v1 = exp2f(v1 - mx); v2 = exp2f(v2 - mx); v3 = exp2f(v3 - mx);
            const float sm = wave_sum((v0 + v1) + (v2 + v3), lane);
            row[lane] = v0; row[lane + 64] = v1; row[lane + 128] = v2; row[lane + 192] = v3;
            if (lane == 0) inv[wave] = 1.0f / sm; }
        __syncthreads();
        if (tid < 384) { const int h = tid >> 6, d = tid & 63; float acc = 0.f; const bf16* vb = P + (size_t)b * SEQ * NP + N_DV + h * 64 + d;
            for (int j = 0; j < L; ++j) acc += lg[h * 256 + j] * bf2f(vb[(size_t)sel[j] * NP]);
            const float o = acc * inv[h]; const float gate = bf2f(P[m * NP + N_DG + h * 64 + d]);
            Y[m * DM + 384 + h * 64 + d] = (bf16)f2bf(o * silu_f(gate)); }
    }
    __syncthreads();
}
template <bool BITS_ONLY> __device__ __forceinline__ void dsa_slow_phase(const Args& a, int l, unsigned char* lds, int wg, int G, int tid) {
    for (int qi = wg; qi < M; qi += G) { asm volatile("" : "+v"(tid)); dsa_slow_query<BITS_ONLY>(a, lds, qi & 7, qi >> 3, tid); }
}
__device__ __forceinline__ void index_phase(const Args& a, unsigned char* lds, unsigned* qctr, volatile LAS unsigned* MISC, int tid) {
    const unsigned short* P = (const unsigned short*)(a.ws + WS_P); unsigned* MK = (unsigned*)(a.ws + WS_MASK);
    __syncthreads();
    if (tid <= 256) ((float*)(lds + idxb::L_XT))[tid] = tid < 256 ? idxb::xthr(tid) : __builtin_inff();
    int bq = blockIdx.x & 7, tries = 0;
    for (;;) {
        asm volatile("" : "+v"(tid));
        __syncthreads();
        if (tid == 0) MISC[17] = __hip_atomic_fetch_add(qctr + 64 * bq, 1u, __ATOMIC_RELAXED, __HIP_MEMORY_SCOPE_AGENT);
        __syncthreads();
        const int k = (int)MISC[17];
        if (k >= 256) { if (++tries == 8) break; bq = (bq + 1) & 7; continue; }
        const int b = bq, qt = 255 - k;
        idxb::index_unit(P, (const unsigned short*)(a.ws + WS_KC), MK, (unsigned*)(a.ws + WS_ZW) + (size_t)blockIdx.x * 128 * 64, lds, b, qt, tid);
        const int* par = (const int*)(lds + idxb::L_PAR);
        if (par[idxb::P_ANY3 * 32]) for (int q = 0; q < 32; ++q) if (par[idxb::P_MODE * 32 + q] == 3) dsa_slow_query<true>(a, lds, b, qt * 32 + q, tid);
    }
}
#ifndef REP_POOL
#define REP_POOL 1
#endif
#ifndef ATT_PRIO
#define ATT_PRIO 0
#endif
#ifndef REP_IDX
#define REP_IDX 1
#endif
#ifndef REP_GLA
#define REP_GLA 1
#endif
#ifndef REP_ATT
#define REP_ATT 1
#endif
#ifndef REP_PREP
#define REP_PREP 1
#endif
#ifndef REP_PRO
#define REP_PRO 1
#endif
#ifndef REP_NORM
#define REP_NORM 1
#endif
#ifndef REP_ALL
#define REP_ALL 1
#endif
#ifndef REP_BAR
#define REP_BAR 1
#endif
#ifndef REP_OUT
#define REP_OUT 1
#endif
#ifndef REP_INP
#define REP_INP 1
#endif
#ifndef GLA_MODE
#define GLA_MODE 1
#endif
#ifndef DSA_MODE
#define DSA_MODE 2
#endif
#ifndef MK_SINGLE
#define MK_SINGLE 1
#endif
__global__ void __launch_bounds__(NTHR, 2) fwd(Args a) {
    extern __shared__ __attribute__((aligned(16))) unsigned char lds[];
    int tid = threadIdx.x, lane = tid & 63, wave = __builtin_amdgcn_readfirstlane(tid >> 6);
    int G = gridDim.x, wg = blockIdx.x;
    const int wave0 = __builtin_amdgcn_readfirstlane(tid >> 6);
#define LAUNDER() do { { int wv_ = wave0; asm volatile("" : "+s"(wv_)); unsigned on_ = ~0u; asm volatile("" : "+s"(on_)); tid = wv_ * 64 + (int)__builtin_amdgcn_mbcnt_hi(on_, __builtin_amdgcn_mbcnt_lo(on_, 0u)); asm volatile("" : "+v"(tid)); } wg = blockIdx.x; G = gridDim.x; asm volatile("" : "+s"(wg), "+s"(G));     \
    lane = tid & 63; wave = __builtin_amdgcn_readfirstlane(tid >> 6); gw = wg * NWAVES + wave; NGW = G * NWAVES; } while (0)
    volatile LAS unsigned* MISC = (volatile LAS unsigned*)((LAS unsigned char*)lds + MISC_OFF);
    for (int u = tid; u < (LDS_BYTES - LDSCTL_OFF) / 4; u += NTHR) ((LAS unsigned*)((LAS unsigned char*)lds + LDSCTL_OFF))[u] = 0u;
    __syncthreads();
    XcdBarrier bar; bar.bar = (unsigned*)(a.ws + WS_CTL) + CW_BAR; bar.x = 0; bar.st = nullptr;
    const bool one = a.single != 0;
    if (one) bar = xcd_barrier_post((unsigned*)(a.ws + WS_CTL) + CW_BAR, MISC + 8);
#define IN(k) (a.ph_lo <= (k) && (k) < a.ph_hi)
#define SEAM() do { if (one) { unsigned* bp_ = (unsigned*)(a.ws + WS_CTL) + CW_BAR; asm volatile("" : "+s"(bp_)); XcdBarrier bb_; bb_.bar = bp_; bb_.x = bar.x; bb_.st = bar.st; xcd_barrier(bb_); if (REP_BAR == 2) xcd_barrier(bb_); } } while (0)
    int gw = wg * NWAVES + wave, NGW = G * NWAVES;
    bf16* XB = (bf16*)(a.ws + WS_XB); bf16* PB = (bf16*)(a.ws + WS_P);
    for (int rpw = 0; rpw < REP_ALL; ++rpw) {
    LAUNDER();
    if (IN(0)) { for (int rp = 0; rp < REP_PRO; ++rp) prologue_phase(a, wg, G, tid); SEAM(); }
    for (int l = a.l_lo; l < a.l_hi; ++l) {
        LAUNDER();
        if (IN(1)) { rowscale_phase((const float*)(a.ws + WS_RS), (float*)(a.ws + WS_RSC), wg, G, tid); SEAM(); }
        LAUNDER();
        if (IN(2)) {
            pg8::Gemm g{(const bf16*)(a.ws + WS_XA), (const bf16*)(a.ws + WS_WIN) + (size_t)l * NP * 1024, M, NP, DM}; pg8::StaticOrder S; S.init(M, NP, G, wg);
            pg8::EpiP E{PB, NP, (const float*)(a.ws + WS_RSC), (pg8::bf16_t*)(a.ws + WS_KC)};
            pg8::gemm_phase<pg8::EpiP, pg8::StaticOrder, true, true>((PG8_LAS unsigned char*)lds, g, S, E, tid);
#if REP_INP == 2
            asm volatile("" : "+v"(tid)); __syncthreads(); pg8::gemm_phase<pg8::EpiP, pg8::StaticOrder, true, true>((PG8_LAS unsigned char*)lds, g, S, E, tid);
#endif
            SEAM();
        }
        LAUNDER();
        if (IN(3)) {
#if GLA_MODE == 0
            if (wg < 32) gla_rec_phase(a, l, lds, wg, tid);
#endif
            for (int rp = 0; rp < REP_POOL; ++rp) { asm volatile("" : "+v"(tid)); poolb::pool_phase(PB, XB, a.pool_w + (size_t)l * 4 * 4096, a.pool_scale + l * 256, lds, wg, G, tid); }
#if GLA_MODE == 1
            glab::gla_prep_loop(PB, a.ws + WS_GOP, a.gate_w2 + (size_t)l * 16 * 192, a.gate_b + l * 192, lds, wg, G, tid);
#if REP_PREP == 2
            __syncthreads(); asm volatile("" : "+v"(tid), "+s"(wg));
            for (int item = wg; item < BATCH * 4 * 128; item += G) { asm volatile("" : "+v"(tid)); glab::gla_prep_item(PB, a.ws + WS_GOP, a.gate_w2 + (size_t)l * 16 * 192, a.gate_b + l * 192, lds, item, tid); }
#endif
            __syncthreads();
#endif
#if DSA_MODE == 0
            dsa_slow_phase<false>(a, l, lds, wg, G, tid);
#elif DSA_MODE == 1
            dsa_slow_phase<true>(a, l, lds, wg, G, tid);
#else
            for (int rp = 0; rp < REP_IDX; ++rp) { asm volatile("" : "+v"(tid)); index_phase(a, lds, (unsigned*)(a.ws + WS_CTL) + CW_QUEUE + 64 * (32 + 8 * (l + 4 * rp + 8 * rpw)), MISC, tid); }
#endif
            SEAM();
        }
        LAUNDER();
        if (IN(4)) {
#if DSA_MODE >= 1
            { float* dl = (float*)(lds + 86016);
                for (int i = tid; i < 1032; i += NTHR) { const int rel = i >> 3, h = i & 7; dl[i] = (h < 6 && rel < 128) ? (a.rel_bias[(int)T5B[rel] * 6 + h] - a.rel_bias[31 * 6 + h]) * LOG2E : 0.f; } for (int i = tid; i < 512; i += NTHR) { const unsigned nb = ((unsigned)(i >> 1) >> (4 * (i & 1))) & 15u; ((unsigned*)(lds + attn_body::LDS_TAB))[i] = (nb & 1u ? 0xffu : 0u) | (nb & 2u ? 0xff00u : 0u) | (nb & 4u ? 0xff0000u : 0u) | (nb & 8u ? 0xff000000u : 0u); }
                __syncthreads();
                const attn_body::AttnTensors AT{(const attn_body::bf16*)(PB + N_DQ), (const attn_body::bf16*)(PB + N_DK), (const attn_body::bf16*)(PB + N_DV), (attn_body::bf16*)(XB + 384), (const attn_body::bf16*)(PB + N_DG), (const unsigned*)(a.ws + WS_MASK)};
#if GLA_MODE == 1
                if (wg < 32) { glab::gla_seq_unit(PB, XB, a.ws + WS_GOP, a.gla_norm_g + l * 96, lds, wg >> 2, wg & 3, tid);
#if REP_GLA == 2
                    asm volatile("" : "+v"(tid)); glab::gla_seq_unit(PB, XB, a.ws + WS_GOP, a.gla_norm_g + l * 96, lds, wg >> 2, wg & 3, tid);
#endif
                    for (int i = tid; i < 1032; i += NTHR) { const int rel = i >> 3, h = i & 7; dl[i] = (h < 6 && rel < 128) ? (a.rel_bias[(int)T5B[rel] * 6 + h] - a.rel_bias[31 * 6 + h]) * LOG2E : 0.f; } for (int i = tid; i < 512; i += NTHR) { const unsigned nb = ((unsigned)(i >> 1) >> (4 * (i & 1))) & 15u; ((unsigned*)(lds + attn_body::LDS_TAB))[i] = (nb & 1u ? 0xffu : 0u) | (nb & 2u ? 0xff00u : 0u) | (nb & 4u ? 0xff0000u : 0u) | (nb & 8u ? 0xff000000u : 0u); }
                    __syncthreads(); }
#endif
#if ATT_PRIO
                if (__builtin_amdgcn_readfirstlane(tid) >= 256) __builtin_amdgcn_s_setprio(1);
#endif
                for (int rp = 0; rp < REP_ATT; ++rp) { unsigned* qctr = (unsigned*)(a.ws + WS_CTL) + CW_QUEUE + 64 * (l * 4 + rp + 2 * rpw);
                for (;;) { asm volatile("" : "+v"(tid));
                    __syncthreads();
                    if (tid == 0) MISC[16] = __hip_atomic_fetch_add(qctr, 1u, __ATOMIC_RELAXED, __HIP_MEMORY_SCOPE_AGENT);
                    __syncthreads();
                    const int k = (int)MISC[16];
                    if (k >= 48 * 32) break;
                    const int qb = 31 - k / 48, bh = k % 48;
                    attn_body::attn_unit<24>(bh / 6, bh % 6, qb, AT.Q, AT.K, AT.V, AT.O, AT.GT, AT.MK, (attn_body::lds_cfptr)(LAS const float*)((LAS unsigned char*)lds + 86016), (char*)lds, tid); } }
#if ATT_PRIO
                __builtin_amdgcn_s_setprio(0);
#endif
            }
#endif
            SEAM();
        }
        LAUNDER();
        if (IN(5)) {
            pg8::Gemm g{XB, (const bf16*)(a.ws + WS_WOUT) + (size_t)l * 1024 * 1024, M, DM, DM}; pg8::StaticOrder S; S.init(M, DM, G, wg);
            pg8::EpiRes E{(bf16*)(a.ws + WS_XA), DM, (float*)(a.ws + WS_RS)};
            pg8::gemm_phase<pg8::EpiRes, pg8::StaticOrder, true, true>((PG8_LAS unsigned char*)lds, g, S, E, tid);
#if REP_OUT == 2
            { asm volatile("" : "+v"(tid)); __syncthreads(); pg8::EpiRes E2{(bf16*)(a.ws + WS_P), DM, (float*)(a.ws + WS_P) + (size_t)M * DM}; pg8::gemm_phase<pg8::EpiRes, pg8::StaticOrder, true, true>((PG8_LAS unsigned char*)lds, g, S, E2, tid); }
#endif
            SEAM();
        }
    }
    }
    LAUNDER();
    if (IN(6)) final_norm_phase((const bf16*)(a.ws + WS_XA), a.out, a.final_g, (const float*)(a.ws + WS_RS), gw, NGW, lane);
#undef IN
#undef SEAM
}

extern "C" void kernel_launch(void* const* d_in, const int* in_sizes, int n_in, void* d_out, int out_size, void* d_ws, size_t ws_size, hipStream_t stream) {
    static int grid = 0;
    if (grid == 0) {
        if (n_in != 11 || in_sizes[0] != M * DM || out_size != M * DM || ws_size < WS_END) { fprintf(stderr, "kernel_launch: unexpected shapes (n_in %d, in0 %d, out %d, ws %zu); nothing launched\n", n_in, n_in > 0 ? in_sizes[0] : -1, out_size, ws_size); grid = -1; return; }
        int dev = 0, cus = 0, per_cu = 0;
        if (hipGetDevice(&dev) != hipSuccess || hipDeviceGetAttribute(&cus, hipDeviceAttributeMultiprocessorCount, dev) != hipSuccess) { grid = -1; return; }
        if (hipFuncSetAttribute((const void*)fwd, hipFuncAttributeMaxDynamicSharedMemorySize, LDS_BYTES) != hipSuccess) { fprintf(stderr, "kernel_launch: hipFuncSetAttribute failed\n"); grid = -1; return; }
        if (hipOccupancyMaxActiveBlocksPerMultiprocessor(&per_cu, (const void*)fwd, NTHR, LDS_BYTES) != hipSuccess || per_cu < 1) fprintf(stderr, "kernel_launch: occupancy query reports %d\n", per_cu);
        (void)hipGetLastError();
        grid = cus;
    }
    if (grid < 0) return;
    if (hipMemsetAsync((char*)d_ws + WS_CTL, 0, CTL_ZERO_BYTES, stream) != hipSuccess) return;
    Args a{};
    a.x = (const float*)d_in[0]; a.norm_g = (const float*)d_in[1]; a.w_in = (const float*)d_in[2]; a.gate_w2 = (const float*)d_in[3]; a.gate_b = (const float*)d_in[4]; a.gla_norm_g = (const float*)d_in[5];
    a.rel_bias = (const float*)d_in[6]; a.pool_w = (const float*)d_in[7]; a.pool_scale = (const float*)d_in[8]; a.w_out = (const float*)d_in[9]; a.final_g = (const float*)d_in[10];
    a.out = (float*)d_out; a.ws = (unsigned char*)d_ws; a.pad = 0;
#if MK_SINGLE
    a.l_lo = 0; a.l_hi = DEPTH; a.ph_lo = 0; a.ph_hi = 7; a.single = 1;
    hipLaunchKernelGGL(fwd, dim3(grid), dim3(NTHR), LDS_BYTES, stream, a);
#else
    a.single = 0;
    a.l_lo = 0; a.l_hi = 0; a.ph_lo = 0; a.ph_hi = 1; hipLaunchKernelGGL(fwd, dim3(grid), dim3(NTHR), LDS_BYTES, stream, a);
    for (int l = 0; l < DEPTH; ++l) for (int ph = 1; ph <= 5; ++ph) { a.l_lo = l; a.l_hi = l + 1; a.ph_lo = ph; a.ph_hi = ph + 1; hipLaunchKernelGGL(fwd, dim3(grid), dim3(NTHR), LDS_BYTES, stream, a); }
    a.l_lo = 0; a.l_hi = 0; a.ph_lo = 6; a.ph_hi = 7; hipLaunchKernelGGL(fwd, dim3(grid), dim3(NTHR), LDS_BYTES, stream, a);
#endif
    const hipError_t le = hipPeekAtLastError();
    if (le != hipSuccess) fprintf(stderr, "kernel_launch: launch failed: %s\n", hipGetErrorName(le));
}
```

```cpp
#include <hip/hip_runtime.h>
#include <cstdio>
#include <cstdint>
namespace pg8 {
#define PG8_LAS __attribute__((address_space(3)))
typedef unsigned short bf16_t;
typedef short bf16x8 __attribute__((ext_vector_type(8)));
typedef float f32x4 __attribute__((ext_vector_type(4)));
typedef unsigned u32x4 __attribute__((ext_vector_type(4)));
constexpr int BM = 256, BK = 64, HALF = 128, HTB = HALF * BK * 2  , STAGE_BYTES = 8 * HTB, NXCD = 8, WGM = 8;

__host__ __device__ __forceinline__ int lds_byte(int r, int c) { const int st = (r >> 4) * 2 + (c >> 5), rr = r & 15, cc = c & 31, ob = rr * 64 + cc * 2; return st * 1024 + (ob ^ (((ob >> 9) & 1) << 5)); }
__host__ __device__ __forceinline__ void stage_rc(int b, int& R, int& C) { const int st = b / 1024, sb = b % 1024, swz = sb ^ (((sb >> 9) & 1) << 5); R = (st >> 1) * 16 + swz / 64; C = (st & 1) * 32 + (swz % 64) / 2; }
__host__ __device__ __forceinline__ int perm32(int rho) { const int n = rho >> 4, i = rho & 15; return 8 * (i >> 2) + 4 * n + (i & 3); }

struct Unit { int pm, pn; };
struct Gemm { const bf16_t* A; const bf16_t* Bt; int M, N, K; };

struct StaticOrder {
    int nM, nN, nwg, G, c;
    __host__ __device__ void init(int M, int N, int G_, int c_) { nM = M / BM; nN = N / BM; nwg = nM * nN; G = G_; c = c_; }
    __host__ __device__ bool next(int i, Unit& u) const {
        const long L = (long)i * G + c; if (L >= nwg) return false;
        int wgid = (int)L; { const int q = nwg / NXCD, r = nwg % NXCD, xcd = wgid % NXCD, off = wgid / NXCD; wgid = (xcd < r ? xcd * (q + 1) : r * (q + 1) + (xcd - r) * q) + off; }
        const int nig = WGM * nN, gid = wgid / nig, fm = gid * WGM, gsz = (nM - fm) < WGM ? (nM - fm) : WGM;
        u.pm = fm + ((wgid % nig) % gsz); u.pn = (wgid % nig) / gsz; return true;
    }
    __device__ __forceinline__ void a_ready(const Unit&) const {}
    __device__ __forceinline__ void done(const Unit&) const {}
};

__device__ __forceinline__ unsigned cvt_pk_bf16(float lo, float hi) { unsigned r; asm volatile("v_cvt_pk_bf16_f32 %0, %1, %2" : "=v"(r) : "v"(lo), "v"(hi)); return r; }
typedef float f32x2 __attribute__((ext_vector_type(2)));
struct EpiP {
    static constexpr bool PERM = true, AFTER_DRAIN = false;
    bf16_t* O; int ldc; const float* RS; bf16_t* KC;
    __device__ __forceinline__ void operator()(const f32x4 (&acc)[2][2][4][2], const Unit& u, int wr, int wc, int fr, int fq) const {
        const int row0 = u.pm * BM + wr * 64 + fr, col0 = u.pn * BM + wc * 32 + 8 * fq;
        float rr[2][4];
#pragma unroll
        for (int ai = 0; ai < 2; ++ai)
#pragma unroll
            for (int m = 0; m < 4; ++m) rr[ai][m] = RS[row0 + ai * HALF + m * 16];
#pragma unroll
        for (int ai = 0; ai < 2; ++ai)
#pragma unroll
            for (int m = 0; m < 4; ++m) { const int row = row0 + ai * HALF + m * 16; bf16_t* rowp = O + (size_t)row * ldc + col0;
                const float r = rr[ai][m];
#pragma unroll
                for (int bj = 0; bj < 2; ++bj) { const f32x4 v0 = acc[ai][bj][m][0] * r, v1 = acc[ai][bj][m][1] * r;
                    u32x4 w; w.x = cvt_pk_bf16(v0[0], v0[1]); w.y = cvt_pk_bf16(v0[2], v0[3]); w.z = cvt_pk_bf16(v1[0], v1[1]); w.w = cvt_pk_bf16(v1[2], v1[3]);
                    if (col0 + bj * HALF < 3384) *(u32x4*)(rowp + bj * HALF) = w;
                    if (bj == 0 && wc == 0 && u.pn == 13) *(u32x4*)(KC + (size_t)row * 32 + 8 * fq) = w; } }
    }
};
struct EpiRes {
    static constexpr bool PERM = true, AFTER_DRAIN = false;
    bf16_t* XA; int ldc; float* RS;
    __device__ __forceinline__ void operator()(const f32x4 (&acc)[2][2][4][2], const Unit& u, int wr, int wc, int fr, int fq) const {
        const int row0 = u.pm * BM + wr * 64 + fr, col0 = u.pn * BM + wc * 32 + 8 * fq, lane = fr + 16 * fq;
#pragma unroll
        for (int ai = 0; ai < 2; ++ai) { u32x4 rb[4][2];
#pragma unroll
            for (int m = 0; m < 4; ++m)
#pragma unroll
                for (int bj = 0; bj < 2; ++bj) rb[m][bj] = *(const u32x4*)(XA + (size_t)(row0 + ai * HALF + m * 16) * ldc + col0 + bj * HALF);
#pragma unroll
            for (int m = 0; m < 4; ++m) { const int row = row0 + ai * HALF + m * 16; const size_t off = (size_t)row * ldc + col0; float s = 0.f;
#pragma unroll
                for (int bj = 0; bj < 2; ++bj) { const u32x4 b = rb[m][bj]; u32x4 w;
#pragma unroll
                    for (int k = 0; k < 4; ++k) { const float lo = __uint_as_float(b[k] << 16) + acc[ai][bj][m][k >> 1][2 * (k & 1)], hi = __uint_as_float(b[k] & 0xffff0000u) + acc[ai][bj][m][k >> 1][2 * (k & 1) + 1];
                        w[k] = cvt_pk_bf16(lo, hi); const float rl = __uint_as_float(w[k] << 16), rh = __uint_as_float(w[k] & 0xffff0000u); s += rl * rl + rh * rh; }
                    *(u32x4*)(XA + off + bj * HALF) = w; }
                s += __builtin_bit_cast(float, __builtin_amdgcn_ds_bpermute((lane ^ 16) << 2, __builtin_bit_cast(int, s)));
                s += __builtin_bit_cast(float, __builtin_amdgcn_ds_bpermute((lane ^ 32) << 2, __builtin_bit_cast(int, s)));
                if (fq == 0) RS[(size_t)row * 16 + u.pn * 4 + wc] = s; } }
    }
};
template <class Epi, class Sched, bool ALIGN_EPI = false, bool SP2 = false>
__device__ __forceinline__ void gemm_phase(PG8_LAS unsigned char* lds, const Gemm g, const Sched& S, const Epi& E, const int tid) {
    const int wid = __builtin_amdgcn_readfirstlane(tid >> 6), lane = tid & 63, wr = wid >> 2, wc = wid & 3, fr = lane & 15, fq = lane >> 4;
    const int K = g.K, nt = K / BK;
    unsigned voffA[2], voffB[2];
#pragma unroll
    for (int i = 0; i < 2; ++i) { int R, C; stage_rc(tid * 16 + i * 8192, R, C); const int Rb = Epi::PERM ? ((R & ~31) + perm32(R & 31)) : R;
        voffA[i] = (unsigned)(R * K + C) * 2u; voffB[i] = (unsigned)(Rb * K + C) * 2u; }
    const size_t kstep = (size_t)(BK * 2);
    const size_t hstep = (size_t)HALF * K * 2;
    const size_t tstep = 2 * hstep;
    const unsigned ldsw = (unsigned)wid * 1024u;
    const int aoff = lds_byte(wr * 64 + fr, fq * 8), boff = lds_byte(wc * 32 + fr, fq * 8);
#define PG8_SA(b, h) (((b) * 2 + (h)) * HTB)
#define PG8_SB(b, h) ((4 + (b) * 2 + (h)) * HTB)
#define PG8_STAGE(bufoff, gbase, voff) do { _Pragma("unroll") for (int _i = 0; _i < 2; ++_i) \
        __builtin_amdgcn_global_load_lds((const unsigned*)((const char*)(gbase) + (voff)[_i]), (PG8_LAS unsigned*)(lds + (bufoff) + ldsw + _i * 8192), 16, 0, 0); } while (0)
#define PG8_LDA(dst, b, h) do { _Pragma("unroll") for (int m = 0; m < 4; ++m) _Pragma("unroll") for (int k = 0; k < 2; ++k) dst[m][k] = *(const PG8_LAS bf16x8*)(lds + PG8_SA(b, h) + aoff + m * 2048 + k * 1024); } while (0)
#define PG8_LDB(dst, b, h) do { _Pragma("unroll") for (int n = 0; n < 2; ++n) _Pragma("unroll") for (int k = 0; k < 2; ++k) dst[n][k] = *(const PG8_LAS bf16x8*)(lds + PG8_SB(b, h) + boff + n * 2048 + k * 1024); } while (0)
#define PG8_MMA(ai, bj, At, Bt) do { __builtin_amdgcn_s_setprio(1); _Pragma("unroll") for (int m = 0; m < 4; ++m) _Pragma("unroll") for (int n = 0; n < 2; ++n) _Pragma("unroll") for (int k = 0; k < 2; ++k) \
        acc[ai][bj][m][n] = __builtin_amdgcn_mfma_f32_16x16x32_bf16(Bt[n][k], At[m][k], acc[ai][bj][m][n], 0, 0, 0); __builtin_amdgcn_s_setprio(0); } while (0)
#define PG8_WAIT_V(n) asm volatile("s_waitcnt vmcnt(" #n ")" ::: "memory")
#define PG8_WAIT_L(n) asm volatile("s_waitcnt lgkmcnt(" #n ")" ::: "memory")
#define PG8_BAR __builtin_amdgcn_s_barrier()
#define PG8_SCHED __builtin_amdgcn_sched_barrier(0)
    Unit cur, nxt; int ui = 0;
    if (!S.next(0, cur)) return;
    f32x4 acc[2][2][4][2];
#pragma unroll
    for (int a = 0; a < 2; ++a)
#pragma unroll
        for (int b = 0; b < 2; ++b)
#pragma unroll
            for (int m = 0; m < 4; ++m)
#pragma unroll
                for (int n = 0; n < 2; ++n) acc[a][b][m][n] = (f32x4){0.f, 0.f, 0.f, 0.f};
    bf16x8 At[4][2], B0[2][2], B1[2][2];
    const char* cA = (const char*)g.A + (size_t)cur.pm * tstep; const char* cB = (const char*)g.Bt + (size_t)cur.pn * tstep;
    S.a_ready(cur);
    if constexpr (SP2) {
        PG8_STAGE(PG8_SB(0, 0), cB, voffB); PG8_STAGE(PG8_SB(0, 1), cB + hstep, voffB); PG8_STAGE(PG8_SA(0, 0), cA, voffA); PG8_STAGE(PG8_SA(0, 1), cA + hstep, voffA);
        if (wr == 1) PG8_BAR;
        PG8_WAIT_V(2); PG8_BAR;
        PG8_STAGE(PG8_SB(1, 0), cB + kstep, voffB); PG8_STAGE(PG8_SA(1, 0), cA + kstep, voffA); PG8_STAGE(PG8_SB(1, 1), cB + hstep + kstep, voffB);
        PG8_WAIT_V(6); PG8_BAR;
    } else {
        PG8_STAGE(PG8_SB(0, 0), cB, voffB); PG8_STAGE(PG8_SA(0, 0), cA, voffA); PG8_STAGE(PG8_SB(0, 1), cB + hstep, voffB); PG8_STAGE(PG8_SA(0, 1), cA + hstep, voffA);
        if (wr == 1) PG8_BAR;
        PG8_WAIT_V(4); PG8_BAR;
        PG8_STAGE(PG8_SB(1, 0), cB + kstep, voffB); PG8_STAGE(PG8_SA(1, 0), cA + kstep, voffA); PG8_STAGE(PG8_SB(1, 1), cB + hstep + kstep, voffB);
        PG8_WAIT_V(6); PG8_BAR;
    }
    for (;;) {
        const bool has_next = S.next(ui + 1, nxt);
        const char* nA = has_next ? (const char*)g.A + (size_t)nxt.pm * tstep : cA; const char* nB = has_next ? (const char*)g.Bt + (size_t)nxt.pn * tstep : cB;
        for (int t = 0; t < nt; t += 2) {
            const bool last = (t == nt - 2);
            const char* a1 = cA + (size_t)(t + 1) * kstep;
            const char* a2 = last ? nA : cA + (size_t)(t + 2) * kstep; const char* b2 = last ? nB : cB + (size_t)(t + 2) * kstep;
            const char* a3 = a2 + kstep; const char* b3 = b2 + kstep;
            if (last && has_next) S.a_ready(nxt);
            if constexpr (SP2) {
            PG8_LDB(B0, 0, 0); PG8_LDB(B1, 0, 1); PG8_SCHED; PG8_LDA(At, 0, 0); PG8_STAGE(PG8_SA(1, 1), a1 + hstep, voffA);
            PG8_WAIT_V(8); PG8_WAIT_L(0); PG8_BAR; PG8_MMA(0, 0, At, B0); PG8_MMA(0, 1, At, B1); PG8_BAR; PG8_SCHED;
            PG8_LDA(At, 0, 1); PG8_STAGE(PG8_SB(0, 0), b2, voffB); PG8_STAGE(PG8_SB(0, 1), b2 + hstep, voffB); PG8_STAGE(PG8_SA(0, 0), a2, voffA);
            PG8_WAIT_V(8); PG8_WAIT_L(0); PG8_BAR; PG8_MMA(1, 0, At, B0); PG8_MMA(1, 1, At, B1); PG8_BAR; PG8_SCHED;
            PG8_LDB(B0, 1, 0); PG8_LDB(B1, 1, 1); PG8_SCHED; PG8_LDA(At, 1, 0); PG8_STAGE(PG8_SA(0, 1), a2 + hstep, voffA);
            PG8_WAIT_V(8); PG8_WAIT_L(0); PG8_BAR; PG8_MMA(0, 0, At, B0); PG8_MMA(0, 1, At, B1); PG8_BAR; PG8_SCHED;
            PG8_LDA(At, 1, 1); PG8_STAGE(PG8_SB(1, 0), b3, voffB); PG8_STAGE(PG8_SB(1, 1), b3 + hstep, voffB); PG8_STAGE(PG8_SA(1, 0), a3, voffA);
            PG8_WAIT_V(8); PG8_WAIT_L(0); PG8_BAR; PG8_MMA(1, 0, At, B0); PG8_MMA(1, 1, At, B1); PG8_BAR; PG8_SCHED;
            } else {
            PG8_LDB(B0, 0, 0); PG8_SCHED; PG8_LDA(At, 0, 0); PG8_STAGE(PG8_SA(1, 1), a1 + hstep, voffA);
            PG8_WAIT_L(8); PG8_BAR; PG8_WAIT_L(0); PG8_MMA(0, 0, At, B0); PG8_BAR; PG8_SCHED;
            PG8_LDB(B1, 0, 1); PG8_STAGE(PG8_SB(0, 0), b2, voffB);
            PG8_BAR; PG8_WAIT_L(0); PG8_MMA(0, 1, At, B1); PG8_BAR;
            PG8_LDA(At, 0, 1); PG8_STAGE(PG8_SA(0, 0), a2, voffA);
            PG8_BAR; PG8_WAIT_L(0); PG8_MMA(1, 0, At, B0); PG8_BAR; PG8_SCHED;
            PG8_STAGE(PG8_SB(0, 1), b2 + hstep, voffB);
            PG8_WAIT_V(6); PG8_BAR; PG8_MMA(1, 1, At, B1); PG8_BAR;
            PG8_LDB(B0, 1, 0); PG8_SCHED; PG8_LDA(At, 1, 0); PG8_STAGE(PG8_SA(0, 1), a2 + hstep, voffA);
            PG8_WAIT_L(8); PG8_BAR; PG8_WAIT_L(0); PG8_MMA(0, 0, At, B0); PG8_BAR; PG8_SCHED;
            PG8_LDB(B1, 1, 1); PG8_STAGE(PG8_SB(1, 0), b3, voffB);
            PG8_BAR; PG8_WAIT_L(0); PG8_MMA(0, 1, At, B1); PG8_BAR;
            PG8_LDA(At, 1, 1); PG8_STAGE(PG8_SA(1, 0), a3, voffA);
            PG8_BAR; PG8_WAIT_L(0); PG8_MMA(1, 0, At, B0); PG8_BAR; PG8_SCHED;
            PG8_STAGE(PG8_SB(1, 1), b3 + hstep, voffB);
            PG8_WAIT_V(6); PG8_BAR; PG8_MMA(1, 1, At, B1); PG8_BAR;
            }
        }
        if constexpr (ALIGN_EPI) { if (wr == 0) PG8_BAR; }
        if constexpr (!Epi::AFTER_DRAIN) { E(acc, cur, wr, wc, fr, fq); S.done(cur); }
        if (!has_next) break;
#pragma unroll
        for (int a = 0; a < 2; ++a)
#pragma unroll
            for (int b = 0; b < 2; ++b)
#pragma unroll
                for (int m = 0; m < 4; ++m)
#pragma unroll
                    for (int n = 0; n < 2; ++n) acc[a][b][m][n] = (f32x4){0.f, 0.f, 0.f, 0.f};
        cur = nxt; cA = nA; cB = nB; ++ui;
        if constexpr (ALIGN_EPI) { if (wr == 1) PG8_BAR; }
    }
    PG8_WAIT_V(0);
    if constexpr (!ALIGN_EPI) { if (wr == 0) PG8_BAR; }
    PG8_BAR;
    if constexpr (Epi::AFTER_DRAIN) { E.fused(acc, cur, wr, wc, fr, fq, lds, wid, lane); S.done(cur); }
#undef PG8_SA
#undef PG8_SB
#undef PG8_STAGE
#undef PG8_LDA
#undef PG8_LDB
#undef PG8_MMA
#undef PG8_WAIT_V
#undef PG8_WAIT_L
#undef PG8_BAR
#undef PG8_SCHED
}
}
#include <hip/hip_bf16.h>
#include <cmath>
namespace attn_body {
using bf16=__hip_bfloat16;
using bf16x8=__attribute__((ext_vector_type(8)))short;
using s16x4=__attribute__((ext_vector_type(4)))short;
using f32x16=__attribute__((ext_vector_type(16)))float;
using u32x4=__attribute__((ext_vector_type(4)))unsigned;
constexpr int BATCH=8,NHEAD=6,SEQ=8192,D=64,DM=3584,DMO=1024;
constexpr int NW=8,QBLK=32,QB=QBLK*NW,KVBLK=64,NQB=SEQ/QB;
constexpr int ATTN_UNIT_ROWS=QB;
__device__ __forceinline__ int crow(int r,int hi){return (r&3)+8*(r>>2)+4*hi;}
#define SBAR() __builtin_amdgcn_sched_barrier(0)
typedef __attribute__((address_space(3))) const float* lds_cfptr;
__device__ __forceinline__ void biasadd(f32x16&p0,f32x16&p1,int tt,int tq,int hi,lds_cfptr dl,int h){
  const int rb=tq-64*tt-4*hi; const lds_cfptr dh=dl+h;
  #pragma unroll
  for(int r=0;r<16;++r){ const unsigned i0=(unsigned)(rb-(r&3)-8*(r>>2)), i1=i0-32u;
    float a0=dh[(i0<128u?i0:128u)*8], a1=dh[(i1<128u?i1:128u)*8];
    asm volatile("s_waitcnt lgkmcnt(0)":"+v"(a0),"+v"(a1)::"memory");
    p0[r]+=a0; p1[r]+=a1; }
}
typedef unsigned u32x2m __attribute__((ext_vector_type(2)));
template<int K> __device__ __forceinline__ float mands(float p,unsigned md){ return __uint_as_float(__float_as_uint(p)&(unsigned)(K==3?((int)md>>24):(int)(signed char)(md>>(8*K)))); }
template<int K> __device__ __forceinline__ float mandk(float p,unsigned bits){ unsigned m; asm("v_bfe_i32 %0, %1, %2, 1":"=v"(m):"v"(bits),"n"(K)); return __uint_as_float(__float_as_uint(p)&m); }
__device__ __forceinline__ float mand(float p,unsigned bits,int k){ return __uint_as_float(__float_as_uint(p)&(unsigned)__builtin_amdgcn_sbfe((int)bits,k,1)); }

constexpr int NSLOT=3, SLOTB=8192;
constexpr int LDS_K=0, LDS_V=NSLOT*SLOTB, LDS_TAB=2*NSLOT*SLOTB, LDS_OST=LDS_TAB+2048, LDS_WS=LDS_OST+NW*4096, LDS_BYTES=LDS_WS+NW*64*4, LDS_QST=90624;
constexpr float C2=0.125f*1.4426950408889634f;
__device__ __forceinline__ void glds16(const void*gsrc,unsigned lds_dst){unsigned keep;
  asm volatile("s_mov_b32 %0, m0\n\ts_mov_b32 m0, %2\n\ts_nop 0\n\tglobal_load_lds_dwordx4 %1, off\n\ts_mov_b32 m0, %0":"=&s"(keep):"v"(gsrc),"s"(lds_dst):"memory");}
__device__ __forceinline__ float max3f(float a,float b,float c){float r;asm("v_max3_f32 %0, %1, %2, %3":"=v"(r):"v"(a),"v"(b),"v"(c));return r;}
__device__ __forceinline__ float max2f(float a,float b){float r;asm("v_max_f32_e32 %0, %1, %2":"=v"(r):"v"(a),"v"(b));return r;}
__device__ __forceinline__ float fadd_s(float a,float b){float r;asm("v_add_f32_e32 %0, %1, %2":"=v"(r):"v"(a),"v"(b));return r;}
__device__ __forceinline__ float fsub_s(float a,float b){float r;asm("v_sub_f32_e32 %0, %1, %2":"=v"(r):"v"(a),"v"(b));return r;}
typedef float f32x2_t __attribute__((ext_vector_type(2))); typedef __bf16 bf16x2_t __attribute__((ext_vector_type(2)));
__device__ __forceinline__ unsigned cvtpk_s(float lo,float hi){f32x2_t v={lo,hi};bf16x2_t b=__builtin_convertvector(v,bf16x2_t);return __builtin_bit_cast(unsigned,b);}
#define WAIT_BAR(N) asm volatile("s_waitcnt vmcnt(" #N ") lgkmcnt(0)\n\ts_barrier":::"memory")

__device__ __forceinline__ void qkt(f32x16&p0,f32x16&p1,const char*Kslot,const bf16x8*qr,const f32x16&negm,int r32,int hi){
  const char*kb=Kslot+hi*1024+r32*16;
  #pragma unroll
  for(int d0=0;d0<4;++d0){
    const bf16x8 b0=*reinterpret_cast<const bf16x8*>(kb+d0*2048);
    const bf16x8 b1=*reinterpret_cast<const bf16x8*>(kb+d0*2048+512);
    if(d0==0){p0=__builtin_amdgcn_mfma_f32_32x32x16_bf16(b0,qr[0],negm,0,0,0);p1=__builtin_amdgcn_mfma_f32_32x32x16_bf16(b1,qr[0],negm,0,0,0);}
    else{p0=__builtin_amdgcn_mfma_f32_32x32x16_bf16(b0,qr[d0],p0,0,0,0);p1=__builtin_amdgcn_mfma_f32_32x32x16_bf16(b1,qr[d0],p1,0,0,0);}}
}
typedef __attribute__((address_space(3))) const char* lds_cptr;
typedef short v4i16_t __attribute__((ext_vector_type(4)));
__device__ __forceinline__ void kload8(bf16x8*kf,lds_cptr kp){
  kf[0]=*(const __attribute__((address_space(3))) bf16x8*)(kp);      kf[1]=*(const __attribute__((address_space(3))) bf16x8*)(kp+512);
  kf[2]=*(const __attribute__((address_space(3))) bf16x8*)(kp+2048); kf[3]=*(const __attribute__((address_space(3))) bf16x8*)(kp+2560);
  kf[4]=*(const __attribute__((address_space(3))) bf16x8*)(kp+4096); kf[5]=*(const __attribute__((address_space(3))) bf16x8*)(kp+4608);
  kf[6]=*(const __attribute__((address_space(3))) bf16x8*)(kp+6144); kf[7]=*(const __attribute__((address_space(3))) bf16x8*)(kp+6656);
}
__device__ __forceinline__ void kload2(bf16x8*kf,lds_cptr kp,int j){ kf[2*j]=*(const __attribute__((address_space(3))) bf16x8*)(kp+j*2048); kf[2*j+1]=*(const __attribute__((address_space(3))) bf16x8*)(kp+j*2048+512); }
__device__ __forceinline__ s16x4 vtr(lds_cptr p){ return __builtin_bit_cast(s16x4,__builtin_amdgcn_ds_read_tr16_b64_v4i16((__attribute__((address_space(3))) v4i16_t*)p)); }
__device__ __forceinline__ float rowmax(const f32x16&p0,const f32x16&p1){
  float a=max3f(p0[0],p0[1],p1[0]),b=max3f(p0[2],p0[3],p1[1]);a=max3f(a,p1[2],p1[3]);
  #pragma unroll
  for(int r=4;r<16;r+=4){a=max3f(a,p0[r],p0[r+1]);b=max3f(b,p0[r+2],p0[r+3]);a=max3f(a,p1[r],p1[r+1]);b=max3f(b,p1[r+2],p1[r+3]);}
  const float m=max2f(a,b);
  auto rr=__builtin_amdgcn_permlane32_swap(__float_as_uint(m),__float_as_uint(m),false,false);
  return max2f(__uint_as_float(rr[0]),__uint_as_float(rr[1]));
}
__device__ __forceinline__ void pv(f32x16*o,int vb,bf16x8 pa0,bf16x8 pa1,bf16x8 pa2,bf16x8 pa3){
  #pragma unroll
  for(int d0=0;d0<2;++d0){s16x4 lo[4],hi[4];
    #pragma unroll
    for(int ks=0;ks<4;++ks){
      asm volatile("ds_read_b64_tr_b16 %0,%1 offset:%c2":"=&v"(lo[ks]):"v"(vb),"i"(d0*4096+ks*1024):"memory");
      asm volatile("ds_read_b64_tr_b16 %0,%1 offset:%c2":"=&v"(hi[ks]):"v"(vb),"i"(d0*4096+ks*1024+512):"memory");}
    asm volatile("s_waitcnt lgkmcnt(0)":::"memory");SBAR();
    #define PK(k) (bf16x8){lo[k][0],lo[k][1],lo[k][2],lo[k][3],hi[k][0],hi[k][1],hi[k][2],hi[k][3]}
    o[d0]=__builtin_amdgcn_mfma_f32_32x32x16_bf16(pa0,PK(0),o[d0],0,0,0);
    o[d0]=__builtin_amdgcn_mfma_f32_32x32x16_bf16(pa1,PK(1),o[d0],0,0,0);
    o[d0]=__builtin_amdgcn_mfma_f32_32x32x16_bf16(pa2,PK(2),o[d0],0,0,0);
    o[d0]=__builtin_amdgcn_mfma_f32_32x32x16_bf16(pa3,PK(3),o[d0],0,0,0);
    #undef PK
  }
}

#ifndef ATTN_STORE16
#define ATTN_STORE16(p,v) (*(u32x4*)(p)=(v))
#endif
template<int THRL> __device__ __forceinline__ void attn_unit(int b,int h,int qb,const bf16*Q,const bf16*__restrict__ K,const bf16*__restrict__ V,bf16*O,const bf16*GT,const unsigned*MK,lds_cfptr dl,char*shm,const int tid){
  const int lane=tid&63,r32=lane&31,hi=lane>>5; const int wid=__builtin_amdgcn_readfirstlane(tid>>6);
  const long rowbase=(long)b*SEQ; const int q0=qb*QB;
  const bf16*Qw=Q+(rowbase+q0+wid*QBLK)*DM+h*D;
  const bf16*Kh=K+rowbase*DM+h*D,*Vh=V+rowbase*DM+h*D;
  const unsigned lds0=(unsigned)(uintptr_t)shm;
  float*wsf=(float*)(shm+LDS_WS)+wid*64;
  const bf16*ksrc=Kh+(long)lane*DM+wid*8;
  const bf16*vsrc=Vh+(long)(16*(wid&3)+(lane>>2))*DM+(wid>>2)*32+(lane&3)*8;
  const unsigned kdst=lds0+LDS_K+wid*1024, vdst=lds0+LDS_V+wid*1024;
  #define DMA_K(t,slot) glds16(ksrc+(long)(t)*KVBLK*DM,(unsigned)__builtin_amdgcn_readfirstlane(kdst+(slot)))
  #define DMA_V(t,slot) glds16(vsrc+(long)(t)*KVBLK*DM,(unsigned)__builtin_amdgcn_readfirstlane(vdst+(slot)))
  const int vb0=(int)(lds0+LDS_V)+((lane>>4)&1)*32+(lane&3)*8+(4*hi+((lane&15)>>2))*64;
  const char*Kbase=shm+LDS_K; bf16x8 kf[8];
  const lds_cptr shm3=(lds_cptr)shm; const lds_cptr kp0=shm3+LDS_K+hi*1024+r32*16; const lds_cptr vp0=shm3+LDS_V+((lane>>4)&1)*32+(lane&3)*8+(4*hi+((lane&15)>>2))*64;
  const int NT=(q0+QB)/KVBLK;
  DMA_K(0,0);DMA_V(0,0);DMA_K(1,SLOTB);
  const __attribute__((address_space(3))) char* shm3q=(const __attribute__((address_space(3))) char*)shm;
  bf16x8 qr[4];
  #pragma unroll
  for(int d0=0;d0<4;++d0)qr[d0]=*reinterpret_cast<const bf16x8*>(&Qw[(long)r32*DM+d0*16+hi*8]);
  const __attribute__((address_space(3))) bf16x8* qls=(const __attribute__((address_space(3))) bf16x8*)(shm3q+LDS_QST+wid*4096)+lane;
  #pragma unroll
  for(int d0=0;d0<4;++d0)((__attribute__((address_space(3))) bf16x8*)qls)[64*d0]=qr[d0];
  float mhat=0.f,l_reg=0.f;f32x16 o[2];o[0]=f32x16{};o[1]=f32x16{};float nmh=0.f;
  const int tq=q0+wid*QBLK+r32;
  const unsigned*mbase=MK+((size_t)(b*256+(q0>>5)+wid)*128)*64;
  unsigned bits_cur=mbase[lane],bits_next=mbase[64+lane];
  #define CMASK(P0,P1,t) do{ if((t)>=NT-6)biasadd(P0,P1,(t),tq,hi,dl,h);}while(0)
  bool resc=false;
  #define START(P0,P1) do{ const float rm=rowmax(P0,P1); resc=false; \
    { const float dl=(rm>(float)THRL||rm<-(float)THRL)?rm:0.f; mhat=fadd_s(mhat,dl);     \
      _Pragma("unroll") for(int r=0;r<16;++r){P0[r]=fsub_s(P0[r],dl);P1[r]=fsub_s(P1[r],dl);} \
      nmh=-mhat; } \
    _Pragma("unroll") for(int r=0;r<16;++r)P0[r]=mand(__builtin_amdgcn_exp2f(P0[r]),bits_cur,r); }while(0)
  #define RESC() do{ if(resc){ asm volatile("s_waitcnt lgkmcnt(0)":::"memory"); \
      _Pragma("unroll") for(int d_=0;d_<2;++d_) _Pragma("unroll") for(int r=0;r<16;++r)o[d_][r]*=wsf[crow(r,hi)]; } }while(0)
  f32x16 pA0,pA1,pB0,pB1;
  int sl_prev=0,sl_cur=0,sl_next=SLOTB;
  #define ROT() do{sl_prev=sl_cur;sl_cur=sl_next;sl_next=(sl_next==(NSLOT-1)*SLOTB)?0:sl_next+SLOTB;}while(0)
  DMA_K(2,2*SLOTB);
  WAIT_BAR(3);
  { const f32x16 zc=f32x16{}; qkt(pA0,pA1,Kbase,qr,zc,r32,hi); }asm volatile("s_nop 15\n\ts_nop 7":"+v"(pA0),"+v"(pA1));CMASK(pA0,pA1,0);
  START(pA0,pA1);
  _Pragma("unroll") for(int r=0;r<16;++r)pA1[r]=mand(__builtin_amdgcn_exp2f(pA1[r]),bits_cur,16+r);
  WAIT_BAR(0);
  DMA_K(3,0);DMA_V(1,SLOTB);
  ROT();
  kload8(kf,kp0+sl_cur);
  WAIT_BAR(2);
  u32x2m mk01,mk23,mk45,mk67;
  s16x4 vlo[8],vhi[8]; u32x4 pw0,pw1,pw2,pw3; bf16x8 qa_=qls[0],qb_;
  #define PKW(P,B) cvtpk_s(P[B],P[B+1])
  #define PAF(k) __builtin_bit_cast(bf16x8,pw##k)
  #define VFR(i) (bf16x8){vlo[i][0],vlo[i][1],vlo[i][2],vlo[i][3],vhi[i][0],vhi[i][1],vhi[i][2],vhi[i][3]}
  #define PIN(x) asm volatile("":"+v"(x))
  #define MX3(a,b,c) __builtin_fmaxf(__builtin_fmaxf((a),(b)),(c))
  #define GAPA(MF,A0,A1,A2,A3,W0,W1,PW) do{ MF; sacc+=A0; sacc+=A1; sacc+=A2; sacc+=A3; PIN(sacc); W0; W1; PIN(PW); SBAR(); }while(0)
  #define EX(v) __builtin_amdgcn_exp2f(v)
  #define MKD(e) (((e)>>2)==0?mk01[0]:((e)>>2)==1?mk01[1]:((e)>>2)==2?mk23[0]:((e)>>2)==3?mk23[1]:((e)>>2)==4?mk45[0]:((e)>>2)==5?mk45[1]:((e)>>2)==6?mk67[0]:mk67[1])
  #define GAPB(MF,X,B,MB) do{ MF; { const unsigned md_=MKD((MB)+(B)); X[B]=mands<0>(EX(X[B]),md_); X[B+1]=mands<1>(EX(X[B+1]),md_); X[B+2]=mands<2>(EX(X[B+2]),md_); X[B+3]=mands<3>(EX(X[B+3]),md_); } PIN(X); SBAR(); }while(0)
  #define VRD(i) do{ vlo[i]=vtr(vp_+(((i)>>2)*4096+((i)&3)*1024)); vhi[i]=vtr(vp_+(((i)>>2)*4096+((i)&3)*1024+512)); }while(0)
  #define KRD(G,j) do{ if(G){ kload2(kf,kp0+sl_next,j); SBAR(); } }while(0)
  #define STEP(C0,C1,P0,P1,t,GK,GV,GL) do{ SBAR(); \
    bits_cur=bits_next; if(GV){ bits_next=mbase[64*((t)+1)+lane]; } \
    { typedef const __attribute__((address_space(3))) u32x2m* tp_;     \
      mk01=*(tp_)(LDS_TAB+(((unsigned)(unsigned char)(bits_cur))<<3)); mk23=*(tp_)(LDS_TAB+(((unsigned)(unsigned char)(bits_cur>>8))<<3)); mk45=*(tp_)(LDS_TAB+(((unsigned)(unsigned char)(bits_cur>>16))<<3)); mk67=*(tp_)(LDS_TAB+((bits_cur>>24)<<3)); } \
    const lds_cptr vp_=vp0+sl_prev; \
    VRD(0); qb_=qls[64]; SBAR(); float sacc=(P0[0]+P0[1]); \
    if(!__any(nmh!=0.f)){ const f32x16 zc_=f32x16{}; \
      GAPA(C0=__builtin_amdgcn_mfma_f32_32x32x16_bf16(kf[0],qa_,zc_,0,0,0), P0[2],P0[3],P0[4],P0[5],     pw0[0]=PKW(P0,0), pw0[1]=PKW(P0,2), pw0); \
      VRD(4); SBAR(); GAPA(C1=__builtin_amdgcn_mfma_f32_32x32x16_bf16(kf[1],qa_,zc_,0,0,0), P0[6],P0[7],P0[8],P0[9],     pw0[2]=PKW(P0,4), pw0[3]=PKW(P0,6), pw0); \
    }else{ f32x16 negm; { float nm_=nmh; asm volatile("":"+v"(nm_)); _Pragma("unroll") for(int r=0;r<16;++r)negm[r]=nm_; } \
      GAPA(C0=__builtin_amdgcn_mfma_f32_32x32x16_bf16(kf[0],qa_,negm,0,0,0), P0[2],P0[3],P0[4],P0[5],     pw0[0]=PKW(P0,0), pw0[1]=PKW(P0,2), pw0); \
      VRD(4); SBAR(); GAPA(C1=__builtin_amdgcn_mfma_f32_32x32x16_bf16(kf[1],qa_,negm,0,0,0), P0[6],P0[7],P0[8],P0[9],     pw0[2]=PKW(P0,4), pw0[3]=PKW(P0,6), pw0); } \
    VRD(1); qa_=qls[128]; SBAR(); GAPA(C0=__builtin_amdgcn_mfma_f32_32x32x16_bf16(kf[2],qb_,C0,0,0,0),   P0[10],P0[11],P0[12],P0[13], pw1[0]=PKW(P0,8), pw1[1]=PKW(P0,10), pw1); \
    VRD(5); SBAR(); GAPA(C1=__builtin_amdgcn_mfma_f32_32x32x16_bf16(kf[3],qb_,C1,0,0,0),   P0[14],P0[15],P1[0],P1[1],   pw1[2]=PKW(P0,12),pw1[3]=PKW(P0,14), pw1); \
    VRD(2); qb_=qls[192]; SBAR(); GAPA(C0=__builtin_amdgcn_mfma_f32_32x32x16_bf16(kf[4],qa_,C0,0,0,0),   P1[2],P1[3],P1[4],P1[5],     pw2[0]=PKW(P1,0), pw2[1]=PKW(P1,2), pw2); \
    VRD(6); SBAR(); GAPA(C1=__builtin_amdgcn_mfma_f32_32x32x16_bf16(kf[5],qa_,C1,0,0,0),   P1[6],P1[7],P1[8],P1[9],     pw2[2]=PKW(P1,4), pw2[3]=PKW(P1,6), pw2); \
    VRD(3); qa_=qls[0]; SBAR(); GAPA(C0=__builtin_amdgcn_mfma_f32_32x32x16_bf16(kf[6],qb_,C0,0,0,0),   P1[10],P1[11],P1[12],P1[13], pw3[0]=PKW(P1,8), pw3[1]=PKW(P1,10), pw3); \
    VRD(7); SBAR(); GAPA(C1=__builtin_amdgcn_mfma_f32_32x32x16_bf16(kf[7],qb_,C1,0,0,0),   P1[14],P1[15],0.f,0.f,       pw3[2]=PKW(P1,12),pw3[3]=PKW(P1,14), pw3); \
    l_reg+=sacc; \
    if(GK){DMA_K((t)+3,sl_cur);} if(GV){DMA_V((t)+1,sl_next);} \
    CMASK(C0,C1,t); \
    { float a=MX3(C0[0],C0[1],C1[0]),b=MX3(C0[2],C0[3],C1[1]); a=MX3(a,C1[2],C1[3]); \
      _Pragma("unroll") for(int r=4;r<16;r+=4){a=MX3(a,C0[r],C0[r+1]);b=MX3(b,C0[r+2],C0[r+3]);a=MX3(a,C1[r],C1[r+1]);b=MX3(b,C1[r+2],C1[r+3]);} \
      float rm=__builtin_fmaxf(a,b); { auto rr=__builtin_amdgcn_permlane32_swap(__float_as_uint(rm),__float_as_uint(rm),false,false); rm=__builtin_fmaxf(__uint_as_float(rr[0]),__uint_as_float(rr[1])); } \
      resc=false; \
      if(__builtin_expect(__any(rm>(float)THRL),0)){ const float dl=__builtin_fmaxf(rm,0.f); mhat+=dl; \
        _Pragma("unroll") for(int r=0;r<16;++r){C0[r]-=dl;C1[r]-=dl;} \
        nmh=-mhat; \
        const float f=__builtin_amdgcn_exp2f(-dl); l_reg*=f; if(hi==0)wsf[r32]=f; resc=true; } } \
    SBAR(); \
    GAPB(o[0]=__builtin_amdgcn_mfma_f32_32x32x16_bf16(PAF(0),VFR(0),o[0],0,0,0), C0,0,0); \
    GAPB(o[1]=__builtin_amdgcn_mfma_f32_32x32x16_bf16(PAF(0),VFR(4),o[1],0,0,0), C0,4,0); \
    KRD(GL,0); GAPB(o[0]=__builtin_amdgcn_mfma_f32_32x32x16_bf16(PAF(1),VFR(1),o[0],0,0,0), C0,8,0); \
    KRD(GL,1); GAPB(o[1]=__builtin_amdgcn_mfma_f32_32x32x16_bf16(PAF(1),VFR(5),o[1],0,0,0), C0,12,0); \
    KRD(GL,2); GAPB(o[0]=__builtin_amdgcn_mfma_f32_32x32x16_bf16(PAF(2),VFR(2),o[0],0,0,0), C1,0,16); \
    KRD(GL,3); GAPB(o[1]=__builtin_amdgcn_mfma_f32_32x32x16_bf16(PAF(2),VFR(6),o[1],0,0,0), C1,4,16); \
    GAPB(o[0]=__builtin_amdgcn_mfma_f32_32x32x16_bf16(PAF(3),VFR(3),o[0],0,0,0), C1,8,16); \
    GAPB(o[1]=__builtin_amdgcn_mfma_f32_32x32x16_bf16(PAF(3),VFR(7),o[1],0,0,0), C1,12,16); \
    }while(0)
  int t=1;
  #undef CMASK
  #define CMASK(P0,P1,t) do{}while(0)
  for(;t+7<NT;t+=2){
    STEP(pB0,pB1,pA0,pA1,t,true,true,true);     WAIT_BAR(2); RESC(); ROT();
    STEP(pA0,pA1,pB0,pB1,t+1,true,true,true);   WAIT_BAR(2); RESC(); ROT();
  }
  #undef CMASK
  #define CMASK(P0,P1,t) do{ if((t)>=NT-6)biasadd(P0,P1,(t),tq,hi,dl,h);}while(0)
  #define ENDW(tt) do{ if((tt)+3<NT){WAIT_BAR(2);} else if((tt)+2<NT){WAIT_BAR(1);} else {WAIT_BAR(0);} }while(0)
  for(;t+1<NT;t+=2){
    STEP(pB0,pB1,pA0,pA1,t,(t+3<NT),(t+1<NT),(t+1<NT));       ENDW(t);   RESC(); ROT();
    STEP(pA0,pA1,pB0,pB1,t+1,(t+4<NT),(t+2<NT),(t+2<NT));     ENDW(t+1); RESC(); ROT();
  }
  STEP(pB0,pB1,pA0,pA1,NT-1,false,false,false); RESC();
  { float sacc=pB0[0]+pB0[1]; _Pragma("unroll") for(int r=2;r<16;++r)sacc+=pB0[r]; _Pragma("unroll") for(int r=0;r<16;++r)sacc+=pB1[r]; l_reg+=sacc;
    pw0=(u32x4){PKW(pB0,0),PKW(pB0,2),PKW(pB0,4),PKW(pB0,6)};pw1=(u32x4){PKW(pB0,8),PKW(pB0,10),PKW(pB0,12),PKW(pB0,14)};pw2=(u32x4){PKW(pB1,0),PKW(pB1,2),PKW(pB1,4),PKW(pB1,6)};pw3=(u32x4){PKW(pB1,8),PKW(pB1,10),PKW(pB1,12),PKW(pB1,14)};
    SBAR(); pv(o,vb0+sl_cur,PAF(0),PAF(1),PAF(2),PAF(3)); }
  #undef PKW
  #undef PAF
  #undef VFR
  #undef PIN
  #undef MX3
  #undef GAPA
  #undef GAPB
  #undef EX
  #undef VRD
  #undef KRD
  #undef STEP
  #undef ENDW
  {auto rr=__builtin_amdgcn_permlane32_swap(__float_as_uint(l_reg),__float_as_uint(l_reg),false,false);l_reg=__uint_as_float(rr[0])+__uint_as_float(rr[1]);}
  if(hi==0)wsf[32+r32]=l_reg;asm volatile("s_waitcnt lgkmcnt(0)":::"memory");
  float rli[16];
  #pragma unroll
  for(int r=0;r<16;++r)rli[r]=__builtin_amdgcn_rcpf(wsf[32+crow(r,hi)]);
  bf16*Ow=O+(rowbase+q0+wid*QBLK)*DMO+h*D; const bf16*Gw=GT+(rowbase+q0+wid*QBLK)*DM+h*D;
  { bf16*stg=(bf16*)(shm+LDS_OST)+wid*2048;
    #pragma unroll
    for(int r=0;r<16;++r){const int orow=crow(r,hi);
      #pragma unroll
      for(int d0=0;d0<2;++d0)stg[orow*64+d0*32+r32]=__float2bfloat16(o[d0][r]*rli[r]);}
    asm volatile("s_waitcnt lgkmcnt(0)":::"memory");
    #pragma unroll
    for(int i=0;i<4;++i){const int row=i*8+(lane>>3),ch=lane&7; const u32x4 v=*(const u32x4*)(stg+row*64+ch*8); const u32x4 g=*(const u32x4*)(Gw+(long)row*DM+ch*8); u32x4 w;
      #pragma unroll
      for(int k=0;k<4;++k){ const float g0=__uint_as_float(g[k]<<16),g1=__uint_as_float(g[k]&0xffff0000u); const float v0=__uint_as_float(v[k]<<16),v1=__uint_as_float(v[k]&0xffff0000u);
        w[k]=cvtpk_s(v0*(g0/(1.0f+__expf(-g0))),v1*(g1/(1.0f+__expf(-g1)))); }
      ATTN_STORE16(Ow+(long)row*DMO+ch*8,w);} }
  asm volatile("s_waitcnt lgkmcnt(0)\n\ts_barrier":::"memory");
  #undef DMA_K
  #undef DMA_V
  #undef CMASK
  #undef START
  #undef RESC
  #undef ROT
}
constexpr int ATTN_LDS_BYTES=LDS_BYTES;
struct AttnTensors { const bf16* Q; const bf16* K; const bf16* V; bf16* O; const bf16* GT; const unsigned* MK; };
struct AttnUnit { int bh; int qb; };
struct StaticOrder {
  int wg,G;
  __device__ __forceinline__ explicit StaticOrder(int grid,int block):wg(block),G(grid){}
  __device__ __forceinline__ bool next(int i,AttnUnit&u)const{ const int p=wg+(i>>1)*G; if(p>=768)return false; const int s=p&15; u.bh=p>>4; u.qb=(i&1)?31-s:s; return true; }
  __device__ __forceinline__ void a_ready(const AttnUnit&)const{}
  __device__ __forceinline__ void done(const AttnUnit&)const{}
};
template<class Sched,int THRL=8> __device__ __forceinline__ void attn_phase(char*lds,const AttnTensors&T,lds_cfptr dl,const Sched&S,int tid){
  AttnUnit u;
  for(int i=0;S.next(i,u);++i){ asm volatile("":"+v"(tid)); S.a_ready(u); attn_unit<THRL>(u.bh/NHEAD,u.bh%NHEAD,u.qb,T.Q,T.K,T.V,T.O,T.GT,T.MK,dl,lds,tid); S.done(u); }
}
#undef SBAR
#undef WAIT_BAR
}

constexpr int NWAVES = 8, NTHR = 512;
constexpr int BATCH = 8, SEQ = 8192, DM = 1024, DEPTH = 4, M = BATCH * SEQ;
constexpr int IN_COLS = 3380, NP = 3584;
constexpr float EPS = 1e-6f;
constexpr int N_GQ = 0, N_GK = 192, N_GV = 384, N_GG = 768, N_DQ = 1152, N_DK = 1536, N_DV = 1920, N_DG = 2304, N_PU = 2688, N_PG = 2944, N_QI = 3200, N_KI = 3328, N_GZ = 3360, N_WI = 3376;
constexpr float LOG2E = 1.4426950408889634f;
constexpr size_t MiB = 1u << 20;
constexpr size_t WS_CTL = 0, CTL_ZERO_BYTES = 1 * MiB;
constexpr size_t WS_WIN = 2 * MiB;
constexpr size_t WS_WOUT = 32 * MiB;
constexpr size_t WS_XB = 48 * MiB;
constexpr size_t WS_P = 176 * MiB;
constexpr size_t WS_MASK = 624 * MiB;
constexpr size_t WS_GOP = 688 * MiB;
constexpr size_t WS_XA = 832 * MiB;
constexpr size_t WS_RSC = 44 * MiB;
constexpr size_t WS_RS = 40 * MiB;
constexpr size_t WS_ZW = 960 * MiB;
constexpr size_t WS_KC = 968 * MiB;
constexpr size_t WS_END = 972 * MiB;
constexpr int CW_BAR = 4096, CW_QUEUE = 8192;
constexpr int RING_BYTES = 131072, LDSCTL_OFF = RING_BYTES, MISC_OFF = LDSCTL_OFF + 320, LDS_BYTES = 147456;

#define GAS __attribute__((address_space(1)))
#define LAS __attribute__((address_space(3)))
typedef unsigned short bf16;
typedef unsigned v4u __attribute__((ext_vector_type(4)));
typedef unsigned v2u __attribute__((ext_vector_type(2)));
typedef float f32x4 __attribute__((ext_vector_type(4)));
typedef GAS unsigned gu32;
#define RLX_AGENT __ATOMIC_RELAXED, __HIP_MEMORY_SCOPE_AGENT
__device__ __forceinline__ unsigned f2bf(float f) { unsigned u = __builtin_bit_cast(unsigned, f); return (u + 0x7fffu + ((u >> 16) & 1u)) >> 16; }
__device__ __forceinline__ unsigned pk2(float lo, float hi) { return f2bf(lo) | (f2bf(hi) << 16); }
__device__ __forceinline__ float bf2f(unsigned short b) { return __builtin_bit_cast(float, (unsigned)b << 16); }
__device__ __forceinline__ float bflo(unsigned w) { return __builtin_bit_cast(float, w << 16); }
__device__ __forceinline__ float bfhi(unsigned w) { return __builtin_bit_cast(float, w & 0xffff0000u); }
__device__ __forceinline__ float shx(float v, int o, int lane) { return __builtin_bit_cast(float, __builtin_amdgcn_ds_bpermute((lane ^ o) << 2, __builtin_bit_cast(int, v))); }
__device__ __forceinline__ int shdn(int v, int o, int lane) { return __builtin_amdgcn_ds_bpermute(((lane + o) & 63) << 2, v); }
__device__ __forceinline__ float wave_sum(float v, int lane) {
#pragma unroll
    for (int o = 1; o < 64; o <<= 1) v += shx(v, o, lane);
    return v;
}
__device__ __forceinline__ float silu_f(float x) { return x / (1.0f + __expf(-x)); }

__constant__ unsigned char T5B[128] = {0, 1, 2, 3, 4, 5, 6, 7, 8, 9, 10, 11, 12, 13, 14, 15, 16, 16, 16, 17, 17, 18, 18, 18, 19, 19, 19, 20, 20, 20, 20, 21, 21, 21, 21, 22, 22, 22, 22, 22, 23, 23, 23, 23, 23, 23, 24, 24, 24, 24, 24, 24, 25, 25, 25, 25, 25, 25, 25, 26, 26, 26, 26, 26, 26, 26, 26, 27, 27, 27, 27, 27, 27, 27, 27, 27, 27, 28, 28, 28, 28, 28, 28, 28, 28, 28, 28, 29, 29, 29, 29, 29, 29, 29, 29, 29, 29, 29, 29, 30, 30, 30, 30, 30, 30, 30, 30, 30, 30, 30, 30, 30, 30, 31, 31, 31, 31, 31, 31, 31, 31, 31, 31, 31, 31, 31, 31, 31};
__device__ __forceinline__ int t5_bucket(int rel) { return rel >= 128 ? 31 : (int)T5B[rel]; }

#define XB_TMO      128
#define XB_XCNT(j)  (256  + 64 * (j))
#define XB_XSUB(j)  (1280 + 64 * (j))
#define XB_XGEN(j)  (2304 + 64 * (j))
#define XB_TOP      3328
#define XB_TOPGEN   3392
#define XCD_BAR_WORDS 3456
#define XB_SPIN_CAP (1u << 22)

__device__ __forceinline__ unsigned xb_ld(unsigned* p)              { return __hip_atomic_load(p, __ATOMIC_RELAXED, __HIP_MEMORY_SCOPE_AGENT); }
__device__ __forceinline__ unsigned xb_add(unsigned* p, unsigned v) { return __hip_atomic_fetch_add(p, v, __ATOMIC_RELAXED, __HIP_MEMORY_SCOPE_AGENT); }
__device__ __forceinline__ unsigned xb_xcc_id() { return (unsigned)__builtin_amdgcn_s_getreg((3 << 11) | 20) & 0xFu; }
#define XB_SPIN(cond, bar) do { unsigned _sp = 0; while (cond) { __builtin_amdgcn_s_sleep(1); \
    if ((++_sp & 255u) == 0u) { if (xb_ld(&(bar)[XB_TMO])) break; if (_sp > XB_SPIN_CAP) { atomicAdd(&(bar)[XB_TMO], 1u); break; } } } } while (0)

struct XcdBarrier {
    unsigned* bar; unsigned x;
    volatile LAS unsigned* st;
};

__device__ __forceinline__ XcdBarrier xcd_barrier_post(unsigned* bar, volatile LAS unsigned* st) {
    XcdBarrier b; b.bar = bar; b.x = xb_xcc_id(); b.st = st;
    if (threadIdx.x == 0) (void)xb_add(&bar[XB_XCNT(b.x)], 1u);
    return b;
}
__device__ __forceinline__ void xcd_barrier_complete(unsigned* bar, unsigned x, unsigned& nloc, unsigned& nx) {
    const unsigned G = gridDim.x * gridDim.y * gridDim.z;
    unsigned sum, cnt, mine, sp = 0u;
    for (;;) {
        sum = 0u; cnt = 0u; mine = 0u;
#pragma unroll
        for (unsigned j = 0; j < 16; ++j) { const unsigned c = xb_ld(&bar[XB_XCNT(j)]); sum += c; cnt += (c > 0u) ? 1u : 0u; mine = (j == x) ? c : mine; }
        if (sum == G) break;
        __builtin_amdgcn_s_sleep(1);
        if ((++sp & 255u) == 0u) { if (xb_ld(&bar[XB_TMO])) break; if (sp > XB_SPIN_CAP) { atomicAdd(&bar[XB_TMO], 1u); break; } }
    }
    nloc = mine > 0u ? mine : 1u; nx = cnt > 0u ? cnt : 1u;
}

__device__ __forceinline__ void xcd_barrier(const XcdBarrier& b) {
    asm volatile("s_waitcnt vmcnt(0)" ::: "memory");
    __syncthreads();
    if (threadIdx.x == 0) {
        unsigned* bar = b.bar;
        __builtin_amdgcn_s_waitcnt(0);
        unsigned nloc = b.st[0], nx = b.st[1];
        if (nloc == 0u) { xcd_barrier_complete(bar, b.x, nloc, nx); b.st[0] = nloc; b.st[1] = nx; }
        const unsigned old = xb_add(&bar[XB_XSUB(b.x)], 1u);
        const unsigned gen = old / nloc;
        if (old + 1u == (gen + 1u) * nloc) {
            __builtin_amdgcn_fence(__ATOMIC_RELEASE, "agent");
            asm volatile("s_waitcnt vmcnt(0)" ::: "memory");
            const unsigned og = xb_add(&bar[XB_TOP], 1u);
            const unsigned tg = og / nx;
            if (og + 1u == (tg + 1u) * nx) xb_add(&bar[XB_TOPGEN], 1u);
            else XB_SPIN(xb_ld(&bar[XB_TOPGEN]) == tg, bar);
            __builtin_amdgcn_fence(__ATOMIC_ACQUIRE, "agent");
            xb_add(&bar[XB_XGEN(b.x)], 1u);
            asm volatile("s_waitcnt vmcnt(0)" ::: "memory");
        } else {
            XB_SPIN(xb_ld(&bar[XB_XGEN(b.x)]) == gen, bar);
            __builtin_amdgcn_fence(__ATOMIC_ACQUIRE, "agent");
            asm volatile("s_waitcnt vmcnt(0)" ::: "memory");
        }
    }
    __syncthreads();
}
#ifndef IDX_NOFALLBACK
#define IDX_NOFALLBACK 0
#endif
#ifndef REP_RES
#define REP_RES 1
#endif
#ifndef REP_PATCH
#define REP_PATCH 1
#endif
#ifndef REP_P1
#define REP_P1 1
#endif
#ifndef REP_P3
#define REP_P3 1
#endif
#ifndef REP_HEAD
#define REP_HEAD 1
#endif
#ifndef REP_RES
#define REP_RES 1
#endif
#ifndef REP_P2
#define REP_P2 1
#endif
#ifndef REP_RANK
#define REP_RANK 1
#endif
#ifndef IDX_PRIO
#define IDX_PRIO 1
#endif
#ifndef IDX_PKFMA
#define IDX_PKFMA 0
#endif
#ifndef PROBE_MFMA2
#define PROBE_MFMA2 0
#endif
#ifndef PROBE_ADD2
#define PROBE_ADD2 0
#endif
#ifndef IDX_ASMFMA
#define IDX_ASMFMA 0
#endif
#ifndef IDX_ASMBIN
#define IDX_ASMBIN 0
#endif
namespace idxb {
typedef short bf16x8 __attribute__((ext_vector_type(8)));
typedef float f32x16 __attribute__((ext_vector_type(16)));
constexpr int ZBIN = 0, NBINS = 512, CAP = 256;
constexpr int L_HIST = 0, L_ZC = 65536, L_PAR = 81920, L_KBUF = 83968, L_XT = 116736;
enum { P_BSTAR = 0, P_KK, P_CCNT, P_TAU, P_CUT, P_MODE, P_TSTAR, P_RSTAR, P_OVF, P_NRANK, P_PRE, P_XL, P_XU, P_ANY3 };
__device__ __forceinline__ unsigned lds_add(unsigned* p, unsigned v) { return __hip_atomic_fetch_add((__attribute__((address_space(3))) unsigned*)p, v, __ATOMIC_RELAXED, __HIP_MEMORY_SCOPE_WORKGROUP); }
__device__ __forceinline__ int crow(int r, int hi) { return (r & 3) + 8 * (r >> 2) + 4 * hi; }
struct QFrag { bf16x8 q[4][2]; float w[4]; };
__device__ __forceinline__ f32x16 score_sub(const bf16x8 k0, const bf16x8 k1, const QFrag& Q) {
    f32x16 acc;
#pragma unroll
    for (int r = 0; r < 16; ++r) acc[r] = 0.f;
    const f32x16 zz = {0.f, 0.f, 0.f, 0.f, 0.f, 0.f, 0.f, 0.f, 0.f, 0.f, 0.f, 0.f, 0.f, 0.f, 0.f, 0.f};
    float INFV; asm("s_mov_b32 %0, 0x7f800000" : "=s"(INFV));
#pragma unroll
    for (int hp = 0; hp < 2; ++hp) {
        f32x16 d0 = __builtin_amdgcn_mfma_f32_32x32x16_bf16(k0, Q.q[2 * hp][0], zz, 0, 0, 0), d1 = __builtin_amdgcn_mfma_f32_32x32x16_bf16(k0, Q.q[2 * hp + 1][0], zz, 0, 0, 0);
        d0 = __builtin_amdgcn_mfma_f32_32x32x16_bf16(k1, Q.q[2 * hp][1], d0, 0, 0, 0); d1 = __builtin_amdgcn_mfma_f32_32x32x16_bf16(k1, Q.q[2 * hp + 1][1], d1, 0, 0, 0);
#if PROBE_MFMA2
        { f32x16 e0 = __builtin_amdgcn_mfma_f32_32x32x16_bf16(k0, Q.q[2 * hp][1], zz, 0, 0, 0); e0 = __builtin_amdgcn_mfma_f32_32x32x16_bf16(k1, Q.q[2 * hp][0], e0, 0, 0, 0);
          e0 = __builtin_amdgcn_mfma_f32_32x32x16_bf16(k0, Q.q[2 * hp + 1][1], e0, 0, 0, 0); e0 = __builtin_amdgcn_mfma_f32_32x32x16_bf16(k1, Q.q[2 * hp + 1][0], e0, 0, 0, 0); asm volatile("" :: "v"(e0)); }
#endif
#if IDX_PKFMA
        { typedef float f32x2 __attribute__((ext_vector_type(2)));
            const f32x2 wa = {Q.w[2 * hp], Q.w[2 * hp]}, wb = {Q.w[2 * hp + 1], Q.w[2 * hp + 1]};
#pragma unroll
            for (int r = 0; r < 16; r += 2) { const f32x2 ra = {__builtin_amdgcn_fmed3f(d0[r], 0.f, INFV), __builtin_amdgcn_fmed3f(d0[r + 1], 0.f, INFV)}, rb = {__builtin_amdgcn_fmed3f(d1[r], 0.f, INFV), __builtin_amdgcn_fmed3f(d1[r + 1], 0.f, INFV)};
                f32x2 ac = {acc[r], acc[r + 1]}; ac = __builtin_elementwise_fma(wa, ra, ac); ac = __builtin_elementwise_fma(wb, rb, ac); acc[r] = ac[0]; acc[r + 1] = ac[1]; } }
#else
#pragma unroll
        for (int r = 0; r < 16; ++r) {
#if IDX_ASMFMA
            const float r0 = __builtin_amdgcn_fmed3f(d0[r], 0.f, INFV), r1 = __builtin_amdgcn_fmed3f(d1[r], 0.f, INFV); float a0 = acc[r], a1;
            if (hp == 0) asm("v_mul_f32 %0, %1, %2" : "=v"(a0) : "v"(Q.w[0]), "v"(r0)); else asm("v_fma_f32 %0, %1, %2, %3" : "=v"(a0) : "v"(Q.w[2]), "v"(r0), "v"(acc[r]));
            asm("v_fma_f32 %0, %1, %2, %3" : "=v"(a1) : "v"(Q.w[2 * hp + 1]), "v"(r1), "v"(a0)); acc[r] = a1;
#else
            acc[r] = __builtin_fmaf(Q.w[2 * hp + 1], __builtin_amdgcn_fmed3f(d1[r], 0.f, INFV), __builtin_fmaf(Q.w[2 * hp], __builtin_amdgcn_fmed3f(d0[r], 0.f, INFV), acc[r]));
#endif
        }
#endif
    }
    return acc;
}
constexpr int G0 = (int)(0x3F800000u >> 18);
typedef __attribute__((address_space(3))) unsigned lds_u32;
__device__ __forceinline__ void hist_add(unsigned hb, float x, unsigned inc) {
    const float xc = __builtin_amdgcn_fmed3f(x, -254.0f, 254.0f);
#if IDX_ASMBIN
    float os, y; const unsigned m = 0x7fffffffu;
    asm("v_bfi_b32 %0, %1, 1.0, %2" : "=v"(os) : "s"(m), "v"(xc));
    asm("v_add_f32 %0, %1, %2" : "=v"(y) : "v"(xc), "v"(os));
    unsigned sh; asm("v_lshrrev_b32 %0, 18, %1" : "=v"(sh) : "v"(y));
    const unsigned a = hb + (sh << 2);
#else
    const float y = xc + __uint_as_float((__float_as_uint(xc) & 0x80000000u) | 0x3F800000u);
    const unsigned a = hb + ((__float_as_uint(y) >> 18) << 2);
#endif
    __hip_atomic_fetch_add((lds_u32*)a, inc, __ATOMIC_RELAXED, __HIP_MEMORY_SCOPE_WORKGROUP);
#if PROBE_ADD2
    __hip_atomic_fetch_add((lds_u32*)(a ^ 64u), 0u, __ATOMIC_RELAXED, __HIP_MEMORY_SCOPE_WORKGROUP);
#endif
}
__device__ __forceinline__ int hword(int q, int h) { return ((h >> 8) << 13) + q * 256 + (h & 255); }
__device__ __forceinline__ int rank_to_bin(int k) { return k < 256 ? 255 - k : k; }
__device__ __forceinline__ float xthr(int ot) { if (ot == 0) return 0.f;
    const unsigned B = (unsigned)(G0 + ot) << 18; unsigned hi = __float_as_uint(__uint_as_float(B) - 1.0f), lo = 0u;
#pragma unroll 1
    for (int i = 0; i < 32; ++i) { const unsigned mid = lo + ((hi - lo) >> 1); if (__float_as_uint(__uint_as_float(mid) + 1.0f) >= B) hi = mid; else lo = mid; }
    return __uint_as_float(hi); }
__device__ __forceinline__ unsigned wave_or(unsigned v) { int x = (int)v;
    x |= __builtin_amdgcn_update_dpp(0, x, 0x111, 0xf, 0xf, true); x |= __builtin_amdgcn_update_dpp(0, x, 0x112, 0xf, 0xf, true);
    x |= __builtin_amdgcn_update_dpp(0, x, 0x114, 0xf, 0xf, true); x |= __builtin_amdgcn_update_dpp(0, x, 0x118, 0xf, 0xf, true);
    x |= __builtin_amdgcn_update_dpp(0, x, 0x142, 0xf, 0xf, true); x |= __builtin_amdgcn_update_dpp(0, x, 0x143, 0xf, 0xf, true);
    return (unsigned)__builtin_amdgcn_readlane(x, 63); }
__device__ __forceinline__ float sel32(const f32x16& a, const f32x16& b, int e) {
    const bool b0 = e & 1, b1 = e & 2, b2 = e & 4, b3 = e & 8, b4 = e & 16;
    float v0 = a[0], v1 = a[1], v2 = a[2], v3 = a[3], v4 = a[4], v5 = a[5], v6 = a[6], v7 = a[7], v8 = a[8], v9 = a[9], v10 = a[10], v11 = a[11], v12 = a[12], v13 = a[13], v14 = a[14], v15 = a[15], v16 = b[0], v17 = b[1], v18 = b[2], v19 = b[3], v20 = b[4], v21 = b[5], v22 = b[6], v23 = b[7], v24 = b[8], v25 = b[9], v26 = b[10], v27 = b[11], v28 = b[12], v29 = b[13], v30 = b[14], v31 = b[15];
    asm("" : "+v"(v0)); asm("" : "+v"(v1)); asm("" : "+v"(v2)); asm("" : "+v"(v3)); asm("" : "+v"(v4)); asm("" : "+v"(v5)); asm("" : "+v"(v6)); asm("" : "+v"(v7)); asm("" : "+v"(v8)); asm("" : "+v"(v9)); asm("" : "+v"(v10)); asm("" : "+v"(v11)); asm("" : "+v"(v12)); asm("" : "+v"(v13)); asm("" : "+v"(v14)); asm("" : "+v"(v15)); asm("" : "+v"(v16)); asm("" : "+v"(v17)); asm("" : "+v"(v18)); asm("" : "+v"(v19)); asm("" : "+v"(v20)); asm("" : "+v"(v21)); asm("" : "+v"(v22)); asm("" : "+v"(v23)); asm("" : "+v"(v24)); asm("" : "+v"(v25)); asm("" : "+v"(v26)); asm("" : "+v"(v27)); asm("" : "+v"(v28)); asm("" : "+v"(v29)); asm("" : "+v"(v30)); asm("" : "+v"(v31));
    const float p0 = b0 ? v1 : v0, p1 = b0 ? v3 : v2, p2 = b0 ? v5 : v4, p3 = b0 ? v7 : v6, p4 = b0 ? v9 : v8, p5 = b0 ? v11 : v10, p6 = b0 ? v13 : v12, p7 = b0 ? v15 : v14, p8 = b0 ? v17 : v16, p9 = b0 ? v19 : v18, p10 = b0 ? v21 : v20, p11 = b0 ? v23 : v22, p12 = b0 ? v25 : v24, p13 = b0 ? v27 : v26, p14 = b0 ? v29 : v28, p15 = b0 ? v31 : v30;
    const float q0 = b1 ? p1 : p0, q1 = b1 ? p3 : p2, q2 = b1 ? p5 : p4, q3 = b1 ? p7 : p6, q4 = b1 ? p9 : p8, q5 = b1 ? p11 : p10, q6 = b1 ? p13 : p12, q7 = b1 ? p15 : p14;
    const float r0 = b2 ? q1 : q0, r1 = b2 ? q3 : q2, r2 = b2 ? q5 : q4, r3 = b2 ? q7 : q6;
    const float s0 = b3 ? r1 : r0, s1 = b3 ? r3 : r2;
    return b4 ? s1 : s0; }
__device__ __forceinline__ unsigned spread_nib(unsigned x) { x = (x | (x << 8)) & 0x00FF00FFu; return (x | (x << 4)) & 0x0F0F0F0Fu; }


template <int HP, int MODE, bool NEXT>
__device__ __forceinline__ void pstage(f32x16& acc, const f32x16& dc0, const f32x16& dc1, f32x16& dn0, f32x16& dn1, const bf16x8 ka, const bf16x8 kb,
                                       const bf16x8 qa0, const bf16x8 qa1, const bf16x8 qb0, const bf16x8 qb1, const float wA, const float wB,
                                       const unsigned hb, const unsigned inc, const int s0, const int t, const int hi, const float XU, const float XL, unsigned& wn, unsigned& wl) {
    const f32x16 zz = {0.f, 0.f, 0.f, 0.f, 0.f, 0.f, 0.f, 0.f, 0.f, 0.f, 0.f, 0.f, 0.f, 0.f, 0.f, 0.f};
    float INFV; asm("s_mov_b32 %0, 0x7f800000" : "=s"(INFV));
#pragma unroll
    for (int c = 3; c >= 0; --c) {
        if (NEXT) {
            if (c == 3) dn0 = __builtin_amdgcn_mfma_f32_32x32x16_bf16(ka, qa0, zz, 0, 0, 0);
            else if (c == 2) dn1 = __builtin_amdgcn_mfma_f32_32x32x16_bf16(ka, qb0, zz, 0, 0, 0);
            else if (c == 1) dn0 = __builtin_amdgcn_mfma_f32_32x32x16_bf16(kb, qa1, dn0, 0, 0, 0);
            else dn1 = __builtin_amdgcn_mfma_f32_32x32x16_bf16(kb, qb1, dn1, 0, 0, 0);
            __builtin_amdgcn_sched_barrier(0);
        }
#pragma unroll
        for (int r = 4 * c + 3; r >= 4 * c; --r) {
            const float r0 = __builtin_amdgcn_fmed3f(dc0[r], 0.f, INFV), r1 = __builtin_amdgcn_fmed3f(dc1[r], 0.f, INFV);
            float x = __builtin_fmaf(wB, r1, __builtin_fmaf(wA, r0, HP == 0 ? 0.f : acc[r]));
            if (MODE == 4) { if (s0 + crow(r, hi) > t) x = -__builtin_inff(); }
            acc[r] = x;
            if (MODE == 1) hist_add(hb, x, inc);
            if (MODE == 2) { if (s0 + crow(r, hi) <= t) hist_add(hb, x, inc); }
            if (MODE == 3 || MODE == 4) { const float t1 = x - XU, t2 = x - XL; wn = __builtin_amdgcn_alignbit(wn, __float_as_uint(t1), 31); wl = __builtin_amdgcn_alignbit(wl, __float_as_uint(t2), 31); }
        }
        if (NEXT) __builtin_amdgcn_sched_barrier(0);
    }
}
__device__ __forceinline__ void index_unit(const unsigned short* P, const unsigned short* KC, unsigned* MK, unsigned* ZWg, unsigned char* lds, int b, int qt, int tid) {
    const int lane = tid & 63, wave = __builtin_amdgcn_readfirstlane(tid >> 6), r32 = lane & 31, hi = lane >> 5;
    unsigned* hist32 = (unsigned*)(lds + L_HIST); unsigned* cand_s = (unsigned*)(lds + L_HIST); unsigned* cand_i = (unsigned*)(lds + L_HIST + 32768);     unsigned* zc = (unsigned*)(lds + L_ZC); int* par = (int*)(lds + L_PAR);
    const int t = qt * 32 + r32; const size_t qrow = (size_t)b * SEQ + t;
    const int kt_max = (qt * 32 + 31) >> 6, NTW = ((qt >> 3) + 1) * 4;
    const unsigned short* KI = KC + (size_t)b * SEQ * 32;
    QFrag Q; float invw;
    for (int rh_ = 0; rh_ < REP_HEAD; ++rh_) { asm volatile("" ::: "memory");
    { const unsigned short* qp = P + qrow * NP + N_QI + hi * 8; float var = 0.f;
#pragma unroll
        for (int h = 0; h < 4; ++h) { float s = 0.f;
#pragma unroll
            for (int ks = 0; ks < 2; ++ks) { Q.q[h][ks] = *(const bf16x8*)(qp + h * 32 + ks * 16);
#pragma unroll
                for (int j = 0; j < 8; ++j) { const float v = bf2f((unsigned short)Q.q[h][ks][j]); s += v * v; } }
            s += shx(s, 32, lane); Q.w[h] = bf2f(P[qrow * NP + N_WI + h]); var += Q.w[h] * Q.w[h] * s; }
        invw = 82.7f / sqrtf(var > 1e-20f ? var : 1e-20f);
#pragma unroll
        for (int h = 0; h < 4; ++h) Q.w[h] *= invw; }
    __syncthreads();
    { typedef unsigned u32x4z __attribute__((ext_vector_type(4))); for (int i = tid; i < (L_PAR + 2048) / 16; i += NTHR) ((__attribute__((address_space(3))) u32x4z*)lds)[i] = (u32x4z){0u, 0u, 0u, 0u}; }
    __syncthreads(); }
    __attribute__((address_space(3))) unsigned char* kbuf = (__attribute__((address_space(3))) unsigned char*)lds + L_KBUF + wave * 4096;
#define IDX_KISSUE(kt_) do { const unsigned short* kp_ = KI + (size_t)(kt_) * 2048 + lane * 8;        \
        __builtin_amdgcn_global_load_lds((const unsigned*)kp_, (__attribute__((address_space(3))) unsigned*)kbuf, 16, 0, 0); \
        __builtin_amdgcn_global_load_lds((const unsigned*)(kp_ + 512), (__attribute__((address_space(3))) unsigned*)(kbuf + 1024), 16, 0, 0); \
        __builtin_amdgcn_global_load_lds((const unsigned*)(kp_ + 1024), (__attribute__((address_space(3))) unsigned*)(kbuf + 2048), 16, 0, 0); \
        __builtin_amdgcn_global_load_lds((const unsigned*)(kp_ + 1536), (__attribute__((address_space(3))) unsigned*)(kbuf + 3072), 16, 0, 0); } while (0)
#define IDX_KREAD(dst) do { const int ko_ = r32 * 64 + hi * 16;                                     \
        dst[0] = *(__attribute__((address_space(3))) bf16x8*)(kbuf + ko_); dst[1] = *(__attribute__((address_space(3))) bf16x8*)(kbuf + ko_ + 32); \
        dst[2] = *(__attribute__((address_space(3))) bf16x8*)(kbuf + ko_ + 2048); dst[3] = *(__attribute__((address_space(3))) bf16x8*)(kbuf + ko_ + 2080); } while (0)
#define IDX_KTAKE(dst, cnt_) do { asm volatile("s_waitcnt vmcnt(" cnt_ ")" ::: "memory"); IDX_KREAD(dst); asm volatile("s_waitcnt lgkmcnt(0)" ::: "memory"); } while (0)
    const unsigned hb = (unsigned)(size_t)((__attribute__((address_space(3))) unsigned char*)lds) + L_HIST + r32 * 1024 - 4 * G0;
#if IDX_PRIO
    if (wave >= 4) __builtin_amdgcn_s_setprio(1);
#endif
    const int qlo = qt * 32;
#define IDX_PRO(dA, dB) do { const f32x16 zz_ = {0.f, 0.f, 0.f, 0.f, 0.f, 0.f, 0.f, 0.f, 0.f, 0.f, 0.f, 0.f, 0.f, 0.f, 0.f, 0.f}; \
        dA = __builtin_amdgcn_mfma_f32_32x32x16_bf16(kc[0], Q.q[0][0], zz_, 0, 0, 0); dB = __builtin_amdgcn_mfma_f32_32x32x16_bf16(kc[0], Q.q[1][0], zz_, 0, 0, 0); \
        dA = __builtin_amdgcn_mfma_f32_32x32x16_bf16(kc[1], Q.q[0][1], dA, 0, 0, 0); dB = __builtin_amdgcn_mfma_f32_32x32x16_bf16(kc[1], Q.q[1][1], dB, 0, 0, 0); } while (0)
#define IDX_QHI Q.q[2][0], Q.q[2][1], Q.q[3][0], Q.q[3][1]
#define IDX_QLO Q.q[0][0], Q.q[0][1], Q.q[1][0], Q.q[1][1]
    for (int rp1 = 0; rp1 < REP_P1; ++rp1) { bf16x8 kc[4]; const unsigned inc1 = (rp1 & 1) ? 0xffffffffu : 1u; if (wave <= kt_max) IDX_KISSUE(wave);
      for (int kt = wave; kt <= kt_max; kt += 8) {
        IDX_KTAKE(kc, "0"); if (kt + 8 <= kt_max) IDX_KISSUE(kt + 8);
        if (kt * 64 + 63 <= qlo) {
#pragma unroll
            for (int sub = 0; sub < 2; ++sub) { const f32x16 sc = score_sub(kc[2 * sub], kc[2 * sub + 1], Q);
#pragma unroll
                for (int r = 0; r < 16; ++r) hist_add(hb, sc[r], inc1); }
        } else {
#pragma unroll
            for (int sub = 0; sub < 2; ++sub) { const f32x16 sc = score_sub(kc[2 * sub], kc[2 * sub + 1], Q); const int s0 = kt * 64 + sub * 32;
#pragma unroll
                for (int r = 0; r < 16; ++r) { if (s0 + crow(r, hi) <= t) hist_add(hb, sc[r], inc1); } }
        }
      } }
    __syncthreads();
    for (int rr_ = 0; rr_ < REP_RES; ++rr_) { __syncthreads(); asm volatile("" ::: "memory");
    { typedef unsigned u32x4r __attribute__((ext_vector_type(4)));
        const int q = tid >> 4, j = tid & 15, N = qt * 32 + q + 1; const bool neg = j >= 8;
        const unsigned* hs = hist32 + (neg ? 8192 + q * 256 + 32 * (j - 8) : q * 256 + 224 - 32 * j); int c = 0;
#pragma unroll
        for (int u = 0; u < 8; ++u) { const u32x4r v = *(const u32x4r*)(hs + 4 * ((u + (j >> 1)) & 7)); c += (int)(v[0] + v[1] + v[2] + v[3]); }
        int incl = c;
#pragma unroll
        for (int o = 1; o < 16; o <<= 1) { const int v = __builtin_amdgcn_ds_bpermute(((lane - o) & 63) << 2, incl); if (j >= o) incl += v; }
        const int excl = incl - c;
        if (N <= 256) { if (j == 0) par[P_MODE * 32 + q] = 0; }
        else if (excl < 256 && 256 <= incl) { u32x4r w[8];
#pragma unroll
            for (int u = 0; u < 8; ++u) w[u] = *(const u32x4r*)(hs + 4 * u);
            int above = excl, isel = -1, cntb = 0, ab = 0;
#pragma unroll
            for (int i = 0; i < 32; ++i) { const int cb = (int)(neg ? w[i >> 2][i & 3] : w[(31 - i) >> 2][(31 - i) & 3]); if (isel < 0 && above + cb >= 256) { isel = i; cntb = cb; ab = above; } above += cb; }
            const int bsel = rank_to_bin(32 * j + isel), ot = bsel & 255; const float* XT = (const float*)(lds + L_XT);
            par[P_BSTAR * 32 + q] = bsel; par[P_KK * 32 + q] = 256 - ab; par[P_MODE * 32 + q] = (bsel != 0 && cntb > CAP) ? 3 : 1; if (bsel != 0 && cntb > CAP) par[P_ANY3 * 32] = 1;
            const float xa = XT[ot], xb = XT[ot + 1];
            const float XL = neg ? -__uint_as_float(__float_as_uint(xb) - 1u) : xa;
            const float XU = neg ? (xa > 0.f ? -__uint_as_float(__float_as_uint(xa) - 1u) : 0.f) : xb;
            par[P_XL * 32 + q] = (int)__float_as_uint(XL); par[P_XU * 32 + q] = (int)__float_as_uint(XU); }
    } }
    __syncthreads();
    const int my_mode = par[P_MODE * 32 + r32], my_b = par[P_BSTAR * 32 + r32];
    __syncthreads();
    float XL = __uint_as_float((unsigned)par[P_XL * 32 + r32]), XU = __uint_as_float((unsigned)par[P_XU * 32 + r32]);
    if (my_mode == 0) { XL = -3.0e38f; XU = -3.0e38f; }
    if (my_mode == 3) { XL = __builtin_inff(); XU = __builtin_inff(); }
    const bool central = (my_mode == 1 && my_b == 0);
    unsigned* ZW = ZWg;
    for (int r2_ = 0; r2_ < REP_P2; ++r2_) { if (r2_) { __syncthreads(); for (int i = tid; i < 32 * 128; i += NTHR) zc[i] = 0u; if (tid < 32) { par[P_CCNT * 32 + tid] = 0; par[P_OVF * 32 + tid] = 0; } __syncthreads(); }
    { bf16x8 kc[4]; if (wave <= kt_max) IDX_KISSUE(wave);
      for (int kt = wave; kt < NTW; kt += 8) {
        unsigned word = 0u, wz = 0u;
        if (kt <= kt_max) {
            if (kt == wave) { IDX_KTAKE(kc, "0"); } else { IDX_KTAKE(kc, "2"); }
            if (kt + 8 <= kt_max) IDX_KISSUE(kt + 8);
            asm volatile("" ::: "memory");
            f32x16 s0v = score_sub(kc[0], kc[1], Q), s1v = score_sub(kc[2], kc[3], Q);
            const bool diag = kt * 64 + 63 > qlo;
            if (diag) {
#pragma unroll
                for (int r = 0; r < 16; ++r) { const int s = kt * 64 + crow(r, hi); if (s > t) s0v[r] = -__builtin_inff(); if (s + 32 > t) s1v[r] = -__builtin_inff(); } }
            unsigned wn = 0u, wl = 0u;
#pragma unroll
            for (int e = 31; e >= 0; --e) { const float x = (e < 16) ? s0v[e & 15] : s1v[e & 15]; float t1, t2;
#if IDX_ASMBIN
                asm("v_sub_f32 %0, %1, %2" : "=v"(t1) : "v"(x), "v"(XU)); asm("v_sub_f32 %0, %1, %2" : "=v"(t2) : "v"(x), "v"(XL));
#else
                t1 = x - XU; t2 = x - XL;
#endif
                wn = __builtin_amdgcn_alignbit(wn, __float_as_uint(t1), 31); wl = __builtin_amdgcn_alignbit(wl, __float_as_uint(t2), 31); }
            word = ~wn; const unsigned inb = wn & ~wl;
            if ((REP_P2 == 1 || r2_ > 0) && __any(inb != 0u)) {
                unsigned zb = 0u;
                if (__any(central && inb != 0u)) { unsigned UZ = wave_or(central ? inb : 0u);
                    while (UZ) { const int e = __builtin_ctz(UZ); UZ &= UZ - 1u; const float x = (e < 16) ? s0v[e & 15] : s1v[e & 15];
                        if (central && ((inb >> e) & 1u) && x == 0.f) zb |= (1u << e); }
                    if (zb) lds_add(&zc[r32 * 128 + kt], (unsigned)__builtin_popcount(zb)); wz = zb; }
                const unsigned cb = inb & ~zb; const int cnt = __builtin_popcount(cb); int pos = 0;
                if (cnt) { pos = (int)lds_add((unsigned*)&par[P_CCNT * 32 + r32], (unsigned)cnt); if (pos + cnt > CAP) par[P_OVF * 32 + r32] = 1; }
                unsigned m = cb; int slot = pos;
                while (__any(m != 0u)) { const int e = (int)__builtin_ctz(m | 0x80000000u); const float x = sel32(s0v, s1v, e);
                    if (m != 0u && slot < CAP) { cand_s[r32 * CAP + slot] = __float_as_uint(x); cand_i[r32 * CAP + slot] = (unsigned)(kt * 64 + 32 * (e >> 4) + ((e & 3) + 8 * ((e & 15) >> 2) + 4 * hi)); }
                    m &= m - 1u; ++slot; }
            }
        }
        MK[((size_t)(b * 256 + qt) * 128 + kt) * 64 + lane] = word; ZW[kt * 64 + lane] = wz;
      } } }
#if IDX_PRIO
    __builtin_amdgcn_s_setprio(0);
#endif
    asm volatile("s_waitcnt vmcnt(0)" ::: "memory");
    __syncthreads();
    for (int rk_ = 0; rk_ < REP_RANK; ++rk_) { if (rk_) __syncthreads(); asm volatile("" ::: "memory");
    { const int q = tid >> 4, j = tid & 15, mode = par[P_MODE * 32 + q], kk = par[P_KK * 32 + q], bq = par[P_BSTAR * 32 + q];
        const int n = par[P_CCNT * 32 + q] < CAP ? par[P_CCNT * 32 + q] : CAP, n4 = (n + 3) & ~3;
        if (mode == 1 && par[P_OVF * 32 + q]) { if (j == 0) { par[P_MODE * 32 + q] = 3; par[P_ANY3 * 32] = 1; } }
        else if (mode == 1 && kk <= n) {
            if (j < n4 - n) { cand_s[q * CAP + n + j] = 0xFF800000u; cand_i[q * CAP + n + j] = 0xFFFFFFFFu; }
            if (j == 0) { par[P_NRANK * 32 + q] = n; par[P_TSTAR * 32 + q] = -1; } }
        else if (mode == 1 && bq == 0) {
            const int need = kk - n; int zl[8], c = 0;
#pragma unroll
            for (int u = 0; u < 8; ++u) { zl[u] = (int)zc[q * 128 + 8 * j + u]; c += zl[u]; }
            int incl = c;
#pragma unroll
            for (int o = 1; o < 16; o <<= 1) { const int v = __builtin_amdgcn_ds_bpermute(((lane - o) & 63) << 2, incl); if (j >= o) incl += v; }
            int cum = incl - c;
            if (j == 0) { par[P_TAU * 32 + q] = (int)0xFF800000u; par[P_CUT * 32 + q] = -1; }
            if (cum < need && need <= incl) { int ts = 8 * j + 7, rs = 1; bool done = false;
#pragma unroll
                for (int u = 0; u < 8; ++u) { if (!done && cum + zl[u] >= need) { ts = 8 * j + u; rs = need - cum; done = true; } cum += zl[u]; }
                par[P_TSTAR * 32 + q] = ts; par[P_RSTAR * 32 + q] = rs; } }
        else if (mode == 1) { if (j == 0) { par[P_MODE * 32 + q] = 3; par[P_ANY3 * 32] = 1; } }
    }
    __syncthreads();
    if (tid < 64) { const int q = lane & 31; int incl = par[P_NRANK * 32 + q];
#pragma unroll
        for (int o = 1; o < 32; o <<= 1) { const int v = __builtin_amdgcn_ds_bpermute(((lane - o) & 63) << 2, incl); if (q >= o) incl += v; }
        if (lane < 32) par[P_PRE * 32 + q] = incl; }
    __syncthreads();
    { typedef unsigned u32x4v __attribute__((ext_vector_type(4)));
        const int total = par[P_PRE * 32 + 31];
        for (int g = tid; g < total; g += NTHR) {
            int q = 0;
#pragma unroll
            for (int st = 16; st >= 1; st >>= 1) { if (par[P_PRE * 32 + q + st - 1] <= g) q += st; }
            const int i = g - (q ? par[P_PRE * 32 + q - 1] : 0), n = par[P_NRANK * 32 + q], n4 = (n + 3) & ~3, kk = par[P_KK * 32 + q];
            const unsigned cix = cand_s[q * CAP + i], ciy = cand_i[q * CAP + i]; const float si = __uint_as_float(cix); int rank = 0;
#pragma unroll 2
            for (int m2 = 0; m2 < n4; m2 += 4) { const u32x4v sv = *(const u32x4v*)&cand_s[q * CAP + m2], iv = *(const u32x4v*)&cand_i[q * CAP + m2];
#pragma unroll
                for (int u = 0; u < 4; ++u) { const float sm = __uint_as_float(sv[u]); rank += (sm > si || (sm == si && iv[u] < ciy)) ? 1 : 0; } }
            if (rank == kk - 1) { par[P_TAU * 32 + q] = (int)cix; par[P_CUT * 32 + q] = (int)ciy; } } }
    __syncthreads(); }
    for (int rpp = 0; rpp < REP_PATCH; ++rpp)
    { const int q = tid >> 4, j = tid & 15, mode = par[P_MODE * 32 + q];
        if (mode == 1) { const int n = par[P_CCNT * 32 + q]; const float tau = __uint_as_float((unsigned)par[P_TAU * 32 + q]); const unsigned cut = (unsigned)par[P_CUT * 32 + q]; const int ts = par[P_TSTAR * 32 + q], rs = par[P_RSTAR * 32 + q];
            unsigned* mq = MK + (size_t)(b * 256 + qt) * 128 * 64 + q;
#pragma unroll 1
            for (int i = j; i < n; i += 16) { const float sc = __uint_as_float(cand_s[q * CAP + i]); const unsigned s = cand_i[q * CAP + i];
                if (sc > tau || (sc == tau && s <= cut)) { const int kap = s & 63, k5 = kap & 31, hh = (k5 >> 2) & 1, e = (k5 & 3) + 4 * (k5 >> 3) + 16 * (kap >> 5);
                    __hip_atomic_fetch_or(mq + (s >> 6) * 64 + 32 * hh, 1u << e, __ATOMIC_RELAXED, __HIP_MEMORY_SCOPE_AGENT); } }
            if (ts >= 0) {
                unsigned zw0[8], zw1[8];
#pragma unroll
                for (int u = 0; u < 8; ++u) { const int kt = j + 16 * u; zw0[u] = 0u; zw1[u] = 0u; if (kt <= ts) { zw0[u] = __hip_atomic_load(ZW + kt * 64 + q, __ATOMIC_RELAXED, __HIP_MEMORY_SCOPE_AGENT); zw1[u] = __hip_atomic_load(ZW + kt * 64 + 32 + q, __ATOMIC_RELAXED, __HIP_MEMORY_SCOPE_AGENT); } }
#pragma unroll
                for (int u = 0; u < 8; ++u) { const int kt = j + 16 * u; if (kt <= ts) { const unsigned w0 = zw0[u], w1 = zw1[u]; unsigned a0 = w0, a1 = w1;
                    if (kt == ts) { const unsigned lo32 = spread_nib(w0 & 0xffffu) | (spread_nib(w1 & 0xffffu) << 4), hi32 = spread_nib(w0 >> 16) | (spread_nib(w1 >> 16) << 4);
                        const unsigned long long ord = (unsigned long long)lo32 | ((unsigned long long)hi32 << 32);
                        int nn = rs, kap = 0; unsigned w = (unsigned)ord; int c = __builtin_popcount(w);
                        if (nn > c) { nn -= c; w = (unsigned)(ord >> 32); kap = 32; }
                        c = __builtin_popcount(w & 0xffffu); if (nn > c) { nn -= c; w >>= 16; kap += 16; }
                        c = __builtin_popcount(w & 0xffu); if (nn > c) { nn -= c; w >>= 8; kap += 8; }
                        c = __builtin_popcount(w & 0xfu); if (nn > c) { nn -= c; w >>= 4; kap += 4; }
                        c = __builtin_popcount(w & 0x3u); if (nn > c) { nn -= c; w >>= 2; kap += 2; }
                        c = (int)(w & 1u); if (nn > c) kap += 1;
                        unsigned k0 = 0u, k1 = 0u;
#pragma unroll
                        for (int e = 0; e < 32; ++e) { const int pos0 = 32 * (e >> 4) + crow(e & 15, 0), pos1 = 32 * (e >> 4) + crow(e & 15, 1); if (pos0 <= kap) k0 |= (1u << e); if (pos1 <= kap) k1 |= (1u << e); }
                        a0 &= k0; a1 &= k1; }
                    if (a0) __hip_atomic_fetch_or(mq + kt * 64, a0, __ATOMIC_RELAXED, __HIP_MEMORY_SCOPE_AGENT);
                    if (a1) __hip_atomic_fetch_or(mq + kt * 64 + 32, a1, __ATOMIC_RELAXED, __HIP_MEMORY_SCOPE_AGENT); } } }
        }
    }
    __syncthreads();
}
#undef IDX_KISSUE
#undef IDX_KTAKE
#undef IDX_KREAD
}
namespace glab {
typedef short bf16x8 __attribute__((ext_vector_type(8)));
typedef short s16x4 __attribute__((ext_vector_type(4)));
typedef float f32x16 __attribute__((ext_vector_type(16)));
typedef float f32x4 __attribute__((ext_vector_type(4)));
typedef unsigned u32x4 __attribute__((ext_vector_type(4)));
typedef unsigned u32x2 __attribute__((ext_vector_type(2)));
typedef float f32x2_t __attribute__((ext_vector_type(2))); typedef __bf16 bf16x2_t __attribute__((ext_vector_type(2)));
#define GLAS __attribute__((address_space(3)))
constexpr int RAW_Q = 0, RAW_K = 6144, RAW_V = 12288, RAW_Z = 24576, OP_QE = 26624, OP_KE = 33792, OP_KDT = 40960, OP_VT = 47872, OP_DEC = 61696, OP_BLK_BYTES = 35328  ,
              OP_BLK1 = 61952  , OP_ST = 97280, ST_BYTES = 10752;
__device__ __forceinline__ unsigned cvtpk(float lo, float hi) { f32x2_t v = {lo, hi}; bf16x2_t b = __builtin_convertvector(v, bf16x2_t); return __builtin_bit_cast(unsigned, b); }
__device__ __forceinline__ int crow(int r, int hi) { return (r & 3) + 8 * (r >> 2) + 4 * hi; }
__device__ __forceinline__ float bfl(unsigned short b) { return __uint_as_float((unsigned)b << 16); }


__device__ __forceinline__ void gla_prep_item(const unsigned short* P, unsigned char* GOP, const float* w2, const float* gb, unsigned char* ldsg, int item, int tid) {
    GLAS unsigned char* lds = (GLAS unsigned char*)ldsg;
    const int lane = tid & 63; const int b = item >> 9, h = (item >> 7) & 3, n = item & 127;
    const size_t m0 = (size_t)b * SEQ + (size_t)n * 64;
    __syncthreads();
#define GLA_PCOL(c) (((c) < 6) ? (N_GQ + h * 48 + (c) * 8) : ((c) < 12) ? (N_GK + h * 48 + ((c) - 6) * 8) : ((c) < 24) ? (N_GV + h * 96 + ((c) - 12) * 8) : (N_GZ + ((c) - 24) * 8))
#define GLA_PDST(row, c) (((c) < 6) ? (RAW_Q + (row) * 96 + (c) * 16) : ((c) < 12) ? (RAW_K + (row) * 96 + ((c) - 6) * 16) : ((c) < 24) ? (RAW_V + (row) * 192 + ((c) - 12) * 16) : (RAW_Z + (row) * 32 + ((c) - 24) * 16))
#pragma unroll
    for (int k = 0; k < 4; ++k) { const int p = tid + 512 * k; if (p < 1664) { const int row = p / 26, c = p % 26; *(GLAS u32x4*)(lds + GLA_PDST(row, c)) = *(const u32x4*)(P + (m0 + row) * NP + GLA_PCOL(c)); } }
    __syncthreads();
    const int sd = tid >> 3, tg = tid & 7;
    if (tid < 384) {
            float c[8], w2c[16]; const float bc = gb[h * 48 + sd];
#pragma unroll
            for (int r = 0; r < 16; ++r) w2c[r] = w2[(size_t)r * 192 + h * 48 + sd];
#pragma unroll
            for (int tt = 0; tt < 8; ++tt) { const int t = 8 * tg + tt; const u32x4 z0 = *(GLAS u32x4*)(lds + RAW_Z + t * 32), z1 = *(GLAS u32x4*)(lds + RAW_Z + t * 32 + 16); float z = bc;
#pragma unroll
                for (int k = 0; k < 4; ++k) { z += w2c[2 * k] * __uint_as_float(z0[k] << 16) + w2c[2 * k + 1] * __uint_as_float(z0[k] & 0xffff0000u); z += w2c[8 + 2 * k] * __uint_as_float(z1[k] << 16) + w2c[8 + 2 * k + 1] * __uint_as_float(z1[k] & 0xffff0000u); }
                const float ls = fminf(z, 0.f) - __logf(1.0f + __expf(-fabsf(z)));
                c[tt] = ls * (1.0f / 16.0f) + (tt ? c[tt - 1] : 0.f); }
            float incl = c[7];
#pragma unroll
            for (int o = 1; o < 8; o <<= 1) { const float v = __builtin_bit_cast(float, __builtin_amdgcn_ds_bpermute(((lane - o) & 63) << 2, __builtin_bit_cast(int, incl))); if (tg >= o) incl += v; }
            const float off = incl - c[7];
            const float bl = __builtin_bit_cast(float, __builtin_amdgcn_ds_bpermute((lane | 7) << 2, __builtin_bit_cast(int, incl)));
            unsigned kdp[4];
#pragma unroll
            for (int tt = 0; tt < 8; tt += 2) { float kdv[2];
#pragma unroll
                for (int u = 0; u < 2; ++u) { const int t = 8 * tg + tt + u; const float bb = off + c[tt + u];
                    const float q = bfl(*(GLAS unsigned short*)(lds + RAW_Q + (t * 48 + sd) * 2)), kx = bfl(*(GLAS unsigned short*)(lds + RAW_K + (t * 48 + sd) * 2));
                    const float e1 = __expf(bb), e2 = __expf(-bb), e3 = __expf(bl - bb);
                    *(GLAS unsigned short*)(lds + OP_QE + (t * 56 + sd) * 2) = (unsigned short)(cvtpk(q * e1, 0.f) & 0xffffu);
                    *(GLAS unsigned short*)(lds + OP_KE + (t * 56 + sd) * 2) = (unsigned short)(cvtpk(kx * e2, 0.f) & 0xffffu);
                    kdv[u] = kx * e3; }
                kdp[tt >> 1] = cvtpk(kdv[0], kdv[1]); }
            *(GLAS u32x4*)(lds + OP_KDT + (sd * 72 + 8 * tg) * 2) = (u32x4){kdp[0], kdp[1], kdp[2], kdp[3]};
            if (tg == 7) ((GLAS float*)(lds + OP_DEC))[sd] = __expf(bl);
    } else {
            for (int idx = tid - 384; idx < 96 * 8; idx += 128) { const int v = idx % 96, t8 = idx / 96; unsigned pk[4];
#pragma unroll
                for (int tt = 0; tt < 8; tt += 2) { const unsigned a0 = *(GLAS unsigned short*)(lds + RAW_V + ((8 * t8 + tt) * 96 + v) * 2), a1 = *(GLAS unsigned short*)(lds + RAW_V + ((8 * t8 + tt + 1) * 96 + v) * 2); pk[tt >> 1] = a0 | (a1 << 16); }
                *(GLAS u32x4*)(lds + OP_VT + (v * 72 + 8 * t8) * 2) = (u32x4){pk[0], pk[1], pk[2], pk[3]}; }
    }
    __syncthreads();
    unsigned char* dst = GOP + (size_t)item * OP_BLK_BYTES;
    for (int i = tid; i < (OP_DEC + 192 - OP_QE) / 16; i += NTHR) *(u32x4*)(dst + i * 16) = *(GLAS u32x4*)(lds + OP_QE + i * 16);
}
__device__ __forceinline__ void gla_prep_loop(const unsigned short* P, unsigned char* GOP, const float* w2, const float* gb, unsigned char* ldsg, int wg, int G, int tid) {
    GLAS unsigned char* lds = (GLAS unsigned char*)ldsg;
    const int lane = tid & 63;
#define GLA_PCOLH(c, hh) (((c) < 6) ? (N_GQ + (hh) * 48 + (c) * 8) : ((c) < 12) ? (N_GK + (hh) * 48 + ((c) - 6) * 8) : ((c) < 24) ? (N_GV + (hh) * 96 + ((c) - 12) * 8) : (N_GZ + ((c) - 24) * 8))
#define GLA_PDST(row, c) (((c) < 6) ? (RAW_Q + (row) * 96 + (c) * 16) : ((c) < 12) ? (RAW_K + (row) * 96 + ((c) - 6) * 16) : ((c) < 24) ? (RAW_V + (row) * 192 + ((c) - 12) * 16) : (RAW_Z + (row) * 32 + ((c) - 24) * 16))
#define GLA_FETCH(it_) do { const int b_ = (it_) >> 9, h_ = ((it_) >> 7) & 3, n_ = (it_) & 127; const size_t mr_ = (size_t)b_ * SEQ + (size_t)n_ * 64; \
        _Pragma("unroll") for (int k = 0; k < 4; ++k) { const int p = tid + 512 * k; if (p < 1664) { const int row = p / 26, c = p % 26; rawr[k] = *(const u32x4*)(P + (mr_ + row) * NP + GLA_PCOLH(c, h_)); } } } while (0)
    u32x4 rawr[4];
    if (wg < BATCH * 4 * 128) GLA_FETCH(wg);
    for (int item = wg; item < BATCH * 4 * 128; item += G) {
    const int h = (item >> 7) & 3;
    __syncthreads();
#pragma unroll
    for (int k = 0; k < 4; ++k) { const int p = tid + 512 * k; if (p < 1664) { const int row = p / 26, c = p % 26; *(GLAS u32x4*)(lds + GLA_PDST(row, c)) = rawr[k]; } }
    if (item + G < BATCH * 4 * 128) GLA_FETCH(item + G);
    __syncthreads();
    const int sd = tid >> 3, tg = tid & 7;
    if (tid < 384) {
            float c[8], w2c[16]; const float bc = gb[h * 48 + sd];
#pragma unroll
            for (int r = 0; r < 16; ++r) w2c[r] = w2[(size_t)r * 192 + h * 48 + sd];
#pragma unroll
            for (int tt = 0; tt < 8; ++tt) { const int t = 8 * tg + tt; const u32x4 z0 = *(GLAS u32x4*)(lds + RAW_Z + t * 32), z1 = *(GLAS u32x4*)(lds + RAW_Z + t * 32 + 16); float z = bc;
#pragma unroll
                for (int k = 0; k < 4; ++k) { z += w2c[2 * k] * __uint_as_float(z0[k] << 16) + w2c[2 * k + 1] * __uint_as_float(z0[k] & 0xffff0000u); z += w2c[8 + 2 * k] * __uint_as_float(z1[k] << 16) + w2c[8 + 2 * k + 1] * __uint_as_float(z1[k] & 0xffff0000u); }
                const float ls = fminf(z, 0.f) - __logf(1.0f + __expf(-fabsf(z)));
                c[tt] = ls * (1.0f / 16.0f) + (tt ? c[tt - 1] : 0.f); }
            float incl = c[7];
#pragma unroll
            for (int o = 1; o < 8; o <<= 1) { const float v = __builtin_bit_cast(float, __builtin_amdgcn_ds_bpermute(((lane - o) & 63) << 2, __builtin_bit_cast(int, incl))); if (tg >= o) incl += v; }
            const float off = incl - c[7];
            const float bl = __builtin_bit_cast(float, __builtin_amdgcn_ds_bpermute((lane | 7) << 2, __builtin_bit_cast(int, incl)));
            unsigned kdp[4];
#pragma unroll
            for (int tt = 0; tt < 8; tt += 2) { float kdv[2];
#pragma unroll
                for (int u = 0; u < 2; ++u) { const int t = 8 * tg + tt + u; const float bb = off + c[tt + u];
                    const float q = bfl(*(GLAS unsigned short*)(lds + RAW_Q + (t * 48 + sd) * 2)), kx = bfl(*(GLAS unsigned short*)(lds + RAW_K + (t * 48 + sd) * 2));
                    const float e1 = __expf(bb), e2 = __expf(-bb), e3 = __expf(bl - bb);
                    *(GLAS unsigned short*)(lds + OP_QE + (t * 56 + sd) * 2) = (unsigned short)(cvtpk(q * e1, 0.f) & 0xffffu);
                    *(GLAS unsigned short*)(lds + OP_KE + (t * 56 + sd) * 2) = (unsigned short)(cvtpk(kx * e2, 0.f) & 0xffffu);
                    kdv[u] = kx * e3; }
                kdp[tt >> 1] = cvtpk(kdv[0], kdv[1]); }
            *(GLAS u32x4*)(lds + OP_KDT + (sd * 72 + 8 * tg) * 2) = (u32x4){kdp[0], kdp[1], kdp[2], kdp[3]};
            if (tg == 7) ((GLAS float*)(lds + OP_DEC))[sd] = __expf(bl);
    } else {
            for (int idx = tid - 384; idx < 96 * 8; idx += 128) { const int v = idx % 96, t8 = idx / 96; unsigned pk[4];
#pragma unroll
                for (int tt = 0; tt < 8; tt += 2) { const unsigned a0 = *(GLAS unsigned short*)(lds + RAW_V + ((8 * t8 + tt) * 96 + v) * 2), a1 = *(GLAS unsigned short*)(lds + RAW_V + ((8 * t8 + tt + 1) * 96 + v) * 2); pk[tt >> 1] = a0 | (a1 << 16); }
                *(GLAS u32x4*)(lds + OP_VT + (v * 72 + 8 * t8) * 2) = (u32x4){pk[0], pk[1], pk[2], pk[3]}; }
    }
    __syncthreads();
    unsigned char* dst = GOP + (size_t)item * OP_BLK_BYTES;
    for (int i = tid; i < (OP_DEC + 192 - OP_QE) / 16; i += NTHR) *(u32x4*)(dst + i * 16) = *(GLAS u32x4*)(lds + OP_QE + i * 16);
    }
#undef GLA_FETCH
#undef GLA_PCOLH
}
__device__ __forceinline__ void gla_seq_unit(const unsigned short* P, unsigned short* Y, const unsigned char* GOP, const float* ng, unsigned char* ldsg, int b, int h, int tid) {
    GLAS unsigned char* lds = (GLAS unsigned char*)ldsg;
    const int lane = tid & 63, wave = __builtin_amdgcn_readfirstlane(tid >> 6), r32 = lane & 31, hi = lane >> 5, l15 = lane & 15, quad = lane >> 4;
    const size_t rowbase = (size_t)b * SEQ; const unsigned char* gsrc = GOP + (size_t)((b * 4 + h) * 128) * OP_BLK_BYTES;
    constexpr int NPC = (OP_DEC + 192 - OP_QE) / 16;
    constexpr int SQ_BLK0 = 0, SQ_BLK1 = OP_BLK_BYTES, SQ_ST = 2 * OP_BLK_BYTES  , SQ_OB = SQ_ST + 2 * ST_BYTES  , SQ_OB_BYTES = 64 * 96 * 2, SQ_NG = SQ_OB + 2 * SQ_OB_BYTES  ;
    __syncthreads();
    for (int i = tid; i < 2 * ST_BYTES / 4; i += NTHR) ((GLAS unsigned*)(lds + SQ_ST))[i] = 0u;
    if (tid < 96) ((GLAS float*)(lds + SQ_NG))[tid] = ng[tid];
    u32x4 rg[5];
#pragma unroll
    for (int k = 0; k < 5; ++k) { const int i = tid + 512 * k; if (i < NPC) rg[k] = *(const u32x4*)(gsrc + (size_t)i * 16); }
#pragma unroll
    for (int k = 0; k < 5; ++k) { const int i = tid + 512 * k; if (i < NPC) *(GLAS u32x4*)(lds + SQ_BLK0 + i * 16) = rg[k]; }
#pragma unroll
    for (int k = 0; k < 5; ++k) { const int i = tid + 512 * k; if (i < NPC) rg[k] = *(const u32x4*)(gsrc + OP_BLK_BYTES + (size_t)i * 16); }
    __syncthreads();
    f32x4 S[2][3];
#pragma unroll
    for (int mt = 0; mt < 2; ++mt)
#pragma unroll
        for (int nt = 0; nt < 3; ++nt) S[mt][nt] = (f32x4){0.f, 0.f, 0.f, 0.f};
#define GLA_EPILOGUE(nn) do { const int cc_ = (nn) & 1; const size_t mm_ = rowbase + (size_t)(nn) * 64; \
        _Pragma("unroll") for (int k_ = 0; k_ < 4; ++k_) { const int vec_ = (tid - 320) + 192 * k_, t_ = vec_ / 12, v_ = (vec_ % 12) * 8; \
            const u32x4 ov_ = *(GLAS u32x4*)(lds + SQ_OB + cc_ * SQ_OB_BYTES + t_ * 192 + v_ * 2); const u32x4 gv_ = *(const u32x4*)(P + (mm_ + t_) * NP + N_GG + h * 96 + v_); \
            const f32x4 n0_ = *(GLAS f32x4*)(lds + SQ_NG + v_ * 4), n1_ = *(GLAS f32x4*)(lds + SQ_NG + v_ * 4 + 16); u32x4 yo_; \
            _Pragma("unroll") for (int e_ = 0; e_ < 4; ++e_) { const float ga_ = __uint_as_float(gv_[e_] << 16), gb_ = __uint_as_float(gv_[e_] & 0xffff0000u); \
                const float na_ = (e_ < 2) ? n0_[2 * e_] : n1_[2 * e_ - 4], nb_ = (e_ < 2) ? n0_[2 * e_ + 1] : n1_[2 * e_ - 3]; \
                yo_[e_] = cvtpk(__uint_as_float(ov_[e_] << 16) * na_ * (ga_ / (1.0f + __expf(-ga_))), __uint_as_float(ov_[e_] & 0xffff0000u) * nb_ * (gb_ / (1.0f + __expf(-gb_)))); } \
            *(u32x4*)(Y + (mm_ + t_) * DM + h * 96 + v_) = yo_; } } while (0)
    for (int n = 0; n < SEQ / 64; ++n) {
        const int cur = n & 1, nxt = cur ^ 1; const size_t m0 = rowbase + (size_t)n * 64;
        const int BO = (cur ? SQ_BLK1 : SQ_BLK0) - OP_QE;
        if (n + 1 < SEQ / 64) { const int BN = (cur ? SQ_BLK0 : SQ_BLK1) - OP_QE;
#pragma unroll
            for (int k = 0; k < 5; ++k) { const int i = tid + 512 * k; if (i < NPC) *(GLAS u32x4*)(lds + OP_QE + BN + i * 16) = rg[k]; }
            if (n + 2 < SEQ / 64) {
#pragma unroll
                for (int k = 0; k < 5; ++k) { const int i = tid + 512 * k; if (i < NPC) rg[k] = *(const u32x4*)(gsrc + (size_t)(n + 2) * OP_BLK_BYTES + (size_t)i * 16); } } }
        if (wave < 2) {
            const int it = wave; bf16x8 qf[3];
#pragma unroll
            for (int ks = 0; ks < 3; ++ks) qf[ks] = *(GLAS bf16x8*)(lds + BO + OP_QE + (32 * it + r32) * 112 + (16 * ks + 8 * hi) * 2);
            f32x16 acc[3];
#pragma unroll
            for (int vt = 0; vt < 3; ++vt)
#pragma unroll
                for (int r = 0; r < 16; ++r) acc[vt][r] = 0.f;
#pragma unroll
            for (int jt = 0; jt < 2; ++jt) if (jt <= it) {
                f32x16 X;
#pragma unroll
                for (int r = 0; r < 16; ++r) X[r] = 0.f;
#pragma unroll
                for (int ks = 0; ks < 3; ++ks) { const bf16x8 kf = *(GLAS bf16x8*)(lds + BO + OP_KE + (32 * jt + r32) * 112 + (16 * ks + 8 * hi) * 2); X = __builtin_amdgcn_mfma_f32_32x32x16_bf16(kf, qf[ks], X, 0, 0, 0); }
                if (jt == it) {
#pragma unroll
                    for (int r = 0; r < 16; ++r) if (crow(r, hi) > r32) X[r] = 0.f; }
                u32x4 p0, p1;
#pragma unroll
                for (int k = 0; k < 4; ++k) { p0[k] = cvtpk(X[2 * k], X[2 * k + 1]); p1[k] = cvtpk(X[8 + 2 * k], X[8 + 2 * k + 1]); }
                const bf16x8 pa0 = __builtin_bit_cast(bf16x8, p0), pa1 = __builtin_bit_cast(bf16x8, p1);
#pragma unroll
                for (int vt = 0; vt < 3; ++vt)
#pragma unroll
                    for (int s = 0; s < 2; ++s) { const int vo = BO + OP_VT + (32 * vt + r32) * 144 + (32 * jt + 16 * s + 4 * hi) * 2;
                        const s16x4 lo = *(GLAS s16x4*)(lds + vo), hi4 = *(GLAS s16x4*)(lds + vo + 16);
                        const bf16x8 a2 = (bf16x8){lo[0], lo[1], lo[2], lo[3], hi4[0], hi4[1], hi4[2], hi4[3]};
                        acc[vt] = __builtin_amdgcn_mfma_f32_32x32x16_bf16(a2, s ? pa1 : pa0, acc[vt], 0, 0, 0); }
            }
#pragma unroll
            for (int vt = 0; vt < 3; ++vt)
#pragma unroll
                for (int ks = 0; ks < 3; ++ks) { const bf16x8 sf = *(GLAS bf16x8*)(lds + SQ_ST + cur * ST_BYTES + (32 * vt + r32) * 112 + (16 * ks + 8 * hi) * 2); acc[vt] = __builtin_amdgcn_mfma_f32_32x32x16_bf16(sf, qf[ks], acc[vt], 0, 0, 0); }
            float ss = 0.f;
#pragma unroll
            for (int vt = 0; vt < 3; ++vt)
#pragma unroll
                for (int r = 0; r < 16; ++r) ss += acc[vt][r] * acc[vt][r];
            ss += __builtin_bit_cast(float, __builtin_amdgcn_ds_bpermute((lane ^ 32) << 2, __builtin_bit_cast(int, ss)));
            const float rn = 1.0f / sqrtf(ss * (1.0f / 96.0f) + EPS);
            GLAS unsigned char* ob = lds + SQ_OB + cur * SQ_OB_BYTES + (32 * it + r32) * 192;
#pragma unroll
            for (int vt = 0; vt < 3; ++vt)
#pragma unroll
                for (int g = 0; g < 4; ++g) { const int v0 = 32 * vt + 8 * g + 4 * hi;
                    *(GLAS u32x2*)(ob + v0 * 2) = (u32x2){cvtpk(acc[vt][4 * g] * rn, acc[vt][4 * g + 1] * rn), cvtpk(acc[vt][4 * g + 2] * rn, acc[vt][4 * g + 3] * rn)}; }
        } else if (wave < 5) {
            const int sw = wave - 2;
#pragma unroll
            for (int mt = 0; mt < 2; ++mt)
#pragma unroll
                for (int nt = 0; nt < 3; ++nt) { const int d = 16 * nt + l15; const float dec = ((GLAS float*)(lds + BO + OP_DEC))[d]; f32x4 a = S[mt][nt] * dec;
#pragma unroll
                    for (int ks = 0; ks < 2; ++ks) { const bf16x8 va = *(GLAS bf16x8*)(lds + BO + OP_VT + (32 * sw + 16 * mt + l15) * 144 + (32 * ks + 8 * quad) * 2), kb = *(GLAS bf16x8*)(lds + BO + OP_KDT + d * 144 + (32 * ks + 8 * quad) * 2);
                        a = __builtin_amdgcn_mfma_f32_16x16x32_bf16(va, kb, a, 0, 0, 0); }
                    S[mt][nt] = a;
#pragma unroll
                    for (int jj = 0; jj < 4; jj += 2) { const unsigned pk = cvtpk(a[jj], a[jj + 1]);
                        *(GLAS unsigned short*)(lds + SQ_ST + nxt * ST_BYTES + ((32 * sw + 16 * mt + 4 * quad + jj) * 56 + d) * 2) = (unsigned short)(pk & 0xffffu);
                        *(GLAS unsigned short*)(lds + SQ_ST + nxt * ST_BYTES + ((32 * sw + 16 * mt + 4 * quad + jj + 1) * 56 + d) * 2) = (unsigned short)(pk >> 16); } }
        } else if (n > 0) {
            GLA_EPILOGUE(n - 1);
        }
        __syncthreads();
    }
    if (wave >= 5) { GLA_EPILOGUE(SEQ / 64 - 1); }
    __syncthreads();
}
#undef GLA_EPILOGUE
#undef GLA_PCOL
#undef GLA_PDST
#undef GLAS
}
namespace poolb {
typedef short bf16x8 __attribute__((ext_vector_type(8)));
typedef float f32x16 __attribute__((ext_vector_type(16)));
typedef unsigned u32x4 __attribute__((ext_vector_type(4)));
typedef unsigned u32x2 __attribute__((ext_vector_type(2)));
typedef float f32x2_t __attribute__((ext_vector_type(2))); typedef __bf16 bf16x2_t __attribute__((ext_vector_type(2)));
#define PLAS __attribute__((address_space(3)))
constexpr int US_PITCH = 528  , US = 0, US_BYTES = 79 * US_PITCH  , PS = 41728, PS_PITCH = 144  , PS_WAVE = 32 * PS_PITCH  ,
              WT = PS + 8 * PS_WAVE  , WT_PITCH = 144, WT_GROUP = 64 * WT_PITCH  ;
__device__ __forceinline__ unsigned cvtpk(float lo, float hi) { f32x2_t v = {lo, hi}; bf16x2_t b = __builtin_convertvector(v, bf16x2_t); return __builtin_bit_cast(unsigned, b); }
__device__ __forceinline__ void pool_phase(const unsigned short* P, unsigned short* Y, const float* pw, const float* pscale, unsigned char* ldsg, int wg, int G, int tid) {
    PLAS unsigned char* lds = (PLAS unsigned char*)ldsg;
    const int lane = tid & 63, wave = __builtin_amdgcn_readfirstlane(tid >> 6), r32 = lane & 31, hi = lane >> 5, g = wave & 3, th = wave >> 2;
    __syncthreads();
    for (int i = tid; i < 4 * 64 * 64; i += NTHR) { const int gg = i >> 12, c = (i >> 6) & 63, d = i & 63; const float v = pw[i] * pscale[gg * 64 + d];
        *(PLAS unsigned short*)(lds + WT + gg * WT_GROUP + d * WT_PITCH + c * 2) = (unsigned short)(cvtpk(v, 0.f) & 0xffffu); }
    const int w = 2 << g;
    for (int tile = wg; tile < M / 64; tile += G) {
        const int m0 = tile * 64, t0 = m0 % SEQ;
        __syncthreads();
        for (int i = tid; i < 79 * 32; i += NTHR) { const int row = i >> 5, pc = i & 31; u32x4 v = {0u, 0u, 0u, 0u};
            if (t0 + row - 15 >= 0) v = *(const u32x4*)(P + (size_t)(m0 - 15 + row) * NP + N_PU + pc * 8);
            *(PLAS u32x4*)(lds + US + row * US_PITCH + pc * 16) = v; }
        __syncthreads();
        { float sum[32];
#pragma unroll
            for (int c = 0; c < 32; ++c) sum[c] = 0.f;
            const int tl = 32 * th + r32; const PLAS unsigned char* base = lds + US + (tl + 15) * US_PITCH + (g * 64 + 32 * hi) * 2;
            for (int j = 0; j < w; ++j) {
#pragma unroll
                for (int q4 = 0; q4 < 4; ++q4) { const u32x4 v = *(const PLAS u32x4*)(base - j * US_PITCH + q4 * 16);
#pragma unroll
                    for (int k = 0; k < 4; ++k) { const float lo = __uint_as_float(v[k] << 16), hh = __uint_as_float(v[k] & 0xffff0000u); sum[8 * q4 + 2 * k] += lo; sum[8 * q4 + 2 * k + 1] += hh; } } }
            const int pos = t0 + tl; const float inv = 1.0f / (float)((pos + 1 < w) ? pos + 1 : w);
            PLAS unsigned char* pd = lds + PS + wave * PS_WAVE + r32 * PS_PITCH + 32 * hi * 2;
#pragma unroll
            for (int q4 = 0; q4 < 4; ++q4) { u32x4 o; const u32x4 sv = *(const PLAS u32x4*)(base + q4 * 16);
#pragma unroll
                for (int k = 0; k < 4; ++k) o[k] = cvtpk(sum[8 * q4 + 2 * k] * inv - __uint_as_float(sv[k] << 16), sum[8 * q4 + 2 * k + 1] * inv - __uint_as_float(sv[k] & 0xffff0000u));
                *(PLAS u32x4*)(pd + q4 * 16) = o; } }
        asm volatile("s_waitcnt lgkmcnt(0)" ::: "memory");
        f32x16 acc[2];
#pragma unroll
        for (int dt = 0; dt < 2; ++dt) {
#pragma unroll
            for (int r = 0; r < 16; ++r) acc[dt][r] = 0.f;
#pragma unroll
            for (int ks = 0; ks < 4; ++ks) { const bf16x8 a = *(const PLAS bf16x8*)(lds + WT + g * WT_GROUP + (32 * dt + r32) * WT_PITCH + (16 * ks + 8 * hi) * 2), bq = *(const PLAS bf16x8*)(lds + PS + wave * PS_WAVE + r32 * PS_PITCH + (16 * ks + 8 * hi) * 2);
                acc[dt] = __builtin_amdgcn_mfma_f32_32x32x16_bf16(a, bq, acc[dt], 0, 0, 0); } }
        { const size_t m = (size_t)m0 + 32 * th + r32; const unsigned short* gp = P + m * NP + N_PG + g * 64; unsigned short* yp = Y + m * DM + 768 + g * 64;
#pragma unroll
            for (int dt = 0; dt < 2; ++dt)
#pragma unroll
                for (int g4 = 0; g4 < 4; ++g4) { const int d0 = 32 * dt + 8 * g4 + 4 * hi; const u32x2 gw = *(const u32x2*)(gp + d0);
                    const float g0 = __uint_as_float(gw[0] << 16), g1 = __uint_as_float(gw[0] & 0xffff0000u), g2 = __uint_as_float(gw[1] << 16), g3 = __uint_as_float(gw[1] & 0xffff0000u);
                    const float y0 = acc[dt][4 * g4] * (g0 / (1.0f + __expf(-g0))), y1 = acc[dt][4 * g4 + 1] * (g1 / (1.0f + __expf(-g1))), y2 = acc[dt][4 * g4 + 2] * (g2 / (1.0f + __expf(-g2))), y3 = acc[dt][4 * g4 + 3] * (g3 / (1.0f + __expf(-g3)));
                    *(u32x2*)(yp + d0) = (u32x2){cvtpk(y0, y1), cvtpk(y2, y3)}; } }
    }
    __syncthreads();
}
#undef PLAS
}
struct Args {
    const float* x; const float* norm_g; const float* w_in; const float* gate_w2; const float* gate_b; const float* gla_norm_g;
    const float* rel_bias; const float* pool_w; const float* pool_scale; const float* w_out; const float* final_g;
    float* out; unsigned char* ws;
    int l_lo, l_hi, ph_lo, ph_hi, single, pad;
};

__device__ __forceinline__ int src_col(int n, float& sc) {
    sc = 1.f;
    if (n < 192) { sc = 0.14433756729740643f; return n; }
    if (n < 768) return n;
    if (n < 1152) return 784 + (n - 768);
    if (n < 1536) { sc = 0.125f * LOG2E; return 1168 + (n - 1152); }
    if (n < 1920) return 1552 + (n - 1536);
    if (n < 2304) return 1936 + (n - 1920);
    if (n < 2688) return 2320 + (n - 2304);
    if (n < 2944) return 2868 + (n - 2688);
    if (n < 3200) return 3124 + (n - 2944);
    if (n < 3328) { sc = 0.17677669529663687f; return 2704 + (n - 3200); }
    if (n < 3360) return 2832 + (n - 3328);
    if (n < 3376) return 768 + (n - 3360);
    if (n < 3380) { sc = 0.5f; return 2864 + (n - 3376); }
    return -1;
}
__device__ __forceinline__ void prologue_phase(const Args& a, int wg, int G, int tid) {
    bf16* WIN = (bf16*)(a.ws + WS_WIN); bf16* WOUT = (bf16*)(a.ws + WS_WOUT);
    const long gt = (long)wg * NTHR + tid, gs = (long)G * NTHR;
    for (long i = gt; i < 4L * NP * 128; i += gs) {
        const int n = (int)(i % NP), k8 = (int)((i / NP) % 128), l = (int)(i / ((long)NP * 128));
        float sc; const int c = src_col(n, sc);
        v4u o = {0u, 0u, 0u, 0u};
        if (c >= 0) { const float* w = a.w_in + ((size_t)l * 1024 + k8 * 8) * IN_COLS + c; float v[8];
#pragma unroll
            for (int j = 0; j < 8; ++j) v[j] = w[(size_t)j * IN_COLS] * sc * a.norm_g[l * 1024 + k8 * 8 + j];
            o.x = pk2(v[0], v[1]); o.y = pk2(v[2], v[3]); o.z = pk2(v[4], v[5]); o.w = pk2(v[6], v[7]); }
        *(v4u*)(WIN + ((size_t)l * NP + n) * 1024 + k8 * 8) = o;
    }
    for (long i = gt; i < 4L * 1024 * 128; i += gs) {
        const int n = (int)(i % 1024), k8 = (int)((i / 1024) % 128), l = (int)(i / (1024L * 128));
        const float* w = a.w_out + ((size_t)l * 1024 + k8 * 8) * 1024 + n; float v[8];
#pragma unroll
        for (int j = 0; j < 8; ++j) v[j] = w[(size_t)j * 1024];
        v4u o; o.x = pk2(v[0], v[1]); o.y = pk2(v[2], v[3]); o.z = pk2(v[4], v[5]); o.w = pk2(v[6], v[7]);
        *(v4u*)(WOUT + ((size_t)l * 1024 + n) * 1024 + k8 * 8) = o;
    }
    { bf16* XA = (bf16*)(a.ws + WS_XA); float* RS = (float*)(a.ws + WS_RS); const int lane = tid & 63;
        for (int m = wg * NWAVES + (tid >> 6); m < M; m += G * NWAVES) { const f32x4* xr = (const f32x4*)(a.x + (size_t)m * DM) + lane; v2u* o = (v2u*)(XA + (size_t)m * DM) + lane; float s = 0.f;
#pragma unroll
            for (int j = 0; j < 4; ++j) { const f32x4 v = xr[64 * j]; v2u w; w.x = pk2(v.x, v.y); w.y = pk2(v.z, v.w); o[64 * j] = w; s += (bflo(w.x) * bflo(w.x) + bfhi(w.x) * bfhi(w.x)) + (bflo(w.y) * bflo(w.y) + bfhi(w.y) * bfhi(w.y)); }
            s = wave_sum(s, lane); if (lane < 16) RS[(size_t)m * 16 + lane] = (lane == 0) ? s : 0.f; } }
}
__device__ __forceinline__ void norm_phase(const float* src, const float* g, bf16* dst, int gw, int NGW, int lane) {
    for (int m = gw; m < M; m += NGW) {
        const f32x4* xr = (const f32x4*)(src + (size_t)m * DM) + lane; f32x4 v[4]; float s = 0.f;
#pragma unroll
        for (int j = 0; j < 4; ++j) { v[j] = xr[64 * j]; s += (v[j].x * v[j].x + v[j].y * v[j].y) + (v[j].z * v[j].z + v[j].w * v[j].w); }
        const float r = 1.0f / sqrtf(wave_sum(s, lane) * (1.f / DM) + EPS);
        const f32x4* gr = (const f32x4*)g + lane; v2u* o = (v2u*)(dst + (size_t)m * DM) + lane;
#pragma unroll
        for (int j = 0; j < 4; ++j) { const f32x4 gv = gr[64 * j]; v2u w; w.x = pk2(v[j].x * r * gv.x, v[j].y * r * gv.y); w.y = pk2(v[j].z * r * gv.z, v[j].w * r * gv.w); o[64 * j] = w; }
    }
}
__device__ __forceinline__ void final_norm_phase(const bf16* xa, float* out, const float* g, const float* RS, int gw, int NGW, int lane) {
    for (int m = gw; m < M; m += NGW) {
        const v2u* xr = (const v2u*)(xa + (size_t)m * DM) + lane; f32x4* orow = (f32x4*)(out + (size_t)m * DM) + lane;
        const f32x4* rs = (const f32x4*)(RS + (size_t)m * 16); const f32x4 s0 = rs[0], s1 = rs[1], s2 = rs[2], s3 = rs[3];
        const float ss = (((s0[0] + s0[1]) + (s0[2] + s0[3])) + ((s1[0] + s1[1]) + (s1[2] + s1[3]))) + (((s2[0] + s2[1]) + (s2[2] + s2[3])) + ((s3[0] + s3[1]) + (s3[2] + s3[3])));
        const float r = 1.0f / sqrtf(ss * (1.f / DM) + EPS);
        const f32x4* gr = (const f32x4*)g + lane;
#pragma unroll
        for (int j = 0; j < 4; ++j) { const f32x4 gv = gr[64 * j]; const v2u w = xr[64 * j]; orow[64 * j] = (f32x4){bflo(w.x) * r * gv.x, bfhi(w.x) * r * gv.y, bflo(w.y) * r * gv.z, bfhi(w.y) * r * gv.w}; }
    }
}
__device__ __forceinline__ void rowscale_phase(const float* RS, float* RSC, int wg, int G, int tid) {
    for (int m = wg * NTHR + tid; m < M; m += G * NTHR) { const f32x4* rs = (const f32x4*)(RS + (size_t)m * 16); const f32x4 s0 = rs[0], s1 = rs[1], s2 = rs[2], s3 = rs[3];
        const float ss = (((s0[0] + s0[1]) + (s0[2] + s0[3])) + ((s1[0] + s1[1]) + (s1[2] + s1[3]))) + (((s2[0] + s2[1]) + (s2[2] + s2[3])) + ((s3[0] + s3[1]) + (s3[2] + s3[3])));
        RSC[m] = 1.0f / sqrtf(ss * (1.0f / 1024.0f) + EPS); }
}
__device__ __forceinline__ void pool_phase(const Args& a, int l, unsigned char* lds, int wg, int G, int tid) {
    float* wsm = (float*)lds; float* us = (float*)(lds + 16384); float* ps = (float*)(lds + 32768);
    const bf16* P = (const bf16*)(a.ws + WS_P); bf16* Y = (bf16*)(a.ws + WS_XB);
    for (int g = 0; g < 4; ++g) {
        __syncthreads();
        const float* pw = a.pool_w + (size_t)(l * 4 + g) * 4096;
        for (int i = tid; i < 4096; i += NTHR) wsm[i] = pw[i];
        const int w = 2 << g;
        for (int tile = wg; tile < M / 32; tile += G) {
            __syncthreads();
            const int m0 = tile * 32, t0 = m0 % SEQ;
            for (int i = tid; i < 47 * 64; i += NTHR) { const int r = i >> 6, c = i & 63; float v = 0.f;
                if (t0 + r - 15 >= 0) v = bf2f(P[(size_t)(m0 - 15 + r) * NP + N_PU + g * 64 + c]);
                us[i] = v; }
            __syncthreads();
            { const int t = tid >> 4, c4 = (tid & 15) * 4, pos = t0 + t; const int cnt = (pos + 1 < w) ? pos + 1 : w; const float inv = 1.0f / (float)cnt;
#pragma unroll
                for (int k = 0; k < 4; ++k) { const int c = c4 + k; float s = 0.f; for (int j = 0; j < w; ++j) s += us[(t + 15 - j) * 64 + c]; ps[t * 64 + c] = s * inv - us[(t + 15) * 64 + c]; } }
            __syncthreads();
            { const int t = tid >> 4, d4 = (tid & 15) * 4; float a0 = 0.f, a1 = 0.f, a2 = 0.f, a3 = 0.f;
                for (int c = 0; c < 64; ++c) { const float p = ps[t * 64 + c]; const f32x4 wv = *(const f32x4*)&wsm[c * 64 + d4]; a0 += p * wv.x; a1 += p * wv.y; a2 += p * wv.z; a3 += p * wv.w; }
                const size_t m = (size_t)m0 + t; const v2u gw2 = *(const v2u*)(P + m * NP + N_PG + g * 64 + d4);
                const float* scl = a.pool_scale + l * 256 + g * 64 + d4;
                const float y0 = a0 * scl[0] * silu_f(bflo(gw2.x)), y1 = a1 * scl[1] * silu_f(bfhi(gw2.x)), y2 = a2 * scl[2] * silu_f(bflo(gw2.y)), y3 = a3 * scl[3] * silu_f(bfhi(gw2.y));
                v2u o; o.x = pk2(y0, y1); o.y = pk2(y2, y3); *(v2u*)(Y + m * DM + 768 + g * 64 + d4) = o; }
        }
    }
    __syncthreads();
}
__device__ __forceinline__ void gla_rec_phase(const Args& a, int l, unsigned char* lds, int unit, int tid) {
    const int b = unit >> 2, h = unit & 3;
    float* qs = (float*)lds; float* ks = (float*)(lds + 12288); float* es = (float*)(lds + 24576); float* vs = (float*)(lds + 36864); float* os = (float*)(lds + 61440);
    float* w2s = (float*)(lds + 86016); float* bs = (float*)(lds + 89088); float* gzs = (float*)(lds + 89280);
    const bf16* P = (const bf16*)(a.ws + WS_P); bf16* Y = (bf16*)(a.ws + WS_XB);
    __syncthreads();
    for (int i = tid; i < 16 * 48; i += NTHR) { const int r = i / 48, d = i % 48; w2s[i] = a.gate_w2[(size_t)(l * 16 + r) * 192 + h * 48 + d]; }
    if (tid < 48) bs[tid] = a.gate_b[l * 192 + h * 48 + tid];
    float S[48];
#pragma unroll
    for (int d = 0; d < 48; ++d) S[d] = 0.f;
    for (int blk = 0; blk < SEQ / 64; ++blk) {
        const size_t m0 = (size_t)b * SEQ + (size_t)blk * 64;
        __syncthreads();
        for (int i = tid; i < 64 * 48; i += NTHR) { const int t = i / 48, d = i % 48; const bf16* row = P + (m0 + t) * NP; qs[i] = bf2f(row[N_GQ + h * 48 + d]); ks[i] = bf2f(row[N_GK + h * 48 + d]); }
        for (int i = tid; i < 64 * 96; i += NTHR) { const int t = i / 96, v = i % 96; vs[i] = bf2f(P[(m0 + t) * NP + N_GV + h * 96 + v]); }
        for (int i = tid; i < 64 * 16; i += NTHR) { const int t = i >> 4, r = i & 15; gzs[i] = bf2f(P[(m0 + t) * NP + N_GZ + r]); }
        __syncthreads();
        for (int i = tid; i < 64 * 48; i += NTHR) { const int t = i / 48, d = i % 48; float z = bs[d];
#pragma unroll
            for (int r = 0; r < 16; ++r) z += gzs[t * 16 + r] * w2s[r * 48 + d];
            const float ls = fminf(z, 0.f) - log1pf(__expf(-fabsf(z)));
            es[i] = __expf(ls * (1.0f / 16.0f)); }
        __syncthreads();
        if (tid < 96) { const int v = tid;
            for (int t = 0; t < 64; ++t) { const float vv = vs[t * 96 + v]; float o = 0.f;
#pragma unroll
                for (int d = 0; d < 48; ++d) { S[d] = es[t * 48 + d] * S[d] + ks[t * 48 + d] * vv; o += qs[t * 48 + d] * S[d]; }
                os[t * 96 + v] = o; } }
        __syncthreads();
        { const int t = tid >> 3, part = tid & 7; float ov[12]; float ss = 0.f;
#pragma unroll
            for (int k = 0; k < 12; ++k) { ov[k] = os[t * 96 + part * 12 + k]; ss += ov[k] * ov[k]; }
            { const int ln = tid & 63; ss += shx(ss, 1, ln); ss += shx(ss, 2, ln); ss += shx(ss, 4, ln); }
            const float r = 1.0f / sqrtf(ss * (1.0f / 96.0f) + EPS);
            const size_t m = m0 + t; const bf16* gp = P + m * NP + N_GG + h * 96 + part * 12; const float* ng = a.gla_norm_g + l * 96 + part * 12;
            unsigned* yo = (unsigned*)(Y + m * DM + h * 96 + part * 12);
#pragma unroll
            for (int k = 0; k < 12; k += 2) { const float y0 = ov[k] * r * ng[k] * silu_f(bf2f(gp[k])), y1 = ov[k + 1] * r * ng[k + 1] * silu_f(bf2f(gp[k + 1])); yo[k >> 1] = pk2(y0, y1); } }
    }
    __syncthreads();
}
template <bool BITS_ONLY> __device__ __forceinline__ void dsa_slow_query(const Args& a, unsigned char* lds, int b, int t, int tid) {
    const int lane = tid & 63, wave = tid >> 6;
    unsigned* sc = (unsigned*)lds; int* hist = (int*)(lds + 32768); int* sel = (int*)(lds + 33792); float* qf = (float*)(lds + 34816); float* wq = (float*)(lds + 35328);
    int* misc = (int*)(lds + 35344); float* qh = (float*)(lds + 35456); float* lg = (float*)(lds + 36992); float* inv = (float*)(lds + 43136);
    const bf16* P = (const bf16*)(a.ws + WS_P); bf16* Y = (bf16*)(a.ws + WS_XB);
    {
        const size_t m = (size_t)b * SEQ + t; const int N = t + 1;
        __syncthreads();
        if (tid < 128) qf[tid] = bf2f(P[m * NP + N_QI + tid]);
        if (tid >= 128 && tid < 132) wq[tid - 128] = bf2f(P[m * NP + N_WI + tid - 128]);
        for (int i = tid; i < 384; i += NTHR) qh[i] = bf2f(P[m * NP + N_DQ + i]);
        __syncthreads();
        for (int s = tid; s < N; s += NTHR) {
            const v4u* kr = (const v4u*)(P + ((size_t)b * SEQ + s) * NP + N_KI); float kf[32];
#pragma unroll
            for (int c = 0; c < 4; ++c) { const v4u w = kr[c]; kf[8 * c] = bflo(w.x); kf[8 * c + 1] = bfhi(w.x); kf[8 * c + 2] = bflo(w.y); kf[8 * c + 3] = bfhi(w.y); kf[8 * c + 4] = bflo(w.z); kf[8 * c + 5] = bfhi(w.z); kf[8 * c + 6] = bflo(w.w); kf[8 * c + 7] = bfhi(w.w); }
            float score = 0.f;
#pragma unroll
            for (int hh = 0; hh < 4; ++hh) { float dot = 0.f;
#pragma unroll
                for (int d = 0; d < 32; ++d) dot += qf[hh * 32 + d] * kf[d];
                score += wq[hh] * fmaxf(dot, 0.f); }
            const unsigned u = __builtin_bit_cast(unsigned, score);
            sc[s] = (u & 0x80000000u) ? ~u : (u | 0x80000000u);
        }
        __syncthreads();
        int L;
        if (N <= 256) { if (tid < N) sel[tid] = tid; L = N; }
        else {
            unsigned prefix = 0u; int kk = 256;
            for (int pass = 0; pass < 4; ++pass) {
                const int shift = 24 - 8 * pass;
                if (tid < 256) hist[tid] = 0;
                __syncthreads();
                for (int s = tid; s < N; s += NTHR) { const unsigned key = sc[s]; const bool match = (pass == 0) ? true : ((key >> ((shift + 8) & 31)) == prefix); if (match) atomicAdd(&hist[(key >> shift) & 255u], 1); }
                __syncthreads();
                if (wave == 0) {
                    const int c0 = hist[4 * lane], c1 = hist[4 * lane + 1], c2 = hist[4 * lane + 2], c3 = hist[4 * lane + 3]; const int tot = c0 + c1 + c2 + c3;
                    int incl = tot;
#pragma unroll
                    for (int o = 1; o < 64; o <<= 1) { const int tt = shdn(incl, o, lane); if (lane + o < 64) incl += tt; }
                    const int excl = incl - tot;
                    if (excl < kk && kk <= incl) { int above = excl, D;
                        if (above + c3 >= kk) D = 4 * lane + 3;
                        else { above += c3; if (above + c2 >= kk) D = 4 * lane + 2; else { above += c2; if (above + c1 >= kk) D = 4 * lane + 1; else { above += c1; D = 4 * lane; } } }
                        misc[1] = D; misc[2] = above; }
                }
                __syncthreads();
                prefix = (prefix << 8) | (unsigned)misc[1]; kk -= misc[2];
            }
            const unsigned tau = prefix;
            const int seg = (((N + 7) >> 3) + 63) & ~63; const int s_lo = wave * seg, s_hi = (s_lo + seg < N) ? s_lo + seg : N;
            { int cg = 0, ce = 0;
                for (int base = s_lo; base < s_hi; base += 64) { const int s = base + lane; const bool in = s < s_hi; const unsigned key = in ? sc[s] : 0u;
                    cg += __popcll(__ballot(in && key > tau)); ce += __popcll(__ballot(in && key == tau)); }
                if (lane == 0) { misc[4 + wave] = cg; misc[12 + wave] = ce; } }
            __syncthreads();
            { int bg = 0, be = 0;
                for (int w2 = 0; w2 < 8; ++w2) if (w2 < wave) { bg += misc[4 + w2]; be += misc[12 + w2]; }
                int run_sel = bg + (be < kk ? be : kk), run_eq = be;
                for (int base = s_lo; base < s_hi; base += 64) { const int s = base + lane; const bool in = s < s_hi; const unsigned key = in ? sc[s] : 0u;
                    const bool gt = in && key > tau, eq = in && key == tau; const unsigned long long me = __ballot(eq); const unsigned long long lt = (1ull << lane) - 1ull;
                    const bool take = gt || (eq && (run_eq + __popcll(me & lt) < kk)); const unsigned long long mt = __ballot(take);
                    if (take) sel[run_sel + __popcll(mt & lt)] = s;
                    run_sel += __popcll(mt); run_eq += __popcll(me); } }
            L = 256;
        }
        __syncthreads();
        if constexpr (BITS_ONLY) {
            unsigned* bm = (unsigned*)lg; unsigned* MK = (unsigned*)(a.ws + WS_MASK);
            if (tid < 256) bm[tid] = 0u;
            __syncthreads();
            if (tid < L) { const int s = sel[tid]; const int kt = s >> 6, kap = s & 63, half = kap >> 5, k5 = kap & 31, hi = (k5 >> 2) & 1, r = (k5 & 3) + 4 * (k5 >> 3);
                atomicOr(&bm[kt * 2 + hi], 1u << (r + 16 * half)); }
            __syncthreads();
            const int ntw = ((t >> 8) + 1) * 8;
            if (tid < ntw) { const int kt = tid >> 1, hi = tid & 1; MK[((size_t)(b * 256 + (t >> 5)) * 128 + kt) * 64 + (t & 31) + 32 * hi] = bm[tid]; }
            __syncthreads();
            return;
        }
        { const int j = tid >> 1, h0 = (tid & 1) * 3;
            if (j < L) { const int s = sel[j]; const size_t srow = (size_t)b * SEQ + s; const int bk = t5_bucket(t - s);
#pragma unroll
                for (int hh = 0; hh < 3; ++hh) { const int h = h0 + hh; const v4u* kr = (const v4u*)(P + srow * NP + N_DK + h * 64); const float* q = qh + h * 64; float dot = 0.f;
#pragma unroll
                    for (int c = 0; c < 8; ++c) { const v4u w = kr[c]; dot += q[8 * c] * bflo(w.x) + q[8 * c + 1] * bfhi(w.x) + q[8 * c + 2] * bflo(w.y) + q[8 * c + 3] * bfhi(w.y) + q[8 * c + 4] * bflo(w.z) + q[8 * c + 5] * bfhi(w.z) + q[8 * c + 6] * bflo(w.w) + q[8 * c + 7] * bfhi(w.w); }
                    lg[h * 256 + j] = dot + a.rel_bias[bk * 6 + h] * LOG2E; } }
            else {
#pragma unroll
                for (int hh = 0; hh < 3; ++hh) lg[(h0 + hh) * 256 + j] = -INFINITY; } }
        __syncthreads();
        if (wave < 6) { float* row = lg + wave * 256; float v0 = row[lane], v1 = row[lane + 64], v2 = row[lane + 128], v3 = row[lane + 192];
            float mx = fmaxf(fmaxf(v0, v1), fmaxf(v2, v3));
#pragma unroll
            for (int o = 1; o < 64; o <<= 1) mx = fmaxf(mx, shx(mx, o, lane));
            v0 = exp2f(v0 - mx); v1 = exp2f(v1 - mx); v2 = exp2f(v2 - mx); v3 = exp2f(v3 - mx);
            const float sm = wave_sum((v0 + v1) + (v2 + v3), lane);
            row[lane] = v0; row[lane + 64] = v1; row[lane + 128] = v2; row[lane + 192] = v3;
            if (lane == 0) inv[wave] = 1.0f / sm; }
        __syncthreads();
        if (tid < 384) { const int h = tid >> 6, d = tid & 63; float acc = 0.f; const bf16* vb = P + (size_t)b * SEQ * NP + N_DV + h * 64 + d;
            for (int j = 0; j < L; ++j) acc += lg[h * 256 + j] * bf2f(vb[(size_t)sel[j] * NP]);
            const float o = acc * inv[h]; const float gate = bf2f(P[m * NP + N_DG + h * 64 + d]);
            Y[m * DM + 384 + h * 64 + d] = (bf16)f2bf(o * silu_f(gate)); }
    }
    __syncthreads();
}
template <bool BITS_ONLY> __device__ __forceinline__ void dsa_slow_phase(const Args& a, int l, unsigned char* lds, int wg, int G, int tid) {
    for (int qi = wg; qi < M; qi += G) { asm volatile("" : "+v"(tid)); dsa_slow_query<BITS_ONLY>(a, lds, qi & 7, qi >> 3, tid); }
}
__device__ __forceinline__ void index_phase(const Args& a, unsigned char* lds, unsigned* qctr, volatile LAS unsigned* MISC, int tid) {
    const unsigned short* P = (const unsigned short*)(a.ws + WS_P); unsigned* MK = (unsigned*)(a.ws + WS_MASK);
    __syncthreads();
    if (tid <= 256) ((float*)(lds + idxb::L_XT))[tid] = tid < 256 ? idxb::xthr(tid) : __builtin_inff();
    int bq = blockIdx.x & 7, tries = 0;
    for (;;) {
        asm volatile("" : "+v"(tid));
        __syncthreads();
        if (tid == 0) MISC[17] = __hip_atomic_fetch_add(qctr + 64 * bq, 1u, __ATOMIC_RELAXED, __HIP_MEMORY_SCOPE_AGENT);
        __syncthreads();
        const int k = (int)MISC[17];
        if (k >= 256) { if (++tries == 8) break; bq = (bq + 1) & 7; continue; }
        const int b = bq, qt = 255 - k;
        idxb::index_unit(P, (const unsigned short*)(a.ws + WS_KC), MK, (unsigned*)(a.ws + WS_ZW) + (size_t)blockIdx.x * 128 * 64, lds, b, qt, tid);
        const int* par = (const int*)(lds + idxb::L_PAR);
        if (par[idxb::P_ANY3 * 32]) for (int q = 0; q < 32; ++q) if (par[idxb::P_MODE * 32 + q] == 3) dsa_slow_query<true>(a, lds, b, qt * 32 + q, tid);
    }
}
#ifndef REP_POOL
#define REP_POOL 1
#endif
#ifndef ATT_PRIO
#define ATT_PRIO 0
#endif
#ifndef REP_IDX
#define REP_IDX 1
#endif
#ifndef REP_GLA
#define REP_GLA 1
#endif
#ifndef REP_ATT
#define REP_ATT 1
#endif
#ifndef REP_PREP
#define REP_PREP 1
#endif
#ifndef REP_PRO
#define REP_PRO 1
#endif
#ifndef REP_NORM
#define REP_NORM 1
#endif
#ifndef REP_ALL
#define REP_ALL 1
#endif
#ifndef REP_BAR
#define REP_BAR 1
#endif
#ifndef REP_OUT
#define REP_OUT 1
#endif
#ifndef REP_INP
#define REP_INP 1
#endif
#ifndef GLA_MODE
#define GLA_MODE 1
#endif
#ifndef DSA_MODE
#define DSA_MODE 2
#endif
#ifndef MK_SINGLE
#define MK_SINGLE 1
#endif
__global__ void __launch_bounds__(NTHR, 2) fwd(Args a) {
    extern __shared__ __attribute__((aligned(16))) unsigned char lds[];
    int tid = threadIdx.x, lane = tid & 63, wave = __builtin_amdgcn_readfirstlane(tid >> 6);
    int G = gridDim.x, wg = blockIdx.x;
    const int wave0 = __builtin_amdgcn_readfirstlane(tid >> 6);
#define LAUNDER() do { { int wv_ = wave0; asm volatile("" : "+s"(wv_)); unsigned on_ = ~0u; asm volatile("" : "+s"(on_)); tid = wv_ * 64 + (int)__builtin_amdgcn_mbcnt_hi(on_, __builtin_amdgcn_mbcnt_lo(on_, 0u)); asm volatile("" : "+v"(tid)); } wg = blockIdx.x; G = gridDim.x; asm volatile("" : "+s"(wg), "+s"(G));     \
    lane = tid & 63; wave = __builtin_amdgcn_readfirstlane(tid >> 6); gw = wg * NWAVES + wave; NGW = G * NWAVES; } while (0)
    volatile LAS unsigned* MISC = (volatile LAS unsigned*)((LAS unsigned char*)lds + MISC_OFF);
    for (int u = tid; u < (LDS_BYTES - LDSCTL_OFF) / 4; u += NTHR) ((LAS unsigned*)((LAS unsigned char*)lds + LDSCTL_OFF))[u] = 0u;
    __syncthreads();
    XcdBarrier bar; bar.bar = (unsigned*)(a.ws + WS_CTL) + CW_BAR; bar.x = 0; bar.st = nullptr;
    const bool one = a.single != 0;
    if (one) bar = xcd_barrier_post((unsigned*)(a.ws + WS_CTL) + CW_BAR, MISC + 8);
#define IN(k) (a.ph_lo <= (k) && (k) < a.ph_hi)
#define SEAM() do { if (one) { unsigned* bp_ = (unsigned*)(a.ws + WS_CTL) + CW_BAR; asm volatile("" : "+s"(bp_)); XcdBarrier bb_; bb_.bar = bp_; bb_.x = bar.x; bb_.st = bar.st; xcd_barrier(bb_); if (REP_BAR == 2) xcd_barrier(bb_); } } while (0)
    int gw = wg * NWAVES + wave, NGW = G * NWAVES;
    bf16* XB = (bf16*)(a.ws + WS_XB); bf16* PB = (bf16*)(a.ws + WS_P);
    for (int rpw = 0; rpw < REP_ALL; ++rpw) {
    LAUNDER();
    if (IN(0)) { for (int rp = 0; rp < REP_PRO; ++rp) prologue_phase(a, wg, G, tid); SEAM(); }
    for (int l = a.l_lo; l < a.l_hi; ++l) {
        LAUNDER();
        if (IN(1)) { rowscale_phase((const float*)(a.ws + WS_RS), (float*)(a.ws + WS_RSC), wg, G, tid); SEAM(); }
        LAUNDER();
        if (IN(2)) {
            pg8::Gemm g{(const bf16*)(a.ws + WS_XA), (const bf16*)(a.ws + WS_WIN) + (size_t)l * NP * 1024, M, NP, DM}; pg8::StaticOrder S; S.init(M, NP, G, wg);
            pg8::EpiP E{PB, NP, (const float*)(a.ws + WS_RSC), (pg8::bf16_t*)(a.ws + WS_KC)};
            pg8::gemm_phase<pg8::EpiP, pg8::StaticOrder, true, true>((PG8_LAS unsigned char*)lds, g, S, E, tid);
#if REP_INP == 2
            asm volatile("" : "+v"(tid)); __syncthreads(); pg8::gemm_phase<pg8::EpiP, pg8::StaticOrder, true, true>((PG8_LAS unsigned char*)lds, g, S, E, tid);
#endif
            SEAM();
        }
        LAUNDER();
        if (IN(3)) {
#if GLA_MODE == 0
            if (wg < 32) gla_rec_phase(a, l, lds, wg, tid);
#endif
            for (int rp = 0; rp < REP_POOL; ++rp) { asm volatile("" : "+v"(tid)); poolb::pool_phase(PB, XB, a.pool_w + (size_t)l * 4 * 4096, a.pool_scale + l * 256, lds, wg, G, tid); }
#if GLA_MODE == 1
            glab::gla_prep_loop(PB, a.ws + WS_GOP, a.gate_w2 + (size_t)l * 16 * 192, a.gate_b + l * 192, lds, wg, G, tid);
#if REP_PREP == 2
            __syncthreads(); asm volatile("" : "+v"(tid), "+s"(wg));
            for (int item = wg; item < BATCH * 4 * 128; item += G) { asm volatile("" : "+v"(tid)); glab::gla_prep_item(PB, a.ws + WS_GOP, a.gate_w2 + (size_t)l * 16 * 192, a.gate_b + l * 192, lds, item, tid); }
#endif
            __syncthreads();
#endif
#if DSA_MODE == 0
            dsa_slow_phase<false>(a, l, lds, wg, G, tid);
#elif DSA_MODE == 1
            dsa_slow_phase<true>(a, l, lds, wg, G, tid);
#else
            for (int rp = 0; rp < REP_IDX; ++rp) { asm volatile("" : "+v"(tid)); index_phase(a, lds, (unsigned*)(a.ws + WS_CTL) + CW_QUEUE + 64 * (32 + 8 * (l + 4 * rp + 8 * rpw)), MISC, tid); }
#endif
            SEAM();
        }
        LAUNDER();
        if (IN(4)) {
#if DSA_MODE >= 1
            { float* dl = (float*)(lds + 86016);
                for (int i = tid; i < 1032; i += NTHR) { const int rel = i >> 3, h = i & 7; dl[i] = (h < 6 && rel < 128) ? (a.rel_bias[(int)T5B[rel] * 6 + h] - a.rel_bias[31 * 6 + h]) * LOG2E : 0.f; } for (int i = tid; i < 512; i += NTHR) { const unsigned nb = ((unsigned)(i >> 1) >> (4 * (i & 1))) & 15u; ((unsigned*)(lds + attn_body::LDS_TAB))[i] = (nb & 1u ? 0xffu : 0u) | (nb & 2u ? 0xff00u : 0u) | (nb & 4u ? 0xff0000u : 0u) | (nb & 8u ? 0xff000000u : 0u); }
                __syncthreads();
                const attn_body::AttnTensors AT{(const attn_body::bf16*)(PB + N_DQ), (const attn_body::bf16*)(PB + N_DK), (const attn_body::bf16*)(PB + N_DV), (attn_body::bf16*)(XB + 384), (const attn_body::bf16*)(PB + N_DG), (const unsigned*)(a.ws + WS_MASK)};
#if GLA_MODE == 1
                if (wg < 32) { glab::gla_seq_unit(PB, XB, a.ws + WS_GOP, a.gla_norm_g + l * 96, lds, wg >> 2, wg & 3, tid);
#if REP_GLA == 2
                    asm volatile("" : "+v"(tid)); glab::gla_seq_unit(PB, XB, a.ws + WS_GOP, a.gla_norm_g + l * 96, lds, wg >> 2, wg & 3, tid);
#endif
                    for (int i = tid; i < 1032; i += NTHR) { const int rel = i >> 3, h = i & 7; dl[i] = (h < 6 && rel < 128) ? (a.rel_bias[(int)T5B[rel] * 6 + h] - a.rel_bias[31 * 6 + h]) * LOG2E : 0.f; } for (int i = tid; i < 512; i += NTHR) { const unsigned nb = ((unsigned)(i >> 1) >> (4 * (i & 1))) & 15u; ((unsigned*)(lds + attn_body::LDS_TAB))[i] = (nb & 1u ? 0xffu : 0u) | (nb & 2u ? 0xff00u : 0u) | (nb & 4u ? 0xff0000u : 0u) | (nb & 8u ? 0xff000000u : 0u); }
                    __syncthreads(); }
#endif
#if ATT_PRIO
                if (__builtin_amdgcn_readfirstlane(tid) >= 256) __builtin_amdgcn_s_setprio(1);
#endif
                for (int rp = 0; rp < REP_ATT; ++rp) { unsigned* qctr = (unsigned*)(a.ws + WS_CTL) + CW_QUEUE + 64 * (l * 4 + rp + 2 * rpw);
                for (;;) { asm volatile("" : "+v"(tid));
                    __syncthreads();
                    if (tid == 0) MISC[16] = __hip_atomic_fetch_add(qctr, 1u, __ATOMIC_RELAXED, __HIP_MEMORY_SCOPE_AGENT);
                    __syncthreads();
                    const int k = (int)MISC[16];
                    if (k >= 48 * 32) break;
                    const int qb = 31 - k / 48, bh = k % 48;
                    attn_body::attn_unit<24>(bh / 6, bh % 6, qb, AT.Q, AT.K, AT.V, AT.O, AT.GT, AT.MK, (attn_body::lds_cfptr)(LAS const float*)((LAS unsigned char*)lds + 86016), (char*)lds, tid); } }
#if ATT_PRIO
                __builtin_amdgcn_s_setprio(0);
#endif
            }
#endif
            SEAM();
        }
        LAUNDER();
        if (IN(5)) {
            pg8::Gemm g{XB, (const bf16*)(a.ws + WS_WOUT) + (size_t)l * 1024 * 1024, M, DM, DM}; pg8::StaticOrder S; S.init(M, DM, G, wg);
            pg8::EpiRes E{(bf16*)(a.ws + WS_XA), DM, (float*)(a.ws + WS_RS)};
            pg8::gemm_phase<pg8::EpiRes, pg8::StaticOrder, true, true>((PG8_LAS unsigned char*)lds, g, S, E, tid);
#if REP_OUT == 2
            { asm volatile("" : "+v"(tid)); __syncthreads(); pg8::EpiRes E2{(bf16*)(a.ws + WS_P), DM, (float*)(a.ws + WS_P) + (size_t)M * DM}; pg8::gemm_phase<pg8::EpiRes, pg8::StaticOrder, true, true>((PG8_LAS unsigned char*)lds, g, S, E2, tid); }
#endif
            SEAM();
        }
    }
    }
    LAUNDER();
    if (IN(6)) final_norm_phase((const bf16*)(a.ws + WS_XA), a.out, a.final_g, (const float*)(a.ws + WS_RS), gw, NGW, lane);
#undef IN
#undef SEAM
}

extern "C" void kernel_launch(void* const* d_in, const int* in_sizes, int n_in, void* d_out, int out_size, void* d_ws, size_t ws_size, hipStream_t stream) {
    static int grid = 0;
    if (grid == 0) {
        if (n_in != 11 || in_sizes[0] != M * DM || out_size != M * DM || ws_size < WS_END) { fprintf(stderr, "kernel_launch: unexpected shapes (n_in %d, in0 %d, out %d, ws %zu); nothing launched\n", n_in, n_in > 0 ? in_sizes[0] : -1, out_size, ws_size); grid = -1; return; }
        int dev = 0, cus = 0, per_cu = 0;
        if (hipGetDevice(&dev) != hipSuccess || hipDeviceGetAttribute(&cus, hipDeviceAttributeMultiprocessorCount, dev) != hipSuccess) { grid = -1; return; }
        if (hipFuncSetAttribute((const void*)fwd, hipFuncAttributeMaxDynamicSharedMemorySize, LDS_BYTES) != hipSuccess) { fprintf(stderr, "kernel_launch: hipFuncSetAttribute failed\n"); grid = -1; return; }
        if (hipOccupancyMaxActiveBlocksPerMultiprocessor(&per_cu, (const void*)fwd, NTHR, LDS_BYTES) != hipSuccess || per_cu < 1) fprintf(stderr, "kernel_launch: occupancy query reports %d\n", per_cu);
        (void)hipGetLastError();
        grid = cus;
    }
    if (grid < 0) return;
    if (hipMemsetAsync((char*)d_ws + WS_CTL, 0, CTL_ZERO_BYTES, stream) != hipSuccess) return;
    Args a{};
    a.x = (const float*)d_in[0]; a.norm_g = (const float*)d_in[1]; a.w_in = (const float*)d_in[2]; a.gate_w2 = (const float*)d_in[3]; a.gate_b = (const float*)d_in[4]; a.gla_norm_g = (const float*)d_in[5];
    a.rel_bias = (const float*)d_in[6]; a.pool_w = (const float*)d_in[7]; a.pool_scale = (const float*)d_in[8]; a.w_out = (const float*)d_in[9]; a.final_g = (const float*)d_in[10];
    a.out = (float*)d_out; a.ws = (unsigned char*)d_ws; a.pad = 0;
#if MK_SINGLE
    a.l_lo = 0; a.l_hi = DEPTH; a.ph_lo = 0; a.ph_hi = 7; a.single = 1;
    hipLaunchKernelGGL(fwd, dim3(grid), dim3(NTHR), LDS_BYTES, stream, a);
#else
    a.single = 0;
    a.l_lo = 0; a.l_hi = 0; a.ph_lo = 0; a.ph_hi = 1; hipLaunchKernelGGL(fwd, dim3(grid), dim3(NTHR), LDS_BYTES, stream, a);
    for (int l = 0; l < DEPTH; ++l) for (int ph = 1; ph <= 5; ++ph) { a.l_lo = l; a.l_hi = l + 1; a.ph_lo = ph; a.ph_hi = ph + 1; hipLaunchKernelGGL(fwd, dim3(grid), dim3(NTHR), LDS_BYTES, stream, a); }
    a.l_lo = 0; a.l_hi = 0; a.ph_lo = 6; a.ph_hi = 7; hipLaunchKernelGGL(fwd, dim3(grid), dim3(NTHR), LDS_BYTES, stream, a);
#endif
    const hipError_t le = hipPeekAtLastError();
    if (le != hipSuccess) fprintf(stderr, "kernel_launch: launch failed: %s\n", hipGetErrorName(le));
}
```

```cpp
#include <hip/hip_runtime.h>
#include <cstdio>
#include <cstdint>
namespace pg8 {
#define PG8_LAS __attribute__((address_space(3)))
typedef unsigned short bf16_t;
typedef short bf16x8 __attribute__((ext_vector_type(8)));
typedef float f32x4 __attribute__((ext_vector_type(4)));
typedef unsigned u32x4 __attribute__((ext_vector_type(4)));
constexpr int BM = 256, BK = 64, HALF = 128, HTB = HALF * BK * 2  , STAGE_BYTES = 8 * HTB, NXCD = 8, WGM = 8;

__host__ __device__ __forceinline__ int lds_byte(int r, int c) { const int st = (r >> 4) * 2 + (c >> 5), rr = r & 15, cc = c & 31, ob = rr * 64 + cc * 2; return st * 1024 + (ob ^ (((ob >> 9) & 1) << 5)); }
__host__ __device__ __forceinline__ void stage_rc(int b, int& R, int& C) { const int st = b / 1024, sb = b % 1024, swz = sb ^ (((sb >> 9) & 1) << 5); R = (st >> 1) * 16 + swz / 64; C = (st & 1) * 32 + (swz % 64) / 2; }
__host__ __device__ __forceinline__ int perm32(int rho) { const int n = rho >> 4, i = rho & 15; return 8 * (i >> 2) + 4 * n + (i & 3); }

struct Unit { int pm, pn; };
struct Gemm { const bf16_t* A; const bf16_t* Bt; int M, N, K; };

struct StaticOrder {
    int nM, nN, nwg, G, c;
    __host__ __device__ void init(int M, int N, int G_, int c_) { nM = M / BM; nN = N / BM; nwg = nM * nN; G = G_; c = c_; }
    __host__ __device__ bool next(int i, Unit& u) const {
        const long L = (long)i * G + c; if (L >= nwg) return false;
        int wgid = (int)L; { const int q = nwg / NXCD, r = nwg % NXCD, xcd = wgid % NXCD, off = wgid / NXCD; wgid = (xcd < r ? xcd * (q + 1) : r * (q + 1) + (xcd - r) * q) + off; }
        const int nig = WGM * nN, gid = wgid / nig, fm = gid * WGM, gsz = (nM - fm) < WGM ? (nM - fm) : WGM;
        u.pm = fm + ((wgid % nig) % gsz); u.pn = (wgid % nig) / gsz; return true;
    }
    __device__ __forceinline__ void a_ready(const Unit&) const {}
    __device__ __forceinline__ void done(const Unit&) const {}
};

__device__ __forceinline__ unsigned cvt_pk_bf16(float lo, float hi) { unsigned r; asm volatile("v_cvt_pk_bf16_f32 %0, %1, %2" : "=v"(r) : "v"(lo), "v"(hi)); return r; }
typedef float f32x2 __attribute__((ext_vector_type(2)));
struct EpiP {
    static constexpr bool PERM = true, AFTER_DRAIN = false;
    bf16_t* O; int ldc; const float* RS; bf16_t* KC;
    __device__ __forceinline__ void operator()(const f32x4 (&acc)[2][2][4][2], const Unit& u, int wr, int wc, int fr, int fq) const {
        const int row0 = u.pm * BM + wr * 64 + fr, col0 = u.pn * BM + wc * 32 + 8 * fq;
        float rr[2][4];
#pragma unroll
        for (int ai = 0; ai < 2; ++ai)
#pragma unroll
            for (int m = 0; m < 4; ++m) rr[ai][m] = RS[row0 + ai * HALF + m * 16];
#pragma unroll
        for (int ai = 0; ai < 2; ++ai)
#pragma unroll
            for (int m = 0; m < 4; ++m) { const int row = row0 + ai * HALF + m * 16; bf16_t* rowp = O + (size_t)row * ldc + col0;
                const float r = rr[ai][m];
#pragma unroll
                for (int bj = 0; bj < 2; ++bj) { const f32x4 v0 = acc[ai][bj][m][0] * r, v1 = acc[ai][bj][m][1] * r;
                    u32x4 w; w.x = cvt_pk_bf16(v0[0], v0[1]); w.y = cvt_pk_bf16(v0[2], v0[3]); w.z = cvt_pk_bf16(v1[0], v1[1]); w.w = cvt_pk_bf16(v1[2], v1[3]);
                    if (col0 + bj * HALF < 3384) *(u32x4*)(rowp + bj * HALF) = w;
                    if (bj == 0 && wc == 0 && u.pn == 13) *(u32x4*)(KC + (size_t)row * 32 + 8 * fq) = w; } }
    }
};
struct EpiRes {
    static constexpr bool PERM = true, AFTER_DRAIN = false;
    bf16_t* XA; int ldc; float* RS;
    __device__ __forceinline__ void operator()(const f32x4 (&acc)[2][2][4][2], const Unit& u, int wr, int wc, int fr, int fq) const {
        const int row0 = u.pm * BM + wr * 64 + fr, col0 = u.pn * BM + wc * 32 + 8 * fq, lane = fr + 16 * fq;
#pragma unroll
        for (int ai = 0; ai < 2; ++ai) { u32x4 rb[4][2];
#pragma unroll
            for (int m = 0; m < 4; ++m)
#pragma unroll
                for (int bj = 0; bj < 2; ++bj) rb[m][bj] = *(const u32x4*)(XA + (size_t)(row0 + ai * HALF + m * 16) * ldc + col0 + bj * HALF);
#pragma unroll
            for (int m = 0; m < 4; ++m) { const int row = row0 + ai * HALF + m * 16; const size_t off = (size_t)row * ldc + col0; float s = 0.f;
#pragma unroll
                for (int bj = 0; bj < 2; ++bj) { const u32x4 b = rb[m][bj]; u32x4 w;
#pragma unroll
                    for (int k = 0; k < 4; ++k) { const float lo = __uint_as_float(b[k] << 16) + acc[ai][bj][m][k >> 1][2 * (k & 1)], hi = __uint_as_float(b[k] & 0xffff0000u) + acc[ai][bj][m][k >> 1][2 * (k & 1) + 1];
                        w[k] = cvt_pk_bf16(lo, hi); const float rl = __uint_as_float(w[k] << 16), rh = __uint_as_float(w[k] & 0xffff0000u); s += rl * rl + rh * rh; }
                    *(u32x4*)(XA + off + bj * HALF) = w; }
                s += __builtin_bit_cast(float, __builtin_amdgcn_ds_bpermute((lane ^ 16) << 2, __builtin_bit_cast(int, s)));
                s += __builtin_bit_cast(float, __builtin_amdgcn_ds_bpermute((lane ^ 32) << 2, __builtin_bit_cast(int, s)));
                if (fq == 0) RS[(size_t)row * 16 + u.pn * 4 + wc] = s; } }
    }
};
template <class Epi, class Sched, bool ALIGN_EPI = false, bool SP2 = false>
__device__ __forceinline__ void gemm_phase(PG8_LAS unsigned char* lds, const Gemm g, const Sched& S, const Epi& E, const int tid) {
    const int wid = __builtin_amdgcn_readfirstlane(tid >> 6), lane = tid & 63, wr = wid >> 2, wc = wid & 3, fr = lane & 15, fq = lane >> 4;
    const int K = g.K, nt = K / BK;
    unsigned voffA[2], voffB[2];
#pragma unroll
    for (int i = 0; i < 2; ++i) { int R, C; stage_rc(tid * 16 + i * 8192, R, C); const int Rb = Epi::PERM ? ((R & ~31) + perm32(R & 31)) : R;
        voffA[i] = (unsigned)(R * K + C) * 2u; voffB[i] = (unsigned)(Rb * K + C) * 2u; }
    const size_t kstep = (size_t)(BK * 2);
    const size_t hstep = (size_t)HALF * K * 2;
    const size_t tstep = 2 * hstep;
    const unsigned ldsw = (unsigned)wid * 1024u;
    const int aoff = lds_byte(wr * 64 + fr, fq * 8), boff = lds_byte(wc * 32 + fr, fq * 8);
#define PG8_SA(b, h) (((b) * 2 + (h)) * HTB)
#define PG8_SB(b, h) ((4 + (b) * 2 + (h)) * HTB)
#define PG8_STAGE(bufoff, gbase, voff) do { _Pragma("unroll") for (int _i = 0; _i < 2; ++_i) \
        __builtin_amdgcn_global_load_lds((const unsigned*)((const char*)(gbase) + (voff)[_i]), (PG8_LAS unsigned*)(lds + (bufoff) + ldsw + _i * 8192), 16, 0, 0); } while (0)
#define PG8_LDA(dst, b, h) do { _Pragma("unroll") for (int m = 0; m < 4; ++m) _Pragma("unroll") for (int k = 0; k < 2; ++k) dst[m][k] = *(const PG8_LAS bf16x8*)(lds + PG8_SA(b, h) + aoff + m * 2048 + k * 1024); } while (0)
#define PG8_LDB(dst, b, h) do { _Pragma("unroll") for (int n = 0; n < 2; ++n) _Pragma("unroll") for (int k = 0; k < 2; ++k) dst[n][k] = *(const PG8_LAS bf16x8*)(lds + PG8_SB(b, h) + boff + n * 2048 + k * 1024); } while (0)
#define PG8_MMA(ai, bj, At, Bt) do { __builtin_amdgcn_s_setprio(1); _Pragma("unroll") for (int m = 0; m < 4; ++m) _Pragma("unroll") for (int n = 0; n < 2; ++n) _Pragma("unroll") for (int k = 0; k < 2; ++k) \
        acc[ai][bj][m][n] = __builtin_amdgcn_mfma_f32_16x16x32_bf16(Bt[n][k], At[m][k], acc[ai][bj][m][n], 0, 0, 0); __builtin_amdgcn_s_setprio(0); } while (0)
#define PG8_WAIT_V(n) asm volatile("s_waitcnt vmcnt(" #n ")" ::: "memory")
#define PG8_WAIT_L(n) asm volatile("s_waitcnt lgkmcnt(" #n ")" ::: "memory")
#define PG8_BAR __builtin_amdgcn_s_barrier()
#define PG8_SCHED __builtin_amdgcn_sched_barrier(0)
    Unit cur, nxt; int ui = 0;
    if (!S.next(0, cur)) return;
    f32x4 acc[2][2][4][2];
#pragma unroll
    for (int a = 0; a < 2; ++a)
#pragma unroll
        for (int b = 0; b < 2; ++b)
#pragma unroll
            for (int m = 0; m < 4; ++m)
#pragma unroll
                for (int n = 0; n < 2; ++n) acc[a][b][m][n] = (f32x4){0.f, 0.f, 0.f, 0.f};
    bf16x8 At[4][2], B0[2][2], B1[2][2];
    const char* cA = (const char*)g.A + (size_t)cur.pm * tstep; const char* cB = (const char*)g.Bt + (size_t)cur.pn * tstep;
    S.a_ready(cur);
    if constexpr (SP2) {
        PG8_STAGE(PG8_SB(0, 0), cB, voffB); PG8_STAGE(PG8_SB(0, 1), cB + hstep, voffB); PG8_STAGE(PG8_SA(0, 0), cA, voffA); PG8_STAGE(PG8_SA(0, 1), cA + hstep, voffA);
        if (wr == 1) PG8_BAR;
        PG8_WAIT_V(2); PG8_BAR;
        PG8_STAGE(PG8_SB(1, 0), cB + kstep, voffB); PG8_STAGE(PG8_SA(1, 0), cA + kstep, voffA); PG8_STAGE(PG8_SB(1, 1), cB + hstep + kstep, voffB);
        PG8_WAIT_V(6); PG8_BAR;
    } else {
        PG8_STAGE(PG8_SB(0, 0), cB, voffB); PG8_STAGE(PG8_SA(0, 0), cA, voffA); PG8_STAGE(PG8_SB(0, 1), cB + hstep, voffB); PG8_STAGE(PG8_SA(0, 1), cA + hstep, voffA);
        if (wr == 1) PG8_BAR;
        PG8_WAIT_V(4); PG8_BAR;
        PG8_STAGE(PG8_SB(1, 0), cB + kstep, voffB); PG8_STAGE(PG8_SA(1, 0), cA + kstep, voffA); PG8_STAGE(PG8_SB(1, 1), cB + hstep + kstep, voffB);
        PG8_WAIT_V(6); PG8_BAR;
    }
    for (;;) {
        const bool has_next = S.next(ui + 1, nxt);
        const char* nA = has_next ? (const char*)g.A + (size_t)nxt.pm * tstep : cA; const char* nB = has_next ? (const char*)g.Bt + (size_t)nxt.pn * tstep : cB;
        for (int t = 0; t < nt; t += 2) {
            const bool last = (t == nt - 2);
            const char* a1 = cA + (size_t)(t + 1) * kstep;
            const char* a2 = last ? nA : cA + (size_t)(t + 2) * kstep; const char* b2 = last ? nB : cB + (size_t)(t + 2) * kstep;
            const char* a3 = a2 + kstep; const char* b3 = b2 + kstep;
            if (last && has_next) S.a_ready(nxt);
            if constexpr (SP2) {
            PG8_LDB(B0, 0, 0); PG8_LDB(B1, 0, 1); PG8_SCHED; PG8_LDA(At, 0, 0); PG8_STAGE(PG8_SA(1, 1), a1 + hstep, voffA);
            PG8_WAIT_V(8); PG8_WAIT_L(0); PG8_BAR; PG8_MMA(0, 0, At, B0); PG8_MMA(0, 1, At, B1); PG8_BAR; PG8_SCHED;
            PG8_LDA(At, 0, 1); PG8_STAGE(PG8_SB(0, 0), b2, voffB); PG8_STAGE(PG8_SB(0, 1), b2 + hstep, voffB); PG8_STAGE(PG8_SA(0, 0), a2, voffA);
            PG8_WAIT_V(8); PG8_WAIT_L(0); PG8_BAR; PG8_MMA(1, 0, At, B0); PG8_MMA(1, 1, At, B1); PG8_BAR; PG8_SCHED;
            PG8_LDB(B0, 1, 0); PG8_LDB(B1, 1, 1); PG8_SCHED; PG8_LDA(At, 1, 0); PG8_STAGE(PG8_SA(0, 1), a2 + hstep, voffA);
            PG8_WAIT_V(8); PG8_WAIT_L(0); PG8_BAR; PG8_MMA(0, 0, At, B0); PG8_MMA(0, 1, At, B1); PG8_BAR; PG8_SCHED;
            PG8_LDA(At, 1, 1); PG8_STAGE(PG8_SB(1, 0), b3, voffB); PG8_STAGE(PG8_SB(1, 1), b3 + hstep, voffB); PG8_STAGE(PG8_SA(1, 0), a3, voffA);
            PG8_WAIT_V(8); PG8_WAIT_L(0); PG8_BAR; PG8_MMA(1, 0, At, B0); PG8_MMA(1, 1, At, B1); PG8_BAR; PG8_SCHED;
            } else {
            PG8_LDB(B0, 0, 0); PG8_SCHED; PG8_LDA(At, 0, 0); PG8_STAGE(PG8_SA(1, 1), a1 + hstep, voffA);
            PG8_WAIT_L(8); PG8_BAR; PG8_WAIT_L(0); PG8_MMA(0, 0, At, B0); PG8_BAR; PG8_SCHED;
            PG8_LDB(B1, 0, 1); PG8_STAGE(PG8_SB(0, 0), b2, voffB);
            PG8_BAR; PG8_WAIT_L(0); PG8_MMA(0, 1, At, B1); PG8_BAR;
            PG8_LDA(At, 0, 1); PG8_STAGE(PG8_SA(0, 0), a2, voffA);
            PG8_BAR; PG8_WAIT_L(0); PG8_MMA(1, 0, At, B0); PG8_BAR; PG8_SCHED;
            PG8_STAGE(PG8_SB(0, 1), b2 + hstep, voffB);
            PG8_WAIT_V(6); PG8_BAR; PG8_MMA(1, 1, At, B1); PG8_BAR;
            PG8_LDB(B0, 1, 0); PG8_SCHED; PG8_LDA(At, 1, 0); PG8_STAGE(PG8_SA(0, 1), a2 + hstep, voffA);
            PG8_WAIT_L(8); PG8_BAR; PG8_WAIT_L(0); PG8_MMA(0, 0, At, B0); PG8_BAR; PG8_SCHED;
            PG8_LDB(B1, 1, 1); PG8_STAGE(PG8_SB(1, 0), b3, voffB);
            PG8_BAR; PG8_WAIT_L(0); PG8_MMA(0, 1, At, B1); PG8_BAR;
            PG8_LDA(At, 1, 1); PG8_STAGE(PG8_SA(1, 0), a3, voffA);
            PG8_BAR; PG8_WAIT_L(0); PG8_MMA(1, 0, At, B0); PG8_BAR; PG8_SCHED;
            PG8_STAGE(PG8_SB(1, 1), b3 + hstep, voffB);
            PG8_WAIT_V(6); PG8_BAR; PG8_MMA(1, 1, At, B1); PG8_BAR;
            }
        }
        if constexpr (ALIGN_EPI) { if (wr == 0) PG8_BAR; }
        if constexpr (!Epi::AFTER_DRAIN) { E(acc, cur, wr, wc, fr, fq); S.done(cur); }
        if (!has_next) break;
#pragma unroll
        for (int a = 0; a < 2; ++a)
#pragma unroll
            for (int b = 0; b < 2; ++b)
#pragma unroll
                for (int m = 0; m < 4; ++m)
#pragma unroll
                    for (int n = 0; n < 2; ++n) acc[a][b][m][n] = (f32x4){0.f, 0.f, 0.f, 0.f};
        cur = nxt; cA = nA; cB = nB; ++ui;
        if constexpr (ALIGN_EPI) { if (wr == 1) PG8_BAR; }
    }
    PG8_WAIT_V(0);
    if constexpr (!ALIGN_EPI) { if (wr == 0) PG8_BAR; }
    PG8_BAR;
    if constexpr (Epi::AFTER_DRAIN) { E.fused(acc, cur, wr, wc, fr, fq, lds, wid, lane); S.done(cur); }
#undef PG8_SA
#undef PG8_SB
#undef PG8_STAGE
#undef PG8_LDA
#undef PG8_LDB
#undef PG8_MMA
#undef PG8_WAIT_V
#undef PG8_WAIT_L
#undef PG8_BAR
#undef PG8_SCHED
}
}
#include <hip/hip_bf16.h>
#include <cmath>
namespace attn_body {
using bf16=__hip_bfloat16;
using bf16x8=__attribute__((ext_vector_type(8)))short;
using s16x4=__attribute__((ext_vector_type(4)))short;
using f32x16=__attribute__((ext_vector_type(16)))float;
using u32x4=__attribute__((ext_vector_type(4)))unsigned;
constexpr int BATCH=8,NHEAD=6,SEQ=8192,D=64,DM=3584,DMO=1024;
constexpr int NW=8,QBLK=32,QB=QBLK*NW,KVBLK=64,NQB=SEQ/QB;
constexpr int ATTN_UNIT_ROWS=QB;
__device__ __forceinline__ int crow(int r,int hi){return (r&3)+8*(r>>2)+4*hi;}
#define SBAR() __builtin_amdgcn_sched_barrier(0)
typedef __attribute__((address_space(3))) const float* lds_cfptr;
__device__ __forceinline__ void biasadd(f32x16&p0,f32x16&p1,int tt,int tq,int hi,lds_cfptr dl,int h){
  const int rb=tq-64*tt-4*hi; const lds_cfptr dh=dl+h;
  #pragma unroll
  for(int r=0;r<16;++r){ const unsigned i0=(unsigned)(rb-(r&3)-8*(r>>2)), i1=i0-32u;
    float a0=dh[(i0<128u?i0:128u)*8], a1=dh[(i1<128u?i1:128u)*8];
    asm volatile("s_waitcnt lgkmcnt(0)":"+v"(a0),"+v"(a1)::"memory");
    p0[r]+=a0; p1[r]+=a1; }
}
typedef unsigned u32x2m __attribute__((ext_vector_type(2)));
template<int K> __device__ __forceinline__ float mands(float p,unsigned md){ return __uint_as_float(__float_as_uint(p)&(unsigned)(K==3?((int)md>>24):(int)(signed char)(md>>(8*K)))); }
template<int K> __device__ __forceinline__ float mandk(float p,unsigned bits){ unsigned m; asm("v_bfe_i32 %0, %1, %2, 1":"=v"(m):"v"(bits),"n"(K)); return __uint_as_float(__float_as_uint(p)&m); }
__device__ __forceinline__ float mand(float p,unsigned bits,int k){ return __uint_as_float(__float_as_uint(p)&(unsigned)__builtin_amdgcn_sbfe((int)bits,k,1)); }

constexpr int NSLOT=3, SLOTB=8192;
constexpr int LDS_K=0, LDS_V=NSLOT*SLOTB, LDS_TAB=2*NSLOT*SLOTB, LDS_OST=LDS_TAB+2048, LDS_WS=LDS_OST+NW*4096, LDS_BYTES=LDS_WS+NW*64*4, LDS_QST=90624;
constexpr float C2=0.125f*1.4426950408889634f;
__device__ __forceinline__ void glds16(const void*gsrc,unsigned lds_dst){unsigned keep;
  asm volatile("s_mov_b32 %0, m0\n\ts_mov_b32 m0, %2\n\ts_nop 0\n\tglobal_load_lds_dwordx4 %1, off\n\ts_mov_b32 m0, %0":"=&s"(keep):"v"(gsrc),"s"(lds_dst):"memory");}
__device__ __forceinline__ float max3f(float a,float b,float c){float r;asm("v_max3_f32 %0, %1, %2, %3":"=v"(r):"v"(a),"v"(b),"v"(c));return r;}
__device__ __forceinline__ float max2f(float a,float b){float r;asm("v_max_f32_e32 %0, %1, %2":"=v"(r):"v"(a),"v"(b));return r;}
__device__ __forceinline__ float fadd_s(float a,float b){float r;asm("v_add_f32_e32 %0, %1, %2":"=v"(r):"v"(a),"v"(b));return r;}
__device__ __forceinline__ float fsub_s(float a,float b){float r;asm("v_sub_f32_e32 %0, %1, %2":"=v"(r):"v"(a),"v"(b));return r;}
typedef float f32x2_t __attribute__((ext_vector_type(2))); typedef __bf16 bf16x2_t __attribute__((ext_vector_type(2)));
__device__ __forceinline__ unsigned cvtpk_s(float lo,float hi){f32x2_t v={lo,hi};bf16x2_t b=__builtin_convertvector(v,bf16x2_t);return __builtin_bit_cast(unsigned,b);}
#define WAIT_BAR(N) asm volatile("s_waitcnt vmcnt(" #N ") lgkmcnt(0)\n\ts_barrier":::"memory")

__device__ __forceinline__ void qkt(f32x16&p0,f32x16&p1,const char*Kslot,const bf16x8*qr,const f32x16&negm,int r32,int hi){
  const char*kb=Kslot+hi*1024+r32*16;
  #pragma unroll
  for(int d0=0;d0<4;++d0){
    const bf16x8 b0=*reinterpret_cast<const bf16x8*>(kb+d0*2048);
    const bf16x8 b1=*reinterpret_cast<const bf16x8*>(kb+d0*2048+512);
    if(d0==0){p0=__builtin_amdgcn_mfma_f32_32x32x16_bf16(b0,qr[0],negm,0,0,0);p1=__builtin_amdgcn_mfma_f32_32x32x16_bf16(b1,qr[0],negm,0,0,0);}
    else{p0=__builtin_amdgcn_mfma_f32_32x32x16_bf16(b0,qr[d0],p0,0,0,0);p1=__builtin_amdgcn_mfma_f32_32x32x16_bf16(b1,qr[d0],p1,0,0,0);}}
}
typedef __attribute__((address_space(3))) const char* lds_cptr;
typedef short v4i16_t __attribute__((ext_vector_type(4)));
__device__ __forceinline__ void kload8(bf16x8*kf,lds_cptr kp){
  kf[0]=*(const __attribute__((address_space(3))) bf16x8*)(kp);      kf[1]=*(const __attribute__((address_space(3))) bf16x8*)(kp+512);
  kf[2]=*(const __attribute__((address_space(3))) bf16x8*)(kp+2048); kf[3]=*(const __attribute__((address_space(3))) bf16x8*)(kp+2560);
  kf[4]=*(const __attribute__((address_space(3))) bf16x8*)(kp+4096); kf[5]=*(const __attribute__((address_space(3))) bf16x8*)(kp+4608);
  kf[6]=*(const __attribute__((address_space(3))) bf16x8*)(kp+6144); kf[7]=*(const __attribute__((address_space(3))) bf16x8*)(kp+6656);
}
__device__ __forceinline__ void kload2(bf16x8*kf,lds_cptr kp,int j){ kf[2*j]=*(const __attribute__((address_space(3))) bf16x8*)(kp+j*2048); kf[2*j+1]=*(const __attribute__((address_space(3))) bf16x8*)(kp+j*2048+512); }
__device__ __forceinline__ s16x4 vtr(lds_cptr p){ return __builtin_bit_cast(s16x4,__builtin_amdgcn_ds_read_tr16_b64_v4i16((__attribute__((address_space(3))) v4i16_t*)p)); }
__device__ __forceinline__ float rowmax(const f32x16&p0,const f32x16&p1){
  float a=max3f(p0[0],p0[1],p1[0]),b=max3f(p0[2],p0[3],p1[1]);a=max3f(a,p1[2],p1[3]);
  #pragma unroll
  for(int r=4;r<16;r+=4){a=max3f(a,p0[r],p0[r+1]);b=max3f(b,p0[r+2],p0[r+3]);a=max3f(a,p1[r],p1[r+1]);b=max3f(b,p1[r+2],p1[r+3]);}
  const float m=max2f(a,b);
  auto rr=__builtin_amdgcn_permlane32_swap(__float_as_uint(m),__float_as_uint(m),false,false);
  return max2f(__uint_as_float(rr[0]),__uint_as_float(rr[1]));
}
__device__ __forceinline__ void pv(f32x16*o,int vb,bf16x8 pa0,bf16x8 pa1,bf16x8 pa2,bf16x8 pa3){
  #pragma unroll
  for(int d0=0;d0<2;++d0){s16x4 lo[4],hi[4];
    #pragma unroll
    for(int ks=0;ks<4;++ks){
      asm volatile("ds_read_b64_tr_b16 %0,%1 offset:%c2":"=&v"(lo[ks]):"v"(vb),"i"(d0*4096+ks*1024):"memory");
      asm volatile("ds_read_b64_tr_b16 %0,%1 offset:%c2":"=&v"(hi[ks]):"v"(vb),"i"(d0*4096+ks*1024+512):"memory");}
    asm volatile("s_waitcnt lgkmcnt(0)":::"memory");SBAR();
    #define PK(k) (bf16x8){lo[k][0],lo[k][1],lo[k][2],lo[k][3],hi[k][0],hi[k][1],hi[k][2],hi[k][3]}
    o[d0]=__builtin_amdgcn_mfma_f32_32x32x16_bf16(pa0,PK(0),o[d0],0,0,0);
    o[d0]=__builtin_amdgcn_mfma_f32_32x32x16_bf16(pa1,PK(1),o[d0],0,0,0);
    o[d0]=__builtin_amdgcn_mfma_f32_32x32x16_bf16(pa2,PK(2),o[d0],0,0,0);
    o[d0]=__builtin_amdgcn_mfma_f32_32x32x16_bf16(pa3,PK(3),o[d0],0,0,0);
    #undef PK
  }
}

#ifndef ATTN_STORE16
#define ATTN_STORE16(p,v) (*(u32x4*)(p)=(v))
#endif
template<int THRL> __device__ __forceinline__ void attn_unit(int b,int h,int qb,const bf16*Q,const bf16*__restrict__ K,const bf16*__restrict__ V,bf16*O,const bf16*GT,const unsigned*MK,lds_cfptr dl,char*shm,const int tid){
  const int lane=tid&63,r32=lane&31,hi=lane>>5; const int wid=__builtin_amdgcn_readfirstlane(tid>>6);
  const long rowbase=(long)b*SEQ; const int q0=qb*QB;
  const bf16*Qw=Q+(rowbase+q0+wid*QBLK)*DM+h*D;
  const bf16*Kh=K+rowbase*DM+h*D,*Vh=V+rowbase*DM+h*D;
  const unsigned lds0=(unsigned)(uintptr_t)shm;
  float*wsf=(float*)(shm+LDS_WS)+wid*64;
  const bf16*ksrc=Kh+(long)lane*DM+wid*8;
  const bf16*vsrc=Vh+(long)(16*(wid&3)+(lane>>2))*DM+(wid>>2)*32+(lane&3)*8;
  const unsigned kdst=lds0+LDS_K+wid*1024, vdst=lds0+LDS_V+wid*1024;
  #define DMA_K(t,slot) glds16(ksrc+(long)(t)*KVBLK*DM,(unsigned)__builtin_amdgcn_readfirstlane(kdst+(slot)))
  #define DMA_V(t,slot) glds16(vsrc+(long)(t)*KVBLK*DM,(unsigned)__builtin_amdgcn_readfirstlane(vdst+(slot)))
  const int vb0=(int)(lds0+LDS_V)+((lane>>4)&1)*32+(lane&3)*8+(4*hi+((lane&15)>>2))*64;
  const char*Kbase=shm+LDS_K; bf16x8 kf[8];
  const lds_cptr shm3=(lds_cptr)shm; const lds_cptr kp0=shm3+LDS_K+hi*1024+r32*16; const lds_cptr vp0=shm3+LDS_V+((lane>>4)&1)*32+(lane&3)*8+(4*hi+((lane&15)>>2))*64;
  const int NT=(q0+QB)/KVBLK;
  DMA_K(0,0);DMA_V(0,0);DMA_K(1,SLOTB);
  const __attribute__((address_space(3))) char* shm3q=(const __attribute__((address_space(3))) char*)shm;
  bf16x8 qr[4];
  #pragma unroll
  for(int d0=0;d0<4;++d0)qr[d0]=*reinterpret_cast<const bf16x8*>(&Qw[(long)r32*DM+d0*16+hi*8]);
  const __attribute__((address_space(3))) bf16x8* qls=(const __attribute__((address_space(3))) bf16x8*)(shm3q+LDS_QST+wid*4096)+lane;
  #pragma unroll
  for(int d0=0;d0<4;++d0)((__attribute__((address_space(3))) bf16x8*)qls)[64*d0]=qr[d0];
  float mhat=0.f,l_reg=0.f;f32x16 o[2];o[0]=f32x16{};o[1]=f32x16{};float nmh=0.f;
  const int tq=q0+wid*QBLK+r32;
  const unsigned*mbase=MK+((size_t)(b*256+(q0>>5)+wid)*128)*64;
  unsigned bits_cur=mbase[lane],bits_next=mbase[64+lane];
  #define CMASK(P0,P1,t) do{ if((t)>=NT-6)biasadd(P0,P1,(t),tq,hi,dl,h);}while(0)
  bool resc=false;
  #define START(P0,P1) do{ const float rm=rowmax(P0,P1); resc=false; \
    { const float dl=(rm>(float)THRL||rm<-(float)THRL)?rm:0.f; mhat=fadd_s(mhat,dl);     \
      _Pragma("unroll") for(int r=0;r<16;++r){P0[r]=fsub_s(P0[r],dl);P1[r]=fsub_s(P1[r],dl);} \
      nmh=-mhat; } \
    _Pragma("unroll") for(int r=0;r<16;++r)P0[r]=mand(__builtin_amdgcn_exp2f(P0[r]),bits_cur,r); }while(0)
  #define RESC() do{ if(resc){ asm volatile("s_waitcnt lgkmcnt(0)":::"memory"); \
      _Pragma("unroll") for(int d_=0;d_<2;++d_) _Pragma("unroll") for(int r=0;r<16;++r)o[d_][r]*=wsf[crow(r,hi)]; } }while(0)
  f32x16 pA0,pA1,pB0,pB1;
  int sl_prev=0,sl_cur=0,sl_next=SLOTB;
  #define ROT() do{sl_prev=sl_cur;sl_cur=sl_next;sl_next=(sl_next==(NSLOT-1)*SLOTB)?0:sl_next+SLOTB;}while(0)
  DMA_K(2,2*SLOTB);
  WAIT_BAR(3);
  { const f32x16 zc=f32x16{}; qkt(pA0,pA1,Kbase,qr,zc,r32,hi); }asm volatile("s_nop 15\n\ts_nop 7":"+v"(pA0),"+v"(pA1));CMASK(pA0,pA1,0);
  START(pA0,pA1);
  _Pragma("unroll") for(int r=0;r<16;++r)pA1[r]=mand(__builtin_amdgcn_exp2f(pA1[r]),bits_cur,16+r);
  WAIT_BAR(0);
  DMA_K(3,0);DMA_V(1,SLOTB);
  ROT();
  kload8(kf,kp0+sl_cur);
  WAIT_BAR(2);
  u32x2m mk01,mk23,mk45,mk67;
  s16x4 vlo[8],vhi[8]; u32x4 pw0,pw1,pw2,pw3; bf16x8 qa_=qls[0],qb_;
  #define PKW(P,B) cvtpk_s(P[B],P[B+1])
  #define PAF(k) __builtin_bit_cast(bf16x8,pw##k)
  #define VFR(i) (bf16x8){vlo[i][0],vlo[i][1],vlo[i][2],vlo[i][3],vhi[i][0],vhi[i][1],vhi[i][2],vhi[i][3]}
  #define PIN(x) asm volatile("":"+v"(x))
  #define MX3(a,b,c) __builtin_fmaxf(__builtin_fmaxf((a),(b)),(c))
  #define GAPA(MF,A0,A1,A2,A3,W0,W1,PW) do{ MF; sacc+=A0; sacc+=A1; sacc+=A2; sacc+=A3; PIN(sacc); W0; W1; PIN(PW); SBAR(); }while(0)
  #define EX(v) __builtin_amdgcn_exp2f(v)
  #define MKD(e) (((e)>>2)==0?mk01[0]:((e)>>2)==1?mk01[1]:((e)>>2)==2?mk23[0]:((e)>>2)==3?mk23[1]:((e)>>2)==4?mk45[0]:((e)>>2)==5?mk45[1]:((e)>>2)==6?mk67[0]:mk67[1])
  #define GAPB(MF,X,B,MB) do{ MF; { const unsigned md_=MKD((MB)+(B)); X[B]=mands<0>(EX(X[B]),md_); X[B+1]=mands<1>(EX(X[B+1]),md_); X[B+2]=mands<2>(EX(X[B+2]),md_); X[B+3]=mands<3>(EX(X[B+3]),md_); } PIN(X); SBAR(); }while(0)
  #define VRD(i) do{ vlo[i]=vtr(vp_+(((i)>>2)*4096+((i)&3)*1024)); vhi[i]=vtr(vp_+(((i)>>2)*4096+((i)&3)*1024+512)); }while(0)
  #define KRD(G,j) do{ if(G){ kload2(kf,kp0+sl_next,j); SBAR(); } }while(0)
  #define STEP(C0,C1,P0,P1,t,GK,GV,GL) do{ SBAR(); \
    bits_cur=bits_next; if(GV){ bits_next=mbase[64*((t)+1)+lane]; } \
    { typedef const __attribute__((address_space(3))) u32x2m* tp_;     \
      mk01=*(tp_)(LDS_TAB+(((unsigned)(unsigned char)(bits_cur))<<3)); mk23=*(tp_)(LDS_TAB+(((unsigned)(unsigned char)(bits_cur>>8))<<3)); mk45=*(tp_)(LDS_TAB+(((unsigned)(unsigned char)(bits_cur>>16))<<3)); mk67=*(tp_)(LDS_TAB+((bits_cur>>24)<<3)); } \
    const lds_cptr vp_=vp0+sl_prev; \
    VRD(0); qb_=qls[64]; SBAR(); float sacc=(P0[0]+P0[1]); \
    if(!__any(nmh!=0.f)){ const f32x16 zc_=f32x16{}; \
      GAPA(C0=__builtin_amdgcn_mfma_f32_32x32x16_bf16(kf[0],qa_,zc_,0,0,0), P0[2],P0[3],P0[4],P0[5],     pw0[0]=PKW(P0,0), pw0[1]=PKW(P0,2), pw0); \
      VRD(4); SBAR(); GAPA(C1=__builtin_amdgcn_mfma_f32_32x32x16_bf16(kf[1],qa_,zc_,0,0,0), P0[6],P0[7],P0[8],P0[9],     pw0[2]=PKW(P0,4), pw0[3]=PKW(P0,6), pw0); \
    }else{ f32x16 negm; { float nm_=nmh; asm volatile("":"+v"(nm_)); _Pragma("unroll") for(int r=0;r<16;++r)negm[r]=nm_; } \
      GAPA(C0=__builtin_amdgcn_mfma_f32_32x32x16_bf16(kf[0],qa_,negm,0,0,0), P0[2],P0[3],P0[4],P0[5],     pw0[0]=PKW(P0,0), pw0[1]=PKW(P0,2), pw0); \
      VRD(4); SBAR(); GAPA(C1=__builtin_amdgcn_mfma_f32_32x32x16_bf16(kf[1],qa_,negm,0,0,0), P0[6],P0[7],P0[8],P0[9],     pw0[2]=PKW(P0,4), pw0[3]=PKW(P0,6), pw0); } \
    VRD(1); qa_=qls[128]; SBAR(); GAPA(C0=__builtin_amdgcn_mfma_f32_32x32x16_bf16(kf[2],qb_,C0,0,0,0),   P0[10],P0[11],P0[12],P0[13], pw1[0]=PKW(P0,8), pw1[1]=PKW(P0,10), pw1); \
    VRD(5); SBAR(); GAPA(C1=__builtin_amdgcn_mfma_f32_32x32x16_bf16(kf[3],qb_,C1,0,0,0),   P0[14],P0[15],P1[0],P1[1],   pw1[2]=PKW(P0,12),pw1[3]=PKW(P0,14), pw1); \
    VRD(2); qb_=qls[192]; SBAR(); GAPA(C0=__builtin_amdgcn_mfma_f32_32x32x16_bf16(kf[4],qa_,C0,0,0,0),   P1[2],P1[3],P1[4],P1[5],     pw2[0]=PKW(P1,0), pw2[1]=PKW(P1,2), pw2); \
    VRD(6); SBAR(); GAPA(C1=__builtin_amdgcn_mfma_f32_32x32x16_bf16(kf[5],qa_,C1,0,0,0),   P1[6],P1[7],P1[8],P1[9],     pw2[2]=PKW(P1,4), pw2[3]=PKW(P1,6), pw2); \
    VRD(3); qa_=qls[0]; SBAR(); GAPA(C0=__builtin_amdgcn_mfma_f32_32x32x16_bf16(kf[6],qb_,C0,0,0,0),   P1[10],P1[11],P1[12],P1[13], pw3[0]=PKW(P1,8), pw3[1]=PKW(P1,10), pw3); \
    VRD(7); SBAR(); GAPA(C1=__builtin_amdgcn_mfma_f32_32x32x16_bf16(kf[7],qb_,C1,0,0,0),   P1[14],P1[15],0.f,0.f,       pw3[2]=PKW(P1,12),pw3[3]=PKW(P1,14), pw3); \
    l_reg+=sacc; \
    if(GK){DMA_K((t)+3,sl_cur);} if(GV){DMA_V((t)+1,sl_next);} \
    CMASK(C0,C1,t); \
    { float a=MX3(C0[0],C0[1],C1[0]),b=MX3(C0[2],C0[3],C1[1]); a=MX3(a,C1[2],C1[3]); \
      _Pragma("unroll") for(int r=4;r<16;r+=4){a=MX3(a,C0[r],C0[r+1]);b=MX3(b,C0[r+2],C0[r+3]);a=MX3(a,C1[r],C1[r+1]);b=MX3(b,C1[r+2],C1[r+3]);} \
      float rm=__builtin_fmaxf(a,b); { auto rr=__builtin_amdgcn_permlane32_swap(__float_as_uint(rm),__float_as_uint(rm),false,false); rm=__builtin_fmaxf(__uint_as_float(rr[0]),__uint_as_float(rr[1])); } \
      resc=false; \
      if(__builtin_expect(__any(rm>(float)THRL),0)){ const float dl=__builtin_fmaxf(rm,0.f); mhat+=dl; \
        _Pragma("unroll") for(int r=0;r<16;++r){C0[r]-=dl;C1[r]-=dl;} \
        nmh=-mhat; \
        const float f=__builtin_amdgcn_exp2f(-dl); l_reg*=f; if(hi==0)wsf[r32]=f; resc=true; } } \
    SBAR(); \
    GAPB(o[0]=__builtin_amdgcn_mfma_f32_32x32x16_bf16(PAF(0),VFR(0),o[0],0,0,0), C0,0,0); \
    GAPB(o[1]=__builtin_amdgcn_mfma_f32_32x32x16_bf16(PAF(0),VFR(4),o[1],0,0,0), C0,4,0); \
    KRD(GL,0); GAPB(o[0]=__builtin_amdgcn_mfma_f32_32x32x16_bf16(PAF(1),VFR(1),o[0],0,0,0), C0,8,0); \
    KRD(GL,1); GAPB(o[1]=__builtin_amdgcn_mfma_f32_32x32x16_bf16(PAF(1),VFR(5),o[1],0,0,0), C0,12,0); \
    KRD(GL,2); GAPB(o[0]=__builtin_amdgcn_mfma_f32_32x32x16_bf16(PAF(2),VFR(2),o[0],0,0,0), C1,0,16); \
    KRD(GL,3); GAPB(o[1]=__builtin_amdgcn_mfma_f32_32x32x16_bf16(PAF(2),VFR(6),o[1],0,0,0), C1,4,16); \
    GAPB(o[0]=__builtin_amdgcn_mfma_f32_32x32x16_bf16(PAF(3),VFR(3),o[0],0,0,0), C1,8,16); \
    GAPB(o[1]=__builtin_amdgcn_mfma_f32_32x32x16_bf16(PAF(3),VFR(7),o[1],0,0,0), C1,12,16); \
    }while(0)
  int t=1;
  #undef CMASK
  #define CMASK(P0,P1,t) do{}while(0)
  for(;t+7<NT;t+=2){
    STEP(pB0,pB1,pA0,pA1,t,true,true,true);     WAIT_BAR(2); RESC(); ROT();
    STEP(pA0,pA1,pB0,pB1,t+1,true,true,true);   WAIT_BAR(2); RESC(); ROT();
  }
  #undef CMASK
  #define CMASK(P0,P1,t) do{ if((t)>=NT-6)biasadd(P0,P1,(t),tq,hi,dl,h);}while(0)
  #define ENDW(tt) do{ if((tt)+3<NT){WAIT_BAR(2);} else if((tt)+2<NT){WAIT_BAR(1);} else {WAIT_BAR(0);} }while(0)
  for(;t+1<NT;t+=2){
    STEP(pB0,pB1,pA0,pA1,t,(t+3<NT),(t+1<NT),(t+1<NT));       ENDW(t);   RESC(); ROT();
    STEP(pA0,pA1,pB0,pB1,t+1,(t+4<NT),(t+2<NT),(t+2<NT));     ENDW(t+1); RESC(); ROT();
  }
  STEP(pB0,pB1,pA0,pA1,NT-1,false,false,false); RESC();
  { float sacc=pB0[0]+pB0[1]; _Pragma("unroll") for(int r=2;r<16;++r)sacc+=pB0[r]; _Pragma("unroll") for(int r=0;r<16;++r)sacc+=pB1[r]; l_reg+=sacc;
    pw0=(u32x4){PKW(pB0,0),PKW(pB0,2),PKW(pB0,4),PKW(pB0,6)};pw1=(u32x4){PKW(pB0,8),PKW(pB0,10),PKW(pB0,12),PKW(pB0,14)};pw2=(u32x4){PKW(pB1,0),PKW(pB1,2),PKW(pB1,4),PKW(pB1,6)};pw3=(u32x4){PKW(pB1,8),PKW(pB1,10),PKW(pB1,12),PKW(pB1,14)};
    SBAR(); pv(o,vb0+sl_cur,PAF(0),PAF(1),PAF(2),PAF(3)); }
  #undef PKW
  #undef PAF
  #undef VFR
  #undef PIN
  #undef MX3
  #undef GAPA
  #undef GAPB
  #undef EX
  #undef VRD
  #undef KRD
  #undef STEP
  #undef ENDW
  {auto rr=__builtin_amdgcn_permlane32_swap(__float_as_uint(l_reg),__float_as_uint(l_reg),false,false);l_reg=__uint_as_float(rr[0])+__uint_as_float(rr[1]);}
  if(hi==0)wsf[32+r32]=l_reg;asm volatile("s_waitcnt lgkmcnt(0)":::"memory");
  float rli[16];
  #pragma unroll
  for(int r=0;r<16;++r)rli[r]=__builtin_amdgcn_rcpf(wsf[32+crow(r,hi)]);
  bf16*Ow=O+(rowbase+q0+wid*QBLK)*DMO+h*D; const bf16*Gw=GT+(rowbase+q0+wid*QBLK)*DM+h*D;
  { bf16*stg=(bf16*)(shm+LDS_OST)+wid*2048;
    #pragma unroll
    for(int r=0;r<16;++r){const int orow=crow(r,hi);
      #pragma unroll
      for(int d0=0;d0<2;++d0)stg[orow*64+d0*32+r32]=__float2bfloat16(o[d0][r]*rli[r]);}
    asm volatile("s_waitcnt lgkmcnt(0)":::"memory");
    #pragma unroll
    for(int i=0;i<4;++i){const int row=i*8+(lane>>3),ch=lane&7; const u32x4 v=*(const u32x4*)(stg+row*64+ch*8); const u32x4 g=*(const u32x4*)(Gw+(long)row*DM+ch*8); u32x4 w;
      #pragma unroll
      for(int k=0;k<4;++k){ const float g0=__uint_as_float(g[k]<<16),g1=__uint_as_float(g[k]&0xffff0000u); const float v0=__uint_as_float(v[k]<<16),v1=__uint_as_float(v[k]&0xffff0000u);
        w[k]=cvtpk_s(v0*(g0/(1.0f+__expf(-g0))),v1*(g1/(1.0f+__expf(-g1)))); }
      ATTN_STORE16(Ow+(long)row*DMO+ch*8,w);} }
  asm volatile("s_waitcnt lgkmcnt(0)\n\ts_barrier":::"memory");
  #undef DMA_K
  #undef DMA_V
  #undef CMASK
  #undef START
  #undef RESC
  #undef ROT
}
constexpr int ATTN_LDS_BYTES=LDS_BYTES;
struct AttnTensors { const bf16* Q; const bf16* K; const bf16* V; bf16* O; const bf16* GT; const unsigned* MK; };
struct AttnUnit { int bh; int qb; };
struct StaticOrder {
  int wg,G;
  __device__ __forceinline__ explicit StaticOrder(int grid,int block):wg(block),G(grid){}
  __device__ __forceinline__ bool next(int i,AttnUnit&u)const{ const int p=wg+(i>>1)*G; if(p>=768)return false; const int s=p&15; u.bh=p>>4; u.qb=(i&1)?31-s:s; return true; }
  __device__ __forceinline__ void a_ready(const AttnUnit&)const{}
  __device__ __forceinline__ void done(const AttnUnit&)const{}
};
template<class Sched,int THRL=8> __device__ __forceinline__ void attn_phase(char*lds,const AttnTensors&T,lds_cfptr dl,const Sched&S,int tid){
  AttnUnit u;
  for(int i=0;S.next(i,u);++i){ asm volatile("":"+v"(tid)); S.a_ready(u); attn_unit<THRL>(u.bh/NHEAD,u.bh%NHEAD,u.qb,T.Q,T.K,T.V,T.O,T.GT,T.MK,dl,lds,tid); S.done(u); }
}
#undef SBAR
#undef WAIT_BAR
}

constexpr int NWAVES = 8, NTHR = 512;
constexpr int BATCH = 8, SEQ = 8192, DM = 1024, DEPTH = 4, M = BATCH * SEQ;
constexpr int IN_COLS = 3380, NP = 3584;
constexpr float EPS = 1e-6f;
constexpr int N_GQ = 0, N_GK = 192, N_GV = 384, N_GG = 768, N_DQ = 1152, N_DK = 1536, N_DV = 1920, N_DG = 2304, N_PU = 2688, N_PG = 2944, N_QI = 3200, N_KI = 3328, N_GZ = 3360, N_WI = 3376;
constexpr float LOG2E = 1.4426950408889634f;
constexpr size_t MiB = 1u << 20;
constexpr size_t WS_CTL = 0, CTL_ZERO_BYTES = 1 * MiB;
constexpr size_t WS_WIN = 2 * MiB;
constexpr size_t WS_WOUT = 32 * MiB;
constexpr size_t WS_XB = 48 * MiB;
constexpr size_t WS_P = 176 * MiB;
constexpr size_t WS_MASK = 624 * MiB;
constexpr size_t WS_GOP = 688 * MiB;
constexpr size_t WS_XA = 832 * MiB;
constexpr size_t WS_RSC = 44 * MiB;
constexpr size_t WS_RS = 40 * MiB;
constexpr size_t WS_ZW = 960 * MiB;
constexpr size_t WS_KC = 968 * MiB;
constexpr size_t WS_END = 972 * MiB;
constexpr int CW_BAR = 4096, CW_QUEUE = 8192;
constexpr int RING_BYTES = 131072, LDSCTL_OFF = RING_BYTES, MISC_OFF = LDSCTL_OFF + 320, LDS_BYTES = 147456;

#define GAS __attribute__((address_space(1)))
#define LAS __attribute__((address_space(3)))
typedef unsigned short bf16;
typedef unsigned v4u __attribute__((ext_vector_type(4)));
typedef unsigned v2u __attribute__((ext_vector_type(2)));
typedef float f32x4 __attribute__((ext_vector_type(4)));
typedef GAS unsigned gu32;
#define RLX_AGENT __ATOMIC_RELAXED, __HIP_MEMORY_SCOPE_AGENT
__device__ __forceinline__ unsigned f2bf(float f) { unsigned u = __builtin_bit_cast(unsigned, f); return (u + 0x7fffu + ((u >> 16) & 1u)) >> 16; }
__device__ __forceinline__ unsigned pk2(float lo, float hi) { return f2bf(lo) | (f2bf(hi) << 16); }
__device__ __forceinline__ float bf2f(unsigned short b) { return __builtin_bit_cast(float, (unsigned)b << 16); }
__device__ __forceinline__ float bflo(unsigned w) { return __builtin_bit_cast(float, w << 16); }
__device__ __forceinline__ float bfhi(unsigned w) { return __builtin_bit_cast(float, w & 0xffff0000u); }
__device__ __forceinline__ float shx(float v, int o, int lane) { return __builtin_bit_cast(float, __builtin_amdgcn_ds_bpermute((lane ^ o) << 2, __builtin_bit_cast(int, v))); }
__device__ __forceinline__ int shdn(int v, int o, int lane) { return __builtin_amdgcn_ds_bpermute(((lane + o) & 63) << 2, v); }
__device__ __forceinline__ float wave_sum(float v, int lane) {
#pragma unroll
    for (int o = 1; o < 64; o <<= 1) v += shx(v, o, lane);
    return v;
}
__device__ __forceinline__ float silu_f(float x) { return x / (1.0f + __expf(-x)); }

__constant__ unsigned char T5B[128] = {0, 1, 2, 3, 4, 5, 6, 7, 8, 9, 10, 11, 12, 13, 14, 15, 16, 16, 16, 17, 17, 18, 18, 18, 19, 19, 19, 20, 20, 20, 20, 21, 21, 21, 21, 22, 22, 22, 22, 22, 23, 23, 23, 23, 23, 23, 24, 24, 24, 24, 24, 24, 25, 25, 25, 25, 25, 25, 25, 26, 26, 26, 26, 26, 26, 26, 26, 27, 27, 27, 27, 27, 27, 27, 27, 27, 27, 28, 28, 28, 28, 28, 28, 28, 28, 28, 28, 29, 29, 29, 29, 29, 29, 29, 29, 29, 29, 29, 29, 30, 30, 30, 30, 30, 30, 30, 30, 30, 30, 30, 30, 30, 30, 31, 31, 31, 31, 31, 31, 31, 31, 31, 31, 31, 31, 31, 31, 31};
__device__ __forceinline__ int t5_bucket(int rel) { return rel >= 128 ? 31 : (int)T5B[rel]; }

#define XB_TMO      128
#define XB_XCNT(j)  (256  + 64 * (j))
#define XB_XSUB(j)  (1280 + 64 * (j))
#define XB_XGEN(j)  (2304 + 64 * (j))
#define XB_TOP      3328
#define XB_TOPGEN   3392
#define XCD_BAR_WORDS 3456
#define XB_SPIN_CAP (1u << 22)

__device__ __forceinline__ unsigned xb_ld(unsigned* p)              { return __hip_atomic_load(p, __ATOMIC_RELAXED, __HIP_MEMORY_SCOPE_AGENT); }
__device__ __forceinline__ unsigned xb_add(unsigned* p, unsigned v) { return __hip_atomic_fetch_add(p, v, __ATOMIC_RELAXED, __HIP_MEMORY_SCOPE_AGENT); }
__device__ __forceinline__ unsigned xb_xcc_id() { return (unsigned)__builtin_amdgcn_s_getreg((3 << 11) | 20) & 0xFu; }
#define XB_SPIN(cond, bar) do { unsigned _sp = 0; while (cond) { __builtin_amdgcn_s_sleep(1); \
    if ((++_sp & 255u) == 0u) { if (xb_ld(&(bar)[XB_TMO])) break; if (_sp > XB_SPIN_CAP) { atomicAdd(&(bar)[XB_TMO], 1u); break; } } } } while (0)

struct XcdBarrier {
    unsigned* bar; unsigned x;
    volatile LAS unsigned* st;
};

__device__ __forceinline__ XcdBarrier xcd_barrier_post(unsigned* bar, volatile LAS unsigned* st) {
    XcdBarrier b; b.bar = bar; b.x = xb_xcc_id(); b.st = st;
    if (threadIdx.x == 0) (void)xb_add(&bar[XB_XCNT(b.x)], 1u);
    return b;
}
__device__ __forceinline__ void xcd_barrier_complete(unsigned* bar, unsigned x, unsigned& nloc, unsigned& nx) {
    const unsigned G = gridDim.x * gridDim.y * gridDim.z;
    unsigned sum, cnt, mine, sp = 0u;
    for (;;) {
        sum = 0u; cnt = 0u; mine = 0u;
#pragma unroll
        for (unsigned j = 0; j < 16; ++j) { const unsigned c = xb_ld(&bar[XB_XCNT(j)]); sum += c; cnt += (c > 0u) ? 1u : 0u; mine = (j == x) ? c : mine; }
        if (sum == G) break;
        __builtin_amdgcn_s_sleep(1);
        if ((++sp & 255u) == 0u) { if (xb_ld(&bar[XB_TMO])) break; if (sp > XB_SPIN_CAP) { atomicAdd(&bar[XB_TMO], 1u); break; } }
    }
    nloc = mine > 0u ? mine : 1u; nx = cnt > 0u ? cnt : 1u;
}

__device__ __forceinline__ void xcd_barrier(const XcdBarrier& b) {
    asm volatile("s_waitcnt vmcnt(0)" ::: "memory");
    __syncthreads();
    if (threadIdx.x == 0) {
        unsigned* bar = b.bar;
        __builtin_amdgcn_s_waitcnt(0);
        unsigned nloc = b.st[0], nx = b.st[1];
        if (nloc == 0u) { xcd_barrier_complete(bar, b.x, nloc, nx); b.st[0] = nloc; b.st[1] = nx; }
        const unsigned old = xb_add(&bar[XB_XSUB(b.x)], 1u);
        const unsigned gen = old / nloc;
        if (old + 1u == (gen + 1u) * nloc) {
            __builtin_amdgcn_fence(__ATOMIC_RELEASE, "agent");
            asm volatile("s_waitcnt vmcnt(0)" ::: "memory");
            const unsigned og = xb_add(&bar[XB_TOP], 1u);
            const unsigned tg = og / nx;
            if (og + 1u == (tg + 1u) * nx) xb_add(&bar[XB_TOPGEN], 1u);
            else XB_SPIN(xb_ld(&bar[XB_TOPGEN]) == tg, bar);
            __builtin_amdgcn_fence(__ATOMIC_ACQUIRE, "agent");
            xb_add(&bar[XB_XGEN(b.x)], 1u);
            asm volatile("s_waitcnt vmcnt(0)" ::: "memory");
        } else {
            XB_SPIN(xb_ld(&bar[XB_XGEN(b.x)]) == gen, bar);
            __builtin_amdgcn_fence(__ATOMIC_ACQUIRE, "agent");
            asm volatile("s_waitcnt vmcnt(0)" ::: "memory");
        }
    }
    __syncthreads();
}
#ifndef IDX_NOFALLBACK
#define IDX_NOFALLBACK 0
#endif
#ifndef REP_RES
#define REP_RES 1
#endif
#ifndef REP_PATCH
#define REP_PATCH 1
#endif
#ifndef REP_P1
#define REP_P1 1
#endif
#ifndef REP_P3
#define REP_P3 1
#endif
#ifndef REP_HEAD
#define REP_HEAD 1
#endif
#ifndef REP_RES
#define REP_RES 1
#endif
#ifndef REP_P2
#define REP_P2 1
#endif
#ifndef REP_RANK
#define REP_RANK 1
#endif
#ifndef IDX_PRIO
#define IDX_PRIO 1
#endif
#ifndef IDX_PKFMA
#define IDX_PKFMA 0
#endif
#ifndef PROBE_MFMA2
#define PROBE_MFMA2 0
#endif
#ifndef PROBE_ADD2
#define PROBE_ADD2 0
#endif
#ifndef IDX_ASMFMA
#define IDX_ASMFMA 0
#endif
#ifndef IDX_ASMBIN
#define IDX_ASMBIN 0
#endif
namespace idxb {
typedef short bf16x8 __attribute__((ext_vector_type(8)));
typedef float f32x16 __attribute__((ext_vector_type(16)));
constexpr int ZBIN = 0, NBINS = 512, CAP = 256;
constexpr int L_HIST = 0, L_ZC = 65536, L_PAR = 81920, L_KBUF = 83968, L_XT = 116736;
enum { P_BSTAR = 0, P_KK, P_CCNT, P_TAU, P_CUT, P_MODE, P_TSTAR, P_RSTAR, P_OVF, P_NRANK, P_PRE, P_XL, P_XU, P_ANY3 };
__device__ __forceinline__ unsigned lds_add(unsigned* p, unsigned v) { return __hip_atomic_fetch_add((__attribute__((address_space(3))) unsigned*)p, v, __ATOMIC_RELAXED, __HIP_MEMORY_SCOPE_WORKGROUP); }
__device__ __forceinline__ int crow(int r, int hi) { return (r & 3) + 8 * (r >> 2) + 4 * hi; }
struct QFrag { bf16x8 q[4][2]; float w[4]; };
__device__ __forceinline__ f32x16 score_sub(const bf16x8 k0, const bf16x8 k1, const QFrag& Q) {
    f32x16 acc;
#pragma unroll
    for (int r = 0; r < 16; ++r) acc[r] = 0.f;
    const f32x16 zz = {0.f, 0.f, 0.f, 0.f, 0.f, 0.f, 0.f, 0.f, 0.f, 0.f, 0.f, 0.f, 0.f, 0.f, 0.f, 0.f};
    float INFV; asm("s_mov_b32 %0, 0x7f800000" : "=s"(INFV));
#pragma unroll
    for (int hp = 0; hp < 2; ++hp) {
        f32x16 d0 = __builtin_amdgcn_mfma_f32_32x32x16_bf16(k0, Q.q[2 * hp][0], zz, 0, 0, 0), d1 = __builtin_amdgcn_mfma_f32_32x32x16_bf16(k0, Q.q[2 * hp + 1][0], zz, 0, 0, 0);
        d0 = __builtin_amdgcn_mfma_f32_32x32x16_bf16(k1, Q.q[2 * hp][1], d0, 0, 0, 0); d1 = __builtin_amdgcn_mfma_f32_32x32x16_bf16(k1, Q.q[2 * hp + 1][1], d1, 0, 0, 0);
#if PROBE_MFMA2
        { f32x16 e0 = __builtin_amdgcn_mfma_f32_32x32x16_bf16(k0, Q.q[2 * hp][1], zz, 0, 0, 0); e0 = __builtin_amdgcn_mfma_f32_32x32x16_bf16(k1, Q.q[2 * hp][0], e0, 0, 0, 0);
          e0 = __builtin_amdgcn_mfma_f32_32x32x16_bf16(k0, Q.q[2 * hp + 1][1], e0, 0, 0, 0); e0 = __builtin_amdgcn_mfma_f32_32x32x16_bf16(k1, Q.q[2 * hp + 1][0], e0, 0, 0, 0); asm volatile("" :: "v"(e0)); }
#endif
#if IDX_PKFMA
        { typedef float f32x2 __attribute__((ext_vector_type(2)));
            const f32x2 wa = {Q.w[2 * hp], Q.w[2 * hp]}, wb = {Q.w[2 * hp + 1], Q.w[2 * hp + 1]};
#pragma unroll
            for (int r = 0; r < 16; r += 2) { const f32x2 ra = {__builtin_amdgcn_fmed3f(d0[r], 0.f, INFV), __builtin_amdgcn_fmed3f(d0[r + 1], 0.f, INFV)}, rb = {__builtin_amdgcn_fmed3f(d1[r], 0.f, INFV), __builtin_amdgcn_fmed3f(d1[r + 1], 0.f, INFV)};
                f32x2 ac = {acc[r], acc[r + 1]}; ac = __builtin_elementwise_fma(wa, ra, ac); ac = __builtin_elementwise_fma(wb, rb, ac); acc[r] = ac[0]; acc[r + 1] = ac[1]; } }
#else
#pragma unroll
        for (int r = 0; r < 16; ++r) {
#if IDX_ASMFMA
            const float r0 = __builtin_amdgcn_fmed3f(d0[r], 0.f, INFV), r1 = __builtin_amdgcn_fmed3f(d1[r], 0.f, INFV); float a0 = acc[r], a1;
            if (hp == 0) asm("v_mul_f32 %0, %1, %2" : "=v"(a0) : "v"(Q.w[0]), "v"(r0)); else asm("v_fma_f32 %0, %1, %2, %3" : "=v"(a0) : "v"(Q.w[2]), "v"(r0), "v"(acc[r]));
            asm("v_fma_f32 %0, %1, %2, %3" : "=v"(a1) : "v"(Q.w[2 * hp + 1]), "v"(r1), "v"(a0)); acc[r] = a1;
#else
            acc[r] = __builtin_fmaf(Q.w[2 * hp + 1], __builtin_amdgcn_fmed3f(d1[r], 0.f, INFV), __builtin_fmaf(Q.w[2 * hp], __builtin_amdgcn_fmed3f(d0[r], 0.f, INFV), acc[r]));
#endif
        }
#endif
    }
    return acc;
}
constexpr int G0 = (int)(0x3F800000u >> 18);
typedef __attribute__((address_space(3))) unsigned lds_u32;
__device__ __forceinline__ void hist_add(unsigned hb, float x, unsigned inc) {
    const float xc = __builtin_amdgcn_fmed3f(x, -254.0f, 254.0f);
#if IDX_ASMBIN
    float os, y; const unsigned m = 0x7fffffffu;
    asm("v_bfi_b32 %0, %1, 1.0, %2" : "=v"(os) : "s"(m), "v"(xc));
    asm("v_add_f32 %0, %1, %2" : "=v"(y) : "v"(xc), "v"(os));
    unsigned sh; asm("v_lshrrev_b32 %0, 18, %1" : "=v"(sh) : "v"(y));
    const unsigned a = hb + (sh << 2);
#else
    const float y = xc + __uint_as_float((__float_as_uint(xc) & 0x80000000u) | 0x3F800000u);
    const unsigned a = hb + ((__float_as_uint(y) >> 18) << 2);
#endif
    __hip_atomic_fetch_add((lds_u32*)a, inc, __ATOMIC_RELAXED, __HIP_MEMORY_SCOPE_WORKGROUP);
#if PROBE_ADD2
    __hip_atomic_fetch_add((lds_u32*)(a ^ 64u), 0u, __ATOMIC_RELAXED, __HIP_MEMORY_SCOPE_WORKGROUP);
#endif
}
__device__ __forceinline__ int hword(int q, int h) { return ((h >> 8) << 13) + q * 256 + (h & 255); }
__device__ __forceinline__ int rank_to_bin(int k) { return k < 256 ? 255 - k : k; }
__device__ __forceinline__ float xthr(int ot) { if (ot == 0) return 0.f;
    const unsigned B = (unsigned)(G0 + ot) << 18; unsigned hi = __float_as_uint(__uint_as_float(B) - 1.0f), lo = 0u;
#pragma unroll 1
    for (int i = 0; i < 32; ++i) { const unsigned mid = lo + ((hi - lo) >> 1); if (__float_as_uint(__uint_as_float(mid) + 1.0f) >= B) hi = mid; else lo = mid; }
    return __uint_as_float(hi); }
__device__ __forceinline__ unsigned wave_or(unsigned v) { int x = (int)v;
    x |= __builtin_amdgcn_update_dpp(0, x, 0x111, 0xf, 0xf, true); x |= __builtin_amdgcn_update_dpp(0, x, 0x112, 0xf, 0xf, true);
    x |= __builtin_amdgcn_update_dpp(0, x, 0x114, 0xf, 0xf, true); x |= __builtin_amdgcn_update_dpp(0, x, 0x118, 0xf, 0xf, true);
    x |= __builtin_amdgcn_update_dpp(0, x, 0x142, 0xf, 0xf, true); x |= __builtin_amdgcn_update_dpp(0, x, 0x143, 0xf, 0xf, true);
    return (unsigned)__builtin_amdgcn_readlane(x, 63); }
__device__ __forceinline__ float sel32(const f32x16& a, const f32x16& b, int e) {
    const bool b0 = e & 1, b1 = e & 2, b2 = e & 4, b3 = e & 8, b4 = e & 16;
    float v0 = a[0], v1 = a[1], v2 = a[2], v3 = a[3], v4 = a[4], v5 = a[5], v6 = a[6], v7 = a[7], v8 = a[8], v9 = a[9], v10 = a[10], v11 = a[11], v12 = a[12], v13 = a[13], v14 = a[14], v15 = a[15], v16 = b[0], v17 = b[1], v18 = b[2], v19 = b[3], v20 = b[4], v21 = b[5], v22 = b[6], v23 = b[7], v24 = b[8], v25 = b[9], v26 = b[10], v27 = b[11], v28 = b[12], v29 = b[13], v30 = b[14], v31 = b[15];
    asm("" : "+v"(v0)); asm("" : "+v"(v1)); asm("" : "+v"(v2)); asm("" : "+v"(v3)); asm("" : "+v"(v4)); asm("" : "+v"(v5)); asm("" : "+v"(v6)); asm("" : "+v"(v7)); asm("" : "+v"(v8)); asm("" : "+v"(v9)); asm("" : "+v"(v10)); asm("" : "+v"(v11)); asm("" : "+v"(v12)); asm("" : "+v"(v13)); asm("" : "+v"(v14)); asm("" : "+v"(v15)); asm("" : "+v"(v16)); asm("" : "+v"(v17)); asm("" : "+v"(v18)); asm("" : "+v"(v19)); asm("" : "+v"(v20)); asm("" : "+v"(v21)); asm("" : "+v"(v22)); asm("" : "+v"(v23)); asm("" : "+v"(v24)); asm("" : "+v"(v25)); asm("" : "+v"(v26)); asm("" : "+v"(v27)); asm("" : "+v"(v28)); asm("" : "+v"(v29)); asm("" : "+v"(v30)); asm("" : "+v"(v31));
    const float p0 = b0 ? v1 : v0, p1 = b0 ? v3 : v2, p2 = b0 ? v5 : v4, p3 = b0 ? v7 : v6, p4 = b0 ? v9 : v8, p5 = b0 ? v11 : v10, p6 = b0 ? v13 : v12, p7 = b0 ? v15 : v14, p8 = b0 ? v17 : v16, p9 = b0 ? v19 : v18, p10 = b0 ? v21 : v20, p11 = b0 ? v23 : v22, p12 = b0 ? v25 : v24, p13 = b0 ? v27 : v26, p14 = b0 ? v29 : v28, p15 = b0 ? v31 : v30;
    const float q0 = b1 ? p1 : p0, q1 = b1 ? p3 : p2, q2 = b1 ? p5 : p4, q3 = b1 ? p7 : p6, q4 = b1 ? p9 : p8, q5 = b1 ? p11 : p10, q6 = b1 ? p13 : p12, q7 = b1 ? p15 : p14;
    const float r0 = b2 ? q1 : q0, r1 = b2 ? q3 : q2, r2 = b2 ? q5 : q4, r3 = b2 ? q7 : q6;
    const float s0 = b3 ? r1 : r0, s1 = b3 ? r3 : r2;
    return b4 ? s1 : s0; }
__device__ __forceinline__ unsigned spread_nib(unsigned x) { x = (x | (x << 8)) & 0x00FF00FFu; return (x | (x << 4)) & 0x0F0F0F0Fu; }


template <int HP, int MODE, bool NEXT>
__device__ __forceinline__ void pstage(f32x16& acc, const f32x16& dc0, const f32x16& dc1, f32x16& dn0, f32x16& dn1, const bf16x8 ka, const bf16x8 kb,
                                       const bf16x8 qa0, const bf16x8 qa1, const bf16x8 qb0, const bf16x8 qb1, const float wA, const float wB,
                                       const unsigned hb, const unsigned inc, const int s0, const int t, const int hi, const float XU, const float XL, unsigned& wn, unsigned& wl) {
    const f32x16 zz = {0.f, 0.f, 0.f, 0.f, 0.f, 0.f, 0.f, 0.f, 0.f, 0.f, 0.f, 0.f, 0.f, 0.f, 0.f, 0.f};
    float INFV; asm("s_mov_b32 %0, 0x7f800000" : "=s"(INFV));
#pragma unroll
    for (int c = 3; c >= 0; --c) {
        if (NEXT) {
            if (c == 3) dn0 = __builtin_amdgcn_mfma_f32_32x32x16_bf16(ka, qa0, zz, 0, 0, 0);
            else if (c == 2) dn1 = __builtin_amdgcn_mfma_f32_32x32x16_bf16(ka, qb0, zz, 0, 0, 0);
            else if (c == 1) dn0 = __builtin_amdgcn_mfma_f32_32x32x16_bf16(kb, qa1, dn0, 0, 0, 0);
            else dn1 = __builtin_amdgcn_mfma_f32_32x32x16_bf16(kb, qb1, dn1, 0, 0, 0);
            __builtin_amdgcn_sched_barrier(0);
        }
#pragma unroll
        for (int r = 4 * c + 3; r >= 4 * c; --r) {
            const float r0 = __builtin_amdgcn_fmed3f(dc0[r], 0.f, INFV), r1 = __builtin_amdgcn_fmed3f(dc1[r], 0.f, INFV);
            float x = __builtin_fmaf(wB, r1, __builtin_fmaf(wA, r0, HP == 0 ? 0.f : acc[r]));
            if (MODE == 4) { if (s0 + crow(r, hi) > t) x = -__builtin_inff(); }
            acc[r] = x;
            if (MODE == 1) hist_add(hb, x, inc);
            if (MODE == 2) { if (s0 + crow(r, hi) <= t) hist_add(hb, x, inc); }
            if (MODE == 3 || MODE == 4) { const float t1 = x - XU, t2 = x - XL; wn = __builtin_amdgcn_alignbit(wn, __float_as_uint(t1), 31); wl = __builtin_amdgcn_alignbit(wl, __float_as_uint(t2), 31); }
        }
        if (NEXT) __builtin_amdgcn_sched_barrier(0);
    }
}
__device__ __forceinline__ void index_unit(const unsigned short* P, const unsigned short* KC, unsigned* MK, unsigned* ZWg, unsigned char* lds, int b, int qt, int tid) {
    const int lane = tid & 63, wave = __builtin_amdgcn_readfirstlane(tid >> 6), r32 = lane & 31, hi = lane >> 5;
    unsigned* hist32 = (unsigned*)(lds + L_HIST); unsigned* cand_s = (unsigned*)(lds + L_HIST); unsigned* cand_i = (unsigned*)(lds + L_HIST + 32768);     unsigned* zc = (unsigned*)(lds + L_ZC); int* par = (int*)(lds + L_PAR);
    const int t = qt * 32 + r32; const size_t qrow = (size_t)b * SEQ + t;
    const int kt_max = (qt * 32 + 31) >> 6, NTW = ((qt >> 3) + 1) * 4;
    const unsigned short* KI = KC + (size_t)b * SEQ * 32;
    QFrag Q; float invw;
    for (int rh_ = 0; rh_ < REP_HEAD; ++rh_) { asm volatile("" ::: "memory");
    { const unsigned short* qp = P + qrow * NP + N_QI + hi * 8; float var = 0.f;
#pragma unroll
        for (int h = 0; h < 4; ++h) { float s = 0.f;
#pragma unroll
            for (int ks = 0; ks < 2; ++ks) { Q.q[h][ks] = *(const bf16x8*)(qp + h * 32 + ks * 16);
#pragma unroll
                for (int j = 0; j < 8; ++j) { const float v = bf2f((unsigned short)Q.q[h][ks][j]); s += v * v; } }
            s += shx(s, 32, lane); Q.w[h] = bf2f(P[qrow * NP + N_WI + h]); var += Q.w[h] * Q.w[h] * s; }
        invw = 82.7f / sqrtf(var > 1e-20f ? var : 1e-20f);
#pragma unroll
        for (int h = 0; h < 4; ++h) Q.w[h] *= invw; }
    __syncthreads();
    { typedef unsigned u32x4z __attribute__((ext_vector_type(4))); for (int i = tid; i < (L_PAR + 2048) / 16; i += NTHR) ((__attribute__((address_space(3))) u32x4z*)lds)[i] = (u32x4z){0u, 0u, 0u, 0u}; }
    __syncthreads(); }
    __attribute__((address_space(3))) unsigned char* kbuf = (__attribute__((address_space(3))) unsigned char*)lds + L_KBUF + wave * 4096;
#define IDX_KISSUE(kt_) do { const unsigned short* kp_ = KI + (size_t)(kt_) * 2048 + lane * 8;        \
        __builtin_amdgcn_global_load_lds((const unsigned*)kp_, (__attribute__((address_space(3))) unsigned*)kbuf, 16, 0, 0); \
        __builtin_amdgcn_global_load_lds((const unsigned*)(kp_ + 512), (__attribute__((address_space(3))) unsigned*)(kbuf + 1024), 16, 0, 0); \
        __builtin_amdgcn_global_load_lds((const unsigned*)(kp_ + 1024), (__attribute__((address_space(3))) unsigned*)(kbuf + 2048), 16, 0, 0); \
        __builtin_amdgcn_global_load_lds((const unsigned*)(kp_ + 1536), (__attribute__((address_space(3))) unsigned*)(kbuf + 3072), 16, 0, 0); } while (0)
#define IDX_KREAD(dst) do { const int ko_ = r32 * 64 + hi * 16;                                     \
        dst[0] = *(__attribute__((address_space(3))) bf16x8*)(kbuf + ko_); dst[1] = *(__attribute__((address_space(3))) bf16x8*)(kbuf + ko_ + 32); \
        dst[2] = *(__attribute__((address_space(3))) bf16x8*)(kbuf + ko_ + 2048); dst[3] = *(__attribute__((address_space(3))) bf16x8*)(kbuf + ko_ + 2080); } while (0)
#define IDX_KTAKE(dst, cnt_) do { asm volatile("s_waitcnt vmcnt(" cnt_ ")" ::: "memory"); IDX_KREAD(dst); asm volatile("s_waitcnt lgkmcnt(0)" ::: "memory"); } while (0)
    const unsigned hb = (unsigned)(size_t)((__attribute__((address_space(3))) unsigned char*)lds) + L_HIST + r32 * 1024 - 4 * G0;
#if IDX_PRIO
    if (wave >= 4) __builtin_amdgcn_s_setprio(1);
#endif
    const int qlo = qt * 32;
#define IDX_PRO(dA, dB) do { const f32x16 zz_ = {0.f, 0.f, 0.f, 0.f, 0.f, 0.f, 0.f, 0.f, 0.f, 0.f, 0.f, 0.f, 0.f, 0.f, 0.f, 0.f}; \
        dA = __builtin_amdgcn_mfma_f32_32x32x16_bf16(kc[0], Q.q[0][0], zz_, 0, 0, 0); dB = __builtin_amdgcn_mfma_f32_32x32x16_bf16(kc[0], Q.q[1][0], zz_, 0, 0, 0); \
        dA = __builtin_amdgcn_mfma_f32_32x32x16_bf16(kc[1], Q.q[0][1], dA, 0, 0, 0); dB = __builtin_amdgcn_mfma_f32_32x32x16_bf16(kc[1], Q.q[1][1], dB, 0, 0, 0); } while (0)
#define IDX_QHI Q.q[2][0], Q.q[2][1], Q.q[3][0], Q.q[3][1]
#define IDX_QLO Q.q[0][0], Q.q[0][1], Q.q[1][0], Q.q[1][1]
    for (int rp1 = 0; rp1 < REP_P1; ++rp1) { bf16x8 kc[4]; const unsigned inc1 = (rp1 & 1) ? 0xffffffffu : 1u; if (wave <= kt_max) IDX_KISSUE(wave);
      for (int kt = wave; kt <= kt_max; kt += 8) {
        IDX_KTAKE(kc, "0"); if (kt + 8 <= kt_max) IDX_KISSUE(kt + 8);
        if (kt * 64 + 63 <= qlo) {
#pragma unroll
            for (int sub = 0; sub < 2; ++sub) { const f32x16 sc = score_sub(kc[2 * sub], kc[2 * sub + 1], Q);
#pragma unroll
                for (int r = 0; r < 16; ++r) hist_add(hb, sc[r], inc1); }
        } else {
#pragma unroll
            for (int sub = 0; sub < 2; ++sub) { const f32x16 sc = score_sub(kc[2 * sub], kc[2 * sub + 1], Q); const int s0 = kt * 64 + sub * 32;
#pragma unroll
                for (int r = 0; r < 16; ++r) { if (s0 + crow(r, hi) <= t) hist_add(hb, sc[r], inc1); } }
        }
      } }
    __syncthreads();
    for (int rr_ = 0; rr_ < REP_RES; ++rr_) { __syncthreads(); asm volatile("" ::: "memory");
    { typedef unsigned u32x4r __attribute__((ext_vector_type(4)));
        const int q = tid >> 4, j = tid & 15, N = qt * 32 + q + 1; const bool neg = j >= 8;
        const unsigned* hs = hist32 + (neg ? 8192 + q * 256 + 32 * (j - 8) : q * 256 + 224 - 32 * j); int c = 0;
#pragma unroll
        for (int u = 0; u < 8; ++u) { const u32x4r v = *(const u32x4r*)(hs + 4 * ((u + (j >> 1)) & 7)); c += (int)(v[0] + v[1] + v[2] + v[3]); }
        int incl = c;
#pragma unroll
        for (int o = 1; o < 16; o <<= 1) { const int v = __builtin_amdgcn_ds_bpermute(((lane - o) & 63) << 2, incl); if (j >= o) incl += v; }
        const int excl = incl - c;
        if (N <= 256) { if (j == 0) par[P_MODE * 32 + q] = 0; }
        else if (excl < 256 && 256 <= incl) { u32x4r w[8];
#pragma unroll
            for (int u = 0; u < 8; ++u) w[u] = *(const u32x4r*)(hs + 4 * u);
            int above = excl, isel = -1, cntb = 0, ab = 0;
#pragma unroll
            for (int i = 0; i < 32; ++i) { const int cb = (int)(neg ? w[i >> 2][i & 3] : w[(31 - i) >> 2][(31 - i) & 3]); if (isel < 0 && above + cb >= 256) { isel = i; cntb = cb; ab = above; } above += cb; }
            const int bsel = rank_to_bin(32 * j + isel), ot = bsel & 255; const float* XT = (const float*)(lds + L_XT);
            par[P_BSTAR * 32 + q] = bsel; par[P_KK * 32 + q] = 256 - ab; par[P_MODE * 32 + q] = (bsel != 0 && cntb > CAP) ? 3 : 1; if (bsel != 0 && cntb > CAP) par[P_ANY3 * 32] = 1;
            const float xa = XT[ot], xb = XT[ot + 1];
            const float XL = neg ? -__uint_as_float(__float_as_uint(xb) - 1u) : xa;
            const float XU = neg ? (xa > 0.f ? -__uint_as_float(__float_as_uint(xa) - 1u) : 0.f) : xb;
            par[P_XL * 32 + q] = (int)__float_as_uint(XL); par[P_XU * 32 + q] = (int)__float_as_uint(XU); }
    } }
    __syncthreads();
    const int my_mode = par[P_MODE * 32 + r32], my_b = par[P_BSTAR * 32 + r32];
    __syncthreads();
    float XL = __uint_as_float((unsigned)par[P_XL * 32 + r32]), XU = __uint_as_float((unsigned)par[P_XU * 32 + r32]);
    if (my_mode == 0) { XL = -3.0e38f; XU = -3.0e38f; }
    if (my_mode == 3) { XL = __builtin_inff(); XU = __builtin_inff(); }
    const bool central = (my_mode == 1 && my_b == 0);
    unsigned* ZW = ZWg;
    for (int r2_ = 0; r2_ < REP_P2; ++r2_) { if (r2_) { __syncthreads(); for (int i = tid; i < 32 * 128; i += NTHR) zc[i] = 0u; if (tid < 32) { par[P_CCNT * 32 + tid] = 0; par[P_OVF * 32 + tid] = 0; } __syncthreads(); }
    { bf16x8 kc[4]; if (wave <= kt_max) IDX_KISSUE(wave);
      for (int kt = wave; kt < NTW; kt += 8) {
        unsigned word = 0u, wz = 0u;
        if (kt <= kt_max) {
            if (kt == wave) { IDX_KTAKE(kc, "0"); } else { IDX_KTAKE(kc, "2"); }
            if (kt + 8 <= kt_max) IDX_KISSUE(kt + 8);
            asm volatile("" ::: "memory");
            f32x16 s0v = score_sub(kc[0], kc[1], Q), s1v = score_sub(kc[2], kc[3], Q);
            const bool diag = kt * 64 + 63 > qlo;
            if (diag) {
#pragma unroll
                for (int r = 0; r < 16; ++r) { const int s = kt * 64 + crow(r, hi); if (s > t) s0v[r] = -__builtin_inff(); if (s + 32 > t) s1v[r] = -__builtin_inff(); } }
            unsigned wn = 0u, wl = 0u;
#pragma unroll
            for (int e = 31; e >= 0; --e) { const float x = (e < 16) ? s0v[e & 15] : s1v[e & 15]; float t1, t2;
#if IDX_ASMBIN
                asm("v_sub_f32 %0, %1, %2" : "=v"(t1) : "v"(x), "v"(XU)); asm("v_sub_f32 %0, %1, %2" : "=v"(t2) : "v"(x), "v"(XL));
#else
                t1 = x - XU; t2 = x - XL;
#endif
                wn = __builtin_amdgcn_alignbit(wn, __float_as_uint(t1), 31); wl = __builtin_amdgcn_alignbit(wl, __float_as_uint(t2), 31); }
            word = ~wn; const unsigned inb = wn & ~wl;
            if ((REP_P2 == 1 || r2_ > 0) && __any(inb != 0u)) {
                unsigned zb = 0u;
                if (__any(central && inb != 0u)) { unsigned UZ = wave_or(central ? inb : 0u);
                    while (UZ) { const int e = __builtin_ctz(UZ); UZ &= UZ - 1u; const float x = (e < 16) ? s0v[e & 15] : s1v[e & 15];
                        if (central && ((inb >> e) & 1u) && x == 0.f) zb |= (1u << e); }
                    if (zb) lds_add(&zc[r32 * 128 + kt], (unsigned)__builtin_popcount(zb)); wz = zb; }
                const unsigned cb = inb & ~zb; const int cnt = __builtin_popcount(cb); int pos = 0;
                if (cnt) { pos = (int)lds_add((unsigned*)&par[P_CCNT * 32 + r32], (unsigned)cnt); if (pos + cnt > CAP) par[P_OVF * 32 + r32] = 1; }
                unsigned m = cb; int slot = pos;
                while (__any(m != 0u)) { const int e = (int)__builtin_ctz(m | 0x80000000u); const float x = sel32(s0v, s1v, e);
                    if (m != 0u && slot < CAP) { cand_s[r32 * CAP + slot] = __float_as_uint(x); cand_i[r32 * CAP + slot] = (unsigned)(kt * 64 + 32 * (e >> 4) + ((e & 3) + 8 * ((e & 15) >> 2) + 4 * hi)); }
                    m &= m - 1u; ++slot; }
            }
        }
        MK[((size_t)(b * 256 + qt) * 128 + kt) * 64 + lane] = word; ZW[kt * 64 + lane] = wz;
      } } }
#if IDX_PRIO
    __builtin_amdgcn_s_setprio(0);
#endif
    asm volatile("s_waitcnt vmcnt(0)" ::: "memory");
    __syncthreads();
    for (int rk_ = 0; rk_ < REP_RANK; ++rk_) { if (rk_) __syncthreads(); asm volatile("" ::: "memory");
    { const int q = tid >> 4, j = tid & 15, mode = par[P_MODE * 32 + q], kk = par[P_KK * 32 + q], bq = par[P_BSTAR * 32 + q];
        const int n = par[P_CCNT * 32 + q] < CAP ? par[P_CCNT * 32 + q] : CAP, n4 = (n + 3) & ~3;
        if (mode == 1 && par[P_OVF * 32 + q]) { if (j == 0) { par[P_MODE * 32 + q] = 3; par[P_ANY3 * 32] = 1; } }
        else if (mode == 1 && kk <= n) {
            if (j < n4 - n) { cand_s[q * CAP + n + j] = 0xFF800000u; cand_i[q * CAP + n + j] = 0xFFFFFFFFu; }
            if (j == 0) { par[P_NRANK * 32 + q] = n; par[P_TSTAR * 32 + q] = -1; } }
        else if (mode == 1 && bq == 0) {
            const int need = kk - n; int zl[8], c = 0;
#pragma unroll
            for (int u = 0; u < 8; ++u) { zl[u] = (int)zc[q * 128 + 8 * j + u]; c += zl[u]; }
            int incl = c;
#pragma unroll
            for (int o = 1; o < 16; o <<= 1) { const int v = __builtin_amdgcn_ds_bpermute(((lane - o) & 63) << 2, incl); if (j >= o) incl += v; }
            int cum = incl - c;
            if (j == 0) { par[P_TAU * 32 + q] = (int)0xFF800000u; par[P_CUT * 32 + q] = -1; }
            if (cum < need && need <= incl) { int ts = 8 * j + 7, rs = 1; bool done = false;
#pragma unroll
                for (int u = 0; u < 8; ++u) { if (!done && cum + zl[u] >= need) { ts = 8 * j + u; rs = need - cum; done = true; } cum += zl[u]; }
                par[P_TSTAR * 32 + q] = ts; par[P_RSTAR * 32 + q] = rs; } }
        else if (mode == 1) { if (j == 0) { par[P_MODE * 32 + q] = 3; par[P_ANY3 * 32] = 1; } }
    }
    __syncthreads();
    if (tid < 64) { const int q = lane & 31; int incl = par[P_NRANK * 32 + q];
#pragma unroll
        for (int o = 1; o < 32; o <<= 1) { const int v = __builtin_amdgcn_ds_bpermute(((lane - o) & 63) << 2, incl); if (q >= o) incl += v; }
        if (lane < 32) par[P_PRE * 32 + q] = incl; }
    __syncthreads();
    { typedef unsigned u32x4v __attribute__((ext_vector_type(4)));
        const int total = par[P_PRE * 32 + 31];
        for (int g = tid; g < total; g += NTHR) {
            int q = 0;
#pragma unroll
            for (int st = 16; st >= 1; st >>= 1) { if (par[P_PRE * 32 + q + st - 1] <= g) q += st; }
            const int i = g - (q ? par[P_PRE * 32 + q - 1] : 0), n = par[P_NRANK * 32 + q], n4 = (n + 3) & ~3, kk = par[P_KK * 32 + q];
            const unsigned cix = cand_s[q * CAP + i], ciy = cand_i[q * CAP + i]; const float si = __uint_as_float(cix); int rank = 0;
#pragma unroll 2
            for (int m2 = 0; m2 < n4; m2 += 4) { const u32x4v sv = *(const u32x4v*)&cand_s[q * CAP + m2], iv = *(const u32x4v*)&cand_i[q * CAP + m2];
#pragma unroll
                for (int u = 0; u < 4; ++u) { const float sm = __uint_as_float(sv[u]); rank += (sm > si || (sm == si && iv[u] < ciy)) ? 1 : 0; } }
            if (rank == kk - 1) { par[P_TAU * 32 + q] = (int)cix; par[P_CUT * 32 + q] = (int)ciy; } } }
    __syncthreads(); }
    for (int rpp = 0; rpp < REP_PATCH; ++rpp)
    { const int q = tid >> 4, j = tid & 15, mode = par[P_MODE * 32 + q];
        if (mode == 1) { const int n = par[P_CCNT * 32 + q]; const float tau = __uint_as_float((unsigned)par[P_TAU * 32 + q]); const unsigned cut = (unsigned)par[P_CUT * 32 + q]; const int ts = par[P_TSTAR * 32 + q], rs = par[P_RSTAR * 32 + q];
            unsigned* mq = MK + (size_t)(b * 256 + qt) * 128 * 64 + q;
#pragma unroll 1
            for (int i = j; i < n; i += 16) { const float sc = __uint_as_float(cand_s[q * CAP + i]); const unsigned s = cand_i[q * CAP + i];
                if (sc > tau || (sc == tau && s <= cut)) { const int kap = s & 63, k5 = kap & 31, hh = (k5 >> 2) & 1, e = (k5 & 3) + 4 * (k5 >> 3) + 16 * (kap >> 5);
                    __hip_atomic_fetch_or(mq + (s >> 6) * 64 + 32 * hh, 1u << e, __ATOMIC_RELAXED, __HIP_MEMORY_SCOPE_AGENT); } }
            if (ts >= 0) {
                unsigned zw0[8], zw1[8];
#pragma unroll
                for (int u = 0; u < 8; ++u) { const int kt = j + 16 * u; zw0[u] = 0u; zw1[u] = 0u; if (kt <= ts) { zw0[u] = __hip_atomic_load(ZW + kt * 64 + q, __ATOMIC_RELAXED, __HIP_MEMORY_SCOPE_AGENT); zw1[u] = __hip_atomic_load(ZW + kt * 64 + 32 + q, __ATOMIC_RELAXED, __HIP_MEMORY_SCOPE_AGENT); } }
#pragma unroll
                for (int u = 0; u < 8; ++u) { const int kt = j + 16 * u; if (kt <= ts) { const unsigned w0 = zw0[u], w1 = zw1[u]; unsigned a0 = w0, a1 = w1;
                    if (kt == ts) { const unsigned lo32 = spread_nib(w0 & 0xffffu) | (spread_nib(w1 & 0xffffu) << 4), hi32 = spread_nib(w0 >> 16) | (spread_nib(w1 >> 16) << 4);
                        const unsigned long long ord = (unsigned long long)lo32 | ((unsigned long long)hi32 << 32);
                        int nn = rs, kap = 0; unsigned w = (unsigned)ord; int c = __builtin_popcount(w);
                        if (nn > c) { nn -= c; w = (unsigned)(ord >> 32); kap = 32; }
                        c = __builtin_popcount(w & 0xffffu); if (nn > c) { nn -= c; w >>= 16; kap += 16; }
                        c = __builtin_popcount(w & 0xffu); if (nn > c) { nn -= c; w >>= 8; kap += 8; }
                        c = __builtin_popcount(w & 0xfu); if (nn > c) { nn -= c; w >>= 4; kap += 4; }
                        c = __builtin_popcount(w & 0x3u); if (nn > c) { nn -= c; w >>= 2; kap += 2; }
                        c = (int)(w & 1u); if (nn > c) kap += 1;
                        unsigned k0 = 0u, k1 = 0u;
#pragma unroll
                        for (int e = 0; e < 32; ++e) { const int pos0 = 32 * (e >> 4) + crow(e & 15, 0), pos1 = 32 * (e >> 4) + crow(e & 15, 1); if (pos0 <= kap) k0 |= (1u << e); if (pos1 <= kap) k1 |= (1u << e); }
                        a0 &= k0; a1 &= k1; }
                    if (a0) __hip_atomic_fetch_or(mq + kt * 64, a0, __ATOMIC_RELAXED, __HIP_MEMORY_SCOPE_AGENT);
                    if (a1) __hip_atomic_fetch_or(mq + kt * 64 + 32, a1, __ATOMIC_RELAXED, __HIP_MEMORY_SCOPE_AGENT); } } }
        }
    }
    __syncthreads();
}
#undef IDX_KISSUE
#undef IDX_KTAKE
#undef IDX_KREAD
}
namespace glab {
typedef short bf16x8 __attribute__((ext_vector_type(8)));
typedef short s16x4 __attribute__((ext_vector_type(4)));
typedef float f32x16 __attribute__((ext_vector_type(16)));
typedef float f32x4 __attribute__((ext_vector_type(4)));
typedef unsigned u32x4 __attribute__((ext_vector_type(4)));
typedef unsigned u32x2 __attribute__((ext_vector_type(2)));
typedef float f32x2_t __attribute__((ext_vector_type(2))); typedef __bf16 bf16x2_t __attribute__((ext_vector_type(2)));
#define GLAS __attribute__((address_space(3)))
constexpr int RAW_Q = 0, RAW_K = 6144, RAW_V = 12288, RAW_Z = 24576, OP_QE = 26624, OP_KE = 33792, OP_KDT = 40960, OP_VT = 47872, OP_DEC = 61696, OP_BLK_BYTES = 35328  ,
              OP_BLK1 = 61952  , OP_ST = 97280, ST_BYTES = 10752;
__device__ __forceinline__ unsigned cvtpk(float lo, float hi) { f32x2_t v = {lo, hi}; bf16x2_t b = __builtin_convertvector(v, bf16x2_t); return __builtin_bit_cast(unsigned, b); }
__device__ __forceinline__ int crow(int r, int hi) { return (r & 3) + 8 * (r >> 2) + 4 * hi; }
__device__ __forceinline__ float bfl(unsigned short b) { return __uint_as_float((unsigned)b << 16); }


__device__ __forceinline__ void gla_prep_item(const unsigned short* P, unsigned char* GOP, const float* w2, const float* gb, unsigned char* ldsg, int item, int tid) {
    GLAS unsigned char* lds = (GLAS unsigned char*)ldsg;
    const int lane = tid & 63; const int b = item >> 9, h = (item >> 7) & 3, n = item & 127;
    const size_t m0 = (size_t)b * SEQ + (size_t)n * 64;
    __syncthreads();
#define GLA_PCOL(c) (((c) < 6) ? (N_GQ + h * 48 + (c) * 8) : ((c) < 12) ? (N_GK + h * 48 + ((c) - 6) * 8) : ((c) < 24) ? (N_GV + h * 96 + ((c) - 12) * 8) : (N_GZ + ((c) - 24) * 8))
#define GLA_PDST(row, c) (((c) < 6) ? (RAW_Q + (row) * 96 + (c) * 16) : ((c) < 12) ? (RAW_K + (row) * 96 + ((c) - 6) * 16) : ((c) < 24) ? (RAW_V + (row) * 192 + ((c) - 12) * 16) : (RAW_Z + (row) * 32 + ((c) - 24) * 16))
#pragma unroll
    for (int k = 0; k < 4; ++k) { const int p = tid + 512 * k; if (p < 1664) { const int row = p / 26, c = p % 26; *(GLAS u32x4*)(lds + GLA_PDST(row, c)) = *(const u32x4*)(P + (m0 + row) * NP + GLA_PCOL(c)); } }
    __syncthreads();
    const int sd = tid >> 3, tg = tid & 7;
    if (tid < 384) {
            float c[8], w2c[16]; const float bc = gb[h * 48 + sd];
#pragma unroll
            for (int r = 0; r < 16; ++r) w2c[r] = w2[(size_t)r * 192 + h * 48 + sd];
#pragma unroll
            for (int tt = 0; tt < 8; ++tt) { const int t = 8 * tg + tt; const u32x4 z0 = *(GLAS u32x4*)(lds + RAW_Z + t * 32), z1 = *(GLAS u32x4*)(lds + RAW_Z + t * 32 + 16); float z = bc;
#pragma unroll
                for (int k = 0; k < 4; ++k) { z += w2c[2 * k] * __uint_as_float(z0[k] << 16) + w2c[2 * k + 1] * __uint_as_float(z0[k] & 0xffff0000u); z += w2c[8 + 2 * k] * __uint_as_float(z1[k] << 16) + w2c[8 + 2 * k + 1] * __uint_as_float(z1[k] & 0xffff0000u); }
                const float ls = fminf(z, 0.f) - __logf(1.0f + __expf(-fabsf(z)));
                c[tt] = ls * (1.0f / 16.0f) + (tt ? c[tt - 1] : 0.f); }
            float incl = c[7];
#pragma unroll
            for (int o = 1; o < 8; o <<= 1) { const float v = __builtin_bit_cast(float, __builtin_amdgcn_ds_bpermute(((lane - o) & 63) << 2, __builtin_bit_cast(int, incl))); if (tg >= o) incl += v; }
            const float off = incl - c[7];
            const float bl = __builtin_bit_cast(float, __builtin_amdgcn_ds_bpermute((lane | 7) << 2, __builtin_bit_cast(int, incl)));
            unsigned kdp[4];
#pragma unroll
            for (int tt = 0; tt < 8; tt += 2) { float kdv[2];
#pragma unroll
                for (int u = 0; u < 2; ++u) { const int t = 8 * tg + tt + u; const float bb = off + c[tt + u];
                    const float q = bfl(*(GLAS unsigned short*)(lds + RAW_Q + (t * 48 + sd) * 2)), kx = bfl(*(GLAS unsigned short*)(lds + RAW_K + (t * 48 + sd) * 2));
                    const float e1 = __expf(bb), e2 = __expf(-bb), e3 = __expf(bl - bb);
                    *(GLAS unsigned short*)(lds + OP_QE + (t * 56 + sd) * 2) = (unsigned short)(cvtpk(q * e1, 0.f) & 0xffffu);
                    *(GLAS unsigned short*)(lds + OP_KE + (t * 56 + sd) * 2) = (unsigned short)(cvtpk(kx * e2, 0.f) & 0xffffu);
                    kdv[u] = kx * e3; }
                kdp[tt >> 1] = cvtpk(kdv[0], kdv[1]); }
            *(GLAS u32x4*)(lds + OP_KDT + (sd * 72 + 8 * tg) * 2) = (u32x4){kdp[0], kdp[1], kdp[2], kdp[3]};
            if (tg == 7) ((GLAS float*)(lds + OP_DEC))[sd] = __expf(bl);
    } else {
            for (int idx = tid - 384; idx < 96 * 8; idx += 128) { const int v = idx % 96, t8 = idx / 96; unsigned pk[4];
#pragma unroll
                for (int tt = 0; tt < 8; tt += 2) { const unsigned a0 = *(GLAS unsigned short*)(lds + RAW_V + ((8 * t8 + tt) * 96 + v) * 2), a1 = *(GLAS unsigned short*)(lds + RAW_V + ((8 * t8 + tt + 1) * 96 + v) * 2); pk[tt >> 1] = a0 | (a1 << 16); }
                *(GLAS u32x4*)(lds + OP_VT + (v * 72 + 8 * t8) * 2) = (u32x4){pk[0], pk[1], pk[2], pk[3]}; }
    }
    __syncthreads();
    unsigned char* dst = GOP + (size_t)item * OP_BLK_BYTES;
    for (int i = tid; i < (OP_DEC + 192 - OP_QE) / 16; i += NTHR) *(u32x4*)(dst + i * 16) = *(GLAS u32x4*)(lds + OP_QE + i * 16);
}
__device__ __forceinline__ void gla_prep_loop(const unsigned short* P, unsigned char* GOP, const float* w2, const float* gb, unsigned char* ldsg, int wg, int G, int tid) {
    GLAS unsigned char* lds0 = (GLAS unsigned char*)ldsg;
    const int lane = tid & 63; constexpr int NIT = BATCH * 4 * 128, BUF1 = OP_BLK1, NCP = (OP_DEC + 192 - OP_QE) / 16;
#define GLA_PCOLH(c, hh) (((c) < 6) ? (N_GQ + (hh) * 48 + (c) * 8) : ((c) < 12) ? (N_GK + (hh) * 48 + ((c) - 6) * 8) : ((c) < 24) ? (N_GV + (hh) * 96 + ((c) - 12) * 8) : (N_GZ + ((c) - 24) * 8))
#define GLA_PDST(row, c) (((c) < 6) ? (RAW_Q + (row) * 96 + (c) * 16) : ((c) < 12) ? (RAW_K + (row) * 96 + ((c) - 6) * 16) : ((c) < 24) ? (RAW_V + (row) * 192 + ((c) - 12) * 16) : (RAW_Z + (row) * 32 + ((c) - 24) * 16))
#define GLA_SRC(it_, p_) (P + ((size_t)((it_) >> 9) * SEQ + (size_t)((it_) & 127) * 64 + (p_) / 26) * NP + GLA_PCOLH((p_) % 26, ((it_) >> 7) & 3))
    __syncthreads();
    if (wg < NIT) {
#pragma unroll
        for (int k = 0; k < 4; ++k) { const int p = tid + 512 * k; if (p < 1664) *(GLAS u32x4*)(lds0 + GLA_PDST(p / 26, p % 26)) = *(const u32x4*)GLA_SRC(wg, p); } }
    float w2n[16], bcn = 0.f;
    { const int sd0 = tid >> 3, h0 = (wg >> 7) & 3;
#pragma unroll
        for (int r = 0; r < 16; ++r) w2n[r] = 0.f;
        if (tid < 384 && wg < NIT) { bcn = gb[h0 * 48 + sd0];
#pragma unroll
            for (int r = 0; r < 16; ++r) w2n[r] = w2[(size_t)r * 192 + h0 * 48 + sd0]; } }
    __syncthreads();
    int buf = 0, prev = -1;
    for (int item = wg; item < NIT; item += G, buf ^= 1) {
        GLAS unsigned char* lds = lds0 + buf * BUF1; GLAS unsigned char* ldo = lds0 + (buf ^ 1) * BUF1;
        const int nxt = item + G; const bool has_next = nxt < NIT;
        if (tid < 384) {
            const int sd = tid >> 3, tg = tid & 7;
            float c[8], w2c[16]; const float bc = bcn;
#pragma unroll
            for (int r = 0; r < 16; ++r) w2c[r] = w2n[r];
            if (has_next) { const int hn = (nxt >> 7) & 3; bcn = gb[hn * 48 + sd];
#pragma unroll
                for (int r = 0; r < 16; ++r) w2n[r] = w2[(size_t)r * 192 + hn * 48 + sd]; }
#pragma unroll
            for (int tt = 0; tt < 8; ++tt) { const int t = 8 * tg + tt; const u32x4 z0 = *(GLAS u32x4*)(lds + RAW_Z + t * 32), z1 = *(GLAS u32x4*)(lds + RAW_Z + t * 32 + 16); float z = bc;
#pragma unroll
                for (int k = 0; k < 4; ++k) { z += w2c[2 * k] * __uint_as_float(z0[k] << 16) + w2c[2 * k + 1] * __uint_as_float(z0[k] & 0xffff0000u); z += w2c[8 + 2 * k] * __uint_as_float(z1[k] << 16) + w2c[8 + 2 * k + 1] * __uint_as_float(z1[k] & 0xffff0000u); }
                const float ls = fminf(z, 0.f) - __logf(1.0f + __expf(-fabsf(z)));
                c[tt] = ls * (1.0f / 16.0f) + (tt ? c[tt - 1] : 0.f); }
            float incl = c[7];
#pragma unroll
            for (int o = 1; o < 8; o <<= 1) { const float v = __builtin_bit_cast(float, __builtin_amdgcn_ds_bpermute(((lane - o) & 63) << 2, __builtin_bit_cast(int, incl))); if (tg >= o) incl += v; }
            const float off = incl - c[7];
            const float bl = __builtin_bit_cast(float, __builtin_amdgcn_ds_bpermute((lane | 7) << 2, __builtin_bit_cast(int, incl)));
            unsigned kdp[4];
#pragma unroll
            for (int tt = 0; tt < 8; tt += 2) { float kdv[2];
#pragma unroll
                for (int u = 0; u < 2; ++u) { const int t = 8 * tg + tt + u; const float bb = off + c[tt + u];
                    const float q = bfl(*(GLAS unsigned short*)(lds + RAW_Q + (t * 48 + sd) * 2)), kx = bfl(*(GLAS unsigned short*)(lds + RAW_K + (t * 48 + sd) * 2));
                    const float e1 = __expf(bb), e2 = __expf(-bb), e3 = __expf(bl - bb);
                    *(GLAS unsigned short*)(lds + OP_QE + (t * 56 + sd) * 2) = (unsigned short)(cvtpk(q * e1, 0.f) & 0xffffu);
                    *(GLAS unsigned short*)(lds + OP_KE + (t * 56 + sd) * 2) = (unsigned short)(cvtpk(kx * e2, 0.f) & 0xffffu);
                    kdv[u] = kx * e3; }
                kdp[tt >> 1] = cvtpk(kdv[0], kdv[1]); }
            *(GLAS u32x4*)(lds + OP_KDT + (sd * 72 + 8 * tg) * 2) = (u32x4){kdp[0], kdp[1], kdp[2], kdp[3]};
            if (tg == 7) ((GLAS float*)(lds + OP_DEC))[sd] = __expf(bl);
        } else {
            const int ht = tid - 384;
            u32x4 ra[7];
            if (has_next) {
#pragma unroll
                for (int k = 0; k < 7; ++k) ra[k] = *(const u32x4*)GLA_SRC(nxt, ht + 128 * k); }
            if (prev >= 0) { unsigned char* dst = GOP + (size_t)prev * OP_BLK_BYTES;
#pragma unroll 6
                for (int i = ht; i < NCP; i += 128) *(u32x4*)(dst + i * 16) = *(GLAS u32x4*)(ldo + OP_QE + i * 16); }
            u32x4 rb[6];
            if (has_next) {
#pragma unroll
                for (int k = 0; k < 7; ++k) { const int p = ht + 128 * k; *(GLAS u32x4*)(ldo + GLA_PDST(p / 26, p % 26)) = ra[k]; }
#pragma unroll
                for (int k = 0; k < 6; ++k) rb[k] = *(const u32x4*)GLA_SRC(nxt, ht + 128 * (7 + k)); }
            for (int idx = ht; idx < 96 * 8; idx += 128) { const int v = idx % 96, t8 = idx / 96; unsigned pk[4];
#pragma unroll
                for (int tt = 0; tt < 8; tt += 2) { const unsigned a0 = *(GLAS unsigned short*)(lds + RAW_V + ((8 * t8 + tt) * 96 + v) * 2), a1 = *(GLAS unsigned short*)(lds + RAW_V + ((8 * t8 + tt + 1) * 96 + v) * 2); pk[tt >> 1] = a0 | (a1 << 16); }
                *(GLAS u32x4*)(lds + OP_VT + (v * 72 + 8 * t8) * 2) = (u32x4){pk[0], pk[1], pk[2], pk[3]}; }
            if (has_next) {
#pragma unroll
                for (int k = 0; k < 6; ++k) { const int p = ht + 128 * (7 + k); *(GLAS u32x4*)(ldo + GLA_PDST(p / 26, p % 26)) = rb[k]; } }
        }
        __syncthreads();
        prev = item;
    }
    if (prev >= 0) { GLAS unsigned char* ldl = lds0 + (buf ^ 1) * BUF1; unsigned char* dst = GOP + (size_t)prev * OP_BLK_BYTES;
        for (int i = tid; i < NCP; i += NTHR) *(u32x4*)(dst + i * 16) = *(GLAS u32x4*)(ldl + OP_QE + i * 16); }
    __syncthreads();
#undef GLA_SRC
#undef GLA_PDST
#undef GLA_PCOLH
}
__device__ __forceinline__ void gla_seq_unit(const unsigned short* P, unsigned short* Y, const unsigned char* GOP, const float* ng, unsigned char* ldsg, int b, int h, int tid) {
    GLAS unsigned char* lds = (GLAS unsigned char*)ldsg;
    const int lane = tid & 63, wave = __builtin_amdgcn_readfirstlane(tid >> 6), r32 = lane & 31, hi = lane >> 5, l15 = lane & 15, quad = lane >> 4;
    const size_t rowbase = (size_t)b * SEQ; const unsigned char* gsrc = GOP + (size_t)((b * 4 + h) * 128) * OP_BLK_BYTES;
    constexpr int NPC = (OP_DEC + 192 - OP_QE) / 16;
    constexpr int SQ_BLK0 = 0, SQ_BLK1 = OP_BLK_BYTES, SQ_ST = 2 * OP_BLK_BYTES  , SQ_OB = SQ_ST + 2 * ST_BYTES  , SQ_OB_BYTES = 64 * 96 * 2, SQ_NG = SQ_OB + 2 * SQ_OB_BYTES  ;
    __syncthreads();
    for (int i = tid; i < 2 * ST_BYTES / 4; i += NTHR) ((GLAS unsigned*)(lds + SQ_ST))[i] = 0u;
    if (tid < 96) ((GLAS float*)(lds + SQ_NG))[tid] = ng[tid];
    u32x4 rg[5];
#pragma unroll
    for (int k = 0; k < 5; ++k) { const int i = tid + 512 * k; if (i < NPC) rg[k] = *(const u32x4*)(gsrc + (size_t)i * 16); }
#pragma unroll
    for (int k = 0; k < 5; ++k) { const int i = tid + 512 * k; if (i < NPC) *(GLAS u32x4*)(lds + SQ_BLK0 + i * 16) = rg[k]; }
#pragma unroll
    for (int k = 0; k < 5; ++k) { const int i = tid + 512 * k; if (i < NPC) rg[k] = *(const u32x4*)(gsrc + OP_BLK_BYTES + (size_t)i * 16); }
    __syncthreads();
    f32x4 S[2][3];
#pragma unroll
    for (int mt = 0; mt < 2; ++mt)
#pragma unroll
        for (int nt = 0; nt < 3; ++nt) S[mt][nt] = (f32x4){0.f, 0.f, 0.f, 0.f};
#define GLA_EPILOGUE(nn) do { const int cc_ = (nn) & 1; const size_t mm_ = rowbase + (size_t)(nn) * 64; \
        _Pragma("unroll") for (int k_ = 0; k_ < 4; ++k_) { const int vec_ = (tid - 320) + 192 * k_, t_ = vec_ / 12, v_ = (vec_ % 12) * 8; \
            const u32x4 ov_ = *(GLAS u32x4*)(lds + SQ_OB + cc_ * SQ_OB_BYTES + t_ * 192 + v_ * 2); const u32x4 gv_ = *(const u32x4*)(P + (mm_ + t_) * NP + N_GG + h * 96 + v_); \
            const f32x4 n0_ = *(GLAS f32x4*)(lds + SQ_NG + v_ * 4), n1_ = *(GLAS f32x4*)(lds + SQ_NG + v_ * 4 + 16); u32x4 yo_; \
            _Pragma("unroll") for (int e_ = 0; e_ < 4; ++e_) { const float ga_ = __uint_as_float(gv_[e_] << 16), gb_ = __uint_as_float(gv_[e_] & 0xffff0000u); \
                const float na_ = (e_ < 2) ? n0_[2 * e_] : n1_[2 * e_ - 4], nb_ = (e_ < 2) ? n0_[2 * e_ + 1] : n1_[2 * e_ - 3]; \
                yo_[e_] = cvtpk(__uint_as_float(ov_[e_] << 16) * na_ * (ga_ / (1.0f + __expf(-ga_))), __uint_as_float(ov_[e_] & 0xffff0000u) * nb_ * (gb_ / (1.0f + __expf(-gb_)))); } \
            *(u32x4*)(Y + (mm_ + t_) * DM + h * 96 + v_) = yo_; } } while (0)
    for (int n = 0; n < SEQ / 64; ++n) {
        const int cur = n & 1, nxt = cur ^ 1; const size_t m0 = rowbase + (size_t)n * 64;
        const int BO = (cur ? SQ_BLK1 : SQ_BLK0) - OP_QE;
        if (n + 1 < SEQ / 64) { const int BN = (cur ? SQ_BLK0 : SQ_BLK1) - OP_QE;
#pragma unroll
            for (int k = 0; k < 5; ++k) { const int i = tid + 512 * k; if (i < NPC) *(GLAS u32x4*)(lds + OP_QE + BN + i * 16) = rg[k]; }
            if (n + 2 < SEQ / 64) {
#pragma unroll
                for (int k = 0; k < 5; ++k) { const int i = tid + 512 * k; if (i < NPC) rg[k] = *(const u32x4*)(gsrc + (size_t)(n + 2) * OP_BLK_BYTES + (size_t)i * 16); } } }
        if (wave < 2) {
            const int it = wave; bf16x8 qf[3];
#pragma unroll
            for (int ks = 0; ks < 3; ++ks) qf[ks] = *(GLAS bf16x8*)(lds + BO + OP_QE + (32 * it + r32) * 112 + (16 * ks + 8 * hi) * 2);
            f32x16 acc[3];
#pragma unroll
            for (int vt = 0; vt < 3; ++vt)
#pragma unroll
                for (int r = 0; r < 16; ++r) acc[vt][r] = 0.f;
#pragma unroll
            for (int jt = 0; jt < 2; ++jt) if (jt <= it) {
                f32x16 X;
#pragma unroll
                for (int r = 0; r < 16; ++r) X[r] = 0.f;
#pragma unroll
                for (int ks = 0; ks < 3; ++ks) { const bf16x8 kf = *(GLAS bf16x8*)(lds + BO + OP_KE + (32 * jt + r32) * 112 + (16 * ks + 8 * hi) * 2); X = __builtin_amdgcn_mfma_f32_32x32x16_bf16(kf, qf[ks], X, 0, 0, 0); }
                if (jt == it) {
#pragma unroll
                    for (int r = 0; r < 16; ++r) if (crow(r, hi) > r32) X[r] = 0.f; }
                u32x4 p0, p1;
#pragma unroll
                for (int k = 0; k < 4; ++k) { p0[k] = cvtpk(X[2 * k], X[2 * k + 1]); p1[k] = cvtpk(X[8 + 2 * k], X[8 + 2 * k + 1]); }
                const bf16x8 pa0 = __builtin_bit_cast(bf16x8, p0), pa1 = __builtin_bit_cast(bf16x8, p1);
#pragma unroll
                for (int vt = 0; vt < 3; ++vt)
#pragma unroll
                    for (int s = 0; s < 2; ++s) { const int vo = BO + OP_VT + (32 * vt + r32) * 144 + (32 * jt + 16 * s + 4 * hi) * 2;
                        const s16x4 lo = *(GLAS s16x4*)(lds + vo), hi4 = *(GLAS s16x4*)(lds + vo + 16);
                        const bf16x8 a2 = (bf16x8){lo[0], lo[1], lo[2], lo[3], hi4[0], hi4[1], hi4[2], hi4[3]};
                        acc[vt] = __builtin_amdgcn_mfma_f32_32x32x16_bf16(a2, s ? pa1 : pa0, acc[vt], 0, 0, 0); }
            }
#pragma unroll
            for (int vt = 0; vt < 3; ++vt)
#pragma unroll
                for (int ks = 0; ks < 3; ++ks) { const bf16x8 sf = *(GLAS bf16x8*)(lds + SQ_ST + cur * ST_BYTES + (32 * vt + r32) * 112 + (16 * ks + 8 * hi) * 2); acc[vt] = __builtin_amdgcn_mfma_f32_32x32x16_bf16(sf, qf[ks], acc[vt], 0, 0, 0); }
            float ss = 0.f;
#pragma unroll
            for (int vt = 0; vt < 3; ++vt)
#pragma unroll
                for (int r = 0; r < 16; ++r) ss += acc[vt][r] * acc[vt][r];
            ss += __builtin_bit_cast(float, __builtin_amdgcn_ds_bpermute((lane ^ 32) << 2, __builtin_bit_cast(int, ss)));
            const float rn = 1.0f / sqrtf(ss * (1.0f / 96.0f) + EPS);
            GLAS unsigned char* ob = lds + SQ_OB + cur * SQ_OB_BYTES + (32 * it + r32) * 192;
#pragma unroll
            for (int vt = 0; vt < 3; ++vt)
#pragma unroll
                for (int g = 0; g < 4; ++g) { const int v0 = 32 * vt + 8 * g + 4 * hi;
                    *(GLAS u32x2*)(ob + v0 * 2) = (u32x2){cvtpk(acc[vt][4 * g] * rn, acc[vt][4 * g + 1] * rn), cvtpk(acc[vt][4 * g + 2] * rn, acc[vt][4 * g + 3] * rn)}; }
        } else if (wave < 5) {
            const int sw = wave - 2;
#pragma unroll
            for (int mt = 0; mt < 2; ++mt)
#pragma unroll
                for (int nt = 0; nt < 3; ++nt) { const int d = 16 * nt + l15; const float dec = ((GLAS float*)(lds + BO + OP_DEC))[d]; f32x4 a = S[mt][nt] * dec;
#pragma unroll
                    for (int ks = 0; ks < 2; ++ks) { const bf16x8 va = *(GLAS bf16x8*)(lds + BO + OP_VT + (32 * sw + 16 * mt + l15) * 144 + (32 * ks + 8 * quad) * 2), kb = *(GLAS bf16x8*)(lds + BO + OP_KDT + d * 144 + (32 * ks + 8 * quad) * 2);
                        a = __builtin_amdgcn_mfma_f32_16x16x32_bf16(va, kb, a, 0, 0, 0); }
                    S[mt][nt] = a;
#pragma unroll
                    for (int jj = 0; jj < 4; jj += 2) { const unsigned pk = cvtpk(a[jj], a[jj + 1]);
                        *(GLAS unsigned short*)(lds + SQ_ST + nxt * ST_BYTES + ((32 * sw + 16 * mt + 4 * quad + jj) * 56 + d) * 2) = (unsigned short)(pk & 0xffffu);
                        *(GLAS unsigned short*)(lds + SQ_ST + nxt * ST_BYTES + ((32 * sw + 16 * mt + 4 * quad + jj + 1) * 56 + d) * 2) = (unsigned short)(pk >> 16); } }
        } else if (n > 0) {
            GLA_EPILOGUE(n - 1);
        }
        __syncthreads();
    }
    if (wave >= 5) { GLA_EPILOGUE(SEQ / 64 - 1); }
    __syncthreads();
}
#undef GLA_EPILOGUE
#undef GLA_PCOL
#undef GLA_PDST
#undef GLAS
}
namespace poolb {
typedef short bf16x8 __attribute__((ext_vector_type(8)));
typedef float f32x16 __attribute__((ext_vector_type(16)));
typedef unsigned u32x4 __attribute__((ext_vector_type(4)));
typedef unsigned u32x2 __attribute__((ext_vector_type(2)));
typedef float f32x2_t __attribute__((ext_vector_type(2))); typedef __bf16 bf16x2_t __attribute__((ext_vector_type(2)));
#define PLAS __attribute__((address_space(3)))
constexpr int US_PITCH = 528  , US = 0, US_BYTES = 79 * US_PITCH  , PS = 41728, PS_PITCH = 144  , PS_WAVE = 32 * PS_PITCH  ,
              WT = PS + 8 * PS_WAVE  , WT_PITCH = 144, WT_GROUP = 64 * WT_PITCH  ;
__device__ __forceinline__ unsigned cvtpk(float lo, float hi) { f32x2_t v = {lo, hi}; bf16x2_t b = __builtin_convertvector(v, bf16x2_t); return __builtin_bit_cast(unsigned, b); }
__device__ __forceinline__ void pool_phase(const unsigned short* P, unsigned short* Y, const float* pw, const float* pscale, unsigned char* ldsg, int wg, int G, int tid) {
    PLAS unsigned char* lds = (PLAS unsigned char*)ldsg;
    const int lane = tid & 63, wave = __builtin_amdgcn_readfirstlane(tid >> 6), r32 = lane & 31, hi = lane >> 5, g = wave & 3, th = wave >> 2;
    __syncthreads();
    for (int i = tid; i < 4 * 64 * 64; i += NTHR) { const int gg = i >> 12, c = (i >> 6) & 63, d = i & 63; const float v = pw[i] * pscale[gg * 64 + d];
        *(PLAS unsigned short*)(lds + WT + gg * WT_GROUP + d * WT_PITCH + c * 2) = (unsigned short)(cvtpk(v, 0.f) & 0xffffu); }
    const int w = 2 << g;
    for (int tile = wg; tile < M / 64; tile += G) {
        const int m0 = tile * 64, t0 = m0 % SEQ;
        __syncthreads();
        for (int i = tid; i < 79 * 32; i += NTHR) { const int row = i >> 5, pc = i & 31; u32x4 v = {0u, 0u, 0u, 0u};
            if (t0 + row - 15 >= 0) v = *(const u32x4*)(P + (size_t)(m0 - 15 + row) * NP + N_PU + pc * 8);
            *(PLAS u32x4*)(lds + US + row * US_PITCH + pc * 16) = v; }
        __syncthreads();
        { float sum[32];
#pragma unroll
            for (int c = 0; c < 32; ++c) sum[c] = 0.f;
            const int tl = 32 * th + r32; const PLAS unsigned char* base = lds + US + (tl + 15) * US_PITCH + (g * 64 + 32 * hi) * 2;
            for (int j = 0; j < w; ++j) {
#pragma unroll
                for (int q4 = 0; q4 < 4; ++q4) { const u32x4 v = *(const PLAS u32x4*)(base - j * US_PITCH + q4 * 16);
#pragma unroll
                    for (int k = 0; k < 4; ++k) { const float lo = __uint_as_float(v[k] << 16), hh = __uint_as_float(v[k] & 0xffff0000u); sum[8 * q4 + 2 * k] += lo; sum[8 * q4 + 2 * k + 1] += hh; } } }
            const int pos = t0 + tl; const float inv = 1.0f / (float)((pos + 1 < w) ? pos + 1 : w);
            PLAS unsigned char* pd = lds + PS + wave * PS_WAVE + r32 * PS_PITCH + 32 * hi * 2;
#pragma unroll
            for (int q4 = 0; q4 < 4; ++q4) { u32x4 o; const u32x4 sv = *(const PLAS u32x4*)(base + q4 * 16);
#pragma unroll
                for (int k = 0; k < 4; ++k) o[k] = cvtpk(sum[8 * q4 + 2 * k] * inv - __uint_as_float(sv[k] << 16), sum[8 * q4 + 2 * k + 1] * inv - __uint_as_float(sv[k] & 0xffff0000u));
                *(PLAS u32x4*)(pd + q4 * 16) = o; } }
        asm volatile("s_waitcnt lgkmcnt(0)" ::: "memory");
        f32x16 acc[2];
#pragma unroll
        for (int dt = 0; dt < 2; ++dt) {
#pragma unroll
            for (int r = 0; r < 16; ++r) acc[dt][r] = 0.f;
#pragma unroll
            for (int ks = 0; ks < 4; ++ks) { const bf16x8 a = *(const PLAS bf16x8*)(lds + WT + g * WT_GROUP + (32 * dt + r32) * WT_PITCH + (16 * ks + 8 * hi) * 2), bq = *(const PLAS bf16x8*)(lds + PS + wave * PS_WAVE + r32 * PS_PITCH + (16 * ks + 8 * hi) * 2);
                acc[dt] = __builtin_amdgcn_mfma_f32_32x32x16_bf16(a, bq, acc[dt], 0, 0, 0); } }
        { const size_t m = (size_t)m0 + 32 * th + r32; const unsigned short* gp = P + m * NP + N_PG + g * 64; unsigned short* yp = Y + m * DM + 768 + g * 64;
#pragma unroll
            for (int dt = 0; dt < 2; ++dt)
#pragma unroll
                for (int g4 = 0; g4 < 4; ++g4) { const int d0 = 32 * dt + 8 * g4 + 4 * hi; const u32x2 gw = *(const u32x2*)(gp + d0);
                    const float g0 = __uint_as_float(gw[0] << 16), g1 = __uint_as_float(gw[0] & 0xffff0000u), g2 = __uint_as_float(gw[1] << 16), g3 = __uint_as_float(gw[1] & 0xffff0000u);
                    const float y0 = acc[dt][4 * g4] * (g0 / (1.0f + __expf(-g0))), y1 = acc[dt][4 * g4 + 1] * (g1 / (1.0f + __expf(-g1))), y2 = acc[dt][4 * g4 + 2] * (g2 / (1.0f + __expf(-g2))), y3 = acc[dt][4 * g4 + 3] * (g3 / (1.0f + __expf(-g3)));
                    *(u32x2*)(yp + d0) = (u32x2){cvtpk(y0, y1), cvtpk(y2, y3)}; } }
    }
    __syncthreads();
}
#undef PLAS
}
struct Args {
    const float* x; const float* norm_g; const float* w_in; const float* gate_w2; const float* gate_b; const float* gla_norm_g;
    const float* rel_bias; const float* pool_w; const float* pool_scale; const float* w_out; const float* final_g;
    float* out; unsigned char* ws;
    int l_lo, l_hi, ph_lo, ph_hi, single, pad;
};

__device__ __forceinline__ int src_col(int n, float& sc) {
    sc = 1.f;
    if (n < 192) { sc = 0.14433756729740643f; return n; }
    if (n < 768) return n;
    if (n < 1152) return 784 + (n - 768);
    if (n < 1536) { sc = 0.125f * LOG2E; return 1168 + (n - 1152); }
    if (n < 1920) return 1552 + (n - 1536);
    if (n < 2304) return 1936 + (n - 1920);
    if (n < 2688) return 2320 + (n - 2304);
    if (n < 2944) return 2868 + (n - 2688);
    if (n < 3200) return 3124 + (n - 2944);
    if (n < 3328) { sc = 0.17677669529663687f; return 2704 + (n - 3200); }
    if (n < 3360) return 2832 + (n - 3328);
    if (n < 3376) return 768 + (n - 3360);
    if (n < 3380) { sc = 0.5f; return 2864 + (n - 3376); }
    return -1;
}
__device__ __forceinline__ void prologue_phase(const Args& a, int wg, int G, int tid) {
    bf16* WIN = (bf16*)(a.ws + WS_WIN); bf16* WOUT = (bf16*)(a.ws + WS_WOUT);
    const long gt = (long)wg * NTHR + tid, gs = (long)G * NTHR;
    for (long i = gt; i < 4L * NP * 128; i += gs) {
        const int n = (int)(i % NP), k8 = (int)((i / NP) % 128), l = (int)(i / ((long)NP * 128));
        float sc; const int c = src_col(n, sc);
        v4u o = {0u, 0u, 0u, 0u};
        if (c >= 0) { const float* w = a.w_in + ((size_t)l * 1024 + k8 * 8) * IN_COLS + c; float v[8];
#pragma unroll
            for (int j = 0; j < 8; ++j) v[j] = w[(size_t)j * IN_COLS] * sc * a.norm_g[l * 1024 + k8 * 8 + j];
            o.x = pk2(v[0], v[1]); o.y = pk2(v[2], v[3]); o.z = pk2(v[4], v[5]); o.w = pk2(v[6], v[7]); }
        *(v4u*)(WIN + ((size_t)l * NP + n) * 1024 + k8 * 8) = o;
    }
    for (long i = gt; i < 4L * 1024 * 128; i += gs) {
        const int n = (int)(i % 1024), k8 = (int)((i / 1024) % 128), l = (int)(i / (1024L * 128));
        const float* w = a.w_out + ((size_t)l * 1024 + k8 * 8) * 1024 + n; float v[8];
#pragma unroll
        for (int j = 0; j < 8; ++j) v[j] = w[(size_t)j * 1024];
        v4u o; o.x = pk2(v[0], v[1]); o.y = pk2(v[2], v[3]); o.z = pk2(v[4], v[5]); o.w = pk2(v[6], v[7]);
        *(v4u*)(WOUT + ((size_t)l * 1024 + n) * 1024 + k8 * 8) = o;
    }
    { bf16* XA = (bf16*)(a.ws + WS_XA); float* RS = (float*)(a.ws + WS_RS); const int lane = tid & 63;
        for (int m = wg * NWAVES + (tid >> 6); m < M; m += G * NWAVES) { const f32x4* xr = (const f32x4*)(a.x + (size_t)m * DM) + lane; v2u* o = (v2u*)(XA + (size_t)m * DM) + lane; float s = 0.f;
#pragma unroll
            for (int j = 0; j < 4; ++j) { const f32x4 v = xr[64 * j]; v2u w; w.x = pk2(v.x, v.y); w.y = pk2(v.z, v.w); o[64 * j] = w; s += (bflo(w.x) * bflo(w.x) + bfhi(w.x) * bfhi(w.x)) + (bflo(w.y) * bflo(w.y) + bfhi(w.y) * bfhi(w.y)); }
            s = wave_sum(s, lane); if (lane < 16) RS[(size_t)m * 16 + lane] = (lane == 0) ? s : 0.f; } }
}
__device__ __forceinline__ void norm_phase(const float* src, const float* g, bf16* dst, int gw, int NGW, int lane) {
    for (int m = gw; m < M; m += NGW) {
        const f32x4* xr = (const f32x4*)(src + (size_t)m * DM) + lane; f32x4 v[4]; float s = 0.f;
#pragma unroll
        for (int j = 0; j < 4; ++j) { v[j] = xr[64 * j]; s += (v[j].x * v[j].x + v[j].y * v[j].y) + (v[j].z * v[j].z + v[j].w * v[j].w); }
        const float r = 1.0f / sqrtf(wave_sum(s, lane) * (1.f / DM) + EPS);
        const f32x4* gr = (const f32x4*)g + lane; v2u* o = (v2u*)(dst + (size_t)m * DM) + lane;
#pragma unroll
        for (int j = 0; j < 4; ++j) { const f32x4 gv = gr[64 * j]; v2u w; w.x = pk2(v[j].x * r * gv.x, v[j].y * r * gv.y); w.y = pk2(v[j].z * r * gv.z, v[j].w * r * gv.w); o[64 * j] = w; }
    }
}
__device__ __forceinline__ void final_norm_phase(const bf16* xa, float* out, const float* g, const float* RS, int gw, int NGW, int lane) {
    for (int m = gw; m < M; m += NGW) {
        const v2u* xr = (const v2u*)(xa + (size_t)m * DM) + lane; f32x4* orow = (f32x4*)(out + (size_t)m * DM) + lane;
        const f32x4* rs = (const f32x4*)(RS + (size_t)m * 16); const f32x4 s0 = rs[0], s1 = rs[1], s2 = rs[2], s3 = rs[3];
        const float ss = (((s0[0] + s0[1]) + (s0[2] + s0[3])) + ((s1[0] + s1[1]) + (s1[2] + s1[3]))) + (((s2[0] + s2[1]) + (s2[2] + s2[3])) + ((s3[0] + s3[1]) + (s3[2] + s3[3])));
        const float r = 1.0f / sqrtf(ss * (1.f / DM) + EPS);
        const f32x4* gr = (const f32x4*)g + lane;
#pragma unroll
        for (int j = 0; j < 4; ++j) { const f32x4 gv = gr[64 * j]; const v2u w = xr[64 * j]; orow[64 * j] = (f32x4){bflo(w.x) * r * gv.x, bfhi(w.x) * r * gv.y, bflo(w.y) * r * gv.z, bfhi(w.y) * r * gv.w}; }
    }
}
__device__ __forceinline__ void rowscale_phase(const float* RS, float* RSC, int wg, int G, int tid) {
    for (int m = wg * NTHR + tid; m < M; m += G * NTHR) { const f32x4* rs = (const f32x4*)(RS + (size_t)m * 16); const f32x4 s0 = rs[0], s1 = rs[1], s2 = rs[2], s3 = rs[3];
        const float ss = (((s0[0] + s0[1]) + (s0[2] + s0[3])) + ((s1[0] + s1[1]) + (s1[2] + s1[3]))) + (((s2[0] + s2[1]) + (s2[2] + s2[3])) + ((s3[0] + s3[1]) + (s3[2] + s3[3])));
        RSC[m] = 1.0f / sqrtf(ss * (1.0f / 1024.0f) + EPS); }
}
__device__ __forceinline__ void pool_phase(const Args& a, int l, unsigned char* lds, int wg, int G, int tid) {
    float* wsm = (float*)lds; float* us = (float*)(lds + 16384); float* ps = (float*)(lds + 32768);
    const bf16* P = (const bf16*)(a.ws + WS_P); bf16* Y = (bf16*)(a.ws + WS_XB);
    for (int g = 0; g < 4; ++g) {
        __syncthreads();
        const float* pw = a.pool_w + (size_t)(l * 4 + g) * 4096;
        for (int i = tid; i < 4096; i += NTHR) wsm[i] = pw[i];
        const int w = 2 << g;
        for (int tile = wg; tile < M / 32; tile += G) {
            __syncthreads();
            const int m0 = tile * 32, t0 = m0 % SEQ;
            for (int i = tid; i < 47 * 64; i += NTHR) { const int r = i >> 6, c = i & 63; float v = 0.f;
                if (t0 + r - 15 >= 0) v = bf2f(P[(size_t)(m0 - 15 + r) * NP + N_PU + g * 64 + c]);
                us[i] = v; }
            __syncthreads();
            { const int t = tid >> 4, c4 = (tid & 15) * 4, pos = t0 + t; const int cnt = (pos + 1 < w) ? pos + 1 : w; const float inv = 1.0f / (float)cnt;
#pragma unroll
                for (int k = 0; k < 4; ++k) { const int c = c4 + k; float s = 0.f; for (int j = 0; j < w; ++j) s += us[(t + 15 - j) * 64 + c]; ps[t * 64 + c] = s * inv - us[(t + 15) * 64 + c]; } }
            __syncthreads();
            { const int t = tid >> 4, d4 = (tid & 15) * 4; float a0 = 0.f, a1 = 0.f, a2 = 0.f, a3 = 0.f;
                for (int c = 0; c < 64; ++c) { const float p = ps[t * 64 + c]; const f32x4 wv = *(const f32x4*)&wsm[c * 64 + d4]; a0 += p * wv.x; a1 += p * wv.y; a2 += p * wv.z; a3 += p * wv.w; }
                const size_t m = (size_t)m0 + t; const v2u gw2 = *(const v2u*)(P + m * NP + N_PG + g * 64 + d4);
                const float* scl = a.pool_scale + l * 256 + g * 64 + d4;
                const float y0 = a0 * scl[0] * silu_f(bflo(gw2.x)), y1 = a1 * scl[1] * silu_f(bfhi(gw2.x)), y2 = a2 * scl[2] * silu_f(bflo(gw2.y)), y3 = a3 * scl[3] * silu_f(bfhi(gw2.y));
                v2u o; o.x = pk2(y0, y1); o.y = pk2(y2, y3); *(v2u*)(Y + m * DM + 768 + g * 64 + d4) = o; }
        }
    }
    __syncthreads();
}
__device__ __forceinline__ void gla_rec_phase(const Args& a, int l, unsigned char* lds, int unit, int tid) {
    const int b = unit >> 2, h = unit & 3;
    float* qs = (float*)lds; float* ks = (float*)(lds + 12288); float* es = (float*)(lds + 24576); float* vs = (float*)(lds + 36864); float* os = (float*)(lds + 61440);
    float* w2s = (float*)(lds + 86016); float* bs = (float*)(lds + 89088); float* gzs = (float*)(lds + 89280);
    const bf16* P = (const bf16*)(a.ws + WS_P); bf16* Y = (bf16*)(a.ws + WS_XB);
    __syncthreads();
    for (int i = tid; i < 16 * 48; i += NTHR) { const int r = i / 48, d = i % 48; w2s[i] = a.gate_w2[(size_t)(l * 16 + r) * 192 + h * 48 + d]; }
    if (tid < 48) bs[tid] = a.gate_b[l * 192 + h * 48 + tid];
    float S[48];
#pragma unroll
    for (int d = 0; d < 48; ++d) S[d] = 0.f;
    for (int blk = 0; blk < SEQ / 64; ++blk) {
        const size_t m0 = (size_t)b * SEQ + (size_t)blk * 64;
        __syncthreads();
        for (int i = tid; i < 64 * 48; i += NTHR) { const int t = i / 48, d = i % 48; const bf16* row = P + (m0 + t) * NP; qs[i] = bf2f(row[N_GQ + h * 48 + d]); ks[i] = bf2f(row[N_GK + h * 48 + d]); }
        for (int i = tid; i < 64 * 96; i += NTHR) { const int t = i / 96, v = i % 96; vs[i] = bf2f(P[(m0 + t) * NP + N_GV + h * 96 + v]); }
        for (int i = tid; i < 64 * 16; i += NTHR) { const int t = i >> 4, r = i & 15; gzs[i] = bf2f(P[(m0 + t) * NP + N_GZ + r]); }
        __syncthreads();
        for (int i = tid; i < 64 * 48; i += NTHR) { const int t = i / 48, d = i % 48; float z = bs[d];
#pragma unroll
            for (int r = 0; r < 16; ++r) z += gzs[t * 16 + r] * w2s[r * 48 + d];
            const float ls = fminf(z, 0.f) - log1pf(__expf(-fabsf(z)));
            es[i] = __expf(ls * (1.0f / 16.0f)); }
        __syncthreads();
        if (tid < 96) { const int v = tid;
            for (int t = 0; t < 64; ++t) { const float vv = vs[t * 96 + v]; float o = 0.f;
#pragma unroll
                for (int d = 0; d < 48; ++d) { S[d] = es[t * 48 + d] * S[d] + ks[t * 48 + d] * vv; o += qs[t * 48 + d] * S[d]; }
                os[t * 96 + v] = o; } }
        __syncthreads();
        { const int t = tid >> 3, part = tid & 7; float ov[12]; float ss = 0.f;
#pragma unroll
            for (int k = 0; k < 12; ++k) { ov[k] = os[t * 96 + part * 12 + k]; ss += ov[k] * ov[k]; }
            { const int ln = tid & 63; ss += shx(ss, 1, ln); ss += shx(ss, 2, ln); ss += shx(ss, 4, ln); }
            const float r = 1.0f / sqrtf(ss * (1.0f / 96.0f) + EPS);
            const size_t m = m0 + t; const bf16* gp = P + m * NP + N_GG + h * 96 + part * 12; const float* ng = a.gla_norm_g + l * 96 + part * 12;
            unsigned* yo = (unsigned*)(Y + m * DM + h * 96 + part * 12);
#pragma unroll
            for (int k = 0; k < 12; k += 2) { const float y0 = ov[k] * r * ng[k] * silu_f(bf2f(gp[k])), y1 = ov[k + 1] * r * ng[k + 1] * silu_f(bf2f(gp[k + 1])); yo[k >> 1] = pk2(y0, y1); } }
    }
    __syncthreads();
}
template <bool BITS_ONLY> __device__ __forceinline__ void dsa_slow_query(const Args& a, unsigned char* lds, int b, int t, int tid) {
    const int lane = tid & 63, wave = tid >> 6;
    unsigned* sc = (unsigned*)lds; int* hist = (int*)(lds + 32768); int* sel = (int*)(lds + 33792); float* qf = (float*)(lds + 34816); float* wq = (float*)(lds + 35328);
    int* misc = (int*)(lds + 35344); float* qh = (float*)(lds + 35456); float* lg = (float*)(lds + 36992); float* inv = (float*)(lds + 43136);
    const bf16* P = (const bf16*)(a.ws + WS_P); bf16* Y = (bf16*)(a.ws + WS_XB);
    {
        const size_t m = (size_t)b * SEQ + t; const int N = t + 1;
        __syncthreads();
        if (tid < 128) qf[tid] = bf2f(P[m * NP + N_QI + tid]);
        if (tid >= 128 && tid < 132) wq[tid - 128] = bf2f(P[m * NP + N_WI + tid - 128]);
        for (int i = tid; i < 384; i += NTHR) qh[i] = bf2f(P[m * NP + N_DQ + i]);
        __syncthreads();
        for (int s = tid; s < N; s += NTHR) {
            const v4u* kr = (const v4u*)(P + ((size_t)b * SEQ + s) * NP + N_KI); float kf[32];
#pragma unroll
            for (int c = 0; c < 4; ++c) { const v4u w = kr[c]; kf[8 * c] = bflo(w.x); kf[8 * c + 1] = bfhi(w.x); kf[8 * c + 2] = bflo(w.y); kf[8 * c + 3] = bfhi(w.y); kf[8 * c + 4] = bflo(w.z); kf[8 * c + 5] = bfhi(w.z); kf[8 * c + 6] = bflo(w.w); kf[8 * c + 7] = bfhi(w.w); }
            float score = 0.f;
#pragma unroll
            for (int hh = 0; hh < 4; ++hh) { float dot = 0.f;
#pragma unroll
                for (int d = 0; d < 32; ++d) dot += qf[hh * 32 + d] * kf[d];
                score += wq[hh] * fmaxf(dot, 0.f); }
            const unsigned u = __builtin_bit_cast(unsigned, score);
            sc[s] = (u & 0x80000000u) ? ~u : (u | 0x80000000u);
        }
        __syncthreads();
        int L;
        if (N <= 256) { if (tid < N) sel[tid] = tid; L = N; }
        else {
            unsigned prefix = 0u; int kk = 256;
            for (int pass = 0; pass < 4; ++pass) {
                const int shift = 24 - 8 * pass;
                if (tid < 256) hist[tid] = 0;
                __syncthreads();
                for (int s = tid; s < N; s += NTHR) { const unsigned key = sc[s]; const bool match = (pass == 0) ? true : ((key >> ((shift + 8) & 31)) == prefix); if (match) atomicAdd(&hist[(key >> shift) & 255u], 1); }
                __syncthreads();
                if (wave == 0) {
                    const int c0 = hist[4 * lane], c1 = hist[4 * lane + 1], c2 = hist[4 * lane + 2], c3 = hist[4 * lane + 3]; const int tot = c0 + c1 + c2 + c3;
                    int incl = tot;
#pragma unroll
                    for (int o = 1; o < 64; o <<= 1) { const int tt = shdn(incl, o, lane); if (lane + o < 64) incl += tt; }
                    const int excl = incl - tot;
                    if (excl < kk && kk <= incl) { int above = excl, D;
                        if (above + c3 >= kk) D = 4 * lane + 3;
                        else { above += c3; if (above + c2 >= kk) D = 4 * lane + 2; else { above += c2; if (above + c1 >= kk) D = 4 * lane + 1; else { above += c1; D = 4 * lane; } } }
                        misc[1] = D; misc[2] = above; }
                }
                __syncthreads();
                prefix = (prefix << 8) | (unsigned)misc[1]; kk -= misc[2];
            }
            const unsigned tau = prefix;
            const int seg = (((N + 7) >> 3) + 63) & ~63; const int s_lo = wave * seg, s_hi = (s_lo + seg < N) ? s_lo + seg : N;
            { int cg = 0, ce = 0;
                for (int base = s_lo; base < s_hi; base += 64) { const int s = base + lane; const bool in = s < s_hi; const unsigned key = in ? sc[s] : 0u;
                    cg += __popcll(__ballot(in && key > tau)); ce += __popcll(__ballot(in && key == tau)); }
                if (lane == 0) { misc[4 + wave] = cg; misc[12 + wave] = ce; } }
            __syncthreads();
            { int bg = 0, be = 0;
                for (int w2 = 0; w2 < 8; ++w2) if (w2 < wave) { bg += misc[4 + w2]; be += misc[12 + w2]; }
                int run_sel = bg + (be < kk ? be : kk), run_eq = be;
                for (int base = s_lo; base < s_hi; base += 64) { const int s = base + lane; const bool in = s < s_hi; const unsigned key = in ? sc[s] : 0u;
                    const bool gt = in && key > tau, eq = in && key == tau; const unsigned long long me = __ballot(eq); const unsigned long long lt = (1ull << lane) - 1ull;
                    const bool take = gt || (eq && (run_eq + __popcll(me & lt) < kk)); const unsigned long long mt = __ballot(take);
                    if (take) sel[run_sel + __popcll(mt & lt)] = s;
                    run_sel += __popcll(mt); run_eq += __popcll(me); } }
            L = 256;
        }
        __syncthreads();
        if constexpr (BITS_ONLY) {
            unsigned* bm = (unsigned*)lg; unsigned* MK = (unsigned*)(a.ws + WS_MASK);
            if (tid < 256) bm[tid] = 0u;
            __syncthreads();
            if (tid < L) { const int s = sel[tid]; const int kt = s >> 6, kap = s & 63, half = kap >> 5, k5 = kap & 31, hi = (k5 >> 2) & 1, r = (k5 & 3) + 4 * (k5 >> 3);
                atomicOr(&bm[kt * 2 + hi], 1u << (r + 16 * half)); }
            __syncthreads();
            const int ntw = ((t >> 8) + 1) * 8;
            if (tid < ntw) { const int kt = tid >> 1, hi = tid & 1; MK[((size_t)(b * 256 + (t >> 5)) * 128 + kt) * 64 + (t & 31) + 32 * hi] = bm[tid]; }
            __syncthreads();
            return;
        }
        { const int j = tid >> 1, h0 = (tid & 1) * 3;
            if (j < L) { const int s = sel[j]; const size_t srow = (size_t)b * SEQ + s; const int bk = t5_bucket(t - s);
#pragma unroll
                for (int hh = 0; hh < 3; ++hh) { const int h = h0 + hh; const v4u* kr = (const v4u*)(P + srow * NP + N_DK + h * 64); const float* q = qh + h * 64; float dot = 0.f;
#pragma unroll
                    for (int c = 0; c < 8; ++c) { const v4u w = kr[c]; dot += q[8 * c] * bflo(w.x) + q[8 * c + 1] * bfhi(w.x) + q[8 * c + 2] * bflo(w.y) + q[8 * c + 3] * bfhi(w.y) + q[8 * c + 4] * bflo(w.z) + q[8 * c + 5] * bfhi(w.z) + q[8 * c + 6] * bflo(w.w) + q[8 * c + 7] * bfhi(w.w); }
                    lg[h * 256 + j] = dot + a.rel_bias[bk * 6 + h] * LOG2E; } }
            else {
#pragma unroll
                for (int hh = 0; hh < 3; ++hh) lg[(h0 + hh) * 256 + j] = -INFINITY; } }
        __syncthreads();
        if (wave < 6) { float* row = lg + wave * 256; float v0 = row[lane], v1 = row[lane + 64], v2 = row[lane + 128], v3 = row[lane + 192];
            float mx = fmaxf(fmaxf(v0, v1), fmaxf(v2, v3));
#pragma unroll
            for (int o = 1; o < 64; o <<= 1) mx = fmaxf(mx, shx(mx, o, lane));
            v0 = exp2f(v0 - mx); v1 = exp2f(v1 - mx); v2 = exp2f(v2 - mx); v3 = exp2f(v3 - mx);
            const float sm = wave_sum((v0 + v1) + (v2 + v3), lane);
            row[lane] = v0; row[lane + 64] = v1; row[lane + 128] = v2; row[lane + 192] = v3;
            if (lane == 0) inv[wave] = 1.0f / sm; }
        __syncthreads();
        if (tid < 384) { const int h = tid >> 6, d = tid & 63; float acc = 0.f; const bf16* vb = P + (size_t)b * SEQ * NP + N_DV + h * 64 + d;
            for (int j = 0; j < L; ++j) acc += lg[h * 256 + j] * bf2f(vb[(size_t)sel[j] * NP]);
            const float o = acc * inv[h]; const float gate = bf2f(P[m * NP + N_DG + h * 64 + d]);
            Y[m * DM + 384 + h * 64 + d] = (bf16)f2bf(o * silu_f(gate)); }
    }
    __syncthreads();
}
template <bool BITS_ONLY> __device__ __forceinline__ void dsa_slow_phase(const Args& a, int l, unsigned char* lds, int wg, int G, int tid) {
    for (int qi = wg; qi < M; qi += G) { asm volatile("" : "+v"(tid)); dsa_slow_query<BITS_ONLY>(a, lds, qi & 7, qi >> 3, tid); }
}
__device__ __forceinline__ void index_phase(const Args& a, unsigned char* lds, unsigned* qctr, volatile LAS unsigned* MISC, int tid) {
    const unsigned short* P = (const unsigned short*)(a.ws + WS_P); unsigned* MK = (unsigned*)(a.ws + WS_MASK);
    __syncthreads();
    if (tid <= 256) ((float*)(lds + idxb::L_XT))[tid] = tid < 256 ? idxb::xthr(tid) : __builtin_inff();
    int bq = blockIdx.x & 7, tries = 0;
    for (;;) {
        asm volatile("" : "+v"(tid));
        __syncthreads();
        if (tid == 0) MISC[17] = __hip_atomic_fetch_add(qctr + 64 * bq, 1u, __ATOMIC_RELAXED, __HIP_MEMORY_SCOPE_AGENT);
        __syncthreads();
        const int k = (int)MISC[17];
        if (k >= 256) { if (++tries == 8) break; bq = (bq + 1) & 7; continue; }
        const int b = bq, qt = 255 - k;
        idxb::index_unit(P, (const unsigned short*)(a.ws + WS_KC), MK, (unsigned*)(a.ws + WS_ZW) + (size_t)blockIdx.x * 128 * 64, lds, b, qt, tid);
        const int* par = (const int*)(lds + idxb::L_PAR);
        if (par[idxb::P_ANY3 * 32]) for (int q = 0; q < 32; ++q) if (par[idxb::P_MODE * 32 + q] == 3) dsa_slow_query<true>(a, lds, b, qt * 32 + q, tid);
    }
}
#ifndef REP_POOL
#define REP_POOL 1
#endif
#ifndef ATT_PRIO
#define ATT_PRIO 0
#endif
#ifndef REP_IDX
#define REP_IDX 1
#endif
#ifndef REP_GLA
#define REP_GLA 1
#endif
#ifndef REP_ATT
#define REP_ATT 1
#endif
#ifndef REP_PREP
#define REP_PREP 1
#endif
#ifndef REP_PRO
#define REP_PRO 1
#endif
#ifndef REP_NORM
#define REP_NORM 1
#endif
#ifndef REP_ALL
#define REP_ALL 1
#endif
#ifndef REP_BAR
#define REP_BAR 1
#endif
#ifndef REP_OUT
#define REP_OUT 1
#endif
#ifndef REP_INP
#define REP_INP 1
#endif
#ifndef GLA_MODE
#define GLA_MODE 1
#endif
#ifndef DSA_MODE
#define DSA_MODE 2
#endif
#ifndef MK_SINGLE
#define MK_SINGLE 1
#endif
__global__ void __launch_bounds__(NTHR, 2) fwd(Args a) {
    extern __shared__ __attribute__((aligned(16))) unsigned char lds[];
    int tid = threadIdx.x, lane = tid & 63, wave = __builtin_amdgcn_readfirstlane(tid >> 6);
    int G = gridDim.x, wg = blockIdx.x;
    const int wave0 = __builtin_amdgcn_readfirstlane(tid >> 6);
#define LAUNDER() do { { int wv_ = wave0; asm volatile("" : "+s"(wv_)); unsigned on_ = ~0u; asm volatile("" : "+s"(on_)); tid = wv_ * 64 + (int)__builtin_amdgcn_mbcnt_hi(on_, __builtin_amdgcn_mbcnt_lo(on_, 0u)); asm volatile("" : "+v"(tid)); } wg = blockIdx.x; G = gridDim.x; asm volatile("" : "+s"(wg), "+s"(G));     \
    lane = tid & 63; wave = __builtin_amdgcn_readfirstlane(tid >> 6); gw = wg * NWAVES + wave; NGW = G * NWAVES; } while (0)
    volatile LAS unsigned* MISC = (volatile LAS unsigned*)((LAS unsigned char*)lds + MISC_OFF);
    for (int u = tid; u < (LDS_BYTES - LDSCTL_OFF) / 4; u += NTHR) ((LAS unsigned*)((LAS unsigned char*)lds + LDSCTL_OFF))[u] = 0u;
    __syncthreads();
    XcdBarrier bar; bar.bar = (unsigned*)(a.ws + WS_CTL) + CW_BAR; bar.x = 0; bar.st = nullptr;
    const bool one = a.single != 0;
    if (one) bar = xcd_barrier_post((unsigned*)(a.ws + WS_CTL) + CW_BAR, MISC + 8);
#define IN(k) (a.ph_lo <= (k) && (k) < a.ph_hi)
#define SEAM() do { if (one) { unsigned* bp_ = (unsigned*)(a.ws + WS_CTL) + CW_BAR; asm volatile("" : "+s"(bp_)); XcdBarrier bb_; bb_.bar = bp_; bb_.x = bar.x; bb_.st = bar.st; xcd_barrier(bb_); if (REP_BAR == 2) xcd_barrier(bb_); } } while (0)
    int gw = wg * NWAVES + wave, NGW = G * NWAVES;
    bf16* XB = (bf16*)(a.ws + WS_XB); bf16* PB = (bf16*)(a.ws + WS_P);
    for (int rpw = 0; rpw < REP_ALL; ++rpw) {
    LAUNDER();
    if (IN(0)) { for (int rp = 0; rp < REP_PRO; ++rp) prologue_phase(a, wg, G, tid); SEAM(); }
    for (int l = a.l_lo; l < a.l_hi; ++l) {
        LAUNDER();
        if (IN(1)) { rowscale_phase((const float*)(a.ws + WS_RS), (float*)(a.ws + WS_RSC), wg, G, tid); SEAM(); }
        LAUNDER();
        if (IN(2)) {
            pg8::Gemm g{(const bf16*)(a.ws + WS_XA), (const bf16*)(a.ws + WS_WIN) + (size_t)l * NP * 1024, M, NP, DM}; pg8::StaticOrder S; S.init(M, NP, G, wg);
            pg8::EpiP E{PB, NP, (const float*)(a.ws + WS_RSC), (pg8::bf16_t*)(a.ws + WS_KC)};
            pg8::gemm_phase<pg8::EpiP, pg8::StaticOrder, true, true>((PG8_LAS unsigned char*)lds, g, S, E, tid);
#if REP_INP == 2
            asm volatile("" : "+v"(tid)); __syncthreads(); pg8::gemm_phase<pg8::EpiP, pg8::StaticOrder, true, true>((PG8_LAS unsigned char*)lds, g, S, E, tid);
#endif
            SEAM();
        }
        LAUNDER();
        if (IN(3)) {
#if GLA_MODE == 0
            if (wg < 32) gla_rec_phase(a, l, lds, wg, tid);
#endif
            for (int rp = 0; rp < REP_POOL; ++rp) { asm volatile("" : "+v"(tid)); poolb::pool_phase(PB, XB, a.pool_w + (size_t)l * 4 * 4096, a.pool_scale + l * 256, lds, wg, G, tid); }
#if GLA_MODE == 1
            glab::gla_prep_loop(PB, a.ws + WS_GOP, a.gate_w2 + (size_t)l * 16 * 192, a.gate_b + l * 192, lds, wg, G, tid);
#if REP_PREP == 2
            __syncthreads(); asm volatile("" : "+v"(tid), "+s"(wg));
            for (int item = wg; item < BATCH * 4 * 128; item += G) { asm volatile("" : "+v"(tid)); glab::gla_prep_item(PB, a.ws + WS_GOP, a.gate_w2 + (size_t)l * 16 * 192, a.gate_b + l * 192, lds, item, tid); }
#endif
            __syncthreads();
#endif
#if DSA_MODE == 0
            dsa_slow_phase<false>(a, l, lds, wg, G, tid);
#elif DSA_MODE == 1
            dsa_slow_phase<true>(a, l, lds, wg, G, tid);
#else
            for (int rp = 0; rp < REP_IDX; ++rp) { asm volatile("" : "+v"(tid)); index_phase(a, lds, (unsigned*)(a.ws + WS_CTL) + CW_QUEUE + 64 * (32 + 8 * (l + 4 * rp + 8 * rpw)), MISC, tid); }
#endif
            SEAM();
        }
        LAUNDER();
        if (IN(4)) {
#if DSA_MODE >= 1
            { float* dl = (float*)(lds + 86016);
                for (int i = tid; i < 1032; i += NTHR) { const int rel = i >> 3, h = i & 7; dl[i] = (h < 6 && rel < 128) ? (a.rel_bias[(int)T5B[rel] * 6 + h] - a.rel_bias[31 * 6 + h]) * LOG2E : 0.f; } for (int i = tid; i < 512; i += NTHR) { const unsigned nb = ((unsigned)(i >> 1) >> (4 * (i & 1))) & 15u; ((unsigned*)(lds + attn_body::LDS_TAB))[i] = (nb & 1u ? 0xffu : 0u) | (nb & 2u ? 0xff00u : 0u) | (nb & 4u ? 0xff0000u : 0u) | (nb & 8u ? 0xff000000u : 0u); }
                __syncthreads();
                const attn_body::AttnTensors AT{(const attn_body::bf16*)(PB + N_DQ), (const attn_body::bf16*)(PB + N_DK), (const attn_body::bf16*)(PB + N_DV), (attn_body::bf16*)(XB + 384), (const attn_body::bf16*)(PB + N_DG), (const unsigned*)(a.ws + WS_MASK)};
#if GLA_MODE == 1
                if (wg < 32) { glab::gla_seq_unit(PB, XB, a.ws + WS_GOP, a.gla_norm_g + l * 96, lds, wg >> 2, wg & 3, tid);
#if REP_GLA == 2
                    asm volatile("" : "+v"(tid)); glab::gla_seq_unit(PB, XB, a.ws + WS_GOP, a.gla_norm_g + l * 96, lds, wg >> 2, wg & 3, tid);
#endif
                    for (int i = tid; i < 1032; i += NTHR) { const int rel = i >> 3, h = i & 7; dl[i] = (h < 6 && rel < 128) ? (a.rel_bias[(int)T5B[rel] * 6 + h] - a.rel_bias[31 * 6 + h]) * LOG2E : 0.f; } for (int i = tid; i < 512; i += NTHR) { const unsigned nb = ((unsigned)(i >> 1) >> (4 * (i & 1))) & 15u; ((unsigned*)(lds + attn_body::LDS_TAB))[i] = (nb & 1u ? 0xffu : 0u) | (nb & 2u ? 0xff00u : 0u) | (nb & 4u ? 0xff0000u : 0u) | (nb & 8u ? 0xff000000u : 0u); }
                    __syncthreads(); }
#endif
#if ATT_PRIO
                if (__builtin_amdgcn_readfirstlane(tid) >= 256) __builtin_amdgcn_s_setprio(1);
#endif
                for (int rp = 0; rp < REP_ATT; ++rp) { unsigned* qctr = (unsigned*)(a.ws + WS_CTL) + CW_QUEUE + 64 * (l * 4 + rp + 2 * rpw);
                for (;;) { asm volatile("" : "+v"(tid));
                    __syncthreads();
                    if (tid == 0) MISC[16] = __hip_atomic_fetch_add(qctr, 1u, __ATOMIC_RELAXED, __HIP_MEMORY_SCOPE_AGENT);
                    __syncthreads();
                    const int k = (int)MISC[16];
                    if (k >= 48 * 32) break;
                    const int qb = 31 - k / 48, bh = k % 48;
                    attn_body::attn_unit<24>(bh / 6, bh % 6, qb, AT.Q, AT.K, AT.V, AT.O, AT.GT, AT.MK, (attn_body::lds_cfptr)(LAS const float*)((LAS unsigned char*)lds + 86016), (char*)lds, tid); } }
#if ATT_PRIO
                __builtin_amdgcn_s_setprio(0);
#endif
            }
#endif
            SEAM();
        }
        LAUNDER();
        if (IN(5)) {
            pg8::Gemm g{XB, (const bf16*)(a.ws + WS_WOUT) + (size_t)l * 1024 * 1024, M, DM, DM}; pg8::StaticOrder S; S.init(M, DM, G, wg);
            pg8::EpiRes E{(bf16*)(a.ws + WS_XA), DM, (float*)(a.ws + WS_RS)};
            pg8::gemm_phase<pg8::EpiRes, pg8::StaticOrder, true, true>((PG8_LAS unsigned char*)lds, g, S, E, tid);
#if REP_OUT == 2
            { asm volatile("" : "+v"(tid)); __syncthreads(); pg8::EpiRes E2{(bf16*)(a.ws + WS_P), DM, (float*)(a.ws + WS_P) + (size_t)M * DM}; pg8::gemm_phase<pg8::EpiRes, pg8::StaticOrder, true, true>((PG8_LAS unsigned char*)lds, g, S, E2, tid); }
#endif
            SEAM();
        }
    }
    }
    LAUNDER();
    if (IN(6)) final_norm_phase((const bf16*)(a.ws + WS_XA), a.out, a.final_g, (const float*)(a.ws + WS_RS), gw, NGW, lane);
#undef IN
#undef SEAM
}

extern "C" void kernel_launch(void* const* d_in, const int* in_sizes, int n_in, void* d_out, int out_size, void* d_ws, size_t ws_size, hipStream_t stream) {
    static int grid = 0;
    if (grid == 0) {
        if (n_in != 11 || in_sizes[0] != M * DM || out_size != M * DM || ws_size < WS_END) { fprintf(stderr, "kernel_launch: unexpected shapes (n_in %d, in0 %d, out %d, ws %zu); nothing launched\n", n_in, n_in > 0 ? in_sizes[0] : -1, out_size, ws_size); grid = -1; return; }
        int dev = 0, cus = 0, per_cu = 0;
        if (hipGetDevice(&dev) != hipSuccess || hipDeviceGetAttribute(&cus, hipDeviceAttributeMultiprocessorCount, dev) != hipSuccess) { grid = -1; return; }
        if (hipFuncSetAttribute((const void*)fwd, hipFuncAttributeMaxDynamicSharedMemorySize, LDS_BYTES) != hipSuccess) { fprintf(stderr, "kernel_launch: hipFuncSetAttribute failed\n"); grid = -1; return; }
        if (hipOccupancyMaxActiveBlocksPerMultiprocessor(&per_cu, (const void*)fwd, NTHR, LDS_BYTES) != hipSuccess || per_cu < 1) fprintf(stderr, "kernel_launch: occupancy query reports %d\n", per_cu);
        (void)hipGetLastError();
        grid = cus;
    }
    if (grid < 0) return;
    if (hipMemsetAsync((char*)d_ws + WS_CTL, 0, CTL_ZERO_BYTES, stream) != hipSuccess) return;
    Args a{};
    a.x = (const float*)d_in[0]; a.norm_g = (const float*)d_in[1]; a.w_in = (const float*)d_in[2]; a.gate_w2 = (const float*)d_in[3]; a.gate_b = (const float*)d_in[4]; a.gla_norm_g = (const float*)d_in[5];
    a.rel_bias = (const float*)d_in[6]; a.pool_w = (const float*)d_in[7]; a.pool_scale = (const float*)d_in[8]; a.w_out = (const float*)d_in[9]; a.final_g = (const float*)d_in[10];
    a.out = (float*)d_out; a.ws = (unsigned char*)d_ws; a.pad = 0;
#if MK_SINGLE
    a.l_lo = 0; a.l_hi = DEPTH; a.ph_lo = 0; a.ph_hi = 7; a.single = 1;
    hipLaunchKernelGGL(fwd, dim3(grid), dim3(NTHR), LDS_BYTES, stream, a);
#else
    a.single = 0;
    a.l_lo = 0; a.l_hi = 0; a.ph_lo = 0; a.ph_hi = 1; hipLaunchKernelGGL(fwd, dim3(grid), dim3(NTHR), LDS_BYTES, stream, a);
    for (int l = 0; l < DEPTH; ++l) for (int ph = 1; ph <= 5; ++ph) { a.l_lo = l; a.l_hi = l + 1; a.ph_lo = ph; a.ph_hi = ph + 1; hipLaunchKernelGGL(fwd, dim3(grid), dim3(NTHR), LDS_BYTES, stream, a); }
    a.l_lo = 0; a.l_hi = 0; a.ph_lo = 6; a.ph_hi = 7; hipLaunchKernelGGL(fwd, dim3(grid), dim3(NTHR), LDS_BYTES, stream, a);
#endif
    const hipError_t le = hipPeekAtLastError();
    if (le != hipSuccess) fprintf(stderr, "kernel_launch: launch failed: %s\n", hipGetErrorName(le));
}
```
